# Optimizing an MI355X kernel written in HIP

```python
import math
import jax, jax.numpy as jnp
from jax import lax
import numpy as np

D_MODEL = 2048
BATCH = 4
SEQ = 4096
DEPTH = 2

BLOCK = 128
EPS = 1e-6
N_HEADS_MLA = 8
Q_LORA = 512
KV_LORA = 512
QK_NOPE = 128
QK_ROPE = 64
V_DIM = 128
ROPE_THETA = 10000.0
N_HEADS_DIL = 8
HEAD_DIM = 128
DIL_PATTERNS = ((128, 1), (512, 4), (2048, 16))
N_BUCKETS = 32
BUCKET_MAX_DIST = 2048
N_HEADS_SB = 16

MIX_A = N_HEADS_MLA * V_DIM
MIX_B = N_HEADS_DIL * HEAD_DIM
MIX_EVEN = MIX_A + MIX_B
MIX_ODD = N_HEADS_SB * HEAD_DIM
EVEN_SPLITS = (Q_LORA, KV_LORA, QK_ROPE, MIX_B, MIX_B, MIX_B, MIX_EVEN)
ODD_SPLITS = (MIX_ODD, MIX_ODD, MIX_ODD, MIX_ODD)
IN_EVEN = sum(EVEN_SPLITS)
IN_ODD = sum(ODD_SPLITS)
N_EVEN = (DEPTH + 1) // 2
N_ODD = DEPTH // 2

kernel_name = "hybrid_mla_dilated_stickbreaking"


def rms_norm(x, gain):
    x32 = x.astype(jnp.float32)
    y = x32 * lax.rsqrt(jnp.mean(x32 * x32, axis=-1, keepdims=True) + EPS)
    return y.astype(x.dtype) * gain


def split_cols(t, widths):
    offs = np.cumsum(widths)[:-1].tolist()
    return jnp.split(t, offs, axis=-1)


def to_heads(t, n):
    b, s, _ = t.shape
    return t.reshape(b, s, n, -1).transpose(0, 2, 1, 3)


def from_heads(t):
    b, n, s, d = t.shape
    return t.transpose(0, 2, 1, 3).reshape(b, s, n * d)


def rope(x, pos):
    half = QK_ROPE // 2
    inv = 1.0 / (ROPE_THETA ** (jnp.arange(half, dtype=jnp.float32) / half))
    ang = pos.astype(jnp.float32)[:, None] * inv[None, :]
    cos = jnp.cos(ang).astype(x.dtype)
    sin = jnp.sin(ang).astype(x.dtype)
    x1, x2 = x[..., :half], x[..., half:]
    return jnp.concatenate([x1 * cos - x2 * sin, x1 * sin + x2 * cos], axis=-1)


def t5_bucket(dist):
    max_exact = N_BUCKETS // 2
    d = jnp.maximum(dist.astype(jnp.float32), 1.0)
    large = max_exact + (jnp.log(d / max_exact) / math.log(BUCKET_MAX_DIST / max_exact)
                         * (N_BUCKETS - max_exact)).astype(jnp.int32)
    large = jnp.minimum(large, N_BUCKETS - 1)
    return jnp.where(dist < max_exact, dist, large)


def block_queries(q):
    b, h, s, d = q.shape
    return q.reshape(b, h, s // BLOCK, BLOCK, d).transpose(2, 0, 1, 3, 4)


def unblock(o):
    nb, b, h, blk, d = o.shape
    return o.transpose(1, 2, 0, 3, 4).reshape(b, h, nb * blk, d)


def causal_softmax_attention(q, k, v):
    s_len = q.shape[2]
    scale = q.shape[-1] ** -0.5
    kpos = jnp.arange(s_len)

    def one_block(args):
        qi, i = args
        s = jnp.einsum('bhqd,bhkd->bhqk', qi, k).astype(jnp.float32) * scale
        qpos = i * BLOCK + jnp.arange(BLOCK)
        s = jnp.where(kpos[None, :] <= qpos[:, None], s, -jnp.inf)
        p = jax.nn.softmax(s, axis=-1).astype(v.dtype)
        return jnp.einsum('bhqk,bhkd->bhqd', p, v)

    nb = s_len // BLOCK
    return unblock(lax.map(one_block, (block_queries(q), jnp.arange(nb))))


def dilated_partial(q, k, v, rel_bias, window, dilation):
    b, h, s_len, d = q.shape
    sub_len = s_len // dilation
    nb = -(-sub_len // BLOCK)
    padded = nb * BLOCK
    span = window // dilation

    def to_blocks(t):
        t = t.reshape(b, h, sub_len, dilation, d).transpose(0, 1, 3, 2, 4)
        t = jnp.pad(t, ((0, 0), (0, 0), (0, 0), (0, padded - sub_len), (0, 0)))
        return t.reshape(b, h, dilation, nb, BLOCK, d)

    def with_prev(t):
        prev = jnp.pad(t[:, :, :, :-1], ((0, 0), (0, 0), (0, 0), (1, 0), (0, 0), (0, 0)))
        return jnp.concatenate([prev, t], axis=4)

    qb = to_blocks(q)
    kb = with_prev(to_blocks(k))
    vb = with_prev(to_blocks(v))

    qi = jnp.arange(BLOCK)[:, None]
    kj = jnp.arange(2 * BLOCK)[None, :]
    rel = BLOCK + qi - kj
    blk = jnp.arange(nb)[:, None, None]
    valid = (rel >= 0) & (rel <= span) & (blk * BLOCK - BLOCK + kj >= 0)
    bias = rel_bias[t5_bucket(jnp.maximum(rel, 0) * dilation)]
    bias = bias.transpose(2, 0, 1).astype(jnp.float32)[:, None, None]

    s = jnp.einsum('bhrnqd,bhrnkd->bhrnqk', qb, kb).astype(jnp.float32) * (d ** -0.5)
    s = jnp.where(valid, s + bias, -jnp.inf)
    mx = jnp.max(s, axis=-1)
    p = jnp.exp(s - mx[..., None])
    den = jnp.sum(p, axis=-1)
    num = jnp.einsum('bhrnqk,bhrnkd->bhrnqd', p, vb.astype(jnp.float32))

    def from_blocks(t):
        t = t.reshape(b, h, dilation, padded, *t.shape[5:])[:, :, :, :sub_len]
        t = jnp.swapaxes(t, 2, 3)
        return t.reshape(b, h, s_len, *t.shape[4:])

    return from_blocks(num), from_blocks(den), from_blocks(mx)


def dilated_attention(q, k, v, rel_bias):
    parts = [dilated_partial(q, k, v, rel_bias, w, dl) for (w, dl) in DIL_PATTERNS]
    mx = parts[0][2]
    for part in parts[1:]:
        mx = jnp.maximum(mx, part[2])
    w0 = jnp.exp(parts[0][2] - mx)
    num = parts[0][0] * w0[..., None]
    den = parts[0][1] * w0
    for part in parts[1:]:
        wi = jnp.exp(part[2] - mx)
        num = num + part[0] * wi[..., None]
        den = den + part[1] * wi
    return (num / den[..., None]).astype(q.dtype)


def stick_breaking_attention(q, k, v):
    s_len = q.shape[2]
    scale = q.shape[-1] ** -0.5
    kpos = jnp.arange(s_len)

    def one_block(args):
        qi, i = args
        z = jnp.einsum('bhqd,bhkd->bhqk', qi, k).astype(jnp.float32) * scale
        qpos = i * BLOCK + jnp.arange(BLOCK)
        before = kpos[None, :] < qpos[:, None]
        log_beta = jax.nn.log_sigmoid(z)
        log_rest = jnp.where(before, jax.nn.log_sigmoid(-z), 0.0)
        between = lax.cumsum(log_rest, axis=3, reverse=True) - log_rest
        a = jnp.where(before, jnp.exp(log_beta + between), 0.0).astype(v.dtype)
        return jnp.einsum('bhqk,bhkd->bhqd', a, v)

    nb = s_len // BLOCK
    return unblock(lax.map(one_block, (block_queries(q), jnp.arange(nb))))


def even_mixer(h, w_in, q_norm_gain, kv_norm_gain, w_uq, w_ukv, w_out, rel_bias, pos):
    b, s_len, _ = h.shape
    proj = h @ w_in
    c_q, c_kv, k_rope, q_b, k_b, v_b, gate = split_cols(proj, EVEN_SPLITS)
    q_a = to_heads(rms_norm(c_q, q_norm_gain) @ w_uq, N_HEADS_MLA)
    q_nope, q_rot = q_a[..., :QK_NOPE], q_a[..., QK_NOPE:]
    kv_a = to_heads(rms_norm(c_kv, kv_norm_gain) @ w_ukv, N_HEADS_MLA)
    k_nope, v_a = kv_a[..., :QK_NOPE], kv_a[..., QK_NOPE:]
    k_rot = rope(k_rope, pos)[:, None]
    q_full = jnp.concatenate([q_nope, rope(q_rot, pos)], axis=-1)
    k_full = jnp.concatenate([k_nope, jnp.broadcast_to(k_rot, (b, N_HEADS_MLA, s_len, QK_ROPE))], axis=-1)
    o_a = from_heads(causal_softmax_attention(q_full, k_full, v_a))
    o_b = from_heads(dilated_attention(to_heads(q_b, N_HEADS_DIL), to_heads(k_b, N_HEADS_DIL),
                                       to_heads(v_b, N_HEADS_DIL), rel_bias))
    mix = jnp.concatenate([o_a, o_b], axis=-1) * jax.nn.silu(gate)
    return mix @ w_out


def odd_mixer(h, w_in, w_out):
    proj = h @ w_in
    q, k, v, gate = split_cols(proj, ODD_SPLITS)
    o = stick_breaking_attention(to_heads(q, N_HEADS_SB), to_heads(k, N_HEADS_SB), to_heads(v, N_HEADS_SB))
    return (from_heads(o) * jax.nn.silu(gate)) @ w_out


def setup_inputs(seed: int = 0) -> dict:
    key = jax.random.key(seed)
    ks = jax.random.split(key, 12)
    f32 = jnp.float32
    return {
        "x": jax.random.normal(ks[0], (BATCH, SEQ, D_MODEL), f32),
        "norm_gain": 1.0 + 0.02 * jax.random.normal(ks[1], (DEPTH, D_MODEL), f32),
        "w_in_even": jax.random.normal(ks[2], (N_EVEN, D_MODEL, IN_EVEN), f32) * D_MODEL ** -0.5,
        "q_norm_gain": 1.0 + 0.02 * jax.random.normal(ks[3], (N_EVEN, Q_LORA), f32),
        "kv_norm_gain": 1.0 + 0.02 * jax.random.normal(ks[4], (N_EVEN, KV_LORA), f32),
        "w_uq": jax.random.normal(ks[5], (N_EVEN, Q_LORA, N_HEADS_MLA * (QK_NOPE + QK_ROPE)), f32) * Q_LORA ** -0.5,
        "w_ukv": jax.random.normal(ks[6], (N_EVEN, KV_LORA, N_HEADS_MLA * (QK_NOPE + V_DIM)), f32) * KV_LORA ** -0.5,
        "w_out_even": jax.random.normal(ks[7], (N_EVEN, MIX_EVEN, D_MODEL), f32) * MIX_EVEN ** -0.5,
        "rel_bias": 0.5 * jax.random.normal(ks[8], (N_BUCKETS, N_HEADS_DIL), f32),
        "w_in_odd": jax.random.normal(ks[9], (N_ODD, D_MODEL, IN_ODD), f32) * D_MODEL ** -0.5,
        "w_out_odd": jax.random.normal(ks[10], (N_ODD, MIX_ODD, D_MODEL), f32) * MIX_ODD ** -0.5,
        "final_norm_gain": 1.0 + 0.02 * jax.random.normal(ks[11], (D_MODEL,), f32),
    }


def reference(x, norm_gain, w_in_even, q_norm_gain, kv_norm_gain, w_uq, w_ukv, w_out_even,
              rel_bias, w_in_odd, w_out_odd, final_norm_gain):
    pos = jnp.arange(x.shape[1])
    for layer in range(DEPTH):
        h = rms_norm(x, norm_gain[layer])
        j = layer // 2
        if layer % 2 == 0:
            x = x + even_mixer(h, w_in_even[j], q_norm_gain[j], kv_norm_gain[j], w_uq[j], w_ukv[j],
                               w_out_even[j], rel_bias, pos)
        else:
            x = x + odd_mixer(h, w_in_odd[j], w_out_odd[j])
    return rms_norm(x, final_norm_gain)
```

```cpp
#include <hip/hip_runtime.h>
#include <cstdio>
#include <cstdint>
#include <cmath>

typedef unsigned short bf16_t;
typedef unsigned u32x4 __attribute__((ext_vector_type(4)));
typedef float f32x4 __attribute__((ext_vector_type(4)));

constexpr int D_MODEL = 2048, BATCH = 4, SEQ = 4096, M = BATCH * SEQ;
constexpr int NH_MLA = 8, NH_DIL = 8, NH_SB = 16, HD = 128;
constexpr int IN_EVEN = 6208, IN_EVEN_PAD = 6400, IN_ODD = 8192;
constexpr float EPS = 1e-6f;
constexpr float LOG2E = 1.4426950408889634f;
constexpr float MLA_QSCALE = 0.07216878364870322f * LOG2E;
constexpr float D128_QSCALE = 0.08838834764831845f * LOG2E;

constexpr size_t MiB = 1u << 20;
constexpr size_t WS_CTL = 0;
constexpr size_t WS_ROPE = 1 * MiB;
constexpr size_t WS_BIASN = 2 * MiB;
constexpr size_t WS_BIASC = 2 * MiB + 65536;
constexpr size_t WS_SSX = 3 * MiB;
constexpr size_t WS_SSC = 4 * MiB;
constexpr size_t WS_SSX1 = 5 * MiB;
constexpr size_t WS_LSE = 9 * MiB;
constexpr size_t WS_WT_IN_E = 12 * MiB;
constexpr size_t WS_WT_UQ = 37 * MiB;
constexpr size_t WS_WT_UKV = 39 * MiB;
constexpr size_t WS_WT_OUT_E = 41 * MiB;
constexpr size_t WS_WT_IN_O = 49 * MiB;
constexpr size_t WS_WT_OUT_O = 81 * MiB;
constexpr size_t WS_A = 90 * MiB;
constexpr size_t WS_B = 154 * MiB;
constexpr size_t WS_C = 218 * MiB;
constexpr size_t WS_H0 = WS_A, WS_OP0 = WS_A, WS_OP1 = WS_A + 32 * MiB, WS_X1BF = WS_A;
constexpr size_t WS_CQ = WS_B, WS_CKV = WS_B + 16 * MiB, WS_QB = WS_B + 32 * MiB, WS_MIX = WS_B, WS_MIX2 = WS_B;
constexpr size_t WS_KB = WS_C, WS_VB = WS_C + 32 * MiB, WS_SG = WS_C + 64 * MiB, WS_QN = WS_C + 128 * MiB, WS_QR = WS_C + 160 * MiB,
                 WS_KN = WS_C + 176 * MiB, WS_VA = WS_C + 208 * MiB, WS_KR = WS_C + 240 * MiB, WS_OP2 = WS_C + 242 * MiB;
constexpr size_t WS_Q2 = WS_C, WS_K2 = WS_C + 64 * MiB, WS_V2 = WS_C + 128 * MiB, WS_SG2 = WS_C + 192 * MiB;
constexpr size_t WS_END = WS_C + 274 * MiB;

struct Ctx {
    const float *x, *norm_gain, *w_in_even, *q_norm_gain, *kv_norm_gain, *w_uq, *w_ukv, *w_out_even, *rel_bias, *w_in_odd, *w_out_odd, *final_gain;
    float* out; unsigned char* ws;
};

#define DI __device__ __forceinline__
DI int phase_tid(int wave_s) { int lane; asm volatile("v_mbcnt_lo_u32_b32 %0, -1, 0\n\tv_mbcnt_hi_u32_b32 %0, -1, %0" : "=v"(lane)); return wave_s * 64 + lane; }
DI float bf2f(bf16_t v) { return __uint_as_float(((unsigned)v) << 16); }
DI bf16_t f2bf(float f) { unsigned u = __float_as_uint(f); return (bf16_t)((u + 0x7fffu + ((u >> 16) & 1u)) >> 16); }
DI float wave_sum(float v) {
#pragma unroll
    for (int o = 1; o < 64; o <<= 1) v += __shfl_xor(v, o);
    return v;
}
DI float wave_max(float v) {
#pragma unroll
    for (int o = 1; o < 64; o <<= 1) v = fmaxf(v, __shfl_xor(v, o));
    return v;
}
DI float silu_f(float v) { return v / (1.0f + __expf(-v)); }

DI int map_in_even(int n) { if (n < 1024) return n; if (n < 1056) return 1024 + (n - 1024); if (n < 1088) return 1152 + (n - 1056); return n - 1088 + 1280; }
DI int map_uq(int n) { const int h = n / 192, j = n % 192; if (j < 128) return h * 128 + j; if (j < 160) return 1024 + (h >> 2) * 256 + (h & 3) * 32 + (j - 128);
    return 1024 + (h >> 2) * 256 + 128 + (h & 3) * 32 + (j - 160); }
DI int map_ukv(int n) { const int h = n / 256, j = n % 256; if (j < 128) return h * 128 + j; return 1024 + h * 128 + (j - 128); }
DI int map_id(int n) { return n; }

template <int MAPID>
DI void transpose_item(const float* W, int K, int N, const float* gain, bf16_t* WT, float* scr  , int item, int lane) {
    const int nblk = N / 32, kb = item / nblk, nb = item % nblk, k0 = 64 * kb, n0 = 32 * nb;
    f32x4 v[8];
#pragma unroll
    for (int i = 0; i < 8; ++i) { const int kk = 8 * i + (lane >> 3); v[i] = *(const f32x4*)(W + (size_t)(k0 + kk) * N + n0 + 4 * (lane & 7)); }
#pragma unroll
    for (int i = 0; i < 8; ++i) { const int kk = 8 * i + (lane >> 3); const float g = gain ? gain[k0 + kk] : 1.0f; *(f32x4*)(scr + kk * 36 + 4 * (lane & 7)) = v[i] * g; }
    asm volatile("s_waitcnt lgkmcnt(0)" ::: "memory");
    const int d0 = MAPID == 0 ? map_in_even(n0) : MAPID == 1 ? map_uq(n0) : MAPID == 2 ? map_ukv(n0) : map_id(n0);
    const int c = lane & 7;
#pragma unroll
    for (int j = 0; j < 4; ++j) { const int n = (lane >> 3) + 8 * j; const float* s = scr + (8 * c) * 36 + n;
        u32x4 o; o.x = f2bf(s[0]) | ((unsigned)f2bf(s[36]) << 16); o.y = f2bf(s[72]) | ((unsigned)f2bf(s[108]) << 16);
        o.z = f2bf(s[144]) | ((unsigned)f2bf(s[180]) << 16); o.w = f2bf(s[216]) | ((unsigned)f2bf(s[252]) << 16);
        *(u32x4*)(WT + (size_t)(d0 + n) * K + k0 + 8 * c) = o; }
    asm volatile("s_waitcnt lgkmcnt(0)" ::: "memory");
}

DI int t5_bucket(int dist) {
    if (dist < 16) return dist;
    float d = (float)dist;
    int large = 16 + (int)(logf(d / 16.0f) / 4.852030263919617f * 16.0f);
    return large < 31 ? large : 31;
}

template <int PART> DI void prep_weights(const Ctx& c, float* scr, int lane, int gw, int NGW) {
    unsigned char* ws = c.ws;
    constexpr int I0 = (2048 / 64) * (IN_EVEN / 32), I1 = (512 / 64) * (1536 / 32), I2 = (512 / 64) * (2048 / 32), I3 = (2048 / 64) * (2048 / 32),
                  I4 = (2048 / 64) * (IN_ODD / 32), I5 = I3;
    constexpr int LO = PART == 1 ? I0 : 0, HI = PART == 0 ? I0 : I0 + I1 + I2 + I3 + I4 + I5;
    for (int it = LO + gw; it < HI; it += NGW) {
        int r = it;
        if (r < I0) { transpose_item<0>(c.w_in_even, 2048, IN_EVEN, c.norm_gain, (bf16_t*)(ws + WS_WT_IN_E), scr, r, lane); continue; } r -= I0;
        if (r < I1) { transpose_item<1>(c.w_uq, 512, 1536, c.q_norm_gain, (bf16_t*)(ws + WS_WT_UQ), scr, r, lane); continue; } r -= I1;
        if (r < I2) { transpose_item<2>(c.w_ukv, 512, 2048, c.kv_norm_gain, (bf16_t*)(ws + WS_WT_UKV), scr, r, lane); continue; } r -= I2;
        if (r < I3) { transpose_item<3>(c.w_out_even, 2048, 2048, nullptr, (bf16_t*)(ws + WS_WT_OUT_E), scr, r, lane); continue; } r -= I3;
        if (r < I4) { transpose_item<3>(c.w_in_odd, 2048, IN_ODD, c.norm_gain + 2048, (bf16_t*)(ws + WS_WT_IN_O), scr, r, lane); continue; } r -= I4;
        transpose_item<3>(c.w_out_odd, 2048, 2048, nullptr, (bf16_t*)(ws + WS_WT_OUT_O), scr, r, lane);
    }
}
template <int NW, int PART> DI void prep_phase(const Ctx& c, float* scr_all, const int tid) {
    const int lane = tid & 63, wave = tid >> 6;
    float* scr = scr_all + wave * 64 * 36;
    const int gw = blockIdx.x * NW + wave, NGW = gridDim.x * NW;
    unsigned char* ws = c.ws;
    prep_weights<PART>(c, scr, lane, gw, NGW);
    const int gt = blockIdx.x * (NW * 64) + tid, NGT = gridDim.x * (NW * 64);
    { bf16_t* wt = (bf16_t*)(ws + WS_WT_IN_E);
      for (int i = gt; i < 192 * 256; i += NGT) { const int rr = i / 256, cc = i % 256; const int row = rr < 96 ? 1056 + rr : 1184 + (rr - 96);
          *(u32x4*)(wt + (size_t)row * 2048 + cc * 8) = (u32x4){0u, 0u, 0u, 0u}; } }
    { float* rc = (float*)(ws + WS_ROPE); float* rs = rc + 4096 * 32;
      for (int i = gt; i < 4096 * 32; i += NGT) { const int pos = i >> 5, j = i & 31; const float inv = 1.0f / powf(10000.0f, (float)j / 32.0f); const float ang = (float)pos * inv;
          rc[i] = cosf(ang); rs[i] = sinf(ang); } }
    { float* bn = (float*)(ws + WS_BIASN);
      for (int i = gt; i < 3 * 8 * 132; i += NGT) { const int p = i / (8 * 132), h = (i / 132) % 8, rel = i % 132; const int dil = p == 0 ? 1 : p == 1 ? 4 : 16;
          bn[i] = rel <= 128 ? c.rel_bias[t5_bucket(rel * dil) * 8 + h] * LOG2E : 0.f; } }
    { float* bc = (float*)(ws + WS_BIASC);
      for (int i = gt; i < 3 * 8 * 5 * 1024; i += NGT) { const int g = i & 15, ln = (i >> 4) & 63, di = (i >> 10) % 5, ph = i / 5120, h = ph & 7, p = ph >> 3; const int dil = p == 0 ? 1 : p == 1 ? 4 : 16;
          const int rel = 32 * di + (ln & 31) - ((g & 3) + 8 * (g >> 2) + 4 * (ln >> 5));
          bc[i] = (rel >= 0 && rel <= 128) ? c.rel_bias[t5_bucket(rel * dil) * 8 + h] * LOG2E : -INFINITY; } }
    { bf16_t* h0 = (bf16_t*)(ws + WS_H0); float* ssx = (float*)(ws + WS_SSX);
      for (int m = gw; m < M; m += NGW) { const f32x4* xr = (const f32x4*)(c.x + (size_t)m * D_MODEL) + lane; float s = 0.f;
          unsigned long long* o8 = (unsigned long long*)(h0 + (size_t)m * D_MODEL) + lane;
          for (int j = 0; j < 8; ++j) { const f32x4 v = xr[64 * j]; s += v.x * v.x + v.y * v.y + v.z * v.z + v.w * v.w;
              o8[64 * j] = (unsigned long long)(f2bf(v.x) | ((unsigned)f2bf(v.y) << 16)) | ((unsigned long long)(f2bf(v.z) | ((unsigned)f2bf(v.w) << 16)) << 32); }
          s = wave_sum(s); if (lane == 0) ssx[m] = s; } }
}

__global__ void __launch_bounds__(256) k_prep(Ctx c) { __shared__ float scr_all[4 * 64 * 36]; prep_phase<4, 2>(c, scr_all, (int)threadIdx.x); }

DI float rscale(const float* part, int n, float inv_cols) { float s = 0.f; for (int i = 0; i < n; ++i) s += part[i]; return rsqrtf(s * inv_cols + EPS); }

struct Epi1 {
    unsigned char* ws;
    DI void operator()(int row, int col, float acc) const {
        const float v = acc * rsqrtf(((const float*)(ws + WS_SSX))[row] * (1.0f / 2048.0f) + EPS);
        if (col < 512) ((bf16_t*)(ws + WS_CQ))[(size_t)row * 512 + col] = f2bf(v);
        else if (col < 1024) ((bf16_t*)(ws + WS_CKV))[(size_t)row * 512 + col - 512] = f2bf(v);
        else if (col < 1280) { const int t = col - 1024; if (t < 32) ((bf16_t*)(ws + WS_KR))[(size_t)row * 64 + t] = f2bf(v); else if (t >= 128 && t < 160) ((bf16_t*)(ws + WS_KR))[(size_t)row * 64 + 32 + t - 128] = f2bf(v); }
        else if (col < 2304) ((bf16_t*)(ws + WS_QB))[(size_t)row * 1024 + col - 1280] = f2bf(v * D128_QSCALE);
        else if (col < 3328) ((bf16_t*)(ws + WS_KB))[(size_t)row * 1024 + col - 2304] = f2bf(v);
        else if (col < 4352) ((bf16_t*)(ws + WS_VB))[(size_t)row * 1024 + col - 3328] = f2bf(v);
        else ((bf16_t*)(ws + WS_SG))[(size_t)row * 2048 + col - 4352] = f2bf(silu_f(v));
    }
};
struct Epi2a {
    unsigned char* ws;
    DI void operator()(int row, int col, float acc) const {
        const float v = acc * rscale((const float*)(ws + WS_SSC) + (size_t)row * 16, 8, 1.0f / 512.0f) * MLA_QSCALE;
        if (col < 1024) ((bf16_t*)(ws + WS_QN))[(size_t)row * 1024 + col] = f2bf(v);
        else { const int t = col - 1024, grp = t >> 8, u = t & 255, half = u >> 7, hh = (u & 127) >> 5, i = u & 31;
            ((bf16_t*)(ws + WS_QR))[(size_t)row * 512 + (4 * grp + hh) * 64 + half * 32 + i] = f2bf(v); }
    }
};
struct Epi2b {
    unsigned char* ws;
    DI void operator()(int row, int col, float acc) const {
        const float v = acc * rscale((const float*)(ws + WS_SSC) + (size_t)row * 16 + 8, 8, 1.0f / 512.0f);
        if (col < 1024) ((bf16_t*)(ws + WS_KN))[(size_t)row * 1024 + col] = f2bf(v); else ((bf16_t*)(ws + WS_VA))[(size_t)row * 1024 + col - 1024] = f2bf(v);
    }
};
struct Epi4 {
    unsigned char* ws; const float* x; float* out;
    DI void operator()(int row, int col, float acc) const {
        const float v = x[(size_t)row * 2048 + col] + acc; out[(size_t)row * 2048 + col] = v; ((bf16_t*)(ws + WS_X1BF))[(size_t)row * 2048 + col] = f2bf(v);
    }
};
struct Epi5 {
    unsigned char* ws;
    DI void operator()(int row, int col, float acc) const {
        const float v = acc * rscale((const float*)(ws + WS_SSX1) + (size_t)row * 32, 32, 1.0f / 2048.0f);
        if (col < 2048) ((bf16_t*)(ws + WS_Q2))[(size_t)row * 2048 + col] = f2bf(v * D128_QSCALE);
        else if (col < 4096) ((bf16_t*)(ws + WS_K2))[(size_t)row * 2048 + col - 2048] = f2bf(v);
        else if (col < 6144) ((bf16_t*)(ws + WS_V2))[(size_t)row * 2048 + col - 4096] = f2bf(v);
        else ((bf16_t*)(ws + WS_SG2))[(size_t)row * 2048 + col - 6144] = f2bf(silu_f(v));
    }
};
struct Epi7 {
    float* out;
    DI void operator()(int row, int col, float acc) const { out[(size_t)row * 2048 + col] += acc; }
};

namespace pg8 {
#define PG8_LAS __attribute__((address_space(3)))
typedef short bf16x8 __attribute__((ext_vector_type(8)));
constexpr int BM = 256, BK = 64, HALF = 128, HTB = HALF * BK * 2  , STAGE_BYTES = 8 * HTB, NXCD = 8, WGM = 8;

__host__ __device__ __forceinline__ int lds_byte(int r, int c) { const int st = (r >> 4) * 2 + (c >> 5), rr = r & 15, cc = c & 31, ob = rr * 64 + cc * 2; return st * 1024 + (ob ^ (((ob >> 9) & 1) << 5)); }
__host__ __device__ __forceinline__ void stage_rc(int b, int& R, int& C) { const int st = b / 1024, sb = b % 1024, swz = sb ^ (((sb >> 9) & 1) << 5); R = (st >> 1) * 16 + swz / 64; C = (st & 1) * 32 + (swz % 64) / 2; }
__host__ __device__ __forceinline__ int perm32(int rho) { const int n = rho >> 4, i = rho & 15; return 8 * (i >> 2) + 4 * n + (i & 3); }

struct Unit { int pm, pn; };
struct Gemm { const bf16_t* A; const bf16_t* Bt; int M, N, K; };

struct StaticOrder {
    int nM, nN, nwg, G, c;
    __host__ __device__ void init(int M, int N, int G_, int c_) { nM = M / BM; nN = N / BM; nwg = nM * nN; G = G_; c = c_; }
    __host__ __device__ bool next(int i, Unit& u) const {
        const long L = (long)i * G + c; if (L >= nwg) return false;
        int wgid = (int)L; { const int q = nwg / NXCD, r = nwg % NXCD, xcd = wgid % NXCD, off = wgid / NXCD; wgid = (xcd < r ? xcd * (q + 1) : r * (q + 1) + (xcd - r) * q) + off; }
        const int nig = WGM * nN, gid = wgid / nig, fm = gid * WGM, gsz = (nM - fm) < WGM ? (nM - fm) : WGM;
        u.pm = fm + ((wgid % nig) % gsz); u.pn = (wgid % nig) / gsz; return true;
    }
    __device__ __forceinline__ void a_ready(const Unit&) const {}
    __device__ __forceinline__ void done(const Unit&) const {}
};


typedef float f32x2_t __attribute__((ext_vector_type(2))); typedef __bf16 bf16x2_t __attribute__((ext_vector_type(2)));
__device__ __forceinline__ unsigned cvtpk(float lo, float hi) { f32x2_t v = {lo, hi}; bf16x2_t b = __builtin_convertvector(v, bf16x2_t); return __builtin_bit_cast(unsigned, b); }
__device__ __forceinline__ u32x4 pack8(const f32x4& a, const f32x4& b) { u32x4 w; w.x = cvtpk(a[0], a[1]); w.y = cvtpk(a[2], a[3]); w.z = cvtpk(b[0], b[1]); w.w = cvtpk(b[2], b[3]); return w; }
__device__ __forceinline__ float sumsq4(const f32x4& a) { return (a[0] * a[0] + a[1] * a[1]) + (a[2] * a[2] + a[3] * a[3]); }
__device__ __forceinline__ float silu1(float v) { return v * __builtin_amdgcn_rcpf(1.0f + __builtin_amdgcn_exp2f(-v * LOG2E)); }
__device__ __forceinline__ f32x4 silu4(const f32x4& a) { return (f32x4){silu1(a[0]), silu1(a[1]), silu1(a[2]), silu1(a[3])}; }
__device__ __forceinline__ float quad_sum(float s) { s += __shfl_xor(s, 16); s += __shfl_xor(s, 32); return s; }
__device__ __forceinline__ void rope8(const f32x4& a0, const f32x4& a1, const f32x4& b0, const f32x4& b1, const float* rc, const float* rs, int pos, int i0, u32x4& o1, u32x4& o2) {
    const f32x4 c0 = *(const f32x4*)(rc + pos * 32 + i0), c1 = *(const f32x4*)(rc + pos * 32 + i0 + 4), s0 = *(const f32x4*)(rs + pos * 32 + i0), s1 = *(const f32x4*)(rs + pos * 32 + i0 + 4);
    o1 = pack8(a0 * c0 - b0 * s0, a1 * c1 - b1 * s1); o2 = pack8(a0 * s0 + b0 * c0, a1 * s1 + b1 * c1);
}
#define PG8_EPI_ROWS(...) _Pragma("unroll") for (int ai = 0; ai < 2; ++ai) _Pragma("unroll") for (int m = 0; m < 4; ++m) { const int row = u.pm * BM + ai * HALF + wr * 64 + m * 16 + fr; __VA_ARGS__ }

struct FEpi1 {
    static constexpr bool PERM = true, AFTER_DRAIN = false; unsigned char* ws;
    __device__ __forceinline__ void operator()(const f32x4 (&acc)[2][2][4][2], const Unit& u, int wr, int wc, int fr, int fq) const {
        const int pn = u.pn, cw = wc * 32 + 8 * fq; const float* ssx = (const float*)(ws + WS_SSX);
        PG8_EPI_ROWS(
            const float rs = rsqrtf(ssx[row] * (1.0f / 2048.0f) + EPS);
            if (pn < 4) { bf16_t* dst = (bf16_t*)(ws + (pn < 2 ? WS_CQ : WS_CKV)) + (size_t)row * 512 + (pn & 1) * 256 + cw; float ss = 0.f;
                _Pragma("unroll") for (int bj = 0; bj < 2; ++bj) { const f32x4 v0 = acc[ai][bj][m][0] * rs, v1 = acc[ai][bj][m][1] * rs; ss += sumsq4(v0) + sumsq4(v1); *(u32x4*)(dst + bj * HALF) = pack8(v0, v1); }
                ss = quad_sum(ss); if (fq == 0) ((float*)(ws + WS_SSC))[(size_t)row * 16 + pn * 4 + wc] = ss; }
            else if (pn == 4) { if (wc == 0) { const float* rc = (const float*)(ws + WS_ROPE); u32x4 o1, o2;
                rope8(acc[ai][0][m][0] * rs, acc[ai][0][m][1] * rs, acc[ai][1][m][0] * rs, acc[ai][1][m][1] * rs, rc, rc + 4096 * 32, row % SEQ, 8 * fq, o1, o2);
                bf16_t* dst = (bf16_t*)(ws + WS_KR) + (size_t)row * 64 + 8 * fq; *(u32x4*)dst = o1; *(u32x4*)(dst + 32) = o2; } }
            else if (pn < 17) { const int t = pn - 5; bf16_t* dst = (bf16_t*)(ws + (t < 4 ? WS_QB : t < 8 ? WS_KB : WS_VB)) + (size_t)row * 1024 + (t & 3) * 256 + cw; const float sc = t < 4 ? rs * D128_QSCALE : rs;
                _Pragma("unroll") for (int bj = 0; bj < 2; ++bj) *(u32x4*)(dst + bj * HALF) = pack8(acc[ai][bj][m][0] * sc, acc[ai][bj][m][1] * sc); }
            else { bf16_t* dst = (bf16_t*)(ws + WS_SG) + (size_t)row * 2048 + (pn - 17) * 256 + cw;
                _Pragma("unroll") for (int bj = 0; bj < 2; ++bj) *(u32x4*)(dst + bj * HALF) = pack8(silu4(acc[ai][bj][m][0] * rs), silu4(acc[ai][bj][m][1] * rs)); }
        )
    }
};
struct FEpi2a {
    static constexpr bool PERM = true, AFTER_DRAIN = false; unsigned char* ws;
    __device__ __forceinline__ void operator()(const f32x4 (&acc)[2][2][4][2], const Unit& u, int wr, int wc, int fr, int fq) const {
        const int pn = u.pn, cw = wc * 32 + 8 * fq;
        PG8_EPI_ROWS(
            const f32x4* sp = (const f32x4*)((const float*)(ws + WS_SSC) + (size_t)row * 16); const f32x4 p0 = sp[0], p1 = sp[1];
            const float rs = rsqrtf(((p0[0] + p0[1]) + (p0[2] + p0[3]) + (p1[0] + p1[1]) + (p1[2] + p1[3])) * (1.0f / 512.0f) + EPS) * MLA_QSCALE;
            if (pn < 4) { bf16_t* dst = (bf16_t*)(ws + WS_QN) + (size_t)row * 1024 + pn * 256 + cw;
                _Pragma("unroll") for (int bj = 0; bj < 2; ++bj) *(u32x4*)(dst + bj * HALF) = pack8(acc[ai][bj][m][0] * rs, acc[ai][bj][m][1] * rs); }
            else { const float* rc = (const float*)(ws + WS_ROPE); u32x4 o1, o2; const int head = 4 * (pn - 4) + wc;
                rope8(acc[ai][0][m][0] * rs, acc[ai][0][m][1] * rs, acc[ai][1][m][0] * rs, acc[ai][1][m][1] * rs, rc, rc + 4096 * 32, row % SEQ, 8 * fq, o1, o2);
                bf16_t* dst = (bf16_t*)(ws + WS_QR) + (size_t)row * 512 + head * 64 + 8 * fq; *(u32x4*)dst = o1; *(u32x4*)(dst + 32) = o2; }
        )
    }
};
struct FEpi2b {
    static constexpr bool PERM = true, AFTER_DRAIN = false; unsigned char* ws;
    __device__ __forceinline__ void operator()(const f32x4 (&acc)[2][2][4][2], const Unit& u, int wr, int wc, int fr, int fq) const {
        const int pn = u.pn, cw = wc * 32 + 8 * fq;
        PG8_EPI_ROWS(
            const f32x4* sp = (const f32x4*)((const float*)(ws + WS_SSC) + (size_t)row * 16 + 8); const f32x4 p0 = sp[0], p1 = sp[1];
            const float rs = rsqrtf(((p0[0] + p0[1]) + (p0[2] + p0[3]) + (p1[0] + p1[1]) + (p1[2] + p1[3])) * (1.0f / 512.0f) + EPS);
            bf16_t* dst = (bf16_t*)(ws + (pn < 4 ? WS_KN : WS_VA)) + (size_t)row * 1024 + (pn & 3) * 256 + cw;
            _Pragma("unroll") for (int bj = 0; bj < 2; ++bj) *(u32x4*)(dst + bj * HALF) = pack8(acc[ai][bj][m][0] * rs, acc[ai][bj][m][1] * rs);
        )
    }
};
struct FEpi4 {
    static constexpr bool PERM = true, AFTER_DRAIN = false; unsigned char* ws; const float* x; float* out;
    __device__ __forceinline__ void operator()(const f32x4 (&acc)[2][2][4][2], const Unit& u, int wr, int wc, int fr, int fq) const {
        const int pn = u.pn, cw = pn * 256 + wc * 32 + 8 * fq;
        PG8_EPI_ROWS(
            const size_t off = (size_t)row * 2048 + cw; float ss = 0.f;
            _Pragma("unroll") for (int bj = 0; bj < 2; ++bj) { const f32x4 v0 = *(const f32x4*)(x + off + bj * HALF) + acc[ai][bj][m][0], v1 = *(const f32x4*)(x + off + bj * HALF + 4) + acc[ai][bj][m][1];
                *(f32x4*)(out + off + bj * HALF) = v0; *(f32x4*)(out + off + bj * HALF + 4) = v1; ss += sumsq4(v0) + sumsq4(v1);
                *(u32x4*)((bf16_t*)(ws + WS_X1BF) + off + bj * HALF) = pack8(v0, v1); }
            ss = quad_sum(ss); if (fq == 0) ((float*)(ws + WS_SSX1))[(size_t)row * 32 + pn * 4 + wc] = ss;
        )
    }
};
struct FEpi5 {
    static constexpr bool PERM = true, AFTER_DRAIN = false; unsigned char* ws;
    __device__ __forceinline__ void operator()(const f32x4 (&acc)[2][2][4][2], const Unit& u, int wr, int wc, int fr, int fq) const {
        const int pn = u.pn, cw = (pn & 7) * 256 + wc * 32 + 8 * fq; const int sel = pn >> 3;
        PG8_EPI_ROWS(
            const f32x4* sp = (const f32x4*)((const float*)(ws + WS_SSX1) + (size_t)row * 32 + 8 * fq); const f32x4 p0 = sp[0], p1 = sp[1];
            const float tot = quad_sum((p0[0] + p0[1]) + (p0[2] + p0[3]) + (p1[0] + p1[1]) + (p1[2] + p1[3]));
            const float rs = rsqrtf(tot * (1.0f / 2048.0f) + EPS);
            bf16_t* dst = (bf16_t*)(ws + (sel == 0 ? WS_Q2 : sel == 1 ? WS_K2 : sel == 2 ? WS_V2 : WS_SG2)) + (size_t)row * 2048 + cw;
            if (sel == 3) { _Pragma("unroll") for (int bj = 0; bj < 2; ++bj) *(u32x4*)(dst + bj * HALF) = pack8(silu4(acc[ai][bj][m][0] * rs), silu4(acc[ai][bj][m][1] * rs)); }
            else { const float sc = sel == 0 ? rs * D128_QSCALE : rs;
                _Pragma("unroll") for (int bj = 0; bj < 2; ++bj) *(u32x4*)(dst + bj * HALF) = pack8(acc[ai][bj][m][0] * sc, acc[ai][bj][m][1] * sc); }
        )
    }
};
struct FEpi7 {
    static constexpr bool PERM = true, AFTER_DRAIN = false; float* out;
    __device__ __forceinline__ void operator()(const f32x4 (&acc)[2][2][4][2], const Unit& u, int wr, int wc, int fr, int fq) const {
        const int cw = u.pn * 256 + wc * 32 + 8 * fq;
        PG8_EPI_ROWS(
            const size_t off = (size_t)row * 2048 + cw;
            _Pragma("unroll") for (int bj = 0; bj < 2; ++bj) { *(f32x4*)(out + off + bj * HALF) = *(const f32x4*)(out + off + bj * HALF) + acc[ai][bj][m][0];
                *(f32x4*)(out + off + bj * HALF + 4) = *(const f32x4*)(out + off + bj * HALF + 4) + acc[ai][bj][m][1]; }
        )
    }
};
template <class Epi, class Sched, bool ALIGN_EPI = false, bool SP2 = false>
__device__ __forceinline__ void gemm_phase(PG8_LAS unsigned char* lds, const Gemm g, const Sched& S, const Epi& E, const int tid) {
    const int wid = __builtin_amdgcn_readfirstlane(tid >> 6), lane = tid & 63, wr = wid >> 2, wc = wid & 3, fr = lane & 15, fq = lane >> 4;
    const int K = g.K, nt = K / BK;
    unsigned voffA[2], voffB[2];
#pragma unroll
    for (int i = 0; i < 2; ++i) { int R, C; stage_rc(tid * 16 + i * 8192, R, C); const int Rb = Epi::PERM ? ((R & ~31) + perm32(R & 31)) : R;
        voffA[i] = (unsigned)(R * K + C) * 2u; voffB[i] = (unsigned)(Rb * K + C) * 2u; }
    const size_t kstep = (size_t)(BK * 2);
    const size_t hstep = (size_t)HALF * K * 2;
    const size_t tstep = 2 * hstep;
    const unsigned ldsw = (unsigned)wid * 1024u;
    const int aoff = lds_byte(wr * 64 + fr, fq * 8), boff = lds_byte(wc * 32 + fr, fq * 8);
#define PG8_SA(b, h) (((b) * 2 + (h)) * HTB)
#define PG8_SB(b, h) ((4 + (b) * 2 + (h)) * HTB)
#define PG8_STAGE(bufoff, gbase, voff) do { _Pragma("unroll") for (int _i = 0; _i < 2; ++_i) \
        __builtin_amdgcn_global_load_lds((const unsigned*)((const char*)(gbase) + (voff)[_i]), (PG8_LAS unsigned*)(lds + (bufoff) + ldsw + _i * 8192), 16, 0, 0); } while (0)
#define PG8_LDA(dst, b, h) do { _Pragma("unroll") for (int m = 0; m < 4; ++m) _Pragma("unroll") for (int k = 0; k < 2; ++k) dst[m][k] = *(const PG8_LAS bf16x8*)(lds + PG8_SA(b, h) + aoff + m * 2048 + k * 1024); } while (0)
#define PG8_LDB(dst, b, h) do { _Pragma("unroll") for (int n = 0; n < 2; ++n) _Pragma("unroll") for (int k = 0; k < 2; ++k) dst[n][k] = *(const PG8_LAS bf16x8*)(lds + PG8_SB(b, h) + boff + n * 2048 + k * 1024); } while (0)
#define PG8_MMA(ai, bj, At, Bt) do { __builtin_amdgcn_s_setprio(1); _Pragma("unroll") for (int m = 0; m < 4; ++m) _Pragma("unroll") for (int n = 0; n < 2; ++n) _Pragma("unroll") for (int k = 0; k < 2; ++k) \
        acc[ai][bj][m][n] = __builtin_amdgcn_mfma_f32_16x16x32_bf16(Bt[n][k], At[m][k], acc[ai][bj][m][n], 0, 0, 0); __builtin_amdgcn_s_setprio(0); } while (0)
#define PG8_WAIT_V(n) asm volatile("s_waitcnt vmcnt(" #n ")" ::: "memory")
#define PG8_WAIT_L(n) asm volatile("s_waitcnt lgkmcnt(" #n ")" ::: "memory")
#define PG8_BAR __builtin_amdgcn_s_barrier()
#define PG8_SCHED __builtin_amdgcn_sched_barrier(0)
    Unit cur, nxt; int ui = 0;
    if (!S.next(0, cur)) return;
    f32x4 acc[2][2][4][2];
#pragma unroll
    for (int a = 0; a < 2; ++a)
#pragma unroll
        for (int b = 0; b < 2; ++b)
#pragma unroll
            for (int m = 0; m < 4; ++m)
#pragma unroll
                for (int n = 0; n < 2; ++n) acc[a][b][m][n] = (f32x4){0.f, 0.f, 0.f, 0.f};
    bf16x8 At[4][2], B0[2][2], B1[2][2];
    const char* cA = (const char*)g.A + (size_t)cur.pm * tstep; const char* cB = (const char*)g.Bt + (size_t)cur.pn * tstep;
    S.a_ready(cur);
    if constexpr (SP2) {
        PG8_STAGE(PG8_SB(0, 0), cB, voffB); PG8_STAGE(PG8_SB(0, 1), cB + hstep, voffB); PG8_STAGE(PG8_SA(0, 0), cA, voffA); PG8_STAGE(PG8_SA(0, 1), cA + hstep, voffA);
        if (wr == 1) PG8_BAR;
        PG8_WAIT_V(2); PG8_BAR;
        PG8_STAGE(PG8_SB(1, 0), cB + kstep, voffB); PG8_STAGE(PG8_SA(1, 0), cA + kstep, voffA); PG8_STAGE(PG8_SB(1, 1), cB + hstep + kstep, voffB);
        PG8_WAIT_V(6); PG8_BAR;
    } else {
        PG8_STAGE(PG8_SB(0, 0), cB, voffB); PG8_STAGE(PG8_SA(0, 0), cA, voffA); PG8_STAGE(PG8_SB(0, 1), cB + hstep, voffB); PG8_STAGE(PG8_SA(0, 1), cA + hstep, voffA);
        if (wr == 1) PG8_BAR;
        PG8_WAIT_V(4); PG8_BAR;
        PG8_STAGE(PG8_SB(1, 0), cB + kstep, voffB); PG8_STAGE(PG8_SA(1, 0), cA + kstep, voffA); PG8_STAGE(PG8_SB(1, 1), cB + hstep + kstep, voffB);
        PG8_WAIT_V(6); PG8_BAR;
    }
    for (;;) {
        const bool has_next = S.next(ui + 1, nxt);
        const char* nA = has_next ? (const char*)g.A + (size_t)nxt.pm * tstep : cA; const char* nB = has_next ? (const char*)g.Bt + (size_t)nxt.pn * tstep : cB;
        for (int t = 0; t < nt; t += 2) {
            const bool last = (t == nt - 2);
            const char* a1 = cA + (size_t)(t + 1) * kstep;
            const char* a2 = last ? nA : cA + (size_t)(t + 2) * kstep; const char* b2 = last ? nB : cB + (size_t)(t + 2) * kstep;
            const char* a3 = a2 + kstep; const char* b3 = b2 + kstep;
            if (last && has_next) S.a_ready(nxt);
            if constexpr (SP2) {
            PG8_LDB(B0, 0, 0); PG8_LDB(B1, 0, 1); PG8_SCHED; PG8_LDA(At, 0, 0); PG8_STAGE(PG8_SA(1, 1), a1 + hstep, voffA);
            PG8_WAIT_V(8); PG8_WAIT_L(0); PG8_BAR; PG8_MMA(0, 0, At, B0); PG8_MMA(0, 1, At, B1); PG8_BAR; PG8_SCHED;
            PG8_LDA(At, 0, 1); PG8_STAGE(PG8_SB(0, 0), b2, voffB); PG8_STAGE(PG8_SB(0, 1), b2 + hstep, voffB); PG8_STAGE(PG8_SA(0, 0), a2, voffA);
            PG8_WAIT_V(8); PG8_WAIT_L(0); PG8_BAR; PG8_MMA(1, 0, At, B0); PG8_MMA(1, 1, At, B1); PG8_BAR; PG8_SCHED;
            PG8_LDB(B0, 1, 0); PG8_LDB(B1, 1, 1); PG8_SCHED; PG8_LDA(At, 1, 0); PG8_STAGE(PG8_SA(0, 1), a2 + hstep, voffA);
            PG8_WAIT_V(8); PG8_WAIT_L(0); PG8_BAR; PG8_MMA(0, 0, At, B0); PG8_MMA(0, 1, At, B1); PG8_BAR; PG8_SCHED;
            PG8_LDA(At, 1, 1); PG8_STAGE(PG8_SB(1, 0), b3, voffB); PG8_STAGE(PG8_SB(1, 1), b3 + hstep, voffB); PG8_STAGE(PG8_SA(1, 0), a3, voffA);
            PG8_WAIT_V(8); PG8_WAIT_L(0); PG8_BAR; PG8_MMA(1, 0, At, B0); PG8_MMA(1, 1, At, B1); PG8_BAR; PG8_SCHED;
            } else {
            PG8_LDB(B0, 0, 0); PG8_SCHED; PG8_LDA(At, 0, 0); PG8_STAGE(PG8_SA(1, 1), a1 + hstep, voffA);
            PG8_WAIT_L(8); PG8_BAR; PG8_WAIT_L(0); PG8_MMA(0, 0, At, B0); PG8_BAR; PG8_SCHED;
            PG8_LDB(B1, 0, 1); PG8_STAGE(PG8_SB(0, 0), b2, voffB);
            PG8_BAR; PG8_WAIT_L(0); PG8_MMA(0, 1, At, B1); PG8_BAR;
            PG8_LDA(At, 0, 1); PG8_STAGE(PG8_SA(0, 0), a2, voffA);
            PG8_BAR; PG8_WAIT_L(0); PG8_MMA(1, 0, At, B0); PG8_BAR; PG8_SCHED;
            PG8_STAGE(PG8_SB(0, 1), b2 + hstep, voffB);
            PG8_WAIT_V(6); PG8_BAR; PG8_MMA(1, 1, At, B1); PG8_BAR;
            PG8_LDB(B0, 1, 0); PG8_SCHED; PG8_LDA(At, 1, 0); PG8_STAGE(PG8_SA(0, 1), a2 + hstep, voffA);
            PG8_WAIT_L(8); PG8_BAR; PG8_WAIT_L(0); PG8_MMA(0, 0, At, B0); PG8_BAR; PG8_SCHED;
            PG8_LDB(B1, 1, 1); PG8_STAGE(PG8_SB(1, 0), b3, voffB);
            PG8_BAR; PG8_WAIT_L(0); PG8_MMA(0, 1, At, B1); PG8_BAR;
            PG8_LDA(At, 1, 1); PG8_STAGE(PG8_SA(1, 0), a3, voffA);
            PG8_BAR; PG8_WAIT_L(0); PG8_MMA(1, 0, At, B0); PG8_BAR; PG8_SCHED;
            PG8_STAGE(PG8_SB(1, 1), b3 + hstep, voffB);
            PG8_WAIT_V(6); PG8_BAR; PG8_MMA(1, 1, At, B1); PG8_BAR;
            }
        }
        if constexpr (ALIGN_EPI) { if (wr == 0) PG8_BAR; }
        if constexpr (!Epi::AFTER_DRAIN) { E(acc, cur, wr, wc, fr, fq); S.done(cur); }
        if (!has_next) break;
#pragma unroll
        for (int a = 0; a < 2; ++a)
#pragma unroll
            for (int b = 0; b < 2; ++b)
#pragma unroll
                for (int m = 0; m < 4; ++m)
#pragma unroll
                    for (int n = 0; n < 2; ++n) acc[a][b][m][n] = (f32x4){0.f, 0.f, 0.f, 0.f};
        cur = nxt; cA = nA; cB = nB; ++ui;
        if constexpr (ALIGN_EPI) { if (wr == 1) PG8_BAR; }
    }
    PG8_WAIT_V(0);
    if constexpr (!ALIGN_EPI) { if (wr == 0) PG8_BAR; }
    PG8_BAR;
    if constexpr (Epi::AFTER_DRAIN) { E.fused(acc, cur, wr, wc, fr, fq, lds, wid, lane); S.done(cur); }
#undef PG8_SA
#undef PG8_SB
#undef PG8_STAGE
#undef PG8_LDA
#undef PG8_LDB
#undef PG8_MMA
#undef PG8_WAIT_V
#undef PG8_WAIT_L
#undef PG8_BAR
#undef PG8_SCHED
}
}

#define LAS __attribute__((address_space(3)))
template <class Epi> __global__ void __launch_bounds__(512, 2) k_gemm_fast(pg8::Gemm g, Epi E) {
    extern __shared__ __attribute__((aligned(16))) unsigned char lds[];
    pg8::StaticOrder S; S.init(g.M, g.N, (int)gridDim.x, (int)blockIdx.x);
    pg8::gemm_phase<Epi, pg8::StaticOrder, true, true>((LAS unsigned char*)lds, g, S, E, (int)threadIdx.x);
}

template <class Epi>
__global__ void __launch_bounds__(256) k_gemm_naive(const bf16_t* A, const bf16_t* Bt, int N, int K, Epi epi) {
    __shared__ float As[64][33], Bs[64][33];
    const int tid = threadIdx.x, tx = tid & 15, ty = tid >> 4;
    const int nbn = N / 64; const int bm = blockIdx.x / nbn, bn = blockIdx.x % nbn;
    float acc[4][4] = {};
    const int lr = tid >> 2, lc = (tid & 3) * 8;
    for (int k0 = 0; k0 < K; k0 += 32) {
        const u32x4 av = *(const u32x4*)(A + (size_t)(bm * 64 + lr) * K + k0 + lc);
        const u32x4 bv = *(const u32x4*)(Bt + (size_t)(bn * 64 + lr) * K + k0 + lc);
        __syncthreads();
#pragma unroll
        for (int j = 0; j < 4; ++j) { As[lr][lc + 2 * j] = __uint_as_float(av[j] << 16); As[lr][lc + 2 * j + 1] = __uint_as_float(av[j] & 0xffff0000u);
                                      Bs[lr][lc + 2 * j] = __uint_as_float(bv[j] << 16); Bs[lr][lc + 2 * j + 1] = __uint_as_float(bv[j] & 0xffff0000u); }
        __syncthreads();
#pragma unroll 8
        for (int kk = 0; kk < 32; ++kk) { float a[4], b[4];
#pragma unroll
            for (int i = 0; i < 4; ++i) { a[i] = As[ty * 4 + i][kk]; b[i] = Bs[tx * 4 + i][kk]; }
#pragma unroll
            for (int i = 0; i < 4; ++i)
#pragma unroll
                for (int j = 0; j < 4; ++j) acc[i][j] += a[i] * b[j]; }
    }
#pragma unroll
    for (int i = 0; i < 4; ++i)
#pragma unroll
        for (int j = 0; j < 4; ++j) epi(bm * 64 + ty * 4 + i, bn * 64 + tx * 4 + j, acc[i][j]);
}

template <bool F32>
__global__ void __launch_bounds__(256) k_rowss(const void* src, int ld, int ncols, float* dst, int dst_ld, int nslots) {
    const int lane = threadIdx.x & 63, row = blockIdx.x * 4 + (threadIdx.x >> 6);
    float s = 0.f;
    for (int c = lane; c < ncols; c += 64) { const float v = F32 ? ((const float*)src)[(size_t)row * ld + c] : bf2f(((const bf16_t*)src)[(size_t)row * ld + c]); s += v * v; }
    s = wave_sum(s);
    if (lane < nslots) dst[(size_t)row * dst_ld + lane] = lane == 0 ? s : 0.f;
}

__global__ void __launch_bounds__(256) k_rope(bf16_t* buf, int nh, const float* rc, const float* rs) {
    const int idx = blockIdx.x * 256 + threadIdx.x; const int per_row = nh * 32; if (idx >= M * per_row) return;
    const int row = idx / per_row, t = idx % per_row, h = t >> 5, i = t & 31, pos = row % SEQ;
    bf16_t* p = buf + (size_t)row * nh * 64 + h * 64; const float x1 = bf2f(p[i]), x2 = bf2f(p[32 + i]); const float cs = rc[pos * 32 + i], sn = rs[pos * 32 + i];
    p[i] = f2bf(x1 * cs - x2 * sn); p[32 + i] = f2bf(x1 * sn + x2 * cs);
}

template <int D> DI float dot_row(const float* q, const bf16_t* k) {
    float s = 0.f;
#pragma unroll
    for (int d = 0; d < D; d += 8) { const u32x4 v = *(const u32x4*)(k + d);
#pragma unroll
        for (int j = 0; j < 4; ++j) { s += q[d + 2 * j] * __uint_as_float(v[j] << 16); s += q[d + 2 * j + 1] * __uint_as_float(v[j] & 0xffff0000u); } }
    return s;
}

__global__ void __launch_bounds__(256) k_mla_naive(Ctx c) {
    __shared__ float qs[4][192];
    const int lane = threadIdx.x & 63, w = threadIdx.x >> 6; const int gq = blockIdx.x * 4 + w;
    const int t = gq % SEQ, bh = gq / SEQ, h = bh % 8, b = bh / 8; const size_t row = (size_t)b * SEQ + t;
    unsigned char* ws = c.ws;
    const bf16_t *QN = (const bf16_t*)(ws + WS_QN), *QR = (const bf16_t*)(ws + WS_QR), *KN = (const bf16_t*)(ws + WS_KN), *KR = (const bf16_t*)(ws + WS_KR), *VA = (const bf16_t*)(ws + WS_VA), *SG = (const bf16_t*)(ws + WS_SG);
    for (int d = lane; d < 192; d += 64) qs[w][d] = d < 128 ? bf2f(QN[row * 1024 + h * 128 + d]) : bf2f(QR[row * 512 + h * 64 + d - 128]);
    __syncthreads();
    float m = -INFINITY, l = 0.f, o0 = 0.f, o1 = 0.f;
    for (int j0 = 0; j0 <= t; j0 += 64) {
        const int j = j0 + lane; const bool valid = j <= t; const size_t krow = (size_t)b * SEQ + (valid ? j : t);
        float s = dot_row<128>(qs[w], KN + krow * 1024 + h * 128) + dot_row<64>(qs[w] + 128, KR + krow * 64);
        if (!valid) s = -INFINITY;
        const float mn = fmaxf(m, wave_max(s)); const float alpha = exp2f(m - mn); const float p = valid ? exp2f(s - mn) : 0.f;
        l = l * alpha + wave_sum(p); o0 *= alpha; o1 *= alpha; m = mn;
        const int nj = min(64, t - j0 + 1);
        for (int jj = 0; jj < nj; ++jj) { const float pj = __shfl(p, jj); const bf16_t* vr = VA + ((size_t)b * SEQ + j0 + jj) * 1024 + h * 128; o0 += pj * bf2f(vr[lane]); o1 += pj * bf2f(vr[lane + 64]); }
    }
    bf16_t* MIX = (bf16_t*)(ws + WS_MIX); const float il = 1.0f / l;
    MIX[row * 2048 + h * 128 + lane] = f2bf(o0 * il * bf2f(SG[row * 2048 + h * 128 + lane]));
    MIX[row * 2048 + h * 128 + lane + 64] = f2bf(o1 * il * bf2f(SG[row * 2048 + h * 128 + lane + 64]));
}

__global__ void __launch_bounds__(256) k_dil_naive(Ctx c) {
    __shared__ float qs[4][128];
    const int lane = threadIdx.x & 63, w = threadIdx.x >> 6; const int gq = blockIdx.x * 4 + w;
    const int t = gq % SEQ, bh = gq / SEQ, h = bh % 8, b = bh / 8; const size_t row = (size_t)b * SEQ + t;
    unsigned char* ws = c.ws;
    const bf16_t *QB = (const bf16_t*)(ws + WS_QB), *KB = (const bf16_t*)(ws + WS_KB), *VB = (const bf16_t*)(ws + WS_VB);
    const float* bn = (const float*)(ws + WS_BIASN);
    for (int d = lane; d < 128; d += 64) qs[w][d] = bf2f(QB[row * 1024 + h * 128 + d]);
    __syncthreads();
    for (int p = 0; p < 3; ++p) { const int dil = p == 0 ? 1 : p == 1 ? 4 : 16;
        float m = -INFINITY, l = 0.f, o0 = 0.f, o1 = 0.f;
        for (int r0 = 0; r0 < 192; r0 += 64) {
            const int rel = r0 + lane; const int j = t - rel * dil; const bool valid = rel <= 128 && j >= 0; const size_t krow = (size_t)b * SEQ + (valid ? j : t);
            float s = dot_row<128>(qs[w], KB + krow * 1024 + h * 128) + bn[(p * 8 + h) * 132 + (valid ? rel : 0)];
            if (!valid) s = -INFINITY;
            const float mn = fmaxf(m, wave_max(s));
            const float alpha = exp2f(m - mn); const float pp = valid ? exp2f(s - mn) : 0.f;
            l = l * alpha + wave_sum(pp); o0 *= alpha; o1 *= alpha; m = mn;
            for (int jj = 0; jj < 64; ++jj) { const float pj = __shfl(pp, jj); if (pj != 0.f) { const int jr = t - (r0 + jj) * dil; const bf16_t* vr = VB + ((size_t)b * SEQ + jr) * 1024 + h * 128; o0 += pj * bf2f(vr[lane]); o1 += pj * bf2f(vr[lane + 64]); } }
        }
        bf16_t* OP = (bf16_t*)(ws + (p == 0 ? WS_OP0 : p == 1 ? WS_OP1 : WS_OP2)); const float il = 1.0f / l;
        OP[row * 1024 + h * 128 + lane] = f2bf(o0 * il); OP[row * 1024 + h * 128 + lane + 64] = f2bf(o1 * il);
        if (lane == 0) ((float*)(ws + WS_LSE))[((size_t)p * M + row) * 8 + h] = m + log2f(l);
    }
}

DI void dil_merge_item(unsigned char* ws, int row, int col) {
    const int h = col >> 7; const float* lse = (const float*)(ws + WS_LSE);
    const float l0 = lse[((size_t)0 * M + row) * 8 + h], l1 = lse[((size_t)1 * M + row) * 8 + h], l2 = lse[((size_t)2 * M + row) * 8 + h];
    const float mx = fmaxf(l0, fmaxf(l1, l2)); float w0 = exp2f(l0 - mx), w1 = exp2f(l1 - mx), w2 = exp2f(l2 - mx); const float inv = 1.0f / (w0 + w1 + w2); w0 *= inv; w1 *= inv; w2 *= inv;
    const u32x4 a0 = *(const u32x4*)((const bf16_t*)(ws + WS_OP0) + (size_t)row * 1024 + col), a1 = *(const u32x4*)((const bf16_t*)(ws + WS_OP1) + (size_t)row * 1024 + col),
                a2 = *(const u32x4*)((const bf16_t*)(ws + WS_OP2) + (size_t)row * 1024 + col), sg = *(const u32x4*)((const bf16_t*)(ws + WS_SG) + (size_t)row * 2048 + 1024 + col);
    u32x4 o;
#pragma unroll
    for (int j = 0; j < 4; ++j) {
        const float lo = (w0 * __uint_as_float(a0[j] << 16) + w1 * __uint_as_float(a1[j] << 16) + w2 * __uint_as_float(a2[j] << 16)) * __uint_as_float(sg[j] << 16);
        const float hi = (w0 * __uint_as_float(a0[j] & 0xffff0000u) + w1 * __uint_as_float(a1[j] & 0xffff0000u) + w2 * __uint_as_float(a2[j] & 0xffff0000u)) * __uint_as_float(sg[j] & 0xffff0000u);
        o[j] = (unsigned)f2bf(lo) | ((unsigned)f2bf(hi) << 16); }
    *(u32x4*)((bf16_t*)(ws + WS_MIX) + (size_t)row * 2048 + 1024 + col) = o;
}
__global__ void __launch_bounds__(128) k_dil_merge(Ctx c) { dil_merge_item(c.ws, blockIdx.x, threadIdx.x * 8); }

__global__ void __launch_bounds__(256) k_sb_naive(Ctx c) {
    __shared__ float qs[4][128];
    const int lane = threadIdx.x & 63, w = threadIdx.x >> 6; const int gq = blockIdx.x * 4 + w;
    const int t = gq % SEQ, bh = gq / SEQ, h = bh % 16, b = bh / 16; const size_t row = (size_t)b * SEQ + t;
    unsigned char* ws = c.ws;
    const bf16_t *Q2 = (const bf16_t*)(ws + WS_Q2), *K2 = (const bf16_t*)(ws + WS_K2), *V2 = (const bf16_t*)(ws + WS_V2), *SG2 = (const bf16_t*)(ws + WS_SG2);
    for (int d = lane; d < 128; d += 64) qs[w][d] = bf2f(Q2[row * 2048 + h * 128 + d]);
    __syncthreads();
    float carry = 0.f, o0 = 0.f, o1 = 0.f;
    for (int c0 = 0; c0 < t; c0 += 64) {
        const int j = t - 1 - c0 - lane; const bool valid = j >= 0; const size_t krow = (size_t)b * SEQ + (valid ? j : 0);
        const float z = dot_row<128>(qs[w], K2 + krow * 2048 + h * 128);
        const float sp = fmaxf(z, 0.f) + log2f(1.0f + exp2f(-fabsf(z)));
        const float L = valid ? -sp : 0.f;
        float incl = L;
#pragma unroll
        for (int o = 1; o < 64; o <<= 1) { const float v = __shfl_up(incl, o); if (lane >= o) incl += v; }
        const float between = carry + (incl - L);
        const float a = valid ? exp2f(z - sp + between) : 0.f;
        carry += __shfl(incl, 63);
        const int nj = min(64, t - c0);
        for (int jj = 0; jj < nj; ++jj) { const float aj = __shfl(a, jj); const bf16_t* vr = V2 + ((size_t)b * SEQ + t - 1 - c0 - jj) * 2048 + h * 128; o0 += aj * bf2f(vr[lane]); o1 += aj * bf2f(vr[lane + 64]); }
    }
    bf16_t* MIX2 = (bf16_t*)(ws + WS_MIX2);
    MIX2[row * 2048 + h * 128 + lane] = f2bf(o0 * bf2f(SG2[row * 2048 + h * 128 + lane]));
    MIX2[row * 2048 + h * 128 + lane + 64] = f2bf(o1 * bf2f(SG2[row * 2048 + h * 128 + lane + 64]));
}

namespace att {
typedef short bf16x8 __attribute__((ext_vector_type(8)));
typedef short s16x4 __attribute__((ext_vector_type(4)));
typedef short v4i16_t __attribute__((ext_vector_type(4)));
typedef float f32x16 __attribute__((ext_vector_type(16)));
typedef _Float16 f16x8 __attribute__((ext_vector_type(8)));
typedef _Float16 f16x2 __attribute__((ext_vector_type(2)));
typedef float f32x2_t __attribute__((ext_vector_type(2))); typedef __bf16 bf16x2_t __attribute__((ext_vector_type(2)));
typedef LAS const unsigned char* lcp;
#define MFMA_BF16(a, b, c) __builtin_amdgcn_mfma_f32_32x32x16_bf16((a), (b), (c), 0, 0, 0)
#define MFMA_F16(a, b, c) __builtin_amdgcn_mfma_f32_32x32x16_f16((a), (b), (c), 0, 0, 0)
#define SBAR() __builtin_amdgcn_sched_barrier(0)
DI int crow(int g, int h) { return (g & 3) + 8 * (g >> 2) + 4 * h; }
DI unsigned off_b(unsigned row, unsigned ch) { return 256u * row + 16u * (ch ^ (((row & 3) << 2) | ((row >> 2) & 3))); }
DI unsigned cvtpk(float lo, float hi) { f32x2_t v = {lo, hi}; bf16x2_t b = __builtin_convertvector(v, bf16x2_t); return __builtin_bit_cast(unsigned, b); }
DI unsigned cvtpk_h(float lo, float hi) { f32x2_t v = {lo, hi}; f16x2 b = __builtin_convertvector(v, f16x2); return __builtin_bit_cast(unsigned, b); }
DI bf16x8 pack_bf(const f32x16& x, int s) { u32x4 p; p.x = cvtpk(x[8 * s], x[8 * s + 1]); p.y = cvtpk(x[8 * s + 2], x[8 * s + 3]); p.z = cvtpk(x[8 * s + 4], x[8 * s + 5]); p.w = cvtpk(x[8 * s + 6], x[8 * s + 7]); return __builtin_bit_cast(bf16x8, p); }
DI f16x8 pack_h(const f32x16& x, int s) { u32x4 p; p.x = cvtpk_h(x[8 * s], x[8 * s + 1]); p.y = cvtpk_h(x[8 * s + 2], x[8 * s + 3]); p.z = cvtpk_h(x[8 * s + 4], x[8 * s + 5]); p.w = cvtpk_h(x[8 * s + 6], x[8 * s + 7]); return __builtin_bit_cast(f16x8, p); }
DI s16x4 vtr(lcp p) { return __builtin_bit_cast(s16x4, __builtin_amdgcn_ds_read_tr16_b64_v4i16((LAS v4i16_t*)p)); }
DI float swap_max(float m) { auto rr = __builtin_amdgcn_permlane32_swap(__float_as_uint(m), __float_as_uint(m), false, false); return fmaxf(__uint_as_float(rr[0]), __uint_as_float(rr[1])); }
DI float swap_sum(float m) { auto rr = __builtin_amdgcn_permlane32_swap(__float_as_uint(m), __float_as_uint(m), false, false); return __uint_as_float(rr[0]) + __uint_as_float(rr[1]); }
DI float bcast_lo(float m) { auto rr = __builtin_amdgcn_permlane32_swap(__float_as_uint(m), __float_as_uint(m), false, false); return __uint_as_float(rr[0]); }
DI __amdgpu_buffer_rsrc_t mk_rsrc(const void* p, unsigned bytes) { return __builtin_amdgcn_make_buffer_rsrc((void*)p, 0, bytes, 0x00020000); }
DI u32x4 bload(__amdgpu_buffer_rsrc_t rs, unsigned voff, unsigned soff) { return __builtin_amdgcn_raw_buffer_load_b128(rs, voff, soff, 0); }
struct VAddr { unsigned a[2][4]; };
DI VAddr make_vaddr(int lane) { VAddr v; const unsigned hh = lane >> 5, blk = (lane >> 4) & 1, qq = (lane & 15) >> 2, p = lane & 3;
#pragma unroll
    for (int t = 0; t < 2; ++t)
#pragma unroll
        for (int d0 = 0; d0 < 4; ++d0) v.a[t][d0] = off_b(8 * t + 4 * hh + qq, 4 * d0 + 2 * blk + (p >> 1)) + 8 * (p & 1);
    return v; }
DI bf16x8 vfrag(lcp img, int s, int d0, const VAddr& va) {
    const s16x4 lo = vtr(img + 4096 * s + va.a[0][d0]);
    const s16x4 hi = vtr(img + 4096 * s + va.a[1][d0]);
    return (bf16x8){lo[0], lo[1], lo[2], lo[3], hi[0], hi[1], hi[2], hi[3]};
}
DI void softmax_tile(f32x16& s0, f32x16& s1, f32x16 (&o)[4], float& mrun, float& lrun) {
    float mt = fmaxf(s0[0], s1[0]);
#pragma unroll
    for (int g = 1; g < 16; ++g) mt = fmaxf(mt, fmaxf(s0[g], s1[g]));
    mt = swap_max(mt);
    const float mn = fmaxf(mrun, mt), alpha = __builtin_amdgcn_exp2f(mrun - mn); mrun = mn;
    float ps = 0.f;
#pragma unroll
    for (int g = 0; g < 16; ++g) { s0[g] = __builtin_amdgcn_exp2f(s0[g] - mn); s1[g] = __builtin_amdgcn_exp2f(s1[g] - mn); ps += s0[g] + s1[g]; }
    lrun = lrun * alpha + ps;
#pragma unroll
    for (int d0 = 0; d0 < 4; ++d0)
#pragma unroll
        for (int g = 0; g < 16; ++g) o[d0][g] *= alpha;
}

constexpr int MLA_KSTR = 400, MLA_KBUF = 64 * MLA_KSTR, VBUF = 16384, MLA_LDS_V = 2 * MLA_KBUF, MLA_LDS_BYTES = 2 * MLA_KBUF + 2 * VBUF;
template <bool MASKED>
DI void mla_tile(lcp kb, lcp vb, const bf16x8 (&qf)[12], f32x16 (&o)[4], float& mrun, float& lrun, const VAddr& va, int qrel, int hh) {
    f32x16 s0, s1;
#pragma unroll
    for (int g = 0; g < 16; ++g) { s0[g] = 0.f; s1[g] = 0.f; }
    bf16x8 f0a = *(LAS const bf16x8*)kb, f0b = *(LAS const bf16x8*)(kb + 32 * MLA_KSTR), f1a = *(LAS const bf16x8*)(kb + 32), f1b = *(LAS const bf16x8*)(kb + 32 * MLA_KSTR + 32), f2a, f2b;
#pragma unroll
    for (int d0 = 0; d0 < 12; ++d0) {
        if (d0 + 2 < 12) { const bf16x8 n0 = *(LAS const bf16x8*)(kb + (d0 + 2) * 32), n1 = *(LAS const bf16x8*)(kb + 32 * MLA_KSTR + (d0 + 2) * 32);
            if ((d0 + 2) % 3 == 0) { f0a = n0; f0b = n1; } else if ((d0 + 2) % 3 == 1) { f1a = n0; f1b = n1; } else { f2a = n0; f2b = n1; } }
        SBAR();
        s0 = MFMA_BF16(d0 % 3 == 0 ? f0a : d0 % 3 == 1 ? f1a : f2a, qf[d0], s0); s1 = MFMA_BF16(d0 % 3 == 0 ? f0b : d0 % 3 == 1 ? f1b : f2b, qf[d0], s1);
        SBAR();
    }
    if (MASKED) {
#pragma unroll
        for (int g = 0; g < 16; ++g) { const int kv = crow(g, 0); if (kv > qrel - 4 * hh) s0[g] = -INFINITY; if (kv + 32 > qrel - 4 * hh) s1[g] = -INFINITY; } }
    float mt = fmaxf(s0[0], s1[0]);
#pragma unroll
    for (int g = 1; g < 16; ++g) mt = fmaxf(mt, fmaxf(s0[g], s1[g]));
    mt = swap_max(mt);
    if (__builtin_amdgcn_ballot_w64(mt > mrun) != 0ull) {
        const float mn = fmaxf(mrun, mt), alpha = __builtin_amdgcn_exp2f(mrun - mn); mrun = mn; lrun *= alpha;
#pragma unroll
        for (int d0 = 0; d0 < 4; ++d0)
#pragma unroll
            for (int g = 0; g < 16; ++g) o[d0][g] *= alpha;
    }
    float ps = 0.f;
#pragma unroll
    for (int g = 0; g < 16; ++g) { s0[g] = __builtin_amdgcn_exp2f(s0[g] - mrun); s1[g] = __builtin_amdgcn_exp2f(s1[g] - mrun); ps += s0[g] + s1[g]; }
    lrun += ps;
    bf16x8 pf[4]; pf[0] = pack_bf(s0, 0); pf[1] = pack_bf(s0, 1); pf[2] = pack_bf(s1, 0); pf[3] = pack_bf(s1, 1);
    bf16x8 v0 = vfrag(vb, 0, 0, va), v1 = vfrag(vb, 0, 1, va), v2;
#pragma unroll
    for (int j = 0; j < 16; ++j) {
        if (j + 2 < 16) { const int ks = (j + 2) >> 2, d0 = (j + 2) & 3; const bf16x8 nx = vfrag(vb + (ks >> 1) * 8192, ks & 1, d0, va);
            if ((j + 2) % 3 == 0) v0 = nx; else if ((j + 2) % 3 == 1) v1 = nx; else v2 = nx; }
        SBAR();
        o[j & 3] = MFMA_BF16(j % 3 == 0 ? v0 : j % 3 == 1 ? v1 : v2, pf[j >> 2], o[j & 3]);
        SBAR();
    }
}
DI void mla_unit(LAS unsigned char* lds, unsigned char* ws, int b, int h, int qb, const int tid_in) {
    int tid = tid_in; asm volatile("" : "+v"(tid));
    const int lane = tid & 63, wid = __builtin_amdgcn_readfirstlane(tid >> 6), r = lane & 31, hh = lane >> 5;
    const bf16_t *QN = (const bf16_t*)(ws + WS_QN), *QR = (const bf16_t*)(ws + WS_QR), *KN = (const bf16_t*)(ws + WS_KN), *KR = (const bf16_t*)(ws + WS_KR), *VA = (const bf16_t*)(ws + WS_VA), *SG = (const bf16_t*)(ws + WS_SG);
    bf16_t* MIX = (bf16_t*)(ws + WS_MIX);
    const int q0 = qb * 256, NT = 4 * (qb + 1), tmax = (q0 + 32 * wid) >> 6; const size_t rowbase = (size_t)b * SEQ;
    bf16x8 qf[12];
    { const size_t qrow = rowbase + q0 + 32 * wid + r;
#pragma unroll
      for (int d0 = 0; d0 < 8; ++d0) qf[d0] = *(const bf16x8*)(QN + qrow * 1024 + h * 128 + d0 * 16 + hh * 8);
#pragma unroll
      for (int d0 = 0; d0 < 4; ++d0) qf[8 + d0] = *(const bf16x8*)(QR + qrow * 512 + h * 64 + d0 * 16 + hh * 8); }
    f32x16 o[4];
#pragma unroll
    for (int d0 = 0; d0 < 4; ++d0)
#pragma unroll
        for (int g = 0; g < 16; ++g) o[d0][g] = 0.f;
    float mrun = -INFINITY, lrun = 0.f;
    u32x4 kreg[3], vreg[2];
    const VAddr va = make_vaddr(lane);
    const __amdgpu_buffer_rsrc_t rKN = mk_rsrc(KN, M * 1024 * 2), rKR = mk_rsrc(KR, M * 64 * 2), rVA = mk_rsrc(VA, M * 1024 * 2);
    const unsigned vo0 = (tid >> 4) * 2048 + (tid & 15) * 16, vo1 = vo0 + 32 * 2048, vor = (tid >> 3) * 128 + (tid & 7) * 16;
    const unsigned so_n = ((unsigned)rowbase * 1024 + h * 128) * 2, so_r = (unsigned)rowbase * 64 * 2;
    const unsigned lk0 = (tid >> 4) * MLA_KSTR + (tid & 15) * 16, lk1 = lk0 + 32 * MLA_KSTR, lkr = (tid >> 3) * MLA_KSTR + 256 + (tid & 7) * 16;
    const unsigned lv0 = off_b((tid >> 4) & 31, tid & 15), lv1 = lv0 + 8192;
    const unsigned kfo = r * MLA_KSTR + hh * 16;
#define MLA_LOAD(t) do { const unsigned tn = so_n + (unsigned)(t) * (64 * 2048), tr_ = so_r + (unsigned)(t) * (64 * 128); \
        kreg[0] = bload(rKN, vo0, tn); kreg[1] = bload(rKN, vo1, tn); kreg[2] = bload(rKR, vor, tr_); vreg[0] = bload(rVA, vo0, tn); vreg[1] = bload(rVA, vo1, tn); } while (0)
#define MLA_STORE(buf) do { LAS unsigned char* kd = lds + (buf) * MLA_KBUF; LAS unsigned char* vd = lds + MLA_LDS_V + (buf) * VBUF; \
        *(LAS u32x4*)(kd + lk0) = kreg[0]; *(LAS u32x4*)(kd + lk1) = kreg[1]; *(LAS u32x4*)(kd + lkr) = kreg[2]; *(LAS u32x4*)(vd + lv0) = vreg[0]; *(LAS u32x4*)(vd + lv1) = vreg[1]; } while (0)
    MLA_LOAD(0); MLA_STORE(0); __builtin_amdgcn_s_waitcnt(0x0F70);   __syncthreads();
#define MLA_INTERVAL(MODE) { const int buf = t & 1; \
        if (t + 1 < NT) MLA_LOAD(t + 1); \
        if (MODE == 0) mla_tile<false>(lds + buf * MLA_KBUF + kfo, lds + MLA_LDS_V + buf * VBUF, qf, o, mrun, lrun, va, 0, hh); \
        if (MODE == 1) mla_tile<true>(lds + buf * MLA_KBUF + kfo, lds + MLA_LDS_V + buf * VBUF, qf, o, mrun, lrun, va, q0 + 32 * wid + r - 64 * t, hh); \
        if (t + 1 < NT) MLA_STORE(buf ^ 1); \
        __syncthreads(); }
    int t = 0;
    for (; t < tmax; ++t) MLA_INTERVAL(0)
    MLA_INTERVAL(1)
    for (++t; t < NT; ++t) MLA_INTERVAL(2)
#undef MLA_INTERVAL
#undef MLA_LOAD
#undef MLA_STORE
    const float inv = 1.0f / swap_sum(lrun);
    int t4 = tid; asm volatile("" : "+v"(t4)); const size_t qrow = rowbase + q0 + 32 * wid + (t4 & 31); const int hh2 = (t4 >> 5) & 1;
#pragma unroll
    for (int d0 = 0; d0 < 4; ++d0)
#pragma unroll
        for (int gg = 0; gg < 4; ++gg) { const size_t off = qrow * 2048 + h * 128 + 32 * d0 + 8 * gg + 4 * hh2;
            const unsigned long long sg = *(const unsigned long long*)(SG + off);
            const float g0 = __uint_as_float((unsigned)(sg << 16)), g1 = __uint_as_float((unsigned)sg & 0xffff0000u), g2 = __uint_as_float((unsigned)(sg >> 32) << 16), g3 = __uint_as_float((unsigned)(sg >> 32) & 0xffff0000u);
            const unsigned lo = cvtpk(o[d0][4 * gg] * inv * g0, o[d0][4 * gg + 1] * inv * g1), hi = cvtpk(o[d0][4 * gg + 2] * inv * g2, o[d0][4 * gg + 3] * inv * g3);
            *(unsigned long long*)(MIX + off) = (unsigned long long)lo | ((unsigned long long)hi << 32); }
}
DI void mla_phase(LAS unsigned char* lds, unsigned char* ws, const int tid) {
    const int G = gridDim.x, bx = blockIdx.x; const int vcu = (G % 8 == 0) ? (bx % 8) * (G / 8) + bx / 8 : bx;
    for (int p = vcu; p < 256; p += G) { const int bh = p >> 3, pr = p & 7; mla_unit(lds, ws, bh >> 3, bh & 7, 15 - pr, tid); mla_unit(lds, ws, bh >> 3, bh & 7, pr, tid); }
}

constexpr int SB_KBUF = 16384, SB_LDS_V = 3 * SB_KBUF, SB_LDS_UM = SB_LDS_V + 3 * VBUF, SB_LDS_BYTES = SB_LDS_UM + 2048;
DI float vmin_s(float a, float b) { float r; asm("v_min_f32 %0, %1, %2" : "=v"(r) : "v"(a), "v"(b)); return r; }
struct SbAddr { unsigned kx, vb0, vq; };
template <bool MASKED, int VAR>
DI void sb_iter(f32x16& zin, f32x16& zout, f32x16 (&o)[4], const u32x4& pi0, const u32x4& pi1, u32x4& po0, u32x4& po1, float& carry, const bf16x8 (&qf)[8], lcp ump, lcp knext, lcp vprev, const SbAddr& ad, int qrh) {
    u32x4 lw0, lw1; const float z0 = zin[0];
    unsigned kx = ad.kx, vq = ad.vq; asm volatile("" : "+v"(kx), "+v"(vq));
    bf16x8 kfa = *(LAS const bf16x8*)(knext + kx), kfb;
    const f16x8 um0 = *(LAS const f16x8*)ump, um1 = *(LAS const f16x8*)(ump + 16);
    SBAR();
#pragma unroll
    for (int k = 0; k < 8; ++k) {
        if (k == 0) {
#pragma unroll
            for (int g = 0; g < 16; ++g) zout[g] = 0.f;
        }
        if (VAR == 2 || VAR == 4) { asm volatile("" :: "v"((k & 1) ? kfb : kfa)); } else zout = MFMA_BF16((k & 1) ? kfb : kfa, qf[k], zout);
        if (k + 1 < 8) { bf16x8 nx; if (VAR == 3 || VAR == 4) nx = qf[k]; else nx = *(LAS const bf16x8*)(knext + ((32u * (k + 1)) ^ kx)); if (k & 1) kfa = nx; else kfb = nx; }
        SBAR();
        float lv[2];
#pragma unroll
        for (int i = 0; i < 2; ++i) { const int g = 2 * k + i;
            float sp; if (VAR == 8) sp = zin[g]; else if (VAR == 1 || VAR == 4) sp = vmin_s(zin[g], 64.0f) * 0.5f; else sp = __builtin_amdgcn_logf(1.0f + __builtin_amdgcn_exp2f(vmin_s(zin[g], 64.0f)));
            if (MASKED) lv[i] = (crow(g, 0) < qrh) ? sp : 0.f; else lv[i] = sp; }
        unsigned w = cvtpk_h(lv[0], lv[1]);
        asm volatile("" : "+v"(w));
        if (k < 4) lw0[k & 3] = w; else lw1[k & 3] = w;
        SBAR();
    }
    s16x4 la, ha, lb, hb;
    const unsigned vb0 = ad.vb0, vb1 = 2048 + (vb0 ^ 32);
    { const unsigned dq = vq; la = vtr(vprev + vb0 + dq); ha = vtr(vprev + vb1 + dq); }
    SBAR();
    zin = MFMA_F16(um0, __builtin_bit_cast(f16x8, lw0), zin); zin = MFMA_F16(um1, __builtin_bit_cast(f16x8, lw1), zin);
    SBAR();
#pragma unroll
    for (int j = 0; j < 8; ++j) {
        { const s16x4 lo = (j & 1) ? lb : la, hi = (j & 1) ? hb : ha;
          const bf16x8 vf = (bf16x8){lo[0], lo[1], lo[2], lo[3], hi[0], hi[1], hi[2], hi[3]};
          if (VAR == 2 || VAR == 4) { asm volatile("" :: "v"(vf)); } else o[j & 3] = MFMA_BF16(vf, __builtin_bit_cast(bf16x8, (j >> 2) ? pi1 : pi0), o[j & 3]); }
        if (j + 1 < 8) { const unsigned dq = (64u * ((j + 1) & 3)) ^ vq; s16x4 l_, h_; if (VAR == 3 || VAR == 4) { l_ = (s16x4){(short)pi0[0], (short)pi0[1], (short)pi0[2], (short)pi0[3]}; h_ = l_; } else { l_ = vtr(vprev + 4096 * ((j + 1) >> 2) + vb0 + dq); h_ = vtr(vprev + 4096 * ((j + 1) >> 2) + vb1 + dq); }
            if (j & 1) { la = l_; ha = h_; } else { lb = l_; hb = h_; } }
        SBAR();
        float av[2];
#pragma unroll
        for (int i = 0; i < 2; ++i) { const int g = 2 * j + i; float a; if (VAR == 8) a = zin[g]; else if (VAR == 1 || VAR == 4) a = zin[g] + carry; else a = __builtin_amdgcn_exp2f(zin[g] + carry); if (MASKED) av[i] = (crow(g, 0) < qrh) ? a : 0.f; else av[i] = a; }
        unsigned w = cvtpk(av[0], av[1]);
        asm volatile("" : "+v"(w));
        if (j < 4) po0[j & 3] = w; else po1[j & 3] = w;
        SBAR();
    }
    carry += bcast_lo(zin[0] - z0);
}
template <bool MASKED, int VAR>
DI void sb_tile(LAS unsigned char* lds, f32x16& za, f32x16& zb, f32x16 (&o)[4], u32x4 (&pa)[2], u32x4 (&pb)[2], float& carry, const bf16x8 (&qf)[8], lcp ump, const SbAddr& ad,
                unsigned krow_off, int ks, int ksn, int vs, int vsp, int qrh0) {
    sb_iter<MASKED, VAR>(za, zb, o, pa[0], pa[1], pb[0], pb[1], carry, qf, ump, lds + ks * SB_KBUF + krow_off, lds + SB_LDS_V + vsp * VBUF, ad, qrh0 - 32);
    sb_iter<MASKED, VAR>(zb, za, o, pb[0], pb[1], pa[0], pa[1], carry, qf, ump, lds + ksn * SB_KBUF + 8192 + krow_off, lds + SB_LDS_V + vs * VBUF + 8192, ad, qrh0);
}
template <int VAR> DI void sb_unit(LAS unsigned char* lds, unsigned char* ws, int b, int h, int qb, const int tid_in) {
    int tid = tid_in; asm volatile("" : "+v"(tid));
    const int lane = tid & 63, wid = __builtin_amdgcn_readfirstlane(tid >> 6), r = lane & 31, hh = lane >> 5;
    const bf16_t *Q2 = (const bf16_t*)(ws + WS_Q2), *K2 = (const bf16_t*)(ws + WS_K2), *V2 = (const bf16_t*)(ws + WS_V2), *SG2 = (const bf16_t*)(ws + WS_SG2);
    bf16_t* MIX2 = (bf16_t*)(ws + (VAR ? WS_A : WS_MIX2));
    const int q0 = qb * 256, NT = 4 * (qb + 1), tmax = (q0 + 32 * wid) >> 6; const size_t rowbase = (size_t)b * SEQ;
    bf16x8 qf[8];
    { const size_t qrow = rowbase + q0 + 32 * wid + r;
#pragma unroll
      for (int d0 = 0; d0 < 8; ++d0) qf[d0] = *(const bf16x8*)(Q2 + qrow * 2048 + h * 128 + d0 * 16 + hh * 8); }
    { f16x8 um[2];
#pragma unroll
      for (int s = 0; s < 2; ++s)
#pragma unroll
          for (int j = 0; j < 8; ++j) um[s][j] = (16 * s + 8 * (j >> 2) + 4 * hh + (j & 3)) >= r ? (_Float16)-1.0f : (_Float16)0.0f;
      *(LAS f16x8*)(lds + SB_LDS_UM + lane * 32) = um[0]; *(LAS f16x8*)(lds + SB_LDS_UM + lane * 32 + 16) = um[1]; }
    lcp ump = lds + SB_LDS_UM + lane * 32;
    f32x16 o[4];
#pragma unroll
    for (int d0 = 0; d0 < 4; ++d0)
#pragma unroll
        for (int g = 0; g < 16; ++g) o[d0][g] = 0.f;
    float carry = 0.f;
    SbAddr ad;
    { const unsigned blk = (lane >> 4) & 1, qq = (lane & 15) >> 2, p = lane & 3;
      ad.kx = ((r & 15) >> 1) << 5;
      ad.vb0 = 256 * (4 * hh + qq) + 8 * (p & 1) + 16 * ((2 * blk + (p >> 1)) ^ hh); ad.vq = 64 * qq; }
    const unsigned krow_off = r * 256 + ((hh ^ (r & 1)) << 4);
    const bf16_t* kbase = K2 + rowbase * 2048 + h * 128; const bf16_t* vbase = V2 + rowbase * 2048 + h * 128;
#define SB_DMA_SRC() int t2_ = tid; asm volatile("" : "+v"(t2_)); const int ln_ = t2_ & 63, drow_ = 8 * wid + (ln_ >> 4), c15_ = ln_ & 15;
#define SB_DMAK(tau, slot) do { SB_DMA_SRC(); const unsigned s0_ = (unsigned)drow_ * 2048 + ((c15_ ^ (drow_ & 15)) * 8), s1_ = (unsigned)(drow_ + 4) * 2048 + ((c15_ ^ ((drow_ + 4) & 15)) * 8); \
        const bf16_t* kt = kbase + (size_t)(NT - 1 - (tau)) * (64 * 2048); LAS unsigned char* kd = lds + (slot) * SB_KBUF + wid * 2048; \
        __builtin_amdgcn_global_load_lds((const unsigned*)(kt + s0_), (LAS unsigned*)kd, 16, 0, 0); __builtin_amdgcn_global_load_lds((const unsigned*)(kt + s1_), (LAS unsigned*)(kd + 1024), 16, 0, 0); } while (0)
#define SB_DMAV(tau, slot) do { SB_DMA_SRC(); const unsigned s0_ = (unsigned)drow_ * 2048 + ((c15_ ^ (((drow_ & 3) << 2) | ((drow_ >> 2) & 3))) * 8), s1_ = (unsigned)(drow_ + 4) * 2048 + ((c15_ ^ ((((drow_ + 4) & 3) << 2) | (((drow_ + 4) >> 2) & 3))) * 8); \
        const bf16_t* vt = vbase + (size_t)(NT - 1 - (tau)) * (64 * 2048); LAS unsigned char* vd = lds + SB_LDS_V + (slot) * VBUF + wid * 2048; \
        __builtin_amdgcn_global_load_lds((const unsigned*)(vt + s0_), (LAS unsigned*)vd, 16, 0, 0); __builtin_amdgcn_global_load_lds((const unsigned*)(vt + s1_), (LAS unsigned*)(vd + 1024), 16, 0, 0); } while (0)
    SB_DMAK(0, 0); SB_DMAV(0, 0);
    if (NT > 1) SB_DMAK(1, 1);
    __builtin_amdgcn_s_waitcnt(0x0F70);
    __syncthreads();
    f32x16 za, zb;
#pragma unroll
    for (int g = 0; g < 16; ++g) { za[g] = 0.f; zb[g] = 0.f; }
    u32x4 pa[2], pb[2]; pa[0] = (u32x4){0u, 0u, 0u, 0u}; pa[1] = pa[0]; pb[0] = pa[0]; pb[1] = pa[0];
    int ks = 0, ks1 = 1, vs = 0, vsp = 0;
    const int nmask = NT - tmax;
#define SB_INTERVAL(MASKED) { const int t = NT - 1 - tau; const int ks2 = (ks1 == 2) ? 0 : ks1 + 1, vs1 = (vs == 2) ? 0 : vs + 1; \
        if (VAR != 5 && tau + 2 < NT) SB_DMAK(tau + 2, ks2); \
        if (VAR != 5 && tau + 1 < NT) SB_DMAV(tau + 1, vs1); \
        int qrh0; { int t3 = tid; asm volatile("" : "+v"(t3)); qrh0 = q0 + 32 * wid + (t3 & 31) - 4 * ((t3 >> 5) & 1) - 64 * t; }        \
        if (VAR != 7 || wid < 4) sb_tile<MASKED, VAR>(lds, za, zb, o, pa, pb, carry, qf, ump, ad, krow_off, ks, (tau + 1 < NT ? ks1 : ks), vs, vsp, qrh0); \
        ks = ks1; ks1 = ks2; vsp = vs; vs = vs1; \
        if (VAR != 5) __syncthreads(); }
    int tau = 0;
    for (; tau < nmask - 1; ++tau) { const int ks2 = (ks1 == 2) ? 0 : ks1 + 1, vs1 = (vs == 2) ? 0 : vs + 1;
        if (VAR != 5 && tau + 2 < NT) SB_DMAK(tau + 2, ks2);
        if (VAR != 5 && tau + 1 < NT) SB_DMAV(tau + 1, vs1);
        ks = ks1; ks1 = ks2; vsp = vs; vs = vs1;
        if (VAR != 5) __syncthreads(); }
    { lcp kp = lds + ks * SB_KBUF + 8192 + krow_off;
#pragma unroll
      for (int k = 0; k < 8; ++k) za = MFMA_BF16(*(LAS const bf16x8*)(kp + ((32u * k) ^ ad.kx)), qf[k], za); }
    for (; tau < nmask; ++tau) SB_INTERVAL(true)
    for (; tau < NT; ++tau) SB_INTERVAL(false)
#undef SB_INTERVAL
    { lcp vp = lds + SB_LDS_V + vsp * VBUF;
#pragma unroll
      for (int j = 0; j < 8; ++j) { const unsigned dq = (64u * (j & 3)) ^ ad.vq;
          const s16x4 lo = vtr(vp + 4096 * (j >> 2) + ad.vb0 + dq), hi = vtr(vp + 4096 * (j >> 2) + 2048 + (ad.vb0 ^ 32) + dq);
          o[j & 3] = MFMA_BF16(((bf16x8){lo[0], lo[1], lo[2], lo[3], hi[0], hi[1], hi[2], hi[3]}), __builtin_bit_cast(bf16x8, (j >> 2) ? pa[1] : pa[0]), o[j & 3]); } }
    __syncthreads();
#undef SB_DMAK
#undef SB_DMAV
#undef SB_DMA_SRC
    int t4 = tid; asm volatile("" : "+v"(t4)); const size_t qrow = rowbase + q0 + 32 * wid + (t4 & 31); const int hh2 = (t4 >> 5) & 1;
#pragma unroll
    for (int d0 = 0; d0 < 4; ++d0)
#pragma unroll
        for (int gg = 0; gg < 4; ++gg) { const size_t off = qrow * 2048 + h * 128 + 32 * d0 + 8 * gg + 4 * hh2;
            const unsigned long long sg = *(const unsigned long long*)(SG2 + off);
            const float g0 = __uint_as_float((unsigned)(sg << 16)), g1 = __uint_as_float((unsigned)sg & 0xffff0000u), g2 = __uint_as_float((unsigned)(sg >> 32) << 16), g3 = __uint_as_float((unsigned)(sg >> 32) & 0xffff0000u);
            const unsigned lo = cvtpk(o[d0][4 * gg] * g0, o[d0][4 * gg + 1] * g1), hi = cvtpk(o[d0][4 * gg + 2] * g2, o[d0][4 * gg + 3] * g3);
            *(unsigned long long*)(MIX2 + off) = (unsigned long long)lo | ((unsigned long long)hi << 32); }
}
template <int VAR> DI void sb_phase(LAS unsigned char* lds, unsigned char* ws, const int tid) {
    const int G = gridDim.x, bx = blockIdx.x; const int vcu = (G % 8 == 0) ? (bx % 8) * (G / 8) + bx / 8 : bx;
    for (int p = vcu; p < 512; p += G) { const int bh = p >> 3, pr = p & 7; sb_unit<VAR>(lds, ws, bh >> 4, bh & 15, 15 - pr, tid); sb_unit<VAR>(lds, ws, bh >> 4, bh & 15, pr, tid); }
}

constexpr int DIL_KSTR = 272, DIL_WAVE_BYTES = 32 * DIL_KSTR + 8192, DIL_LDS_BYTES = 8 * DIL_WAVE_BYTES;
DI void softmax_blk(f32x16& s0, f32x16 (&o)[4], float& mrun, float& lrun) {
    float mt = s0[0];
#pragma unroll
    for (int g = 1; g < 16; ++g) mt = fmaxf(mt, s0[g]);
    mt = swap_max(mt);
    if (__builtin_amdgcn_ballot_w64(mt > mrun) != 0ull) {
        const float mn = fmaxf(mrun, mt), alpha = __builtin_amdgcn_exp2f(mrun - mn); mrun = mn; lrun *= alpha;
#pragma unroll
        for (int d0 = 0; d0 < 4; ++d0)
#pragma unroll
            for (int g = 0; g < 16; ++g) o[d0][g] *= alpha;
    }
    float ps = 0.f;
#pragma unroll
    for (int g = 0; g < 16; ++g) { s0[g] = __builtin_amdgcn_exp2f(s0[g] - mrun); ps += s0[g]; }
    lrun += ps;
}
DI void dil_wave_unit(LAS unsigned char* wl, unsigned char* ws, int p, int b, int h, int res, int m0w, const int tid_in) {
    int tid = tid_in; asm volatile("" : "+v"(tid));
    const int lane = tid & 63, r = lane & 31, hh = lane >> 5; const int dil = p == 0 ? 1 : p == 1 ? 4 : 16;
    const bf16_t *QB = (const bf16_t*)(ws + WS_QB), *KB = (const bf16_t*)(ws + WS_KB), *VB = (const bf16_t*)(ws + WS_VB);
    const size_t rowbase = (size_t)b * SEQ; const size_t qrow = rowbase + (size_t)(m0w + r) * dil + res;
    const __amdgpu_buffer_rsrc_t rK = mk_rsrc(KB, M * 1024 * 2), rV = mk_rsrc(VB, M * 1024 * 2);
    const unsigned vo = (unsigned)(lane >> 4) * dil * 2048 + (lane & 15) * 16;
    const unsigned so0 = (unsigned)((rowbase + res) * 1024 + h * 128) * 2;
    const float* biasc = (const float*)(ws + WS_BIASC) + (size_t)(p * 8 + h) * 5 * 1024 + lane * 16;
    u32x4 kr[8], vr[8]; f32x4 br[4];
    const int kb0 = m0w >> 5;
#define DIL_LOAD(di) do { const unsigned sb_ = so0 + (unsigned)(32 * (kb0 - (di))) * dil * 2048; \
        _Pragma("unroll") for (int i = 0; i < 8; ++i) { kr[i] = bload(rK, vo + (unsigned)(4 * i) * dil * 2048, sb_); vr[i] = bload(rV, vo + (unsigned)(4 * i) * dil * 2048, sb_); } \
        _Pragma("unroll") for (int j = 0; j < 4; ++j) br[j] = ((const f32x4*)(biasc + (di) * 1024))[j]; } while (0)
    DIL_LOAD(0);
    bf16x8 qf[8];
#pragma unroll
    for (int d0 = 0; d0 < 8; ++d0) qf[d0] = *(const bf16x8*)(QB + qrow * 1024 + h * 128 + d0 * 16 + hh * 8);
    f32x16 o[4];
#pragma unroll
    for (int d0 = 0; d0 < 4; ++d0)
#pragma unroll
        for (int g = 0; g < 16; ++g) o[d0][g] = 0.f;
    float mrun = -INFINITY, lrun = 0.f;
    const VAddr va = make_vaddr(lane);
    const unsigned lk = (lane >> 4) * DIL_KSTR + (lane & 15) * 16;
    for (int di = 0; di < 5; ++di) {
        if (kb0 - di < 0) break;
        asm volatile("s_waitcnt lgkmcnt(0)" ::: "memory");
#pragma unroll
        for (int i = 0; i < 8; ++i) { *(LAS u32x4*)(wl + lk + 4 * i * DIL_KSTR) = kr[i]; *(LAS u32x4*)(wl + 32 * DIL_KSTR + off_b((lane >> 4) + 4 * i, lane & 15)) = vr[i]; }
        f32x16 s0;
#pragma unroll
        for (int j = 0; j < 4; ++j) { s0[4 * j] = br[j][0]; s0[4 * j + 1] = br[j][1]; s0[4 * j + 2] = br[j][2]; s0[4 * j + 3] = br[j][3]; }
        if (di + 1 < 5 && kb0 - (di + 1) >= 0) DIL_LOAD(di + 1);
        asm volatile("s_waitcnt lgkmcnt(0)" ::: "memory");
        lcp kp = wl + r * DIL_KSTR + hh * 16;
#pragma unroll
        for (int d0 = 0; d0 < 8; ++d0) s0 = MFMA_BF16(*(LAS const bf16x8*)(kp + d0 * 32), qf[d0], s0);
        softmax_blk(s0, o, mrun, lrun);
        lcp vb = wl + 32 * DIL_KSTR;
#pragma unroll
        for (int s = 0; s < 2; ++s) { const bf16x8 pf = pack_bf(s0, s);
#pragma unroll
            for (int d0 = 0; d0 < 4; ++d0) o[d0] = MFMA_BF16(vfrag(vb, s, d0, va), pf, o[d0]); }
    }
#undef DIL_LOAD
    const float lt = swap_sum(lrun), inv = 1.0f / lt;
    bf16_t* OP = (bf16_t*)(ws + (p == 0 ? WS_OP0 : p == 1 ? WS_OP1 : WS_OP2));
#pragma unroll
    for (int d0 = 0; d0 < 4; ++d0)
#pragma unroll
        for (int gg = 0; gg < 4; ++gg) { const size_t off = qrow * 1024 + h * 128 + 32 * d0 + 8 * gg + 4 * hh;
            const unsigned lo = cvtpk(o[d0][4 * gg] * inv, o[d0][4 * gg + 1] * inv), hi = cvtpk(o[d0][4 * gg + 2] * inv, o[d0][4 * gg + 3] * inv);
            *(unsigned long long*)(OP + off) = (unsigned long long)lo | ((unsigned long long)hi << 32); }
    if (hh == 0) ((float*)(ws + WS_LSE))[((size_t)p * M + qrow) * 8 + h] = mrun + __builtin_amdgcn_logf(lt);
}
DI void dil_phase(LAS unsigned char* lds, unsigned char* ws, const int tid) {
    const int wid = __builtin_amdgcn_readfirstlane(tid >> 6);
    LAS unsigned char* wl = lds + wid * DIL_WAVE_BYTES;
    for (int u = blockIdx.x; u < 1536; u += gridDim.x) {
        const int cidx = u & 15, h = (u >> 4) & 7, b = (u >> 7) & 3, p = u >> 9;
        const int res = p == 0 ? 0 : p == 1 ? (cidx & 3) : cidx, m0 = p == 0 ? 256 * cidx : p == 1 ? 256 * (cidx >> 2) : 0;
        dil_wave_unit(wl, ws, p, b, h, res, m0 + 32 * wid, tid);
    }
}
}

__global__ void __launch_bounds__(512, 2) k_mla_fast(Ctx c) { extern __shared__ __attribute__((aligned(16))) unsigned char lds[]; att::mla_phase((LAS unsigned char*)lds, c.ws, (int)threadIdx.x); }
__global__ void __launch_bounds__(512, 2) k_sb_fast(Ctx c) { extern __shared__ __attribute__((aligned(16))) unsigned char lds[]; att::sb_phase<0>((LAS unsigned char*)lds, c.ws, (int)threadIdx.x); }
__global__ void __launch_bounds__(512, 2) k_dil_fast(Ctx c) { extern __shared__ __attribute__((aligned(16))) unsigned char lds[]; att::dil_phase((LAS unsigned char*)lds, c.ws, (int)threadIdx.x); }

DI void final_norm_row(float* out, const float* gain, int row, int lane) {
    f32x4* xr = (f32x4*)(out + (size_t)row * D_MODEL) + lane; const f32x4* g = (const f32x4*)gain + lane;
    f32x4 v[8]; float s = 0.f;
#pragma unroll
    for (int j = 0; j < 8; ++j) { v[j] = xr[64 * j]; s += v[j].x * v[j].x + v[j].y * v[j].y + v[j].z * v[j].z + v[j].w * v[j].w; }
    const float r = rsqrtf(wave_sum(s) * (1.0f / D_MODEL) + EPS);
#pragma unroll
    for (int j = 0; j < 8; ++j) xr[64 * j] = v[j] * r * g[64 * j];
}
__global__ void __launch_bounds__(256) k_final_norm(float* out, const float* gain) { final_norm_row(out, gain, blockIdx.x * 4 + (threadIdx.x >> 6), threadIdx.x & 63); }

#define XB_TMO      128
#define XB_XCNT(j)  (256  + 64 * (j))
#define XB_XSUB(j)  (1280 + 64 * (j))
#define XB_XGEN(j)  (2304 + 64 * (j))
#define XB_TOP      3328
#define XB_TOPGEN   3392
#define XCD_BAR_WORDS 3456
#define XB_SPIN_CAP (1u << 22)
DI unsigned xb_ld(unsigned* p)              { return __hip_atomic_load(p, __ATOMIC_RELAXED, __HIP_MEMORY_SCOPE_AGENT); }
DI unsigned xb_add(unsigned* p, unsigned v) { return __hip_atomic_fetch_add(p, v, __ATOMIC_RELAXED, __HIP_MEMORY_SCOPE_AGENT); }
DI unsigned xb_xcc_id() { return (unsigned)__builtin_amdgcn_s_getreg((3 << 11) | 20) & 0xFu; }
#define XB_SPIN(cond, bar) do { unsigned _sp = 0; while (cond) { __builtin_amdgcn_s_sleep(1); \
    if ((++_sp & 255u) == 0u) { if (xb_ld(&(bar)[XB_TMO])) break; if (_sp > XB_SPIN_CAP) { atomicAdd(&(bar)[XB_TMO], 1u); break; } } } } while (0)
struct XcdBarrier { unsigned* bar; unsigned x; volatile LAS unsigned* st; };
DI XcdBarrier xcd_barrier_post(unsigned* bar, volatile LAS unsigned* st, int tid) {
    XcdBarrier b; b.bar = bar; b.x = xb_xcc_id(); b.st = st;
    if (tid == 0) (void)xb_add(&bar[XB_XCNT(b.x)], 1u);
    return b;
}
DI void xcd_barrier_complete(unsigned* bar, unsigned x, unsigned& nloc, unsigned& nx) {
    const unsigned G = gridDim.x * gridDim.y * gridDim.z;
    unsigned sum, cnt, mine, sp = 0u;
    for (;;) {
        sum = 0u; cnt = 0u; mine = 0u;
#pragma unroll
        for (unsigned j = 0; j < 16; ++j) { const unsigned c = xb_ld(&bar[XB_XCNT(j)]); sum += c; cnt += (c > 0u) ? 1u : 0u; mine = (j == x) ? c : mine; }
        if (sum == G) break;
        __builtin_amdgcn_s_sleep(1);
        if ((++sp & 255u) == 0u) { if (xb_ld(&bar[XB_TMO])) break; if (sp > XB_SPIN_CAP) { atomicAdd(&bar[XB_TMO], 1u); break; } }
    }
    nloc = mine > 0u ? mine : 1u; nx = cnt > 0u ? cnt : 1u;
}
DI void xcd_barrier(const XcdBarrier& b, int tid) {
    asm volatile("s_waitcnt vmcnt(0)" ::: "memory");
    __syncthreads();
    if (tid == 0) {
        unsigned* bar = b.bar;
        __builtin_amdgcn_s_waitcnt(0);
        unsigned nloc = b.st[0], nx = b.st[1];
        if (nloc == 0u) { xcd_barrier_complete(bar, b.x, nloc, nx); b.st[0] = nloc; b.st[1] = nx; }
        const unsigned old = xb_add(&bar[XB_XSUB(b.x)], 1u);
        const unsigned gen = old / nloc;
        if (old + 1u == (gen + 1u) * nloc) {
            __builtin_amdgcn_fence(__ATOMIC_RELEASE, "agent");
            asm volatile("s_waitcnt vmcnt(0)" ::: "memory");
            const unsigned og = xb_add(&bar[XB_TOP], 1u);
            const unsigned tg = og / nx;
            if (og + 1u == (tg + 1u) * nx) xb_add(&bar[XB_TOPGEN], 1u);
            else XB_SPIN(xb_ld(&bar[XB_TOPGEN]) == tg, bar);
            __builtin_amdgcn_fence(__ATOMIC_ACQUIRE, "agent");
            xb_add(&bar[XB_XGEN(b.x)], 1u);
            asm volatile("s_waitcnt vmcnt(0)" ::: "memory");
        } else {
            XB_SPIN(xb_ld(&bar[XB_XGEN(b.x)]) == gen, bar);
            __builtin_amdgcn_fence(__ATOMIC_ACQUIRE, "agent");
            asm volatile("s_waitcnt vmcnt(0)" ::: "memory");
        }
    }
    __syncthreads();
}

constexpr int MEGA_LDS_PHASE = 135168, MEGA_LDS = MEGA_LDS_PHASE + 64;
#ifndef SYNC_PROBE
#define SYNC_PROBE 0
#endif
#ifndef SB_PROBE_VAR
#define SB_PROBE_VAR 0
#endif
#ifndef PROBE_MASK
#define PROBE_MASK 0
#endif
#define PREP(k) for (int rep_ = 0; rep_ < 1 + ((PROBE_MASK >> (k)) & 1); ++rep_)
__global__ void __launch_bounds__(512, 2) k_mega(Ctx c) {
    extern __shared__ __attribute__((aligned(16))) unsigned char lds_raw[];
    LAS unsigned char* lds = (LAS unsigned char*)lds_raw;
    unsigned char* ws = c.ws; const int G = gridDim.x, bx = blockIdx.x;
    const int wave_s = __builtin_amdgcn_readfirstlane((int)threadIdx.x >> 6);
    volatile LAS unsigned* bst = (volatile LAS unsigned*)(lds + MEGA_LDS_PHASE);
    if (threadIdx.x < 16) bst[threadIdx.x] = 0u;
    __syncthreads();
    const XcdBarrier xbar = xcd_barrier_post((unsigned*)(ws + WS_CTL), bst, (int)threadIdx.x);
#define GRID_BAR() xcd_barrier(xbar, phase_tid(wave_s))
    PREP(0) { prep_phase<8, 0>(c, (float*)lds_raw, phase_tid(wave_s)); __syncthreads(); }
    GRID_BAR();
    PREP(1) { pg8::Gemm g{(const bf16_t*)(ws + WS_H0), (const bf16_t*)(ws + WS_WT_IN_E), M, IN_EVEN_PAD, 2048}; pg8::StaticOrder S; S.init(g.M, g.N, G, bx);
      pg8::gemm_phase<pg8::FEpi1, pg8::StaticOrder, true, true>(lds, g, S, pg8::FEpi1{ws}, phase_tid(wave_s)); }
    { const int nlast = (M / 256) * (IN_EVEN_PAD / 256) % G; const int nfree = nlast ? G - nlast : G, me = nlast ? bx - nlast : bx;
      if (me >= 0) { const int tid = phase_tid(wave_s); prep_weights<1>(c, (float*)lds_raw + (tid >> 6) * 64 * 36, tid & 63, me * 8 + (tid >> 6), nfree * 8); } }
    GRID_BAR();
    PREP(2) { att::dil_phase(lds, ws, phase_tid(wave_s));
    __syncthreads(); }
    PREP(7) { pg8::Gemm g{(const bf16_t*)(ws + WS_CQ), (const bf16_t*)(ws + WS_WT_UQ), M, 1536, 512}; pg8::StaticOrder S; S.init(g.M, g.N, G, bx);
      pg8::gemm_phase<pg8::FEpi2a, pg8::StaticOrder, true, true>(lds, g, S, pg8::FEpi2a{ws}, phase_tid(wave_s)); }
    PREP(7) { pg8::Gemm g{(const bf16_t*)(ws + WS_CKV), (const bf16_t*)(ws + WS_WT_UKV), M, 2048, 512}; pg8::StaticOrder S; S.init(g.M, g.N, G, bx);
      pg8::gemm_phase<pg8::FEpi2b, pg8::StaticOrder, true, true>(lds, g, S, pg8::FEpi2b{ws}, phase_tid(wave_s)); }
    GRID_BAR();
    PREP(3) att::mla_phase(lds, ws, phase_tid(wave_s));
    PREP(8) { const int tid = phase_tid(wave_s); for (int it = bx * 512 + tid; it < M * 128; it += G * 512) dil_merge_item(ws, it >> 7, (it & 127) * 8); }
    GRID_BAR();
    PREP(4) { pg8::Gemm g{(const bf16_t*)(ws + WS_MIX), (const bf16_t*)(ws + WS_WT_OUT_E), M, 2048, 2048}; pg8::StaticOrder S; S.init(g.M, g.N, G, bx);
      pg8::gemm_phase<pg8::FEpi4, pg8::StaticOrder, true, true>(lds, g, S, pg8::FEpi4{ws, c.x, c.out}, phase_tid(wave_s)); }
    GRID_BAR();
    PREP(5) { pg8::Gemm g{(const bf16_t*)(ws + WS_X1BF), (const bf16_t*)(ws + WS_WT_IN_O), M, IN_ODD, 2048}; pg8::StaticOrder S; S.init(g.M, g.N, G, bx);
      pg8::gemm_phase<pg8::FEpi5, pg8::StaticOrder, true, true>(lds, g, S, pg8::FEpi5{ws}, phase_tid(wave_s)); }
    GRID_BAR();
    PREP(6) att::sb_phase<0>(lds, ws, phase_tid(wave_s));
#if SB_PROBE_VAR
    att::sb_phase<SB_PROBE_VAR>(lds, ws, phase_tid(wave_s));
#endif
    GRID_BAR();
    { pg8::Gemm g{(const bf16_t*)(ws + WS_MIX2), (const bf16_t*)(ws + WS_WT_OUT_O), M, 2048, 2048}; pg8::StaticOrder S; S.init(g.M, g.N, G, bx);
      pg8::gemm_phase<pg8::FEpi7, pg8::StaticOrder, true, true>(lds, g, S, pg8::FEpi7{c.out}, phase_tid(wave_s)); }
    GRID_BAR();
#if SYNC_PROBE
    for (int i_ = 0; i_ < 8; ++i_) GRID_BAR();
#endif
    { const int tid = phase_tid(wave_s); for (int row = bx * 8 + (tid >> 6); row < M; row += G * 8) final_norm_row(c.out, c.final_gain, row, tid & 63); }
}

#ifndef MK_ONE_LAUNCH
#define MK_ONE_LAUNCH 1
#endif
#ifndef FAST_G1
#define FAST_G1 1
#endif
#ifndef FAST_G2
#define FAST_G2 1
#endif
#ifndef FAST_G4
#define FAST_G4 1
#endif
#ifndef FAST_G5
#define FAST_G5 1
#endif
#ifndef FAST_G7
#define FAST_G7 1
#endif
#ifndef FAST_MLA
#define FAST_MLA 1
#endif
#ifndef FAST_SB
#define FAST_SB 1
#endif
#ifndef FAST_DIL
#define FAST_DIL 1
#endif
static void launch_att(void (*k)(Ctx), int lds_bytes, const Ctx& c, hipStream_t s) {
    (void)hipFuncSetAttribute((const void*)k, hipFuncAttributeMaxDynamicSharedMemorySize, lds_bytes);
    hipLaunchKernelGGL(k, dim3(256), dim3(512), lds_bytes, s, c);
}
template <class Epi> static void launch_gemm_fast(const bf16_t* A, const bf16_t* Bt, int N, int K, Epi E, hipStream_t s) {
    static bool attr = false; if (!attr) { (void)hipFuncSetAttribute((const void*)k_gemm_fast<Epi>, hipFuncAttributeMaxDynamicSharedMemorySize, 131072); attr = true; }
    pg8::Gemm g{A, Bt, M, N, K};
    k_gemm_fast<Epi><<<256, 512, 131072, s>>>(g, E);
}

extern "C" void kernel_launch(void* const* d_in, const int* in_sizes, int n_in, void* d_out, int out_size, void* d_ws, size_t ws_size, hipStream_t stream) {
    if (n_in != 12 || out_size != M * D_MODEL || ws_size < WS_END) { fprintf(stderr, "kernel_launch: unexpected shapes (n_in %d out %d ws %zu)\n", n_in, out_size, ws_size); return; }
    Ctx c{};
    c.x = (const float*)d_in[0]; c.norm_gain = (const float*)d_in[1]; c.w_in_even = (const float*)d_in[2]; c.q_norm_gain = (const float*)d_in[3]; c.kv_norm_gain = (const float*)d_in[4];
    c.w_uq = (const float*)d_in[5]; c.w_ukv = (const float*)d_in[6]; c.w_out_even = (const float*)d_in[7]; c.rel_bias = (const float*)d_in[8]; c.w_in_odd = (const float*)d_in[9];
    c.w_out_odd = (const float*)d_in[10]; c.final_gain = (const float*)d_in[11]; c.out = (float*)d_out; c.ws = (unsigned char*)d_ws;
#if MK_ONE_LAUNCH
    static int grid_blocks = 0;
    if (!grid_blocks) {
        int dev = 0, cus = 0, per_cu = 0;
        (void)hipGetDevice(&dev); (void)hipDeviceGetAttribute(&cus, hipDeviceAttributeMultiprocessorCount, dev);
        (void)hipFuncSetAttribute((const void*)k_mega, hipFuncAttributeMaxDynamicSharedMemorySize, MEGA_LDS);
        (void)hipOccupancyMaxActiveBlocksPerMultiprocessor(&per_cu, (const void*)k_mega, 512, MEGA_LDS);
        if (per_cu < 1) { fprintf(stderr, "kernel_launch: occupancy query says %d blocks/CU\n", per_cu); per_cu = 1; }
        grid_blocks = cus;
    }
    (void)hipMemsetAsync((char*)d_ws + WS_CTL, 0, 65536, stream);
    { void* args[] = {&c};
      hipError_t e = hipLaunchCooperativeKernel((void*)k_mega, dim3(grid_blocks), dim3(512), args, MEGA_LDS, stream);
      if (e != hipSuccess) fprintf(stderr, "cooperative launch failed: %s (grid %d)\n", hipGetErrorString(e), grid_blocks); }
    return;
#endif
    unsigned char* ws = c.ws;
    const float* rc = (const float*)(ws + WS_ROPE); const float* rs = rc + 4096 * 32;
    k_prep<<<2048, 256, 0, stream>>>(c);
#if FAST_G1
    launch_gemm_fast((const bf16_t*)(ws + WS_H0), (const bf16_t*)(ws + WS_WT_IN_E), IN_EVEN_PAD, 2048, pg8::FEpi1{ws}, stream);
#else
    k_gemm_naive<Epi1><<<(M / 64) * (IN_EVEN_PAD / 64), 256, 0, stream>>>((const bf16_t*)(ws + WS_H0), (const bf16_t*)(ws + WS_WT_IN_E), IN_EVEN_PAD, 2048, Epi1{ws});
    k_rowss<false><<<M / 4, 256, 0, stream>>>(ws + WS_CQ, 512, 512, (float*)(ws + WS_SSC), 16, 8);
    k_rowss<false><<<M / 4, 256, 0, stream>>>(ws + WS_CKV, 512, 512, (float*)(ws + WS_SSC) + 8, 16, 8);
    k_rope<<<(M * 32 + 255) / 256, 256, 0, stream>>>((bf16_t*)(ws + WS_KR), 1, rc, rs);
#endif
#if FAST_DIL
    launch_att(k_dil_fast, att::DIL_LDS_BYTES, c, stream);
#else
    k_dil_naive<<<BATCH * 8 * SEQ / 4, 256, 0, stream>>>(c);
#endif
#if FAST_G2
    launch_gemm_fast((const bf16_t*)(ws + WS_CQ), (const bf16_t*)(ws + WS_WT_UQ), 1536, 512, pg8::FEpi2a{ws}, stream);
    launch_gemm_fast((const bf16_t*)(ws + WS_CKV), (const bf16_t*)(ws + WS_WT_UKV), 2048, 512, pg8::FEpi2b{ws}, stream);
#else
    k_gemm_naive<Epi2a><<<(M / 64) * (1536 / 64), 256, 0, stream>>>((const bf16_t*)(ws + WS_CQ), (const bf16_t*)(ws + WS_WT_UQ), 1536, 512, Epi2a{ws});
    k_rope<<<(M * 256 + 255) / 256, 256, 0, stream>>>((bf16_t*)(ws + WS_QR), 8, rc, rs);
    k_gemm_naive<Epi2b><<<(M / 64) * (2048 / 64), 256, 0, stream>>>((const bf16_t*)(ws + WS_CKV), (const bf16_t*)(ws + WS_WT_UKV), 2048, 512, Epi2b{ws});
#endif
#if FAST_MLA
    launch_att(k_mla_fast, att::MLA_LDS_BYTES, c, stream);
#else
    k_mla_naive<<<BATCH * 8 * SEQ / 4, 256, 0, stream>>>(c);
#endif
    k_dil_merge<<<M, 128, 0, stream>>>(c);
#if FAST_G4
    launch_gemm_fast((const bf16_t*)(ws + WS_MIX), (const bf16_t*)(ws + WS_WT_OUT_E), 2048, 2048, pg8::FEpi4{ws, c.x, c.out}, stream);
#else
    k_gemm_naive<Epi4><<<(M / 64) * (2048 / 64), 256, 0, stream>>>((const bf16_t*)(ws + WS_MIX), (const bf16_t*)(ws + WS_WT_OUT_E), 2048, 2048, Epi4{ws, c.x, c.out});
    k_rowss<true><<<M / 4, 256, 0, stream>>>(c.out, 2048, 2048, (float*)(ws + WS_SSX1), 32, 32);
#endif
#if FAST_G5
    launch_gemm_fast((const bf16_t*)(ws + WS_X1BF), (const bf16_t*)(ws + WS_WT_IN_O), IN_ODD, 2048, pg8::FEpi5{ws}, stream);
#else
    k_gemm_naive<Epi5><<<(M / 64) * (IN_ODD / 64), 256, 0, stream>>>((const bf16_t*)(ws + WS_X1BF), (const bf16_t*)(ws + WS_WT_IN_O), IN_ODD, 2048, Epi5{ws});
#endif
#if FAST_SB
    launch_att(k_sb_fast, att::SB_LDS_BYTES, c, stream);
#else
    k_sb_naive<<<BATCH * 16 * SEQ / 4, 256, 0, stream>>>(c);
#endif
#if FAST_G7
    launch_gemm_fast((const bf16_t*)(ws + WS_MIX2), (const bf16_t*)(ws + WS_WT_OUT_O), 2048, 2048, pg8::FEpi7{c.out}, stream);
#else
    k_gemm_naive<Epi7><<<(M / 64) * (2048 / 64), 256, 0, stream>>>((const bf16_t*)(ws + WS_MIX2), (const bf16_t*)(ws + WS_WT_OUT_O), 2048, 2048, Epi7{c.out});
#endif
    k_final_norm<<<M / 4, 256, 0, stream>>>(c.out, c.final_gain);
}
```

```cpp
#include <hip/hip_runtime.h>
#include <cstdio>
#include <cstdint>
#include <cmath>

typedef unsigned short bf16_t;
typedef unsigned u32x4 __attribute__((ext_vector_type(4)));
typedef float f32x4 __attribute__((ext_vector_type(4)));

constexpr int D_MODEL = 2048, BATCH = 4, SEQ = 4096, M = BATCH * SEQ;
constexpr int NH_MLA = 8, NH_DIL = 8, NH_SB = 16, HD = 128;
constexpr int IN_EVEN = 6208, IN_EVEN_PAD = 6400, IN_ODD = 8192;
constexpr float EPS = 1e-6f;
constexpr float LOG2E = 1.4426950408889634f;
constexpr float MLA_QSCALE = 0.07216878364870322f * LOG2E;
constexpr float D128_QSCALE = 0.08838834764831845f * LOG2E;

constexpr size_t MiB = 1u << 20;
constexpr size_t WS_CTL = 0;
constexpr size_t WS_ROPE = 1 * MiB;
constexpr size_t WS_BIASN = 2 * MiB;
constexpr size_t WS_BIASC = 2 * MiB + 65536;
constexpr size_t WS_SSX = 3 * MiB;
constexpr size_t WS_SSC = 4 * MiB;
constexpr size_t WS_SSX1 = 5 * MiB;
constexpr size_t WS_LSE = 9 * MiB;
constexpr size_t WS_WT_IN_E = 12 * MiB;
constexpr size_t WS_WT_UQ = 37 * MiB;
constexpr size_t WS_WT_UKV = 39 * MiB;
constexpr size_t WS_WT_OUT_E = 41 * MiB;
constexpr size_t WS_WT_IN_O = 49 * MiB;
constexpr size_t WS_WT_OUT_O = 81 * MiB;
constexpr size_t WS_A = 90 * MiB;
constexpr size_t WS_B = 154 * MiB;
constexpr size_t WS_C = 218 * MiB;
constexpr size_t WS_H0 = WS_A, WS_OP0 = WS_A, WS_OP1 = WS_A + 32 * MiB, WS_X1BF = WS_A;
constexpr size_t WS_CQ = WS_B, WS_CKV = WS_B + 16 * MiB, WS_QB = WS_B + 32 * MiB, WS_MIX = WS_B, WS_MIX2 = WS_B;
constexpr size_t WS_KB = WS_C, WS_VB = WS_C + 32 * MiB, WS_SG = WS_C + 64 * MiB, WS_QN = WS_C + 128 * MiB, WS_QR = WS_C + 160 * MiB,
                 WS_KN = WS_C + 176 * MiB, WS_VA = WS_C + 208 * MiB, WS_KR = WS_C + 240 * MiB, WS_OP2 = WS_C + 242 * MiB;
constexpr size_t WS_Q2 = WS_C, WS_K2 = WS_C + 64 * MiB, WS_V2 = WS_C + 128 * MiB, WS_SG2 = WS_C + 192 * MiB;
constexpr size_t WS_END = WS_C + 274 * MiB;

struct Ctx {
    const float *x, *norm_gain, *w_in_even, *q_norm_gain, *kv_norm_gain, *w_uq, *w_ukv, *w_out_even, *rel_bias, *w_in_odd, *w_out_odd, *final_gain;
    float* out; unsigned char* ws;
};

#define DI __device__ __forceinline__
DI int phase_tid(int wave_s) { int lane; asm volatile("v_mbcnt_lo_u32_b32 %0, -1, 0\n\tv_mbcnt_hi_u32_b32 %0, -1, %0" : "=v"(lane)); return wave_s * 64 + lane; }
DI float bf2f(bf16_t v) { return __uint_as_float(((unsigned)v) << 16); }
DI bf16_t f2bf(float f) { unsigned u = __float_as_uint(f); return (bf16_t)((u + 0x7fffu + ((u >> 16) & 1u)) >> 16); }
DI float wave_sum(float v) {
#pragma unroll
    for (int o = 1; o < 64; o <<= 1) v += __shfl_xor(v, o);
    return v;
}
DI float wave_max(float v) {
#pragma unroll
    for (int o = 1; o < 64; o <<= 1) v = fmaxf(v, __shfl_xor(v, o));
    return v;
}
DI float silu_f(float v) { return v / (1.0f + __expf(-v)); }

DI int map_in_even(int n) { if (n < 1024) return n; if (n < 1056) return 1024 + (n - 1024); if (n < 1088) return 1152 + (n - 1056); return n - 1088 + 1280; }
DI int map_uq(int n) { const int h = n / 192, j = n % 192; if (j < 128) return h * 128 + j; if (j < 160) return 1024 + (h >> 2) * 256 + (h & 3) * 32 + (j - 128);
    return 1024 + (h >> 2) * 256 + 128 + (h & 3) * 32 + (j - 160); }
DI int map_ukv(int n) { const int h = n / 256, j = n % 256; if (j < 128) return h * 128 + j; return 1024 + h * 128 + (j - 128); }
DI int map_id(int n) { return n; }

template <int MAPID>
DI void transpose_item(const float* W, int K, int N, const float* gain, bf16_t* WT, float* scr  , int item, int lane) {
    const int nblk = N / 32, kb = item / nblk, nb = item % nblk, k0 = 64 * kb, n0 = 32 * nb;
    f32x4 v[8];
#pragma unroll
    for (int i = 0; i < 8; ++i) { const int kk = 8 * i + (lane >> 3); v[i] = *(const f32x4*)(W + (size_t)(k0 + kk) * N + n0 + 4 * (lane & 7)); }
#pragma unroll
    for (int i = 0; i < 8; ++i) { const int kk = 8 * i + (lane >> 3); const float g = gain ? gain[k0 + kk] : 1.0f; *(f32x4*)(scr + kk * 36 + 4 * (lane & 7)) = v[i] * g; }
    asm volatile("s_waitcnt lgkmcnt(0)" ::: "memory");
    const int d0 = MAPID == 0 ? map_in_even(n0) : MAPID == 1 ? map_uq(n0) : MAPID == 2 ? map_ukv(n0) : map_id(n0);
    const int c = lane & 7;
#pragma unroll
    for (int j = 0; j < 4; ++j) { const int n = (lane >> 3) + 8 * j; const float* s = scr + (8 * c) * 36 + n;
        u32x4 o; o.x = f2bf(s[0]) | ((unsigned)f2bf(s[36]) << 16); o.y = f2bf(s[72]) | ((unsigned)f2bf(s[108]) << 16);
        o.z = f2bf(s[144]) | ((unsigned)f2bf(s[180]) << 16); o.w = f2bf(s[216]) | ((unsigned)f2bf(s[252]) << 16);
        *(u32x4*)(WT + (size_t)(d0 + n) * K + k0 + 8 * c) = o; }
    asm volatile("s_waitcnt lgkmcnt(0)" ::: "memory");
}

DI int t5_bucket(int dist) {
    if (dist < 16) return dist;
    float d = (float)dist;
    int large = 16 + (int)(logf(d / 16.0f) / 4.852030263919617f * 16.0f);
    return large < 31 ? large : 31;
}

template <int PART> DI void prep_weights(const Ctx& c, float* scr, int lane, int gw, int NGW) {
    unsigned char* ws = c.ws;
    constexpr int I0 = (2048 / 64) * (IN_EVEN / 32), I1 = (512 / 64) * (1536 / 32), I2 = (512 / 64) * (2048 / 32), I3 = (2048 / 64) * (2048 / 32),
                  I4 = (2048 / 64) * (IN_ODD / 32), I5 = I3;
    constexpr int LO = PART == 1 ? I0 : 0, HI = PART == 0 ? I0 : I0 + I1 + I2 + I3 + I4 + I5;
    for (int it = LO + gw; it < HI; it += NGW) {
        int r = it;
        if (r < I0) { transpose_item<0>(c.w_in_even, 2048, IN_EVEN, c.norm_gain, (bf16_t*)(ws + WS_WT_IN_E), scr, r, lane); continue; } r -= I0;
        if (r < I1) { transpose_item<1>(c.w_uq, 512, 1536, c.q_norm_gain, (bf16_t*)(ws + WS_WT_UQ), scr, r, lane); continue; } r -= I1;
        if (r < I2) { transpose_item<2>(c.w_ukv, 512, 2048, c.kv_norm_gain, (bf16_t*)(ws + WS_WT_UKV), scr, r, lane); continue; } r -= I2;
        if (r < I3) { transpose_item<3>(c.w_out_even, 2048, 2048, nullptr, (bf16_t*)(ws + WS_WT_OUT_E), scr, r, lane); continue; } r -= I3;
        if (r < I4) { transpose_item<3>(c.w_in_odd, 2048, IN_ODD, c.norm_gain + 2048, (bf16_t*)(ws + WS_WT_IN_O), scr, r, lane); continue; } r -= I4;
        transpose_item<3>(c.w_out_odd, 2048, 2048, nullptr, (bf16_t*)(ws + WS_WT_OUT_O), scr, r, lane);
    }
}
template <int NW, int PART> DI void prep_phase(const Ctx& c, float* scr_all, const int tid) {
    const int lane = tid & 63, wave = tid >> 6;
    float* scr = scr_all + wave * 64 * 36;
    const int gw = blockIdx.x * NW + wave, NGW = gridDim.x * NW;
    unsigned char* ws = c.ws;
    prep_weights<PART>(c, scr, lane, gw, NGW);
    const int gt = blockIdx.x * (NW * 64) + tid, NGT = gridDim.x * (NW * 64);
    { bf16_t* wt = (bf16_t*)(ws + WS_WT_IN_E);
      for (int i = gt; i < 192 * 256; i += NGT) { const int rr = i / 256, cc = i % 256; const int row = rr < 96 ? 1056 + rr : 1184 + (rr - 96);
          *(u32x4*)(wt + (size_t)row * 2048 + cc * 8) = (u32x4){0u, 0u, 0u, 0u}; } }
    { float* rc = (float*)(ws + WS_ROPE); float* rs = rc + 4096 * 32;
      for (int i = gt; i < 4096 * 32; i += NGT) { const int pos = i >> 5, j = i & 31; const float inv = 1.0f / powf(10000.0f, (float)j / 32.0f); const float ang = (float)pos * inv;
          rc[i] = cosf(ang); rs[i] = sinf(ang); } }
    { float* bn = (float*)(ws + WS_BIASN);
      for (int i = gt; i < 3 * 8 * 132; i += NGT) { const int p = i / (8 * 132), h = (i / 132) % 8, rel = i % 132; const int dil = p == 0 ? 1 : p == 1 ? 4 : 16;
          bn[i] = rel <= 128 ? c.rel_bias[t5_bucket(rel * dil) * 8 + h] * LOG2E : 0.f; } }
    { float* bc = (float*)(ws + WS_BIASC);
      for (int i = gt; i < 3 * 8 * 5 * 1024; i += NGT) { const int g = i & 15, ln = (i >> 4) & 63, di = (i >> 10) % 5, ph = i / 5120, h = ph & 7, p = ph >> 3; const int dil = p == 0 ? 1 : p == 1 ? 4 : 16;
          const int rel = 32 * di + (ln & 31) - ((g & 3) + 8 * (g >> 2) + 4 * (ln >> 5));
          bc[i] = (rel >= 0 && rel <= 128) ? c.rel_bias[t5_bucket(rel * dil) * 8 + h] * LOG2E : -INFINITY; } }
    { bf16_t* h0 = (bf16_t*)(ws + WS_H0); float* ssx = (float*)(ws + WS_SSX);
      for (int m = gw; m < M; m += NGW) { const f32x4* xr = (const f32x4*)(c.x + (size_t)m * D_MODEL) + lane; float s = 0.f;
          unsigned long long* o8 = (unsigned long long*)(h0 + (size_t)m * D_MODEL) + lane;
          for (int j = 0; j < 8; ++j) { const f32x4 v = xr[64 * j]; s += v.x * v.x + v.y * v.y + v.z * v.z + v.w * v.w;
              o8[64 * j] = (unsigned long long)(f2bf(v.x) | ((unsigned)f2bf(v.y) << 16)) | ((unsigned long long)(f2bf(v.z) | ((unsigned)f2bf(v.w) << 16)) << 32); }
          s = wave_sum(s); if (lane == 0) ssx[m] = s; } }
}

__global__ void __launch_bounds__(256) k_prep(Ctx c) { __shared__ float scr_all[4 * 64 * 36]; prep_phase<4, 2>(c, scr_all, (int)threadIdx.x); }

DI float rscale(const float* part, int n, float inv_cols) { float s = 0.f; for (int i = 0; i < n; ++i) s += part[i]; return rsqrtf(s * inv_cols + EPS); }

struct Epi1 {
    unsigned char* ws;
    DI void operator()(int row, int col, float acc) const {
        const float v = acc * rsqrtf(((const float*)(ws + WS_SSX))[row] * (1.0f / 2048.0f) + EPS);
        if (col < 512) ((bf16_t*)(ws + WS_CQ))[(size_t)row * 512 + col] = f2bf(v);
        else if (col < 1024) ((bf16_t*)(ws + WS_CKV))[(size_t)row * 512 + col - 512] = f2bf(v);
        else if (col < 1280) { const int t = col - 1024; if (t < 32) ((bf16_t*)(ws + WS_KR))[(size_t)row * 64 + t] = f2bf(v); else if (t >= 128 && t < 160) ((bf16_t*)(ws + WS_KR))[(size_t)row * 64 + 32 + t - 128] = f2bf(v); }
        else if (col < 2304) ((bf16_t*)(ws + WS_QB))[(size_t)row * 1024 + col - 1280] = f2bf(v * D128_QSCALE);
        else if (col < 3328) ((bf16_t*)(ws + WS_KB))[(size_t)row * 1024 + col - 2304] = f2bf(v);
        else if (col < 4352) ((bf16_t*)(ws + WS_VB))[(size_t)row * 1024 + col - 3328] = f2bf(v);
        else ((bf16_t*)(ws + WS_SG))[(size_t)row * 2048 + col - 4352] = f2bf(silu_f(v));
    }
};
struct Epi2a {
    unsigned char* ws;
    DI void operator()(int row, int col, float acc) const {
        const float v = acc * rscale((const float*)(ws + WS_SSC) + (size_t)row * 16, 8, 1.0f / 512.0f) * MLA_QSCALE;
        if (col < 1024) ((bf16_t*)(ws + WS_QN))[(size_t)row * 1024 + col] = f2bf(v);
        else { const int t = col - 1024, grp = t >> 8, u = t & 255, half = u >> 7, hh = (u & 127) >> 5, i = u & 31;
            ((bf16_t*)(ws + WS_QR))[(size_t)row * 512 + (4 * grp + hh) * 64 + half * 32 + i] = f2bf(v); }
    }
};
struct Epi2b {
    unsigned char* ws;
    DI void operator()(int row, int col, float acc) const {
        const float v = acc * rscale((const float*)(ws + WS_SSC) + (size_t)row * 16 + 8, 8, 1.0f / 512.0f);
        if (col < 1024) ((bf16_t*)(ws + WS_KN))[(size_t)row * 1024 + col] = f2bf(v); else ((bf16_t*)(ws + WS_VA))[(size_t)row * 1024 + col - 1024] = f2bf(v);
    }
};
struct Epi4 {
    unsigned char* ws; const float* x; float* out;
    DI void operator()(int row, int col, float acc) const {
        const float v = x[(size_t)row * 2048 + col] + acc; out[(size_t)row * 2048 + col] = v; ((bf16_t*)(ws + WS_X1BF))[(size_t)row * 2048 + col] = f2bf(v);
    }
};
struct Epi5 {
    unsigned char* ws;
    DI void operator()(int row, int col, float acc) const {
        const float v = acc * rscale((const float*)(ws + WS_SSX1) + (size_t)row * 32, 32, 1.0f / 2048.0f);
        if (col < 2048) ((bf16_t*)(ws + WS_Q2))[(size_t)row * 2048 + col] = f2bf(v * D128_QSCALE);
        else if (col < 4096) ((bf16_t*)(ws + WS_K2))[(size_t)row * 2048 + col - 2048] = f2bf(v);
        else if (col < 6144) ((bf16_t*)(ws + WS_V2))[(size_t)row * 2048 + col - 4096] = f2bf(v);
        else ((bf16_t*)(ws + WS_SG2))[(size_t)row * 2048 + col - 6144] = f2bf(silu_f(v));
    }
};
struct Epi7 {
    float* out;
    DI void operator()(int row, int col, float acc) const { out[(size_t)row * 2048 + col] += acc; }
};

namespace pg8 {
#define PG8_LAS __attribute__((address_space(3)))
typedef short bf16x8 __attribute__((ext_vector_type(8)));
constexpr int BM = 256, BK = 64, HALF = 128, HTB = HALF * BK * 2  , STAGE_BYTES = 8 * HTB, NXCD = 8, WGM = 8;

__host__ __device__ __forceinline__ int lds_byte(int r, int c) { const int st = (r >> 4) * 2 + (c >> 5), rr = r & 15, cc = c & 31, ob = rr * 64 + cc * 2; return st * 1024 + (ob ^ (((ob >> 9) & 1) << 5)); }
__host__ __device__ __forceinline__ void stage_rc(int b, int& R, int& C) { const int st = b / 1024, sb = b % 1024, swz = sb ^ (((sb >> 9) & 1) << 5); R = (st >> 1) * 16 + swz / 64; C = (st & 1) * 32 + (swz % 64) / 2; }
__host__ __device__ __forceinline__ int perm32(int rho) { const int n = rho >> 4, i = rho & 15; return 8 * (i >> 2) + 4 * n + (i & 3); }

struct Unit { int pm, pn; };
struct Gemm { const bf16_t* A; const bf16_t* Bt; int M, N, K; };

struct StaticOrder {
    int nM, nN, nwg, G, c;
    __host__ __device__ void init(int M, int N, int G_, int c_) { nM = M / BM; nN = N / BM; nwg = nM * nN; G = G_; c = c_; }
    __host__ __device__ bool next(int i, Unit& u) const {
        const long L = (long)i * G + c; if (L >= nwg) return false;
        int wgid = (int)L; { const int q = nwg / NXCD, r = nwg % NXCD, xcd = wgid % NXCD, off = wgid / NXCD; wgid = (xcd < r ? xcd * (q + 1) : r * (q + 1) + (xcd - r) * q) + off; }
        const int nig = WGM * nN, gid = wgid / nig, fm = gid * WGM, gsz = (nM - fm) < WGM ? (nM - fm) : WGM;
        u.pm = fm + ((wgid % nig) % gsz); u.pn = (wgid % nig) / gsz; return true;
    }
    __device__ __forceinline__ void a_ready(const Unit&) const {}
    __device__ __forceinline__ void done(const Unit&) const {}
};


typedef float f32x2_t __attribute__((ext_vector_type(2))); typedef __bf16 bf16x2_t __attribute__((ext_vector_type(2)));
__device__ __forceinline__ unsigned cvtpk(float lo, float hi) { f32x2_t v = {lo, hi}; bf16x2_t b = __builtin_convertvector(v, bf16x2_t); return __builtin_bit_cast(unsigned, b); }
__device__ __forceinline__ u32x4 pack8(const f32x4& a, const f32x4& b) { u32x4 w; w.x = cvtpk(a[0], a[1]); w.y = cvtpk(a[2], a[3]); w.z = cvtpk(b[0], b[1]); w.w = cvtpk(b[2], b[3]); return w; }
__device__ __forceinline__ float sumsq4(const f32x4& a) { return (a[0] * a[0] + a[1] * a[1]) + (a[2] * a[2] + a[3] * a[3]); }
__device__ __forceinline__ float silu1(float v) { return v * __builtin_amdgcn_rcpf(1.0f + __builtin_amdgcn_exp2f(-v * LOG2E)); }
__device__ __forceinline__ f32x4 silu4(const f32x4& a) { return (f32x4){silu1(a[0]), silu1(a[1]), silu1(a[2]), silu1(a[3])}; }
__device__ __forceinline__ float quad_sum(float s) { s += __shfl_xor(s, 16); s += __shfl_xor(s, 32); return s; }
__device__ __forceinline__ void rope8(const f32x4& a0, const f32x4& a1, const f32x4& b0, const f32x4& b1, const float* rc, const float* rs, int pos, int i0, u32x4& o1, u32x4& o2) {
    const f32x4 c0 = *(const f32x4*)(rc + pos * 32 + i0), c1 = *(const f32x4*)(rc + pos * 32 + i0 + 4), s0 = *(const f32x4*)(rs + pos * 32 + i0), s1 = *(const f32x4*)(rs + pos * 32 + i0 + 4);
    o1 = pack8(a0 * c0 - b0 * s0, a1 * c1 - b1 * s1); o2 = pack8(a0 * s0 + b0 * c0, a1 * s1 + b1 * c1);
}
#define PG8_EPI_ROWS(...) _Pragma("unroll") for (int ai = 0; ai < 2; ++ai) _Pragma("unroll") for (int m = 0; m < 4; ++m) { const int row = u.pm * BM + ai * HALF + wr * 64 + m * 16 + fr; __VA_ARGS__ }

struct FEpi1 {
    static constexpr bool PERM = true, AFTER_DRAIN = false; unsigned char* ws;
    __device__ __forceinline__ void operator()(const f32x4 (&acc)[2][2][4][2], const Unit& u, int wr, int wc, int fr, int fq) const {
        const int pn = u.pn, cw = wc * 32 + 8 * fq; const float* ssx = (const float*)(ws + WS_SSX);
        PG8_EPI_ROWS(
            const float rs = rsqrtf(ssx[row] * (1.0f / 2048.0f) + EPS);
            if (pn < 4) { bf16_t* dst = (bf16_t*)(ws + (pn < 2 ? WS_CQ : WS_CKV)) + (size_t)row * 512 + (pn & 1) * 256 + cw; float ss = 0.f;
                _Pragma("unroll") for (int bj = 0; bj < 2; ++bj) { const f32x4 v0 = acc[ai][bj][m][0] * rs, v1 = acc[ai][bj][m][1] * rs; ss += sumsq4(v0) + sumsq4(v1); *(u32x4*)(dst + bj * HALF) = pack8(v0, v1); }
                ss = quad_sum(ss); if (fq == 0) ((float*)(ws + WS_SSC))[(size_t)row * 16 + pn * 4 + wc] = ss; }
            else if (pn == 4) { if (wc == 0) { const float* rc = (const float*)(ws + WS_ROPE); u32x4 o1, o2;
                rope8(acc[ai][0][m][0] * rs, acc[ai][0][m][1] * rs, acc[ai][1][m][0] * rs, acc[ai][1][m][1] * rs, rc, rc + 4096 * 32, row % SEQ, 8 * fq, o1, o2);
                bf16_t* dst = (bf16_t*)(ws + WS_KR) + (size_t)row * 64 + 8 * fq; *(u32x4*)dst = o1; *(u32x4*)(dst + 32) = o2; } }
            else if (pn < 17) { const int t = pn - 5; bf16_t* dst = (bf16_t*)(ws + (t < 4 ? WS_QB : t < 8 ? WS_KB : WS_VB)) + (size_t)row * 1024 + (t & 3) * 256 + cw; const float sc = t < 4 ? rs * D128_QSCALE : rs;
                _Pragma("unroll") for (int bj = 0; bj < 2; ++bj) *(u32x4*)(dst + bj * HALF) = pack8(acc[ai][bj][m][0] * sc, acc[ai][bj][m][1] * sc); }
            else { bf16_t* dst = (bf16_t*)(ws + WS_SG) + (size_t)row * 2048 + (pn - 17) * 256 + cw;
                _Pragma("unroll") for (int bj = 0; bj < 2; ++bj) *(u32x4*)(dst + bj * HALF) = pack8(silu4(acc[ai][bj][m][0] * rs), silu4(acc[ai][bj][m][1] * rs)); }
        )
    }
};
struct FEpi2a {
    static constexpr bool PERM = true, AFTER_DRAIN = false; unsigned char* ws;
    __device__ __forceinline__ void operator()(const f32x4 (&acc)[2][2][4][2], const Unit& u, int wr, int wc, int fr, int fq) const {
        const int pn = u.pn, cw = wc * 32 + 8 * fq;
        PG8_EPI_ROWS(
            const f32x4* sp = (const f32x4*)((const float*)(ws + WS_SSC) + (size_t)row * 16); const f32x4 p0 = sp[0], p1 = sp[1];
            const float rs = rsqrtf(((p0[0] + p0[1]) + (p0[2] + p0[3]) + (p1[0] + p1[1]) + (p1[2] + p1[3])) * (1.0f / 512.0f) + EPS) * MLA_QSCALE;
            if (pn < 4) { bf16_t* dst = (bf16_t*)(ws + WS_QN) + (size_t)row * 1024 + pn * 256 + cw;
                _Pragma("unroll") for (int bj = 0; bj < 2; ++bj) *(u32x4*)(dst + bj * HALF) = pack8(acc[ai][bj][m][0] * rs, acc[ai][bj][m][1] * rs); }
            else { const float* rc = (const float*)(ws + WS_ROPE); u32x4 o1, o2; const int head = 4 * (pn - 4) + wc;
                rope8(acc[ai][0][m][0] * rs, acc[ai][0][m][1] * rs, acc[ai][1][m][0] * rs, acc[ai][1][m][1] * rs, rc, rc + 4096 * 32, row % SEQ, 8 * fq, o1, o2);
                bf16_t* dst = (bf16_t*)(ws + WS_QR) + (size_t)row * 512 + head * 64 + 8 * fq; *(u32x4*)dst = o1; *(u32x4*)(dst + 32) = o2; }
        )
    }
};
struct FEpi2b {
    static constexpr bool PERM = true, AFTER_DRAIN = false; unsigned char* ws;
    __device__ __forceinline__ void operator()(const f32x4 (&acc)[2][2][4][2], const Unit& u, int wr, int wc, int fr, int fq) const {
        const int pn = u.pn, cw = wc * 32 + 8 * fq;
        PG8_EPI_ROWS(
            const f32x4* sp = (const f32x4*)((const float*)(ws + WS_SSC) + (size_t)row * 16 + 8); const f32x4 p0 = sp[0], p1 = sp[1];
            const float rs = rsqrtf(((p0[0] + p0[1]) + (p0[2] + p0[3]) + (p1[0] + p1[1]) + (p1[2] + p1[3])) * (1.0f / 512.0f) + EPS);
            bf16_t* dst = (bf16_t*)(ws + (pn < 4 ? WS_KN : WS_VA)) + (size_t)row * 1024 + (pn & 3) * 256 + cw;
            _Pragma("unroll") for (int bj = 0; bj < 2; ++bj) *(u32x4*)(dst + bj * HALF) = pack8(acc[ai][bj][m][0] * rs, acc[ai][bj][m][1] * rs);
        )
    }
};
struct FEpi4 {
    static constexpr bool PERM = true, AFTER_DRAIN = false; unsigned char* ws; const float* x; float* out;
    __device__ __forceinline__ void operator()(const f32x4 (&acc)[2][2][4][2], const Unit& u, int wr, int wc, int fr, int fq) const {
        const int pn = u.pn, cw = pn * 256 + wc * 32 + 8 * fq;
        const size_t off0 = (size_t)(u.pm * BM + wr * 64 + fr) * 2048 + cw;
        f32x4 pre[2][4];
#define EPI4_LOAD(q, slot) { const float* p_ = x + off0 + (size_t)(((q) >> 2) * HALF + ((q) & 3) * 16) * 2048; pre[slot][0] = *(const f32x4*)p_; pre[slot][1] = *(const f32x4*)(p_ + 4); pre[slot][2] = *(const f32x4*)(p_ + HALF); pre[slot][3] = *(const f32x4*)(p_ + HALF + 4); }
        EPI4_LOAD(0, 0) EPI4_LOAD(1, 1)
#pragma unroll
        for (int q = 0; q < 8; ++q) { const int ai = q >> 2, m = q & 3; const size_t off = off0 + (size_t)(ai * HALF + m * 16) * 2048;
            const f32x4 v00 = pre[q & 1][0] + acc[ai][0][m][0], v01 = pre[q & 1][1] + acc[ai][0][m][1], v10 = pre[q & 1][2] + acc[ai][1][m][0], v11 = pre[q & 1][3] + acc[ai][1][m][1];
            if (q + 2 < 8) EPI4_LOAD(q + 2, q & 1)
            *(u32x4*)((bf16_t*)(ws + WS_X1BF) + off) = pack8(v00, v01); *(u32x4*)((bf16_t*)(ws + WS_X1BF) + off + HALF) = pack8(v10, v11);
            float ss = (sumsq4(v00) + sumsq4(v01)) + (sumsq4(v10) + sumsq4(v11));
            ss = quad_sum(ss); if (fq == 0) ((float*)(ws + WS_SSX1))[(size_t)(u.pm * BM + ai * HALF + wr * 64 + m * 16 + fr) * 32 + pn * 4 + wc] = ss; }
#undef EPI4_LOAD
    }
};
struct FEpi5 {
    static constexpr bool PERM = true, AFTER_DRAIN = false; unsigned char* ws;
    __device__ __forceinline__ void operator()(const f32x4 (&acc)[2][2][4][2], const Unit& u, int wr, int wc, int fr, int fq) const {
        const int pn = u.pn, cw = (pn & 7) * 256 + wc * 32 + 8 * fq; const int sel = pn >> 3;
        PG8_EPI_ROWS(
            const f32x4* sp = (const f32x4*)((const float*)(ws + WS_SSX1) + (size_t)row * 32 + 8 * fq); const f32x4 p0 = sp[0], p1 = sp[1];
            const float tot = quad_sum((p0[0] + p0[1]) + (p0[2] + p0[3]) + (p1[0] + p1[1]) + (p1[2] + p1[3]));
            const float rs = rsqrtf(tot * (1.0f / 2048.0f) + EPS);
            bf16_t* dst = (bf16_t*)(ws + (sel == 0 ? WS_Q2 : sel == 1 ? WS_K2 : sel == 2 ? WS_V2 : WS_SG2)) + (size_t)row * 2048 + cw;
            if (sel == 3) { _Pragma("unroll") for (int bj = 0; bj < 2; ++bj) *(u32x4*)(dst + bj * HALF) = pack8(silu4(acc[ai][bj][m][0] * rs), silu4(acc[ai][bj][m][1] * rs)); }
            else { const float sc = sel == 0 ? rs * D128_QSCALE : rs;
                _Pragma("unroll") for (int bj = 0; bj < 2; ++bj) *(u32x4*)(dst + bj * HALF) = pack8(acc[ai][bj][m][0] * sc, acc[ai][bj][m][1] * sc); }
        )
    }
};
struct FEpi7 {
    static constexpr bool PERM = true, AFTER_DRAIN = false; float* out; const bf16_t* x1;
    __device__ __forceinline__ void operator()(const f32x4 (&acc)[2][2][4][2], const Unit& u, int wr, int wc, int fr, int fq) const {
        const int cw = u.pn * 256 + wc * 32 + 8 * fq;
        const size_t off0 = (size_t)(u.pm * BM + wr * 64 + fr) * 2048 + cw;
        u32x4 pre[2][2];
#define EPI7_LOAD(q, slot) { const bf16_t* p_ = x1 + off0 + (size_t)(((q) >> 2) * HALF + ((q) & 3) * 16) * 2048; pre[slot][0] = *(const u32x4*)p_; pre[slot][1] = *(const u32x4*)(p_ + HALF); }
        EPI7_LOAD(0, 0) EPI7_LOAD(1, 1)
#pragma unroll
        for (int q = 0; q < 8; ++q) { const int ai = q >> 2, m = q & 3; const size_t off = off0 + (size_t)(ai * HALF + m * 16) * 2048;
            const u32x4 r0 = pre[q & 1][0], r1 = pre[q & 1][1];
            if (q + 2 < 8) EPI7_LOAD(q + 2, q & 1)
#define BFLO(w) __uint_as_float((w) << 16)
#define BFHI(w) __uint_as_float((w) & 0xffff0000u)
            *(f32x4*)(out + off) = (f32x4){BFLO(r0[0]), BFHI(r0[0]), BFLO(r0[1]), BFHI(r0[1])} + acc[ai][0][m][0];
            *(f32x4*)(out + off + 4) = (f32x4){BFLO(r0[2]), BFHI(r0[2]), BFLO(r0[3]), BFHI(r0[3])} + acc[ai][0][m][1];
            *(f32x4*)(out + off + HALF) = (f32x4){BFLO(r1[0]), BFHI(r1[0]), BFLO(r1[1]), BFHI(r1[1])} + acc[ai][1][m][0];
            *(f32x4*)(out + off + HALF + 4) = (f32x4){BFLO(r1[2]), BFHI(r1[2]), BFLO(r1[3]), BFHI(r1[3])} + acc[ai][1][m][1]; }
#undef BFLO
#undef BFHI
#undef EPI7_LOAD
    }
};
template <class Epi, class Sched, bool ALIGN_EPI = false, bool SP2 = false>
__device__ __forceinline__ void gemm_phase(PG8_LAS unsigned char* lds, const Gemm g, const Sched& S, const Epi& E, const int tid) {
    const int wid = __builtin_amdgcn_readfirstlane(tid >> 6), lane = tid & 63, wr = wid >> 2, wc = wid & 3, fr = lane & 15, fq = lane >> 4;
    const int K = g.K, nt = K / BK;
    unsigned voffA[2], voffB[2];
#pragma unroll
    for (int i = 0; i < 2; ++i) { int R, C; stage_rc(tid * 16 + i * 8192, R, C); const int Rb = Epi::PERM ? ((R & ~31) + perm32(R & 31)) : R;
        voffA[i] = (unsigned)(R * K + C) * 2u; voffB[i] = (unsigned)(Rb * K + C) * 2u; }
    const size_t kstep = (size_t)(BK * 2);
    const size_t hstep = (size_t)HALF * K * 2;
    const size_t tstep = 2 * hstep;
    const unsigned ldsw = (unsigned)wid * 1024u;
    const int aoff = lds_byte(wr * 64 + fr, fq * 8), boff = lds_byte(wc * 32 + fr, fq * 8);
#define PG8_SA(b, h) (((b) * 2 + (h)) * HTB)
#define PG8_SB(b, h) ((4 + (b) * 2 + (h)) * HTB)
#define PG8_STAGE(bufoff, gbase, voff) do { _Pragma("unroll") for (int _i = 0; _i < 2; ++_i) \
        __builtin_amdgcn_global_load_lds((const unsigned*)((const char*)(gbase) + (voff)[_i]), (PG8_LAS unsigned*)(lds + (bufoff) + ldsw + _i * 8192), 16, 0, 0); } while (0)
#define PG8_LDA(dst, b, h) do { _Pragma("unroll") for (int m = 0; m < 4; ++m) _Pragma("unroll") for (int k = 0; k < 2; ++k) dst[m][k] = *(const PG8_LAS bf16x8*)(lds + PG8_SA(b, h) + aoff + m * 2048 + k * 1024); } while (0)
#define PG8_LDB(dst, b, h) do { _Pragma("unroll") for (int n = 0; n < 2; ++n) _Pragma("unroll") for (int k = 0; k < 2; ++k) dst[n][k] = *(const PG8_LAS bf16x8*)(lds + PG8_SB(b, h) + boff + n * 2048 + k * 1024); } while (0)
#define PG8_MMA(ai, bj, At, Bt) do { __builtin_amdgcn_s_setprio(1); _Pragma("unroll") for (int m = 0; m < 4; ++m) _Pragma("unroll") for (int n = 0; n < 2; ++n) _Pragma("unroll") for (int k = 0; k < 2; ++k) \
        acc[ai][bj][m][n] = __builtin_amdgcn_mfma_f32_16x16x32_bf16(Bt[n][k], At[m][k], acc[ai][bj][m][n], 0, 0, 0); __builtin_amdgcn_s_setprio(0); } while (0)
#define PG8_WAIT_V(n) asm volatile("s_waitcnt vmcnt(" #n ")" ::: "memory")
#define PG8_WAIT_L(n) asm volatile("s_waitcnt lgkmcnt(" #n ")" ::: "memory")
#define PG8_BAR __builtin_amdgcn_s_barrier()
#define PG8_SCHED __builtin_amdgcn_sched_barrier(0)
    Unit cur, nxt; int ui = 0;
    if (!S.next(0, cur)) return;
    f32x4 acc[2][2][4][2];
#pragma unroll
    for (int a = 0; a < 2; ++a)
#pragma unroll
        for (int b = 0; b < 2; ++b)
#pragma unroll
            for (int m = 0; m < 4; ++m)
#pragma unroll
                for (int n = 0; n < 2; ++n) acc[a][b][m][n] = (f32x4){0.f, 0.f, 0.f, 0.f};
    bf16x8 At[4][2], B0[2][2], B1[2][2];
    const char* cA = (const char*)g.A + (size_t)cur.pm * tstep; const char* cB = (const char*)g.Bt + (size_t)cur.pn * tstep;
    S.a_ready(cur);
    if constexpr (SP2) {
        PG8_STAGE(PG8_SB(0, 0), cB, voffB); PG8_STAGE(PG8_SB(0, 1), cB + hstep, voffB); PG8_STAGE(PG8_SA(0, 0), cA, voffA); PG8_STAGE(PG8_SA(0, 1), cA + hstep, voffA);
        if (wr == 1) PG8_BAR;
        PG8_WAIT_V(2); PG8_BAR;
        PG8_STAGE(PG8_SB(1, 0), cB + kstep, voffB); PG8_STAGE(PG8_SA(1, 0), cA + kstep, voffA); PG8_STAGE(PG8_SB(1, 1), cB + hstep + kstep, voffB);
        PG8_WAIT_V(6); PG8_BAR;
    } else {
        PG8_STAGE(PG8_SB(0, 0), cB, voffB); PG8_STAGE(PG8_SA(0, 0), cA, voffA); PG8_STAGE(PG8_SB(0, 1), cB + hstep, voffB); PG8_STAGE(PG8_SA(0, 1), cA + hstep, voffA);
        if (wr == 1) PG8_BAR;
        PG8_WAIT_V(4); PG8_BAR;
        PG8_STAGE(PG8_SB(1, 0), cB + kstep, voffB); PG8_STAGE(PG8_SA(1, 0), cA + kstep, voffA); PG8_STAGE(PG8_SB(1, 1), cB + hstep + kstep, voffB);
        PG8_WAIT_V(6); PG8_BAR;
    }
    for (;;) {
        const bool has_next = S.next(ui + 1, nxt);
        const char* nA = has_next ? (const char*)g.A + (size_t)nxt.pm * tstep : cA; const char* nB = has_next ? (const char*)g.Bt + (size_t)nxt.pn * tstep : cB;
        for (int t = 0; t < nt; t += 2) {
            const bool last = (t == nt - 2);
            const char* a1 = cA + (size_t)(t + 1) * kstep;
            const char* a2 = last ? nA : cA + (size_t)(t + 2) * kstep; const char* b2 = last ? nB : cB + (size_t)(t + 2) * kstep;
            const char* a3 = a2 + kstep; const char* b3 = b2 + kstep;
            if (last && has_next) S.a_ready(nxt);
            if constexpr (SP2) {
            PG8_LDB(B0, 0, 0); PG8_LDB(B1, 0, 1); PG8_SCHED; PG8_LDA(At, 0, 0); PG8_STAGE(PG8_SA(1, 1), a1 + hstep, voffA);
            PG8_WAIT_V(8); PG8_WAIT_L(0); PG8_BAR; PG8_MMA(0, 0, At, B0); PG8_MMA(0, 1, At, B1); PG8_BAR; PG8_SCHED;
            PG8_LDA(At, 0, 1); PG8_STAGE(PG8_SB(0, 0), b2, voffB); PG8_STAGE(PG8_SB(0, 1), b2 + hstep, voffB); PG8_STAGE(PG8_SA(0, 0), a2, voffA);
            PG8_WAIT_V(8); PG8_WAIT_L(0); PG8_BAR; PG8_MMA(1, 0, At, B0); PG8_MMA(1, 1, At, B1); PG8_BAR; PG8_SCHED;
            PG8_LDB(B0, 1, 0); PG8_LDB(B1, 1, 1); PG8_SCHED; PG8_LDA(At, 1, 0); PG8_STAGE(PG8_SA(0, 1), a2 + hstep, voffA);
            PG8_WAIT_V(8); PG8_WAIT_L(0); PG8_BAR; PG8_MMA(0, 0, At, B0); PG8_MMA(0, 1, At, B1); PG8_BAR; PG8_SCHED;
            PG8_LDA(At, 1, 1); PG8_STAGE(PG8_SB(1, 0), b3, voffB); PG8_STAGE(PG8_SB(1, 1), b3 + hstep, voffB); PG8_STAGE(PG8_SA(1, 0), a3, voffA);
            PG8_WAIT_V(8); PG8_WAIT_L(0); PG8_BAR; PG8_MMA(1, 0, At, B0); PG8_MMA(1, 1, At, B1); PG8_BAR; PG8_SCHED;
            } else {
            PG8_LDB(B0, 0, 0); PG8_SCHED; PG8_LDA(At, 0, 0); PG8_STAGE(PG8_SA(1, 1), a1 + hstep, voffA);
            PG8_WAIT_L(8); PG8_BAR; PG8_WAIT_L(0); PG8_MMA(0, 0, At, B0); PG8_BAR; PG8_SCHED;
            PG8_LDB(B1, 0, 1); PG8_STAGE(PG8_SB(0, 0), b2, voffB);
            PG8_BAR; PG8_WAIT_L(0); PG8_MMA(0, 1, At, B1); PG8_BAR;
            PG8_LDA(At, 0, 1); PG8_STAGE(PG8_SA(0, 0), a2, voffA);
            PG8_BAR; PG8_WAIT_L(0); PG8_MMA(1, 0, At, B0); PG8_BAR; PG8_SCHED;
            PG8_STAGE(PG8_SB(0, 1), b2 + hstep, voffB);
            PG8_WAIT_V(6); PG8_BAR; PG8_MMA(1, 1, At, B1); PG8_BAR;
            PG8_LDB(B0, 1, 0); PG8_SCHED; PG8_LDA(At, 1, 0); PG8_STAGE(PG8_SA(0, 1), a2 + hstep, voffA);
            PG8_WAIT_L(8); PG8_BAR; PG8_WAIT_L(0); PG8_MMA(0, 0, At, B0); PG8_BAR; PG8_SCHED;
            PG8_LDB(B1, 1, 1); PG8_STAGE(PG8_SB(1, 0), b3, voffB);
            PG8_BAR; PG8_WAIT_L(0); PG8_MMA(0, 1, At, B1); PG8_BAR;
            PG8_LDA(At, 1, 1); PG8_STAGE(PG8_SA(1, 0), a3, voffA);
            PG8_BAR; PG8_WAIT_L(0); PG8_MMA(1, 0, At, B0); PG8_BAR; PG8_SCHED;
            PG8_STAGE(PG8_SB(1, 1), b3 + hstep, voffB);
            PG8_WAIT_V(6); PG8_BAR; PG8_MMA(1, 1, At, B1); PG8_BAR;
            }
        }
        if constexpr (ALIGN_EPI) { if (wr == 0) PG8_BAR; }
        if constexpr (!Epi::AFTER_DRAIN) { E(acc, cur, wr, wc, fr, fq); S.done(cur); }
        if (!has_next) break;
#pragma unroll
        for (int a = 0; a < 2; ++a)
#pragma unroll
            for (int b = 0; b < 2; ++b)
#pragma unroll
                for (int m = 0; m < 4; ++m)
#pragma unroll
                    for (int n = 0; n < 2; ++n) acc[a][b][m][n] = (f32x4){0.f, 0.f, 0.f, 0.f};
        cur = nxt; cA = nA; cB = nB; ++ui;
        if constexpr (ALIGN_EPI) { if (wr == 1) PG8_BAR; }
    }
    PG8_WAIT_V(0);
    if constexpr (!ALIGN_EPI) { if (wr == 0) PG8_BAR; }
    PG8_BAR;
    if constexpr (Epi::AFTER_DRAIN) { E.fused(acc, cur, wr, wc, fr, fq, lds, wid, lane); S.done(cur); }
#undef PG8_SA
#undef PG8_SB
#undef PG8_STAGE
#undef PG8_LDA
#undef PG8_LDB
#undef PG8_MMA
#undef PG8_WAIT_V
#undef PG8_WAIT_L
#undef PG8_BAR
#undef PG8_SCHED
}
}

#define LAS __attribute__((address_space(3)))
template <class Epi> __global__ void __launch_bounds__(512, 2) k_gemm_fast(pg8::Gemm g, Epi E) {
    extern __shared__ __attribute__((aligned(16))) unsigned char lds[];
    pg8::StaticOrder S; S.init(g.M, g.N, (int)gridDim.x, (int)blockIdx.x);
    pg8::gemm_phase<Epi, pg8::StaticOrder, true, true>((LAS unsigned char*)lds, g, S, E, (int)threadIdx.x);
}

template <class Epi>
__global__ void __launch_bounds__(256) k_gemm_naive(const bf16_t* A, const bf16_t* Bt, int N, int K, Epi epi) {
    __shared__ float As[64][33], Bs[64][33];
    const int tid = threadIdx.x, tx = tid & 15, ty = tid >> 4;
    const int nbn = N / 64; const int bm = blockIdx.x / nbn, bn = blockIdx.x % nbn;
    float acc[4][4] = {};
    const int lr = tid >> 2, lc = (tid & 3) * 8;
    for (int k0 = 0; k0 < K; k0 += 32) {
        const u32x4 av = *(const u32x4*)(A + (size_t)(bm * 64 + lr) * K + k0 + lc);
        const u32x4 bv = *(const u32x4*)(Bt + (size_t)(bn * 64 + lr) * K + k0 + lc);
        __syncthreads();
#pragma unroll
        for (int j = 0; j < 4; ++j) { As[lr][lc + 2 * j] = __uint_as_float(av[j] << 16); As[lr][lc + 2 * j + 1] = __uint_as_float(av[j] & 0xffff0000u);
                                      Bs[lr][lc + 2 * j] = __uint_as_float(bv[j] << 16); Bs[lr][lc + 2 * j + 1] = __uint_as_float(bv[j] & 0xffff0000u); }
        __syncthreads();
#pragma unroll 8
        for (int kk = 0; kk < 32; ++kk) { float a[4], b[4];
#pragma unroll
            for (int i = 0; i < 4; ++i) { a[i] = As[ty * 4 + i][kk]; b[i] = Bs[tx * 4 + i][kk]; }
#pragma unroll
            for (int i = 0; i < 4; ++i)
#pragma unroll
                for (int j = 0; j < 4; ++j) acc[i][j] += a[i] * b[j]; }
    }
#pragma unroll
    for (int i = 0; i < 4; ++i)
#pragma unroll
        for (int j = 0; j < 4; ++j) epi(bm * 64 + ty * 4 + i, bn * 64 + tx * 4 + j, acc[i][j]);
}

template <bool F32>
__global__ void __launch_bounds__(256) k_rowss(const void* src, int ld, int ncols, float* dst, int dst_ld, int nslots) {
    const int lane = threadIdx.x & 63, row = blockIdx.x * 4 + (threadIdx.x >> 6);
    float s = 0.f;
    for (int c = lane; c < ncols; c += 64) { const float v = F32 ? ((const float*)src)[(size_t)row * ld + c] : bf2f(((const bf16_t*)src)[(size_t)row * ld + c]); s += v * v; }
    s = wave_sum(s);
    if (lane < nslots) dst[(size_t)row * dst_ld + lane] = lane == 0 ? s : 0.f;
}

__global__ void __launch_bounds__(256) k_rope(bf16_t* buf, int nh, const float* rc, const float* rs) {
    const int idx = blockIdx.x * 256 + threadIdx.x; const int per_row = nh * 32; if (idx >= M * per_row) return;
    const int row = idx / per_row, t = idx % per_row, h = t >> 5, i = t & 31, pos = row % SEQ;
    bf16_t* p = buf + (size_t)row * nh * 64 + h * 64; const float x1 = bf2f(p[i]), x2 = bf2f(p[32 + i]); const float cs = rc[pos * 32 + i], sn = rs[pos * 32 + i];
    p[i] = f2bf(x1 * cs - x2 * sn); p[32 + i] = f2bf(x1 * sn + x2 * cs);
}

template <int D> DI float dot_row(const float* q, const bf16_t* k) {
    float s = 0.f;
#pragma unroll
    for (int d = 0; d < D; d += 8) { const u32x4 v = *(const u32x4*)(k + d);
#pragma unroll
        for (int j = 0; j < 4; ++j) { s += q[d + 2 * j] * __uint_as_float(v[j] << 16); s += q[d + 2 * j + 1] * __uint_as_float(v[j] & 0xffff0000u); } }
    return s;
}

__global__ void __launch_bounds__(256) k_mla_naive(Ctx c) {
    __shared__ float qs[4][192];
    const int lane = threadIdx.x & 63, w = threadIdx.x >> 6; const int gq = blockIdx.x * 4 + w;
    const int t = gq % SEQ, bh = gq / SEQ, h = bh % 8, b = bh / 8; const size_t row = (size_t)b * SEQ + t;
    unsigned char* ws = c.ws;
    const bf16_t *QN = (const bf16_t*)(ws + WS_QN), *QR = (const bf16_t*)(ws + WS_QR), *KN = (const bf16_t*)(ws + WS_KN), *KR = (const bf16_t*)(ws + WS_KR), *VA = (const bf16_t*)(ws + WS_VA), *SG = (const bf16_t*)(ws + WS_SG);
    for (int d = lane; d < 192; d += 64) qs[w][d] = d < 128 ? bf2f(QN[row * 1024 + h * 128 + d]) : bf2f(QR[row * 512 + h * 64 + d - 128]);
    __syncthreads();
    float m = -INFINITY, l = 0.f, o0 = 0.f, o1 = 0.f;
    for (int j0 = 0; j0 <= t; j0 += 64) {
        const int j = j0 + lane; const bool valid = j <= t; const size_t krow = (size_t)b * SEQ + (valid ? j : t);
        float s = dot_row<128>(qs[w], KN + krow * 1024 + h * 128) + dot_row<64>(qs[w] + 128, KR + krow * 64);
        if (!valid) s = -INFINITY;
        const float mn = fmaxf(m, wave_max(s)); const float alpha = exp2f(m - mn); const float p = valid ? exp2f(s - mn) : 0.f;
        l = l * alpha + wave_sum(p); o0 *= alpha; o1 *= alpha; m = mn;
        const int nj = min(64, t - j0 + 1);
        for (int jj = 0; jj < nj; ++jj) { const float pj = __shfl(p, jj); const bf16_t* vr = VA + ((size_t)b * SEQ + j0 + jj) * 1024 + h * 128; o0 += pj * bf2f(vr[lane]); o1 += pj * bf2f(vr[lane + 64]); }
    }
    bf16_t* MIX = (bf16_t*)(ws + WS_MIX); const float il = 1.0f / l;
    MIX[row * 2048 + h * 128 + lane] = f2bf(o0 * il * bf2f(SG[row * 2048 + h * 128 + lane]));
    MIX[row * 2048 + h * 128 + lane + 64] = f2bf(o1 * il * bf2f(SG[row * 2048 + h * 128 + lane + 64]));
}

__global__ void __launch_bounds__(256) k_dil_naive(Ctx c) {
    __shared__ float qs[4][128];
    const int lane = threadIdx.x & 63, w = threadIdx.x >> 6; const int gq = blockIdx.x * 4 + w;
    const int t = gq % SEQ, bh = gq / SEQ, h = bh % 8, b = bh / 8; const size_t row = (size_t)b * SEQ + t;
    unsigned char* ws = c.ws;
    const bf16_t *QB = (const bf16_t*)(ws + WS_QB), *KB = (const bf16_t*)(ws + WS_KB), *VB = (const bf16_t*)(ws + WS_VB);
    const float* bn = (const float*)(ws + WS_BIASN);
    for (int d = lane; d < 128; d += 64) qs[w][d] = bf2f(QB[row * 1024 + h * 128 + d]);
    __syncthreads();
    for (int p = 0; p < 3; ++p) { const int dil = p == 0 ? 1 : p == 1 ? 4 : 16;
        float m = -INFINITY, l = 0.f, o0 = 0.f, o1 = 0.f;
        for (int r0 = 0; r0 < 192; r0 += 64) {
            const int rel = r0 + lane; const int j = t - rel * dil; const bool valid = rel <= 128 && j >= 0; const size_t krow = (size_t)b * SEQ + (valid ? j : t);
            float s = dot_row<128>(qs[w], KB + krow * 1024 + h * 128) + bn[(p * 8 + h) * 132 + (valid ? rel : 0)];
            if (!valid) s = -INFINITY;
            const float mn = fmaxf(m, wave_max(s));
            const float alpha = exp2f(m - mn); const float pp = valid ? exp2f(s - mn) : 0.f;
            l = l * alpha + wave_sum(pp); o0 *= alpha; o1 *= alpha; m = mn;
            for (int jj = 0; jj < 64; ++jj) { const float pj = __shfl(pp, jj); if (pj != 0.f) { const int jr = t - (r0 + jj) * dil; const bf16_t* vr = VB + ((size_t)b * SEQ + jr) * 1024 + h * 128; o0 += pj * bf2f(vr[lane]); o1 += pj * bf2f(vr[lane + 64]); } }
        }
        bf16_t* OP = (bf16_t*)(ws + (p == 0 ? WS_OP0 : p == 1 ? WS_OP1 : WS_OP2)); const float il = 1.0f / l;
        OP[row * 1024 + h * 128 + lane] = f2bf(o0 * il); OP[row * 1024 + h * 128 + lane + 64] = f2bf(o1 * il);
        if (lane == 0) ((float*)(ws + WS_LSE))[((size_t)p * M + row) * 8 + h] = m + log2f(l);
    }
}

DI void dil_merge_item(unsigned char* ws, int row, int col) {
    const int h = col >> 7; const float* lse = (const float*)(ws + WS_LSE);
    const float l0 = lse[((size_t)0 * M + row) * 8 + h], l1 = lse[((size_t)1 * M + row) * 8 + h], l2 = lse[((size_t)2 * M + row) * 8 + h];
    const float mx = fmaxf(l0, fmaxf(l1, l2)); float w0 = exp2f(l0 - mx), w1 = exp2f(l1 - mx), w2 = exp2f(l2 - mx); const float inv = 1.0f / (w0 + w1 + w2); w0 *= inv; w1 *= inv; w2 *= inv;
    const u32x4 a0 = *(const u32x4*)((const bf16_t*)(ws + WS_OP0) + (size_t)row * 1024 + col), a1 = *(const u32x4*)((const bf16_t*)(ws + WS_OP1) + (size_t)row * 1024 + col),
                a2 = *(const u32x4*)((const bf16_t*)(ws + WS_OP2) + (size_t)row * 1024 + col), sg = *(const u32x4*)((const bf16_t*)(ws + WS_SG) + (size_t)row * 2048 + 1024 + col);
    u32x4 o;
#pragma unroll
    for (int j = 0; j < 4; ++j) {
        const float lo = (w0 * __uint_as_float(a0[j] << 16) + w1 * __uint_as_float(a1[j] << 16) + w2 * __uint_as_float(a2[j] << 16)) * __uint_as_float(sg[j] << 16);
        const float hi = (w0 * __uint_as_float(a0[j] & 0xffff0000u) + w1 * __uint_as_float(a1[j] & 0xffff0000u) + w2 * __uint_as_float(a2[j] & 0xffff0000u)) * __uint_as_float(sg[j] & 0xffff0000u);
        o[j] = (unsigned)f2bf(lo) | ((unsigned)f2bf(hi) << 16); }
    *(u32x4*)((bf16_t*)(ws + WS_MIX) + (size_t)row * 2048 + 1024 + col) = o;
}
__global__ void __launch_bounds__(128) k_dil_merge(Ctx c) { dil_merge_item(c.ws, blockIdx.x, threadIdx.x * 8); }

__global__ void __launch_bounds__(256) k_sb_naive(Ctx c) {
    __shared__ float qs[4][128];
    const int lane = threadIdx.x & 63, w = threadIdx.x >> 6; const int gq = blockIdx.x * 4 + w;
    const int t = gq % SEQ, bh = gq / SEQ, h = bh % 16, b = bh / 16; const size_t row = (size_t)b * SEQ + t;
    unsigned char* ws = c.ws;
    const bf16_t *Q2 = (const bf16_t*)(ws + WS_Q2), *K2 = (const bf16_t*)(ws + WS_K2), *V2 = (const bf16_t*)(ws + WS_V2), *SG2 = (const bf16_t*)(ws + WS_SG2);
    for (int d = lane; d < 128; d += 64) qs[w][d] = bf2f(Q2[row * 2048 + h * 128 + d]);
    __syncthreads();
    float carry = 0.f, o0 = 0.f, o1 = 0.f;
    for (int c0 = 0; c0 < t; c0 += 64) {
        const int j = t - 1 - c0 - lane; const bool valid = j >= 0; const size_t krow = (size_t)b * SEQ + (valid ? j : 0);
        const float z = dot_row<128>(qs[w], K2 + krow * 2048 + h * 128);
        const float sp = fmaxf(z, 0.f) + log2f(1.0f + exp2f(-fabsf(z)));
        const float L = valid ? -sp : 0.f;
        float incl = L;
#pragma unroll
        for (int o = 1; o < 64; o <<= 1) { const float v = __shfl_up(incl, o); if (lane >= o) incl += v; }
        const float between = carry + (incl - L);
        const float a = valid ? exp2f(z - sp + between) : 0.f;
        carry += __shfl(incl, 63);
        const int nj = min(64, t - c0);
        for (int jj = 0; jj < nj; ++jj) { const float aj = __shfl(a, jj); const bf16_t* vr = V2 + ((size_t)b * SEQ + t - 1 - c0 - jj) * 2048 + h * 128; o0 += aj * bf2f(vr[lane]); o1 += aj * bf2f(vr[lane + 64]); }
    }
    bf16_t* MIX2 = (bf16_t*)(ws + WS_MIX2);
    MIX2[row * 2048 + h * 128 + lane] = f2bf(o0 * bf2f(SG2[row * 2048 + h * 128 + lane]));
    MIX2[row * 2048 + h * 128 + lane + 64] = f2bf(o1 * bf2f(SG2[row * 2048 + h * 128 + lane + 64]));
}

#ifndef MLA_PIPE
#define MLA_PIPE 1
#endif
namespace att {
typedef short bf16x8 __attribute__((ext_vector_type(8)));
typedef short s16x4 __attribute__((ext_vector_type(4)));
typedef short v4i16_t __attribute__((ext_vector_type(4)));
typedef float f32x16 __attribute__((ext_vector_type(16)));
typedef _Float16 f16x8 __attribute__((ext_vector_type(8)));
typedef _Float16 f16x2 __attribute__((ext_vector_type(2)));
typedef float f32x2_t __attribute__((ext_vector_type(2))); typedef __bf16 bf16x2_t __attribute__((ext_vector_type(2)));
typedef LAS const unsigned char* lcp;
#define MFMA_BF16(a, b, c) __builtin_amdgcn_mfma_f32_32x32x16_bf16((a), (b), (c), 0, 0, 0)
#define MFMA_F16(a, b, c) __builtin_amdgcn_mfma_f32_32x32x16_f16((a), (b), (c), 0, 0, 0)
#define SBAR() __builtin_amdgcn_sched_barrier(0)
DI int crow(int g, int h) { return (g & 3) + 8 * (g >> 2) + 4 * h; }
DI unsigned off_b(unsigned row, unsigned ch) { return 256u * row + 16u * (ch ^ (((row & 3) << 2) | ((row >> 2) & 3))); }
DI unsigned cvtpk(float lo, float hi) { f32x2_t v = {lo, hi}; bf16x2_t b = __builtin_convertvector(v, bf16x2_t); return __builtin_bit_cast(unsigned, b); }
DI unsigned cvtpk_h(float lo, float hi) { f32x2_t v = {lo, hi}; f16x2 b = __builtin_convertvector(v, f16x2); return __builtin_bit_cast(unsigned, b); }
DI bf16x8 pack_bf(const f32x16& x, int s) { u32x4 p; p.x = cvtpk(x[8 * s], x[8 * s + 1]); p.y = cvtpk(x[8 * s + 2], x[8 * s + 3]); p.z = cvtpk(x[8 * s + 4], x[8 * s + 5]); p.w = cvtpk(x[8 * s + 6], x[8 * s + 7]); return __builtin_bit_cast(bf16x8, p); }
DI f16x8 pack_h(const f32x16& x, int s) { u32x4 p; p.x = cvtpk_h(x[8 * s], x[8 * s + 1]); p.y = cvtpk_h(x[8 * s + 2], x[8 * s + 3]); p.z = cvtpk_h(x[8 * s + 4], x[8 * s + 5]); p.w = cvtpk_h(x[8 * s + 6], x[8 * s + 7]); return __builtin_bit_cast(f16x8, p); }
DI s16x4 vtr(lcp p) { return __builtin_bit_cast(s16x4, __builtin_amdgcn_ds_read_tr16_b64_v4i16((LAS v4i16_t*)p)); }
DI float swap_max(float m) { auto rr = __builtin_amdgcn_permlane32_swap(__float_as_uint(m), __float_as_uint(m), false, false); return fmaxf(__uint_as_float(rr[0]), __uint_as_float(rr[1])); }
DI float swap_sum(float m) { auto rr = __builtin_amdgcn_permlane32_swap(__float_as_uint(m), __float_as_uint(m), false, false); return __uint_as_float(rr[0]) + __uint_as_float(rr[1]); }
DI float bcast_lo(float m) { auto rr = __builtin_amdgcn_permlane32_swap(__float_as_uint(m), __float_as_uint(m), false, false); return __uint_as_float(rr[0]); }
DI __amdgpu_buffer_rsrc_t mk_rsrc(const void* p, unsigned bytes) { return __builtin_amdgcn_make_buffer_rsrc((void*)p, 0, bytes, 0x00020000); }
DI u32x4 bload(__amdgpu_buffer_rsrc_t rs, unsigned voff, unsigned soff) { return __builtin_amdgcn_raw_buffer_load_b128(rs, voff, soff, 0); }
struct VAddr { unsigned a[2][4]; };
DI VAddr make_vaddr(int lane) { VAddr v; const unsigned hh = lane >> 5, blk = (lane >> 4) & 1, qq = (lane & 15) >> 2, p = lane & 3;
#pragma unroll
    for (int t = 0; t < 2; ++t)
#pragma unroll
        for (int d0 = 0; d0 < 4; ++d0) v.a[t][d0] = off_b(8 * t + 4 * hh + qq, 4 * d0 + 2 * blk + (p >> 1)) + 8 * (p & 1);
    return v; }
DI bf16x8 vfrag(lcp img, int s, int d0, const VAddr& va) {
    const s16x4 lo = vtr(img + 4096 * s + va.a[0][d0]);
    const s16x4 hi = vtr(img + 4096 * s + va.a[1][d0]);
    return (bf16x8){lo[0], lo[1], lo[2], lo[3], hi[0], hi[1], hi[2], hi[3]};
}
DI void softmax_tile(f32x16& s0, f32x16& s1, f32x16 (&o)[4], float& mrun, float& lrun) {
    float mt = fmaxf(s0[0], s1[0]);
#pragma unroll
    for (int g = 1; g < 16; ++g) mt = fmaxf(mt, fmaxf(s0[g], s1[g]));
    mt = swap_max(mt);
    const float mn = fmaxf(mrun, mt), alpha = __builtin_amdgcn_exp2f(mrun - mn); mrun = mn;
    float ps = 0.f;
#pragma unroll
    for (int g = 0; g < 16; ++g) { s0[g] = __builtin_amdgcn_exp2f(s0[g] - mn); s1[g] = __builtin_amdgcn_exp2f(s1[g] - mn); ps += s0[g] + s1[g]; }
    lrun = lrun * alpha + ps;
#pragma unroll
    for (int d0 = 0; d0 < 4; ++d0)
#pragma unroll
        for (int g = 0; g < 16; ++g) o[d0][g] *= alpha;
}

constexpr int MLA_KSTR = 400, MLA_KBUF = 64 * MLA_KSTR, VBUF = 16384, MLA_LDS_V = 2 * MLA_KBUF, MLA_LDS_BYTES = 2 * MLA_KBUF + 2 * VBUF;
template <bool MASKED>
DI void mla_tile(lcp kb, lcp vb, const bf16x8 (&qf)[12], f32x16 (&o)[4], float& mrun, float& lrun, const VAddr& va, int qrel, int hh) {
    f32x16 s0, s1;
#pragma unroll
    for (int g = 0; g < 16; ++g) { s0[g] = 0.f; s1[g] = 0.f; }
    bf16x8 f0a = *(LAS const bf16x8*)kb, f0b = *(LAS const bf16x8*)(kb + 32 * MLA_KSTR), f1a = *(LAS const bf16x8*)(kb + 32), f1b = *(LAS const bf16x8*)(kb + 32 * MLA_KSTR + 32), f2a, f2b;
#pragma unroll
    for (int d0 = 0; d0 < 12; ++d0) {
        if (d0 + 2 < 12) { const bf16x8 n0 = *(LAS const bf16x8*)(kb + (d0 + 2) * 32), n1 = *(LAS const bf16x8*)(kb + 32 * MLA_KSTR + (d0 + 2) * 32);
            if ((d0 + 2) % 3 == 0) { f0a = n0; f0b = n1; } else if ((d0 + 2) % 3 == 1) { f1a = n0; f1b = n1; } else { f2a = n0; f2b = n1; } }
        SBAR();
        s0 = MFMA_BF16(d0 % 3 == 0 ? f0a : d0 % 3 == 1 ? f1a : f2a, qf[d0], s0); s1 = MFMA_BF16(d0 % 3 == 0 ? f0b : d0 % 3 == 1 ? f1b : f2b, qf[d0], s1);
        SBAR();
    }
    if (MASKED) {
#pragma unroll
        for (int g = 0; g < 16; ++g) { const int kv = crow(g, 0); if (kv > qrel - 4 * hh) s0[g] = -INFINITY; if (kv + 32 > qrel - 4 * hh) s1[g] = -INFINITY; } }
    float mt = fmaxf(s0[0], s1[0]);
#pragma unroll
    for (int g = 1; g < 16; ++g) mt = fmaxf(mt, fmaxf(s0[g], s1[g]));
    mt = swap_max(mt);
    if (__builtin_amdgcn_ballot_w64(mt > mrun) != 0ull) {
        const float mn = fmaxf(mrun, mt), alpha = __builtin_amdgcn_exp2f(mrun - mn); mrun = mn; lrun *= alpha;
#pragma unroll
        for (int d0 = 0; d0 < 4; ++d0)
#pragma unroll
            for (int g = 0; g < 16; ++g) o[d0][g] *= alpha;
    }
    float ps = 0.f;
#pragma unroll
    for (int g = 0; g < 16; ++g) { s0[g] = __builtin_amdgcn_exp2f(s0[g] - mrun); s1[g] = __builtin_amdgcn_exp2f(s1[g] - mrun); ps += s0[g] + s1[g]; }
    lrun += ps;
    bf16x8 pf[4]; pf[0] = pack_bf(s0, 0); pf[1] = pack_bf(s0, 1); pf[2] = pack_bf(s1, 0); pf[3] = pack_bf(s1, 1);
    bf16x8 v0 = vfrag(vb, 0, 0, va), v1 = vfrag(vb, 0, 1, va), v2;
#pragma unroll
    for (int j = 0; j < 16; ++j) {
        if (j + 2 < 16) { const int ks = (j + 2) >> 2, d0 = (j + 2) & 3; const bf16x8 nx = vfrag(vb + (ks >> 1) * 8192, ks & 1, d0, va);
            if ((j + 2) % 3 == 0) v0 = nx; else if ((j + 2) % 3 == 1) v1 = nx; else v2 = nx; }
        SBAR();
        o[j & 3] = MFMA_BF16(j % 3 == 0 ? v0 : j % 3 == 1 ? v1 : v2, pf[j >> 2], o[j & 3]);
        SBAR();
    }
}
DI void mla_unit(LAS unsigned char* lds, unsigned char* ws, int b, int h, int qb, const int tid_in) {
    int tid = tid_in; asm volatile("" : "+v"(tid));
    const int lane = tid & 63, wid = __builtin_amdgcn_readfirstlane(tid >> 6), r = lane & 31, hh = lane >> 5;
    const bf16_t *QN = (const bf16_t*)(ws + WS_QN), *QR = (const bf16_t*)(ws + WS_QR), *KN = (const bf16_t*)(ws + WS_KN), *KR = (const bf16_t*)(ws + WS_KR), *VA = (const bf16_t*)(ws + WS_VA), *SG = (const bf16_t*)(ws + WS_SG);
    bf16_t* MIX = (bf16_t*)(ws + WS_MIX);
    const int q0 = qb * 256, NT = 4 * (qb + 1), tmax = (q0 + 32 * wid) >> 6; const size_t rowbase = (size_t)b * SEQ;
    bf16x8 qf[12];
    { const size_t qrow = rowbase + q0 + 32 * wid + r;
#pragma unroll
      for (int d0 = 0; d0 < 8; ++d0) qf[d0] = *(const bf16x8*)(QN + qrow * 1024 + h * 128 + d0 * 16 + hh * 8);
#pragma unroll
      for (int d0 = 0; d0 < 4; ++d0) qf[8 + d0] = *(const bf16x8*)(QR + qrow * 512 + h * 64 + d0 * 16 + hh * 8); }
    f32x16 o[4];
#pragma unroll
    for (int d0 = 0; d0 < 4; ++d0)
#pragma unroll
        for (int g = 0; g < 16; ++g) o[d0][g] = 0.f;
    float mrun = -INFINITY, lrun = 0.f;
    u32x4 kreg[3], vreg[2];
    const VAddr va = make_vaddr(lane);
    const __amdgpu_buffer_rsrc_t rKN = mk_rsrc(KN, M * 1024 * 2), rKR = mk_rsrc(KR, M * 64 * 2), rVA = mk_rsrc(VA, M * 1024 * 2);
    const unsigned vo0 = (tid >> 4) * 2048 + (tid & 15) * 16, vo1 = vo0 + 32 * 2048, vor = (tid >> 3) * 128 + (tid & 7) * 16;
    const unsigned so_n = ((unsigned)rowbase * 1024 + h * 128) * 2, so_r = (unsigned)rowbase * 64 * 2;
    const unsigned lk0 = (tid >> 4) * MLA_KSTR + (tid & 15) * 16, lk1 = lk0 + 32 * MLA_KSTR, lkr = (tid >> 3) * MLA_KSTR + 256 + (tid & 7) * 16;
    const unsigned lv0 = off_b((tid >> 4) & 31, tid & 15), lv1 = lv0 + 8192;
    const unsigned kfo = r * MLA_KSTR + hh * 16;
#define MLA_LOAD(t) do { const unsigned tn = so_n + (unsigned)(t) * (64 * 2048), tr_ = so_r + (unsigned)(t) * (64 * 128); \
        kreg[0] = bload(rKN, vo0, tn); kreg[1] = bload(rKN, vo1, tn); kreg[2] = bload(rKR, vor, tr_); vreg[0] = bload(rVA, vo0, tn); vreg[1] = bload(rVA, vo1, tn); } while (0)
#define MLA_STORE(buf) do { LAS unsigned char* kd = lds + (buf) * MLA_KBUF; LAS unsigned char* vd = lds + MLA_LDS_V + (buf) * VBUF; \
        *(LAS u32x4*)(kd + lk0) = kreg[0]; *(LAS u32x4*)(kd + lk1) = kreg[1]; *(LAS u32x4*)(kd + lkr) = kreg[2]; *(LAS u32x4*)(vd + lv0) = vreg[0]; *(LAS u32x4*)(vd + lv1) = vreg[1]; } while (0)
    MLA_LOAD(0); MLA_STORE(0); __builtin_amdgcn_s_waitcnt(0x0F70);   __syncthreads();
#define MLA_INTERVAL(MODE) { const int buf = t & 1; \
        if (t + 1 < NT) MLA_LOAD(t + 1); \
        if (MODE == 0) mla_tile<false>(lds + buf * MLA_KBUF + kfo, lds + MLA_LDS_V + buf * VBUF, qf, o, mrun, lrun, va, 0, hh); \
        if (MODE == 1) mla_tile<true>(lds + buf * MLA_KBUF + kfo, lds + MLA_LDS_V + buf * VBUF, qf, o, mrun, lrun, va, q0 + 32 * wid + r - 64 * t, hh); \
        if (t + 1 < NT) MLA_STORE(buf ^ 1); \
        __syncthreads(); }
    int t = 0;
    for (; t < tmax; ++t) MLA_INTERVAL(0)
    MLA_INTERVAL(1)
    for (++t; t < NT; ++t) MLA_INTERVAL(2)
#undef MLA_INTERVAL
#undef MLA_LOAD
#undef MLA_STORE
    const float inv = 1.0f / swap_sum(lrun);
    int t4 = tid; asm volatile("" : "+v"(t4)); const size_t qrow = rowbase + q0 + 32 * wid + (t4 & 31); const int hh2 = (t4 >> 5) & 1;
#pragma unroll
    for (int d0 = 0; d0 < 4; ++d0)
#pragma unroll
        for (int gg = 0; gg < 4; ++gg) { const size_t off = qrow * 2048 + h * 128 + 32 * d0 + 8 * gg + 4 * hh2;
            const unsigned long long sg = *(const unsigned long long*)(SG + off);
            const float g0 = __uint_as_float((unsigned)(sg << 16)), g1 = __uint_as_float((unsigned)sg & 0xffff0000u), g2 = __uint_as_float((unsigned)(sg >> 32) << 16), g3 = __uint_as_float((unsigned)(sg >> 32) & 0xffff0000u);
            const unsigned lo = cvtpk(o[d0][4 * gg] * inv * g0, o[d0][4 * gg + 1] * inv * g1), hi = cvtpk(o[d0][4 * gg + 2] * inv * g2, o[d0][4 * gg + 3] * inv * g3);
            *(unsigned long long*)(MIX + off) = (unsigned long long)lo | ((unsigned long long)hi << 32); }
}
DI float vmax3_s(float a, float b, float c) { float r; asm("v_max3_f32 %0, %1, %2, %3" : "=v"(r) : "v"(a), "v"(b), "v"(c)); return r; }
constexpr int M2_KBUF = 64 * 384, M2_LDS_V = 3 * M2_KBUF, M2_LDS_BYTES = M2_LDS_V + 3 * VBUF;
struct M2State { f32x16 o[4]; float mrun, lrun; };
template <int KIMM, int VIMM>
DI void mla2_iter(f32x16& zin, f32x16& zout, M2State& st, const u32x4& pi0, const u32x4& pi1, u32x4& po0, u32x4& po1, const bf16x8 (&qf)[12], const unsigned (&koff)[4], const unsigned (&voff)[2][4],
                  const bool masked, const int qrh) {
#define M2_KF(d0) (*(LAS const bf16x8*)(koff[(d0) & 3] + (unsigned)(KIMM + 128 * ((d0) >> 2))))
#define M2_VF(t, j) vtr((lcp)(voff[t][(j) & 3] + (unsigned)(VIMM + 4096 * ((j) >> 2))))
    if (masked) {
        asm volatile("" ::: "memory");
#pragma unroll
        for (int g = 0; g < 16; ++g) if (crow(g, 0) > qrh) zin[g] = -INFINITY;
    }
    bf16x8 kfA = M2_KF(0), kfB; s16x4 la, ha, lb, hb;
    float mt = 0.f, mnew = 0.f, alpha = 1.f, ps = 0.f; bool grow = false; float pe[16];
    SBAR();
#pragma unroll
    for (int i = 0; i < 20; ++i) {
        const int c5 = i % 5, blk5 = i / 5; const bool isP = (c5 == 2 || c5 == 4);
        const int qi = blk5 * 3 + (c5 < 2 ? c5 : 2), pj = blk5 * 2 + (c5 == 2 ? 0 : 1);
        if (isP) { const s16x4 lo = (pj & 1) ? lb : la, hi = (pj & 1) ? hb : ha; const bf16x8 vf = (bf16x8){lo[0], lo[1], lo[2], lo[3], hi[0], hi[1], hi[2], hi[3]};
            st.o[pj & 3] = MFMA_BF16(vf, __builtin_bit_cast(bf16x8, (pj >> 2) ? pi1 : pi0), st.o[pj & 3]); }
        else if (i == 0) { f32x16 zero_;
#pragma unroll
            for (int g = 0; g < 16; ++g) zero_[g] = 0.f;
            zout = MFMA_BF16(kfA, qf[0], zero_); }
        else zout = MFMA_BF16((qi & 1) ? kfB : kfA, qf[qi], zout);
        if (!isP && qi + 1 < 12) { const bf16x8 nx = M2_KF(qi + 1); if ((qi + 1) & 1) kfB = nx; else kfA = nx; }
        if (isP && pj + 1 < 8) { const s16x4 l_ = M2_VF(0, pj + 1), h_ = M2_VF(1, pj + 1); if ((pj + 1) & 1) { lb = l_; hb = h_; } else { la = l_; ha = h_; } }
        if (i == 0) { la = M2_VF(0, 0); ha = M2_VF(1, 0); }
        SBAR();
        if (i < 4) { float a = vmax3_s(zin[4 * i], zin[4 * i + 1], zin[4 * i + 2]); mt = i == 0 ? vmax3_s(a, zin[3], zin[3]) : vmax3_s(mt, a, zin[4 * i + 3]); asm volatile("" : "+v"(mt)); }
        if (i == 4) { mt = swap_max(mt); mnew = fmaxf(st.mrun, mt); alpha = __builtin_amdgcn_exp2f(st.mrun - mnew); grow = __builtin_amdgcn_ballot_w64(mt > st.mrun) != 0ull;
            st.mrun = mnew; st.lrun *= alpha; asm volatile("" : "+v"(mnew), "+v"(alpha)); }
        if (i >= 5 && i < 13) { const int g = 2 * (i - 5); float e0 = __builtin_amdgcn_exp2f(zin[g] - mnew), e1 = __builtin_amdgcn_exp2f(zin[g + 1] - mnew); ps += e0 + e1;
            asm volatile("" : "+v"(ps)); pe[g] = e0; pe[g + 1] = e1; }
        if (i >= 13 && i < 17) { const int w_ = i - 13; unsigned w0 = cvtpk(pe[4 * w_], pe[4 * w_ + 1]), w1 = cvtpk(pe[4 * w_ + 2], pe[4 * w_ + 3]); asm volatile("" : "+v"(w0), "+v"(w1));
            if (w_ < 2) { po0[2 * w_] = w0; po0[2 * w_ + 1] = w1; } else { po1[2 * (w_ - 2)] = w0; po1[2 * (w_ - 2) + 1] = w1; } }
        SBAR();
    }
    st.lrun += ps;
    if (grow) {
#pragma unroll
        for (int d0 = 0; d0 < 4; ++d0)
#pragma unroll
            for (int g = 0; g < 16; ++g) st.o[d0][g] *= alpha;
    }
#undef M2_KF
#undef M2_VF
}
DI void mla2_unit(LAS unsigned char* lds, unsigned char* ws, int b, int h, int qb, const int tid_in) {
    int tid = tid_in; asm volatile("" : "+v"(tid));
    const int lane = tid & 63, wid = __builtin_amdgcn_readfirstlane(tid >> 6), r = lane & 31, hh = lane >> 5;
    const bf16_t *QN = (const bf16_t*)(ws + WS_QN), *QR = (const bf16_t*)(ws + WS_QR), *KN = (const bf16_t*)(ws + WS_KN), *KR = (const bf16_t*)(ws + WS_KR), *VA = (const bf16_t*)(ws + WS_VA), *SG = (const bf16_t*)(ws + WS_SG);
    bf16_t* MIX = (bf16_t*)(ws + WS_MIX);
    const int q0 = qb * 256, NT = 4 * (qb + 1), tmax = (q0 + 32 * wid) >> 6; const size_t rowbase = (size_t)b * SEQ;
    bf16x8 qf[12];
    { const size_t qrow = rowbase + q0 + 32 * wid + r;
#pragma unroll
      for (int d0 = 0; d0 < 8; ++d0) qf[d0] = *(const bf16x8*)(QN + qrow * 1024 + h * 128 + d0 * 16 + hh * 8);
#pragma unroll
      for (int d0 = 0; d0 < 4; ++d0) qf[8 + d0] = *(const bf16x8*)(QR + qrow * 512 + h * 64 + d0 * 16 + hh * 8); }
    M2State st;
#pragma unroll
    for (int d0 = 0; d0 < 4; ++d0)
#pragma unroll
        for (int g = 0; g < 16; ++g) st.o[d0][g] = 0.f;
    st.mrun = -INFINITY; st.lrun = 0.f;
    unsigned koff[4], voff[2][4];
    { const unsigned blk = (lane >> 4) & 1, qq = (lane & 15) >> 2, p = lane & 3, f = (r >> 1) & 7;
      const unsigned kb_ = (unsigned)(size_t)lds + r * 384;
#pragma unroll
      for (int j = 0; j < 4; ++j) koff[j] = kb_ + 16 * ((2 * j + hh) ^ f);
      const unsigned vb0 = 256 * (4 * hh + qq) + 8 * (p & 1) + 16 * ((2 * blk + (p >> 1)) ^ hh), v0_ = (unsigned)(size_t)lds + M2_LDS_V + vb0, v1_ = (unsigned)(size_t)lds + M2_LDS_V + 2048 + (vb0 ^ 32);
#pragma unroll
      for (int d0 = 0; d0 < 4; ++d0) { voff[0][d0] = v0_ + ((64u * d0) ^ (64u * qq)); voff[1][d0] = v1_ + ((64u * d0) ^ (64u * qq)); } }
    const bf16_t* knb = KN + rowbase * 1024 + h * 128; const bf16_t* krb = KR + rowbase * 64; const bf16_t* vab = VA + rowbase * 1024 + h * 128;
    unsigned ksrc[3];
#pragma unroll
    for (int i_ = 0; i_ < 3; ++i_) { const int c_ = (3 * wid + i_) * 64 + lane, row_ = c_ / 24, ch_ = (c_ % 24) ^ ((row_ >> 1) & 7);
        ksrc[i_] = ch_ < 16 ? (unsigned)(row_ * 1024 + ch_ * 8) : (0x80000000u | (unsigned)(row_ * 64 + (ch_ - 16) * 8)); }
#define M2_DMAK(t, slot) do { _Pragma("unroll") for (int i_ = 0; i_ < 3; ++i_) { const unsigned o_ = ksrc[i_] & 0x7fffffffu; \
            const bf16_t* src_ = (ksrc[i_] >> 31) ? krb + (size_t)(t) * (64 * 64) + o_ : knb + (size_t)(t) * (64 * 1024) + o_; \
            __builtin_amdgcn_global_load_lds((const unsigned*)src_, (LAS unsigned*)(lds + (slot) * M2_KBUF + (3 * wid + i_) * 1024), 16, 0, 0); } } while (0)
#define M2_DMAV(t, slot) do { int t2_ = tid; asm volatile("" : "+v"(t2_)); const int ln_ = t2_ & 63, drow_ = 8 * wid + (ln_ >> 4), c15_ = ln_ & 15; \
        const unsigned s0_ = (unsigned)drow_ * 1024 + ((c15_ ^ (((drow_ & 3) << 2) | ((drow_ >> 2) & 3))) * 8), s1_ = (unsigned)(drow_ + 4) * 1024 + ((c15_ ^ ((((drow_ + 4) & 3) << 2) | (((drow_ + 4) >> 2) & 3))) * 8); \
        const bf16_t* vt = vab + (size_t)(t) * (64 * 1024); LAS unsigned char* vd = lds + M2_LDS_V + (slot) * VBUF + wid * 2048; \
        __builtin_amdgcn_global_load_lds((const unsigned*)(vt + s0_), (LAS unsigned*)vd, 16, 0, 0); __builtin_amdgcn_global_load_lds((const unsigned*)(vt + s1_), (LAS unsigned*)(vd + 1024), 16, 0, 0); } while (0)
    M2_DMAK(0, 0); M2_DMAV(0, 0); M2_DMAV(0, 2);
    if (NT > 1) M2_DMAK(1, 1);
    __builtin_amdgcn_s_waitcnt(0x0F70);
    __syncthreads();
    f32x16 za, zb;
#pragma unroll
    for (int g = 0; g < 16; ++g) { za[g] = 0.f; zb[g] = 0.f; }
#pragma unroll
    for (int d0 = 0; d0 < 12; ++d0) za = MFMA_BF16(*(LAS const bf16x8*)(koff[d0 & 3] + (unsigned)(128 * (d0 >> 2))), qf[d0], za);
    u32x4 pa[2], pb[2]; pa[0] = (u32x4){0u, 0u, 0u, 0u}; pa[1] = pa[0]; pb[0] = pa[0]; pb[1] = pa[0];
#define M2_INTERVAL(P) { if (t + 2 < NT) M2_DMAK(t + 2, ((P) + 2) % 3); if (t + 1 < NT) M2_DMAV(t + 1, ((P) + 1) % 3); \
        int qrh; { int t3 = tid; asm volatile("" : "+v"(t3)); qrh = q0 + 32 * wid + (t3 & 31) - 4 * ((t3 >> 5) & 1) - 64 * t; } const bool msk = t >= tmax; \
        mla2_iter<(P) * M2_KBUF + 32 * 384, (((P) + 2) % 3) * VBUF + 8192>(za, zb, st, pa[0], pa[1], pb[0], pb[1], qf, koff, voff, msk, qrh); \
        mla2_iter<(((P) + 1) % 3) * M2_KBUF, (P) * VBUF>(zb, za, st, pb[0], pb[1], pa[0], pa[1], qf, koff, voff, msk, qrh - 32); \
        ++t; __syncthreads(); }
    int t = 0;
    for (;;) { M2_INTERVAL(0) if (t >= NT) break; M2_INTERVAL(1) if (t >= NT) break; M2_INTERVAL(2) if (t >= NT) break; }
#undef M2_INTERVAL
    { lcp vb = lds + M2_LDS_V + ((NT - 1) % 3) * VBUF + 8192; const VAddr va = make_vaddr(lane);
#pragma unroll
      for (int j = 0; j < 8; ++j) st.o[j & 3] = MFMA_BF16(vfrag(vb, j >> 2, j & 3, va), __builtin_bit_cast(bf16x8, (j >> 2) ? pa[1] : pa[0]), st.o[j & 3]); }
    __syncthreads();
#undef M2_DMAK
#undef M2_DMAV
    const float inv = 1.0f / swap_sum(st.lrun);
    int t4 = tid; asm volatile("" : "+v"(t4)); const size_t qrow = rowbase + q0 + 32 * wid + (t4 & 31); const int hh2 = (t4 >> 5) & 1;
#pragma unroll
    for (int d0 = 0; d0 < 4; ++d0)
#pragma unroll
        for (int gg = 0; gg < 4; ++gg) { const size_t off = qrow * 2048 + h * 128 + 32 * d0 + 8 * gg + 4 * hh2;
            const unsigned long long sg = *(const unsigned long long*)(SG + off);
            const float g0 = __uint_as_float((unsigned)(sg << 16)), g1 = __uint_as_float((unsigned)sg & 0xffff0000u), g2 = __uint_as_float((unsigned)(sg >> 32) << 16), g3 = __uint_as_float((unsigned)(sg >> 32) & 0xffff0000u);
            const unsigned lo = cvtpk(st.o[d0][4 * gg] * inv * g0, st.o[d0][4 * gg + 1] * inv * g1), hi = cvtpk(st.o[d0][4 * gg + 2] * inv * g2, st.o[d0][4 * gg + 3] * inv * g3);
            *(unsigned long long*)(MIX + off) = (unsigned long long)lo | ((unsigned long long)hi << 32); }
}
DI void mla_phase(LAS unsigned char* lds, unsigned char* ws, const int tid) {
    const int G = gridDim.x, bx = blockIdx.x; const int vcu = (G % 8 == 0) ? (bx % 8) * (G / 8) + bx / 8 : bx;
    for (int p = vcu; p < 256; p += G) { const int bh = p >> 3, pr = p & 7;
#if MLA_PIPE
        mla2_unit(lds, ws, bh >> 3, bh & 7, 15 - pr, tid); mla2_unit(lds, ws, bh >> 3, bh & 7, pr, tid);
#else
        mla_unit(lds, ws, bh >> 3, bh & 7, 15 - pr, tid); mla_unit(lds, ws, bh >> 3, bh & 7, pr, tid);
#endif
 }
}

constexpr int SB_KBUF = 16384, SB_LDS_V = 3 * SB_KBUF, SB_LDS_UM = SB_LDS_V + 3 * VBUF, SB_LDS_BYTES = SB_LDS_UM + 2048;
DI float vmin_s(float a, float b) { float r; asm("v_min_f32 %0, %1, %2" : "=v"(r) : "v"(a), "v"(b)); return r; }
struct SbAddr { unsigned kx, vb0, vq; };
template <bool MASKED, int VAR>
DI void sb_iter(f32x16& zin, f32x16& zout, f32x16 (&o)[4], const u32x4& pi0, const u32x4& pi1, u32x4& po0, u32x4& po1, float& carry, const bf16x8 (&qf)[8], lcp ump, lcp knext, lcp vprev, const SbAddr& ad, int qrh) {
    u32x4 lw0, lw1; const float z0 = zin[0];
    unsigned kx = ad.kx, vq = ad.vq; asm volatile("" : "+v"(kx), "+v"(vq));
    bf16x8 kfa = *(LAS const bf16x8*)(knext + kx), kfb;
    const f16x8 um0 = *(LAS const f16x8*)ump, um1 = *(LAS const f16x8*)(ump + 16);
    SBAR();
#pragma unroll
    for (int k = 0; k < 8; ++k) {
        if (k == 0) {
#pragma unroll
            for (int g = 0; g < 16; ++g) zout[g] = 0.f;
        }
        if (VAR == 2 || VAR == 4 || VAR == 11 || VAR == 13) { asm volatile("" :: "v"((k & 1) ? kfb : kfa)); } else zout = MFMA_BF16((k & 1) ? kfb : kfa, qf[k], zout);
        if (VAR == 12) { zout = MFMA_BF16((k & 1) ? kfb : kfa, qf[k], zout); zout = MFMA_BF16((k & 1) ? kfb : kfa, qf[k], zout); }
        if (k + 1 < 8) { bf16x8 nx; if (VAR == 3 || VAR == 4 || VAR == 9 || VAR == 11 || VAR == 12 || VAR == 13) nx = qf[k]; else nx = *(LAS const bf16x8*)(knext + ((32u * (k + 1)) ^ kx)); if (k & 1) kfa = nx; else kfb = nx; }
        SBAR();
        float lv[2];
#pragma unroll
        for (int i = 0; i < 2; ++i) { const int g = 2 * k + i;
            float sp; if (VAR == 8 || VAR == 9 || VAR == 12) sp = zin[g]; else if (VAR == 13) { sp = __builtin_amdgcn_logf(1.0f + __builtin_amdgcn_exp2f(vmin_s(zin[g], 64.0f))); sp = __builtin_amdgcn_logf(1.0f + __builtin_amdgcn_exp2f(vmin_s(sp, 64.0f))); sp = __builtin_amdgcn_logf(1.0f + __builtin_amdgcn_exp2f(vmin_s(sp, 64.0f))); } else if (VAR == 1 || VAR == 4) sp = vmin_s(zin[g], 64.0f) * 0.5f; else sp = __builtin_amdgcn_logf(1.0f + __builtin_amdgcn_exp2f(vmin_s(zin[g], 64.0f)));
            if (MASKED) lv[i] = (crow(g, 0) < qrh) ? sp : 0.f; else lv[i] = sp; }
        unsigned w = cvtpk_h(lv[0], lv[1]);
        asm volatile("" : "+v"(w));
        if (k < 4) lw0[k & 3] = w; else lw1[k & 3] = w;
        SBAR();
    }
    zin = MFMA_F16(um0, __builtin_bit_cast(f16x8, lw0), zin); zin = MFMA_F16(um1, __builtin_bit_cast(f16x8, lw1), zin);
    SBAR();
    s16x4 la, ha, lb, hb;
    const unsigned vb0 = ad.vb0, vb1 = 2048 + (vb0 ^ 32);
    { const unsigned dq = vq; la = vtr(vprev + vb0 + dq); ha = vtr(vprev + vb1 + dq); }
#pragma unroll
    for (int j = 0; j < 8; ++j) {
        { const s16x4 lo = (j & 1) ? lb : la, hi = (j & 1) ? hb : ha;
          const bf16x8 vf = (bf16x8){lo[0], lo[1], lo[2], lo[3], hi[0], hi[1], hi[2], hi[3]};
          if (VAR == 2 || VAR == 4 || VAR == 11 || VAR == 13) { asm volatile("" :: "v"(vf)); } else o[j & 3] = MFMA_BF16(vf, __builtin_bit_cast(bf16x8, (j >> 2) ? pi1 : pi0), o[j & 3]);
          if (VAR == 12) { o[(j + 1) & 3] = MFMA_BF16(vf, __builtin_bit_cast(bf16x8, (j >> 2) ? pi1 : pi0), o[(j + 1) & 3]); o[(j + 2) & 3] = MFMA_BF16(vf, __builtin_bit_cast(bf16x8, (j >> 2) ? pi1 : pi0), o[(j + 2) & 3]); } }
        if (j + 1 < 8) { const unsigned dq = (64u * ((j + 1) & 3)) ^ vq; s16x4 l_, h_; if (VAR == 3 || VAR == 4 || VAR == 9 || VAR == 11 || VAR == 12 || VAR == 13) { l_ = (s16x4){(short)pi0[0], (short)pi0[1], (short)pi0[2], (short)pi0[3]}; h_ = l_; } else { l_ = vtr(vprev + 4096 * ((j + 1) >> 2) + vb0 + dq); h_ = vtr(vprev + 4096 * ((j + 1) >> 2) + vb1 + dq); }
            if (j & 1) { la = l_; ha = h_; } else { lb = l_; hb = h_; } }
        SBAR();
        float av[2];
#pragma unroll
        for (int i = 0; i < 2; ++i) { const int g = 2 * j + i; float a; if (VAR == 8 || VAR == 9 || VAR == 12) a = zin[g]; else if (VAR == 13) { a = __builtin_amdgcn_exp2f(zin[g] + carry); a = __builtin_amdgcn_exp2f(a + carry); a = __builtin_amdgcn_exp2f(a + carry); } else if (VAR == 1 || VAR == 4) a = zin[g] + carry; else a = __builtin_amdgcn_exp2f(zin[g] + carry); if (MASKED) av[i] = (crow(g, 0) < qrh) ? a : 0.f; else av[i] = a; }
        unsigned w = cvtpk(av[0], av[1]);
        asm volatile("" : "+v"(w));
        if (j < 4) po0[j & 3] = w; else po1[j & 3] = w;
        SBAR();
    }
    carry += bcast_lo(zin[0] - z0);
}
template <int KIMM, int VIMM>
DI void sb_iter_s(f32x16& zin, f32x16& zout, f32x16 (&o)[4], const u32x4& pi0, const u32x4& pi1, u32x4& po0, u32x4& po1, float& carry, const bf16x8 (&qf)[8], lcp ump,
                  const unsigned (&koff)[8], const unsigned (&voff)[2][4]) {
    u32x4 lw0, lw1; const float z0 = zin[0];
#define SB_KF(k) (*(LAS const bf16x8*)(koff[k] + (unsigned)KIMM))
#define SB_VF(t, j) vtr((lcp)(voff[t][(j) & 3] + (unsigned)(VIMM + 4096 * ((j) >> 2))))
    bf16x8 kfa = SB_KF(0), kfb;
    const f16x8 um0 = *(LAS const f16x8*)ump, um1 = *(LAS const f16x8*)(ump + 16);
    SBAR();
#pragma unroll
    for (int k = 0; k < 8; ++k) {
        if (k == 0) {
#pragma unroll
            for (int g = 0; g < 16; ++g) zout[g] = 0.f;
        }
        zout = MFMA_BF16((k & 1) ? kfb : kfa, qf[k], zout);
        if (k + 1 < 8) { const bf16x8 nx = SB_KF(k + 1); if (k & 1) kfa = nx; else kfb = nx; }
        SBAR();
        float lv[2];
#pragma unroll
        for (int i = 0; i < 2; ++i) lv[i] = __builtin_amdgcn_logf(1.0f + __builtin_amdgcn_exp2f(vmin_s(zin[2 * k + i], 64.0f)));
        unsigned w = cvtpk_h(lv[0], lv[1]);
        asm volatile("" : "+v"(w));
        if (k < 4) lw0[k & 3] = w; else lw1[k & 3] = w;
        SBAR();
    }
    s16x4 la = SB_VF(0, 0), ha = SB_VF(1, 0), lb, hb;
    SBAR();
    zin = MFMA_F16(um0, __builtin_bit_cast(f16x8, lw0), zin); zin = MFMA_F16(um1, __builtin_bit_cast(f16x8, lw1), zin);
    SBAR();
#pragma unroll
    for (int j = 0; j < 8; ++j) {
        { const s16x4 lo = (j & 1) ? lb : la, hi = (j & 1) ? hb : ha;
          const bf16x8 vf = (bf16x8){lo[0], lo[1], lo[2], lo[3], hi[0], hi[1], hi[2], hi[3]};
          o[j & 3] = MFMA_BF16(vf, __builtin_bit_cast(bf16x8, (j >> 2) ? pi1 : pi0), o[j & 3]); }
        if (j + 1 < 8) { const s16x4 l_ = SB_VF(0, j + 1), h_ = SB_VF(1, j + 1); if (j & 1) { la = l_; ha = h_; } else { lb = l_; hb = h_; } }
        SBAR();
        float av[2];
#pragma unroll
        for (int i = 0; i < 2; ++i) av[i] = __builtin_amdgcn_exp2f(zin[2 * j + i] + carry);
        unsigned w = cvtpk(av[0], av[1]);
        asm volatile("" : "+v"(w));
        if (j < 4) po0[j & 3] = w; else po1[j & 3] = w;
        SBAR();
    }
#undef SB_KF
#undef SB_VF
    carry += bcast_lo(zin[0] - z0);
}
template <int P>
DI void sb_tile_s(f32x16& za, f32x16& zb, f32x16 (&o)[4], u32x4 (&pa)[2], u32x4 (&pb)[2], float& carry, const bf16x8 (&qf)[8], lcp ump, const unsigned (&koff)[8], const unsigned (&voff)[2][4]) {
    constexpr int KS = P, KSN = (P + 1) % 3, VS = P, VSP = (P + 2) % 3;
    sb_iter_s<KS * SB_KBUF, VSP * VBUF>(za, zb, o, pa[0], pa[1], pb[0], pb[1], carry, qf, ump, koff, voff);
    sb_iter_s<KSN * SB_KBUF + 8192, VS * VBUF + 8192>(zb, za, o, pb[0], pb[1], pa[0], pa[1], carry, qf, ump, koff, voff);
}
template <bool MASKED, int VAR>
DI void sb_tile(LAS unsigned char* lds, f32x16& za, f32x16& zb, f32x16 (&o)[4], u32x4 (&pa)[2], u32x4 (&pb)[2], float& carry, const bf16x8 (&qf)[8], lcp ump, const SbAddr& ad,
                unsigned krow_off, int ks, int ksn, int vs, int vsp, int qrh0) {
    sb_iter<MASKED, VAR>(za, zb, o, pa[0], pa[1], pb[0], pb[1], carry, qf, ump, lds + ks * SB_KBUF + krow_off, lds + SB_LDS_V + vsp * VBUF, ad, qrh0 - 32);
    sb_iter<MASKED, VAR>(zb, za, o, pb[0], pb[1], pa[0], pa[1], carry, qf, ump, lds + ksn * SB_KBUF + 8192 + krow_off, lds + SB_LDS_V + vs * VBUF + 8192, ad, qrh0);
}
template <int VAR> DI void sb_unit(LAS unsigned char* lds, unsigned char* ws, int b, int h, int qb, const int tid_in) {
    int tid = tid_in; asm volatile("" : "+v"(tid));
    const int lane = tid & 63, wid = __builtin_amdgcn_readfirstlane(tid >> 6), r = lane & 31, hh = lane >> 5;
    const bf16_t *Q2 = (const bf16_t*)(ws + WS_Q2), *K2 = (const bf16_t*)(ws + WS_K2), *V2 = (const bf16_t*)(ws + WS_V2), *SG2 = (const bf16_t*)(ws + WS_SG2);
    bf16_t* MIX2 = (bf16_t*)(ws + (VAR ? WS_A : WS_MIX2));
    const int q0 = qb * 256, NT = 4 * (qb + 1), tmax = (q0 + 32 * wid) >> 6; const size_t rowbase = (size_t)b * SEQ;
    bf16x8 qf[8];
    { const size_t qrow = rowbase + q0 + 32 * wid + r;
#pragma unroll
      for (int d0 = 0; d0 < 8; ++d0) qf[d0] = *(const bf16x8*)(Q2 + qrow * 2048 + h * 128 + d0 * 16 + hh * 8); }
    { f16x8 um[2];
#pragma unroll
      for (int s = 0; s < 2; ++s)
#pragma unroll
          for (int j = 0; j < 8; ++j) um[s][j] = (16 * s + 8 * (j >> 2) + 4 * hh + (j & 3)) >= r ? (_Float16)-1.0f : (_Float16)0.0f;
      *(LAS f16x8*)(lds + SB_LDS_UM + lane * 32) = um[0]; *(LAS f16x8*)(lds + SB_LDS_UM + lane * 32 + 16) = um[1]; }
    lcp ump = lds + SB_LDS_UM + lane * 32;
    f32x16 o[4];
#pragma unroll
    for (int d0 = 0; d0 < 4; ++d0)
#pragma unroll
        for (int g = 0; g < 16; ++g) o[d0][g] = 0.f;
    float carry = 0.f;
    SbAddr ad;
    { const unsigned blk = (lane >> 4) & 1, qq = (lane & 15) >> 2, p = lane & 3;
      ad.kx = ((r & 15) >> 1) << 5;
      ad.vb0 = 256 * (4 * hh + qq) + 8 * (p & 1) + 16 * ((2 * blk + (p >> 1)) ^ hh); ad.vq = 64 * qq; }
    const unsigned krow_off = r * 256 + ((hh ^ (r & 1)) << 4);
    const bf16_t* kbase = K2 + rowbase * 2048 + h * 128; const bf16_t* vbase = V2 + rowbase * 2048 + h * 128;
#define SB_DMA_SRC() int t2_ = tid; asm volatile("" : "+v"(t2_)); const int ln_ = t2_ & 63, drow_ = 8 * wid + (ln_ >> 4), c15_ = ln_ & 15;
#define SB_DMAK(tau, slot) do { SB_DMA_SRC(); const unsigned s0_ = (unsigned)drow_ * 2048 + ((c15_ ^ (drow_ & 15)) * 8), s1_ = (unsigned)(drow_ + 4) * 2048 + ((c15_ ^ ((drow_ + 4) & 15)) * 8); \
        const bf16_t* kt = kbase + (size_t)(NT - 1 - (tau)) * (64 * 2048); LAS unsigned char* kd = lds + (slot) * SB_KBUF + wid * 2048; \
        __builtin_amdgcn_global_load_lds((const unsigned*)(kt + s0_), (LAS unsigned*)kd, 16, 0, 0); __builtin_amdgcn_global_load_lds((const unsigned*)(kt + s1_), (LAS unsigned*)(kd + 1024), 16, 0, 0); } while (0)
#define SB_DMAV(tau, slot) do { SB_DMA_SRC(); const unsigned s0_ = (unsigned)drow_ * 2048 + ((c15_ ^ (((drow_ & 3) << 2) | ((drow_ >> 2) & 3))) * 8), s1_ = (unsigned)(drow_ + 4) * 2048 + ((c15_ ^ ((((drow_ + 4) & 3) << 2) | (((drow_ + 4) >> 2) & 3))) * 8); \
        const bf16_t* vt = vbase + (size_t)(NT - 1 - (tau)) * (64 * 2048); LAS unsigned char* vd = lds + SB_LDS_V + (slot) * VBUF + wid * 2048; \
        __builtin_amdgcn_global_load_lds((const unsigned*)(vt + s0_), (LAS unsigned*)vd, 16, 0, 0); __builtin_amdgcn_global_load_lds((const unsigned*)(vt + s1_), (LAS unsigned*)(vd + 1024), 16, 0, 0); } while (0)
    SB_DMAK(0, 0); SB_DMAV(0, 0);
    if (NT > 1) SB_DMAK(1, 1);
    __builtin_amdgcn_s_waitcnt(0x0F70);
    __syncthreads();
    f32x16 za, zb;
#pragma unroll
    for (int g = 0; g < 16; ++g) { za[g] = 0.f; zb[g] = 0.f; }
    u32x4 pa[2], pb[2]; pa[0] = (u32x4){0u, 0u, 0u, 0u}; pa[1] = pa[0]; pb[0] = pa[0]; pb[1] = pa[0];
    int ks = 0, ks1 = 1, vs = 0, vsp = 0;
    const int nmask = NT - tmax;
#define SB_INTERVAL(MASKED) { const int t = NT - 1 - tau; const int ks2 = (ks1 == 2) ? 0 : ks1 + 1, vs1 = (vs == 2) ? 0 : vs + 1; \
        if (VAR != 5 && tau + 2 < NT) SB_DMAK(tau + 2, ks2); \
        if (VAR != 5 && tau + 1 < NT) SB_DMAV(tau + 1, vs1); \
        int qrh0; { int t3 = tid; asm volatile("" : "+v"(t3)); qrh0 = q0 + 32 * wid + (t3 & 31) - 4 * ((t3 >> 5) & 1) - 64 * t; }        \
        if (VAR != 7 || wid < 4) sb_tile<MASKED, VAR>(lds, za, zb, o, pa, pb, carry, qf, ump, ad, krow_off, ks, (tau + 1 < NT ? ks1 : ks), vs, vsp, qrh0); \
        ks = ks1; ks1 = ks2; vsp = vs; vs = vs1; \
        if (VAR != 5) __syncthreads(); }
    int tau = 0;
    for (; tau < nmask - 1; ++tau) { const int ks2 = (ks1 == 2) ? 0 : ks1 + 1, vs1 = (vs == 2) ? 0 : vs + 1;
        if (VAR != 5 && tau + 2 < NT) SB_DMAK(tau + 2, ks2);
        if (VAR != 5 && tau + 1 < NT) SB_DMAV(tau + 1, vs1);
        ks = ks1; ks1 = ks2; vsp = vs; vs = vs1;
        if (VAR != 5) __syncthreads(); }
    { lcp kp = lds + ks * SB_KBUF + 8192 + krow_off;
#pragma unroll
      for (int k = 0; k < 8; ++k) za = MFMA_BF16(*(LAS const bf16x8*)(kp + ((32u * k) ^ ad.kx)), qf[k], za); }
    for (; tau < nmask; ++tau) SB_INTERVAL(true)
    for (; tau < NT && tau % 3 != 0; ++tau) SB_INTERVAL(false)
    if (VAR == 0 && tau + 3 <= NT) {
        unsigned koff[8], voff[2][4];
        { const unsigned kb_ = (unsigned)(size_t)lds + krow_off, v0_ = (unsigned)(size_t)lds + SB_LDS_V + ad.vb0, v1_ = (unsigned)(size_t)lds + SB_LDS_V + 2048 + (ad.vb0 ^ 32);
#pragma unroll
          for (int k = 0; k < 8; ++k) koff[k] = kb_ + ((32u * k) ^ ad.kx);
#pragma unroll
          for (int d0 = 0; d0 < 4; ++d0) { voff[0][d0] = v0_ + ((64u * d0) ^ ad.vq); voff[1][d0] = v1_ + ((64u * d0) ^ ad.vq); } }
#define SB_INTERVAL_S(P) { if (tau + 2 < NT) SB_DMAK(tau + 2, (P + 2) % 3); if (tau + 1 < NT) SB_DMAV(tau + 1, (P + 1) % 3); \
            sb_tile_s<P>(za, zb, o, pa, pb, carry, qf, ump, koff, voff); ++tau; __syncthreads(); }
        for (; tau + 3 <= NT;) { SB_INTERVAL_S(0) SB_INTERVAL_S(1) SB_INTERVAL_S(2) }
#undef SB_INTERVAL_S
        ks = tau % 3; ks1 = (tau + 1) % 3; vs = tau % 3; vsp = (tau + 2) % 3;
    }
    for (; tau < NT; ++tau) SB_INTERVAL(false)
#undef SB_INTERVAL
    { lcp vp = lds + SB_LDS_V + vsp * VBUF;
#pragma unroll
      for (int j = 0; j < 8; ++j) { const unsigned dq = (64u * (j & 3)) ^ ad.vq;
          const s16x4 lo = vtr(vp + 4096 * (j >> 2) + ad.vb0 + dq), hi = vtr(vp + 4096 * (j >> 2) + 2048 + (ad.vb0 ^ 32) + dq);
          o[j & 3] = MFMA_BF16(((bf16x8){lo[0], lo[1], lo[2], lo[3], hi[0], hi[1], hi[2], hi[3]}), __builtin_bit_cast(bf16x8, (j >> 2) ? pa[1] : pa[0]), o[j & 3]); } }
    __syncthreads();
#undef SB_DMAK
#undef SB_DMAV
#undef SB_DMA_SRC
    int t4 = tid; asm volatile("" : "+v"(t4)); const size_t qrow = rowbase + q0 + 32 * wid + (t4 & 31); const int hh2 = (t4 >> 5) & 1;
#pragma unroll
    for (int d0 = 0; d0 < 4; ++d0)
#pragma unroll
        for (int gg = 0; gg < 4; ++gg) { const size_t off = qrow * 2048 + h * 128 + 32 * d0 + 8 * gg + 4 * hh2;
            const unsigned long long sg = *(const unsigned long long*)(SG2 + off);
            const float g0 = __uint_as_float((unsigned)(sg << 16)), g1 = __uint_as_float((unsigned)sg & 0xffff0000u), g2 = __uint_as_float((unsigned)(sg >> 32) << 16), g3 = __uint_as_float((unsigned)(sg >> 32) & 0xffff0000u);
            const unsigned lo = cvtpk(o[d0][4 * gg] * g0, o[d0][4 * gg + 1] * g1), hi = cvtpk(o[d0][4 * gg + 2] * g2, o[d0][4 * gg + 3] * g3);
            *(unsigned long long*)(MIX2 + off) = (unsigned long long)lo | ((unsigned long long)hi << 32); }
}
template <int VAR> DI void sb_phase(LAS unsigned char* lds, unsigned char* ws, const int tid) {
    const int G = gridDim.x, bx = blockIdx.x; const int vcu = (G % 8 == 0) ? (bx % 8) * (G / 8) + bx / 8 : bx;
    for (int p = vcu; p < 512; p += G) { const int bh = p >> 3, pr = p & 7; sb_unit<VAR>(lds, ws, bh >> 4, bh & 15, 15 - pr, tid); sb_unit<VAR>(lds, ws, bh >> 4, bh & 15, pr, tid); }
}

constexpr int DIL_KSTR = 272, DIL_WAVE_BYTES = 32 * DIL_KSTR + 8192, DIL_LDS_BYTES = 8 * DIL_WAVE_BYTES;
DI void softmax_blk(f32x16& s0, f32x16 (&o)[4], float& mrun, float& lrun) {
    float mt = s0[0];
#pragma unroll
    for (int g = 1; g < 16; ++g) mt = fmaxf(mt, s0[g]);
    mt = swap_max(mt);
    if (__builtin_amdgcn_ballot_w64(mt > mrun) != 0ull) {
        const float mn = fmaxf(mrun, mt), alpha = __builtin_amdgcn_exp2f(mrun - mn); mrun = mn; lrun *= alpha;
#pragma unroll
        for (int d0 = 0; d0 < 4; ++d0)
#pragma unroll
            for (int g = 0; g < 16; ++g) o[d0][g] *= alpha;
    }
    float ps = 0.f;
#pragma unroll
    for (int g = 0; g < 16; ++g) { s0[g] = __builtin_amdgcn_exp2f(s0[g] - mrun); ps += s0[g]; }
    lrun += ps;
}
DI void dil_wave_unit(LAS unsigned char* wl, unsigned char* ws, int p, int b, int h, int res, int m0w, const int tid_in) {
    int tid = tid_in; asm volatile("" : "+v"(tid));
    const int lane = tid & 63, r = lane & 31, hh = lane >> 5; const int dil = p == 0 ? 1 : p == 1 ? 4 : 16;
    const bf16_t *QB = (const bf16_t*)(ws + WS_QB), *KB = (const bf16_t*)(ws + WS_KB), *VB = (const bf16_t*)(ws + WS_VB);
    const size_t rowbase = (size_t)b * SEQ; const size_t qrow = rowbase + (size_t)(m0w + r) * dil + res;
    const __amdgpu_buffer_rsrc_t rK = mk_rsrc(KB, M * 1024 * 2), rV = mk_rsrc(VB, M * 1024 * 2);
    const unsigned vo = (unsigned)(lane >> 4) * dil * 2048 + (lane & 15) * 16;
    const unsigned so0 = (unsigned)((rowbase + res) * 1024 + h * 128) * 2;
    const float* biasc = (const float*)(ws + WS_BIASC) + (size_t)(p * 8 + h) * 5 * 1024 + lane * 16;
    u32x4 kr[8], vr[8]; f32x4 br[4];
    const int kb0 = m0w >> 5;
#define DIL_LOAD(di) do { const unsigned sb_ = so0 + (unsigned)(32 * (kb0 - (di))) * dil * 2048; \
        _Pragma("unroll") for (int i = 0; i < 8; ++i) { kr[i] = bload(rK, vo + (unsigned)(4 * i) * dil * 2048, sb_); vr[i] = bload(rV, vo + (unsigned)(4 * i) * dil * 2048, sb_); } \
        _Pragma("unroll") for (int j = 0; j < 4; ++j) br[j] = ((const f32x4*)(biasc + (di) * 1024))[j]; } while (0)
    DIL_LOAD(0);
    bf16x8 qf[8];
#pragma unroll
    for (int d0 = 0; d0 < 8; ++d0) qf[d0] = *(const bf16x8*)(QB + qrow * 1024 + h * 128 + d0 * 16 + hh * 8);
    f32x16 o[4];
#pragma unroll
    for (int d0 = 0; d0 < 4; ++d0)
#pragma unroll
        for (int g = 0; g < 16; ++g) o[d0][g] = 0.f;
    float mrun = -INFINITY, lrun = 0.f;
    const VAddr va = make_vaddr(lane);
    const unsigned lk = (lane >> 4) * DIL_KSTR + (lane & 15) * 16;
    for (int di = 0; di < 5; ++di) {
        if (kb0 - di < 0) break;
        asm volatile("s_waitcnt lgkmcnt(0)" ::: "memory");
#pragma unroll
        for (int i = 0; i < 8; ++i) { *(LAS u32x4*)(wl + lk + 4 * i * DIL_KSTR) = kr[i]; *(LAS u32x4*)(wl + 32 * DIL_KSTR + off_b((lane >> 4) + 4 * i, lane & 15)) = vr[i]; }
        f32x16 s0;
#pragma unroll
        for (int j = 0; j < 4; ++j) { s0[4 * j] = br[j][0]; s0[4 * j + 1] = br[j][1]; s0[4 * j + 2] = br[j][2]; s0[4 * j + 3] = br[j][3]; }
        if (di + 1 < 5 && kb0 - (di + 1) >= 0) DIL_LOAD(di + 1);
        asm volatile("s_waitcnt lgkmcnt(0)" ::: "memory");
        lcp kp = wl + r * DIL_KSTR + hh * 16;
#pragma unroll
        for (int d0 = 0; d0 < 8; ++d0) s0 = MFMA_BF16(*(LAS const bf16x8*)(kp + d0 * 32), qf[d0], s0);
        softmax_blk(s0, o, mrun, lrun);
        lcp vb = wl + 32 * DIL_KSTR;
#pragma unroll
        for (int s = 0; s < 2; ++s) { const bf16x8 pf = pack_bf(s0, s);
#pragma unroll
            for (int d0 = 0; d0 < 4; ++d0) o[d0] = MFMA_BF16(vfrag(vb, s, d0, va), pf, o[d0]); }
    }
#undef DIL_LOAD
    const float lt = swap_sum(lrun), inv = 1.0f / lt;
    bf16_t* OP = (bf16_t*)(ws + (p == 0 ? WS_OP0 : p == 1 ? WS_OP1 : WS_OP2));
#pragma unroll
    for (int d0 = 0; d0 < 4; ++d0)
#pragma unroll
        for (int gg = 0; gg < 4; ++gg) { const size_t off = qrow * 1024 + h * 128 + 32 * d0 + 8 * gg + 4 * hh;
            const unsigned lo = cvtpk(o[d0][4 * gg] * inv, o[d0][4 * gg + 1] * inv), hi = cvtpk(o[d0][4 * gg + 2] * inv, o[d0][4 * gg + 3] * inv);
            *(unsigned long long*)(OP + off) = (unsigned long long)lo | ((unsigned long long)hi << 32); }
    if (hh == 0) ((float*)(ws + WS_LSE))[((size_t)p * M + qrow) * 8 + h] = mrun + __builtin_amdgcn_logf(lt);
}
constexpr int DILW_LDS_BYTES = 12 * 8192;
DI void dil_wg_unit(LAS unsigned char* lds, unsigned char* ws, int p, int b, int h, int res, int m0, const int tid_in) {
    int tid = tid_in; asm volatile("" : "+v"(tid));
    const int lane = tid & 63, wid = __builtin_amdgcn_readfirstlane(tid >> 6), r = lane & 31, hh = lane >> 5; const int dil = p == 0 ? 1 : p == 1 ? 4 : 16;
    const bf16_t *QB = (const bf16_t*)(ws + WS_QB), *KB = (const bf16_t*)(ws + WS_KB), *VB = (const bf16_t*)(ws + WS_VB);
    const size_t rowbase = (size_t)b * SEQ; const size_t qrow = rowbase + (size_t)(m0 + 32 * wid + r) * dil + res;
    const int kbw = (m0 >> 5) - 4;
    const int prow = 4 * wid + (lane >> 4);
    const unsigned ksw = ((lane & 15) ^ (prow & 15)) * 8, vsw = ((lane & 15) ^ (((prow & 3) << 2) | ((prow >> 2) & 3))) * 8;
    const bf16_t* kg = KB + (rowbase + res) * 1024 + h * 128; const bf16_t* vg = VB + (rowbase + res) * 1024 + h * 128;
#pragma unroll
    for (int i = 0; i < 12; ++i) { const int kb = kbw + i; if (kb >= 0)
        __builtin_amdgcn_global_load_lds((const unsigned*)(kg + (size_t)(32 * kb + prow) * dil * 1024 + ksw), (LAS unsigned*)(lds + i * 8192 + wid * 1024), 16, 0, 0); }
    bf16x8 qf[8];
#pragma unroll
    for (int d0 = 0; d0 < 8; ++d0) qf[d0] = *(const bf16x8*)(QB + qrow * 1024 + h * 128 + d0 * 16 + hh * 8);
    const float* biasc = (const float*)(ws + WS_BIASC) + (size_t)(p * 8 + h) * 5 * 1024 + lane * 16;
    f32x16 sc[5];
#pragma unroll
    for (int di = 0; di < 5; ++di) { const f32x4* bp = (const f32x4*)(biasc + di * 1024);
#pragma unroll
        for (int j = 0; j < 4; ++j) { const f32x4 v = bp[j]; sc[di][4 * j] = v[0]; sc[di][4 * j + 1] = v[1]; sc[di][4 * j + 2] = v[2]; sc[di][4 * j + 3] = v[3]; } }
    __builtin_amdgcn_s_waitcnt(0x0F70);
    __syncthreads();
    const unsigned kx = ((r & 15) >> 1) << 5, krow_off = r * 256 + ((hh ^ (r & 1)) << 4);
#pragma unroll
    for (int di = 0; di < 5; ++di) { const int jj = wid + 4 - di;
        if (kbw + jj >= 0) { lcp kp = lds + jj * 8192 + krow_off;
#pragma unroll
            for (int k = 0; k < 8; ++k) sc[di] = MFMA_BF16(*(LAS const bf16x8*)(kp + ((32u * k) ^ kx)), qf[k], sc[di]); }
        else {
#pragma unroll
            for (int g = 0; g < 16; ++g) sc[di][g] = -INFINITY; } }
    float mx = sc[0][0];
#pragma unroll
    for (int di = 0; di < 5; ++di)
#pragma unroll
        for (int g = 0; g < 16; ++g) mx = fmaxf(mx, sc[di][g]);
    mx = swap_max(mx);
    float ps = 0.f; u32x4 pw[5][2];
#pragma unroll
    for (int di = 0; di < 5; ++di) {
#pragma unroll
        for (int g = 0; g < 16; ++g) { sc[di][g] = __builtin_amdgcn_exp2f(sc[di][g] - mx); ps += sc[di][g]; }
        pw[di][0] = __builtin_bit_cast(u32x4, pack_bf(sc[di], 0)); pw[di][1] = __builtin_bit_cast(u32x4, pack_bf(sc[di], 1)); }
    __syncthreads();
#pragma unroll
    for (int i = 0; i < 12; ++i) { const int kb = kbw + i; if (kb >= 0)
        __builtin_amdgcn_global_load_lds((const unsigned*)(vg + (size_t)(32 * kb + prow) * dil * 1024 + vsw), (LAS unsigned*)(lds + i * 8192 + wid * 1024), 16, 0, 0); }
    f32x16 o[4];
#pragma unroll
    for (int d0 = 0; d0 < 4; ++d0)
#pragma unroll
        for (int g = 0; g < 16; ++g) o[d0][g] = 0.f;
    const VAddr va = make_vaddr(lane);
    __builtin_amdgcn_s_waitcnt(0x0F70);
    __syncthreads();
#pragma unroll
    for (int di = 0; di < 5; ++di) { const int jj = wid + 4 - di;
        if (kbw + jj >= 0) { lcp vb = lds + jj * 8192;
#pragma unroll
            for (int s = 0; s < 2; ++s)
#pragma unroll
                for (int d0 = 0; d0 < 4; ++d0) o[d0] = MFMA_BF16(vfrag(vb, s, d0, va), __builtin_bit_cast(bf16x8, pw[di][s]), o[d0]); } }
    const float lt = swap_sum(ps), inv = 1.0f / lt;
    bf16_t* OP = (bf16_t*)(ws + (p == 0 ? WS_OP0 : p == 1 ? WS_OP1 : WS_OP2));
#pragma unroll
    for (int d0 = 0; d0 < 4; ++d0)
#pragma unroll
        for (int gg = 0; gg < 4; ++gg) { const size_t off = qrow * 1024 + h * 128 + 32 * d0 + 8 * gg + 4 * hh;
            const unsigned lo = cvtpk(o[d0][4 * gg] * inv, o[d0][4 * gg + 1] * inv), hi = cvtpk(o[d0][4 * gg + 2] * inv, o[d0][4 * gg + 3] * inv);
            *(unsigned long long*)(OP + off) = (unsigned long long)lo | ((unsigned long long)hi << 32); }
    if (hh == 0) ((float*)(ws + WS_LSE))[((size_t)p * M + qrow) * 8 + h] = mx + __builtin_amdgcn_logf(lt);
    __syncthreads();
}
DI void dil_phase(LAS unsigned char* lds, unsigned char* ws, const int tid) {
    for (int u = blockIdx.x; u < 1536; u += gridDim.x) {
        const int cidx = u & 15, h = (u >> 4) & 7, b = (u >> 7) & 3, p = u >> 9;
        const int res = p == 0 ? 0 : p == 1 ? (cidx & 3) : cidx, m0 = p == 0 ? 256 * cidx : p == 1 ? 256 * (cidx >> 2) : 0;
        dil_wg_unit(lds, ws, p, b, h, res, m0, tid);
    }
}
}

__global__ void __launch_bounds__(512, 2) k_mla_fast(Ctx c) { extern __shared__ __attribute__((aligned(16))) unsigned char lds[]; att::mla_phase((LAS unsigned char*)lds, c.ws, (int)threadIdx.x); }
__global__ void __launch_bounds__(512, 2) k_sb_fast(Ctx c) { extern __shared__ __attribute__((aligned(16))) unsigned char lds[]; att::sb_phase<0>((LAS unsigned char*)lds, c.ws, (int)threadIdx.x); }
__global__ void __launch_bounds__(512, 2) k_dil_fast(Ctx c) { extern __shared__ __attribute__((aligned(16))) unsigned char lds[]; att::dil_phase((LAS unsigned char*)lds, c.ws, (int)threadIdx.x); }

DI void final_norm_row(float* out, const float* gain, int row, int lane) {
    f32x4* xr = (f32x4*)(out + (size_t)row * D_MODEL) + lane; const f32x4* g = (const f32x4*)gain + lane;
    f32x4 v[8]; float s = 0.f;
#pragma unroll
    for (int j = 0; j < 8; ++j) { v[j] = xr[64 * j]; s += v[j].x * v[j].x + v[j].y * v[j].y + v[j].z * v[j].z + v[j].w * v[j].w; }
    const float r = rsqrtf(wave_sum(s) * (1.0f / D_MODEL) + EPS);
#pragma unroll
    for (int j = 0; j < 8; ++j) xr[64 * j] = v[j] * r * g[64 * j];
}
__global__ void __launch_bounds__(256) k_final_norm(float* out, const float* gain) { final_norm_row(out, gain, blockIdx.x * 4 + (threadIdx.x >> 6), threadIdx.x & 63); }

#define XB_TMO      128
#define XB_XCNT(j)  (256  + 64 * (j))
#define XB_XSUB(j)  (1280 + 64 * (j))
#define XB_XGEN(j)  (2304 + 64 * (j))
#define XB_TOP      3328
#define XB_TOPGEN   3392
#define XCD_BAR_WORDS 3456
#define XB_SPIN_CAP (1u << 22)
DI unsigned xb_ld(unsigned* p)              { return __hip_atomic_load(p, __ATOMIC_RELAXED, __HIP_MEMORY_SCOPE_AGENT); }
DI unsigned xb_add(unsigned* p, unsigned v) { return __hip_atomic_fetch_add(p, v, __ATOMIC_RELAXED, __HIP_MEMORY_SCOPE_AGENT); }
DI unsigned xb_xcc_id() { return (unsigned)__builtin_amdgcn_s_getreg((3 << 11) | 20) & 0xFu; }
#define XB_SPIN(cond, bar) do { unsigned _sp = 0; while (cond) { __builtin_amdgcn_s_sleep(1); \
    if ((++_sp & 255u) == 0u) { if (xb_ld(&(bar)[XB_TMO])) break; if (_sp > XB_SPIN_CAP) { atomicAdd(&(bar)[XB_TMO], 1u); break; } } } } while (0)
struct XcdBarrier { unsigned* bar; unsigned x; volatile LAS unsigned* st; };
DI XcdBarrier xcd_barrier_post(unsigned* bar, volatile LAS unsigned* st, int tid) {
    XcdBarrier b; b.bar = bar; b.x = xb_xcc_id(); b.st = st;
    if (tid == 0) (void)xb_add(&bar[XB_XCNT(b.x)], 1u);
    return b;
}
DI void xcd_barrier_complete(unsigned* bar, unsigned x, unsigned& nloc, unsigned& nx) {
    const unsigned G = gridDim.x * gridDim.y * gridDim.z;
    unsigned sum, cnt, mine, sp = 0u;
    for (;;) {
        sum = 0u; cnt = 0u; mine = 0u;
#pragma unroll
        for (unsigned j = 0; j < 16; ++j) { const unsigned c = xb_ld(&bar[XB_XCNT(j)]); sum += c; cnt += (c > 0u) ? 1u : 0u; mine = (j == x) ? c : mine; }
        if (sum == G) break;
        __builtin_amdgcn_s_sleep(1);
        if ((++sp & 255u) == 0u) { if (xb_ld(&bar[XB_TMO])) break; if (sp > XB_SPIN_CAP) { atomicAdd(&bar[XB_TMO], 1u); break; } }
    }
    nloc = mine > 0u ? mine : 1u; nx = cnt > 0u ? cnt : 1u;
}
DI void xcd_barrier(const XcdBarrier& b, int tid) {
    asm volatile("s_waitcnt vmcnt(0)" ::: "memory");
    __syncthreads();
    if (tid == 0) {
        unsigned* bar = b.bar;
        __builtin_amdgcn_s_waitcnt(0);
        unsigned nloc = b.st[0], nx = b.st[1];
        if (nloc == 0u) { xcd_barrier_complete(bar, b.x, nloc, nx); b.st[0] = nloc; b.st[1] = nx; }
        const unsigned old = xb_add(&bar[XB_XSUB(b.x)], 1u);
        const unsigned gen = old / nloc;
        if (old + 1u == (gen + 1u) * nloc) {
            __builtin_amdgcn_fence(__ATOMIC_RELEASE, "agent");
            asm volatile("s_waitcnt vmcnt(0)" ::: "memory");
            const unsigned og = xb_add(&bar[XB_TOP], 1u);
            const unsigned tg = og / nx;
            if (og + 1u == (tg + 1u) * nx) xb_add(&bar[XB_TOPGEN], 1u);
            else XB_SPIN(xb_ld(&bar[XB_TOPGEN]) == tg, bar);
            __builtin_amdgcn_fence(__ATOMIC_ACQUIRE, "agent");
            xb_add(&bar[XB_XGEN(b.x)], 1u);
            asm volatile("s_waitcnt vmcnt(0)" ::: "memory");
        } else {
            XB_SPIN(xb_ld(&bar[XB_XGEN(b.x)]) == gen, bar);
            __builtin_amdgcn_fence(__ATOMIC_ACQUIRE, "agent");
            asm volatile("s_waitcnt vmcnt(0)" ::: "memory");
        }
    }
    __syncthreads();
}

constexpr int MEGA_LDS_PHASE = 135168, MEGA_LDS = MEGA_LDS_PHASE + 64;
#ifndef SYNC_PROBE
#define SYNC_PROBE 0
#endif
#ifndef SB_PROBE_VAR
#define SB_PROBE_VAR 0
#endif
#ifndef PROBE_MASK
#define PROBE_MASK 0
#endif
#define PREP(k) for (int rep_ = 0; rep_ < 1 + ((PROBE_MASK >> (k)) & 1); ++rep_)
__global__ void __launch_bounds__(512, 2) k_mega(Ctx c) {
    extern __shared__ __attribute__((aligned(16))) unsigned char lds_raw[];
    LAS unsigned char* lds = (LAS unsigned char*)lds_raw;
    unsigned char* ws = c.ws; const int G = gridDim.x, bx = blockIdx.x;
    const int wave_s = __builtin_amdgcn_readfirstlane((int)threadIdx.x >> 6);
    volatile LAS unsigned* bst = (volatile LAS unsigned*)(lds + MEGA_LDS_PHASE);
    if (threadIdx.x < 16) bst[threadIdx.x] = 0u;
    __syncthreads();
    const XcdBarrier xbar = xcd_barrier_post((unsigned*)(ws + WS_CTL), bst, (int)threadIdx.x);
#define GRID_BAR() xcd_barrier(xbar, phase_tid(wave_s))
    PREP(0) { prep_phase<8, 0>(c, (float*)lds_raw, phase_tid(wave_s)); __syncthreads(); }
    GRID_BAR();
    PREP(1) { pg8::Gemm g{(const bf16_t*)(ws + WS_H0), (const bf16_t*)(ws + WS_WT_IN_E), M, IN_EVEN_PAD, 2048}; pg8::StaticOrder S; S.init(g.M, g.N, G, bx);
      pg8::gemm_phase<pg8::FEpi1, pg8::StaticOrder, true, true>(lds, g, S, pg8::FEpi1{ws}, phase_tid(wave_s)); }
    { const int nlast = (M / 256) * (IN_EVEN_PAD / 256) % G; const int nfree = nlast ? G - nlast : G, me = nlast ? bx - nlast : bx;
      if (me >= 0) { const int tid = phase_tid(wave_s); prep_weights<1>(c, (float*)lds_raw + (tid >> 6) * 64 * 36, tid & 63, me * 8 + (tid >> 6), nfree * 8); } }
    GRID_BAR();
    PREP(2) { att::dil_phase(lds, ws, phase_tid(wave_s));
    __syncthreads(); }
    PREP(7) { pg8::Gemm g{(const bf16_t*)(ws + WS_CQ), (const bf16_t*)(ws + WS_WT_UQ), M, 1536, 512}; pg8::StaticOrder S; S.init(g.M, g.N, G, bx);
      pg8::gemm_phase<pg8::FEpi2a, pg8::StaticOrder, true, true>(lds, g, S, pg8::FEpi2a{ws}, phase_tid(wave_s)); }
    PREP(7) { pg8::Gemm g{(const bf16_t*)(ws + WS_CKV), (const bf16_t*)(ws + WS_WT_UKV), M, 2048, 512}; pg8::StaticOrder S; S.init(g.M, g.N, G, bx);
      pg8::gemm_phase<pg8::FEpi2b, pg8::StaticOrder, true, true>(lds, g, S, pg8::FEpi2b{ws}, phase_tid(wave_s)); }
    GRID_BAR();
    PREP(3) att::mla_phase(lds, ws, phase_tid(wave_s));
    PREP(8) { const int tid = phase_tid(wave_s); for (int it = bx * 512 + tid; it < M * 128; it += G * 512) dil_merge_item(ws, it >> 7, (it & 127) * 8); }
    GRID_BAR();
    PREP(4) { pg8::Gemm g{(const bf16_t*)(ws + WS_MIX), (const bf16_t*)(ws + WS_WT_OUT_E), M, 2048, 2048}; pg8::StaticOrder S; S.init(g.M, g.N, G, bx);
      pg8::gemm_phase<pg8::FEpi4, pg8::StaticOrder, true, true>(lds, g, S, pg8::FEpi4{ws, c.x, c.out}, phase_tid(wave_s)); }
    GRID_BAR();
    PREP(5) { pg8::Gemm g{(const bf16_t*)(ws + WS_X1BF), (const bf16_t*)(ws + WS_WT_IN_O), M, IN_ODD, 2048}; pg8::StaticOrder S; S.init(g.M, g.N, G, bx);
      pg8::gemm_phase<pg8::FEpi5, pg8::StaticOrder, true, true>(lds, g, S, pg8::FEpi5{ws}, phase_tid(wave_s)); }
    GRID_BAR();
    PREP(6) att::sb_phase<0>(lds, ws, phase_tid(wave_s));
#if SB_PROBE_VAR
    att::sb_phase<SB_PROBE_VAR>(lds, ws, phase_tid(wave_s));
#endif
    GRID_BAR();
    { pg8::Gemm g{(const bf16_t*)(ws + WS_MIX2), (const bf16_t*)(ws + WS_WT_OUT_O), M, 2048, 2048}; pg8::StaticOrder S; S.init(g.M, g.N, G, bx);
      pg8::gemm_phase<pg8::FEpi7, pg8::StaticOrder, true, true>(lds, g, S, pg8::FEpi7{c.out, (const bf16_t*)(ws + WS_X1BF)}, phase_tid(wave_s)); }
    GRID_BAR();
#if SYNC_PROBE
    for (int i_ = 0; i_ < 8; ++i_) GRID_BAR();
#endif
    { const int tid = phase_tid(wave_s); for (int row = bx * 8 + (tid >> 6); row < M; row += G * 8) final_norm_row(c.out, c.final_gain, row, tid & 63); }
}

#ifndef MK_ONE_LAUNCH
#define MK_ONE_LAUNCH 1
#endif
#ifndef FAST_G1
#define FAST_G1 1
#endif
#ifndef FAST_G2
#define FAST_G2 1
#endif
#ifndef FAST_G4
#define FAST_G4 1
#endif
#ifndef FAST_G5
#define FAST_G5 1
#endif
#ifndef FAST_G7
#define FAST_G7 1
#endif
#ifndef FAST_MLA
#define FAST_MLA 1
#endif
#ifndef FAST_SB
#define FAST_SB 1
#endif
#ifndef FAST_DIL
#define FAST_DIL 1
#endif
static void launch_att(void (*k)(Ctx), int lds_bytes, const Ctx& c, hipStream_t s) {
    (void)hipFuncSetAttribute((const void*)k, hipFuncAttributeMaxDynamicSharedMemorySize, lds_bytes);
    hipLaunchKernelGGL(k, dim3(256), dim3(512), lds_bytes, s, c);
}
template <class Epi> static void launch_gemm_fast(const bf16_t* A, const bf16_t* Bt, int N, int K, Epi E, hipStream_t s) {
    static bool attr = false; if (!attr) { (void)hipFuncSetAttribute((const void*)k_gemm_fast<Epi>, hipFuncAttributeMaxDynamicSharedMemorySize, 131072); attr = true; }
    pg8::Gemm g{A, Bt, M, N, K};
    k_gemm_fast<Epi><<<256, 512, 131072, s>>>(g, E);
}

extern "C" void kernel_launch(void* const* d_in, const int* in_sizes, int n_in, void* d_out, int out_size, void* d_ws, size_t ws_size, hipStream_t stream) {
    if (n_in != 12 || out_size != M * D_MODEL || ws_size < WS_END) { fprintf(stderr, "kernel_launch: unexpected shapes (n_in %d out %d ws %zu)\n", n_in, out_size, ws_size); return; }
    Ctx c{};
    c.x = (const float*)d_in[0]; c.norm_gain = (const float*)d_in[1]; c.w_in_even = (const float*)d_in[2]; c.q_norm_gain = (const float*)d_in[3]; c.kv_norm_gain = (const float*)d_in[4];
    c.w_uq = (const float*)d_in[5]; c.w_ukv = (const float*)d_in[6]; c.w_out_even = (const float*)d_in[7]; c.rel_bias = (const float*)d_in[8]; c.w_in_odd = (const float*)d_in[9];
    c.w_out_odd = (const float*)d_in[10]; c.final_gain = (const float*)d_in[11]; c.out = (float*)d_out; c.ws = (unsigned char*)d_ws;
#if MK_ONE_LAUNCH
    static int grid_blocks = 0;
    if (!grid_blocks) {
        int dev = 0, cus = 0, per_cu = 0;
        (void)hipGetDevice(&dev); (void)hipDeviceGetAttribute(&cus, hipDeviceAttributeMultiprocessorCount, dev);
        (void)hipFuncSetAttribute((const void*)k_mega, hipFuncAttributeMaxDynamicSharedMemorySize, MEGA_LDS);
        (void)hipOccupancyMaxActiveBlocksPerMultiprocessor(&per_cu, (const void*)k_mega, 512, MEGA_LDS);
        if (per_cu < 1) { fprintf(stderr, "kernel_launch: occupancy query says %d blocks/CU\n", per_cu); per_cu = 1; }
        grid_blocks = cus;
    }
    (void)hipMemsetAsync((char*)d_ws + WS_CTL, 0, 65536, stream);
    { void* args[] = {&c};
      hipError_t e = hipLaunchCooperativeKernel((void*)k_mega, dim3(grid_blocks), dim3(512), args, MEGA_LDS, stream);
      if (e != hipSuccess) fprintf(stderr, "cooperative launch failed: %s (grid %d)\n", hipGetErrorString(e), grid_blocks); }
    return;
#endif
    unsigned char* ws = c.ws;
    const float* rc = (const float*)(ws + WS_ROPE); const float* rs = rc + 4096 * 32;
    k_prep<<<2048, 256, 0, stream>>>(c);
#if FAST_G1
    launch_gemm_fast((const bf16_t*)(ws + WS_H0), (const bf16_t*)(ws + WS_WT_IN_E), IN_EVEN_PAD, 2048, pg8::FEpi1{ws}, stream);
#else
    k_gemm_naive<Epi1><<<(M / 64) * (IN_EVEN_PAD / 64), 256, 0, stream>>>((const bf16_t*)(ws + WS_H0), (const bf16_t*)(ws + WS_WT_IN_E), IN_EVEN_PAD, 2048, Epi1{ws});
    k_rowss<false><<<M / 4, 256, 0, stream>>>(ws + WS_CQ, 512, 512, (float*)(ws + WS_SSC), 16, 8);
    k_rowss<false><<<M / 4, 256, 0, stream>>>(ws + WS_CKV, 512, 512, (float*)(ws + WS_SSC) + 8, 16, 8);
    k_rope<<<(M * 32 + 255) / 256, 256, 0, stream>>>((bf16_t*)(ws + WS_KR), 1, rc, rs);
#endif
#if FAST_DIL
    launch_att(k_dil_fast, att::DIL_LDS_BYTES, c, stream);
#else
    k_dil_naive<<<BATCH * 8 * SEQ / 4, 256, 0, stream>>>(c);
#endif
#if FAST_G2
    launch_gemm_fast((const bf16_t*)(ws + WS_CQ), (const bf16_t*)(ws + WS_WT_UQ), 1536, 512, pg8::FEpi2a{ws}, stream);
    launch_gemm_fast((const bf16_t*)(ws + WS_CKV), (const bf16_t*)(ws + WS_WT_UKV), 2048, 512, pg8::FEpi2b{ws}, stream);
#else
    k_gemm_naive<Epi2a><<<(M / 64) * (1536 / 64), 256, 0, stream>>>((const bf16_t*)(ws + WS_CQ), (const bf16_t*)(ws + WS_WT_UQ), 1536, 512, Epi2a{ws});
    k_rope<<<(M * 256 + 255) / 256, 256, 0, stream>>>((bf16_t*)(ws + WS_QR), 8, rc, rs);
    k_gemm_naive<Epi2b><<<(M / 64) * (2048 / 64), 256, 0, stream>>>((const bf16_t*)(ws + WS_CKV), (const bf16_t*)(ws + WS_WT_UKV), 2048, 512, Epi2b{ws});
#endif
#if FAST_MLA
    launch_att(k_mla_fast, att::M2_LDS_BYTES > att::MLA_LDS_BYTES ? att::M2_LDS_BYTES : att::MLA_LDS_BYTES, c, stream);
#else
    k_mla_naive<<<BATCH * 8 * SEQ / 4, 256, 0, stream>>>(c);
#endif
    k_dil_merge<<<M, 128, 0, stream>>>(c);
#if FAST_G4
    launch_gemm_fast((const bf16_t*)(ws + WS_MIX), (const bf16_t*)(ws + WS_WT_OUT_E), 2048, 2048, pg8::FEpi4{ws, c.x, c.out}, stream);
#else
    k_gemm_naive<Epi4><<<(M / 64) * (2048 / 64), 256, 0, stream>>>((const bf16_t*)(ws + WS_MIX), (const bf16_t*)(ws + WS_WT_OUT_E), 2048, 2048, Epi4{ws, c.x, c.out});
    k_rowss<true><<<M / 4, 256, 0, stream>>>(c.out, 2048, 2048, (float*)(ws + WS_SSX1), 32, 32);
#endif
#if FAST_G5
    launch_gemm_fast((const bf16_t*)(ws + WS_X1BF), (const bf16_t*)(ws + WS_WT_IN_O), IN_ODD, 2048, pg8::FEpi5{ws}, stream);
#else
    k_gemm_naive<Epi5><<<(M / 64) * (IN_ODD / 64), 256, 0, stream>>>((const bf16_t*)(ws + WS_X1BF), (const bf16_t*)(ws + WS_WT_IN_O), IN_ODD, 2048, Epi5{ws});
#endif
#if FAST_SB
    launch_att(k_sb_fast, att::SB_LDS_BYTES, c, stream);
#else
    k_sb_naive<<<BATCH * 16 * SEQ / 4, 256, 0, stream>>>(c);
#endif
#if FAST_G7
    launch_gemm_fast((const bf16_t*)(ws + WS_MIX2), (const bf16_t*)(ws + WS_WT_OUT_O), 2048, 2048, pg8::FEpi7{c.out, (const bf16_t*)(ws + WS_X1BF)}, stream);
#else
    k_gemm_naive<Epi7><<<(M / 64) * (2048 / 64), 256, 0, stream>>>((const bf16_t*)(ws + WS_MIX2), (const bf16_t*)(ws + WS_WT_OUT_O), 2048, 2048, Epi7{c.out});
#endif
    k_final_norm<<<M / 4, 256, 0, stream>>>(c.out, c.final_gain);
}
```

```cpp
#include <hip/hip_runtime.h>
#include <cstdio>
#include <cstdint>
#include <cmath>

typedef unsigned short bf16_t;
typedef unsigned u32x4 __attribute__((ext_vector_type(4)));
typedef float f32x4 __attribute__((ext_vector_type(4)));

constexpr int D_MODEL = 2048, BATCH = 4, SEQ = 4096, M = BATCH * SEQ;
constexpr int NH_MLA = 8, NH_DIL = 8, NH_SB = 16, HD = 128;
constexpr int IN_EVEN = 6208, IN_EVEN_PAD = 6400, IN_ODD = 8192;
constexpr float EPS = 1e-6f;
constexpr float LOG2E = 1.4426950408889634f;
constexpr float MLA_QSCALE = 0.07216878364870322f * LOG2E;
constexpr float D128_QSCALE = 0.08838834764831845f * LOG2E;

constexpr size_t MiB = 1u << 20;
constexpr size_t WS_CTL = 0;
constexpr size_t WS_ROPE = 1 * MiB;
constexpr size_t WS_BIASN = 2 * MiB;
constexpr size_t WS_BIASC = 2 * MiB + 65536;
constexpr size_t WS_SSX = 3 * MiB;
constexpr size_t WS_SSC = 4 * MiB;
constexpr size_t WS_SSX1 = 5 * MiB;
constexpr size_t WS_LSE = 9 * MiB;
constexpr size_t WS_WT_IN_E = 12 * MiB;
constexpr size_t WS_WT_UQ = 37 * MiB;
constexpr size_t WS_WT_UKV = 39 * MiB;
constexpr size_t WS_WT_OUT_E = 41 * MiB;
constexpr size_t WS_WT_IN_O = 49 * MiB;
constexpr size_t WS_WT_OUT_O = 81 * MiB;
constexpr size_t WS_A = 90 * MiB;
constexpr size_t WS_B = 154 * MiB;
constexpr size_t WS_C = 218 * MiB;
constexpr size_t WS_H0 = WS_A, WS_OP0 = WS_A, WS_OP1 = WS_A + 32 * MiB, WS_X1BF = WS_A;
constexpr size_t WS_CQ = WS_B, WS_CKV = WS_B + 16 * MiB, WS_QB = WS_B + 32 * MiB, WS_MIX = WS_B, WS_MIX2 = WS_B;
constexpr size_t WS_KB = WS_C, WS_VB = WS_C + 32 * MiB, WS_SG = WS_C + 64 * MiB, WS_QN = WS_C + 128 * MiB, WS_QR = WS_C + 160 * MiB,
                 WS_KN = WS_C + 176 * MiB, WS_VA = WS_C + 208 * MiB, WS_KR = WS_C + 240 * MiB, WS_OP2 = WS_C + 242 * MiB;
constexpr size_t WS_X2BF = WS_C;
constexpr size_t WS_Q2 = WS_C, WS_K2 = WS_C + 64 * MiB, WS_V2 = WS_C + 128 * MiB, WS_SG2 = WS_C + 192 * MiB;
constexpr size_t WS_END = WS_C + 274 * MiB;

struct Ctx {
    const float *x, *norm_gain, *w_in_even, *q_norm_gain, *kv_norm_gain, *w_uq, *w_ukv, *w_out_even, *rel_bias, *w_in_odd, *w_out_odd, *final_gain;
    float* out; unsigned char* ws;
};

#define DI __device__ __forceinline__
DI int phase_tid(int wave_s) { int lane; asm volatile("v_mbcnt_lo_u32_b32 %0, -1, 0\n\tv_mbcnt_hi_u32_b32 %0, -1, %0" : "=v"(lane)); return wave_s * 64 + lane; }
DI float bf2f(bf16_t v) { return __uint_as_float(((unsigned)v) << 16); }
DI bf16_t f2bf(float f) { unsigned u = __float_as_uint(f); return (bf16_t)((u + 0x7fffu + ((u >> 16) & 1u)) >> 16); }
DI float wave_sum(float v) {
#pragma unroll
    for (int o = 1; o < 64; o <<= 1) v += __shfl_xor(v, o);
    return v;
}
DI float wave_max(float v) {
#pragma unroll
    for (int o = 1; o < 64; o <<= 1) v = fmaxf(v, __shfl_xor(v, o));
    return v;
}
DI float silu_f(float v) { return v / (1.0f + __expf(-v)); }

DI int map_in_even(int n) { if (n < 1024) return n; if (n < 1056) return 1024 + (n - 1024); if (n < 1088) return 1152 + (n - 1056); return n - 1088 + 1280; }
DI int map_uq(int n) { const int h = n / 192, j = n % 192; if (j < 128) return h * 128 + j; if (j < 160) return 1024 + (h >> 2) * 256 + (h & 3) * 32 + (j - 128);
    return 1024 + (h >> 2) * 256 + 128 + (h & 3) * 32 + (j - 160); }
DI int map_ukv(int n) { const int h = n / 256, j = n % 256; if (j < 128) return h * 128 + j; return 1024 + h * 128 + (j - 128); }
DI int map_id(int n) { return n; }

template <int MAPID>
DI void transpose_item(const float* W, int K, int N, const float* gain, bf16_t* WT, float* scr  , int item, int lane) {
    const int nblk = N / 32, kb = item / nblk, nb = item % nblk, k0 = 64 * kb, n0 = 32 * nb;
    f32x4 v[8];
#pragma unroll
    for (int i = 0; i < 8; ++i) { const int kk = 8 * i + (lane >> 3); v[i] = *(const f32x4*)(W + (size_t)(k0 + kk) * N + n0 + 4 * (lane & 7)); }
#pragma unroll
    for (int i = 0; i < 8; ++i) { const int kk = 8 * i + (lane >> 3); const float g = gain ? gain[k0 + kk] : 1.0f; *(f32x4*)(scr + kk * 36 + 4 * (lane & 7)) = v[i] * g; }
    asm volatile("s_waitcnt lgkmcnt(0)" ::: "memory");
    const int d0 = MAPID == 0 ? map_in_even(n0) : MAPID == 1 ? map_uq(n0) : MAPID == 2 ? map_ukv(n0) : map_id(n0);
    const int c = lane & 7;
#pragma unroll
    for (int j = 0; j < 4; ++j) { const int n = (lane >> 3) + 8 * j; const float* s = scr + (8 * c) * 36 + n;
        u32x4 o; o.x = f2bf(s[0]) | ((unsigned)f2bf(s[36]) << 16); o.y = f2bf(s[72]) | ((unsigned)f2bf(s[108]) << 16);
        o.z = f2bf(s[144]) | ((unsigned)f2bf(s[180]) << 16); o.w = f2bf(s[216]) | ((unsigned)f2bf(s[252]) << 16);
        *(u32x4*)(WT + (size_t)(d0 + n) * K + k0 + 8 * c) = o; }
    asm volatile("s_waitcnt lgkmcnt(0)" ::: "memory");
}

DI int t5_bucket(int dist) {
    if (dist < 16) return dist;
    float d = (float)dist;
    int large = 16 + (int)(logf(d / 16.0f) / 4.852030263919617f * 16.0f);
    return large < 31 ? large : 31;
}

template <int PART> DI void prep_weights(const Ctx& c, float* scr, int lane, int gw, int NGW) {
    unsigned char* ws = c.ws;
    constexpr int I0 = (2048 / 64) * (IN_EVEN / 32), I1 = (512 / 64) * (1536 / 32), I2 = (512 / 64) * (2048 / 32), I3 = (2048 / 64) * (2048 / 32),
                  I4 = (2048 / 64) * (IN_ODD / 32), I5 = I3;
    constexpr int LO = PART == 1 ? I0 : 0, HI = PART == 0 ? I0 : I0 + I1 + I2 + I3 + I4 + I5;
    for (int it = LO + gw; it < HI; it += NGW) {
        int r = it;
        if (r < I0) { transpose_item<0>(c.w_in_even, 2048, IN_EVEN, c.norm_gain, (bf16_t*)(ws + WS_WT_IN_E), scr, r, lane); continue; } r -= I0;
        if (r < I1) { transpose_item<1>(c.w_uq, 512, 1536, c.q_norm_gain, (bf16_t*)(ws + WS_WT_UQ), scr, r, lane); continue; } r -= I1;
        if (r < I2) { transpose_item<2>(c.w_ukv, 512, 2048, c.kv_norm_gain, (bf16_t*)(ws + WS_WT_UKV), scr, r, lane); continue; } r -= I2;
        if (r < I3) { transpose_item<3>(c.w_out_even, 2048, 2048, nullptr, (bf16_t*)(ws + WS_WT_OUT_E), scr, r, lane); continue; } r -= I3;
        if (r < I4) { transpose_item<3>(c.w_in_odd, 2048, IN_ODD, c.norm_gain + 2048, (bf16_t*)(ws + WS_WT_IN_O), scr, r, lane); continue; } r -= I4;
        transpose_item<3>(c.w_out_odd, 2048, 2048, nullptr, (bf16_t*)(ws + WS_WT_OUT_O), scr, r, lane);
    }
}
template <int NW, int PART> DI void prep_phase(const Ctx& c, float* scr_all, const int tid) {
    const int lane = tid & 63, wave = tid >> 6;
    float* scr = scr_all + wave * 64 * 36;
    const int gw = blockIdx.x * NW + wave, NGW = gridDim.x * NW;
    unsigned char* ws = c.ws;
    prep_weights<PART>(c, scr, lane, gw, NGW);
    const int gt = blockIdx.x * (NW * 64) + tid, NGT = gridDim.x * (NW * 64);
    { bf16_t* wt = (bf16_t*)(ws + WS_WT_IN_E);
      for (int i = gt; i < 192 * 256; i += NGT) { const int rr = i / 256, cc = i % 256; const int row = rr < 96 ? 1056 + rr : 1184 + (rr - 96);
          *(u32x4*)(wt + (size_t)row * 2048 + cc * 8) = (u32x4){0u, 0u, 0u, 0u}; } }
    { float* rc = (float*)(ws + WS_ROPE); float* rs = rc + 4096 * 32;
      for (int i = gt; i < 4096 * 32; i += NGT) { const int pos = i >> 5, j = i & 31; const float inv = 1.0f / powf(10000.0f, (float)j / 32.0f); const float ang = (float)pos * inv;
          rc[i] = cosf(ang); rs[i] = sinf(ang); } }
    { float* bn = (float*)(ws + WS_BIASN);
      for (int i = gt; i < 3 * 8 * 132; i += NGT) { const int p = i / (8 * 132), h = (i / 132) % 8, rel = i % 132; const int dil = p == 0 ? 1 : p == 1 ? 4 : 16;
          bn[i] = rel <= 128 ? c.rel_bias[t5_bucket(rel * dil) * 8 + h] * LOG2E : 0.f; } }
    { float* bc = (float*)(ws + WS_BIASC);
      for (int i = gt; i < 3 * 8 * 5 * 1024; i += NGT) { const int g = i & 15, ln = (i >> 4) & 63, di = (i >> 10) % 5, ph = i / 5120, h = ph & 7, p = ph >> 3; const int dil = p == 0 ? 1 : p == 1 ? 4 : 16;
          const int rel = 32 * di + (ln & 31) - ((g & 3) + 8 * (g >> 2) + 4 * (ln >> 5));
          bc[i] = (rel >= 0 && rel <= 128) ? c.rel_bias[t5_bucket(rel * dil) * 8 + h] * LOG2E : -INFINITY; } }
    { bf16_t* h0 = (bf16_t*)(ws + WS_H0); float* ssx = (float*)(ws + WS_SSX);
      for (int m = gw; m < M; m += NGW) { const f32x4* xr = (const f32x4*)(c.x + (size_t)m * D_MODEL) + lane; float s = 0.f;
          unsigned long long* o8 = (unsigned long long*)(h0 + (size_t)m * D_MODEL) + lane;
          for (int j = 0; j < 8; ++j) { const f32x4 v = xr[64 * j]; s += v.x * v.x + v.y * v.y + v.z * v.z + v.w * v.w;
              o8[64 * j] = (unsigned long long)(f2bf(v.x) | ((unsigned)f2bf(v.y) << 16)) | ((unsigned long long)(f2bf(v.z) | ((unsigned)f2bf(v.w) << 16)) << 32); }
          s = wave_sum(s); if (lane == 0) ssx[m] = s; } }
}

__global__ void __launch_bounds__(256) k_prep(Ctx c) { __shared__ float scr_all[4 * 64 * 36]; prep_phase<4, 2>(c, scr_all, (int)threadIdx.x); }

DI float rscale(const float* part, int n, float inv_cols) { float s = 0.f; for (int i = 0; i < n; ++i) s += part[i]; return rsqrtf(s * inv_cols + EPS); }

struct Epi1 {
    unsigned char* ws;
    DI void operator()(int row, int col, float acc) const {
        const float v = acc * rsqrtf(((const float*)(ws + WS_SSX))[row] * (1.0f / 2048.0f) + EPS);
        if (col < 512) ((bf16_t*)(ws + WS_CQ))[(size_t)row * 512 + col] = f2bf(v);
        else if (col < 1024) ((bf16_t*)(ws + WS_CKV))[(size_t)row * 512 + col - 512] = f2bf(v);
        else if (col < 1280) { const int t = col - 1024; if (t < 32) ((bf16_t*)(ws + WS_KR))[(size_t)row * 64 + t] = f2bf(v); else if (t >= 128 && t < 160) ((bf16_t*)(ws + WS_KR))[(size_t)row * 64 + 32 + t - 128] = f2bf(v); }
        else if (col < 2304) ((bf16_t*)(ws + WS_QB))[(size_t)row * 1024 + col - 1280] = f2bf(v * D128_QSCALE);
        else if (col < 3328) ((bf16_t*)(ws + WS_KB))[(size_t)row * 1024 + col - 2304] = f2bf(v);
        else if (col < 4352) ((bf16_t*)(ws + WS_VB))[(size_t)row * 1024 + col - 3328] = f2bf(v);
        else ((bf16_t*)(ws + WS_SG))[(size_t)row * 2048 + col - 4352] = f2bf(silu_f(v));
    }
};
struct Epi2a {
    unsigned char* ws;
    DI void operator()(int row, int col, float acc) const {
        const float v = acc * rscale((const float*)(ws + WS_SSC) + (size_t)row * 16, 8, 1.0f / 512.0f) * MLA_QSCALE;
        if (col < 1024) ((bf16_t*)(ws + WS_QN))[(size_t)row * 1024 + col] = f2bf(v);
        else { const int t = col - 1024, grp = t >> 8, u = t & 255, half = u >> 7, hh = (u & 127) >> 5, i = u & 31;
            ((bf16_t*)(ws + WS_QR))[(size_t)row * 512 + (4 * grp + hh) * 64 + half * 32 + i] = f2bf(v); }
    }
};
struct Epi2b {
    unsigned char* ws;
    DI void operator()(int row, int col, float acc) const {
        const float v = acc * rscale((const float*)(ws + WS_SSC) + (size_t)row * 16 + 8, 8, 1.0f / 512.0f);
        if (col < 1024) ((bf16_t*)(ws + WS_KN))[(size_t)row * 1024 + col] = f2bf(v); else ((bf16_t*)(ws + WS_VA))[(size_t)row * 1024 + col - 1024] = f2bf(v);
    }
};
struct Epi4 {
    unsigned char* ws; const float* x; float* out;
    DI void operator()(int row, int col, float acc) const {
        const float v = x[(size_t)row * 2048 + col] + acc; out[(size_t)row * 2048 + col] = v; ((bf16_t*)(ws + WS_X1BF))[(size_t)row * 2048 + col] = f2bf(v);
    }
};
struct Epi5 {
    unsigned char* ws;
    DI void operator()(int row, int col, float acc) const {
        const float v = acc * rscale((const float*)(ws + WS_SSX1) + (size_t)row * 32, 32, 1.0f / 2048.0f);
        if (col < 2048) ((bf16_t*)(ws + WS_Q2))[(size_t)row * 2048 + col] = f2bf(v * D128_QSCALE);
        else if (col < 4096) ((bf16_t*)(ws + WS_K2))[(size_t)row * 2048 + col - 2048] = f2bf(v);
        else if (col < 6144) ((bf16_t*)(ws + WS_V2))[(size_t)row * 2048 + col - 4096] = f2bf(v);
        else ((bf16_t*)(ws + WS_SG2))[(size_t)row * 2048 + col - 6144] = f2bf(silu_f(v));
    }
};
struct Epi7 {
    float* out;
    DI void operator()(int row, int col, float acc) const { out[(size_t)row * 2048 + col] += acc; }
};

namespace pg8 {
#define PG8_LAS __attribute__((address_space(3)))
typedef short bf16x8 __attribute__((ext_vector_type(8)));
constexpr int BM = 256, BK = 64, HALF = 128, HTB = HALF * BK * 2  , STAGE_BYTES = 8 * HTB, NXCD = 8, WGM = 8;

__host__ __device__ __forceinline__ int lds_byte(int r, int c) { const int st = (r >> 4) * 2 + (c >> 5), rr = r & 15, cc = c & 31, ob = rr * 64 + cc * 2; return st * 1024 + (ob ^ (((ob >> 9) & 1) << 5)); }
__host__ __device__ __forceinline__ void stage_rc(int b, int& R, int& C) { const int st = b / 1024, sb = b % 1024, swz = sb ^ (((sb >> 9) & 1) << 5); R = (st >> 1) * 16 + swz / 64; C = (st & 1) * 32 + (swz % 64) / 2; }
__host__ __device__ __forceinline__ int perm32(int rho) { const int n = rho >> 4, i = rho & 15; return 8 * (i >> 2) + 4 * n + (i & 3); }

struct Unit { int pm, pn; };
struct Gemm { const bf16_t* A; const bf16_t* Bt; int M, N, K; };

struct StaticOrder {
    int nM, nN, nwg, G, c;
    __host__ __device__ void init(int M, int N, int G_, int c_) { nM = M / BM; nN = N / BM; nwg = nM * nN; G = G_; c = c_; }
    __host__ __device__ bool next(int i, Unit& u) const {
        const long L = (long)i * G + c; if (L >= nwg) return false;
        int wgid = (int)L; { const int q = nwg / NXCD, r = nwg % NXCD, xcd = wgid % NXCD, off = wgid / NXCD; wgid = (xcd < r ? xcd * (q + 1) : r * (q + 1) + (xcd - r) * q) + off; }
        const int nig = WGM * nN, gid = wgid / nig, fm = gid * WGM, gsz = (nM - fm) < WGM ? (nM - fm) : WGM;
        u.pm = fm + ((wgid % nig) % gsz); u.pn = (wgid % nig) / gsz; return true;
    }
    __device__ __forceinline__ void a_ready(const Unit&) const {}
    __device__ __forceinline__ void done(const Unit&) const {}
};


typedef float f32x2_t __attribute__((ext_vector_type(2))); typedef __bf16 bf16x2_t __attribute__((ext_vector_type(2)));
__device__ __forceinline__ unsigned cvtpk(float lo, float hi) { f32x2_t v = {lo, hi}; bf16x2_t b = __builtin_convertvector(v, bf16x2_t); return __builtin_bit_cast(unsigned, b); }
__device__ __forceinline__ u32x4 pack8(const f32x4& a, const f32x4& b) { u32x4 w; w.x = cvtpk(a[0], a[1]); w.y = cvtpk(a[2], a[3]); w.z = cvtpk(b[0], b[1]); w.w = cvtpk(b[2], b[3]); return w; }
__device__ __forceinline__ float sumsq4(const f32x4& a) { return (a[0] * a[0] + a[1] * a[1]) + (a[2] * a[2] + a[3] * a[3]); }
__device__ __forceinline__ float silu1(float v) { return v * __builtin_amdgcn_rcpf(1.0f + __builtin_amdgcn_exp2f(-v * LOG2E)); }
__device__ __forceinline__ f32x4 silu4(const f32x4& a) { return (f32x4){silu1(a[0]), silu1(a[1]), silu1(a[2]), silu1(a[3])}; }
__device__ __forceinline__ float quad_sum(float s) { s += __shfl_xor(s, 16); s += __shfl_xor(s, 32); return s; }
__device__ __forceinline__ void rope8(const f32x4& a0, const f32x4& a1, const f32x4& b0, const f32x4& b1, const float* rc, const float* rs, int pos, int i0, u32x4& o1, u32x4& o2) {
    const f32x4 c0 = *(const f32x4*)(rc + pos * 32 + i0), c1 = *(const f32x4*)(rc + pos * 32 + i0 + 4), s0 = *(const f32x4*)(rs + pos * 32 + i0), s1 = *(const f32x4*)(rs + pos * 32 + i0 + 4);
    o1 = pack8(a0 * c0 - b0 * s0, a1 * c1 - b1 * s1); o2 = pack8(a0 * s0 + b0 * c0, a1 * s1 + b1 * c1);
}
#define PG8_EPI_ROWS(...) _Pragma("unroll") for (int ai = 0; ai < 2; ++ai) _Pragma("unroll") for (int m = 0; m < 4; ++m) { const int row = u.pm * BM + ai * HALF + wr * 64 + m * 16 + fr; __VA_ARGS__ }

struct FEpi1 {
    static constexpr bool PERM = true, AFTER_DRAIN = false; unsigned char* ws;
    __device__ __forceinline__ void operator()(const f32x4 (&acc)[2][2][4][2], const Unit& u, int wr, int wc, int fr, int fq) const {
        const int pn = u.pn, cw = wc * 32 + 8 * fq; const float* ssx = (const float*)(ws + WS_SSX);
        PG8_EPI_ROWS(
            const float rs = rsqrtf(ssx[row] * (1.0f / 2048.0f) + EPS);
            if (pn < 4) { bf16_t* dst = (bf16_t*)(ws + (pn < 2 ? WS_CQ : WS_CKV)) + (size_t)row * 512 + (pn & 1) * 256 + cw; float ss = 0.f;
                _Pragma("unroll") for (int bj = 0; bj < 2; ++bj) { const f32x4 v0 = acc[ai][bj][m][0] * rs, v1 = acc[ai][bj][m][1] * rs; ss += sumsq4(v0) + sumsq4(v1); *(u32x4*)(dst + bj * HALF) = pack8(v0, v1); }
                ss = quad_sum(ss); if (fq == 0) ((float*)(ws + WS_SSC))[(size_t)row * 16 + pn * 4 + wc] = ss; }
            else if (pn == 4) { if (wc == 0) { const float* rc = (const float*)(ws + WS_ROPE); u32x4 o1, o2;
                rope8(acc[ai][0][m][0] * rs, acc[ai][0][m][1] * rs, acc[ai][1][m][0] * rs, acc[ai][1][m][1] * rs, rc, rc + 4096 * 32, row % SEQ, 8 * fq, o1, o2);
                bf16_t* dst = (bf16_t*)(ws + WS_KR) + (size_t)row * 64 + 8 * fq; *(u32x4*)dst = o1; *(u32x4*)(dst + 32) = o2; } }
            else if (pn < 17) { const int t = pn - 5; bf16_t* dst = (bf16_t*)(ws + (t < 4 ? WS_QB : t < 8 ? WS_KB : WS_VB)) + (size_t)row * 1024 + (t & 3) * 256 + cw; const float sc = t < 4 ? rs * D128_QSCALE : rs;
                _Pragma("unroll") for (int bj = 0; bj < 2; ++bj) *(u32x4*)(dst + bj * HALF) = pack8(acc[ai][bj][m][0] * sc, acc[ai][bj][m][1] * sc); }
            else { bf16_t* dst = (bf16_t*)(ws + WS_SG) + (size_t)row * 2048 + (pn - 17) * 256 + cw;
                _Pragma("unroll") for (int bj = 0; bj < 2; ++bj) *(u32x4*)(dst + bj * HALF) = pack8(silu4(acc[ai][bj][m][0] * rs), silu4(acc[ai][bj][m][1] * rs)); }
        )
    }
};
struct FEpi2a {
    static constexpr bool PERM = true, AFTER_DRAIN = false; unsigned char* ws;
    __device__ __forceinline__ void operator()(const f32x4 (&acc)[2][2][4][2], const Unit& u, int wr, int wc, int fr, int fq) const {
        const int pn = u.pn, cw = wc * 32 + 8 * fq;
        PG8_EPI_ROWS(
            const f32x4* sp = (const f32x4*)((const float*)(ws + WS_SSC) + (size_t)row * 16); const f32x4 p0 = sp[0], p1 = sp[1];
            const float rs = rsqrtf(((p0[0] + p0[1]) + (p0[2] + p0[3]) + (p1[0] + p1[1]) + (p1[2] + p1[3])) * (1.0f / 512.0f) + EPS) * MLA_QSCALE;
            if (pn < 4) { bf16_t* dst = (bf16_t*)(ws + WS_QN) + (size_t)row * 1024 + pn * 256 + cw;
                _Pragma("unroll") for (int bj = 0; bj < 2; ++bj) *(u32x4*)(dst + bj * HALF) = pack8(acc[ai][bj][m][0] * rs, acc[ai][bj][m][1] * rs); }
            else { const float* rc = (const float*)(ws + WS_ROPE); u32x4 o1, o2; const int head = 4 * (pn - 4) + wc;
                rope8(acc[ai][0][m][0] * rs, acc[ai][0][m][1] * rs, acc[ai][1][m][0] * rs, acc[ai][1][m][1] * rs, rc, rc + 4096 * 32, row % SEQ, 8 * fq, o1, o2);
                bf16_t* dst = (bf16_t*)(ws + WS_QR) + (size_t)row * 512 + head * 64 + 8 * fq; *(u32x4*)dst = o1; *(u32x4*)(dst + 32) = o2; }
        )
    }
};
struct FEpi2b {
    static constexpr bool PERM = true, AFTER_DRAIN = false; unsigned char* ws;
    __device__ __forceinline__ void operator()(const f32x4 (&acc)[2][2][4][2], const Unit& u, int wr, int wc, int fr, int fq) const {
        const int pn = u.pn, cw = wc * 32 + 8 * fq;
        PG8_EPI_ROWS(
            const f32x4* sp = (const f32x4*)((const float*)(ws + WS_SSC) + (size_t)row * 16 + 8); const f32x4 p0 = sp[0], p1 = sp[1];
            const float rs = rsqrtf(((p0[0] + p0[1]) + (p0[2] + p0[3]) + (p1[0] + p1[1]) + (p1[2] + p1[3])) * (1.0f / 512.0f) + EPS);
            bf16_t* dst = (bf16_t*)(ws + (pn < 4 ? WS_KN : WS_VA)) + (size_t)row * 1024 + (pn & 3) * 256 + cw;
            _Pragma("unroll") for (int bj = 0; bj < 2; ++bj) *(u32x4*)(dst + bj * HALF) = pack8(acc[ai][bj][m][0] * rs, acc[ai][bj][m][1] * rs);
        )
    }
};
struct FEpi4 {
    static constexpr bool PERM = true, AFTER_DRAIN = false; unsigned char* ws; const float* x; float* out;
    __device__ __forceinline__ void operator()(const f32x4 (&acc)[2][2][4][2], const Unit& u, int wr, int wc, int fr, int fq) const {
        const int pn = u.pn, cw = pn * 256 + wc * 32 + 8 * fq;
        const size_t off0 = (size_t)(u.pm * BM + wr * 64 + fr) * 2048 + cw;
        f32x4 pre[2][4];
#define EPI4_LOAD(q, slot) { const float* p_ = x + off0 + (size_t)(((q) >> 2) * HALF + ((q) & 3) * 16) * 2048; pre[slot][0] = *(const f32x4*)p_; pre[slot][1] = *(const f32x4*)(p_ + 4); pre[slot][2] = *(const f32x4*)(p_ + HALF); pre[slot][3] = *(const f32x4*)(p_ + HALF + 4); }
        EPI4_LOAD(0, 0) EPI4_LOAD(1, 1)
#pragma unroll
        for (int q = 0; q < 8; ++q) { const int ai = q >> 2, m = q & 3; const size_t off = off0 + (size_t)(ai * HALF + m * 16) * 2048;
            const f32x4 v00 = pre[q & 1][0] + acc[ai][0][m][0], v01 = pre[q & 1][1] + acc[ai][0][m][1], v10 = pre[q & 1][2] + acc[ai][1][m][0], v11 = pre[q & 1][3] + acc[ai][1][m][1];
            if (q + 2 < 8) EPI4_LOAD(q + 2, q & 1)
            *(u32x4*)((bf16_t*)(ws + WS_X1BF) + off) = pack8(v00, v01); *(u32x4*)((bf16_t*)(ws + WS_X1BF) + off + HALF) = pack8(v10, v11);
            float ss = (sumsq4(v00) + sumsq4(v01)) + (sumsq4(v10) + sumsq4(v11));
            ss = quad_sum(ss); if (fq == 0) ((float*)(ws + WS_SSX1))[(size_t)(u.pm * BM + ai * HALF + wr * 64 + m * 16 + fr) * 32 + pn * 4 + wc] = ss; }
#undef EPI4_LOAD
    }
};
struct FEpi5 {
    static constexpr bool PERM = true, AFTER_DRAIN = false; unsigned char* ws;
    __device__ __forceinline__ void operator()(const f32x4 (&acc)[2][2][4][2], const Unit& u, int wr, int wc, int fr, int fq) const {
        const int pn = u.pn, cw = (pn & 7) * 256 + wc * 32 + 8 * fq; const int sel = pn >> 3;
        PG8_EPI_ROWS(
            const f32x4* sp = (const f32x4*)((const float*)(ws + WS_SSX1) + (size_t)row * 32 + 8 * fq); const f32x4 p0 = sp[0], p1 = sp[1];
            const float tot = quad_sum((p0[0] + p0[1]) + (p0[2] + p0[3]) + (p1[0] + p1[1]) + (p1[2] + p1[3]));
            const float rs = rsqrtf(tot * (1.0f / 2048.0f) + EPS);
            bf16_t* dst = (bf16_t*)(ws + (sel == 0 ? WS_Q2 : sel == 1 ? WS_K2 : sel == 2 ? WS_V2 : WS_SG2)) + (size_t)row * 2048 + cw;
            if (sel == 3) { _Pragma("unroll") for (int bj = 0; bj < 2; ++bj) *(u32x4*)(dst + bj * HALF) = pack8(silu4(acc[ai][bj][m][0] * rs), silu4(acc[ai][bj][m][1] * rs)); }
            else { const float sc = sel == 0 ? rs * D128_QSCALE : rs;
                _Pragma("unroll") for (int bj = 0; bj < 2; ++bj) *(u32x4*)(dst + bj * HALF) = pack8(acc[ai][bj][m][0] * sc, acc[ai][bj][m][1] * sc); }
        )
    }
};
struct FEpi7 {
    static constexpr bool PERM = true, AFTER_DRAIN = false; bf16_t* x2; const bf16_t* x1;
    __device__ __forceinline__ void operator()(const f32x4 (&acc)[2][2][4][2], const Unit& u, int wr, int wc, int fr, int fq) const {
        const int cw = u.pn * 256 + wc * 32 + 8 * fq;
        const size_t off0 = (size_t)(u.pm * BM + wr * 64 + fr) * 2048 + cw;
        u32x4 pre[2][2];
#define EPI7_LOAD(q, slot) { const bf16_t* p_ = x1 + off0 + (size_t)(((q) >> 2) * HALF + ((q) & 3) * 16) * 2048; pre[slot][0] = *(const u32x4*)p_; pre[slot][1] = *(const u32x4*)(p_ + HALF); }
        EPI7_LOAD(0, 0) EPI7_LOAD(1, 1)
#pragma unroll
        for (int q = 0; q < 8; ++q) { const int ai = q >> 2, m = q & 3; const size_t off = off0 + (size_t)(ai * HALF + m * 16) * 2048;
            const u32x4 r0 = pre[q & 1][0], r1 = pre[q & 1][1];
            if (q + 2 < 8) EPI7_LOAD(q + 2, q & 1)
#define BFLO(w) __uint_as_float((w) << 16)
#define BFHI(w) __uint_as_float((w) & 0xffff0000u)
            *(u32x4*)(x2 + off) = pack8((f32x4){BFLO(r0[0]), BFHI(r0[0]), BFLO(r0[1]), BFHI(r0[1])} + acc[ai][0][m][0], (f32x4){BFLO(r0[2]), BFHI(r0[2]), BFLO(r0[3]), BFHI(r0[3])} + acc[ai][0][m][1]);
            *(u32x4*)(x2 + off + HALF) = pack8((f32x4){BFLO(r1[0]), BFHI(r1[0]), BFLO(r1[1]), BFHI(r1[1])} + acc[ai][1][m][0], (f32x4){BFLO(r1[2]), BFHI(r1[2]), BFLO(r1[3]), BFHI(r1[3])} + acc[ai][1][m][1]); }
#undef BFLO
#undef BFHI
#undef EPI7_LOAD
    }
};
template <class Epi, class Sched, bool ALIGN_EPI = false, bool SP2 = false>
__device__ __forceinline__ void gemm_phase(PG8_LAS unsigned char* lds, const Gemm g, const Sched& S, const Epi& E, const int tid) {
    const int wid = __builtin_amdgcn_readfirstlane(tid >> 6), lane = tid & 63, wr = wid >> 2, wc = wid & 3, fr = lane & 15, fq = lane >> 4;
    const int K = g.K, nt = K / BK;
    unsigned voffA[2], voffB[2];
#pragma unroll
    for (int i = 0; i < 2; ++i) { int R, C; stage_rc(tid * 16 + i * 8192, R, C); const int Rb = Epi::PERM ? ((R & ~31) + perm32(R & 31)) : R;
        voffA[i] = (unsigned)(R * K + C) * 2u; voffB[i] = (unsigned)(Rb * K + C) * 2u; }
    const size_t kstep = (size_t)(BK * 2);
    const size_t hstep = (size_t)HALF * K * 2;
    const size_t tstep = 2 * hstep;
    const unsigned ldsw = (unsigned)wid * 1024u;
    const int aoff = lds_byte(wr * 64 + fr, fq * 8), boff = lds_byte(wc * 32 + fr, fq * 8);
#define PG8_SA(b, h) (((b) * 2 + (h)) * HTB)
#define PG8_SB(b, h) ((4 + (b) * 2 + (h)) * HTB)
#define PG8_STAGE(bufoff, gbase, voff) do { _Pragma("unroll") for (int _i = 0; _i < 2; ++_i) \
        __builtin_amdgcn_global_load_lds((const unsigned*)((const char*)(gbase) + (voff)[_i]), (PG8_LAS unsigned*)(lds + (bufoff) + ldsw + _i * 8192), 16, 0, 0); } while (0)
#define PG8_LDA(dst, b, h) do { _Pragma("unroll") for (int m = 0; m < 4; ++m) _Pragma("unroll") for (int k = 0; k < 2; ++k) dst[m][k] = *(const PG8_LAS bf16x8*)(lds + PG8_SA(b, h) + aoff + m * 2048 + k * 1024); } while (0)
#define PG8_LDB(dst, b, h) do { _Pragma("unroll") for (int n = 0; n < 2; ++n) _Pragma("unroll") for (int k = 0; k < 2; ++k) dst[n][k] = *(const PG8_LAS bf16x8*)(lds + PG8_SB(b, h) + boff + n * 2048 + k * 1024); } while (0)
#define PG8_MMA(ai, bj, At, Bt) do { __builtin_amdgcn_s_setprio(1); _Pragma("unroll") for (int m = 0; m < 4; ++m) _Pragma("unroll") for (int n = 0; n < 2; ++n) _Pragma("unroll") for (int k = 0; k < 2; ++k) \
        acc[ai][bj][m][n] = __builtin_amdgcn_mfma_f32_16x16x32_bf16(Bt[n][k], At[m][k], acc[ai][bj][m][n], 0, 0, 0); __builtin_amdgcn_s_setprio(0); } while (0)
#define PG8_WAIT_V(n) asm volatile("s_waitcnt vmcnt(" #n ")" ::: "memory")
#define PG8_WAIT_L(n) asm volatile("s_waitcnt lgkmcnt(" #n ")" ::: "memory")
#define PG8_BAR __builtin_amdgcn_s_barrier()
#define PG8_SCHED __builtin_amdgcn_sched_barrier(0)
    Unit cur, nxt; int ui = 0;
    if (!S.next(0, cur)) return;
    f32x4 acc[2][2][4][2];
#pragma unroll
    for (int a = 0; a < 2; ++a)
#pragma unroll
        for (int b = 0; b < 2; ++b)
#pragma unroll
            for (int m = 0; m < 4; ++m)
#pragma unroll
                for (int n = 0; n < 2; ++n) acc[a][b][m][n] = (f32x4){0.f, 0.f, 0.f, 0.f};
    bf16x8 At[4][2], B0[2][2], B1[2][2];
    const char* cA = (const char*)g.A + (size_t)cur.pm * tstep; const char* cB = (const char*)g.Bt + (size_t)cur.pn * tstep;
    S.a_ready(cur);
    if constexpr (SP2) {
        PG8_STAGE(PG8_SB(0, 0), cB, voffB); PG8_STAGE(PG8_SB(0, 1), cB + hstep, voffB); PG8_STAGE(PG8_SA(0, 0), cA, voffA); PG8_STAGE(PG8_SA(0, 1), cA + hstep, voffA);
        if (wr == 1) PG8_BAR;
        PG8_WAIT_V(2); PG8_BAR;
        PG8_STAGE(PG8_SB(1, 0), cB + kstep, voffB); PG8_STAGE(PG8_SA(1, 0), cA + kstep, voffA); PG8_STAGE(PG8_SB(1, 1), cB + hstep + kstep, voffB);
        PG8_WAIT_V(6); PG8_BAR;
    } else {
        PG8_STAGE(PG8_SB(0, 0), cB, voffB); PG8_STAGE(PG8_SA(0, 0), cA, voffA); PG8_STAGE(PG8_SB(0, 1), cB + hstep, voffB); PG8_STAGE(PG8_SA(0, 1), cA + hstep, voffA);
        if (wr == 1) PG8_BAR;
        PG8_WAIT_V(4); PG8_BAR;
        PG8_STAGE(PG8_SB(1, 0), cB + kstep, voffB); PG8_STAGE(PG8_SA(1, 0), cA + kstep, voffA); PG8_STAGE(PG8_SB(1, 1), cB + hstep + kstep, voffB);
        PG8_WAIT_V(6); PG8_BAR;
    }
    for (;;) {
        const bool has_next = S.next(ui + 1, nxt);
        const char* nA = has_next ? (const char*)g.A + (size_t)nxt.pm * tstep : cA; const char* nB = has_next ? (const char*)g.Bt + (size_t)nxt.pn * tstep : cB;
        for (int t = 0; t < nt; t += 2) {
            const bool last = (t == nt - 2);
            const char* a1 = cA + (size_t)(t + 1) * kstep;
            const char* a2 = last ? nA : cA + (size_t)(t + 2) * kstep; const char* b2 = last ? nB : cB + (size_t)(t + 2) * kstep;
            const char* a3 = a2 + kstep; const char* b3 = b2 + kstep;
            if (last && has_next) S.a_ready(nxt);
            if constexpr (SP2) {
            PG8_LDB(B0, 0, 0); PG8_LDB(B1, 0, 1); PG8_SCHED; PG8_LDA(At, 0, 0); PG8_STAGE(PG8_SA(1, 1), a1 + hstep, voffA);
            PG8_WAIT_V(8); PG8_WAIT_L(0); PG8_BAR; PG8_MMA(0, 0, At, B0); PG8_MMA(0, 1, At, B1); PG8_BAR; PG8_SCHED;
            PG8_LDA(At, 0, 1); PG8_STAGE(PG8_SB(0, 0), b2, voffB); PG8_STAGE(PG8_SB(0, 1), b2 + hstep, voffB); PG8_STAGE(PG8_SA(0, 0), a2, voffA);
            PG8_WAIT_V(8); PG8_WAIT_L(0); PG8_BAR; PG8_MMA(1, 0, At, B0); PG8_MMA(1, 1, At, B1); PG8_BAR; PG8_SCHED;
            PG8_LDB(B0, 1, 0); PG8_LDB(B1, 1, 1); PG8_SCHED; PG8_LDA(At, 1, 0); PG8_STAGE(PG8_SA(0, 1), a2 + hstep, voffA);
            PG8_WAIT_V(8); PG8_WAIT_L(0); PG8_BAR; PG8_MMA(0, 0, At, B0); PG8_MMA(0, 1, At, B1); PG8_BAR; PG8_SCHED;
            PG8_LDA(At, 1, 1); PG8_STAGE(PG8_SB(1, 0), b3, voffB); PG8_STAGE(PG8_SB(1, 1), b3 + hstep, voffB); PG8_STAGE(PG8_SA(1, 0), a3, voffA);
            PG8_WAIT_V(8); PG8_WAIT_L(0); PG8_BAR; PG8_MMA(1, 0, At, B0); PG8_MMA(1, 1, At, B1); PG8_BAR; PG8_SCHED;
            } else {
            PG8_LDB(B0, 0, 0); PG8_SCHED; PG8_LDA(At, 0, 0); PG8_STAGE(PG8_SA(1, 1), a1 + hstep, voffA);
            PG8_WAIT_L(8); PG8_BAR; PG8_WAIT_L(0); PG8_MMA(0, 0, At, B0); PG8_BAR; PG8_SCHED;
            PG8_LDB(B1, 0, 1); PG8_STAGE(PG8_SB(0, 0), b2, voffB);
            PG8_BAR; PG8_WAIT_L(0); PG8_MMA(0, 1, At, B1); PG8_BAR;
            PG8_LDA(At, 0, 1); PG8_STAGE(PG8_SA(0, 0), a2, voffA);
            PG8_BAR; PG8_WAIT_L(0); PG8_MMA(1, 0, At, B0); PG8_BAR; PG8_SCHED;
            PG8_STAGE(PG8_SB(0, 1), b2 + hstep, voffB);
            PG8_WAIT_V(6); PG8_BAR; PG8_MMA(1, 1, At, B1); PG8_BAR;
            PG8_LDB(B0, 1, 0); PG8_SCHED; PG8_LDA(At, 1, 0); PG8_STAGE(PG8_SA(0, 1), a2 + hstep, voffA);
            PG8_WAIT_L(8); PG8_BAR; PG8_WAIT_L(0); PG8_MMA(0, 0, At, B0); PG8_BAR; PG8_SCHED;
            PG8_LDB(B1, 1, 1); PG8_STAGE(PG8_SB(1, 0), b3, voffB);
            PG8_BAR; PG8_WAIT_L(0); PG8_MMA(0, 1, At, B1); PG8_BAR;
            PG8_LDA(At, 1, 1); PG8_STAGE(PG8_SA(1, 0), a3, voffA);
            PG8_BAR; PG8_WAIT_L(0); PG8_MMA(1, 0, At, B0); PG8_BAR; PG8_SCHED;
            PG8_STAGE(PG8_SB(1, 1), b3 + hstep, voffB);
            PG8_WAIT_V(6); PG8_BAR; PG8_MMA(1, 1, At, B1); PG8_BAR;
            }
        }
        if constexpr (ALIGN_EPI) { if (wr == 0) PG8_BAR; }
        if constexpr (!Epi::AFTER_DRAIN) { E(acc, cur, wr, wc, fr, fq); S.done(cur); }
        if (!has_next) break;
#pragma unroll
        for (int a = 0; a < 2; ++a)
#pragma unroll
            for (int b = 0; b < 2; ++b)
#pragma unroll
                for (int m = 0; m < 4; ++m)
#pragma unroll
                    for (int n = 0; n < 2; ++n) acc[a][b][m][n] = (f32x4){0.f, 0.f, 0.f, 0.f};
        cur = nxt; cA = nA; cB = nB; ++ui;
        if constexpr (ALIGN_EPI) { if (wr == 1) PG8_BAR; }
    }
    PG8_WAIT_V(0);
    if constexpr (!ALIGN_EPI) { if (wr == 0) PG8_BAR; }
    PG8_BAR;
    if constexpr (Epi::AFTER_DRAIN) { E.fused(acc, cur, wr, wc, fr, fq, lds, wid, lane); S.done(cur); }
#undef PG8_SA
#undef PG8_SB
#undef PG8_STAGE
#undef PG8_LDA
#undef PG8_LDB
#undef PG8_MMA
#undef PG8_WAIT_V
#undef PG8_WAIT_L
#undef PG8_BAR
#undef PG8_SCHED
}
}

#define LAS __attribute__((address_space(3)))
template <class Epi> __global__ void __launch_bounds__(512, 2) k_gemm_fast(pg8::Gemm g, Epi E) {
    extern __shared__ __attribute__((aligned(16))) unsigned char lds[];
    pg8::StaticOrder S; S.init(g.M, g.N, (int)gridDim.x, (int)blockIdx.x);
    pg8::gemm_phase<Epi, pg8::StaticOrder, true, true>((LAS unsigned char*)lds, g, S, E, (int)threadIdx.x);
}

template <class Epi>
__global__ void __launch_bounds__(256) k_gemm_naive(const bf16_t* A, const bf16_t* Bt, int N, int K, Epi epi) {
    __shared__ float As[64][33], Bs[64][33];
    const int tid = threadIdx.x, tx = tid & 15, ty = tid >> 4;
    const int nbn = N / 64; const int bm = blockIdx.x / nbn, bn = blockIdx.x % nbn;
    float acc[4][4] = {};
    const int lr = tid >> 2, lc = (tid & 3) * 8;
    for (int k0 = 0; k0 < K; k0 += 32) {
        const u32x4 av = *(const u32x4*)(A + (size_t)(bm * 64 + lr) * K + k0 + lc);
        const u32x4 bv = *(const u32x4*)(Bt + (size_t)(bn * 64 + lr) * K + k0 + lc);
        __syncthreads();
#pragma unroll
        for (int j = 0; j < 4; ++j) { As[lr][lc + 2 * j] = __uint_as_float(av[j] << 16); As[lr][lc + 2 * j + 1] = __uint_as_float(av[j] & 0xffff0000u);
                                      Bs[lr][lc + 2 * j] = __uint_as_float(bv[j] << 16); Bs[lr][lc + 2 * j + 1] = __uint_as_float(bv[j] & 0xffff0000u); }
        __syncthreads();
#pragma unroll 8
        for (int kk = 0; kk < 32; ++kk) { float a[4], b[4];
#pragma unroll
            for (int i = 0; i < 4; ++i) { a[i] = As[ty * 4 + i][kk]; b[i] = Bs[tx * 4 + i][kk]; }
#pragma unroll
            for (int i = 0; i < 4; ++i)
#pragma unroll
                for (int j = 0; j < 4; ++j) acc[i][j] += a[i] * b[j]; }
    }
#pragma unroll
    for (int i = 0; i < 4; ++i)
#pragma unroll
        for (int j = 0; j < 4; ++j) epi(bm * 64 + ty * 4 + i, bn * 64 + tx * 4 + j, acc[i][j]);
}

template <bool F32>
__global__ void __launch_bounds__(256) k_rowss(const void* src, int ld, int ncols, float* dst, int dst_ld, int nslots) {
    const int lane = threadIdx.x & 63, row = blockIdx.x * 4 + (threadIdx.x >> 6);
    float s = 0.f;
    for (int c = lane; c < ncols; c += 64) { const float v = F32 ? ((const float*)src)[(size_t)row * ld + c] : bf2f(((const bf16_t*)src)[(size_t)row * ld + c]); s += v * v; }
    s = wave_sum(s);
    if (lane < nslots) dst[(size_t)row * dst_ld + lane] = lane == 0 ? s : 0.f;
}

__global__ void __launch_bounds__(256) k_rope(bf16_t* buf, int nh, const float* rc, const float* rs) {
    const int idx = blockIdx.x * 256 + threadIdx.x; const int per_row = nh * 32; if (idx >= M * per_row) return;
    const int row = idx / per_row, t = idx % per_row, h = t >> 5, i = t & 31, pos = row % SEQ;
    bf16_t* p = buf + (size_t)row * nh * 64 + h * 64; const float x1 = bf2f(p[i]), x2 = bf2f(p[32 + i]); const float cs = rc[pos * 32 + i], sn = rs[pos * 32 + i];
    p[i] = f2bf(x1 * cs - x2 * sn); p[32 + i] = f2bf(x1 * sn + x2 * cs);
}

template <int D> DI float dot_row(const float* q, const bf16_t* k) {
    float s = 0.f;
#pragma unroll
    for (int d = 0; d < D; d += 8) { const u32x4 v = *(const u32x4*)(k + d);
#pragma unroll
        for (int j = 0; j < 4; ++j) { s += q[d + 2 * j] * __uint_as_float(v[j] << 16); s += q[d + 2 * j + 1] * __uint_as_float(v[j] & 0xffff0000u); } }
    return s;
}

__global__ void __launch_bounds__(256) k_mla_naive(Ctx c) {
    __shared__ float qs[4][192];
    const int lane = threadIdx.x & 63, w = threadIdx.x >> 6; const int gq = blockIdx.x * 4 + w;
    const int t = gq % SEQ, bh = gq / SEQ, h = bh % 8, b = bh / 8; const size_t row = (size_t)b * SEQ + t;
    unsigned char* ws = c.ws;
    const bf16_t *QN = (const bf16_t*)(ws + WS_QN), *QR = (const bf16_t*)(ws + WS_QR), *KN = (const bf16_t*)(ws + WS_KN), *KR = (const bf16_t*)(ws + WS_KR), *VA = (const bf16_t*)(ws + WS_VA), *SG = (const bf16_t*)(ws + WS_SG);
    for (int d = lane; d < 192; d += 64) qs[w][d] = d < 128 ? bf2f(QN[row * 1024 + h * 128 + d]) : bf2f(QR[row * 512 + h * 64 + d - 128]);
    __syncthreads();
    float m = -INFINITY, l = 0.f, o0 = 0.f, o1 = 0.f;
    for (int j0 = 0; j0 <= t; j0 += 64) {
        const int j = j0 + lane; const bool valid = j <= t; const size_t krow = (size_t)b * SEQ + (valid ? j : t);
        float s = dot_row<128>(qs[w], KN + krow * 1024 + h * 128) + dot_row<64>(qs[w] + 128, KR + krow * 64);
        if (!valid) s = -INFINITY;
        const float mn = fmaxf(m, wave_max(s)); const float alpha = exp2f(m - mn); const float p = valid ? exp2f(s - mn) : 0.f;
        l = l * alpha + wave_sum(p); o0 *= alpha; o1 *= alpha; m = mn;
        const int nj = min(64, t - j0 + 1);
        for (int jj = 0; jj < nj; ++jj) { const float pj = __shfl(p, jj); const bf16_t* vr = VA + ((size_t)b * SEQ + j0 + jj) * 1024 + h * 128; o0 += pj * bf2f(vr[lane]); o1 += pj * bf2f(vr[lane + 64]); }
    }
    bf16_t* MIX = (bf16_t*)(ws + WS_MIX); const float il = 1.0f / l;
    MIX[row * 2048 + h * 128 + lane] = f2bf(o0 * il * bf2f(SG[row * 2048 + h * 128 + lane]));
    MIX[row * 2048 + h * 128 + lane + 64] = f2bf(o1 * il * bf2f(SG[row * 2048 + h * 128 + lane + 64]));
}

__global__ void __launch_bounds__(256) k_dil_naive(Ctx c) {
    __shared__ float qs[4][128];
    const int lane = threadIdx.x & 63, w = threadIdx.x >> 6; const int gq = blockIdx.x * 4 + w;
    const int t = gq % SEQ, bh = gq / SEQ, h = bh % 8, b = bh / 8; const size_t row = (size_t)b * SEQ + t;
    unsigned char* ws = c.ws;
    const bf16_t *QB = (const bf16_t*)(ws + WS_QB), *KB = (const bf16_t*)(ws + WS_KB), *VB = (const bf16_t*)(ws + WS_VB);
    const float* bn = (const float*)(ws + WS_BIASN);
    for (int d = lane; d < 128; d += 64) qs[w][d] = bf2f(QB[row * 1024 + h * 128 + d]);
    __syncthreads();
    for (int p = 0; p < 3; ++p) { const int dil = p == 0 ? 1 : p == 1 ? 4 : 16;
        float m = -INFINITY, l = 0.f, o0 = 0.f, o1 = 0.f;
        for (int r0 = 0; r0 < 192; r0 += 64) {
            const int rel = r0 + lane; const int j = t - rel * dil; const bool valid = rel <= 128 && j >= 0; const size_t krow = (size_t)b * SEQ + (valid ? j : t);
            float s = dot_row<128>(qs[w], KB + krow * 1024 + h * 128) + bn[(p * 8 + h) * 132 + (valid ? rel : 0)];
            if (!valid) s = -INFINITY;
            const float mn = fmaxf(m, wave_max(s));
            const float alpha = exp2f(m - mn); const float pp = valid ? exp2f(s - mn) : 0.f;
            l = l * alpha + wave_sum(pp); o0 *= alpha; o1 *= alpha; m = mn;
            for (int jj = 0; jj < 64; ++jj) { const float pj = __shfl(pp, jj); if (pj != 0.f) { const int jr = t - (r0 + jj) * dil; const bf16_t* vr = VB + ((size_t)b * SEQ + jr) * 1024 + h * 128; o0 += pj * bf2f(vr[lane]); o1 += pj * bf2f(vr[lane + 64]); } }
        }
        bf16_t* OP = (bf16_t*)(ws + (p == 0 ? WS_OP0 : p == 1 ? WS_OP1 : WS_OP2)); const float il = 1.0f / l;
        OP[row * 1024 + h * 128 + lane] = f2bf(o0 * il); OP[row * 1024 + h * 128 + lane + 64] = f2bf(o1 * il);
        if (lane == 0) ((float*)(ws + WS_LSE))[((size_t)p * M + row) * 8 + h] = m + log2f(l);
    }
}

DI void dil_merge_item(unsigned char* ws, int row, int col) {
    const int h = col >> 7; const float* lse = (const float*)(ws + WS_LSE);
    const float l0 = lse[((size_t)0 * M + row) * 8 + h], l1 = lse[((size_t)1 * M + row) * 8 + h], l2 = lse[((size_t)2 * M + row) * 8 + h];
    const float mx = fmaxf(l0, fmaxf(l1, l2)); float w0 = exp2f(l0 - mx), w1 = exp2f(l1 - mx), w2 = exp2f(l2 - mx); const float inv = 1.0f / (w0 + w1 + w2); w0 *= inv; w1 *= inv; w2 *= inv;
    const u32x4 a0 = *(const u32x4*)((const bf16_t*)(ws + WS_OP0) + (size_t)row * 1024 + col), a1 = *(const u32x4*)((const bf16_t*)(ws + WS_OP1) + (size_t)row * 1024 + col),
                a2 = *(const u32x4*)((const bf16_t*)(ws + WS_OP2) + (size_t)row * 1024 + col), sg = *(const u32x4*)((const bf16_t*)(ws + WS_SG) + (size_t)row * 2048 + 1024 + col);
    u32x4 o;
#pragma unroll
    for (int j = 0; j < 4; ++j) {
        const float lo = (w0 * __uint_as_float(a0[j] << 16) + w1 * __uint_as_float(a1[j] << 16) + w2 * __uint_as_float(a2[j] << 16)) * __uint_as_float(sg[j] << 16);
        const float hi = (w0 * __uint_as_float(a0[j] & 0xffff0000u) + w1 * __uint_as_float(a1[j] & 0xffff0000u) + w2 * __uint_as_float(a2[j] & 0xffff0000u)) * __uint_as_float(sg[j] & 0xffff0000u);
        o[j] = (unsigned)f2bf(lo) | ((unsigned)f2bf(hi) << 16); }
    *(u32x4*)((bf16_t*)(ws + WS_MIX) + (size_t)row * 2048 + 1024 + col) = o;
}
__global__ void __launch_bounds__(128) k_dil_merge(Ctx c) { dil_merge_item(c.ws, blockIdx.x, threadIdx.x * 8); }

__global__ void __launch_bounds__(256) k_sb_naive(Ctx c) {
    __shared__ float qs[4][128];
    const int lane = threadIdx.x & 63, w = threadIdx.x >> 6; const int gq = blockIdx.x * 4 + w;
    const int t = gq % SEQ, bh = gq / SEQ, h = bh % 16, b = bh / 16; const size_t row = (size_t)b * SEQ + t;
    unsigned char* ws = c.ws;
    const bf16_t *Q2 = (const bf16_t*)(ws + WS_Q2), *K2 = (const bf16_t*)(ws + WS_K2), *V2 = (const bf16_t*)(ws + WS_V2), *SG2 = (const bf16_t*)(ws + WS_SG2);
    for (int d = lane; d < 128; d += 64) qs[w][d] = bf2f(Q2[row * 2048 + h * 128 + d]);
    __syncthreads();
    float carry = 0.f, o0 = 0.f, o1 = 0.f;
    for (int c0 = 0; c0 < t; c0 += 64) {
        const int j = t - 1 - c0 - lane; const bool valid = j >= 0; const size_t krow = (size_t)b * SEQ + (valid ? j : 0);
        const float z = dot_row<128>(qs[w], K2 + krow * 2048 + h * 128);
        const float sp = fmaxf(z, 0.f) + log2f(1.0f + exp2f(-fabsf(z)));
        const float L = valid ? -sp : 0.f;
        float incl = L;
#pragma unroll
        for (int o = 1; o < 64; o <<= 1) { const float v = __shfl_up(incl, o); if (lane >= o) incl += v; }
        const float between = carry + (incl - L);
        const float a = valid ? exp2f(z - sp + between) : 0.f;
        carry += __shfl(incl, 63);
        const int nj = min(64, t - c0);
        for (int jj = 0; jj < nj; ++jj) { const float aj = __shfl(a, jj); const bf16_t* vr = V2 + ((size_t)b * SEQ + t - 1 - c0 - jj) * 2048 + h * 128; o0 += aj * bf2f(vr[lane]); o1 += aj * bf2f(vr[lane + 64]); }
    }
    bf16_t* MIX2 = (bf16_t*)(ws + WS_MIX2);
    MIX2[row * 2048 + h * 128 + lane] = f2bf(o0 * bf2f(SG2[row * 2048 + h * 128 + lane]));
    MIX2[row * 2048 + h * 128 + lane + 64] = f2bf(o1 * bf2f(SG2[row * 2048 + h * 128 + lane + 64]));
}

#ifndef MLA_PIPE
#define MLA_PIPE 1
#endif
namespace att {
typedef short bf16x8 __attribute__((ext_vector_type(8)));
typedef short s16x4 __attribute__((ext_vector_type(4)));
typedef short v4i16_t __attribute__((ext_vector_type(4)));
typedef float f32x16 __attribute__((ext_vector_type(16)));
typedef _Float16 f16x8 __attribute__((ext_vector_type(8)));
typedef _Float16 f16x2 __attribute__((ext_vector_type(2)));
typedef float f32x2_t __attribute__((ext_vector_type(2))); typedef __bf16 bf16x2_t __attribute__((ext_vector_type(2)));
typedef LAS const unsigned char* lcp;
#define MFMA_BF16(a, b, c) __builtin_amdgcn_mfma_f32_32x32x16_bf16((a), (b), (c), 0, 0, 0)
#define MFMA_F16(a, b, c) __builtin_amdgcn_mfma_f32_32x32x16_f16((a), (b), (c), 0, 0, 0)
#define SBAR() __builtin_amdgcn_sched_barrier(0)
DI int crow(int g, int h) { return (g & 3) + 8 * (g >> 2) + 4 * h; }
DI unsigned off_b(unsigned row, unsigned ch) { return 256u * row + 16u * (ch ^ (((row & 3) << 2) | ((row >> 2) & 3))); }
DI unsigned cvtpk(float lo, float hi) { f32x2_t v = {lo, hi}; bf16x2_t b = __builtin_convertvector(v, bf16x2_t); return __builtin_bit_cast(unsigned, b); }
DI unsigned cvtpk_h(float lo, float hi) { f32x2_t v = {lo, hi}; f16x2 b = __builtin_convertvector(v, f16x2); return __builtin_bit_cast(unsigned, b); }
DI bf16x8 pack_bf(const f32x16& x, int s) { u32x4 p; p.x = cvtpk(x[8 * s], x[8 * s + 1]); p.y = cvtpk(x[8 * s + 2], x[8 * s + 3]); p.z = cvtpk(x[8 * s + 4], x[8 * s + 5]); p.w = cvtpk(x[8 * s + 6], x[8 * s + 7]); return __builtin_bit_cast(bf16x8, p); }
DI f16x8 pack_h(const f32x16& x, int s) { u32x4 p; p.x = cvtpk_h(x[8 * s], x[8 * s + 1]); p.y = cvtpk_h(x[8 * s + 2], x[8 * s + 3]); p.z = cvtpk_h(x[8 * s + 4], x[8 * s + 5]); p.w = cvtpk_h(x[8 * s + 6], x[8 * s + 7]); return __builtin_bit_cast(f16x8, p); }
DI s16x4 vtr(lcp p) { return __builtin_bit_cast(s16x4, __builtin_amdgcn_ds_read_tr16_b64_v4i16((LAS v4i16_t*)p)); }
DI float swap_max(float m) { auto rr = __builtin_amdgcn_permlane32_swap(__float_as_uint(m), __float_as_uint(m), false, false); return fmaxf(__uint_as_float(rr[0]), __uint_as_float(rr[1])); }
DI float swap_sum(float m) { auto rr = __builtin_amdgcn_permlane32_swap(__float_as_uint(m), __float_as_uint(m), false, false); return __uint_as_float(rr[0]) + __uint_as_float(rr[1]); }
DI float bcast_lo(float m) { auto rr = __builtin_amdgcn_permlane32_swap(__float_as_uint(m), __float_as_uint(m), false, false); return __uint_as_float(rr[0]); }
DI __amdgpu_buffer_rsrc_t mk_rsrc(const void* p, unsigned bytes) { return __builtin_amdgcn_make_buffer_rsrc((void*)p, 0, bytes, 0x00020000); }
DI u32x4 bload(__amdgpu_buffer_rsrc_t rs, unsigned voff, unsigned soff) { return __builtin_amdgcn_raw_buffer_load_b128(rs, voff, soff, 0); }
struct VAddr { unsigned a[2][4]; };
DI VAddr make_vaddr(int lane) { VAddr v; const unsigned hh = lane >> 5, blk = (lane >> 4) & 1, qq = (lane & 15) >> 2, p = lane & 3;
#pragma unroll
    for (int t = 0; t < 2; ++t)
#pragma unroll
        for (int d0 = 0; d0 < 4; ++d0) v.a[t][d0] = off_b(8 * t + 4 * hh + qq, 4 * d0 + 2 * blk + (p >> 1)) + 8 * (p & 1);
    return v; }
DI bf16x8 vfrag(lcp img, int s, int d0, const VAddr& va) {
    const s16x4 lo = vtr(img + 4096 * s + va.a[0][d0]);
    const s16x4 hi = vtr(img + 4096 * s + va.a[1][d0]);
    return (bf16x8){lo[0], lo[1], lo[2], lo[3], hi[0], hi[1], hi[2], hi[3]};
}
DI void softmax_tile(f32x16& s0, f32x16& s1, f32x16 (&o)[4], float& mrun, float& lrun) {
    float mt = fmaxf(s0[0], s1[0]);
#pragma unroll
    for (int g = 1; g < 16; ++g) mt = fmaxf(mt, fmaxf(s0[g], s1[g]));
    mt = swap_max(mt);
    const float mn = fmaxf(mrun, mt), alpha = __builtin_amdgcn_exp2f(mrun - mn); mrun = mn;
    float ps = 0.f;
#pragma unroll
    for (int g = 0; g < 16; ++g) { s0[g] = __builtin_amdgcn_exp2f(s0[g] - mn); s1[g] = __builtin_amdgcn_exp2f(s1[g] - mn); ps += s0[g] + s1[g]; }
    lrun = lrun * alpha + ps;
#pragma unroll
    for (int d0 = 0; d0 < 4; ++d0)
#pragma unroll
        for (int g = 0; g < 16; ++g) o[d0][g] *= alpha;
}

constexpr int MLA_KSTR = 400, MLA_KBUF = 64 * MLA_KSTR, VBUF = 16384, MLA_LDS_V = 2 * MLA_KBUF, MLA_LDS_BYTES = 2 * MLA_KBUF + 2 * VBUF;
template <bool MASKED>
DI void mla_tile(lcp kb, lcp vb, const bf16x8 (&qf)[12], f32x16 (&o)[4], float& mrun, float& lrun, const VAddr& va, int qrel, int hh) {
    f32x16 s0, s1;
#pragma unroll
    for (int g = 0; g < 16; ++g) { s0[g] = 0.f; s1[g] = 0.f; }
    bf16x8 f0a = *(LAS const bf16x8*)kb, f0b = *(LAS const bf16x8*)(kb + 32 * MLA_KSTR), f1a = *(LAS const bf16x8*)(kb + 32), f1b = *(LAS const bf16x8*)(kb + 32 * MLA_KSTR + 32), f2a, f2b;
#pragma unroll
    for (int d0 = 0; d0 < 12; ++d0) {
        if (d0 + 2 < 12) { const bf16x8 n0 = *(LAS const bf16x8*)(kb + (d0 + 2) * 32), n1 = *(LAS const bf16x8*)(kb + 32 * MLA_KSTR + (d0 + 2) * 32);
            if ((d0 + 2) % 3 == 0) { f0a = n0; f0b = n1; } else if ((d0 + 2) % 3 == 1) { f1a = n0; f1b = n1; } else { f2a = n0; f2b = n1; } }
        SBAR();
        s0 = MFMA_BF16(d0 % 3 == 0 ? f0a : d0 % 3 == 1 ? f1a : f2a, qf[d0], s0); s1 = MFMA_BF16(d0 % 3 == 0 ? f0b : d0 % 3 == 1 ? f1b : f2b, qf[d0], s1);
        SBAR();
    }
    if (MASKED) {
#pragma unroll
        for (int g = 0; g < 16; ++g) { const int kv = crow(g, 0); if (kv > qrel - 4 * hh) s0[g] = -INFINITY; if (kv + 32 > qrel - 4 * hh) s1[g] = -INFINITY; } }
    float mt = fmaxf(s0[0], s1[0]);
#pragma unroll
    for (int g = 1; g < 16; ++g) mt = fmaxf(mt, fmaxf(s0[g], s1[g]));
    mt = swap_max(mt);
    if (__builtin_amdgcn_ballot_w64(mt > mrun) != 0ull) {
        const float mn = fmaxf(mrun, mt), alpha = __builtin_amdgcn_exp2f(mrun - mn); mrun = mn; lrun *= alpha;
#pragma unroll
        for (int d0 = 0; d0 < 4; ++d0)
#pragma unroll
            for (int g = 0; g < 16; ++g) o[d0][g] *= alpha;
    }
    float ps = 0.f;
#pragma unroll
    for (int g = 0; g < 16; ++g) { s0[g] = __builtin_amdgcn_exp2f(s0[g] - mrun); s1[g] = __builtin_amdgcn_exp2f(s1[g] - mrun); ps += s0[g] + s1[g]; }
    lrun += ps;
    bf16x8 pf[4]; pf[0] = pack_bf(s0, 0); pf[1] = pack_bf(s0, 1); pf[2] = pack_bf(s1, 0); pf[3] = pack_bf(s1, 1);
    bf16x8 v0 = vfrag(vb, 0, 0, va), v1 = vfrag(vb, 0, 1, va), v2;
#pragma unroll
    for (int j = 0; j < 16; ++j) {
        if (j + 2 < 16) { const int ks = (j + 2) >> 2, d0 = (j + 2) & 3; const bf16x8 nx = vfrag(vb + (ks >> 1) * 8192, ks & 1, d0, va);
            if ((j + 2) % 3 == 0) v0 = nx; else if ((j + 2) % 3 == 1) v1 = nx; else v2 = nx; }
        SBAR();
        o[j & 3] = MFMA_BF16(j % 3 == 0 ? v0 : j % 3 == 1 ? v1 : v2, pf[j >> 2], o[j & 3]);
        SBAR();
    }
}
DI void mla_unit(LAS unsigned char* lds, unsigned char* ws, int b, int h, int qb, const int tid_in) {
    int tid = tid_in; asm volatile("" : "+v"(tid));
    const int lane = tid & 63, wid = __builtin_amdgcn_readfirstlane(tid >> 6), r = lane & 31, hh = lane >> 5;
    const bf16_t *QN = (const bf16_t*)(ws + WS_QN), *QR = (const bf16_t*)(ws + WS_QR), *KN = (const bf16_t*)(ws + WS_KN), *KR = (const bf16_t*)(ws + WS_KR), *VA = (const bf16_t*)(ws + WS_VA), *SG = (const bf16_t*)(ws + WS_SG);
    bf16_t* MIX = (bf16_t*)(ws + WS_MIX);
    const int q0 = qb * 256, NT = 4 * (qb + 1), tmax = (q0 + 32 * wid) >> 6; const size_t rowbase = (size_t)b * SEQ;
    bf16x8 qf[12];
    { const size_t qrow = rowbase + q0 + 32 * wid + r;
#pragma unroll
      for (int d0 = 0; d0 < 8; ++d0) qf[d0] = *(const bf16x8*)(QN + qrow * 1024 + h * 128 + d0 * 16 + hh * 8);
#pragma unroll
      for (int d0 = 0; d0 < 4; ++d0) qf[8 + d0] = *(const bf16x8*)(QR + qrow * 512 + h * 64 + d0 * 16 + hh * 8); }
    f32x16 o[4];
#pragma unroll
    for (int d0 = 0; d0 < 4; ++d0)
#pragma unroll
        for (int g = 0; g < 16; ++g) o[d0][g] = 0.f;
    float mrun = -INFINITY, lrun = 0.f;
    u32x4 kreg[3], vreg[2];
    const VAddr va = make_vaddr(lane);
    const __amdgpu_buffer_rsrc_t rKN = mk_rsrc(KN, M * 1024 * 2), rKR = mk_rsrc(KR, M * 64 * 2), rVA = mk_rsrc(VA, M * 1024 * 2);
    const unsigned vo0 = (tid >> 4) * 2048 + (tid & 15) * 16, vo1 = vo0 + 32 * 2048, vor = (tid >> 3) * 128 + (tid & 7) * 16;
    const unsigned so_n = ((unsigned)rowbase * 1024 + h * 128) * 2, so_r = (unsigned)rowbase * 64 * 2;
    const unsigned lk0 = (tid >> 4) * MLA_KSTR + (tid & 15) * 16, lk1 = lk0 + 32 * MLA_KSTR, lkr = (tid >> 3) * MLA_KSTR + 256 + (tid & 7) * 16;
    const unsigned lv0 = off_b((tid >> 4) & 31, tid & 15), lv1 = lv0 + 8192;
    const unsigned kfo = r * MLA_KSTR + hh * 16;
#define MLA_LOAD(t) do { const unsigned tn = so_n + (unsigned)(t) * (64 * 2048), tr_ = so_r + (unsigned)(t) * (64 * 128); \
        kreg[0] = bload(rKN, vo0, tn); kreg[1] = bload(rKN, vo1, tn); kreg[2] = bload(rKR, vor, tr_); vreg[0] = bload(rVA, vo0, tn); vreg[1] = bload(rVA, vo1, tn); } while (0)
#define MLA_STORE(buf) do { LAS unsigned char* kd = lds + (buf) * MLA_KBUF; LAS unsigned char* vd = lds + MLA_LDS_V + (buf) * VBUF; \
        *(LAS u32x4*)(kd + lk0) = kreg[0]; *(LAS u32x4*)(kd + lk1) = kreg[1]; *(LAS u32x4*)(kd + lkr) = kreg[2]; *(LAS u32x4*)(vd + lv0) = vreg[0]; *(LAS u32x4*)(vd + lv1) = vreg[1]; } while (0)
    MLA_LOAD(0); MLA_STORE(0); __builtin_amdgcn_s_waitcnt(0x0F70);   __syncthreads();
#define MLA_INTERVAL(MODE) { const int buf = t & 1; \
        if (t + 1 < NT) MLA_LOAD(t + 1); \
        if (MODE == 0) mla_tile<false>(lds + buf * MLA_KBUF + kfo, lds + MLA_LDS_V + buf * VBUF, qf, o, mrun, lrun, va, 0, hh); \
        if (MODE == 1) mla_tile<true>(lds + buf * MLA_KBUF + kfo, lds + MLA_LDS_V + buf * VBUF, qf, o, mrun, lrun, va, q0 + 32 * wid + r - 64 * t, hh); \
        if (t + 1 < NT) MLA_STORE(buf ^ 1); \
        __syncthreads(); }
    int t = 0;
    for (; t < tmax; ++t) MLA_INTERVAL(0)
    MLA_INTERVAL(1)
    for (++t; t < NT; ++t) MLA_INTERVAL(2)
#undef MLA_INTERVAL
#undef MLA_LOAD
#undef MLA_STORE
    const float inv = 1.0f / swap_sum(lrun);
    int t4 = tid; asm volatile("" : "+v"(t4)); const size_t qrow = rowbase + q0 + 32 * wid + (t4 & 31); const int hh2 = (t4 >> 5) & 1;
#pragma unroll
    for (int d0 = 0; d0 < 4; ++d0)
#pragma unroll
        for (int gg = 0; gg < 4; ++gg) { const size_t off = qrow * 2048 + h * 128 + 32 * d0 + 8 * gg + 4 * hh2;
            const unsigned long long sg = *(const unsigned long long*)(SG + off);
            const float g0 = __uint_as_float((unsigned)(sg << 16)), g1 = __uint_as_float((unsigned)sg & 0xffff0000u), g2 = __uint_as_float((unsigned)(sg >> 32) << 16), g3 = __uint_as_float((unsigned)(sg >> 32) & 0xffff0000u);
            const unsigned lo = cvtpk(o[d0][4 * gg] * inv * g0, o[d0][4 * gg + 1] * inv * g1), hi = cvtpk(o[d0][4 * gg + 2] * inv * g2, o[d0][4 * gg + 3] * inv * g3);
            *(unsigned long long*)(MIX + off) = (unsigned long long)lo | ((unsigned long long)hi << 32); }
}
DI float vmax3_s(float a, float b, float c) { float r; asm("v_max3_f32 %0, %1, %2, %3" : "=v"(r) : "v"(a), "v"(b), "v"(c)); return r; }
constexpr int M2_KBUF = 64 * 384, M2_LDS_V = 3 * M2_KBUF, M2_LDS_BYTES = M2_LDS_V + 3 * VBUF;
struct M2State { f32x16 o[4]; float mrun, lrun; };
template <int KIMM, int VIMM>
DI void mla2_iter(f32x16& zin, f32x16& zout, M2State& st, const u32x4& pi0, const u32x4& pi1, u32x4& po0, u32x4& po1, const bf16x8 (&qf)[12], const unsigned (&koff)[4], const unsigned (&voff)[2][4],
                  const bool masked, const int qrh) {
#define M2_KF(d0) (*(LAS const bf16x8*)(koff[(d0) & 3] + (unsigned)(KIMM + 128 * ((d0) >> 2))))
#define M2_VF(t, j) vtr((lcp)(voff[t][(j) & 3] + (unsigned)(VIMM + 4096 * ((j) >> 2))))
    if (masked) {
        asm volatile("" ::: "memory");
#pragma unroll
        for (int g = 0; g < 16; ++g) if (crow(g, 0) > qrh) zin[g] = -INFINITY;
    }
    bf16x8 kfA = M2_KF(0), kfB; s16x4 la, ha, lb, hb;
    float mt = 0.f, mnew = 0.f, alpha = 1.f, ps = 0.f; bool grow = false; float pe[16];
    SBAR();
#pragma unroll
    for (int i = 0; i < 20; ++i) {
        const int c5 = i % 5, blk5 = i / 5; const bool isP = (c5 == 2 || c5 == 4);
        const int qi = blk5 * 3 + (c5 < 2 ? c5 : 2), pj = blk5 * 2 + (c5 == 2 ? 0 : 1);
        if (isP) { const s16x4 lo = (pj & 1) ? lb : la, hi = (pj & 1) ? hb : ha; const bf16x8 vf = (bf16x8){lo[0], lo[1], lo[2], lo[3], hi[0], hi[1], hi[2], hi[3]};
            st.o[pj & 3] = MFMA_BF16(vf, __builtin_bit_cast(bf16x8, (pj >> 2) ? pi1 : pi0), st.o[pj & 3]); }
        else if (i == 0) { f32x16 zero_;
#pragma unroll
            for (int g = 0; g < 16; ++g) zero_[g] = 0.f;
            zout = MFMA_BF16(kfA, qf[0], zero_); }
        else zout = MFMA_BF16((qi & 1) ? kfB : kfA, qf[qi], zout);
        if (!isP && qi + 1 < 12) { const bf16x8 nx = M2_KF(qi + 1); if ((qi + 1) & 1) kfB = nx; else kfA = nx; }
        if (isP && pj + 1 < 8) { const s16x4 l_ = M2_VF(0, pj + 1), h_ = M2_VF(1, pj + 1); if ((pj + 1) & 1) { lb = l_; hb = h_; } else { la = l_; ha = h_; } }
        if (i == 0) { la = M2_VF(0, 0); ha = M2_VF(1, 0); }
        SBAR();
        if (i < 4) { float a = vmax3_s(zin[4 * i], zin[4 * i + 1], zin[4 * i + 2]); mt = i == 0 ? vmax3_s(a, zin[3], zin[3]) : vmax3_s(mt, a, zin[4 * i + 3]); asm volatile("" : "+v"(mt)); }
        if (i == 4) { mt = swap_max(mt); mnew = fmaxf(st.mrun, mt); alpha = __builtin_amdgcn_exp2f(st.mrun - mnew); grow = __builtin_amdgcn_ballot_w64(mt > st.mrun) != 0ull;
            st.mrun = mnew; st.lrun *= alpha; asm volatile("" : "+v"(mnew), "+v"(alpha)); }
        if (i >= 5 && i < 13) { const int g = 2 * (i - 5); float e0 = __builtin_amdgcn_exp2f(zin[g] - mnew), e1 = __builtin_amdgcn_exp2f(zin[g + 1] - mnew); ps += e0 + e1;
            asm volatile("" : "+v"(ps)); pe[g] = e0; pe[g + 1] = e1; }
        if (i >= 13 && i < 17) { const int w_ = i - 13; unsigned w0 = cvtpk(pe[4 * w_], pe[4 * w_ + 1]), w1 = cvtpk(pe[4 * w_ + 2], pe[4 * w_ + 3]); asm volatile("" : "+v"(w0), "+v"(w1));
            if (w_ < 2) { po0[2 * w_] = w0; po0[2 * w_ + 1] = w1; } else { po1[2 * (w_ - 2)] = w0; po1[2 * (w_ - 2) + 1] = w1; } }
        SBAR();
    }
    st.lrun += ps;
    if (grow) {
#pragma unroll
        for (int d0 = 0; d0 < 4; ++d0)
#pragma unroll
            for (int g = 0; g < 16; ++g) st.o[d0][g] *= alpha;
    }
#undef M2_KF
#undef M2_VF
}
DI void mla2_unit(LAS unsigned char* lds, unsigned char* ws, int b, int h, int qb, const int tid_in) {
    int tid = tid_in; asm volatile("" : "+v"(tid));
    const int lane = tid & 63, wid = __builtin_amdgcn_readfirstlane(tid >> 6), r = lane & 31, hh = lane >> 5;
    const bf16_t *QN = (const bf16_t*)(ws + WS_QN), *QR = (const bf16_t*)(ws + WS_QR), *KN = (const bf16_t*)(ws + WS_KN), *KR = (const bf16_t*)(ws + WS_KR), *VA = (const bf16_t*)(ws + WS_VA), *SG = (const bf16_t*)(ws + WS_SG);
    bf16_t* MIX = (bf16_t*)(ws + WS_MIX);
    const int q0 = qb * 256, NT = 4 * (qb + 1), tmax = (q0 + 32 * wid) >> 6; const size_t rowbase = (size_t)b * SEQ;
    bf16x8 qf[12];
    { const size_t qrow = rowbase + q0 + 32 * wid + r;
#pragma unroll
      for (int d0 = 0; d0 < 8; ++d0) qf[d0] = *(const bf16x8*)(QN + qrow * 1024 + h * 128 + d0 * 16 + hh * 8);
#pragma unroll
      for (int d0 = 0; d0 < 4; ++d0) qf[8 + d0] = *(const bf16x8*)(QR + qrow * 512 + h * 64 + d0 * 16 + hh * 8); }
    M2State st;
#pragma unroll
    for (int d0 = 0; d0 < 4; ++d0)
#pragma unroll
        for (int g = 0; g < 16; ++g) st.o[d0][g] = 0.f;
    st.mrun = -INFINITY; st.lrun = 0.f;
    unsigned koff[4], voff[2][4];
    { const unsigned blk = (lane >> 4) & 1, qq = (lane & 15) >> 2, p = lane & 3, f = (r >> 1) & 7;
      const unsigned kb_ = (unsigned)(size_t)lds + r * 384;
#pragma unroll
      for (int j = 0; j < 4; ++j) koff[j] = kb_ + 16 * ((2 * j + hh) ^ f);
      const unsigned vb0 = 256 * (4 * hh + qq) + 8 * (p & 1) + 16 * ((2 * blk + (p >> 1)) ^ hh), v0_ = (unsigned)(size_t)lds + M2_LDS_V + vb0, v1_ = (unsigned)(size_t)lds + M2_LDS_V + 2048 + (vb0 ^ 32);
#pragma unroll
      for (int d0 = 0; d0 < 4; ++d0) { voff[0][d0] = v0_ + ((64u * d0) ^ (64u * qq)); voff[1][d0] = v1_ + ((64u * d0) ^ (64u * qq)); } }
    const bf16_t* knb = KN + rowbase * 1024 + h * 128; const bf16_t* krb = KR + rowbase * 64; const bf16_t* vab = VA + rowbase * 1024 + h * 128;
    unsigned ksrc[3];
#pragma unroll
    for (int i_ = 0; i_ < 3; ++i_) { const int c_ = (3 * wid + i_) * 64 + lane, row_ = c_ / 24, ch_ = (c_ % 24) ^ ((row_ >> 1) & 7);
        ksrc[i_] = ch_ < 16 ? (unsigned)(row_ * 1024 + ch_ * 8) : (0x80000000u | (unsigned)(row_ * 64 + (ch_ - 16) * 8)); }
#define M2_DMAK(t, slot) do { _Pragma("unroll") for (int i_ = 0; i_ < 3; ++i_) { const unsigned o_ = ksrc[i_] & 0x7fffffffu; \
            const bf16_t* src_ = (ksrc[i_] >> 31) ? krb + (size_t)(t) * (64 * 64) + o_ : knb + (size_t)(t) * (64 * 1024) + o_; \
            __builtin_amdgcn_global_load_lds((const unsigned*)src_, (LAS unsigned*)(lds + (slot) * M2_KBUF + (3 * wid + i_) * 1024), 16, 0, 0); } } while (0)
#define M2_DMAV(t, slot) do { int t2_ = tid; asm volatile("" : "+v"(t2_)); const int ln_ = t2_ & 63, drow_ = 8 * wid + (ln_ >> 4), c15_ = ln_ & 15; \
        const unsigned s0_ = (unsigned)drow_ * 1024 + ((c15_ ^ (((drow_ & 3) << 2) | ((drow_ >> 2) & 3))) * 8), s1_ = (unsigned)(drow_ + 4) * 1024 + ((c15_ ^ ((((drow_ + 4) & 3) << 2) | (((drow_ + 4) >> 2) & 3))) * 8); \
        const bf16_t* vt = vab + (size_t)(t) * (64 * 1024); LAS unsigned char* vd = lds + M2_LDS_V + (slot) * VBUF + wid * 2048; \
        __builtin_amdgcn_global_load_lds((const unsigned*)(vt + s0_), (LAS unsigned*)vd, 16, 0, 0); __builtin_amdgcn_global_load_lds((const unsigned*)(vt + s1_), (LAS unsigned*)(vd + 1024), 16, 0, 0); } while (0)
    M2_DMAK(0, 0); M2_DMAV(0, 0); M2_DMAV(0, 2);
    if (NT > 1) M2_DMAK(1, 1);
    __builtin_amdgcn_s_waitcnt(0x0F70);
    __syncthreads();
    f32x16 za, zb;
#pragma unroll
    for (int g = 0; g < 16; ++g) { za[g] = 0.f; zb[g] = 0.f; }
#pragma unroll
    for (int d0 = 0; d0 < 12; ++d0) za = MFMA_BF16(*(LAS const bf16x8*)(koff[d0 & 3] + (unsigned)(128 * (d0 >> 2))), qf[d0], za);
    u32x4 pa[2], pb[2]; pa[0] = (u32x4){0u, 0u, 0u, 0u}; pa[1] = pa[0]; pb[0] = pa[0]; pb[1] = pa[0];
#define M2_INTERVAL(P) { if (t + 2 < NT) M2_DMAK(t + 2, ((P) + 2) % 3); if (t + 1 < NT) M2_DMAV(t + 1, ((P) + 1) % 3); \
        if (t <= tmax) {           \
            int qrh; { int t3 = tid; asm volatile("" : "+v"(t3)); qrh = q0 + 32 * wid + (t3 & 31) - 4 * ((t3 >> 5) & 1) - 64 * t; } const bool msk = t == tmax; \
            mla2_iter<(P) * M2_KBUF + 32 * 384, (((P) + 2) % 3) * VBUF + 8192>(za, zb, st, pa[0], pa[1], pb[0], pb[1], qf, koff, voff, msk, qrh); \
            mla2_iter<(((P) + 1) % 3) * M2_KBUF, (P) * VBUF>(zb, za, st, pb[0], pb[1], pa[0], pa[1], qf, koff, voff, msk, qrh - 32); \
            if (msk) {            \
                lcp vb_ = lds + M2_LDS_V + (P) * VBUF + 8192; const VAddr va_ = make_vaddr(tid & 63); \
                _Pragma("unroll") for (int j = 0; j < 8; ++j) st.o[j & 3] = MFMA_BF16(vfrag(vb_, j >> 2, j & 3, va_), __builtin_bit_cast(bf16x8, (j >> 2) ? pa[1] : pa[0]), st.o[j & 3]); } } \
        ++t; __syncthreads(); }
    int t = 0;
    for (;;) { M2_INTERVAL(0) if (t >= NT) break; M2_INTERVAL(1) if (t >= NT) break; M2_INTERVAL(2) if (t >= NT) break; }
#undef M2_INTERVAL
#undef M2_DMAK
#undef M2_DMAV
    const float inv = 1.0f / swap_sum(st.lrun);
    int t4 = tid; asm volatile("" : "+v"(t4)); const size_t qrow = rowbase + q0 + 32 * wid + (t4 & 31); const int hh2 = (t4 >> 5) & 1;
#pragma unroll
    for (int d0 = 0; d0 < 4; ++d0)
#pragma unroll
        for (int gg = 0; gg < 4; ++gg) { const size_t off = qrow * 2048 + h * 128 + 32 * d0 + 8 * gg + 4 * hh2;
            const unsigned long long sg = *(const unsigned long long*)(SG + off);
            const float g0 = __uint_as_float((unsigned)(sg << 16)), g1 = __uint_as_float((unsigned)sg & 0xffff0000u), g2 = __uint_as_float((unsigned)(sg >> 32) << 16), g3 = __uint_as_float((unsigned)(sg >> 32) & 0xffff0000u);
            const unsigned lo = cvtpk(st.o[d0][4 * gg] * inv * g0, st.o[d0][4 * gg + 1] * inv * g1), hi = cvtpk(st.o[d0][4 * gg + 2] * inv * g2, st.o[d0][4 * gg + 3] * inv * g3);
            *(unsigned long long*)(MIX + off) = (unsigned long long)lo | ((unsigned long long)hi << 32); }
}
DI void mla_phase(LAS unsigned char* lds, unsigned char* ws, const int tid) {
    const int G = gridDim.x, bx = blockIdx.x; const int vcu = (G % 8 == 0) ? (bx % 8) * (G / 8) + bx / 8 : bx;
    for (int p = vcu; p < 256; p += G) { const int bh = p >> 3, pr = p & 7;
#if MLA_PIPE
        mla2_unit(lds, ws, bh >> 3, bh & 7, 15 - pr, tid); mla2_unit(lds, ws, bh >> 3, bh & 7, pr, tid);
#else
        mla_unit(lds, ws, bh >> 3, bh & 7, 15 - pr, tid); mla_unit(lds, ws, bh >> 3, bh & 7, pr, tid);
#endif
 }
}

constexpr int SB_KBUF = 16384, SB_LDS_V = 3 * SB_KBUF, SB_LDS_UM = SB_LDS_V + 3 * VBUF, SB_LDS_BYTES = SB_LDS_UM + 2048;
DI float vmin_s(float a, float b) { float r; asm("v_min_f32 %0, %1, %2" : "=v"(r) : "v"(a), "v"(b)); return r; }
struct SbAddr { unsigned kx, vb0, vq; };
template <bool MASKED, int VAR>
DI void sb_iter(f32x16& zin, f32x16& zout, f32x16 (&o)[4], const u32x4& pi0, const u32x4& pi1, u32x4& po0, u32x4& po1, float& carry, const bf16x8 (&qf)[8], lcp ump, lcp knext, lcp vprev, const SbAddr& ad, int qrh) {
    u32x4 lw0, lw1; const float z0 = zin[0];
    unsigned kx = ad.kx, vq = ad.vq; asm volatile("" : "+v"(kx), "+v"(vq));
    bf16x8 kfa = *(LAS const bf16x8*)(knext + kx), kfb;
    const f16x8 um0 = *(LAS const f16x8*)ump, um1 = *(LAS const f16x8*)(ump + 16);
    SBAR();
#pragma unroll
    for (int k = 0; k < 8; ++k) {
        if (k == 0) {
#pragma unroll
            for (int g = 0; g < 16; ++g) zout[g] = 0.f;
        }
        if (VAR == 2 || VAR == 4 || VAR == 11 || VAR == 13) { asm volatile("" :: "v"((k & 1) ? kfb : kfa)); } else zout = MFMA_BF16((k & 1) ? kfb : kfa, qf[k], zout);
        if (VAR == 12) { zout = MFMA_BF16((k & 1) ? kfb : kfa, qf[k], zout); zout = MFMA_BF16((k & 1) ? kfb : kfa, qf[k], zout); }
        if (k + 1 < 8) { bf16x8 nx; if (VAR == 3 || VAR == 4 || VAR == 9 || VAR == 11 || VAR == 12 || VAR == 13) nx = qf[k]; else nx = *(LAS const bf16x8*)(knext + ((32u * (k + 1)) ^ kx)); if (k & 1) kfa = nx; else kfb = nx; }
        SBAR();
        float lv[2];
#pragma unroll
        for (int i = 0; i < 2; ++i) { const int g = 2 * k + i;
            float sp; if (VAR == 8 || VAR == 9 || VAR == 12) sp = zin[g]; else if (VAR == 13) { sp = __builtin_amdgcn_logf(1.0f + __builtin_amdgcn_exp2f(vmin_s(zin[g], 64.0f))); sp = __builtin_amdgcn_logf(1.0f + __builtin_amdgcn_exp2f(vmin_s(sp, 64.0f))); sp = __builtin_amdgcn_logf(1.0f + __builtin_amdgcn_exp2f(vmin_s(sp, 64.0f))); } else if (VAR == 1 || VAR == 4) sp = vmin_s(zin[g], 64.0f) * 0.5f; else sp = __builtin_amdgcn_logf(1.0f + __builtin_amdgcn_exp2f(vmin_s(zin[g], 64.0f)));
            if (MASKED) lv[i] = (crow(g, 0) < qrh) ? sp : 0.f; else lv[i] = sp; }
        unsigned w = cvtpk_h(lv[0], lv[1]);
        asm volatile("" : "+v"(w));
        if (k < 4) lw0[k & 3] = w; else lw1[k & 3] = w;
        SBAR();
    }
    zin = MFMA_F16(um0, __builtin_bit_cast(f16x8, lw0), zin); zin = MFMA_F16(um1, __builtin_bit_cast(f16x8, lw1), zin);
    SBAR();
    s16x4 la, ha, lb, hb;
    const unsigned vb0 = ad.vb0, vb1 = 2048 + (vb0 ^ 32);
    { const unsigned dq = vq; la = vtr(vprev + vb0 + dq); ha = vtr(vprev + vb1 + dq); }
#pragma unroll
    for (int j = 0; j < 8; ++j) {
        { const s16x4 lo = (j & 1) ? lb : la, hi = (j & 1) ? hb : ha;
          const bf16x8 vf = (bf16x8){lo[0], lo[1], lo[2], lo[3], hi[0], hi[1], hi[2], hi[3]};
          if (VAR == 2 || VAR == 4 || VAR == 11 || VAR == 13) { asm volatile("" :: "v"(vf)); } else o[j & 3] = MFMA_BF16(vf, __builtin_bit_cast(bf16x8, (j >> 2) ? pi1 : pi0), o[j & 3]);
          if (VAR == 12) { o[(j + 1) & 3] = MFMA_BF16(vf, __builtin_bit_cast(bf16x8, (j >> 2) ? pi1 : pi0), o[(j + 1) & 3]); o[(j + 2) & 3] = MFMA_BF16(vf, __builtin_bit_cast(bf16x8, (j >> 2) ? pi1 : pi0), o[(j + 2) & 3]); } }
        if (j + 1 < 8) { const unsigned dq = (64u * ((j + 1) & 3)) ^ vq; s16x4 l_, h_; if (VAR == 3 || VAR == 4 || VAR == 9 || VAR == 11 || VAR == 12 || VAR == 13) { l_ = (s16x4){(short)pi0[0], (short)pi0[1], (short)pi0[2], (short)pi0[3]}; h_ = l_; } else { l_ = vtr(vprev + 4096 * ((j + 1) >> 2) + vb0 + dq); h_ = vtr(vprev + 4096 * ((j + 1) >> 2) + vb1 + dq); }
            if (j & 1) { la = l_; ha = h_; } else { lb = l_; hb = h_; } }
        SBAR();
        float av[2];
#pragma unroll
        for (int i = 0; i < 2; ++i) { const int g = 2 * j + i; float a; if (VAR == 8 || VAR == 9 || VAR == 12) a = zin[g]; else if (VAR == 13) { a = __builtin_amdgcn_exp2f(zin[g] + carry); a = __builtin_amdgcn_exp2f(a + carry); a = __builtin_amdgcn_exp2f(a + carry); } else if (VAR == 1 || VAR == 4) a = zin[g] + carry; else a = __builtin_amdgcn_exp2f(zin[g] + carry); if (MASKED) av[i] = (crow(g, 0) < qrh) ? a : 0.f; else av[i] = a; }
        unsigned w = cvtpk(av[0], av[1]);
        asm volatile("" : "+v"(w));
        if (j < 4) po0[j & 3] = w; else po1[j & 3] = w;
        SBAR();
    }
    carry += bcast_lo(zin[0] - z0);
}
template <int KIMM, int VIMM>
DI void sb_iter_s(f32x16& zin, f32x16& zout, f32x16 (&o)[4], const u32x4& pi0, const u32x4& pi1, u32x4& po0, u32x4& po1, float& carry, const bf16x8 (&qf)[8], lcp ump,
                  const unsigned (&koff)[8], const unsigned (&voff)[2][4]) {
    u32x4 lw0, lw1; const float z0 = zin[0];
#define SB_KF(k) (*(LAS const bf16x8*)(koff[k] + (unsigned)KIMM))
#define SB_VF(t, j) vtr((lcp)(voff[t][(j) & 3] + (unsigned)(VIMM + 4096 * ((j) >> 2))))
    bf16x8 kfa = SB_KF(0), kfb;
    const f16x8 um0 = *(LAS const f16x8*)ump, um1 = *(LAS const f16x8*)(ump + 16);
    SBAR();
#pragma unroll
    for (int k = 0; k < 8; ++k) {
        if (k == 0) {
#pragma unroll
            for (int g = 0; g < 16; ++g) zout[g] = 0.f;
        }
        zout = MFMA_BF16((k & 1) ? kfb : kfa, qf[k], zout);
        if (k + 1 < 8) { const bf16x8 nx = SB_KF(k + 1); if (k & 1) kfa = nx; else kfb = nx; }
        SBAR();
        float lv[2];
#pragma unroll
        for (int i = 0; i < 2; ++i) lv[i] = __builtin_amdgcn_logf(1.0f + __builtin_amdgcn_exp2f(vmin_s(zin[2 * k + i], 64.0f)));
        unsigned w = cvtpk_h(lv[0], lv[1]);
        asm volatile("" : "+v"(w));
        if (k < 4) lw0[k & 3] = w; else lw1[k & 3] = w;
        SBAR();
    }
    s16x4 la = SB_VF(0, 0), ha = SB_VF(1, 0), lb, hb;
    SBAR();
    zin = MFMA_F16(um0, __builtin_bit_cast(f16x8, lw0), zin); zin = MFMA_F16(um1, __builtin_bit_cast(f16x8, lw1), zin);
    SBAR();
#pragma unroll
    for (int j = 0; j < 8; ++j) {
        { const s16x4 lo = (j & 1) ? lb : la, hi = (j & 1) ? hb : ha;
          const bf16x8 vf = (bf16x8){lo[0], lo[1], lo[2], lo[3], hi[0], hi[1], hi[2], hi[3]};
          o[j & 3] = MFMA_BF16(vf, __builtin_bit_cast(bf16x8, (j >> 2) ? pi1 : pi0), o[j & 3]); }
        if (j + 1 < 8) { const s16x4 l_ = SB_VF(0, j + 1), h_ = SB_VF(1, j + 1); if (j & 1) { la = l_; ha = h_; } else { lb = l_; hb = h_; } }
        SBAR();
        float av[2];
#pragma unroll
        for (int i = 0; i < 2; ++i) av[i] = __builtin_amdgcn_exp2f(zin[2 * j + i] + carry);
        unsigned w = cvtpk(av[0], av[1]);
        asm volatile("" : "+v"(w));
        if (j < 4) po0[j & 3] = w; else po1[j & 3] = w;
        SBAR();
    }
#undef SB_KF
#undef SB_VF
    carry += bcast_lo(zin[0] - z0);
}
template <int P>
DI void sb_tile_s(f32x16& za, f32x16& zb, f32x16 (&o)[4], u32x4 (&pa)[2], u32x4 (&pb)[2], float& carry, const bf16x8 (&qf)[8], lcp ump, const unsigned (&koff)[8], const unsigned (&voff)[2][4]) {
    constexpr int KS = P, KSN = (P + 1) % 3, VS = P, VSP = (P + 2) % 3;
    sb_iter_s<KS * SB_KBUF, VSP * VBUF>(za, zb, o, pa[0], pa[1], pb[0], pb[1], carry, qf, ump, koff, voff);
    sb_iter_s<KSN * SB_KBUF + 8192, VS * VBUF + 8192>(zb, za, o, pb[0], pb[1], pa[0], pa[1], carry, qf, ump, koff, voff);
}
template <bool MASKED, int VAR>
DI void sb_tile(LAS unsigned char* lds, f32x16& za, f32x16& zb, f32x16 (&o)[4], u32x4 (&pa)[2], u32x4 (&pb)[2], float& carry, const bf16x8 (&qf)[8], lcp ump, const SbAddr& ad,
                unsigned krow_off, int ks, int ksn, int vs, int vsp, int qrh0) {
    sb_iter<MASKED, VAR>(za, zb, o, pa[0], pa[1], pb[0], pb[1], carry, qf, ump, lds + ks * SB_KBUF + krow_off, lds + SB_LDS_V + vsp * VBUF, ad, qrh0 - 32);
    sb_iter<MASKED, VAR>(zb, za, o, pb[0], pb[1], pa[0], pa[1], carry, qf, ump, lds + ksn * SB_KBUF + 8192 + krow_off, lds + SB_LDS_V + vs * VBUF + 8192, ad, qrh0);
}
template <int VAR> DI void sb_unit(LAS unsigned char* lds, unsigned char* ws, int b, int h, int qb, const int tid_in) {
    int tid = tid_in; asm volatile("" : "+v"(tid));
    const int lane = tid & 63, wid = __builtin_amdgcn_readfirstlane(tid >> 6), r = lane & 31, hh = lane >> 5;
    const bf16_t *Q2 = (const bf16_t*)(ws + WS_Q2), *K2 = (const bf16_t*)(ws + WS_K2), *V2 = (const bf16_t*)(ws + WS_V2), *SG2 = (const bf16_t*)(ws + WS_SG2);
    bf16_t* MIX2 = (bf16_t*)(ws + (VAR ? WS_A : WS_MIX2));
    const int q0 = qb * 256, NT = 4 * (qb + 1), tmax = (q0 + 32 * wid) >> 6; const size_t rowbase = (size_t)b * SEQ;
    bf16x8 qf[8];
    { const size_t qrow = rowbase + q0 + 32 * wid + r;
#pragma unroll
      for (int d0 = 0; d0 < 8; ++d0) qf[d0] = *(const bf16x8*)(Q2 + qrow * 2048 + h * 128 + d0 * 16 + hh * 8); }
    { f16x8 um[2];
#pragma unroll
      for (int s = 0; s < 2; ++s)
#pragma unroll
          for (int j = 0; j < 8; ++j) um[s][j] = (16 * s + 8 * (j >> 2) + 4 * hh + (j & 3)) >= r ? (_Float16)-1.0f : (_Float16)0.0f;
      *(LAS f16x8*)(lds + SB_LDS_UM + lane * 32) = um[0]; *(LAS f16x8*)(lds + SB_LDS_UM + lane * 32 + 16) = um[1]; }
    lcp ump = lds + SB_LDS_UM + lane * 32;
    f32x16 o[4];
#pragma unroll
    for (int d0 = 0; d0 < 4; ++d0)
#pragma unroll
        for (int g = 0; g < 16; ++g) o[d0][g] = 0.f;
    float carry = 0.f;
    SbAddr ad;
    { const unsigned blk = (lane >> 4) & 1, qq = (lane & 15) >> 2, p = lane & 3;
      ad.kx = ((r & 15) >> 1) << 5;
      ad.vb0 = 256 * (4 * hh + qq) + 8 * (p & 1) + 16 * ((2 * blk + (p >> 1)) ^ hh); ad.vq = 64 * qq; }
    const unsigned krow_off = r * 256 + ((hh ^ (r & 1)) << 4);
    const bf16_t* kbase = K2 + rowbase * 2048 + h * 128; const bf16_t* vbase = V2 + rowbase * 2048 + h * 128;
#define SB_DMA_SRC() int t2_ = tid; asm volatile("" : "+v"(t2_)); const int ln_ = t2_ & 63, drow_ = 8 * wid + (ln_ >> 4), c15_ = ln_ & 15;
#define SB_DMAK(tau, slot) do { SB_DMA_SRC(); const unsigned s0_ = (unsigned)drow_ * 2048 + ((c15_ ^ (drow_ & 15)) * 8), s1_ = (unsigned)(drow_ + 4) * 2048 + ((c15_ ^ ((drow_ + 4) & 15)) * 8); \
        const bf16_t* kt = kbase + (size_t)(NT - 1 - (tau)) * (64 * 2048); LAS unsigned char* kd = lds + (slot) * SB_KBUF + wid * 2048; \
        __builtin_amdgcn_global_load_lds((const unsigned*)(kt + s0_), (LAS unsigned*)kd, 16, 0, 0); __builtin_amdgcn_global_load_lds((const unsigned*)(kt + s1_), (LAS unsigned*)(kd + 1024), 16, 0, 0); } while (0)
#define SB_DMAV(tau, slot) do { SB_DMA_SRC(); const unsigned s0_ = (unsigned)drow_ * 2048 + ((c15_ ^ (((drow_ & 3) << 2) | ((drow_ >> 2) & 3))) * 8), s1_ = (unsigned)(drow_ + 4) * 2048 + ((c15_ ^ ((((drow_ + 4) & 3) << 2) | (((drow_ + 4) >> 2) & 3))) * 8); \
        const bf16_t* vt = vbase + (size_t)(NT - 1 - (tau)) * (64 * 2048); LAS unsigned char* vd = lds + SB_LDS_V + (slot) * VBUF + wid * 2048; \
        __builtin_amdgcn_global_load_lds((const unsigned*)(vt + s0_), (LAS unsigned*)vd, 16, 0, 0); __builtin_amdgcn_global_load_lds((const unsigned*)(vt + s1_), (LAS unsigned*)(vd + 1024), 16, 0, 0); } while (0)
    SB_DMAK(0, 0); SB_DMAV(0, 0);
    if (NT > 1) SB_DMAK(1, 1);
    __builtin_amdgcn_s_waitcnt(0x0F70);
    __syncthreads();
    f32x16 za, zb;
#pragma unroll
    for (int g = 0; g < 16; ++g) { za[g] = 0.f; zb[g] = 0.f; }
    u32x4 pa[2], pb[2]; pa[0] = (u32x4){0u, 0u, 0u, 0u}; pa[1] = pa[0]; pb[0] = pa[0]; pb[1] = pa[0];
    int ks = 0, ks1 = 1, vs = 0, vsp = 0;
    const int nmask = NT - tmax;
#define SB_INTERVAL(MASKED) { const int t = NT - 1 - tau; const int ks2 = (ks1 == 2) ? 0 : ks1 + 1, vs1 = (vs == 2) ? 0 : vs + 1; \
        if (VAR != 5 && tau + 2 < NT) SB_DMAK(tau + 2, ks2); \
        if (VAR != 5 && tau + 1 < NT) SB_DMAV(tau + 1, vs1); \
        int qrh0; { int t3 = tid; asm volatile("" : "+v"(t3)); qrh0 = q0 + 32 * wid + (t3 & 31) - 4 * ((t3 >> 5) & 1) - 64 * t; }        \
        if (VAR != 7 || wid < 4) sb_tile<MASKED, VAR>(lds, za, zb, o, pa, pb, carry, qf, ump, ad, krow_off, ks, (tau + 1 < NT ? ks1 : ks), vs, vsp, qrh0); \
        ks = ks1; ks1 = ks2; vsp = vs; vs = vs1; \
        if (VAR != 5) __syncthreads(); }
    int tau = 0;
    for (; tau < nmask - 1; ++tau) { const int ks2 = (ks1 == 2) ? 0 : ks1 + 1, vs1 = (vs == 2) ? 0 : vs + 1;
        if (VAR != 5 && tau + 2 < NT) SB_DMAK(tau + 2, ks2);
        if (VAR != 5 && tau + 1 < NT) SB_DMAV(tau + 1, vs1);
        ks = ks1; ks1 = ks2; vsp = vs; vs = vs1;
        if (VAR != 5) __syncthreads(); }
    { lcp kp = lds + ks * SB_KBUF + 8192 + krow_off;
#pragma unroll
      for (int k = 0; k < 8; ++k) za = MFMA_BF16(*(LAS const bf16x8*)(kp + ((32u * k) ^ ad.kx)), qf[k], za); }
    for (; tau < nmask; ++tau) SB_INTERVAL(true)
    for (; tau < NT && tau % 3 != 0; ++tau) SB_INTERVAL(false)
    if (VAR == 0 && tau + 3 <= NT) {
        unsigned koff[8], voff[2][4];
        { const unsigned kb_ = (unsigned)(size_t)lds + krow_off, v0_ = (unsigned)(size_t)lds + SB_LDS_V + ad.vb0, v1_ = (unsigned)(size_t)lds + SB_LDS_V + 2048 + (ad.vb0 ^ 32);
#pragma unroll
          for (int k = 0; k < 8; ++k) koff[k] = kb_ + ((32u * k) ^ ad.kx);
#pragma unroll
          for (int d0 = 0; d0 < 4; ++d0) { voff[0][d0] = v0_ + ((64u * d0) ^ ad.vq); voff[1][d0] = v1_ + ((64u * d0) ^ ad.vq); } }
#define SB_INTERVAL_S(P) { if (tau + 2 < NT) SB_DMAK(tau + 2, (P + 2) % 3); if (tau + 1 < NT) SB_DMAV(tau + 1, (P + 1) % 3); \
            sb_tile_s<P>(za, zb, o, pa, pb, carry, qf, ump, koff, voff); ++tau; __syncthreads(); }
        for (; tau + 3 <= NT;) { SB_INTERVAL_S(0) SB_INTERVAL_S(1) SB_INTERVAL_S(2) }
#undef SB_INTERVAL_S
        ks = tau % 3; ks1 = (tau + 1) % 3; vs = tau % 3; vsp = (tau + 2) % 3;
    }
    for (; tau < NT; ++tau) SB_INTERVAL(false)
#undef SB_INTERVAL
    { lcp vp = lds + SB_LDS_V + vsp * VBUF;
#pragma unroll
      for (int j = 0; j < 8; ++j) { const unsigned dq = (64u * (j & 3)) ^ ad.vq;
          const s16x4 lo = vtr(vp + 4096 * (j >> 2) + ad.vb0 + dq), hi = vtr(vp + 4096 * (j >> 2) + 2048 + (ad.vb0 ^ 32) + dq);
          o[j & 3] = MFMA_BF16(((bf16x8){lo[0], lo[1], lo[2], lo[3], hi[0], hi[1], hi[2], hi[3]}), __builtin_bit_cast(bf16x8, (j >> 2) ? pa[1] : pa[0]), o[j & 3]); } }
    __syncthreads();
#undef SB_DMAK
#undef SB_DMAV
#undef SB_DMA_SRC
    int t4 = tid; asm volatile("" : "+v"(t4)); const size_t qrow = rowbase + q0 + 32 * wid + (t4 & 31); const int hh2 = (t4 >> 5) & 1;
#pragma unroll
    for (int d0 = 0; d0 < 4; ++d0)
#pragma unroll
        for (int gg = 0; gg < 4; ++gg) { const size_t off = qrow * 2048 + h * 128 + 32 * d0 + 8 * gg + 4 * hh2;
            const unsigned long long sg = *(const unsigned long long*)(SG2 + off);
            const float g0 = __uint_as_float((unsigned)(sg << 16)), g1 = __uint_as_float((unsigned)sg & 0xffff0000u), g2 = __uint_as_float((unsigned)(sg >> 32) << 16), g3 = __uint_as_float((unsigned)(sg >> 32) & 0xffff0000u);
            const unsigned lo = cvtpk(o[d0][4 * gg] * g0, o[d0][4 * gg + 1] * g1), hi = cvtpk(o[d0][4 * gg + 2] * g2, o[d0][4 * gg + 3] * g3);
            *(unsigned long long*)(MIX2 + off) = (unsigned long long)lo | ((unsigned long long)hi << 32); }
}
template <int VAR> DI void sb_phase(LAS unsigned char* lds, unsigned char* ws, const int tid) {
    const int G = gridDim.x, bx = blockIdx.x; const int vcu = (G % 8 == 0) ? (bx % 8) * (G / 8) + bx / 8 : bx;
    for (int p = vcu; p < 512; p += G) { const int bh = p >> 3, pr = p & 7; sb_unit<VAR>(lds, ws, bh >> 4, bh & 15, 15 - pr, tid); sb_unit<VAR>(lds, ws, bh >> 4, bh & 15, pr, tid); }
}

constexpr int DIL_KSTR = 272, DIL_WAVE_BYTES = 32 * DIL_KSTR + 8192, DIL_LDS_BYTES = 8 * DIL_WAVE_BYTES;
DI void softmax_blk(f32x16& s0, f32x16 (&o)[4], float& mrun, float& lrun) {
    float mt = s0[0];
#pragma unroll
    for (int g = 1; g < 16; ++g) mt = fmaxf(mt, s0[g]);
    mt = swap_max(mt);
    if (__builtin_amdgcn_ballot_w64(mt > mrun) != 0ull) {
        const float mn = fmaxf(mrun, mt), alpha = __builtin_amdgcn_exp2f(mrun - mn); mrun = mn; lrun *= alpha;
#pragma unroll
        for (int d0 = 0; d0 < 4; ++d0)
#pragma unroll
            for (int g = 0; g < 16; ++g) o[d0][g] *= alpha;
    }
    float ps = 0.f;
#pragma unroll
    for (int g = 0; g < 16; ++g) { s0[g] = __builtin_amdgcn_exp2f(s0[g] - mrun); ps += s0[g]; }
    lrun += ps;
}
DI void dil_wave_unit(LAS unsigned char* wl, unsigned char* ws, int p, int b, int h, int res, int m0w, const int tid_in) {
    int tid = tid_in; asm volatile("" : "+v"(tid));
    const int lane = tid & 63, r = lane & 31, hh = lane >> 5; const int dil = p == 0 ? 1 : p == 1 ? 4 : 16;
    const bf16_t *QB = (const bf16_t*)(ws + WS_QB), *KB = (const bf16_t*)(ws + WS_KB), *VB = (const bf16_t*)(ws + WS_VB);
    const size_t rowbase = (size_t)b * SEQ; const size_t qrow = rowbase + (size_t)(m0w + r) * dil + res;
    const __amdgpu_buffer_rsrc_t rK = mk_rsrc(KB, M * 1024 * 2), rV = mk_rsrc(VB, M * 1024 * 2);
    const unsigned vo = (unsigned)(lane >> 4) * dil * 2048 + (lane & 15) * 16;
    const unsigned so0 = (unsigned)((rowbase + res) * 1024 + h * 128) * 2;
    const float* biasc = (const float*)(ws + WS_BIASC) + (size_t)(p * 8 + h) * 5 * 1024 + lane * 16;
    u32x4 kr[8], vr[8]; f32x4 br[4];
    const int kb0 = m0w >> 5;
#define DIL_LOAD(di) do { const unsigned sb_ = so0 + (unsigned)(32 * (kb0 - (di))) * dil * 2048; \
        _Pragma("unroll") for (int i = 0; i < 8; ++i) { kr[i] = bload(rK, vo + (unsigned)(4 * i) * dil * 2048, sb_); vr[i] = bload(rV, vo + (unsigned)(4 * i) * dil * 2048, sb_); } \
        _Pragma("unroll") for (int j = 0; j < 4; ++j) br[j] = ((const f32x4*)(biasc + (di) * 1024))[j]; } while (0)
    DIL_LOAD(0);
    bf16x8 qf[8];
#pragma unroll
    for (int d0 = 0; d0 < 8; ++d0) qf[d0] = *(const bf16x8*)(QB + qrow * 1024 + h * 128 + d0 * 16 + hh * 8);
    f32x16 o[4];
#pragma unroll
    for (int d0 = 0; d0 < 4; ++d0)
#pragma unroll
        for (int g = 0; g < 16; ++g) o[d0][g] = 0.f;
    float mrun = -INFINITY, lrun = 0.f;
    const VAddr va = make_vaddr(lane);
    const unsigned lk = (lane >> 4) * DIL_KSTR + (lane & 15) * 16;
    for (int di = 0; di < 5; ++di) {
        if (kb0 - di < 0) break;
        asm volatile("s_waitcnt lgkmcnt(0)" ::: "memory");
#pragma unroll
        for (int i = 0; i < 8; ++i) { *(LAS u32x4*)(wl + lk + 4 * i * DIL_KSTR) = kr[i]; *(LAS u32x4*)(wl + 32 * DIL_KSTR + off_b((lane >> 4) + 4 * i, lane & 15)) = vr[i]; }
        f32x16 s0;
#pragma unroll
        for (int j = 0; j < 4; ++j) { s0[4 * j] = br[j][0]; s0[4 * j + 1] = br[j][1]; s0[4 * j + 2] = br[j][2]; s0[4 * j + 3] = br[j][3]; }
        if (di + 1 < 5 && kb0 - (di + 1) >= 0) DIL_LOAD(di + 1);
        asm volatile("s_waitcnt lgkmcnt(0)" ::: "memory");
        lcp kp = wl + r * DIL_KSTR + hh * 16;
#pragma unroll
        for (int d0 = 0; d0 < 8; ++d0) s0 = MFMA_BF16(*(LAS const bf16x8*)(kp + d0 * 32), qf[d0], s0);
        softmax_blk(s0, o, mrun, lrun);
        lcp vb = wl + 32 * DIL_KSTR;
#pragma unroll
        for (int s = 0; s < 2; ++s) { const bf16x8 pf = pack_bf(s0, s);
#pragma unroll
            for (int d0 = 0; d0 < 4; ++d0) o[d0] = MFMA_BF16(vfrag(vb, s, d0, va), pf, o[d0]); }
    }
#undef DIL_LOAD
    const float lt = swap_sum(lrun), inv = 1.0f / lt;
    bf16_t* OP = (bf16_t*)(ws + (p == 0 ? WS_OP0 : p == 1 ? WS_OP1 : WS_OP2));
#pragma unroll
    for (int d0 = 0; d0 < 4; ++d0)
#pragma unroll
        for (int gg = 0; gg < 4; ++gg) { const size_t off = qrow * 1024 + h * 128 + 32 * d0 + 8 * gg + 4 * hh;
            const unsigned lo = cvtpk(o[d0][4 * gg] * inv, o[d0][4 * gg + 1] * inv), hi = cvtpk(o[d0][4 * gg + 2] * inv, o[d0][4 * gg + 3] * inv);
            *(unsigned long long*)(OP + off) = (unsigned long long)lo | ((unsigned long long)hi << 32); }
    if (hh == 0) ((float*)(ws + WS_LSE))[((size_t)p * M + qrow) * 8 + h] = mrun + __builtin_amdgcn_logf(lt);
}
constexpr int DILW_LDS_BYTES = 12 * 8192;
DI void dil_wg_unit(LAS unsigned char* lds, unsigned char* ws, int p, int b, int h, int res, int m0, const int tid_in) {
    int tid = tid_in; asm volatile("" : "+v"(tid));
    const int lane = tid & 63, wid = __builtin_amdgcn_readfirstlane(tid >> 6), r = lane & 31, hh = lane >> 5; const int dil = p == 0 ? 1 : p == 1 ? 4 : 16;
    const bf16_t *QB = (const bf16_t*)(ws + WS_QB), *KB = (const bf16_t*)(ws + WS_KB), *VB = (const bf16_t*)(ws + WS_VB);
    const size_t rowbase = (size_t)b * SEQ; const size_t qrow = rowbase + (size_t)(m0 + 32 * wid + r) * dil + res;
    const int kbw = (m0 >> 5) - 4;
    const int prow = 4 * wid + (lane >> 4);
    const unsigned ksw = ((lane & 15) ^ (prow & 15)) * 8, vsw = ((lane & 15) ^ (((prow & 3) << 2) | ((prow >> 2) & 3))) * 8;
    const bf16_t* kg = KB + (rowbase + res) * 1024 + h * 128; const bf16_t* vg = VB + (rowbase + res) * 1024 + h * 128;
#pragma unroll
    for (int i = 0; i < 12; ++i) { const int kb = kbw + i; if (kb >= 0)
        __builtin_amdgcn_global_load_lds((const unsigned*)(kg + (size_t)(32 * kb + prow) * dil * 1024 + ksw), (LAS unsigned*)(lds + i * 8192 + wid * 1024), 16, 0, 0); }
    bf16x8 qf[8];
#pragma unroll
    for (int d0 = 0; d0 < 8; ++d0) qf[d0] = *(const bf16x8*)(QB + qrow * 1024 + h * 128 + d0 * 16 + hh * 8);
    const float* biasc = (const float*)(ws + WS_BIASC) + (size_t)(p * 8 + h) * 5 * 1024 + lane * 16;
    f32x16 sc[5];
#pragma unroll
    for (int di = 0; di < 5; ++di) { const f32x4* bp = (const f32x4*)(biasc + di * 1024);
#pragma unroll
        for (int j = 0; j < 4; ++j) { const f32x4 v = bp[j]; sc[di][4 * j] = v[0]; sc[di][4 * j + 1] = v[1]; sc[di][4 * j + 2] = v[2]; sc[di][4 * j + 3] = v[3]; } }
    __builtin_amdgcn_s_waitcnt(0x0F70);
    __syncthreads();
    const unsigned kx = ((r & 15) >> 1) << 5, krow_off = r * 256 + ((hh ^ (r & 1)) << 4);
#pragma unroll
    for (int di = 0; di < 5; ++di) { const int jj = wid + 4 - di;
        if (kbw + jj >= 0) { lcp kp = lds + jj * 8192 + krow_off;
#pragma unroll
            for (int k = 0; k < 8; ++k) sc[di] = MFMA_BF16(*(LAS const bf16x8*)(kp + ((32u * k) ^ kx)), qf[k], sc[di]); }
        else {
#pragma unroll
            for (int g = 0; g < 16; ++g) sc[di][g] = -INFINITY; } }
    float mx = sc[0][0];
#pragma unroll
    for (int di = 0; di < 5; ++di)
#pragma unroll
        for (int g = 0; g < 16; ++g) mx = fmaxf(mx, sc[di][g]);
    mx = swap_max(mx);
    float ps = 0.f; u32x4 pw[5][2];
#pragma unroll
    for (int di = 0; di < 5; ++di) {
#pragma unroll
        for (int g = 0; g < 16; ++g) { sc[di][g] = __builtin_amdgcn_exp2f(sc[di][g] - mx); ps += sc[di][g]; }
        pw[di][0] = __builtin_bit_cast(u32x4, pack_bf(sc[di], 0)); pw[di][1] = __builtin_bit_cast(u32x4, pack_bf(sc[di], 1)); }
    __syncthreads();
#pragma unroll
    for (int i = 0; i < 12; ++i) { const int kb = kbw + i; if (kb >= 0)
        __builtin_amdgcn_global_load_lds((const unsigned*)(vg + (size_t)(32 * kb + prow) * dil * 1024 + vsw), (LAS unsigned*)(lds + i * 8192 + wid * 1024), 16, 0, 0); }
    f32x16 o[4];
#pragma unroll
    for (int d0 = 0; d0 < 4; ++d0)
#pragma unroll
        for (int g = 0; g < 16; ++g) o[d0][g] = 0.f;
    const VAddr va = make_vaddr(lane);
    __builtin_amdgcn_s_waitcnt(0x0F70);
    __syncthreads();
#pragma unroll
    for (int di = 0; di < 5; ++di) { const int jj = wid + 4 - di;
        if (kbw + jj >= 0) { lcp vb = lds + jj * 8192;
#pragma unroll
            for (int s = 0; s < 2; ++s)
#pragma unroll
                for (int d0 = 0; d0 < 4; ++d0) o[d0] = MFMA_BF16(vfrag(vb, s, d0, va), __builtin_bit_cast(bf16x8, pw[di][s]), o[d0]); } }
    const float lt = swap_sum(ps), inv = 1.0f / lt;
    bf16_t* OP = (bf16_t*)(ws + (p == 0 ? WS_OP0 : p == 1 ? WS_OP1 : WS_OP2));
#pragma unroll
    for (int d0 = 0; d0 < 4; ++d0)
#pragma unroll
        for (int gg = 0; gg < 4; ++gg) { const size_t off = qrow * 1024 + h * 128 + 32 * d0 + 8 * gg + 4 * hh;
            const unsigned lo = cvtpk(o[d0][4 * gg] * inv, o[d0][4 * gg + 1] * inv), hi = cvtpk(o[d0][4 * gg + 2] * inv, o[d0][4 * gg + 3] * inv);
            *(unsigned long long*)(OP + off) = (unsigned long long)lo | ((unsigned long long)hi << 32); }
    if (hh == 0) ((float*)(ws + WS_LSE))[((size_t)p * M + qrow) * 8 + h] = mx + __builtin_amdgcn_logf(lt);
    __syncthreads();
}
DI void dil_phase(LAS unsigned char* lds, unsigned char* ws, const int tid) {
    for (int u = blockIdx.x; u < 1536; u += gridDim.x) {
        const int cidx = u & 15, h = (u >> 4) & 7, b = (u >> 7) & 3, p = u >> 9;
        const int res = p == 0 ? 0 : p == 1 ? (cidx & 3) : cidx, m0 = p == 0 ? 256 * cidx : p == 1 ? 256 * (cidx >> 2) : 0;
        dil_wg_unit(lds, ws, p, b, h, res, m0, tid);
    }
}
}

__global__ void __launch_bounds__(512, 2) k_mla_fast(Ctx c) { extern __shared__ __attribute__((aligned(16))) unsigned char lds[]; att::mla_phase((LAS unsigned char*)lds, c.ws, (int)threadIdx.x); }
__global__ void __launch_bounds__(512, 2) k_sb_fast(Ctx c) { extern __shared__ __attribute__((aligned(16))) unsigned char lds[]; att::sb_phase<0>((LAS unsigned char*)lds, c.ws, (int)threadIdx.x); }
__global__ void __launch_bounds__(512, 2) k_dil_fast(Ctx c) { extern __shared__ __attribute__((aligned(16))) unsigned char lds[]; att::dil_phase((LAS unsigned char*)lds, c.ws, (int)threadIdx.x); }

template <bool FROMBF>
DI void final_norm_row(float* out, const bf16_t* xb, const float* gain, int row, int lane) {
    f32x4* xr = (f32x4*)(out + (size_t)row * D_MODEL) + lane; const f32x4* g = (const f32x4*)gain + lane;
    f32x4 v[8]; float s = 0.f;
    if (FROMBF) { const u32x4* br = (const u32x4*)(xb + (size_t)row * D_MODEL) + lane;
#pragma unroll
        for (int j = 0; j < 4; ++j) { const u32x4 w = br[64 * j];
            v[2 * j] = (f32x4){__uint_as_float(w[0] << 16), __uint_as_float(w[0] & 0xffff0000u), __uint_as_float(w[1] << 16), __uint_as_float(w[1] & 0xffff0000u)};
            v[2 * j + 1] = (f32x4){__uint_as_float(w[2] << 16), __uint_as_float(w[2] & 0xffff0000u), __uint_as_float(w[3] << 16), __uint_as_float(w[3] & 0xffff0000u)}; }
#pragma unroll
        for (int j = 0; j < 8; ++j) s += v[j].x * v[j].x + v[j].y * v[j].y + v[j].z * v[j].z + v[j].w * v[j].w;
        const float r = rsqrtf(wave_sum(s) * (1.0f / D_MODEL) + EPS);
        f32x4* o4 = (f32x4*)(out + (size_t)row * D_MODEL); const f32x4* g4 = (const f32x4*)gain;
#pragma unroll
        for (int j = 0; j < 4; ++j) { const int i0 = 128 * j + 2 * lane; o4[i0] = v[2 * j] * r * g4[i0]; o4[i0 + 1] = v[2 * j + 1] * r * g4[i0 + 1]; }
    } else {
#pragma unroll
        for (int j = 0; j < 8; ++j) { v[j] = xr[64 * j]; s += v[j].x * v[j].x + v[j].y * v[j].y + v[j].z * v[j].z + v[j].w * v[j].w; }
        const float r = rsqrtf(wave_sum(s) * (1.0f / D_MODEL) + EPS);
#pragma unroll
        for (int j = 0; j < 8; ++j) xr[64 * j] = v[j] * r * g[64 * j];
    }
}
__global__ void __launch_bounds__(256) k_final_norm(float* out, const float* gain) { final_norm_row<false>(out, nullptr, gain, blockIdx.x * 4 + (threadIdx.x >> 6), threadIdx.x & 63); }
__global__ void __launch_bounds__(256) k_final_norm_bf(float* out, const bf16_t* xb, const float* gain) { final_norm_row<true>(out, xb, gain, blockIdx.x * 4 + (threadIdx.x >> 6), threadIdx.x & 63); }

#define XB_TMO      128
#define XB_XCNT(j)  (256  + 64 * (j))
#define XB_XSUB(j)  (1280 + 64 * (j))
#define XB_XGEN(j)  (2304 + 64 * (j))
#define XB_TOP      3328
#define XB_TOPGEN   3392
#define XCD_BAR_WORDS 3456
#define XB_SPIN_CAP (1u << 22)
DI unsigned xb_ld(unsigned* p)              { return __hip_atomic_load(p, __ATOMIC_RELAXED, __HIP_MEMORY_SCOPE_AGENT); }
DI unsigned xb_add(unsigned* p, unsigned v) { return __hip_atomic_fetch_add(p, v, __ATOMIC_RELAXED, __HIP_MEMORY_SCOPE_AGENT); }
DI unsigned xb_xcc_id() { return (unsigned)__builtin_amdgcn_s_getreg((3 << 11) | 20) & 0xFu; }
#define XB_SPIN(cond, bar) do { unsigned _sp = 0; while (cond) { __builtin_amdgcn_s_sleep(1); \
    if ((++_sp & 255u) == 0u) { if (xb_ld(&(bar)[XB_TMO])) break; if (_sp > XB_SPIN_CAP) { atomicAdd(&(bar)[XB_TMO], 1u); break; } } } } while (0)
struct XcdBarrier { unsigned* bar; unsigned x; volatile LAS unsigned* st; };
DI XcdBarrier xcd_barrier_post(unsigned* bar, volatile LAS unsigned* st, int tid) {
    XcdBarrier b; b.bar = bar; b.x = xb_xcc_id(); b.st = st;
    if (tid == 0) (void)xb_add(&bar[XB_XCNT(b.x)], 1u);
    return b;
}
DI void xcd_barrier_complete(unsigned* bar, unsigned x, unsigned& nloc, unsigned& nx) {
    const unsigned G = gridDim.x * gridDim.y * gridDim.z;
    unsigned sum, cnt, mine, sp = 0u;
    for (;;) {
        sum = 0u; cnt = 0u; mine = 0u;
#pragma unroll
        for (unsigned j = 0; j < 16; ++j) { const unsigned c = xb_ld(&bar[XB_XCNT(j)]); sum += c; cnt += (c > 0u) ? 1u : 0u; mine = (j == x) ? c : mine; }
        if (sum == G) break;
        __builtin_amdgcn_s_sleep(1);
        if ((++sp & 255u) == 0u) { if (xb_ld(&bar[XB_TMO])) break; if (sp > XB_SPIN_CAP) { atomicAdd(&bar[XB_TMO], 1u); break; } }
    }
    nloc = mine > 0u ? mine : 1u; nx = cnt > 0u ? cnt : 1u;
}
DI void xcd_barrier(const XcdBarrier& b, int tid) {
    asm volatile("s_waitcnt vmcnt(0)" ::: "memory");
    __syncthreads();
    if (tid == 0) {
        unsigned* bar = b.bar;
        __builtin_amdgcn_s_waitcnt(0);
        unsigned nloc = b.st[0], nx = b.st[1];
        if (nloc == 0u) { xcd_barrier_complete(bar, b.x, nloc, nx); b.st[0] = nloc; b.st[1] = nx; }
        const unsigned old = xb_add(&bar[XB_XSUB(b.x)], 1u);
        const unsigned gen = old / nloc;
        if (old + 1u == (gen + 1u) * nloc) {
            __builtin_amdgcn_fence(__ATOMIC_RELEASE, "agent");
            asm volatile("s_waitcnt vmcnt(0)" ::: "memory");
            const unsigned og = xb_add(&bar[XB_TOP], 1u);
            const unsigned tg = og / nx;
            if (og + 1u == (tg + 1u) * nx) xb_add(&bar[XB_TOPGEN], 1u);
            else XB_SPIN(xb_ld(&bar[XB_TOPGEN]) == tg, bar);
            __builtin_amdgcn_fence(__ATOMIC_ACQUIRE, "agent");
            xb_add(&bar[XB_XGEN(b.x)], 1u);
            asm volatile("s_waitcnt vmcnt(0)" ::: "memory");
        } else {
            XB_SPIN(xb_ld(&bar[XB_XGEN(b.x)]) == gen, bar);
            __builtin_amdgcn_fence(__ATOMIC_ACQUIRE, "agent");
            asm volatile("s_waitcnt vmcnt(0)" ::: "memory");
        }
    }
    __syncthreads();
}

constexpr int MEGA_LDS_PHASE = 135168, MEGA_LDS = MEGA_LDS_PHASE + 64;
#ifndef SYNC_PROBE
#define SYNC_PROBE 0
#endif
#ifndef SB_PROBE_VAR
#define SB_PROBE_VAR 0
#endif
#ifndef PROBE_MASK
#define PROBE_MASK 0
#endif
#define PREP(k) for (int rep_ = 0; rep_ < 1 + ((PROBE_MASK >> (k)) & 1); ++rep_)
__global__ void __launch_bounds__(512, 2) k_mega(Ctx c) {
    extern __shared__ __attribute__((aligned(16))) unsigned char lds_raw[];
    LAS unsigned char* lds = (LAS unsigned char*)lds_raw;
    unsigned char* ws = c.ws; const int G = gridDim.x, bx = blockIdx.x;
    const int wave_s = __builtin_amdgcn_readfirstlane((int)threadIdx.x >> 6);
    volatile LAS unsigned* bst = (volatile LAS unsigned*)(lds + MEGA_LDS_PHASE);
    if (threadIdx.x < 16) bst[threadIdx.x] = 0u;
    __syncthreads();
    const XcdBarrier xbar = xcd_barrier_post((unsigned*)(ws + WS_CTL), bst, (int)threadIdx.x);
#define GRID_BAR() xcd_barrier(xbar, phase_tid(wave_s))
    PREP(0) { prep_phase<8, 0>(c, (float*)lds_raw, phase_tid(wave_s)); __syncthreads(); }
    GRID_BAR();
    PREP(1) { pg8::Gemm g{(const bf16_t*)(ws + WS_H0), (const bf16_t*)(ws + WS_WT_IN_E), M, IN_EVEN_PAD, 2048}; pg8::StaticOrder S; S.init(g.M, g.N, G, bx);
      pg8::gemm_phase<pg8::FEpi1, pg8::StaticOrder, true, true>(lds, g, S, pg8::FEpi1{ws}, phase_tid(wave_s)); }
    { const int nlast = (M / 256) * (IN_EVEN_PAD / 256) % G; const int nfree = nlast ? G - nlast : G, me = nlast ? bx - nlast : bx;
      if (me >= 0) { const int tid = phase_tid(wave_s); prep_weights<1>(c, (float*)lds_raw + (tid >> 6) * 64 * 36, tid & 63, me * 8 + (tid >> 6), nfree * 8); } }
    GRID_BAR();
    PREP(2) { att::dil_phase(lds, ws, phase_tid(wave_s));
    __syncthreads(); }
    PREP(7) { pg8::Gemm g{(const bf16_t*)(ws + WS_CQ), (const bf16_t*)(ws + WS_WT_UQ), M, 1536, 512}; pg8::StaticOrder S; S.init(g.M, g.N, G, bx);
      pg8::gemm_phase<pg8::FEpi2a, pg8::StaticOrder, true, true>(lds, g, S, pg8::FEpi2a{ws}, phase_tid(wave_s)); }
    PREP(7) { pg8::Gemm g{(const bf16_t*)(ws + WS_CKV), (const bf16_t*)(ws + WS_WT_UKV), M, 2048, 512}; pg8::StaticOrder S; S.init(g.M, g.N, G, bx);
      pg8::gemm_phase<pg8::FEpi2b, pg8::StaticOrder, true, true>(lds, g, S, pg8::FEpi2b{ws}, phase_tid(wave_s)); }
    GRID_BAR();
    PREP(3) att::mla_phase(lds, ws, phase_tid(wave_s));
    PREP(8) { const int tid = phase_tid(wave_s); for (int it = bx * 512 + tid; it < M * 128; it += G * 512) dil_merge_item(ws, it >> 7, (it & 127) * 8); }
    GRID_BAR();
    PREP(4) { pg8::Gemm g{(const bf16_t*)(ws + WS_MIX), (const bf16_t*)(ws + WS_WT_OUT_E), M, 2048, 2048}; pg8::StaticOrder S; S.init(g.M, g.N, G, bx);
      pg8::gemm_phase<pg8::FEpi4, pg8::StaticOrder, true, true>(lds, g, S, pg8::FEpi4{ws, c.x, c.out}, phase_tid(wave_s)); }
    GRID_BAR();
    PREP(5) { pg8::Gemm g{(const bf16_t*)(ws + WS_X1BF), (const bf16_t*)(ws + WS_WT_IN_O), M, IN_ODD, 2048}; pg8::StaticOrder S; S.init(g.M, g.N, G, bx);
      pg8::gemm_phase<pg8::FEpi5, pg8::StaticOrder, true, true>(lds, g, S, pg8::FEpi5{ws}, phase_tid(wave_s)); }
    GRID_BAR();
    PREP(6) att::sb_phase<0>(lds, ws, phase_tid(wave_s));
#if SB_PROBE_VAR
    att::sb_phase<SB_PROBE_VAR>(lds, ws, phase_tid(wave_s));
#endif
    GRID_BAR();
    { pg8::Gemm g{(const bf16_t*)(ws + WS_MIX2), (const bf16_t*)(ws + WS_WT_OUT_O), M, 2048, 2048}; pg8::StaticOrder S; S.init(g.M, g.N, G, bx);
      pg8::gemm_phase<pg8::FEpi7, pg8::StaticOrder, true, true>(lds, g, S, pg8::FEpi7{(bf16_t*)(ws + WS_X2BF), (const bf16_t*)(ws + WS_X1BF)}, phase_tid(wave_s)); }
    GRID_BAR();
#if SYNC_PROBE
    for (int i_ = 0; i_ < 8; ++i_) GRID_BAR();
#endif
    { const int tid = phase_tid(wave_s); for (int row = bx * 8 + (tid >> 6); row < M; row += G * 8) final_norm_row<true>(c.out, (const bf16_t*)(ws + WS_X2BF), c.final_gain, row, tid & 63); }
}

#ifndef MK_ONE_LAUNCH
#define MK_ONE_LAUNCH 1
#endif
#ifndef FAST_G1
#define FAST_G1 1
#endif
#ifndef FAST_G2
#define FAST_G2 1
#endif
#ifndef FAST_G4
#define FAST_G4 1
#endif
#ifndef FAST_G5
#define FAST_G5 1
#endif
#ifndef FAST_G7
#define FAST_G7 1
#endif
#ifndef FAST_MLA
#define FAST_MLA 1
#endif
#ifndef FAST_SB
#define FAST_SB 1
#endif
#ifndef FAST_DIL
#define FAST_DIL 1
#endif
static void launch_att(void (*k)(Ctx), int lds_bytes, const Ctx& c, hipStream_t s) {
    (void)hipFuncSetAttribute((const void*)k, hipFuncAttributeMaxDynamicSharedMemorySize, lds_bytes);
    hipLaunchKernelGGL(k, dim3(256), dim3(512), lds_bytes, s, c);
}
template <class Epi> static void launch_gemm_fast(const bf16_t* A, const bf16_t* Bt, int N, int K, Epi E, hipStream_t s) {
    static bool attr = false; if (!attr) { (void)hipFuncSetAttribute((const void*)k_gemm_fast<Epi>, hipFuncAttributeMaxDynamicSharedMemorySize, 131072); attr = true; }
    pg8::Gemm g{A, Bt, M, N, K};
    k_gemm_fast<Epi><<<256, 512, 131072, s>>>(g, E);
}

extern "C" void kernel_launch(void* const* d_in, const int* in_sizes, int n_in, void* d_out, int out_size, void* d_ws, size_t ws_size, hipStream_t stream) {
    if (n_in != 12 || out_size != M * D_MODEL || ws_size < WS_END) { fprintf(stderr, "kernel_launch: unexpected shapes (n_in %d out %d ws %zu)\n", n_in, out_size, ws_size); return; }
    Ctx c{};
    c.x = (const float*)d_in[0]; c.norm_gain = (const float*)d_in[1]; c.w_in_even = (const float*)d_in[2]; c.q_norm_gain = (const float*)d_in[3]; c.kv_norm_gain = (const float*)d_in[4];
    c.w_uq = (const float*)d_in[5]; c.w_ukv = (const float*)d_in[6]; c.w_out_even = (const float*)d_in[7]; c.rel_bias = (const float*)d_in[8]; c.w_in_odd = (const float*)d_in[9];
    c.w_out_odd = (const float*)d_in[10]; c.final_gain = (const float*)d_in[11]; c.out = (float*)d_out; c.ws = (unsigned char*)d_ws;
#if MK_ONE_LAUNCH
    static int grid_blocks = 0;
    if (!grid_blocks) {
        int dev = 0, cus = 0, per_cu = 0;
        (void)hipGetDevice(&dev); (void)hipDeviceGetAttribute(&cus, hipDeviceAttributeMultiprocessorCount, dev);
        (void)hipFuncSetAttribute((const void*)k_mega, hipFuncAttributeMaxDynamicSharedMemorySize, MEGA_LDS);
        (void)hipOccupancyMaxActiveBlocksPerMultiprocessor(&per_cu, (const void*)k_mega, 512, MEGA_LDS);
        if (per_cu < 1) { fprintf(stderr, "kernel_launch: occupancy query says %d blocks/CU\n", per_cu); per_cu = 1; }
        grid_blocks = cus;
    }
    (void)hipMemsetAsync((char*)d_ws + WS_CTL, 0, 65536, stream);
    { void* args[] = {&c};
      hipError_t e = hipLaunchCooperativeKernel((void*)k_mega, dim3(grid_blocks), dim3(512), args, MEGA_LDS, stream);
      if (e != hipSuccess) fprintf(stderr, "cooperative launch failed: %s (grid %d)\n", hipGetErrorString(e), grid_blocks); }
    return;
#endif
    unsigned char* ws = c.ws;
    const float* rc = (const float*)(ws + WS_ROPE); const float* rs = rc + 4096 * 32;
    k_prep<<<2048, 256, 0, stream>>>(c);
#if FAST_G1
    launch_gemm_fast((const bf16_t*)(ws + WS_H0), (const bf16_t*)(ws + WS_WT_IN_E), IN_EVEN_PAD, 2048, pg8::FEpi1{ws}, stream);
#else
    k_gemm_naive<Epi1><<<(M / 64) * (IN_EVEN_PAD / 64), 256, 0, stream>>>((const bf16_t*)(ws + WS_H0), (const bf16_t*)(ws + WS_WT_IN_E), IN_EVEN_PAD, 2048, Epi1{ws});
    k_rowss<false><<<M / 4, 256, 0, stream>>>(ws + WS_CQ, 512, 512, (float*)(ws + WS_SSC), 16, 8);
    k_rowss<false><<<M / 4, 256, 0, stream>>>(ws + WS_CKV, 512, 512, (float*)(ws + WS_SSC) + 8, 16, 8);
    k_rope<<<(M * 32 + 255) / 256, 256, 0, stream>>>((bf16_t*)(ws + WS_KR), 1, rc, rs);
#endif
#if FAST_DIL
    launch_att(k_dil_fast, att::DIL_LDS_BYTES, c, stream);
#else
    k_dil_naive<<<BATCH * 8 * SEQ / 4, 256, 0, stream>>>(c);
#endif
#if FAST_G2
    launch_gemm_fast((const bf16_t*)(ws + WS_CQ), (const bf16_t*)(ws + WS_WT_UQ), 1536, 512, pg8::FEpi2a{ws}, stream);
    launch_gemm_fast((const bf16_t*)(ws + WS_CKV), (const bf16_t*)(ws + WS_WT_UKV), 2048, 512, pg8::FEpi2b{ws}, stream);
#else
    k_gemm_naive<Epi2a><<<(M / 64) * (1536 / 64), 256, 0, stream>>>((const bf16_t*)(ws + WS_CQ), (const bf16_t*)(ws + WS_WT_UQ), 1536, 512, Epi2a{ws});
    k_rope<<<(M * 256 + 255) / 256, 256, 0, stream>>>((bf16_t*)(ws + WS_QR), 8, rc, rs);
    k_gemm_naive<Epi2b><<<(M / 64) * (2048 / 64), 256, 0, stream>>>((const bf16_t*)(ws + WS_CKV), (const bf16_t*)(ws + WS_WT_UKV), 2048, 512, Epi2b{ws});
#endif
#if FAST_MLA
    launch_att(k_mla_fast, att::M2_LDS_BYTES > att::MLA_LDS_BYTES ? att::M2_LDS_BYTES : att::MLA_LDS_BYTES, c, stream);
#else
    k_mla_naive<<<BATCH * 8 * SEQ / 4, 256, 0, stream>>>(c);
#endif
    k_dil_merge<<<M, 128, 0, stream>>>(c);
#if FAST_G4
    launch_gemm_fast((const bf16_t*)(ws + WS_MIX), (const bf16_t*)(ws + WS_WT_OUT_E), 2048, 2048, pg8::FEpi4{ws, c.x, c.out}, stream);
#else
    k_gemm_naive<Epi4><<<(M / 64) * (2048 / 64), 256, 0, stream>>>((const bf16_t*)(ws + WS_MIX), (const bf16_t*)(ws + WS_WT_OUT_E), 2048, 2048, Epi4{ws, c.x, c.out});
    k_rowss<true><<<M / 4, 256, 0, stream>>>(c.out, 2048, 2048, (float*)(ws + WS_SSX1), 32, 32);
#endif
#if FAST_G5
    launch_gemm_fast((const bf16_t*)(ws + WS_X1BF), (const bf16_t*)(ws + WS_WT_IN_O), IN_ODD, 2048, pg8::FEpi5{ws}, stream);
#else
    k_gemm_naive<Epi5><<<(M / 64) * (IN_ODD / 64), 256, 0, stream>>>((const bf16_t*)(ws + WS_X1BF), (const bf16_t*)(ws + WS_WT_IN_O), IN_ODD, 2048, Epi5{ws});
#endif
#if FAST_SB
    launch_att(k_sb_fast, att::SB_LDS_BYTES, c, stream);
#else
    k_sb_naive<<<BATCH * 16 * SEQ / 4, 256, 0, stream>>>(c);
#endif
#if FAST_G7
    launch_gemm_fast((const bf16_t*)(ws + WS_MIX2), (const bf16_t*)(ws + WS_WT_OUT_O), 2048, 2048, pg8::FEpi7{(bf16_t*)(ws + WS_X2BF), (const bf16_t*)(ws + WS_X1BF)}, stream);
#else
    k_gemm_naive<Epi7><<<(M / 64) * (2048 / 64), 256, 0, stream>>>((const bf16_t*)(ws + WS_MIX2), (const bf16_t*)(ws + WS_WT_OUT_O), 2048, 2048, Epi7{c.out});
#endif
#if FAST_G7
    k_final_norm_bf<<<M / 4, 256, 0, stream>>>(c.out, (const bf16_t*)(ws + WS_X2BF), c.final_gain);
#else
    k_final_norm<<<M / 4, 256, 0, stream>>>(c.out, c.final_gain);
#endif
}
```

```cpp
#include <hip/hip_runtime.h>
#include <cstdio>
#include <cstdint>
#include <cmath>

typedef unsigned short bf16_t;
typedef unsigned u32x4 __attribute__((ext_vector_type(4)));
typedef float f32x4 __attribute__((ext_vector_type(4)));

constexpr int D_MODEL = 2048, BATCH = 4, SEQ = 4096, M = BATCH * SEQ;
constexpr int NH_MLA = 8, NH_DIL = 8, NH_SB = 16, HD = 128;
constexpr int IN_EVEN = 6208, IN_EVEN_PAD = 6400, IN_ODD = 8192;
constexpr float EPS = 1e-6f;
constexpr float LOG2E = 1.4426950408889634f;
constexpr float MLA_QSCALE = 0.07216878364870322f * LOG2E;
constexpr float D128_QSCALE = 0.08838834764831845f * LOG2E;

constexpr size_t MiB = 1u << 20;
constexpr size_t WS_CTL = 0;
constexpr size_t WS_ROPE = 1 * MiB;
constexpr size_t WS_BIASN = 2 * MiB;
constexpr size_t WS_BIASC = 2 * MiB + 65536;
constexpr size_t WS_SSX = 3 * MiB;
constexpr size_t WS_SSC = 4 * MiB;
constexpr size_t WS_SSX1 = 5 * MiB;
constexpr size_t WS_LSE = 9 * MiB;
constexpr size_t WS_WT_IN_E = 12 * MiB;
constexpr size_t WS_WT_UQ = 37 * MiB;
constexpr size_t WS_WT_UKV = 39 * MiB;
constexpr size_t WS_WT_OUT_E = 41 * MiB;
constexpr size_t WS_WT_IN_O = 49 * MiB;
constexpr size_t WS_WT_OUT_O = 81 * MiB;
constexpr size_t WS_A = 90 * MiB;
constexpr size_t WS_B = 154 * MiB;
constexpr size_t WS_C = 218 * MiB;
constexpr size_t WS_H0 = WS_A, WS_OP0 = WS_A, WS_OP1 = WS_A + 32 * MiB, WS_X1BF = WS_A;
constexpr size_t WS_CQ = WS_B, WS_CKV = WS_B + 16 * MiB, WS_QB = WS_B + 32 * MiB, WS_MIX = WS_B, WS_MIX2 = WS_B;
constexpr size_t WS_KB = WS_C, WS_VB = WS_C + 32 * MiB, WS_SG = WS_C + 64 * MiB, WS_QN = WS_C + 128 * MiB, WS_QR = WS_C + 160 * MiB,
                 WS_KN = WS_C + 176 * MiB, WS_VA = WS_C + 208 * MiB, WS_KR = WS_C + 240 * MiB, WS_OP2 = WS_C + 242 * MiB;
constexpr size_t WS_X2BF = WS_C;
constexpr size_t WS_Q2 = WS_C, WS_K2 = WS_C + 64 * MiB, WS_V2 = WS_C + 128 * MiB, WS_SG2 = WS_C + 192 * MiB;
constexpr size_t WS_END = WS_C + 274 * MiB;

struct Ctx {
    const float *x, *norm_gain, *w_in_even, *q_norm_gain, *kv_norm_gain, *w_uq, *w_ukv, *w_out_even, *rel_bias, *w_in_odd, *w_out_odd, *final_gain;
    float* out; unsigned char* ws;
};

#define DI __device__ __forceinline__
DI int phase_tid(int wave_s) { int lane; asm volatile("v_mbcnt_lo_u32_b32 %0, -1, 0\n\tv_mbcnt_hi_u32_b32 %0, -1, %0" : "=v"(lane)); return wave_s * 64 + lane; }
DI float bf2f(bf16_t v) { return __uint_as_float(((unsigned)v) << 16); }
DI bf16_t f2bf(float f) { unsigned u = __float_as_uint(f); return (bf16_t)((u + 0x7fffu + ((u >> 16) & 1u)) >> 16); }
DI float wave_sum(float v) {
#pragma unroll
    for (int o = 1; o < 64; o <<= 1) v += __shfl_xor(v, o);
    return v;
}
DI float wave_max(float v) {
#pragma unroll
    for (int o = 1; o < 64; o <<= 1) v = fmaxf(v, __shfl_xor(v, o));
    return v;
}
DI float silu_f(float v) { return v / (1.0f + __expf(-v)); }

DI int map_in_even(int n) { if (n < 1024) return n; if (n < 1056) return 1024 + (n - 1024); if (n < 1088) return 1152 + (n - 1056); return n - 1088 + 1280; }
DI int map_uq(int n) { const int h = n / 192, j = n % 192; if (j < 128) return h * 128 + j; if (j < 160) return 1024 + (h >> 2) * 256 + (h & 3) * 32 + (j - 128);
    return 1024 + (h >> 2) * 256 + 128 + (h & 3) * 32 + (j - 160); }
DI int map_ukv(int n) { const int h = n / 256, j = n % 256; if (j < 128) return h * 128 + j; return 1024 + h * 128 + (j - 128); }
DI int map_id(int n) { return n; }

template <int MAPID>
DI void transpose_item(const float* W, int K, int N, const float* gain, bf16_t* WT, float* scr  , int item, int lane) {
    const int nblk = N / 32, kb = item / nblk, nb = item % nblk, k0 = 64 * kb, n0 = 32 * nb;
    f32x4 v[8];
#pragma unroll
    for (int i = 0; i < 8; ++i) { const int kk = 8 * i + (lane >> 3); v[i] = *(const f32x4*)(W + (size_t)(k0 + kk) * N + n0 + 4 * (lane & 7)); }
#pragma unroll
    for (int i = 0; i < 8; ++i) { const int kk = 8 * i + (lane >> 3); const float g = gain ? gain[k0 + kk] : 1.0f; *(f32x4*)(scr + kk * 36 + 4 * (lane & 7)) = v[i] * g; }
    asm volatile("s_waitcnt lgkmcnt(0)" ::: "memory");
    const int d0 = MAPID == 0 ? map_in_even(n0) : MAPID == 1 ? map_uq(n0) : MAPID == 2 ? map_ukv(n0) : map_id(n0);
    const int c = lane & 7;
#pragma unroll
    for (int j = 0; j < 4; ++j) { const int n = (lane >> 3) + 8 * j; const float* s = scr + (8 * c) * 36 + n;
        u32x4 o; o.x = f2bf(s[0]) | ((unsigned)f2bf(s[36]) << 16); o.y = f2bf(s[72]) | ((unsigned)f2bf(s[108]) << 16);
        o.z = f2bf(s[144]) | ((unsigned)f2bf(s[180]) << 16); o.w = f2bf(s[216]) | ((unsigned)f2bf(s[252]) << 16);
        *(u32x4*)(WT + (size_t)(d0 + n) * K + k0 + 8 * c) = o; }
    asm volatile("s_waitcnt lgkmcnt(0)" ::: "memory");
}

DI int t5_bucket(int dist) {
    if (dist < 16) return dist;
    float d = (float)dist;
    int large = 16 + (int)(logf(d / 16.0f) / 4.852030263919617f * 16.0f);
    return large < 31 ? large : 31;
}

template <int PART> DI void prep_weights(const Ctx& c, float* scr, int lane, int gw, int NGW) {
    unsigned char* ws = c.ws;
    constexpr int I0 = (2048 / 64) * (IN_EVEN / 32), I1 = (512 / 64) * (1536 / 32), I2 = (512 / 64) * (2048 / 32), I3 = (2048 / 64) * (2048 / 32),
                  I4 = (2048 / 64) * (IN_ODD / 32), I5 = I3;
    constexpr int LO = PART == 1 ? I0 : 0, HI = PART == 0 ? I0 : I0 + I1 + I2 + I3 + I4 + I5;
    for (int it = LO + gw; it < HI; it += NGW) {
        int r = it;
        if (r < I0) { transpose_item<0>(c.w_in_even, 2048, IN_EVEN, c.norm_gain, (bf16_t*)(ws + WS_WT_IN_E), scr, r, lane); continue; } r -= I0;
        if (r < I1) { transpose_item<1>(c.w_uq, 512, 1536, c.q_norm_gain, (bf16_t*)(ws + WS_WT_UQ), scr, r, lane); continue; } r -= I1;
        if (r < I2) { transpose_item<2>(c.w_ukv, 512, 2048, c.kv_norm_gain, (bf16_t*)(ws + WS_WT_UKV), scr, r, lane); continue; } r -= I2;
        if (r < I3) { transpose_item<3>(c.w_out_even, 2048, 2048, nullptr, (bf16_t*)(ws + WS_WT_OUT_E), scr, r, lane); continue; } r -= I3;
        if (r < I4) { transpose_item<3>(c.w_in_odd, 2048, IN_ODD, c.norm_gain + 2048, (bf16_t*)(ws + WS_WT_IN_O), scr, r, lane); continue; } r -= I4;
        transpose_item<3>(c.w_out_odd, 2048, 2048, nullptr, (bf16_t*)(ws + WS_WT_OUT_O), scr, r, lane);
    }
}
template <int NW, int PART> DI void prep_phase(const Ctx& c, float* scr_all, const int tid) {
    const int lane = tid & 63, wave = tid >> 6;
    float* scr = scr_all + wave * 64 * 36;
    const int gw = blockIdx.x * NW + wave, NGW = gridDim.x * NW;
    unsigned char* ws = c.ws;
    prep_weights<PART>(c, scr, lane, gw, NGW);
    const int gt = blockIdx.x * (NW * 64) + tid, NGT = gridDim.x * (NW * 64);
    { bf16_t* wt = (bf16_t*)(ws + WS_WT_IN_E);
      for (int i = gt; i < 192 * 256; i += NGT) { const int rr = i / 256, cc = i % 256; const int row = rr < 96 ? 1056 + rr : 1184 + (rr - 96);
          *(u32x4*)(wt + (size_t)row * 2048 + cc * 8) = (u32x4){0u, 0u, 0u, 0u}; } }
    { float* rc = (float*)(ws + WS_ROPE); float* rs = rc + 4096 * 32;
      for (int i = gt; i < 4096 * 32; i += NGT) { const int pos = i >> 5, j = i & 31; const float inv = 1.0f / powf(10000.0f, (float)j / 32.0f); const float ang = (float)pos * inv;
          rc[i] = cosf(ang); rs[i] = sinf(ang); } }
    { float* bn = (float*)(ws + WS_BIASN);
      for (int i = gt; i < 3 * 8 * 132; i += NGT) { const int p = i / (8 * 132), h = (i / 132) % 8, rel = i % 132; const int dil = p == 0 ? 1 : p == 1 ? 4 : 16;
          bn[i] = rel <= 128 ? c.rel_bias[t5_bucket(rel * dil) * 8 + h] * LOG2E : 0.f; } }
    { float* bc = (float*)(ws + WS_BIASC);
      for (int i = gt; i < 3 * 8 * 5 * 1024; i += NGT) { const int g = i & 15, ln = (i >> 4) & 63, di = (i >> 10) % 5, ph = i / 5120, h = ph & 7, p = ph >> 3; const int dil = p == 0 ? 1 : p == 1 ? 4 : 16;
          const int rel = 32 * di + (ln & 31) - ((g & 3) + 8 * (g >> 2) + 4 * (ln >> 5));
          bc[i] = (rel >= 0 && rel <= 128) ? c.rel_bias[t5_bucket(rel * dil) * 8 + h] * LOG2E : -INFINITY; } }
    { bf16_t* h0 = (bf16_t*)(ws + WS_H0); float* ssx = (float*)(ws + WS_SSX);
      for (int m = gw; m < M; m += NGW) { const f32x4* xr = (const f32x4*)(c.x + (size_t)m * D_MODEL) + lane; float s = 0.f;
          unsigned long long* o8 = (unsigned long long*)(h0 + (size_t)m * D_MODEL) + lane;
          for (int j = 0; j < 8; ++j) { const f32x4 v = xr[64 * j]; s += v.x * v.x + v.y * v.y + v.z * v.z + v.w * v.w;
              o8[64 * j] = (unsigned long long)(f2bf(v.x) | ((unsigned)f2bf(v.y) << 16)) | ((unsigned long long)(f2bf(v.z) | ((unsigned)f2bf(v.w) << 16)) << 32); }
          s = wave_sum(s); if (lane == 0) ssx[m] = s; } }
}

__global__ void __launch_bounds__(256) k_prep(Ctx c) { __shared__ float scr_all[4 * 64 * 36]; prep_phase<4, 2>(c, scr_all, (int)threadIdx.x); }

DI float rscale(const float* part, int n, float inv_cols) { float s = 0.f; for (int i = 0; i < n; ++i) s += part[i]; return rsqrtf(s * inv_cols + EPS); }

struct Epi1 {
    unsigned char* ws;
    DI void operator()(int row, int col, float acc) const {
        const float v = acc * rsqrtf(((const float*)(ws + WS_SSX))[row] * (1.0f / 2048.0f) + EPS);
        if (col < 512) ((bf16_t*)(ws + WS_CQ))[(size_t)row * 512 + col] = f2bf(v);
        else if (col < 1024) ((bf16_t*)(ws + WS_CKV))[(size_t)row * 512 + col - 512] = f2bf(v);
        else if (col < 1280) { const int t = col - 1024; if (t < 32) ((bf16_t*)(ws + WS_KR))[(size_t)row * 64 + t] = f2bf(v); else if (t >= 128 && t < 160) ((bf16_t*)(ws + WS_KR))[(size_t)row * 64 + 32 + t - 128] = f2bf(v); }
        else if (col < 2304) ((bf16_t*)(ws + WS_QB))[(size_t)row * 1024 + col - 1280] = f2bf(v * D128_QSCALE);
        else if (col < 3328) ((bf16_t*)(ws + WS_KB))[(size_t)row * 1024 + col - 2304] = f2bf(v);
        else if (col < 4352) ((bf16_t*)(ws + WS_VB))[(size_t)row * 1024 + col - 3328] = f2bf(v);
        else ((bf16_t*)(ws + WS_SG))[(size_t)row * 2048 + col - 4352] = f2bf(silu_f(v));
    }
};
struct Epi2a {
    unsigned char* ws;
    DI void operator()(int row, int col, float acc) const {
        const float v = acc * rscale((const float*)(ws + WS_SSC) + (size_t)row * 16, 8, 1.0f / 512.0f) * MLA_QSCALE;
        if (col < 1024) ((bf16_t*)(ws + WS_QN))[(size_t)row * 1024 + col] = f2bf(v);
        else { const int t = col - 1024, grp = t >> 8, u = t & 255, half = u >> 7, hh = (u & 127) >> 5, i = u & 31;
            ((bf16_t*)(ws + WS_QR))[(size_t)row * 512 + (4 * grp + hh) * 64 + half * 32 + i] = f2bf(v); }
    }
};
struct Epi2b {
    unsigned char* ws;
    DI void operator()(int row, int col, float acc) const {
        const float v = acc * rscale((const float*)(ws + WS_SSC) + (size_t)row * 16 + 8, 8, 1.0f / 512.0f);
        if (col < 1024) ((bf16_t*)(ws + WS_KN))[(size_t)row * 1024 + col] = f2bf(v); else ((bf16_t*)(ws + WS_VA))[(size_t)row * 1024 + col - 1024] = f2bf(v);
    }
};
struct Epi4 {
    unsigned char* ws; const float* x; float* out;
    DI void operator()(int row, int col, float acc) const {
        const float v = x[(size_t)row * 2048 + col] + acc; out[(size_t)row * 2048 + col] = v; ((bf16_t*)(ws + WS_X1BF))[(size_t)row * 2048 + col] = f2bf(v);
    }
};
struct Epi5 {
    unsigned char* ws;
    DI void operator()(int row, int col, float acc) const {
        const float v = acc * rscale((const float*)(ws + WS_SSX1) + (size_t)row * 32, 32, 1.0f / 2048.0f);
        if (col < 2048) ((bf16_t*)(ws + WS_Q2))[(size_t)row * 2048 + col] = f2bf(v * D128_QSCALE);
        else if (col < 4096) ((bf16_t*)(ws + WS_K2))[(size_t)row * 2048 + col - 2048] = f2bf(v);
        else if (col < 6144) ((bf16_t*)(ws + WS_V2))[(size_t)row * 2048 + col - 4096] = f2bf(v);
        else ((bf16_t*)(ws + WS_SG2))[(size_t)row * 2048 + col - 6144] = f2bf(silu_f(v));
    }
};
struct Epi7 {
    float* out;
    DI void operator()(int row, int col, float acc) const { out[(size_t)row * 2048 + col] += acc; }
};

namespace pg8 {
#define PG8_LAS __attribute__((address_space(3)))
typedef short bf16x8 __attribute__((ext_vector_type(8)));
constexpr int BM = 256, BK = 64, HALF = 128, HTB = HALF * BK * 2  , STAGE_BYTES = 8 * HTB, NXCD = 8, WGM = 8;

__host__ __device__ __forceinline__ int lds_byte(int r, int c) { const int st = (r >> 4) * 2 + (c >> 5), rr = r & 15, cc = c & 31, ob = rr * 64 + cc * 2; return st * 1024 + (ob ^ (((ob >> 9) & 1) << 5)); }
__host__ __device__ __forceinline__ void stage_rc(int b, int& R, int& C) { const int st = b / 1024, sb = b % 1024, swz = sb ^ (((sb >> 9) & 1) << 5); R = (st >> 1) * 16 + swz / 64; C = (st & 1) * 32 + (swz % 64) / 2; }
__host__ __device__ __forceinline__ int perm32(int rho) { const int n = rho >> 4, i = rho & 15; return 8 * (i >> 2) + 4 * n + (i & 3); }

struct Unit { int pm, pn; };
struct Gemm { const bf16_t* A; const bf16_t* Bt; int M, N, K; };

struct StaticOrder {
    int nM, nN, nwg, G, c;
    __host__ __device__ void init(int M, int N, int G_, int c_) { nM = M / BM; nN = N / BM; nwg = nM * nN; G = G_; c = c_; }
    __host__ __device__ bool next(int i, Unit& u) const {
        const long L = (long)i * G + c; if (L >= nwg) return false;
        int wgid = (int)L; { const int q = nwg / NXCD, r = nwg % NXCD, xcd = wgid % NXCD, off = wgid / NXCD; wgid = (xcd < r ? xcd * (q + 1) : r * (q + 1) + (xcd - r) * q) + off; }
        const int nig = WGM * nN, gid = wgid / nig, fm = gid * WGM, gsz = (nM - fm) < WGM ? (nM - fm) : WGM;
        u.pm = fm + ((wgid % nig) % gsz); u.pn = (wgid % nig) / gsz; return true;
    }
    __device__ __forceinline__ void a_ready(const Unit&) const {}
    __device__ __forceinline__ void done(const Unit&) const {}
};


typedef float f32x2_t __attribute__((ext_vector_type(2))); typedef __bf16 bf16x2_t __attribute__((ext_vector_type(2)));
__device__ __forceinline__ unsigned cvtpk(float lo, float hi) { f32x2_t v = {lo, hi}; bf16x2_t b = __builtin_convertvector(v, bf16x2_t); return __builtin_bit_cast(unsigned, b); }
__device__ __forceinline__ u32x4 pack8(const f32x4& a, const f32x4& b) { u32x4 w; w.x = cvtpk(a[0], a[1]); w.y = cvtpk(a[2], a[3]); w.z = cvtpk(b[0], b[1]); w.w = cvtpk(b[2], b[3]); return w; }
__device__ __forceinline__ float sumsq4(const f32x4& a) { return (a[0] * a[0] + a[1] * a[1]) + (a[2] * a[2] + a[3] * a[3]); }
__device__ __forceinline__ float silu1(float v) { return v * __builtin_amdgcn_rcpf(1.0f + __builtin_amdgcn_exp2f(-v * LOG2E)); }
__device__ __forceinline__ f32x4 silu4(const f32x4& a) { return (f32x4){silu1(a[0]), silu1(a[1]), silu1(a[2]), silu1(a[3])}; }
__device__ __forceinline__ float quad_sum(float s) { s += __shfl_xor(s, 16); s += __shfl_xor(s, 32); return s; }
__device__ __forceinline__ void rope8(const f32x4& a0, const f32x4& a1, const f32x4& b0, const f32x4& b1, const float* rc, const float* rs, int pos, int i0, u32x4& o1, u32x4& o2) {
    const f32x4 c0 = *(const f32x4*)(rc + pos * 32 + i0), c1 = *(const f32x4*)(rc + pos * 32 + i0 + 4), s0 = *(const f32x4*)(rs + pos * 32 + i0), s1 = *(const f32x4*)(rs + pos * 32 + i0 + 4);
    o1 = pack8(a0 * c0 - b0 * s0, a1 * c1 - b1 * s1); o2 = pack8(a0 * s0 + b0 * c0, a1 * s1 + b1 * c1);
}
#define PG8_EPI_ROWS(...) _Pragma("unroll") for (int ai = 0; ai < 2; ++ai) _Pragma("unroll") for (int m = 0; m < 4; ++m) { const int row = u.pm * BM + ai * HALF + wr * 64 + m * 16 + fr; __VA_ARGS__ }

struct FEpi1 {
    static constexpr bool PERM = true, AFTER_DRAIN = false; unsigned char* ws;
    __device__ __forceinline__ void operator()(const f32x4 (&acc)[2][2][4][2], const Unit& u, int wr, int wc, int fr, int fq) const {
        const int pn = u.pn, cw = wc * 32 + 8 * fq; const float* ssx = (const float*)(ws + WS_SSX);
        PG8_EPI_ROWS(
            const float rs = rsqrtf(ssx[row] * (1.0f / 2048.0f) + EPS);
            if (pn < 4) { bf16_t* dst = (bf16_t*)(ws + (pn < 2 ? WS_CQ : WS_CKV)) + (size_t)row * 512 + (pn & 1) * 256 + cw; float ss = 0.f;
                _Pragma("unroll") for (int bj = 0; bj < 2; ++bj) { const f32x4 v0 = acc[ai][bj][m][0] * rs, v1 = acc[ai][bj][m][1] * rs; ss += sumsq4(v0) + sumsq4(v1); *(u32x4*)(dst + bj * HALF) = pack8(v0, v1); }
                ss = quad_sum(ss); if (fq == 0) ((float*)(ws + WS_SSC))[(size_t)row * 16 + pn * 4 + wc] = ss; }
            else if (pn == 4) { if (wc == 0) { const float* rc = (const float*)(ws + WS_ROPE); u32x4 o1, o2;
                rope8(acc[ai][0][m][0] * rs, acc[ai][0][m][1] * rs, acc[ai][1][m][0] * rs, acc[ai][1][m][1] * rs, rc, rc + 4096 * 32, row % SEQ, 8 * fq, o1, o2);
                bf16_t* dst = (bf16_t*)(ws + WS_KR) + (size_t)row * 64 + 8 * fq; *(u32x4*)dst = o1; *(u32x4*)(dst + 32) = o2; } }
            else if (pn < 17) { const int t = pn - 5; bf16_t* dst = (bf16_t*)(ws + (t < 4 ? WS_QB : t < 8 ? WS_KB : WS_VB)) + (size_t)row * 1024 + (t & 3) * 256 + cw; const float sc = t < 4 ? rs * D128_QSCALE : rs;
                _Pragma("unroll") for (int bj = 0; bj < 2; ++bj) *(u32x4*)(dst + bj * HALF) = pack8(acc[ai][bj][m][0] * sc, acc[ai][bj][m][1] * sc); }
            else { bf16_t* dst = (bf16_t*)(ws + WS_SG) + (size_t)row * 2048 + (pn - 17) * 256 + cw;
                _Pragma("unroll") for (int bj = 0; bj < 2; ++bj) *(u32x4*)(dst + bj * HALF) = pack8(silu4(acc[ai][bj][m][0] * rs), silu4(acc[ai][bj][m][1] * rs)); }
        )
    }
};
struct FEpi2a {
    static constexpr bool PERM = true, AFTER_DRAIN = false; unsigned char* ws;
    __device__ __forceinline__ void operator()(const f32x4 (&acc)[2][2][4][2], const Unit& u, int wr, int wc, int fr, int fq) const {
        const int pn = u.pn, cw = wc * 32 + 8 * fq;
        PG8_EPI_ROWS(
            const f32x4* sp = (const f32x4*)((const float*)(ws + WS_SSC) + (size_t)row * 16); const f32x4 p0 = sp[0], p1 = sp[1];
            const float rs = rsqrtf(((p0[0] + p0[1]) + (p0[2] + p0[3]) + (p1[0] + p1[1]) + (p1[2] + p1[3])) * (1.0f / 512.0f) + EPS) * MLA_QSCALE;
            if (pn < 4) { bf16_t* dst = (bf16_t*)(ws + WS_QN) + (size_t)row * 1024 + pn * 256 + cw;
                _Pragma("unroll") for (int bj = 0; bj < 2; ++bj) *(u32x4*)(dst + bj * HALF) = pack8(acc[ai][bj][m][0] * rs, acc[ai][bj][m][1] * rs); }
            else { const float* rc = (const float*)(ws + WS_ROPE); u32x4 o1, o2; const int head = 4 * (pn - 4) + wc;
                rope8(acc[ai][0][m][0] * rs, acc[ai][0][m][1] * rs, acc[ai][1][m][0] * rs, acc[ai][1][m][1] * rs, rc, rc + 4096 * 32, row % SEQ, 8 * fq, o1, o2);
                bf16_t* dst = (bf16_t*)(ws + WS_QR) + (size_t)row * 512 + head * 64 + 8 * fq; *(u32x4*)dst = o1; *(u32x4*)(dst + 32) = o2; }
        )
    }
};
struct FEpi2b {
    static constexpr bool PERM = true, AFTER_DRAIN = false; unsigned char* ws;
    __device__ __forceinline__ void operator()(const f32x4 (&acc)[2][2][4][2], const Unit& u, int wr, int wc, int fr, int fq) const {
        const int pn = u.pn, cw = wc * 32 + 8 * fq;
        PG8_EPI_ROWS(
            const f32x4* sp = (const f32x4*)((const float*)(ws + WS_SSC) + (size_t)row * 16 + 8); const f32x4 p0 = sp[0], p1 = sp[1];
            const float rs = rsqrtf(((p0[0] + p0[1]) + (p0[2] + p0[3]) + (p1[0] + p1[1]) + (p1[2] + p1[3])) * (1.0f / 512.0f) + EPS);
            bf16_t* dst = (bf16_t*)(ws + (pn < 4 ? WS_KN : WS_VA)) + (size_t)row * 1024 + (pn & 3) * 256 + cw;
            _Pragma("unroll") for (int bj = 0; bj < 2; ++bj) *(u32x4*)(dst + bj * HALF) = pack8(acc[ai][bj][m][0] * rs, acc[ai][bj][m][1] * rs);
        )
    }
};
struct FEpi4 {
    static constexpr bool PERM = true, AFTER_DRAIN = false; unsigned char* ws; const float* x; float* out;
    __device__ __forceinline__ void operator()(const f32x4 (&acc)[2][2][4][2], const Unit& u, int wr, int wc, int fr, int fq) const {
        const int pn = u.pn, cw = pn * 256 + wc * 32 + 8 * fq;
        const size_t off0 = (size_t)(u.pm * BM + wr * 64 + fr) * 2048 + cw;
        f32x4 pre[2][4];
#define EPI4_LOAD(q, slot) { const float* p_ = x + off0 + (size_t)(((q) >> 2) * HALF + ((q) & 3) * 16) * 2048; pre[slot][0] = *(const f32x4*)p_; pre[slot][1] = *(const f32x4*)(p_ + 4); pre[slot][2] = *(const f32x4*)(p_ + HALF); pre[slot][3] = *(const f32x4*)(p_ + HALF + 4); }
        EPI4_LOAD(0, 0) EPI4_LOAD(1, 1)
#pragma unroll
        for (int q = 0; q < 8; ++q) { const int ai = q >> 2, m = q & 3; const size_t off = off0 + (size_t)(ai * HALF + m * 16) * 2048;
            const f32x4 v00 = pre[q & 1][0] + acc[ai][0][m][0], v01 = pre[q & 1][1] + acc[ai][0][m][1], v10 = pre[q & 1][2] + acc[ai][1][m][0], v11 = pre[q & 1][3] + acc[ai][1][m][1];
            if (q + 2 < 8) EPI4_LOAD(q + 2, q & 1)
            *(u32x4*)((bf16_t*)(ws + WS_X1BF) + off) = pack8(v00, v01); *(u32x4*)((bf16_t*)(ws + WS_X1BF) + off + HALF) = pack8(v10, v11);
            float ss = (sumsq4(v00) + sumsq4(v01)) + (sumsq4(v10) + sumsq4(v11));
            ss = quad_sum(ss); if (fq == 0) ((float*)(ws + WS_SSX1))[(size_t)(u.pm * BM + ai * HALF + wr * 64 + m * 16 + fr) * 32 + pn * 4 + wc] = ss; }
#undef EPI4_LOAD
    }
};
struct FEpi5 {
    static constexpr bool PERM = true, AFTER_DRAIN = false; unsigned char* ws;
    __device__ __forceinline__ void operator()(const f32x4 (&acc)[2][2][4][2], const Unit& u, int wr, int wc, int fr, int fq) const {
        const int pn = u.pn, cw = (pn & 7) * 256 + wc * 32 + 8 * fq; const int sel = pn >> 3;
        PG8_EPI_ROWS(
            const f32x4* sp = (const f32x4*)((const float*)(ws + WS_SSX1) + (size_t)row * 32 + 8 * fq); const f32x4 p0 = sp[0], p1 = sp[1];
            const float tot = quad_sum((p0[0] + p0[1]) + (p0[2] + p0[3]) + (p1[0] + p1[1]) + (p1[2] + p1[3]));
            const float rs = rsqrtf(tot * (1.0f / 2048.0f) + EPS);
            bf16_t* dst = (bf16_t*)(ws + (sel == 0 ? WS_Q2 : sel == 1 ? WS_K2 : sel == 2 ? WS_V2 : WS_SG2)) + (size_t)row * 2048 + cw;
            if (sel == 3) { _Pragma("unroll") for (int bj = 0; bj < 2; ++bj) *(u32x4*)(dst + bj * HALF) = pack8(silu4(acc[ai][bj][m][0] * rs), silu4(acc[ai][bj][m][1] * rs)); }
            else { const float sc = sel == 0 ? rs * D128_QSCALE : rs;
                _Pragma("unroll") for (int bj = 0; bj < 2; ++bj) *(u32x4*)(dst + bj * HALF) = pack8(acc[ai][bj][m][0] * sc, acc[ai][bj][m][1] * sc); }
        )
    }
};
struct FEpi7 {
    static constexpr bool PERM = true, AFTER_DRAIN = false; bf16_t* x2; const bf16_t* x1;
    __device__ __forceinline__ void operator()(const f32x4 (&acc)[2][2][4][2], const Unit& u, int wr, int wc, int fr, int fq) const {
        const int cw = u.pn * 256 + wc * 32 + 8 * fq;
        const size_t off0 = (size_t)(u.pm * BM + wr * 64 + fr) * 2048 + cw;
        u32x4 pre[2][2];
#define EPI7_LOAD(q, slot) { const bf16_t* p_ = x1 + off0 + (size_t)(((q) >> 2) * HALF + ((q) & 3) * 16) * 2048; pre[slot][0] = *(const u32x4*)p_; pre[slot][1] = *(const u32x4*)(p_ + HALF); }
        EPI7_LOAD(0, 0) EPI7_LOAD(1, 1)
#pragma unroll
        for (int q = 0; q < 8; ++q) { const int ai = q >> 2, m = q & 3; const size_t off = off0 + (size_t)(ai * HALF + m * 16) * 2048;
            const u32x4 r0 = pre[q & 1][0], r1 = pre[q & 1][1];
            if (q + 2 < 8) EPI7_LOAD(q + 2, q & 1)
#define BFLO(w) __uint_as_float((w) << 16)
#define BFHI(w) __uint_as_float((w) & 0xffff0000u)
            *(u32x4*)(x2 + off) = pack8((f32x4){BFLO(r0[0]), BFHI(r0[0]), BFLO(r0[1]), BFHI(r0[1])} + acc[ai][0][m][0], (f32x4){BFLO(r0[2]), BFHI(r0[2]), BFLO(r0[3]), BFHI(r0[3])} + acc[ai][0][m][1]);
            *(u32x4*)(x2 + off + HALF) = pack8((f32x4){BFLO(r1[0]), BFHI(r1[0]), BFLO(r1[1]), BFHI(r1[1])} + acc[ai][1][m][0], (f32x4){BFLO(r1[2]), BFHI(r1[2]), BFLO(r1[3]), BFHI(r1[3])} + acc[ai][1][m][1]); }
#undef BFLO
#undef BFHI
#undef EPI7_LOAD
    }
};
template <class Epi, class Sched, bool ALIGN_EPI = false, bool SP2 = false>
__device__ __forceinline__ void gemm_phase(PG8_LAS unsigned char* lds, const Gemm g, const Sched& S, const Epi& E, const int tid) {
    const int wid = __builtin_amdgcn_readfirstlane(tid >> 6), lane = tid & 63, wr = wid >> 2, wc = wid & 3, fr = lane & 15, fq = lane >> 4;
    const int K = g.K, nt = K / BK;
    unsigned voffA[2], voffB[2];
#pragma unroll
    for (int i = 0; i < 2; ++i) { int R, C; stage_rc(tid * 16 + i * 8192, R, C); const int Rb = Epi::PERM ? ((R & ~31) + perm32(R & 31)) : R;
        voffA[i] = (unsigned)(R * K + C) * 2u; voffB[i] = (unsigned)(Rb * K + C) * 2u; }
    const size_t kstep = (size_t)(BK * 2);
    const size_t hstep = (size_t)HALF * K * 2;
    const size_t tstep = 2 * hstep;
    const unsigned ldsw = (unsigned)wid * 1024u;
    const int aoff = lds_byte(wr * 64 + fr, fq * 8), boff = lds_byte(wc * 32 + fr, fq * 8);
#define PG8_SA(b, h) (((b) * 2 + (h)) * HTB)
#define PG8_SB(b, h) ((4 + (b) * 2 + (h)) * HTB)
#define PG8_STAGE(bufoff, gbase, voff) do { _Pragma("unroll") for (int _i = 0; _i < 2; ++_i) \
        __builtin_amdgcn_global_load_lds((const unsigned*)((const char*)(gbase) + (voff)[_i]), (PG8_LAS unsigned*)(lds + (bufoff) + ldsw + _i * 8192), 16, 0, 0); } while (0)
#define PG8_LDA(dst, b, h) do { _Pragma("unroll") for (int m = 0; m < 4; ++m) _Pragma("unroll") for (int k = 0; k < 2; ++k) dst[m][k] = *(const PG8_LAS bf16x8*)(lds + PG8_SA(b, h) + aoff + m * 2048 + k * 1024); } while (0)
#define PG8_LDB(dst, b, h) do { _Pragma("unroll") for (int n = 0; n < 2; ++n) _Pragma("unroll") for (int k = 0; k < 2; ++k) dst[n][k] = *(const PG8_LAS bf16x8*)(lds + PG8_SB(b, h) + boff + n * 2048 + k * 1024); } while (0)
#define PG8_MMA(ai, bj, At, Bt) do { __builtin_amdgcn_s_setprio(1); _Pragma("unroll") for (int m = 0; m < 4; ++m) _Pragma("unroll") for (int n = 0; n < 2; ++n) _Pragma("unroll") for (int k = 0; k < 2; ++k) \
        acc[ai][bj][m][n] = __builtin_amdgcn_mfma_f32_16x16x32_bf16(Bt[n][k], At[m][k], acc[ai][bj][m][n], 0, 0, 0); __builtin_amdgcn_s_setprio(0); } while (0)
#define PG8_WAIT_V(n) asm volatile("s_waitcnt vmcnt(" #n ")" ::: "memory")
#define PG8_WAIT_L(n) asm volatile("s_waitcnt lgkmcnt(" #n ")" ::: "memory")
#define PG8_BAR __builtin_amdgcn_s_barrier()
#define PG8_SCHED __builtin_amdgcn_sched_barrier(0)
    Unit cur, nxt; int ui = 0;
    if (!S.next(0, cur)) return;
    f32x4 acc[2][2][4][2];
#pragma unroll
    for (int a = 0; a < 2; ++a)
#pragma unroll
        for (int b = 0; b < 2; ++b)
#pragma unroll
            for (int m = 0; m < 4; ++m)
#pragma unroll
                for (int n = 0; n < 2; ++n) acc[a][b][m][n] = (f32x4){0.f, 0.f, 0.f, 0.f};
    bf16x8 At[4][2], B0[2][2], B1[2][2];
    const char* cA = (const char*)g.A + (size_t)cur.pm * tstep; const char* cB = (const char*)g.Bt + (size_t)cur.pn * tstep;
    S.a_ready(cur);
    if constexpr (SP2) {
        PG8_STAGE(PG8_SB(0, 0), cB, voffB); PG8_STAGE(PG8_SB(0, 1), cB + hstep, voffB); PG8_STAGE(PG8_SA(0, 0), cA, voffA); PG8_STAGE(PG8_SA(0, 1), cA + hstep, voffA);
        if (wr == 1) PG8_BAR;
        PG8_WAIT_V(2); PG8_BAR;
        PG8_STAGE(PG8_SB(1, 0), cB + kstep, voffB); PG8_STAGE(PG8_SA(1, 0), cA + kstep, voffA); PG8_STAGE(PG8_SB(1, 1), cB + hstep + kstep, voffB);
        PG8_WAIT_V(6); PG8_BAR;
    } else {
        PG8_STAGE(PG8_SB(0, 0), cB, voffB); PG8_STAGE(PG8_SA(0, 0), cA, voffA); PG8_STAGE(PG8_SB(0, 1), cB + hstep, voffB); PG8_STAGE(PG8_SA(0, 1), cA + hstep, voffA);
        if (wr == 1) PG8_BAR;
        PG8_WAIT_V(4); PG8_BAR;
        PG8_STAGE(PG8_SB(1, 0), cB + kstep, voffB); PG8_STAGE(PG8_SA(1, 0), cA + kstep, voffA); PG8_STAGE(PG8_SB(1, 1), cB + hstep + kstep, voffB);
        PG8_WAIT_V(6); PG8_BAR;
    }
    for (;;) {
        const bool has_next = S.next(ui + 1, nxt);
        const char* nA = has_next ? (const char*)g.A + (size_t)nxt.pm * tstep : cA; const char* nB = has_next ? (const char*)g.Bt + (size_t)nxt.pn * tstep : cB;
        for (int t = 0; t < nt; t += 2) {
            const bool last = (t == nt - 2);
            const char* a1 = cA + (size_t)(t + 1) * kstep;
            const char* a2 = last ? nA : cA + (size_t)(t + 2) * kstep; const char* b2 = last ? nB : cB + (size_t)(t + 2) * kstep;
            const char* a3 = a2 + kstep; const char* b3 = b2 + kstep;
            if (last && has_next) S.a_ready(nxt);
            if constexpr (SP2) {
            PG8_LDB(B0, 0, 0); PG8_LDB(B1, 0, 1); PG8_SCHED; PG8_LDA(At, 0, 0); PG8_STAGE(PG8_SA(1, 1), a1 + hstep, voffA);
            PG8_WAIT_V(8); PG8_WAIT_L(0); PG8_BAR; PG8_MMA(0, 0, At, B0); PG8_MMA(0, 1, At, B1); PG8_BAR; PG8_SCHED;
            PG8_LDA(At, 0, 1); PG8_STAGE(PG8_SB(0, 0), b2, voffB); PG8_STAGE(PG8_SB(0, 1), b2 + hstep, voffB); PG8_STAGE(PG8_SA(0, 0), a2, voffA);
            PG8_WAIT_V(8); PG8_WAIT_L(0); PG8_BAR; PG8_MMA(1, 0, At, B0); PG8_MMA(1, 1, At, B1); PG8_BAR; PG8_SCHED;
            PG8_LDB(B0, 1, 0); PG8_LDB(B1, 1, 1); PG8_SCHED; PG8_LDA(At, 1, 0); PG8_STAGE(PG8_SA(0, 1), a2 + hstep, voffA);
            PG8_WAIT_V(8); PG8_WAIT_L(0); PG8_BAR; PG8_MMA(0, 0, At, B0); PG8_MMA(0, 1, At, B1); PG8_BAR; PG8_SCHED;
            PG8_LDA(At, 1, 1); PG8_STAGE(PG8_SB(1, 0), b3, voffB); PG8_STAGE(PG8_SB(1, 1), b3 + hstep, voffB); PG8_STAGE(PG8_SA(1, 0), a3, voffA);
            PG8_WAIT_V(8); PG8_WAIT_L(0); PG8_BAR; PG8_MMA(1, 0, At, B0); PG8_MMA(1, 1, At, B1); PG8_BAR; PG8_SCHED;
            } else {
            PG8_LDB(B0, 0, 0); PG8_SCHED; PG8_LDA(At, 0, 0); PG8_STAGE(PG8_SA(1, 1), a1 + hstep, voffA);
            PG8_WAIT_L(8); PG8_BAR; PG8_WAIT_L(0); PG8_MMA(0, 0, At, B0); PG8_BAR; PG8_SCHED;
            PG8_LDB(B1, 0, 1); PG8_STAGE(PG8_SB(0, 0), b2, voffB);
            PG8_BAR; PG8_WAIT_L(0); PG8_MMA(0, 1, At, B1); PG8_BAR;
            PG8_LDA(At, 0, 1); PG8_STAGE(PG8_SA(0, 0), a2, voffA);
            PG8_BAR; PG8_WAIT_L(0); PG8_MMA(1, 0, At, B0); PG8_BAR; PG8_SCHED;
            PG8_STAGE(PG8_SB(0, 1), b2 + hstep, voffB);
            PG8_WAIT_V(6); PG8_BAR; PG8_MMA(1, 1, At, B1); PG8_BAR;
            PG8_LDB(B0, 1, 0); PG8_SCHED; PG8_LDA(At, 1, 0); PG8_STAGE(PG8_SA(0, 1), a2 + hstep, voffA);
            PG8_WAIT_L(8); PG8_BAR; PG8_WAIT_L(0); PG8_MMA(0, 0, At, B0); PG8_BAR; PG8_SCHED;
            PG8_LDB(B1, 1, 1); PG8_STAGE(PG8_SB(1, 0), b3, voffB);
            PG8_BAR; PG8_WAIT_L(0); PG8_MMA(0, 1, At, B1); PG8_BAR;
            PG8_LDA(At, 1, 1); PG8_STAGE(PG8_SA(1, 0), a3, voffA);
            PG8_BAR; PG8_WAIT_L(0); PG8_MMA(1, 0, At, B0); PG8_BAR; PG8_SCHED;
            PG8_STAGE(PG8_SB(1, 1), b3 + hstep, voffB);
            PG8_WAIT_V(6); PG8_BAR; PG8_MMA(1, 1, At, B1); PG8_BAR;
            }
        }
        if constexpr (ALIGN_EPI) { if (wr == 0) PG8_BAR; }
        if constexpr (!Epi::AFTER_DRAIN) { E(acc, cur, wr, wc, fr, fq); S.done(cur); }
        if (!has_next) break;
#pragma unroll
        for (int a = 0; a < 2; ++a)
#pragma unroll
            for (int b = 0; b < 2; ++b)
#pragma unroll
                for (int m = 0; m < 4; ++m)
#pragma unroll
                    for (int n = 0; n < 2; ++n) acc[a][b][m][n] = (f32x4){0.f, 0.f, 0.f, 0.f};
        cur = nxt; cA = nA; cB = nB; ++ui;
        if constexpr (ALIGN_EPI) { if (wr == 1) PG8_BAR; }
    }
    PG8_WAIT_V(0);
    if constexpr (!ALIGN_EPI) { if (wr == 0) PG8_BAR; }
    PG8_BAR;
    if constexpr (Epi::AFTER_DRAIN) { E.fused(acc, cur, wr, wc, fr, fq, lds, wid, lane); S.done(cur); }
#undef PG8_SA
#undef PG8_SB
#undef PG8_STAGE
#undef PG8_LDA
#undef PG8_LDB
#undef PG8_MMA
#undef PG8_WAIT_V
#undef PG8_WAIT_L
#undef PG8_BAR
#undef PG8_SCHED
}
}

#define LAS __attribute__((address_space(3)))
template <class Epi> __global__ void __launch_bounds__(512, 2) k_gemm_fast(pg8::Gemm g, Epi E) {
    extern __shared__ __attribute__((aligned(16))) unsigned char lds[];
    pg8::StaticOrder S; S.init(g.M, g.N, (int)gridDim.x, (int)blockIdx.x);
    pg8::gemm_phase<Epi, pg8::StaticOrder, true, true>((LAS unsigned char*)lds, g, S, E, (int)threadIdx.x);
}

template <class Epi>
__global__ void __launch_bounds__(256) k_gemm_naive(const bf16_t* A, const bf16_t* Bt, int N, int K, Epi epi) {
    __shared__ float As[64][33], Bs[64][33];
    const int tid = threadIdx.x, tx = tid & 15, ty = tid >> 4;
    const int nbn = N / 64; const int bm = blockIdx.x / nbn, bn = blockIdx.x % nbn;
    float acc[4][4] = {};
    const int lr = tid >> 2, lc = (tid & 3) * 8;
    for (int k0 = 0; k0 < K; k0 += 32) {
        const u32x4 av = *(const u32x4*)(A + (size_t)(bm * 64 + lr) * K + k0 + lc);
        const u32x4 bv = *(const u32x4*)(Bt + (size_t)(bn * 64 + lr) * K + k0 + lc);
        __syncthreads();
#pragma unroll
        for (int j = 0; j < 4; ++j) { As[lr][lc + 2 * j] = __uint_as_float(av[j] << 16); As[lr][lc + 2 * j + 1] = __uint_as_float(av[j] & 0xffff0000u);
                                      Bs[lr][lc + 2 * j] = __uint_as_float(bv[j] << 16); Bs[lr][lc + 2 * j + 1] = __uint_as_float(bv[j] & 0xffff0000u); }
        __syncthreads();
#pragma unroll 8
        for (int kk = 0; kk < 32; ++kk) { float a[4], b[4];
#pragma unroll
            for (int i = 0; i < 4; ++i) { a[i] = As[ty * 4 + i][kk]; b[i] = Bs[tx * 4 + i][kk]; }
#pragma unroll
            for (int i = 0; i < 4; ++i)
#pragma unroll
                for (int j = 0; j < 4; ++j) acc[i][j] += a[i] * b[j]; }
    }
#pragma unroll
    for (int i = 0; i < 4; ++i)
#pragma unroll
        for (int j = 0; j < 4; ++j) epi(bm * 64 + ty * 4 + i, bn * 64 + tx * 4 + j, acc[i][j]);
}

template <bool F32>
__global__ void __launch_bounds__(256) k_rowss(const void* src, int ld, int ncols, float* dst, int dst_ld, int nslots) {
    const int lane = threadIdx.x & 63, row = blockIdx.x * 4 + (threadIdx.x >> 6);
    float s = 0.f;
    for (int c = lane; c < ncols; c += 64) { const float v = F32 ? ((const float*)src)[(size_t)row * ld + c] : bf2f(((const bf16_t*)src)[(size_t)row * ld + c]); s += v * v; }
    s = wave_sum(s);
    if (lane < nslots) dst[(size_t)row * dst_ld + lane] = lane == 0 ? s : 0.f;
}

__global__ void __launch_bounds__(256) k_rope(bf16_t* buf, int nh, const float* rc, const float* rs) {
    const int idx = blockIdx.x * 256 + threadIdx.x; const int per_row = nh * 32; if (idx >= M * per_row) return;
    const int row = idx / per_row, t = idx % per_row, h = t >> 5, i = t & 31, pos = row % SEQ;
    bf16_t* p = buf + (size_t)row * nh * 64 + h * 64; const float x1 = bf2f(p[i]), x2 = bf2f(p[32 + i]); const float cs = rc[pos * 32 + i], sn = rs[pos * 32 + i];
    p[i] = f2bf(x1 * cs - x2 * sn); p[32 + i] = f2bf(x1 * sn + x2 * cs);
}

template <int D> DI float dot_row(const float* q, const bf16_t* k) {
    float s = 0.f;
#pragma unroll
    for (int d = 0; d < D; d += 8) { const u32x4 v = *(const u32x4*)(k + d);
#pragma unroll
        for (int j = 0; j < 4; ++j) { s += q[d + 2 * j] * __uint_as_float(v[j] << 16); s += q[d + 2 * j + 1] * __uint_as_float(v[j] & 0xffff0000u); } }
    return s;
}

__global__ void __launch_bounds__(256) k_mla_naive(Ctx c) {
    __shared__ float qs[4][192];
    const int lane = threadIdx.x & 63, w = threadIdx.x >> 6; const int gq = blockIdx.x * 4 + w;
    const int t = gq % SEQ, bh = gq / SEQ, h = bh % 8, b = bh / 8; const size_t row = (size_t)b * SEQ + t;
    unsigned char* ws = c.ws;
    const bf16_t *QN = (const bf16_t*)(ws + WS_QN), *QR = (const bf16_t*)(ws + WS_QR), *KN = (const bf16_t*)(ws + WS_KN), *KR = (const bf16_t*)(ws + WS_KR), *VA = (const bf16_t*)(ws + WS_VA), *SG = (const bf16_t*)(ws + WS_SG);
    for (int d = lane; d < 192; d += 64) qs[w][d] = d < 128 ? bf2f(QN[row * 1024 + h * 128 + d]) : bf2f(QR[row * 512 + h * 64 + d - 128]);
    __syncthreads();
    float m = -INFINITY, l = 0.f, o0 = 0.f, o1 = 0.f;
    for (int j0 = 0; j0 <= t; j0 += 64) {
        const int j = j0 + lane; const bool valid = j <= t; const size_t krow = (size_t)b * SEQ + (valid ? j : t);
        float s = dot_row<128>(qs[w], KN + krow * 1024 + h * 128) + dot_row<64>(qs[w] + 128, KR + krow * 64);
        if (!valid) s = -INFINITY;
        const float mn = fmaxf(m, wave_max(s)); const float alpha = exp2f(m - mn); const float p = valid ? exp2f(s - mn) : 0.f;
        l = l * alpha + wave_sum(p); o0 *= alpha; o1 *= alpha; m = mn;
        const int nj = min(64, t - j0 + 1);
        for (int jj = 0; jj < nj; ++jj) { const float pj = __shfl(p, jj); const bf16_t* vr = VA + ((size_t)b * SEQ + j0 + jj) * 1024 + h * 128; o0 += pj * bf2f(vr[lane]); o1 += pj * bf2f(vr[lane + 64]); }
    }
    bf16_t* MIX = (bf16_t*)(ws + WS_MIX); const float il = 1.0f / l;
    MIX[row * 2048 + h * 128 + lane] = f2bf(o0 * il * bf2f(SG[row * 2048 + h * 128 + lane]));
    MIX[row * 2048 + h * 128 + lane + 64] = f2bf(o1 * il * bf2f(SG[row * 2048 + h * 128 + lane + 64]));
}

__global__ void __launch_bounds__(256) k_dil_naive(Ctx c) {
    __shared__ float qs[4][128];
    const int lane = threadIdx.x & 63, w = threadIdx.x >> 6; const int gq = blockIdx.x * 4 + w;
    const int t = gq % SEQ, bh = gq / SEQ, h = bh % 8, b = bh / 8; const size_t row = (size_t)b * SEQ + t;
    unsigned char* ws = c.ws;
    const bf16_t *QB = (const bf16_t*)(ws + WS_QB), *KB = (const bf16_t*)(ws + WS_KB), *VB = (const bf16_t*)(ws + WS_VB);
    const float* bn = (const float*)(ws + WS_BIASN);
    for (int d = lane; d < 128; d += 64) qs[w][d] = bf2f(QB[row * 1024 + h * 128 + d]);
    __syncthreads();
    for (int p = 0; p < 3; ++p) { const int dil = p == 0 ? 1 : p == 1 ? 4 : 16;
        float m = -INFINITY, l = 0.f, o0 = 0.f, o1 = 0.f;
        for (int r0 = 0; r0 < 192; r0 += 64) {
            const int rel = r0 + lane; const int j = t - rel * dil; const bool valid = rel <= 128 && j >= 0; const size_t krow = (size_t)b * SEQ + (valid ? j : t);
            float s = dot_row<128>(qs[w], KB + krow * 1024 + h * 128) + bn[(p * 8 + h) * 132 + (valid ? rel : 0)];
            if (!valid) s = -INFINITY;
            const float mn = fmaxf(m, wave_max(s));
            const float alpha = exp2f(m - mn); const float pp = valid ? exp2f(s - mn) : 0.f;
            l = l * alpha + wave_sum(pp); o0 *= alpha; o1 *= alpha; m = mn;
            for (int jj = 0; jj < 64; ++jj) { const float pj = __shfl(pp, jj); if (pj != 0.f) { const int jr = t - (r0 + jj) * dil; const bf16_t* vr = VB + ((size_t)b * SEQ + jr) * 1024 + h * 128; o0 += pj * bf2f(vr[lane]); o1 += pj * bf2f(vr[lane + 64]); } }
        }
        bf16_t* OP = (bf16_t*)(ws + (p == 0 ? WS_OP0 : p == 1 ? WS_OP1 : WS_OP2)); const float il = 1.0f / l;
        OP[row * 1024 + h * 128 + lane] = f2bf(o0 * il); OP[row * 1024 + h * 128 + lane + 64] = f2bf(o1 * il);
        if (lane == 0) ((float*)(ws + WS_LSE))[((size_t)p * M + row) * 8 + h] = m + log2f(l);
    }
}

DI void dil_merge_item(unsigned char* ws, int row, int col) {
    const int h = col >> 7; const float* lse = (const float*)(ws + WS_LSE);
    const float l0 = lse[((size_t)0 * M + row) * 8 + h], l1 = lse[((size_t)1 * M + row) * 8 + h], l2 = lse[((size_t)2 * M + row) * 8 + h];
    const float mx = fmaxf(l0, fmaxf(l1, l2)); float w0 = exp2f(l0 - mx), w1 = exp2f(l1 - mx), w2 = exp2f(l2 - mx); const float inv = 1.0f / (w0 + w1 + w2); w0 *= inv; w1 *= inv; w2 *= inv;
    const u32x4 a0 = *(const u32x4*)((const bf16_t*)(ws + WS_OP0) + (size_t)row * 1024 + col), a1 = *(const u32x4*)((const bf16_t*)(ws + WS_OP1) + (size_t)row * 1024 + col),
                a2 = *(const u32x4*)((const bf16_t*)(ws + WS_OP2) + (size_t)row * 1024 + col), sg = *(const u32x4*)((const bf16_t*)(ws + WS_SG) + (size_t)row * 2048 + 1024 + col);
    u32x4 o;
#pragma unroll
    for (int j = 0; j < 4; ++j) {
        const float lo = (w0 * __uint_as_float(a0[j] << 16) + w1 * __uint_as_float(a1[j] << 16) + w2 * __uint_as_float(a2[j] << 16)) * __uint_as_float(sg[j] << 16);
        const float hi = (w0 * __uint_as_float(a0[j] & 0xffff0000u) + w1 * __uint_as_float(a1[j] & 0xffff0000u) + w2 * __uint_as_float(a2[j] & 0xffff0000u)) * __uint_as_float(sg[j] & 0xffff0000u);
        o[j] = (unsigned)f2bf(lo) | ((unsigned)f2bf(hi) << 16); }
    *(u32x4*)((bf16_t*)(ws + WS_MIX) + (size_t)row * 2048 + 1024 + col) = o;
}
__global__ void __launch_bounds__(128) k_dil_merge(Ctx c) { dil_merge_item(c.ws, blockIdx.x, threadIdx.x * 8); }

__global__ void __launch_bounds__(256) k_sb_naive(Ctx c) {
    __shared__ float qs[4][128];
    const int lane = threadIdx.x & 63, w = threadIdx.x >> 6; const int gq = blockIdx.x * 4 + w;
    const int t = gq % SEQ, bh = gq / SEQ, h = bh % 16, b = bh / 16; const size_t row = (size_t)b * SEQ + t;
    unsigned char* ws = c.ws;
    const bf16_t *Q2 = (const bf16_t*)(ws + WS_Q2), *K2 = (const bf16_t*)(ws + WS_K2), *V2 = (const bf16_t*)(ws + WS_V2), *SG2 = (const bf16_t*)(ws + WS_SG2);
    for (int d = lane; d < 128; d += 64) qs[w][d] = bf2f(Q2[row * 2048 + h * 128 + d]);
    __syncthreads();
    float carry = 0.f, o0 = 0.f, o1 = 0.f;
    for (int c0 = 0; c0 < t; c0 += 64) {
        const int j = t - 1 - c0 - lane; const bool valid = j >= 0; const size_t krow = (size_t)b * SEQ + (valid ? j : 0);
        const float z = dot_row<128>(qs[w], K2 + krow * 2048 + h * 128);
        const float sp = fmaxf(z, 0.f) + log2f(1.0f + exp2f(-fabsf(z)));
        const float L = valid ? -sp : 0.f;
        float incl = L;
#pragma unroll
        for (int o = 1; o < 64; o <<= 1) { const float v = __shfl_up(incl, o); if (lane >= o) incl += v; }
        const float between = carry + (incl - L);
        const float a = valid ? exp2f(z - sp + between) : 0.f;
        carry += __shfl(incl, 63);
        const int nj = min(64, t - c0);
        for (int jj = 0; jj < nj; ++jj) { const float aj = __shfl(a, jj); const bf16_t* vr = V2 + ((size_t)b * SEQ + t - 1 - c0 - jj) * 2048 + h * 128; o0 += aj * bf2f(vr[lane]); o1 += aj * bf2f(vr[lane + 64]); }
    }
    bf16_t* MIX2 = (bf16_t*)(ws + WS_MIX2);
    MIX2[row * 2048 + h * 128 + lane] = f2bf(o0 * bf2f(SG2[row * 2048 + h * 128 + lane]));
    MIX2[row * 2048 + h * 128 + lane + 64] = f2bf(o1 * bf2f(SG2[row * 2048 + h * 128 + lane + 64]));
}

#ifndef MLA_PIPE
#define MLA_PIPE 1
#endif
namespace att {
typedef short bf16x8 __attribute__((ext_vector_type(8)));
typedef short s16x4 __attribute__((ext_vector_type(4)));
typedef short v4i16_t __attribute__((ext_vector_type(4)));
typedef float f32x16 __attribute__((ext_vector_type(16)));
typedef _Float16 f16x8 __attribute__((ext_vector_type(8)));
typedef _Float16 f16x2 __attribute__((ext_vector_type(2)));
typedef float f32x2_t __attribute__((ext_vector_type(2))); typedef __bf16 bf16x2_t __attribute__((ext_vector_type(2)));
typedef LAS const unsigned char* lcp;
#define MFMA_BF16(a, b, c) __builtin_amdgcn_mfma_f32_32x32x16_bf16((a), (b), (c), 0, 0, 0)
#define MFMA_F16(a, b, c) __builtin_amdgcn_mfma_f32_32x32x16_f16((a), (b), (c), 0, 0, 0)
#define SBAR() __builtin_amdgcn_sched_barrier(0)
DI int crow(int g, int h) { return (g & 3) + 8 * (g >> 2) + 4 * h; }
DI unsigned off_b(unsigned row, unsigned ch) { return 256u * row + 16u * (ch ^ (((row & 3) << 2) | ((row >> 2) & 3))); }
DI unsigned cvtpk(float lo, float hi) { f32x2_t v = {lo, hi}; bf16x2_t b = __builtin_convertvector(v, bf16x2_t); return __builtin_bit_cast(unsigned, b); }
DI unsigned cvtpk_h(float lo, float hi) { f32x2_t v = {lo, hi}; f16x2 b = __builtin_convertvector(v, f16x2); return __builtin_bit_cast(unsigned, b); }
DI bf16x8 pack_bf(const f32x16& x, int s) { u32x4 p; p.x = cvtpk(x[8 * s], x[8 * s + 1]); p.y = cvtpk(x[8 * s + 2], x[8 * s + 3]); p.z = cvtpk(x[8 * s + 4], x[8 * s + 5]); p.w = cvtpk(x[8 * s + 6], x[8 * s + 7]); return __builtin_bit_cast(bf16x8, p); }
DI f16x8 pack_h(const f32x16& x, int s) { u32x4 p; p.x = cvtpk_h(x[8 * s], x[8 * s + 1]); p.y = cvtpk_h(x[8 * s + 2], x[8 * s + 3]); p.z = cvtpk_h(x[8 * s + 4], x[8 * s + 5]); p.w = cvtpk_h(x[8 * s + 6], x[8 * s + 7]); return __builtin_bit_cast(f16x8, p); }
DI s16x4 vtr(lcp p) { return __builtin_bit_cast(s16x4, __builtin_amdgcn_ds_read_tr16_b64_v4i16((LAS v4i16_t*)p)); }
DI float swap_max(float m) { auto rr = __builtin_amdgcn_permlane32_swap(__float_as_uint(m), __float_as_uint(m), false, false); return fmaxf(__uint_as_float(rr[0]), __uint_as_float(rr[1])); }
DI float swap_sum(float m) { auto rr = __builtin_amdgcn_permlane32_swap(__float_as_uint(m), __float_as_uint(m), false, false); return __uint_as_float(rr[0]) + __uint_as_float(rr[1]); }
DI float bcast_lo(float m) { auto rr = __builtin_amdgcn_permlane32_swap(__float_as_uint(m), __float_as_uint(m), false, false); return __uint_as_float(rr[0]); }
DI __amdgpu_buffer_rsrc_t mk_rsrc(const void* p, unsigned bytes) { return __builtin_amdgcn_make_buffer_rsrc((void*)p, 0, bytes, 0x00020000); }
DI u32x4 bload(__amdgpu_buffer_rsrc_t rs, unsigned voff, unsigned soff) { return __builtin_amdgcn_raw_buffer_load_b128(rs, voff, soff, 0); }
struct VAddr { unsigned a[2][4]; };
DI VAddr make_vaddr(int lane) { VAddr v; const unsigned hh = lane >> 5, blk = (lane >> 4) & 1, qq = (lane & 15) >> 2, p = lane & 3;
#pragma unroll
    for (int t = 0; t < 2; ++t)
#pragma unroll
        for (int d0 = 0; d0 < 4; ++d0) v.a[t][d0] = off_b(8 * t + 4 * hh + qq, 4 * d0 + 2 * blk + (p >> 1)) + 8 * (p & 1);
    return v; }
DI bf16x8 vfrag(lcp img, int s, int d0, const VAddr& va) {
    const s16x4 lo = vtr(img + 4096 * s + va.a[0][d0]);
    const s16x4 hi = vtr(img + 4096 * s + va.a[1][d0]);
    return (bf16x8){lo[0], lo[1], lo[2], lo[3], hi[0], hi[1], hi[2], hi[3]};
}
DI void softmax_tile(f32x16& s0, f32x16& s1, f32x16 (&o)[4], float& mrun, float& lrun) {
    float mt = fmaxf(s0[0], s1[0]);
#pragma unroll
    for (int g = 1; g < 16; ++g) mt = fmaxf(mt, fmaxf(s0[g], s1[g]));
    mt = swap_max(mt);
    const float mn = fmaxf(mrun, mt), alpha = __builtin_amdgcn_exp2f(mrun - mn); mrun = mn;
    float ps = 0.f;
#pragma unroll
    for (int g = 0; g < 16; ++g) { s0[g] = __builtin_amdgcn_exp2f(s0[g] - mn); s1[g] = __builtin_amdgcn_exp2f(s1[g] - mn); ps += s0[g] + s1[g]; }
    lrun = lrun * alpha + ps;
#pragma unroll
    for (int d0 = 0; d0 < 4; ++d0)
#pragma unroll
        for (int g = 0; g < 16; ++g) o[d0][g] *= alpha;
}

constexpr int MLA_KSTR = 400, MLA_KBUF = 64 * MLA_KSTR, VBUF = 16384, MLA_LDS_V = 2 * MLA_KBUF, MLA_LDS_BYTES = 2 * MLA_KBUF + 2 * VBUF;
template <bool MASKED>
DI void mla_tile(lcp kb, lcp vb, const bf16x8 (&qf)[12], f32x16 (&o)[4], float& mrun, float& lrun, const VAddr& va, int qrel, int hh) {
    f32x16 s0, s1;
#pragma unroll
    for (int g = 0; g < 16; ++g) { s0[g] = 0.f; s1[g] = 0.f; }
    bf16x8 f0a = *(LAS const bf16x8*)kb, f0b = *(LAS const bf16x8*)(kb + 32 * MLA_KSTR), f1a = *(LAS const bf16x8*)(kb + 32), f1b = *(LAS const bf16x8*)(kb + 32 * MLA_KSTR + 32), f2a, f2b;
#pragma unroll
    for (int d0 = 0; d0 < 12; ++d0) {
        if (d0 + 2 < 12) { const bf16x8 n0 = *(LAS const bf16x8*)(kb + (d0 + 2) * 32), n1 = *(LAS const bf16x8*)(kb + 32 * MLA_KSTR + (d0 + 2) * 32);
            if ((d0 + 2) % 3 == 0) { f0a = n0; f0b = n1; } else if ((d0 + 2) % 3 == 1) { f1a = n0; f1b = n1; } else { f2a = n0; f2b = n1; } }
        SBAR();
        s0 = MFMA_BF16(d0 % 3 == 0 ? f0a : d0 % 3 == 1 ? f1a : f2a, qf[d0], s0); s1 = MFMA_BF16(d0 % 3 == 0 ? f0b : d0 % 3 == 1 ? f1b : f2b, qf[d0], s1);
        SBAR();
    }
    if (MASKED) {
#pragma unroll
        for (int g = 0; g < 16; ++g) { const int kv = crow(g, 0); if (kv > qrel - 4 * hh) s0[g] = -INFINITY; if (kv + 32 > qrel - 4 * hh) s1[g] = -INFINITY; } }
    float mt = fmaxf(s0[0], s1[0]);
#pragma unroll
    for (int g = 1; g < 16; ++g) mt = fmaxf(mt, fmaxf(s0[g], s1[g]));
    mt = swap_max(mt);
    if (__builtin_amdgcn_ballot_w64(mt > mrun) != 0ull) {
        const float mn = fmaxf(mrun, mt), alpha = __builtin_amdgcn_exp2f(mrun - mn); mrun = mn; lrun *= alpha;
#pragma unroll
        for (int d0 = 0; d0 < 4; ++d0)
#pragma unroll
            for (int g = 0; g < 16; ++g) o[d0][g] *= alpha;
    }
    float ps = 0.f;
#pragma unroll
    for (int g = 0; g < 16; ++g) { s0[g] = __builtin_amdgcn_exp2f(s0[g] - mrun); s1[g] = __builtin_amdgcn_exp2f(s1[g] - mrun); ps += s0[g] + s1[g]; }
    lrun += ps;
    bf16x8 pf[4]; pf[0] = pack_bf(s0, 0); pf[1] = pack_bf(s0, 1); pf[2] = pack_bf(s1, 0); pf[3] = pack_bf(s1, 1);
    bf16x8 v0 = vfrag(vb, 0, 0, va), v1 = vfrag(vb, 0, 1, va), v2;
#pragma unroll
    for (int j = 0; j < 16; ++j) {
        if (j + 2 < 16) { const int ks = (j + 2) >> 2, d0 = (j + 2) & 3; const bf16x8 nx = vfrag(vb + (ks >> 1) * 8192, ks & 1, d0, va);
            if ((j + 2) % 3 == 0) v0 = nx; else if ((j + 2) % 3 == 1) v1 = nx; else v2 = nx; }
        SBAR();
        o[j & 3] = MFMA_BF16(j % 3 == 0 ? v0 : j % 3 == 1 ? v1 : v2, pf[j >> 2], o[j & 3]);
        SBAR();
    }
}
DI void mla_unit(LAS unsigned char* lds, unsigned char* ws, int b, int h, int qb, const int tid_in) {
    int tid = tid_in; asm volatile("" : "+v"(tid));
    const int lane = tid & 63, wid = __builtin_amdgcn_readfirstlane(tid >> 6), r = lane & 31, hh = lane >> 5;
    const bf16_t *QN = (const bf16_t*)(ws + WS_QN), *QR = (const bf16_t*)(ws + WS_QR), *KN = (const bf16_t*)(ws + WS_KN), *KR = (const bf16_t*)(ws + WS_KR), *VA = (const bf16_t*)(ws + WS_VA), *SG = (const bf16_t*)(ws + WS_SG);
    bf16_t* MIX = (bf16_t*)(ws + WS_MIX);
    const int q0 = qb * 256, NT = 4 * (qb + 1), tmax = (q0 + 32 * wid) >> 6; const size_t rowbase = (size_t)b * SEQ;
    bf16x8 qf[12];
    { const size_t qrow = rowbase + q0 + 32 * wid + r;
#pragma unroll
      for (int d0 = 0; d0 < 8; ++d0) qf[d0] = *(const bf16x8*)(QN + qrow * 1024 + h * 128 + d0 * 16 + hh * 8);
#pragma unroll
      for (int d0 = 0; d0 < 4; ++d0) qf[8 + d0] = *(const bf16x8*)(QR + qrow * 512 + h * 64 + d0 * 16 + hh * 8); }
    f32x16 o[4];
#pragma unroll
    for (int d0 = 0; d0 < 4; ++d0)
#pragma unroll
        for (int g = 0; g < 16; ++g) o[d0][g] = 0.f;
    float mrun = -INFINITY, lrun = 0.f;
    u32x4 kreg[3], vreg[2];
    const VAddr va = make_vaddr(lane);
    const __amdgpu_buffer_rsrc_t rKN = mk_rsrc(KN, M * 1024 * 2), rKR = mk_rsrc(KR, M * 64 * 2), rVA = mk_rsrc(VA, M * 1024 * 2);
    const unsigned vo0 = (tid >> 4) * 2048 + (tid & 15) * 16, vo1 = vo0 + 32 * 2048, vor = (tid >> 3) * 128 + (tid & 7) * 16;
    const unsigned so_n = ((unsigned)rowbase * 1024 + h * 128) * 2, so_r = (unsigned)rowbase * 64 * 2;
    const unsigned lk0 = (tid >> 4) * MLA_KSTR + (tid & 15) * 16, lk1 = lk0 + 32 * MLA_KSTR, lkr = (tid >> 3) * MLA_KSTR + 256 + (tid & 7) * 16;
    const unsigned lv0 = off_b((tid >> 4) & 31, tid & 15), lv1 = lv0 + 8192;
    const unsigned kfo = r * MLA_KSTR + hh * 16;
#define MLA_LOAD(t) do { const unsigned tn = so_n + (unsigned)(t) * (64 * 2048), tr_ = so_r + (unsigned)(t) * (64 * 128); \
        kreg[0] = bload(rKN, vo0, tn); kreg[1] = bload(rKN, vo1, tn); kreg[2] = bload(rKR, vor, tr_); vreg[0] = bload(rVA, vo0, tn); vreg[1] = bload(rVA, vo1, tn); } while (0)
#define MLA_STORE(buf) do { LAS unsigned char* kd = lds + (buf) * MLA_KBUF; LAS unsigned char* vd = lds + MLA_LDS_V + (buf) * VBUF; \
        *(LAS u32x4*)(kd + lk0) = kreg[0]; *(LAS u32x4*)(kd + lk1) = kreg[1]; *(LAS u32x4*)(kd + lkr) = kreg[2]; *(LAS u32x4*)(vd + lv0) = vreg[0]; *(LAS u32x4*)(vd + lv1) = vreg[1]; } while (0)
    MLA_LOAD(0); MLA_STORE(0); __builtin_amdgcn_s_waitcnt(0x0F70);   __syncthreads();
#define MLA_INTERVAL(MODE) { const int buf = t & 1; \
        if (t + 1 < NT) MLA_LOAD(t + 1); \
        if (MODE == 0) mla_tile<false>(lds + buf * MLA_KBUF + kfo, lds + MLA_LDS_V + buf * VBUF, qf, o, mrun, lrun, va, 0, hh); \
        if (MODE == 1) mla_tile<true>(lds + buf * MLA_KBUF + kfo, lds + MLA_LDS_V + buf * VBUF, qf, o, mrun, lrun, va, q0 + 32 * wid + r - 64 * t, hh); \
        if (t + 1 < NT) MLA_STORE(buf ^ 1); \
        __syncthreads(); }
    int t = 0;
    for (; t < tmax; ++t) MLA_INTERVAL(0)
    MLA_INTERVAL(1)
    for (++t; t < NT; ++t) MLA_INTERVAL(2)
#undef MLA_INTERVAL
#undef MLA_LOAD
#undef MLA_STORE
    const float inv = 1.0f / swap_sum(lrun);
    int t4 = tid; asm volatile("" : "+v"(t4)); const size_t qrow = rowbase + q0 + 32 * wid + (t4 & 31); const int hh2 = (t4 >> 5) & 1;
#pragma unroll
    for (int d0 = 0; d0 < 4; ++d0)
#pragma unroll
        for (int gg = 0; gg < 4; ++gg) { const size_t off = qrow * 2048 + h * 128 + 32 * d0 + 8 * gg + 4 * hh2;
            const unsigned long long sg = *(const unsigned long long*)(SG + off);
            const float g0 = __uint_as_float((unsigned)(sg << 16)), g1 = __uint_as_float((unsigned)sg & 0xffff0000u), g2 = __uint_as_float((unsigned)(sg >> 32) << 16), g3 = __uint_as_float((unsigned)(sg >> 32) & 0xffff0000u);
            const unsigned lo = cvtpk(o[d0][4 * gg] * inv * g0, o[d0][4 * gg + 1] * inv * g1), hi = cvtpk(o[d0][4 * gg + 2] * inv * g2, o[d0][4 * gg + 3] * inv * g3);
            *(unsigned long long*)(MIX + off) = (unsigned long long)lo | ((unsigned long long)hi << 32); }
}
DI float vmax3_s(float a, float b, float c) { float r; asm("v_max3_f32 %0, %1, %2, %3" : "=v"(r) : "v"(a), "v"(b), "v"(c)); return r; }
constexpr int M2_KBUF = 64 * 384, M2_LDS_V = 3 * M2_KBUF, M2_LDS_BYTES = M2_LDS_V + 3 * VBUF;
struct M2State { f32x16 o[4]; float mrun, lrun; };
template <int KIMM, int VIMM>
DI void mla2_iter(f32x16& zin, f32x16& zout, M2State& st, const u32x4& pi0, const u32x4& pi1, u32x4& po0, u32x4& po1, const bf16x8 (&qf)[12], const unsigned (&koff)[4], const unsigned (&voff)[2][4],
                  const bool masked, const int qrh) {
#define M2_KF(d0) (*(LAS const bf16x8*)(koff[(d0) & 3] + (unsigned)(KIMM + 128 * ((d0) >> 2))))
#define M2_VF(t, j) vtr((lcp)(voff[t][(j) & 3] + (unsigned)(VIMM + 4096 * ((j) >> 2))))
    if (masked) {
        asm volatile("" ::: "memory");
#pragma unroll
        for (int g = 0; g < 16; ++g) if (crow(g, 0) > qrh) zin[g] = -INFINITY;
    }
    bf16x8 kfA = M2_KF(0), kfB; s16x4 la, ha, lb, hb;
    float mt = 0.f, mnew = 0.f, alpha = 1.f, ps = 0.f; bool grow = false; float pe[16];
    SBAR();
#pragma unroll
    for (int i = 0; i < 20; ++i) {
        const int c5 = i % 5, blk5 = i / 5; const bool isP = (c5 == 2 || c5 == 4);
        const int qi = blk5 * 3 + (c5 < 2 ? c5 : 2), pj = blk5 * 2 + (c5 == 2 ? 0 : 1);
        if (isP) { const s16x4 lo = (pj & 1) ? lb : la, hi = (pj & 1) ? hb : ha; const bf16x8 vf = (bf16x8){lo[0], lo[1], lo[2], lo[3], hi[0], hi[1], hi[2], hi[3]};
            st.o[pj & 3] = MFMA_BF16(vf, __builtin_bit_cast(bf16x8, (pj >> 2) ? pi1 : pi0), st.o[pj & 3]); }
        else if (i == 0) { f32x16 zero_;
#pragma unroll
            for (int g = 0; g < 16; ++g) zero_[g] = 0.f;
            zout = MFMA_BF16(kfA, qf[0], zero_); }
        else zout = MFMA_BF16((qi & 1) ? kfB : kfA, qf[qi], zout);
        if (!isP && qi + 1 < 12) { const bf16x8 nx = M2_KF(qi + 1); if ((qi + 1) & 1) kfB = nx; else kfA = nx; }
        if (isP && pj + 1 < 8) { const s16x4 l_ = M2_VF(0, pj + 1), h_ = M2_VF(1, pj + 1); if ((pj + 1) & 1) { lb = l_; hb = h_; } else { la = l_; ha = h_; } }
        if (i == 0) { la = M2_VF(0, 0); ha = M2_VF(1, 0); }
        SBAR();
        if (i < 4) { float a = vmax3_s(zin[4 * i], zin[4 * i + 1], zin[4 * i + 2]); mt = i == 0 ? vmax3_s(a, zin[3], zin[3]) : vmax3_s(mt, a, zin[4 * i + 3]); asm volatile("" : "+v"(mt)); }
        if (i == 4) { mt = swap_max(mt); mnew = fmaxf(st.mrun, mt); alpha = __builtin_amdgcn_exp2f(st.mrun - mnew); grow = __builtin_amdgcn_ballot_w64(mt > st.mrun) != 0ull;
            st.mrun = mnew; st.lrun *= alpha; asm volatile("" : "+v"(mnew), "+v"(alpha)); }
        if (i >= 5 && i < 13) { const int g = 2 * (i - 5); float e0 = __builtin_amdgcn_exp2f(zin[g] - mnew), e1 = __builtin_amdgcn_exp2f(zin[g + 1] - mnew); ps += e0 + e1;
            asm volatile("" : "+v"(ps)); pe[g] = e0; pe[g + 1] = e1; }
        if (i >= 13 && i < 17) { const int w_ = i - 13; unsigned w0 = cvtpk(pe[4 * w_], pe[4 * w_ + 1]), w1 = cvtpk(pe[4 * w_ + 2], pe[4 * w_ + 3]); asm volatile("" : "+v"(w0), "+v"(w1));
            if (w_ < 2) { po0[2 * w_] = w0; po0[2 * w_ + 1] = w1; } else { po1[2 * (w_ - 2)] = w0; po1[2 * (w_ - 2) + 1] = w1; } }
        SBAR();
    }
    st.lrun += ps;
    if (grow) {
#pragma unroll
        for (int d0 = 0; d0 < 4; ++d0)
#pragma unroll
            for (int g = 0; g < 16; ++g) st.o[d0][g] *= alpha;
    }
#undef M2_KF
#undef M2_VF
}
DI void mla2_unit(LAS unsigned char* lds, unsigned char* ws, int b, int h, int qb, const int tid_in) {
    int tid = tid_in; asm volatile("" : "+v"(tid));
    const int lane = tid & 63, wid = __builtin_amdgcn_readfirstlane(tid >> 6), r = lane & 31, hh = lane >> 5;
    const bf16_t *QN = (const bf16_t*)(ws + WS_QN), *QR = (const bf16_t*)(ws + WS_QR), *KN = (const bf16_t*)(ws + WS_KN), *KR = (const bf16_t*)(ws + WS_KR), *VA = (const bf16_t*)(ws + WS_VA), *SG = (const bf16_t*)(ws + WS_SG);
    bf16_t* MIX = (bf16_t*)(ws + WS_MIX);
    const int q0 = qb * 256, NT = 4 * (qb + 1), tmax = (q0 + 32 * wid) >> 6; const size_t rowbase = (size_t)b * SEQ;
    bf16x8 qf[12];
    { const size_t qrow = rowbase + q0 + 32 * wid + r;
#pragma unroll
      for (int d0 = 0; d0 < 8; ++d0) qf[d0] = *(const bf16x8*)(QN + qrow * 1024 + h * 128 + d0 * 16 + hh * 8);
#pragma unroll
      for (int d0 = 0; d0 < 4; ++d0) qf[8 + d0] = *(const bf16x8*)(QR + qrow * 512 + h * 64 + d0 * 16 + hh * 8); }
    M2State st;
#pragma unroll
    for (int d0 = 0; d0 < 4; ++d0)
#pragma unroll
        for (int g = 0; g < 16; ++g) st.o[d0][g] = 0.f;
    st.mrun = -INFINITY; st.lrun = 0.f;
    unsigned koff[4], voff[2][4];
    { const unsigned blk = (lane >> 4) & 1, qq = (lane & 15) >> 2, p = lane & 3, f = (r >> 1) & 7;
      const unsigned kb_ = (unsigned)(size_t)lds + r * 384;
#pragma unroll
      for (int j = 0; j < 4; ++j) koff[j] = kb_ + 16 * ((2 * j + hh) ^ f);
      const unsigned vb0 = 256 * (4 * hh + qq) + 8 * (p & 1) + 16 * ((2 * blk + (p >> 1)) ^ hh), v0_ = (unsigned)(size_t)lds + M2_LDS_V + vb0, v1_ = (unsigned)(size_t)lds + M2_LDS_V + 2048 + (vb0 ^ 32);
#pragma unroll
      for (int d0 = 0; d0 < 4; ++d0) { voff[0][d0] = v0_ + ((64u * d0) ^ (64u * qq)); voff[1][d0] = v1_ + ((64u * d0) ^ (64u * qq)); } }
    const bf16_t* knb = KN + rowbase * 1024 + h * 128; const bf16_t* krb = KR + rowbase * 64; const bf16_t* vab = VA + rowbase * 1024 + h * 128;
    unsigned ksrc[3];
#pragma unroll
    for (int i_ = 0; i_ < 3; ++i_) { const int c_ = (3 * wid + i_) * 64 + lane, row_ = c_ / 24, ch_ = (c_ % 24) ^ ((row_ >> 1) & 7);
        ksrc[i_] = ch_ < 16 ? (unsigned)(row_ * 1024 + ch_ * 8) : (0x80000000u | (unsigned)(row_ * 64 + (ch_ - 16) * 8)); }
#define M2_DMAK(t, slot) do { _Pragma("unroll") for (int i_ = 0; i_ < 3; ++i_) { const unsigned o_ = ksrc[i_] & 0x7fffffffu; \
            const bf16_t* src_ = (ksrc[i_] >> 31) ? krb + (size_t)(t) * (64 * 64) + o_ : knb + (size_t)(t) * (64 * 1024) + o_; \
            __builtin_amdgcn_global_load_lds((const unsigned*)src_, (LAS unsigned*)(lds + (slot) * M2_KBUF + (3 * wid + i_) * 1024), 16, 0, 0); } } while (0)
#define M2_DMAV(t, slot) do { int t2_ = tid; asm volatile("" : "+v"(t2_)); const int ln_ = t2_ & 63, drow_ = 8 * wid + (ln_ >> 4), c15_ = ln_ & 15; \
        const unsigned s0_ = (unsigned)drow_ * 1024 + ((c15_ ^ (((drow_ & 3) << 2) | ((drow_ >> 2) & 3))) * 8), s1_ = (unsigned)(drow_ + 4) * 1024 + ((c15_ ^ ((((drow_ + 4) & 3) << 2) | (((drow_ + 4) >> 2) & 3))) * 8); \
        const bf16_t* vt = vab + (size_t)(t) * (64 * 1024); LAS unsigned char* vd = lds + M2_LDS_V + (slot) * VBUF + wid * 2048; \
        __builtin_amdgcn_global_load_lds((const unsigned*)(vt + s0_), (LAS unsigned*)vd, 16, 0, 0); __builtin_amdgcn_global_load_lds((const unsigned*)(vt + s1_), (LAS unsigned*)(vd + 1024), 16, 0, 0); } while (0)
    M2_DMAK(0, 0); M2_DMAV(0, 0); M2_DMAV(0, 2);
    if (NT > 1) M2_DMAK(1, 1);
    __builtin_amdgcn_s_waitcnt(0x0F70);
    __syncthreads();
    f32x16 za, zb;
#pragma unroll
    for (int g = 0; g < 16; ++g) { za[g] = 0.f; zb[g] = 0.f; }
#pragma unroll
    for (int d0 = 0; d0 < 12; ++d0) za = MFMA_BF16(*(LAS const bf16x8*)(koff[d0 & 3] + (unsigned)(128 * (d0 >> 2))), qf[d0], za);
    u32x4 pa[2], pb[2]; pa[0] = (u32x4){0u, 0u, 0u, 0u}; pa[1] = pa[0]; pb[0] = pa[0]; pb[1] = pa[0];
#define M2_INTERVAL(P) { if (t + 2 < NT) M2_DMAK(t + 2, ((P) + 2) % 3); if (t + 1 < NT) M2_DMAV(t + 1, ((P) + 1) % 3); \
        if (t <= tmax) {           \
            int qrh; { int t3 = tid; asm volatile("" : "+v"(t3)); qrh = q0 + 32 * wid + (t3 & 31) - 4 * ((t3 >> 5) & 1) - 64 * t; } const bool msk = t == tmax; \
            mla2_iter<(P) * M2_KBUF + 32 * 384, (((P) + 2) % 3) * VBUF + 8192>(za, zb, st, pa[0], pa[1], pb[0], pb[1], qf, koff, voff, msk, qrh); \
            mla2_iter<(((P) + 1) % 3) * M2_KBUF, (P) * VBUF>(zb, za, st, pb[0], pb[1], pa[0], pa[1], qf, koff, voff, msk, qrh - 32); \
            if (msk) {            \
                lcp vb_ = lds + M2_LDS_V + (P) * VBUF + 8192; const VAddr va_ = make_vaddr(tid & 63); \
                _Pragma("unroll") for (int j = 0; j < 8; ++j) st.o[j & 3] = MFMA_BF16(vfrag(vb_, j >> 2, j & 3, va_), __builtin_bit_cast(bf16x8, (j >> 2) ? pa[1] : pa[0]), st.o[j & 3]); } } \
        ++t; __syncthreads(); }
    int t = 0;
    for (;;) { M2_INTERVAL(0) if (t >= NT) break; M2_INTERVAL(1) if (t >= NT) break; M2_INTERVAL(2) if (t >= NT) break; }
#undef M2_INTERVAL
#undef M2_DMAK
#undef M2_DMAV
    const float inv = 1.0f / swap_sum(st.lrun);
    int t4 = tid; asm volatile("" : "+v"(t4)); const size_t qrow = rowbase + q0 + 32 * wid + (t4 & 31); const int hh2 = (t4 >> 5) & 1;
#pragma unroll
    for (int d0 = 0; d0 < 4; ++d0)
#pragma unroll
        for (int gg = 0; gg < 4; ++gg) { const size_t off = qrow * 2048 + h * 128 + 32 * d0 + 8 * gg + 4 * hh2;
            const unsigned long long sg = *(const unsigned long long*)(SG + off);
            const float g0 = __uint_as_float((unsigned)(sg << 16)), g1 = __uint_as_float((unsigned)sg & 0xffff0000u), g2 = __uint_as_float((unsigned)(sg >> 32) << 16), g3 = __uint_as_float((unsigned)(sg >> 32) & 0xffff0000u);
            const unsigned lo = cvtpk(st.o[d0][4 * gg] * inv * g0, st.o[d0][4 * gg + 1] * inv * g1), hi = cvtpk(st.o[d0][4 * gg + 2] * inv * g2, st.o[d0][4 * gg + 3] * inv * g3);
            *(unsigned long long*)(MIX + off) = (unsigned long long)lo | ((unsigned long long)hi << 32); }
}
DI void mla_phase(LAS unsigned char* lds, unsigned char* ws, const int tid) {
    const int G = gridDim.x, bx = blockIdx.x; const int vcu = (G % 8 == 0) ? (bx % 8) * (G / 8) + bx / 8 : bx;
    for (int p = vcu; p < 256; p += G) { const int bh = p >> 3, pr = p & 7;
#if MLA_PIPE
        mla2_unit(lds, ws, bh >> 3, bh & 7, 15 - pr, tid); mla2_unit(lds, ws, bh >> 3, bh & 7, pr, tid);
#else
        mla_unit(lds, ws, bh >> 3, bh & 7, 15 - pr, tid); mla_unit(lds, ws, bh >> 3, bh & 7, pr, tid);
#endif
 }
}

constexpr int SB_KBUF = 16384, SB_LDS_V = 3 * SB_KBUF, SB_LDS_UM = SB_LDS_V + 3 * VBUF, SB_LDS_BYTES = SB_LDS_UM + 2048;
DI float vmin_s(float a, float b) { float r; asm("v_min_f32 %0, %1, %2" : "=v"(r) : "v"(a), "v"(b)); return r; }
struct SbAddr { unsigned kx, vb0, vq; };
template <bool MASKED, int VAR>
DI void sb_iter(f32x16& zin, f32x16& zout, f32x16 (&o)[4], const u32x4& pi0, const u32x4& pi1, u32x4& po0, u32x4& po1, float& carry, const bf16x8 (&qf)[8], lcp ump, lcp knext, lcp vprev, const SbAddr& ad, int qrh) {
    u32x4 lw0, lw1; const float z0 = zin[0];
    unsigned kx = ad.kx, vq = ad.vq; asm volatile("" : "+v"(kx), "+v"(vq));
    bf16x8 kfa = *(LAS const bf16x8*)(knext + kx), kfb;
    const f16x8 um0 = *(LAS const f16x8*)ump, um1 = *(LAS const f16x8*)(ump + 16);
    SBAR();
#pragma unroll
    for (int k = 0; k < 8; ++k) {
        if (k == 0) {
#pragma unroll
            for (int g = 0; g < 16; ++g) zout[g] = 0.f;
        }
        if (VAR == 2 || VAR == 4 || VAR == 11 || VAR == 13) { asm volatile("" :: "v"((k & 1) ? kfb : kfa)); } else zout = MFMA_BF16((k & 1) ? kfb : kfa, qf[k], zout);
        if (VAR == 12) { zout = MFMA_BF16((k & 1) ? kfb : kfa, qf[k], zout); zout = MFMA_BF16((k & 1) ? kfb : kfa, qf[k], zout); }
        if (k + 1 < 8) { bf16x8 nx; if (VAR == 3 || VAR == 4 || VAR == 9 || VAR == 11 || VAR == 12 || VAR == 13) nx = qf[k]; else nx = *(LAS const bf16x8*)(knext + ((32u * (k + 1)) ^ kx)); if (k & 1) kfa = nx; else kfb = nx; }
        SBAR();
        float lv[2];
#pragma unroll
        for (int i = 0; i < 2; ++i) { const int g = 2 * k + i;
            float sp; if (VAR == 8 || VAR == 9 || VAR == 12) sp = zin[g]; else if (VAR == 13) { sp = __builtin_amdgcn_logf(1.0f + __builtin_amdgcn_exp2f(vmin_s(zin[g], 64.0f))); sp = __builtin_amdgcn_logf(1.0f + __builtin_amdgcn_exp2f(vmin_s(sp, 64.0f))); sp = __builtin_amdgcn_logf(1.0f + __builtin_amdgcn_exp2f(vmin_s(sp, 64.0f))); } else if (VAR == 1 || VAR == 4) sp = vmin_s(zin[g], 64.0f) * 0.5f; else sp = __builtin_amdgcn_logf(1.0f + __builtin_amdgcn_exp2f(vmin_s(zin[g], 64.0f)));
            if (MASKED) lv[i] = (crow(g, 0) < qrh) ? sp : 0.f; else lv[i] = sp; }
        unsigned w = cvtpk_h(lv[0], lv[1]);
        asm volatile("" : "+v"(w));
        if (k < 4) lw0[k & 3] = w; else lw1[k & 3] = w;
        SBAR();
    }
    zin = MFMA_F16(um0, __builtin_bit_cast(f16x8, lw0), zin); zin = MFMA_F16(um1, __builtin_bit_cast(f16x8, lw1), zin);
    SBAR();
    s16x4 la, ha, lb, hb;
    const unsigned vb0 = ad.vb0, vb1 = 2048 + (vb0 ^ 32);
    { const unsigned dq = vq; la = vtr(vprev + vb0 + dq); ha = vtr(vprev + vb1 + dq); }
#pragma unroll
    for (int j = 0; j < 8; ++j) {
        { const s16x4 lo = (j & 1) ? lb : la, hi = (j & 1) ? hb : ha;
          const bf16x8 vf = (bf16x8){lo[0], lo[1], lo[2], lo[3], hi[0], hi[1], hi[2], hi[3]};
          if (VAR == 2 || VAR == 4 || VAR == 11 || VAR == 13) { asm volatile("" :: "v"(vf)); } else o[j & 3] = MFMA_BF16(vf, __builtin_bit_cast(bf16x8, (j >> 2) ? pi1 : pi0), o[j & 3]);
          if (VAR == 12) { o[(j + 1) & 3] = MFMA_BF16(vf, __builtin_bit_cast(bf16x8, (j >> 2) ? pi1 : pi0), o[(j + 1) & 3]); o[(j + 2) & 3] = MFMA_BF16(vf, __builtin_bit_cast(bf16x8, (j >> 2) ? pi1 : pi0), o[(j + 2) & 3]); } }
        if (j + 1 < 8) { const unsigned dq = (64u * ((j + 1) & 3)) ^ vq; s16x4 l_, h_; if (VAR == 3 || VAR == 4 || VAR == 9 || VAR == 11 || VAR == 12 || VAR == 13) { l_ = (s16x4){(short)pi0[0], (short)pi0[1], (short)pi0[2], (short)pi0[3]}; h_ = l_; } else { l_ = vtr(vprev + 4096 * ((j + 1) >> 2) + vb0 + dq); h_ = vtr(vprev + 4096 * ((j + 1) >> 2) + vb1 + dq); }
            if (j & 1) { la = l_; ha = h_; } else { lb = l_; hb = h_; } }
        SBAR();
        float av[2];
#pragma unroll
        for (int i = 0; i < 2; ++i) { const int g = 2 * j + i; float a; if (VAR == 8 || VAR == 9 || VAR == 12) a = zin[g]; else if (VAR == 13) { a = __builtin_amdgcn_exp2f(zin[g] + carry); a = __builtin_amdgcn_exp2f(a + carry); a = __builtin_amdgcn_exp2f(a + carry); } else if (VAR == 1 || VAR == 4) a = zin[g] + carry; else a = __builtin_amdgcn_exp2f(zin[g] + carry); if (MASKED) av[i] = (crow(g, 0) < qrh) ? a : 0.f; else av[i] = a; }
        unsigned w = cvtpk(av[0], av[1]);
        asm volatile("" : "+v"(w));
        if (j < 4) po0[j & 3] = w; else po1[j & 3] = w;
        SBAR();
    }
    carry += bcast_lo(zin[0] - z0);
}
template <int KIMM, int VIMM>
DI void sb_iter_s(f32x16& zin, f32x16& zout, f32x16 (&o)[4], const u32x4& pi0, const u32x4& pi1, u32x4& po0, u32x4& po1, float& carry, const bf16x8 (&qf)[8], lcp ump,
                  const unsigned (&koff)[8], const unsigned (&voff)[2][4]) {
    u32x4 lw0, lw1; const float z0 = zin[0];
#define SB_KF(k) (*(LAS const bf16x8*)(koff[k] + (unsigned)KIMM))
#define SB_VF(t, j) vtr((lcp)(voff[t][(j) & 3] + (unsigned)(VIMM + 4096 * ((j) >> 2))))
    bf16x8 kfa = SB_KF(0), kfb;
    const f16x8 um0 = *(LAS const f16x8*)ump, um1 = *(LAS const f16x8*)(ump + 16);
    SBAR();
#pragma unroll
    for (int k = 0; k < 8; ++k) {
        if (k == 0) {
#pragma unroll
            for (int g = 0; g < 16; ++g) zout[g] = 0.f;
        }
        zout = MFMA_BF16((k & 1) ? kfb : kfa, qf[k], zout);
        if (k + 1 < 8) { const bf16x8 nx = SB_KF(k + 1); if (k & 1) kfa = nx; else kfb = nx; }
        SBAR();
        float lv[2];
#pragma unroll
        for (int i = 0; i < 2; ++i) lv[i] = __builtin_amdgcn_logf(1.0f + __builtin_amdgcn_exp2f(vmin_s(zin[2 * k + i], 64.0f)));
        unsigned w = cvtpk_h(lv[0], lv[1]);
        asm volatile("" : "+v"(w));
        if (k < 4) lw0[k & 3] = w; else lw1[k & 3] = w;
        SBAR();
    }
    s16x4 la = SB_VF(0, 0), ha = SB_VF(1, 0), lb, hb;
    SBAR();
    zin = MFMA_F16(um0, __builtin_bit_cast(f16x8, lw0), zin); zin = MFMA_F16(um1, __builtin_bit_cast(f16x8, lw1), zin);
    SBAR();
#pragma unroll
    for (int j = 0; j < 8; ++j) {
        { const s16x4 lo = (j & 1) ? lb : la, hi = (j & 1) ? hb : ha;
          const bf16x8 vf = (bf16x8){lo[0], lo[1], lo[2], lo[3], hi[0], hi[1], hi[2], hi[3]};
          o[j & 3] = MFMA_BF16(vf, __builtin_bit_cast(bf16x8, (j >> 2) ? pi1 : pi0), o[j & 3]); }
        if (j + 1 < 8) { const s16x4 l_ = SB_VF(0, j + 1), h_ = SB_VF(1, j + 1); if (j & 1) { la = l_; ha = h_; } else { lb = l_; hb = h_; } }
        SBAR();
        float av[2];
#pragma unroll
        for (int i = 0; i < 2; ++i) av[i] = __builtin_amdgcn_exp2f(zin[2 * j + i] + carry);
        unsigned w = cvtpk(av[0], av[1]);
        asm volatile("" : "+v"(w));
        if (j < 4) po0[j & 3] = w; else po1[j & 3] = w;
        SBAR();
    }
#undef SB_KF
#undef SB_VF
    carry += bcast_lo(zin[0] - z0);
}
template <int P>
DI void sb_tile_s(f32x16& za, f32x16& zb, f32x16 (&o)[4], u32x4 (&pa)[2], u32x4 (&pb)[2], float& carry, const bf16x8 (&qf)[8], lcp ump, const unsigned (&koff)[8], const unsigned (&voff)[2][4]) {
    constexpr int KS = P, KSN = (P + 1) % 3, VS = P, VSP = (P + 2) % 3;
    sb_iter_s<KS * SB_KBUF, VSP * VBUF>(za, zb, o, pa[0], pa[1], pb[0], pb[1], carry, qf, ump, koff, voff);
    sb_iter_s<KSN * SB_KBUF + 8192, VS * VBUF + 8192>(zb, za, o, pb[0], pb[1], pa[0], pa[1], carry, qf, ump, koff, voff);
}
template <bool MASKED, int VAR>
DI void sb_tile(LAS unsigned char* lds, f32x16& za, f32x16& zb, f32x16 (&o)[4], u32x4 (&pa)[2], u32x4 (&pb)[2], float& carry, const bf16x8 (&qf)[8], lcp ump, const SbAddr& ad,
                unsigned krow_off, int ks, int ksn, int vs, int vsp, int qrh0) {
    sb_iter<MASKED, VAR>(za, zb, o, pa[0], pa[1], pb[0], pb[1], carry, qf, ump, lds + ks * SB_KBUF + krow_off, lds + SB_LDS_V + vsp * VBUF, ad, qrh0 - 32);
    sb_iter<MASKED, VAR>(zb, za, o, pb[0], pb[1], pa[0], pa[1], carry, qf, ump, lds + ksn * SB_KBUF + 8192 + krow_off, lds + SB_LDS_V + vs * VBUF + 8192, ad, qrh0);
}
template <int VAR> DI void sb_unit(LAS unsigned char* lds, unsigned char* ws, int b, int h, int qb, const int tid_in) {
    int tid = tid_in; asm volatile("" : "+v"(tid));
    const int lane = tid & 63, wid = __builtin_amdgcn_readfirstlane(tid >> 6), r = lane & 31, hh = lane >> 5;
    const bf16_t *Q2 = (const bf16_t*)(ws + WS_Q2), *K2 = (const bf16_t*)(ws + WS_K2), *V2 = (const bf16_t*)(ws + WS_V2), *SG2 = (const bf16_t*)(ws + WS_SG2);
    bf16_t* MIX2 = (bf16_t*)(ws + (VAR ? WS_A : WS_MIX2));
    const int q0 = qb * 256, NT = 4 * (qb + 1), tmax = (q0 + 32 * wid) >> 6; const size_t rowbase = (size_t)b * SEQ;
    bf16x8 qf[8];
    { const size_t qrow = rowbase + q0 + 32 * wid + r;
#pragma unroll
      for (int d0 = 0; d0 < 8; ++d0) qf[d0] = *(const bf16x8*)(Q2 + qrow * 2048 + h * 128 + d0 * 16 + hh * 8); }
    { f16x8 um[2];
#pragma unroll
      for (int s = 0; s < 2; ++s)
#pragma unroll
          for (int j = 0; j < 8; ++j) um[s][j] = (16 * s + 8 * (j >> 2) + 4 * hh + (j & 3)) >= r ? (_Float16)-1.0f : (_Float16)0.0f;
      *(LAS f16x8*)(lds + SB_LDS_UM + lane * 32) = um[0]; *(LAS f16x8*)(lds + SB_LDS_UM + lane * 32 + 16) = um[1]; }
    lcp ump = lds + SB_LDS_UM + lane * 32;
    f32x16 o[4];
#pragma unroll
    for (int d0 = 0; d0 < 4; ++d0)
#pragma unroll
        for (int g = 0; g < 16; ++g) o[d0][g] = 0.f;
    float carry = 0.f;
    SbAddr ad;
    { const unsigned blk = (lane >> 4) & 1, qq = (lane & 15) >> 2, p = lane & 3;
      ad.kx = ((r & 15) >> 1) << 5;
      ad.vb0 = 256 * (4 * hh + qq) + 8 * (p & 1) + 16 * ((2 * blk + (p >> 1)) ^ hh); ad.vq = 64 * qq; }
    const unsigned krow_off = r * 256 + ((hh ^ (r & 1)) << 4);
    const bf16_t* kbase = K2 + rowbase * 2048 + h * 128; const bf16_t* vbase = V2 + rowbase * 2048 + h * 128;
#define SB_DMA_SRC() int t2_ = tid; asm volatile("" : "+v"(t2_)); const int ln_ = t2_ & 63, drow_ = 8 * wid + (ln_ >> 4), c15_ = ln_ & 15;
#define SB_DMAK(tau, slot) do { SB_DMA_SRC(); const unsigned s0_ = (unsigned)drow_ * 2048 + ((c15_ ^ (drow_ & 15)) * 8), s1_ = (unsigned)(drow_ + 4) * 2048 + ((c15_ ^ ((drow_ + 4) & 15)) * 8); \
        const bf16_t* kt = kbase + (size_t)(NT - 1 - (tau)) * (64 * 2048); LAS unsigned char* kd = lds + (slot) * SB_KBUF + wid * 2048; \
        __builtin_amdgcn_global_load_lds((const unsigned*)(kt + s0_), (LAS unsigned*)kd, 16, 0, 0); __builtin_amdgcn_global_load_lds((const unsigned*)(kt + s1_), (LAS unsigned*)(kd + 1024), 16, 0, 0); } while (0)
#define SB_DMAV(tau, slot) do { SB_DMA_SRC(); const unsigned s0_ = (unsigned)drow_ * 2048 + ((c15_ ^ (((drow_ & 3) << 2) | ((drow_ >> 2) & 3))) * 8), s1_ = (unsigned)(drow_ + 4) * 2048 + ((c15_ ^ ((((drow_ + 4) & 3) << 2) | (((drow_ + 4) >> 2) & 3))) * 8); \
        const bf16_t* vt = vbase + (size_t)(NT - 1 - (tau)) * (64 * 2048); LAS unsigned char* vd = lds + SB_LDS_V + (slot) * VBUF + wid * 2048; \
        __builtin_amdgcn_global_load_lds((const unsigned*)(vt + s0_), (LAS unsigned*)vd, 16, 0, 0); __builtin_amdgcn_global_load_lds((const unsigned*)(vt + s1_), (LAS unsigned*)(vd + 1024), 16, 0, 0); } while (0)
    SB_DMAK(0, 0); SB_DMAV(0, 0);
    if (NT > 1) SB_DMAK(1, 1);
    __builtin_amdgcn_s_waitcnt(0x0F70);
    __syncthreads();
    f32x16 za, zb;
#pragma unroll
    for (int g = 0; g < 16; ++g) { za[g] = 0.f; zb[g] = 0.f; }
    u32x4 pa[2], pb[2]; pa[0] = (u32x4){0u, 0u, 0u, 0u}; pa[1] = pa[0]; pb[0] = pa[0]; pb[1] = pa[0];
    int ks = 0, ks1 = 1, vs = 0, vsp = 0;
    const int nmask = NT - tmax;
#define SB_INTERVAL(MASKED) { const int t = NT - 1 - tau; const int ks2 = (ks1 == 2) ? 0 : ks1 + 1, vs1 = (vs == 2) ? 0 : vs + 1; \
        if (VAR != 5 && tau + 2 < NT) SB_DMAK(tau + 2, ks2); \
        if (VAR != 5 && tau + 1 < NT) SB_DMAV(tau + 1, vs1); \
        int qrh0; { int t3 = tid; asm volatile("" : "+v"(t3)); qrh0 = q0 + 32 * wid + (t3 & 31) - 4 * ((t3 >> 5) & 1) - 64 * t; }        \
        if (VAR != 7 || wid < 4) sb_tile<MASKED, VAR>(lds, za, zb, o, pa, pb, carry, qf, ump, ad, krow_off, ks, (tau + 1 < NT ? ks1 : ks), vs, vsp, qrh0); \
        ks = ks1; ks1 = ks2; vsp = vs; vs = vs1; \
        if (VAR != 5) __syncthreads(); }
    int tau = 0;
    for (; tau < nmask - 1; ++tau) { const int ks2 = (ks1 == 2) ? 0 : ks1 + 1, vs1 = (vs == 2) ? 0 : vs + 1;
        if (VAR != 5 && tau + 2 < NT) SB_DMAK(tau + 2, ks2);
        if (VAR != 5 && tau + 1 < NT) SB_DMAV(tau + 1, vs1);
        ks = ks1; ks1 = ks2; vsp = vs; vs = vs1;
        if (VAR != 5) __syncthreads(); }
    { lcp kp = lds + ks * SB_KBUF + 8192 + krow_off;
#pragma unroll
      for (int k = 0; k < 8; ++k) za = MFMA_BF16(*(LAS const bf16x8*)(kp + ((32u * k) ^ ad.kx)), qf[k], za); }
    for (; tau < nmask; ++tau) SB_INTERVAL(true)
    for (; tau < NT && tau % 3 != 0; ++tau) SB_INTERVAL(false)
    if (VAR == 0 && tau + 3 <= NT) {
        unsigned koff[8], voff[2][4];
        { const unsigned kb_ = (unsigned)(size_t)lds + krow_off, v0_ = (unsigned)(size_t)lds + SB_LDS_V + ad.vb0, v1_ = (unsigned)(size_t)lds + SB_LDS_V + 2048 + (ad.vb0 ^ 32);
#pragma unroll
          for (int k = 0; k < 8; ++k) koff[k] = kb_ + ((32u * k) ^ ad.kx);
#pragma unroll
          for (int d0 = 0; d0 < 4; ++d0) { voff[0][d0] = v0_ + ((64u * d0) ^ ad.vq); voff[1][d0] = v1_ + ((64u * d0) ^ ad.vq); } }
#define SB_INTERVAL_S(P) { if (tau + 2 < NT) SB_DMAK(tau + 2, (P + 2) % 3); if (tau + 1 < NT) SB_DMAV(tau + 1, (P + 1) % 3); \
            sb_tile_s<P>(za, zb, o, pa, pb, carry, qf, ump, koff, voff); ++tau; __syncthreads(); }
        for (; tau + 3 <= NT;) { SB_INTERVAL_S(0) SB_INTERVAL_S(1) SB_INTERVAL_S(2) }
#undef SB_INTERVAL_S
        ks = tau % 3; ks1 = (tau + 1) % 3; vs = tau % 3; vsp = (tau + 2) % 3;
    }
    for (; tau < NT; ++tau) SB_INTERVAL(false)
#undef SB_INTERVAL
    { lcp vp = lds + SB_LDS_V + vsp * VBUF;
#pragma unroll
      for (int j = 0; j < 8; ++j) { const unsigned dq = (64u * (j & 3)) ^ ad.vq;
          const s16x4 lo = vtr(vp + 4096 * (j >> 2) + ad.vb0 + dq), hi = vtr(vp + 4096 * (j >> 2) + 2048 + (ad.vb0 ^ 32) + dq);
          o[j & 3] = MFMA_BF16(((bf16x8){lo[0], lo[1], lo[2], lo[3], hi[0], hi[1], hi[2], hi[3]}), __builtin_bit_cast(bf16x8, (j >> 2) ? pa[1] : pa[0]), o[j & 3]); } }
    __syncthreads();
#undef SB_DMAK
#undef SB_DMAV
#undef SB_DMA_SRC
    int t4 = tid; asm volatile("" : "+v"(t4)); const size_t qrow = rowbase + q0 + 32 * wid + (t4 & 31); const int hh2 = (t4 >> 5) & 1;
#pragma unroll
    for (int d0 = 0; d0 < 4; ++d0)
#pragma unroll
        for (int gg = 0; gg < 4; ++gg) { const size_t off = qrow * 2048 + h * 128 + 32 * d0 + 8 * gg + 4 * hh2;
            const unsigned long long sg = *(const unsigned long long*)(SG2 + off);
            const float g0 = __uint_as_float((unsigned)(sg << 16)), g1 = __uint_as_float((unsigned)sg & 0xffff0000u), g2 = __uint_as_float((unsigned)(sg >> 32) << 16), g3 = __uint_as_float((unsigned)(sg >> 32) & 0xffff0000u);
            const unsigned lo = cvtpk(o[d0][4 * gg] * g0, o[d0][4 * gg + 1] * g1), hi = cvtpk(o[d0][4 * gg + 2] * g2, o[d0][4 * gg + 3] * g3);
            *(unsigned long long*)(MIX2 + off) = (unsigned long long)lo | ((unsigned long long)hi << 32); }
}
template <int VAR> DI void sb_phase(LAS unsigned char* lds, unsigned char* ws, const int tid) {
    const int G = gridDim.x, bx = blockIdx.x; const int vcu = (G % 8 == 0) ? (bx % 8) * (G / 8) + bx / 8 : bx;
    for (int p = vcu; p < 512; p += G) { const int bh = p >> 3, pr = p & 7; sb_unit<VAR>(lds, ws, bh >> 4, bh & 15, 15 - pr, tid); sb_unit<VAR>(lds, ws, bh >> 4, bh & 15, pr, tid); }
}

constexpr int DIL_KSTR = 272, DIL_WAVE_BYTES = 32 * DIL_KSTR + 8192, DIL_LDS_BYTES = 8 * DIL_WAVE_BYTES;
DI void softmax_blk(f32x16& s0, f32x16 (&o)[4], float& mrun, float& lrun) {
    float mt = s0[0];
#pragma unroll
    for (int g = 1; g < 16; ++g) mt = fmaxf(mt, s0[g]);
    mt = swap_max(mt);
    if (__builtin_amdgcn_ballot_w64(mt > mrun) != 0ull) {
        const float mn = fmaxf(mrun, mt), alpha = __builtin_amdgcn_exp2f(mrun - mn); mrun = mn; lrun *= alpha;
#pragma unroll
        for (int d0 = 0; d0 < 4; ++d0)
#pragma unroll
            for (int g = 0; g < 16; ++g) o[d0][g] *= alpha;
    }
    float ps = 0.f;
#pragma unroll
    for (int g = 0; g < 16; ++g) { s0[g] = __builtin_amdgcn_exp2f(s0[g] - mrun); ps += s0[g]; }
    lrun += ps;
}
DI void dil_wave_unit(LAS unsigned char* wl, unsigned char* ws, int p, int b, int h, int res, int m0w, const int tid_in) {
    int tid = tid_in; asm volatile("" : "+v"(tid));
    const int lane = tid & 63, r = lane & 31, hh = lane >> 5; const int dil = p == 0 ? 1 : p == 1 ? 4 : 16;
    const bf16_t *QB = (const bf16_t*)(ws + WS_QB), *KB = (const bf16_t*)(ws + WS_KB), *VB = (const bf16_t*)(ws + WS_VB);
    const size_t rowbase = (size_t)b * SEQ; const size_t qrow = rowbase + (size_t)(m0w + r) * dil + res;
    const __amdgpu_buffer_rsrc_t rK = mk_rsrc(KB, M * 1024 * 2), rV = mk_rsrc(VB, M * 1024 * 2);
    const unsigned vo = (unsigned)(lane >> 4) * dil * 2048 + (lane & 15) * 16;
    const unsigned so0 = (unsigned)((rowbase + res) * 1024 + h * 128) * 2;
    const float* biasc = (const float*)(ws + WS_BIASC) + (size_t)(p * 8 + h) * 5 * 1024 + lane * 16;
    u32x4 kr[8], vr[8]; f32x4 br[4];
    const int kb0 = m0w >> 5;
#define DIL_LOAD(di) do { const unsigned sb_ = so0 + (unsigned)(32 * (kb0 - (di))) * dil * 2048; \
        _Pragma("unroll") for (int i = 0; i < 8; ++i) { kr[i] = bload(rK, vo + (unsigned)(4 * i) * dil * 2048, sb_); vr[i] = bload(rV, vo + (unsigned)(4 * i) * dil * 2048, sb_); } \
        _Pragma("unroll") for (int j = 0; j < 4; ++j) br[j] = ((const f32x4*)(biasc + (di) * 1024))[j]; } while (0)
    DIL_LOAD(0);
    bf16x8 qf[8];
#pragma unroll
    for (int d0 = 0; d0 < 8; ++d0) qf[d0] = *(const bf16x8*)(QB + qrow * 1024 + h * 128 + d0 * 16 + hh * 8);
    f32x16 o[4];
#pragma unroll
    for (int d0 = 0; d0 < 4; ++d0)
#pragma unroll
        for (int g = 0; g < 16; ++g) o[d0][g] = 0.f;
    float mrun = -INFINITY, lrun = 0.f;
    const VAddr va = make_vaddr(lane);
    const unsigned lk = (lane >> 4) * DIL_KSTR + (lane & 15) * 16;
    for (int di = 0; di < 5; ++di) {
        if (kb0 - di < 0) break;
        asm volatile("s_waitcnt lgkmcnt(0)" ::: "memory");
#pragma unroll
        for (int i = 0; i < 8; ++i) { *(LAS u32x4*)(wl + lk + 4 * i * DIL_KSTR) = kr[i]; *(LAS u32x4*)(wl + 32 * DIL_KSTR + off_b((lane >> 4) + 4 * i, lane & 15)) = vr[i]; }
        f32x16 s0;
#pragma unroll
        for (int j = 0; j < 4; ++j) { s0[4 * j] = br[j][0]; s0[4 * j + 1] = br[j][1]; s0[4 * j + 2] = br[j][2]; s0[4 * j + 3] = br[j][3]; }
        if (di + 1 < 5 && kb0 - (di + 1) >= 0) DIL_LOAD(di + 1);
        asm volatile("s_waitcnt lgkmcnt(0)" ::: "memory");
        lcp kp = wl + r * DIL_KSTR + hh * 16;
#pragma unroll
        for (int d0 = 0; d0 < 8; ++d0) s0 = MFMA_BF16(*(LAS const bf16x8*)(kp + d0 * 32), qf[d0], s0);
        softmax_blk(s0, o, mrun, lrun);
        lcp vb = wl + 32 * DIL_KSTR;
#pragma unroll
        for (int s = 0; s < 2; ++s) { const bf16x8 pf = pack_bf(s0, s);
#pragma unroll
            for (int d0 = 0; d0 < 4; ++d0) o[d0] = MFMA_BF16(vfrag(vb, s, d0, va), pf, o[d0]); }
    }
#undef DIL_LOAD
    const float lt = swap_sum(lrun), inv = 1.0f / lt;
    bf16_t* OP = (bf16_t*)(ws + (p == 0 ? WS_OP0 : p == 1 ? WS_OP1 : WS_OP2));
#pragma unroll
    for (int d0 = 0; d0 < 4; ++d0)
#pragma unroll
        for (int gg = 0; gg < 4; ++gg) { const size_t off = qrow * 1024 + h * 128 + 32 * d0 + 8 * gg + 4 * hh;
            const unsigned lo = cvtpk(o[d0][4 * gg] * inv, o[d0][4 * gg + 1] * inv), hi = cvtpk(o[d0][4 * gg + 2] * inv, o[d0][4 * gg + 3] * inv);
            *(unsigned long long*)(OP + off) = (unsigned long long)lo | ((unsigned long long)hi << 32); }
    if (hh == 0) ((float*)(ws + WS_LSE))[((size_t)p * M + qrow) * 8 + h] = mrun + __builtin_amdgcn_logf(lt);
}
constexpr int DILW_LDS_BYTES = 12 * 8192;
DI void dil_wg_unit(LAS unsigned char* lds, unsigned char* ws, int p, int b, int h, int res, int m0, const int tid_in) {
    int tid = tid_in; asm volatile("" : "+v"(tid));
    const int lane = tid & 63, wid = __builtin_amdgcn_readfirstlane(tid >> 6), r = lane & 31, hh = lane >> 5; const int dil = p == 0 ? 1 : p == 1 ? 4 : 16;
    const bf16_t *QB = (const bf16_t*)(ws + WS_QB), *KB = (const bf16_t*)(ws + WS_KB), *VB = (const bf16_t*)(ws + WS_VB);
    const size_t rowbase = (size_t)b * SEQ; const size_t qrow = rowbase + (size_t)(m0 + 32 * wid + r) * dil + res;
    const int kbw = (m0 >> 5) - 4;
    const int prow = 4 * wid + (lane >> 4);
    const unsigned ksw = ((lane & 15) ^ (prow & 15)) * 8, vsw = ((lane & 15) ^ (((prow & 3) << 2) | ((prow >> 2) & 3))) * 8;
    const bf16_t* kg = KB + (rowbase + res) * 1024 + h * 128; const bf16_t* vg = VB + (rowbase + res) * 1024 + h * 128;
#pragma unroll
    for (int i = 0; i < 12; ++i) { const int kb = kbw + i; if (kb >= 0)
        __builtin_amdgcn_global_load_lds((const unsigned*)(kg + (size_t)(32 * kb + prow) * dil * 1024 + ksw), (LAS unsigned*)(lds + i * 8192 + wid * 1024), 16, 0, 0); }
    bf16x8 qf[8];
#pragma unroll
    for (int d0 = 0; d0 < 8; ++d0) qf[d0] = *(const bf16x8*)(QB + qrow * 1024 + h * 128 + d0 * 16 + hh * 8);
    const float* biasc = (const float*)(ws + WS_BIASC) + (size_t)(p * 8 + h) * 5 * 1024 + lane * 16;
    f32x16 sc[5];
#pragma unroll
    for (int di = 0; di < 5; ++di) { const f32x4* bp = (const f32x4*)(biasc + di * 1024);
#pragma unroll
        for (int j = 0; j < 4; ++j) { const f32x4 v = bp[j]; sc[di][4 * j] = v[0]; sc[di][4 * j + 1] = v[1]; sc[di][4 * j + 2] = v[2]; sc[di][4 * j + 3] = v[3]; } }
    __builtin_amdgcn_s_waitcnt(0x0F70);
    __syncthreads();
    const unsigned kx = ((r & 15) >> 1) << 5, krow_off = r * 256 + ((hh ^ (r & 1)) << 4);
#pragma unroll
    for (int di = 0; di < 5; ++di) { const int jj = wid + 4 - di;
        if (kbw + jj >= 0) { lcp kp = lds + jj * 8192 + krow_off;
#pragma unroll
            for (int k = 0; k < 8; ++k) sc[di] = MFMA_BF16(*(LAS const bf16x8*)(kp + ((32u * k) ^ kx)), qf[k], sc[di]); }
        else {
#pragma unroll
            for (int g = 0; g < 16; ++g) sc[di][g] = -INFINITY; } }
    float mx = sc[0][0];
#pragma unroll
    for (int di = 0; di < 5; ++di)
#pragma unroll
        for (int g = 0; g < 16; ++g) mx = fmaxf(mx, sc[di][g]);
    mx = swap_max(mx);
    float ps = 0.f; u32x4 pw[5][2];
#pragma unroll
    for (int di = 0; di < 5; ++di) {
#pragma unroll
        for (int g = 0; g < 16; ++g) { sc[di][g] = __builtin_amdgcn_exp2f(sc[di][g] - mx); ps += sc[di][g]; }
        pw[di][0] = __builtin_bit_cast(u32x4, pack_bf(sc[di], 0)); pw[di][1] = __builtin_bit_cast(u32x4, pack_bf(sc[di], 1)); }
    __syncthreads();
#pragma unroll
    for (int i = 0; i < 12; ++i) { const int kb = kbw + i; if (kb >= 0)
        __builtin_amdgcn_global_load_lds((const unsigned*)(vg + (size_t)(32 * kb + prow) * dil * 1024 + vsw), (LAS unsigned*)(lds + i * 8192 + wid * 1024), 16, 0, 0); }
    f32x16 o[4];
#pragma unroll
    for (int d0 = 0; d0 < 4; ++d0)
#pragma unroll
        for (int g = 0; g < 16; ++g) o[d0][g] = 0.f;
    const VAddr va = make_vaddr(lane);
    __builtin_amdgcn_s_waitcnt(0x0F70);
    __syncthreads();
#pragma unroll
    for (int di = 0; di < 5; ++di) { const int jj = wid + 4 - di;
        if (kbw + jj >= 0) { lcp vb = lds + jj * 8192;
#pragma unroll
            for (int s = 0; s < 2; ++s)
#pragma unroll
                for (int d0 = 0; d0 < 4; ++d0) o[d0] = MFMA_BF16(vfrag(vb, s, d0, va), __builtin_bit_cast(bf16x8, pw[di][s]), o[d0]); } }
    const float lt = swap_sum(ps), inv = 1.0f / lt;
    bf16_t* OP = (bf16_t*)(ws + (p == 0 ? WS_OP0 : p == 1 ? WS_OP1 : WS_OP2));
#pragma unroll
    for (int d0 = 0; d0 < 4; ++d0)
#pragma unroll
        for (int gg = 0; gg < 4; ++gg) { const size_t off = qrow * 1024 + h * 128 + 32 * d0 + 8 * gg + 4 * hh;
            const unsigned lo = cvtpk(o[d0][4 * gg] * inv, o[d0][4 * gg + 1] * inv), hi = cvtpk(o[d0][4 * gg + 2] * inv, o[d0][4 * gg + 3] * inv);
            *(unsigned long long*)(OP + off) = (unsigned long long)lo | ((unsigned long long)hi << 32); }
    if (hh == 0) ((float*)(ws + WS_LSE))[((size_t)p * M + qrow) * 8 + h] = mx + __builtin_amdgcn_logf(lt);
    __syncthreads();
}
DI void dil_phase(LAS unsigned char* lds, unsigned char* ws, const int tid) {
    for (int u = blockIdx.x; u < 1536; u += gridDim.x) {
        const int cidx = u & 15, h = (u >> 4) & 7, b = (u >> 7) & 3, p = u >> 9;
        const int res = p == 0 ? 0 : p == 1 ? (cidx & 3) : cidx, m0 = p == 0 ? 256 * cidx : p == 1 ? 256 * (cidx >> 2) : 0;
        dil_wg_unit(lds, ws, p, b, h, res, m0, tid);
    }
}
}

__global__ void __launch_bounds__(512, 2) k_mla_fast(Ctx c) { extern __shared__ __attribute__((aligned(16))) unsigned char lds[]; att::mla_phase((LAS unsigned char*)lds, c.ws, (int)threadIdx.x); }
__global__ void __launch_bounds__(512, 2) k_sb_fast(Ctx c) { extern __shared__ __attribute__((aligned(16))) unsigned char lds[]; att::sb_phase<0>((LAS unsigned char*)lds, c.ws, (int)threadIdx.x); }
__global__ void __launch_bounds__(512, 2) k_dil_fast(Ctx c) { extern __shared__ __attribute__((aligned(16))) unsigned char lds[]; att::dil_phase((LAS unsigned char*)lds, c.ws, (int)threadIdx.x); }

template <bool FROMBF>
DI void final_norm_row(float* out, const bf16_t* xb, const float* gain, int row, int lane) {
    f32x4* xr = (f32x4*)(out + (size_t)row * D_MODEL) + lane; const f32x4* g = (const f32x4*)gain + lane;
    f32x4 v[8]; float s = 0.f;
    if (FROMBF) { const u32x4* br = (const u32x4*)(xb + (size_t)row * D_MODEL) + lane;
#pragma unroll
        for (int j = 0; j < 4; ++j) { const u32x4 w = br[64 * j];
            v[2 * j] = (f32x4){__uint_as_float(w[0] << 16), __uint_as_float(w[0] & 0xffff0000u), __uint_as_float(w[1] << 16), __uint_as_float(w[1] & 0xffff0000u)};
            v[2 * j + 1] = (f32x4){__uint_as_float(w[2] << 16), __uint_as_float(w[2] & 0xffff0000u), __uint_as_float(w[3] << 16), __uint_as_float(w[3] & 0xffff0000u)}; }
#pragma unroll
        for (int j = 0; j < 8; ++j) s += v[j].x * v[j].x + v[j].y * v[j].y + v[j].z * v[j].z + v[j].w * v[j].w;
        const float r = rsqrtf(wave_sum(s) * (1.0f / D_MODEL) + EPS);
        f32x4* o4 = (f32x4*)(out + (size_t)row * D_MODEL); const f32x4* g4 = (const f32x4*)gain;
#pragma unroll
        for (int j = 0; j < 4; ++j) { const int i0 = 128 * j + 2 * lane; o4[i0] = v[2 * j] * r * g4[i0]; o4[i0 + 1] = v[2 * j + 1] * r * g4[i0 + 1]; }
    } else {
#pragma unroll
        for (int j = 0; j < 8; ++j) { v[j] = xr[64 * j]; s += v[j].x * v[j].x + v[j].y * v[j].y + v[j].z * v[j].z + v[j].w * v[j].w; }
        const float r = rsqrtf(wave_sum(s) * (1.0f / D_MODEL) + EPS);
#pragma unroll
        for (int j = 0; j < 8; ++j) xr[64 * j] = v[j] * r * g[64 * j];
    }
}
__global__ void __launch_bounds__(256) k_final_norm(float* out, const float* gain) { final_norm_row<false>(out, nullptr, gain, blockIdx.x * 4 + (threadIdx.x >> 6), threadIdx.x & 63); }
__global__ void __launch_bounds__(256) k_final_norm_bf(float* out, const bf16_t* xb, const float* gain) { final_norm_row<true>(out, xb, gain, blockIdx.x * 4 + (threadIdx.x >> 6), threadIdx.x & 63); }

#define XB_TMO      128
#define XB_XCNT(j)  (256  + 64 * (j))
#define XB_XSUB(j)  (1280 + 64 * (j))
#define XB_XGEN(j)  (2304 + 64 * (j))
#define XB_TOP      3328
#define XB_TOPGEN   3392
#define XCD_BAR_WORDS 3456
#define XB_SPIN_CAP (1u << 22)
DI unsigned xb_ld(unsigned* p)              { return __hip_atomic_load(p, __ATOMIC_RELAXED, __HIP_MEMORY_SCOPE_AGENT); }
DI unsigned xb_add(unsigned* p, unsigned v) { return __hip_atomic_fetch_add(p, v, __ATOMIC_RELAXED, __HIP_MEMORY_SCOPE_AGENT); }
DI unsigned xb_xcc_id() { return (unsigned)__builtin_amdgcn_s_getreg((3 << 11) | 20) & 0xFu; }
#define XB_SPIN(cond, bar) do { unsigned _sp = 0; while (cond) { __builtin_amdgcn_s_sleep(1); \
    if ((++_sp & 255u) == 0u) { if (xb_ld(&(bar)[XB_TMO])) break; if (_sp > XB_SPIN_CAP) { atomicAdd(&(bar)[XB_TMO], 1u); break; } } } } while (0)
struct XcdBarrier { unsigned* bar; unsigned x; volatile LAS unsigned* st; };
DI XcdBarrier xcd_barrier_post(unsigned* bar, volatile LAS unsigned* st, int tid) {
    XcdBarrier b; b.bar = bar; b.x = xb_xcc_id(); b.st = st;
    if (tid == 0) (void)xb_add(&bar[XB_XCNT(b.x)], 1u);
    return b;
}
DI void xcd_barrier_complete(unsigned* bar, unsigned x, unsigned& nloc, unsigned& nx) {
    const unsigned G = gridDim.x * gridDim.y * gridDim.z;
    unsigned sum, cnt, mine, sp = 0u;
    for (;;) {
        sum = 0u; cnt = 0u; mine = 0u;
#pragma unroll
        for (unsigned j = 0; j < 16; ++j) { const unsigned c = xb_ld(&bar[XB_XCNT(j)]); sum += c; cnt += (c > 0u) ? 1u : 0u; mine = (j == x) ? c : mine; }
        if (sum == G) break;
        __builtin_amdgcn_s_sleep(1);
        if ((++sp & 255u) == 0u) { if (xb_ld(&bar[XB_TMO])) break; if (sp > XB_SPIN_CAP) { atomicAdd(&bar[XB_TMO], 1u); break; } }
    }
    nloc = mine > 0u ? mine : 1u; nx = cnt > 0u ? cnt : 1u;
}
DI void xcd_barrier(const XcdBarrier& b, int tid) {
    asm volatile("s_waitcnt vmcnt(0)" ::: "memory");
    __syncthreads();
    if (tid == 0) {
        unsigned* bar = b.bar;
        __builtin_amdgcn_s_waitcnt(0);
        unsigned nloc = b.st[0], nx = b.st[1];
        if (nloc == 0u) { xcd_barrier_complete(bar, b.x, nloc, nx); b.st[0] = nloc; b.st[1] = nx; }
        const unsigned old = xb_add(&bar[XB_XSUB(b.x)], 1u);
        const unsigned gen = old / nloc;
        if (old + 1u == (gen + 1u) * nloc) {
            __builtin_amdgcn_fence(__ATOMIC_RELEASE, "agent");
            asm volatile("s_waitcnt vmcnt(0)" ::: "memory");
            const unsigned og = xb_add(&bar[XB_TOP], 1u);
            const unsigned tg = og / nx;
            if (og + 1u == (tg + 1u) * nx) xb_add(&bar[XB_TOPGEN], 1u);
            else XB_SPIN(xb_ld(&bar[XB_TOPGEN]) == tg, bar);
            __builtin_amdgcn_fence(__ATOMIC_ACQUIRE, "agent");
            xb_add(&bar[XB_XGEN(b.x)], 1u);
            asm volatile("s_waitcnt vmcnt(0)" ::: "memory");
        } else {
            XB_SPIN(xb_ld(&bar[XB_XGEN(b.x)]) == gen, bar);
            __builtin_amdgcn_fence(__ATOMIC_ACQUIRE, "agent");
            asm volatile("s_waitcnt vmcnt(0)" ::: "memory");
        }
    }
    __syncthreads();
}

constexpr int MEGA_LDS_PHASE = 135168, MEGA_LDS = MEGA_LDS_PHASE + 64;
#ifndef SYNC_PROBE
#define SYNC_PROBE 0
#endif
#ifndef SB_PROBE_VAR
#define SB_PROBE_VAR 0
#endif
#ifndef PROBE_MASK
#define PROBE_MASK 0
#endif
#define PREP(k) for (int rep_ = 0; rep_ < 1 + ((PROBE_MASK >> (k)) & 1); ++rep_)
__global__ void __launch_bounds__(512, 2) k_mega(Ctx c) {
    extern __shared__ __attribute__((aligned(16))) unsigned char lds_raw[];
    LAS unsigned char* lds = (LAS unsigned char*)lds_raw;
    unsigned char* ws = c.ws; const int G = gridDim.x, bx = blockIdx.x;
    const int wave_s = __builtin_amdgcn_readfirstlane((int)threadIdx.x >> 6);
    volatile LAS unsigned* bst = (volatile LAS unsigned*)(lds + MEGA_LDS_PHASE);
    if (threadIdx.x < 16) bst[threadIdx.x] = 0u;
    __syncthreads();
    const XcdBarrier xbar = xcd_barrier_post((unsigned*)(ws + WS_CTL), bst, (int)threadIdx.x);
#define GRID_BAR() xcd_barrier(xbar, phase_tid(wave_s))
    PREP(0) { prep_phase<8, 0>(c, (float*)lds_raw, phase_tid(wave_s)); __syncthreads(); }
    GRID_BAR();
    PREP(1) { pg8::Gemm g{(const bf16_t*)(ws + WS_H0), (const bf16_t*)(ws + WS_WT_IN_E), M, IN_EVEN_PAD, 2048}; pg8::StaticOrder S; S.init(g.M, g.N, G, bx);
      pg8::gemm_phase<pg8::FEpi1, pg8::StaticOrder, true, true>(lds, g, S, pg8::FEpi1{ws}, phase_tid(wave_s)); }
    { const int nlast = (M / 256) * (IN_EVEN_PAD / 256) % G; const int nfree = nlast ? G - nlast : G, me = nlast ? bx - nlast : bx;
      if (me >= 0) { const int tid = phase_tid(wave_s); prep_weights<1>(c, (float*)lds_raw + (tid >> 6) * 64 * 36, tid & 63, me * 8 + (tid >> 6), nfree * 8); } }
    GRID_BAR();
    PREP(2) { att::dil_phase(lds, ws, phase_tid(wave_s));
    __syncthreads(); }
    PREP(7) { pg8::Gemm g{(const bf16_t*)(ws + WS_CQ), (const bf16_t*)(ws + WS_WT_UQ), M, 1536, 512}; pg8::StaticOrder S; S.init(g.M, g.N, G, bx);
      pg8::gemm_phase<pg8::FEpi2a, pg8::StaticOrder, true, true>(lds, g, S, pg8::FEpi2a{ws}, phase_tid(wave_s)); }
    PREP(7) { pg8::Gemm g{(const bf16_t*)(ws + WS_CKV), (const bf16_t*)(ws + WS_WT_UKV), M, 2048, 512}; pg8::StaticOrder S; S.init(g.M, g.N, G, bx);
      pg8::gemm_phase<pg8::FEpi2b, pg8::StaticOrder, true, true>(lds, g, S, pg8::FEpi2b{ws}, phase_tid(wave_s)); }
    GRID_BAR();
    PREP(3) att::mla_phase(lds, ws, phase_tid(wave_s));
    PREP(8) { const int tid = phase_tid(wave_s); for (int it = bx * 512 + tid; it < M * 128; it += G * 512) dil_merge_item(ws, it >> 7, (it & 127) * 8); }
    GRID_BAR();
    PREP(4) { pg8::Gemm g{(const bf16_t*)(ws + WS_MIX), (const bf16_t*)(ws + WS_WT_OUT_E), M, 2048, 2048}; pg8::StaticOrder S; S.init(g.M, g.N, G, bx);
      pg8::gemm_phase<pg8::FEpi4, pg8::StaticOrder, false, true>(lds, g, S, pg8::FEpi4{ws, c.x, c.out}, phase_tid(wave_s)); }
    GRID_BAR();
    PREP(5) { pg8::Gemm g{(const bf16_t*)(ws + WS_X1BF), (const bf16_t*)(ws + WS_WT_IN_O), M, IN_ODD, 2048}; pg8::StaticOrder S; S.init(g.M, g.N, G, bx);
      pg8::gemm_phase<pg8::FEpi5, pg8::StaticOrder, true, true>(lds, g, S, pg8::FEpi5{ws}, phase_tid(wave_s)); }
    GRID_BAR();
    PREP(6) att::sb_phase<0>(lds, ws, phase_tid(wave_s));
#if SB_PROBE_VAR
    att::sb_phase<SB_PROBE_VAR>(lds, ws, phase_tid(wave_s));
#endif
    GRID_BAR();
    { pg8::Gemm g{(const bf16_t*)(ws + WS_MIX2), (const bf16_t*)(ws + WS_WT_OUT_O), M, 2048, 2048}; pg8::StaticOrder S; S.init(g.M, g.N, G, bx);
      pg8::gemm_phase<pg8::FEpi7, pg8::StaticOrder, false, true>(lds, g, S, pg8::FEpi7{(bf16_t*)(ws + WS_X2BF), (const bf16_t*)(ws + WS_X1BF)}, phase_tid(wave_s)); }
    GRID_BAR();
#if SYNC_PROBE
    for (int i_ = 0; i_ < 8; ++i_) GRID_BAR();
#endif
    { const int tid = phase_tid(wave_s); for (int row = bx * 8 + (tid >> 6); row < M; row += G * 8) final_norm_row<true>(c.out, (const bf16_t*)(ws + WS_X2BF), c.final_gain, row, tid & 63); }
}

#ifndef MK_ONE_LAUNCH
#define MK_ONE_LAUNCH 1
#endif
#ifndef FAST_G1
#define FAST_G1 1
#endif
#ifndef FAST_G2
#define FAST_G2 1
#endif
#ifndef FAST_G4
#define FAST_G4 1
#endif
#ifndef FAST_G5
#define FAST_G5 1
#endif
#ifndef FAST_G7
#define FAST_G7 1
#endif
#ifndef FAST_MLA
#define FAST_MLA 1
#endif
#ifndef FAST_SB
#define FAST_SB 1
#endif
#ifndef FAST_DIL
#define FAST_DIL 1
#endif
static void launch_att(void (*k)(Ctx), int lds_bytes, const Ctx& c, hipStream_t s) {
    (void)hipFuncSetAttribute((const void*)k, hipFuncAttributeMaxDynamicSharedMemorySize, lds_bytes);
    hipLaunchKernelGGL(k, dim3(256), dim3(512), lds_bytes, s, c);
}
template <class Epi> static void launch_gemm_fast(const bf16_t* A, const bf16_t* Bt, int N, int K, Epi E, hipStream_t s) {
    static bool attr = false; if (!attr) { (void)hipFuncSetAttribute((const void*)k_gemm_fast<Epi>, hipFuncAttributeMaxDynamicSharedMemorySize, 131072); attr = true; }
    pg8::Gemm g{A, Bt, M, N, K};
    k_gemm_fast<Epi><<<256, 512, 131072, s>>>(g, E);
}

extern "C" void kernel_launch(void* const* d_in, const int* in_sizes, int n_in, void* d_out, int out_size, void* d_ws, size_t ws_size, hipStream_t stream) {
    if (n_in != 12 || out_size != M * D_MODEL || ws_size < WS_END) { fprintf(stderr, "kernel_launch: unexpected shapes (n_in %d out %d ws %zu)\n", n_in, out_size, ws_size); return; }
    Ctx c{};
    c.x = (const float*)d_in[0]; c.norm_gain = (const float*)d_in[1]; c.w_in_even = (const float*)d_in[2]; c.q_norm_gain = (const float*)d_in[3]; c.kv_norm_gain = (const float*)d_in[4];
    c.w_uq = (const float*)d_in[5]; c.w_ukv = (const float*)d_in[6]; c.w_out_even = (const float*)d_in[7]; c.rel_bias = (const float*)d_in[8]; c.w_in_odd = (const float*)d_in[9];
    c.w_out_odd = (const float*)d_in[10]; c.final_gain = (const float*)d_in[11]; c.out = (float*)d_out; c.ws = (unsigned char*)d_ws;
#if MK_ONE_LAUNCH
    static int grid_blocks = 0;
    if (!grid_blocks) {
        int dev = 0, cus = 0, per_cu = 0;
        (void)hipGetDevice(&dev); (void)hipDeviceGetAttribute(&cus, hipDeviceAttributeMultiprocessorCount, dev);
        (void)hipFuncSetAttribute((const void*)k_mega, hipFuncAttributeMaxDynamicSharedMemorySize, MEGA_LDS);
        (void)hipOccupancyMaxActiveBlocksPerMultiprocessor(&per_cu, (const void*)k_mega, 512, MEGA_LDS);
        if (per_cu < 1) { fprintf(stderr, "kernel_launch: occupancy query says %d blocks/CU\n", per_cu); per_cu = 1; }
        grid_blocks = cus;
    }
    (void)hipMemsetAsync((char*)d_ws + WS_CTL, 0, 65536, stream);
    { void* args[] = {&c};
      hipError_t e = hipLaunchCooperativeKernel((void*)k_mega, dim3(grid_blocks), dim3(512), args, MEGA_LDS, stream);
      if (e != hipSuccess) fprintf(stderr, "cooperative launch failed: %s (grid %d)\n", hipGetErrorString(e), grid_blocks); }
    return;
#endif
    unsigned char* ws = c.ws;
    const float* rc = (const float*)(ws + WS_ROPE); const float* rs = rc + 4096 * 32;
    k_prep<<<2048, 256, 0, stream>>>(c);
#if FAST_G1
    launch_gemm_fast((const bf16_t*)(ws + WS_H0), (const bf16_t*)(ws + WS_WT_IN_E), IN_EVEN_PAD, 2048, pg8::FEpi1{ws}, stream);
#else
    k_gemm_naive<Epi1><<<(M / 64) * (IN_EVEN_PAD / 64), 256, 0, stream>>>((const bf16_t*)(ws + WS_H0), (const bf16_t*)(ws + WS_WT_IN_E), IN_EVEN_PAD, 2048, Epi1{ws});
    k_rowss<false><<<M / 4, 256, 0, stream>>>(ws + WS_CQ, 512, 512, (float*)(ws + WS_SSC), 16, 8);
    k_rowss<false><<<M / 4, 256, 0, stream>>>(ws + WS_CKV, 512, 512, (float*)(ws + WS_SSC) + 8, 16, 8);
    k_rope<<<(M * 32 + 255) / 256, 256, 0, stream>>>((bf16_t*)(ws + WS_KR), 1, rc, rs);
#endif
#if FAST_DIL
    launch_att(k_dil_fast, att::DIL_LDS_BYTES, c, stream);
#else
    k_dil_naive<<<BATCH * 8 * SEQ / 4, 256, 0, stream>>>(c);
#endif
#if FAST_G2
    launch_gemm_fast((const bf16_t*)(ws + WS_CQ), (const bf16_t*)(ws + WS_WT_UQ), 1536, 512, pg8::FEpi2a{ws}, stream);
    launch_gemm_fast((const bf16_t*)(ws + WS_CKV), (const bf16_t*)(ws + WS_WT_UKV), 2048, 512, pg8::FEpi2b{ws}, stream);
#else
    k_gemm_naive<Epi2a><<<(M / 64) * (1536 / 64), 256, 0, stream>>>((const bf16_t*)(ws + WS_CQ), (const bf16_t*)(ws + WS_WT_UQ), 1536, 512, Epi2a{ws});
    k_rope<<<(M * 256 + 255) / 256, 256, 0, stream>>>((bf16_t*)(ws + WS_QR), 8, rc, rs);
    k_gemm_naive<Epi2b><<<(M / 64) * (2048 / 64), 256, 0, stream>>>((const bf16_t*)(ws + WS_CKV), (const bf16_t*)(ws + WS_WT_UKV), 2048, 512, Epi2b{ws});
#endif
#if FAST_MLA
    launch_att(k_mla_fast, att::M2_LDS_BYTES > att::MLA_LDS_BYTES ? att::M2_LDS_BYTES : att::MLA_LDS_BYTES, c, stream);
#else
    k_mla_naive<<<BATCH * 8 * SEQ / 4, 256, 0, stream>>>(c);
#endif
    k_dil_merge<<<M, 128, 0, stream>>>(c);
#if FAST_G4
    launch_gemm_fast((const bf16_t*)(ws + WS_MIX), (const bf16_t*)(ws + WS_WT_OUT_E), 2048, 2048, pg8::FEpi4{ws, c.x, c.out}, stream);
#else
    k_gemm_naive<Epi4><<<(M / 64) * (2048 / 64), 256, 0, stream>>>((const bf16_t*)(ws + WS_MIX), (const bf16_t*)(ws + WS_WT_OUT_E), 2048, 2048, Epi4{ws, c.x, c.out});
    k_rowss<true><<<M / 4, 256, 0, stream>>>(c.out, 2048, 2048, (float*)(ws + WS_SSX1), 32, 32);
#endif
#if FAST_G5
    launch_gemm_fast((const bf16_t*)(ws + WS_X1BF), (const bf16_t*)(ws + WS_WT_IN_O), IN_ODD, 2048, pg8::FEpi5{ws}, stream);
#else
    k_gemm_naive<Epi5><<<(M / 64) * (IN_ODD / 64), 256, 0, stream>>>((const bf16_t*)(ws + WS_X1BF), (const bf16_t*)(ws + WS_WT_IN_O), IN_ODD, 2048, Epi5{ws});
#endif
#if FAST_SB
    launch_att(k_sb_fast, att::SB_LDS_BYTES, c, stream);
#else
    k_sb_naive<<<BATCH * 16 * SEQ / 4, 256, 0, stream>>>(c);
#endif
#if FAST_G7
    launch_gemm_fast((const bf16_t*)(ws + WS_MIX2), (const bf16_t*)(ws + WS_WT_OUT_O), 2048, 2048, pg8::FEpi7{(bf16_t*)(ws + WS_X2BF), (const bf16_t*)(ws + WS_X1BF)}, stream);
#else
    k_gemm_naive<Epi7><<<(M / 64) * (2048 / 64), 256, 0, stream>>>((const bf16_t*)(ws + WS_MIX2), (const bf16_t*)(ws + WS_WT_OUT_O), 2048, 2048, Epi7{c.out});
#endif
#if FAST_G7
    k_final_norm_bf<<<M / 4, 256, 0, stream>>>(c.out, (const bf16_t*)(ws + WS_X2BF), c.final_gain);
#else
    k_final_norm<<<M / 4, 256, 0, stream>>>(c.out, c.final_gain);
#endif
}
```

```cpp
#include <hip/hip_runtime.h>
#include <cstdio>
#include <cstdint>
#include <cmath>

typedef unsigned short bf16_t;
typedef unsigned u32x4 __attribute__((ext_vector_type(4)));
typedef float f32x4 __attribute__((ext_vector_type(4)));

constexpr int D_MODEL = 2048, BATCH = 4, SEQ = 4096, M = BATCH * SEQ;
constexpr int NH_MLA = 8, NH_DIL = 8, NH_SB = 16, HD = 128;
constexpr int IN_EVEN = 6208, IN_EVEN_PAD = 6400, IN_ODD = 8192;
constexpr float EPS = 1e-6f;
constexpr float LOG2E = 1.4426950408889634f;
constexpr float MLA_QSCALE = 0.07216878364870322f * LOG2E;
constexpr float D128_QSCALE = 0.08838834764831845f * LOG2E;

constexpr size_t MiB = 1u << 20;
constexpr size_t WS_CTL = 0;
constexpr size_t WS_ROPE = 1 * MiB;
constexpr size_t WS_BIASN = 2 * MiB;
constexpr size_t WS_BIASC = 2 * MiB + 65536;
constexpr size_t WS_SSX = 3 * MiB;
constexpr size_t WS_SSC = 4 * MiB;
constexpr size_t WS_SSX1 = 5 * MiB;
constexpr size_t WS_LSE = 9 * MiB;
constexpr size_t WS_WT_IN_E = 12 * MiB;
constexpr size_t WS_WT_UQ = 37 * MiB;
constexpr size_t WS_WT_UKV = 39 * MiB;
constexpr size_t WS_WT_OUT_E = 41 * MiB;
constexpr size_t WS_WT_IN_O = 49 * MiB;
constexpr size_t WS_WT_OUT_O = 81 * MiB;
constexpr size_t WS_A = 90 * MiB;
constexpr size_t WS_B = 154 * MiB;
constexpr size_t WS_C = 218 * MiB;
constexpr size_t WS_H0 = WS_A, WS_OP0 = WS_A, WS_OP1 = WS_A + 32 * MiB, WS_X1BF = WS_A;
constexpr size_t WS_CQ = WS_B, WS_CKV = WS_B + 16 * MiB, WS_QB = WS_B + 32 * MiB, WS_MIX = WS_B, WS_MIX2 = WS_B;
constexpr size_t WS_KB = WS_C, WS_VB = WS_C + 32 * MiB, WS_SG = WS_C + 64 * MiB, WS_QN = WS_C + 128 * MiB, WS_QR = WS_C + 160 * MiB,
                 WS_KN = WS_C + 176 * MiB, WS_VA = WS_C + 208 * MiB, WS_KR = WS_C + 240 * MiB, WS_OP2 = WS_C + 242 * MiB;
constexpr size_t WS_X2BF = WS_C;
constexpr size_t WS_Q2 = WS_C, WS_K2 = WS_C + 64 * MiB, WS_V2 = WS_C + 128 * MiB, WS_SG2 = WS_C + 192 * MiB;
constexpr size_t WS_END = WS_C + 274 * MiB;

struct Ctx {
    const float *x, *norm_gain, *w_in_even, *q_norm_gain, *kv_norm_gain, *w_uq, *w_ukv, *w_out_even, *rel_bias, *w_in_odd, *w_out_odd, *final_gain;
    float* out; unsigned char* ws;
};

#define DI __device__ __forceinline__
DI int phase_tid(int wave_s) { int lane; asm volatile("v_mbcnt_lo_u32_b32 %0, -1, 0\n\tv_mbcnt_hi_u32_b32 %0, -1, %0" : "=v"(lane)); return wave_s * 64 + lane; }
DI float bf2f(bf16_t v) { return __uint_as_float(((unsigned)v) << 16); }
DI bf16_t f2bf(float f) { unsigned u = __float_as_uint(f); return (bf16_t)((u + 0x7fffu + ((u >> 16) & 1u)) >> 16); }
DI float wave_sum(float v) {
#pragma unroll
    for (int o = 1; o < 64; o <<= 1) v += __shfl_xor(v, o);
    return v;
}
DI float wave_max(float v) {
#pragma unroll
    for (int o = 1; o < 64; o <<= 1) v = fmaxf(v, __shfl_xor(v, o));
    return v;
}
DI float silu_f(float v) { return v / (1.0f + __expf(-v)); }

DI int map_in_even(int n) { if (n < 1024) return n; if (n < 1056) return 1024 + (n - 1024); if (n < 1088) return 1152 + (n - 1056); return n - 1088 + 1280; }
DI int map_uq(int n) { const int h = n / 192, j = n % 192; if (j < 128) return h * 128 + j; if (j < 160) return 1024 + (h >> 2) * 256 + (h & 3) * 32 + (j - 128);
    return 1024 + (h >> 2) * 256 + 128 + (h & 3) * 32 + (j - 160); }
DI int map_ukv(int n) { const int h = n / 256, j = n % 256; if (j < 128) return h * 128 + j; return 1024 + h * 128 + (j - 128); }
DI int map_id(int n) { return n; }

template <int MAPID>
DI void transpose_item(const float* W, int K, int N, const float* gain, bf16_t* WT, float* scr  , int item, int lane) {
    const int nblk = N / 32, kb = item / nblk, nb = item % nblk, k0 = 64 * kb, n0 = 32 * nb;
    f32x4 v[8];
#pragma unroll
    for (int i = 0; i < 8; ++i) { const int kk = 8 * i + (lane >> 3); v[i] = *(const f32x4*)(W + (size_t)(k0 + kk) * N + n0 + 4 * (lane & 7)); }
#pragma unroll
    for (int i = 0; i < 8; ++i) { const int kk = 8 * i + (lane >> 3); const float g = gain ? gain[k0 + kk] : 1.0f; *(f32x4*)(scr + kk * 36 + 4 * (lane & 7)) = v[i] * g; }
    asm volatile("s_waitcnt lgkmcnt(0)" ::: "memory");
    const int d0 = MAPID == 0 ? map_in_even(n0) : MAPID == 1 ? map_uq(n0) : MAPID == 2 ? map_ukv(n0) : map_id(n0);
    const int c = lane & 7;
#pragma unroll
    for (int j = 0; j < 4; ++j) { const int n = (lane >> 3) + 8 * j; const float* s = scr + (8 * c) * 36 + n;
        u32x4 o; o.x = f2bf(s[0]) | ((unsigned)f2bf(s[36]) << 16); o.y = f2bf(s[72]) | ((unsigned)f2bf(s[108]) << 16);
        o.z = f2bf(s[144]) | ((unsigned)f2bf(s[180]) << 16); o.w = f2bf(s[216]) | ((unsigned)f2bf(s[252]) << 16);
        *(u32x4*)(WT + (size_t)(d0 + n) * K + k0 + 8 * c) = o; }
    asm volatile("s_waitcnt lgkmcnt(0)" ::: "memory");
}

DI int t5_bucket(int dist) {
    if (dist < 16) return dist;
    float d = (float)dist;
    int large = 16 + (int)(logf(d / 16.0f) / 4.852030263919617f * 16.0f);
    return large < 31 ? large : 31;
}

template <int PART> DI void prep_weights(const Ctx& c, float* scr, int lane, int gw, int NGW) {
    unsigned char* ws = c.ws;
    constexpr int I0 = (2048 / 64) * (IN_EVEN / 32), I1 = (512 / 64) * (1536 / 32), I2 = (512 / 64) * (2048 / 32), I3 = (2048 / 64) * (2048 / 32),
                  I4 = (2048 / 64) * (IN_ODD / 32), I5 = I3;
    constexpr int LO = PART == 1 ? I0 : 0, HI = PART == 0 ? I0 : I0 + I1 + I2 + I3 + I4 + I5;
    for (int it = LO + gw; it < HI; it += NGW) {
        int r = it;
        if (r < I0) { transpose_item<0>(c.w_in_even, 2048, IN_EVEN, c.norm_gain, (bf16_t*)(ws + WS_WT_IN_E), scr, r, lane); continue; } r -= I0;
        if (r < I1) { transpose_item<1>(c.w_uq, 512, 1536, c.q_norm_gain, (bf16_t*)(ws + WS_WT_UQ), scr, r, lane); continue; } r -= I1;
        if (r < I2) { transpose_item<2>(c.w_ukv, 512, 2048, c.kv_norm_gain, (bf16_t*)(ws + WS_WT_UKV), scr, r, lane); continue; } r -= I2;
        if (r < I3) { transpose_item<3>(c.w_out_even, 2048, 2048, nullptr, (bf16_t*)(ws + WS_WT_OUT_E), scr, r, lane); continue; } r -= I3;
        if (r < I4) { transpose_item<3>(c.w_in_odd, 2048, IN_ODD, c.norm_gain + 2048, (bf16_t*)(ws + WS_WT_IN_O), scr, r, lane); continue; } r -= I4;
        transpose_item<3>(c.w_out_odd, 2048, 2048, nullptr, (bf16_t*)(ws + WS_WT_OUT_O), scr, r, lane);
    }
}
template <int NW, int PART> DI void prep_phase(const Ctx& c, float* scr_all, const int tid) {
    const int lane = tid & 63, wave = tid >> 6;
    float* scr = scr_all + wave * 64 * 36;
    const int gw = blockIdx.x * NW + wave, NGW = gridDim.x * NW;
    unsigned char* ws = c.ws;
    prep_weights<PART>(c, scr, lane, gw, NGW);
    const int gt = blockIdx.x * (NW * 64) + tid, NGT = gridDim.x * (NW * 64);
    { bf16_t* wt = (bf16_t*)(ws + WS_WT_IN_E);
      for (int i = gt; i < 192 * 256; i += NGT) { const int rr = i / 256, cc = i % 256; const int row = rr < 96 ? 1056 + rr : 1184 + (rr - 96);
          *(u32x4*)(wt + (size_t)row * 2048 + cc * 8) = (u32x4){0u, 0u, 0u, 0u}; } }
    { float* rc = (float*)(ws + WS_ROPE); float* rs = rc + 4096 * 32;
      for (int i = gt; i < 4096 * 32; i += NGT) { const int pos = i >> 5, j = i & 31; const float inv = 1.0f / powf(10000.0f, (float)j / 32.0f); const float ang = (float)pos * inv;
          rc[i] = cosf(ang); rs[i] = sinf(ang); } }
    { float* bn = (float*)(ws + WS_BIASN);
      for (int i = gt; i < 3 * 8 * 132; i += NGT) { const int p = i / (8 * 132), h = (i / 132) % 8, rel = i % 132; const int dil = p == 0 ? 1 : p == 1 ? 4 : 16;
          bn[i] = rel <= 128 ? c.rel_bias[t5_bucket(rel * dil) * 8 + h] * LOG2E : 0.f; } }
    { float* bc = (float*)(ws + WS_BIASC);
      for (int i = gt; i < 3 * 8 * 5 * 1024; i += NGT) { const int g = i & 15, ln = (i >> 4) & 63, di = (i >> 10) % 5, ph = i / 5120, h = ph & 7, p = ph >> 3; const int dil = p == 0 ? 1 : p == 1 ? 4 : 16;
          const int rel = 32 * di + (ln & 31) - ((g & 3) + 8 * (g >> 2) + 4 * (ln >> 5));
          bc[i] = (rel >= 0 && rel <= 128) ? c.rel_bias[t5_bucket(rel * dil) * 8 + h] * LOG2E : -INFINITY; } }
    { bf16_t* h0 = (bf16_t*)(ws + WS_H0); float* ssx = (float*)(ws + WS_SSX);
      for (int m = gw; m < M; m += NGW) { const f32x4* xr = (const f32x4*)(c.x + (size_t)m * D_MODEL) + lane; float s = 0.f;
          unsigned long long* o8 = (unsigned long long*)(h0 + (size_t)m * D_MODEL) + lane;
          for (int j = 0; j < 8; ++j) { const f32x4 v = xr[64 * j]; s += v.x * v.x + v.y * v.y + v.z * v.z + v.w * v.w;
              o8[64 * j] = (unsigned long long)(f2bf(v.x) | ((unsigned)f2bf(v.y) << 16)) | ((unsigned long long)(f2bf(v.z) | ((unsigned)f2bf(v.w) << 16)) << 32); }
          s = wave_sum(s); if (lane == 0) ssx[m] = s; } }
}

__global__ void __launch_bounds__(256) k_prep(Ctx c) { __shared__ float scr_all[4 * 64 * 36]; prep_phase<4, 2>(c, scr_all, (int)threadIdx.x); }

DI float rscale(const float* part, int n, float inv_cols) { float s = 0.f; for (int i = 0; i < n; ++i) s += part[i]; return rsqrtf(s * inv_cols + EPS); }

struct Epi1 {
    unsigned char* ws;
    DI void operator()(int row, int col, float acc) const {
        const float v = acc * rsqrtf(((const float*)(ws + WS_SSX))[row] * (1.0f / 2048.0f) + EPS);
        if (col < 512) ((bf16_t*)(ws + WS_CQ))[(size_t)row * 512 + col] = f2bf(v);
        else if (col < 1024) ((bf16_t*)(ws + WS_CKV))[(size_t)row * 512 + col - 512] = f2bf(v);
        else if (col < 1280) { const int t = col - 1024; if (t < 32) ((bf16_t*)(ws + WS_KR))[(size_t)row * 64 + t] = f2bf(v); else if (t >= 128 && t < 160) ((bf16_t*)(ws + WS_KR))[(size_t)row * 64 + 32 + t - 128] = f2bf(v); }
        else if (col < 2304) ((bf16_t*)(ws + WS_QB))[(size_t)row * 1024 + col - 1280] = f2bf(v * D128_QSCALE);
        else if (col < 3328) ((bf16_t*)(ws + WS_KB))[(size_t)row * 1024 + col - 2304] = f2bf(v);
        else if (col < 4352) ((bf16_t*)(ws + WS_VB))[(size_t)row * 1024 + col - 3328] = f2bf(v);
        else ((bf16_t*)(ws + WS_SG))[(size_t)row * 2048 + col - 4352] = f2bf(silu_f(v));
    }
};
struct Epi2a {
    unsigned char* ws;
    DI void operator()(int row, int col, float acc) const {
        const float v = acc * rscale((const float*)(ws + WS_SSC) + (size_t)row * 16, 8, 1.0f / 512.0f) * MLA_QSCALE;
        if (col < 1024) ((bf16_t*)(ws + WS_QN))[(size_t)row * 1024 + col] = f2bf(v);
        else { const int t = col - 1024, grp = t >> 8, u = t & 255, half = u >> 7, hh = (u & 127) >> 5, i = u & 31;
            ((bf16_t*)(ws + WS_QR))[(size_t)row * 512 + (4 * grp + hh) * 64 + half * 32 + i] = f2bf(v); }
    }
};
struct Epi2b {
    unsigned char* ws;
    DI void operator()(int row, int col, float acc) const {
        const float v = acc * rscale((const float*)(ws + WS_SSC) + (size_t)row * 16 + 8, 8, 1.0f / 512.0f);
        if (col < 1024) ((bf16_t*)(ws + WS_KN))[(size_t)row * 1024 + col] = f2bf(v); else ((bf16_t*)(ws + WS_VA))[(size_t)row * 1024 + col - 1024] = f2bf(v);
    }
};
struct Epi4 {
    unsigned char* ws; const float* x; float* out;
    DI void operator()(int row, int col, float acc) const {
        const float v = x[(size_t)row * 2048 + col] + acc; out[(size_t)row * 2048 + col] = v; ((bf16_t*)(ws + WS_X1BF))[(size_t)row * 2048 + col] = f2bf(v);
    }
};
struct Epi5 {
    unsigned char* ws;
    DI void operator()(int row, int col, float acc) const {
        const float v = acc * rscale((const float*)(ws + WS_SSX1) + (size_t)row * 32, 32, 1.0f / 2048.0f);
        if (col < 2048) ((bf16_t*)(ws + WS_Q2))[(size_t)row * 2048 + col] = f2bf(v * D128_QSCALE);
        else if (col < 4096) ((bf16_t*)(ws + WS_K2))[(size_t)row * 2048 + col - 2048] = f2bf(v);
        else if (col < 6144) ((bf16_t*)(ws + WS_V2))[(size_t)row * 2048 + col - 4096] = f2bf(v);
        else ((bf16_t*)(ws + WS_SG2))[(size_t)row * 2048 + col - 6144] = f2bf(silu_f(v));
    }
};
struct Epi7 {
    float* out;
    DI void operator()(int row, int col, float acc) const { out[(size_t)row * 2048 + col] += acc; }
};

namespace pg8 {
#define PG8_LAS __attribute__((address_space(3)))
typedef short bf16x8 __attribute__((ext_vector_type(8)));
constexpr int BM = 256, BK = 64, HALF = 128, HTB = HALF * BK * 2  , STAGE_BYTES = 8 * HTB, NXCD = 8, WGM = 8;

__host__ __device__ __forceinline__ int lds_byte(int r, int c) { const int st = (r >> 4) * 2 + (c >> 5), rr = r & 15, cc = c & 31, ob = rr * 64 + cc * 2; return st * 1024 + (ob ^ (((ob >> 9) & 1) << 5)); }
__host__ __device__ __forceinline__ void stage_rc(int b, int& R, int& C) { const int st = b / 1024, sb = b % 1024, swz = sb ^ (((sb >> 9) & 1) << 5); R = (st >> 1) * 16 + swz / 64; C = (st & 1) * 32 + (swz % 64) / 2; }
__host__ __device__ __forceinline__ int perm32(int rho) { const int n = rho >> 4, i = rho & 15; return 8 * (i >> 2) + 4 * n + (i & 3); }

struct Unit { int pm, pn; };
struct Gemm { const bf16_t* A; const bf16_t* Bt; int M, N, K; };

struct StaticOrder {
    int nM, nN, nwg, G, c;
    __host__ __device__ void init(int M, int N, int G_, int c_) { nM = M / BM; nN = N / BM; nwg = nM * nN; G = G_; c = c_; }
    __host__ __device__ bool next(int i, Unit& u) const {
        const long L = (long)i * G + c; if (L >= nwg) return false;
        int wgid = (int)L; { const int q = nwg / NXCD, r = nwg % NXCD, xcd = wgid % NXCD, off = wgid / NXCD; wgid = (xcd < r ? xcd * (q + 1) : r * (q + 1) + (xcd - r) * q) + off; }
        const int nig = WGM * nN, gid = wgid / nig, fm = gid * WGM, gsz = (nM - fm) < WGM ? (nM - fm) : WGM;
        u.pm = fm + ((wgid % nig) % gsz); u.pn = (wgid % nig) / gsz; return true;
    }
    __device__ __forceinline__ void a_ready(const Unit&) const {}
    __device__ __forceinline__ void done(const Unit&) const {}
};


typedef float f32x2_t __attribute__((ext_vector_type(2))); typedef __bf16 bf16x2_t __attribute__((ext_vector_type(2)));
__device__ __forceinline__ unsigned cvtpk(float lo, float hi) { f32x2_t v = {lo, hi}; bf16x2_t b = __builtin_convertvector(v, bf16x2_t); return __builtin_bit_cast(unsigned, b); }
__device__ __forceinline__ u32x4 pack8(const f32x4& a, const f32x4& b) { u32x4 w; w.x = cvtpk(a[0], a[1]); w.y = cvtpk(a[2], a[3]); w.z = cvtpk(b[0], b[1]); w.w = cvtpk(b[2], b[3]); return w; }
__device__ __forceinline__ float sumsq4(const f32x4& a) { return (a[0] * a[0] + a[1] * a[1]) + (a[2] * a[2] + a[3] * a[3]); }
__device__ __forceinline__ float silu1(float v) { return v * __builtin_amdgcn_rcpf(1.0f + __builtin_amdgcn_exp2f(-v * LOG2E)); }
__device__ __forceinline__ f32x4 silu4(const f32x4& a) { return (f32x4){silu1(a[0]), silu1(a[1]), silu1(a[2]), silu1(a[3])}; }
__device__ __forceinline__ float quad_sum(float s) { s += __shfl_xor(s, 16); s += __shfl_xor(s, 32); return s; }
__device__ __forceinline__ void rope8(const f32x4& a0, const f32x4& a1, const f32x4& b0, const f32x4& b1, const float* rc, const float* rs, int pos, int i0, u32x4& o1, u32x4& o2) {
    const f32x4 c0 = *(const f32x4*)(rc + pos * 32 + i0), c1 = *(const f32x4*)(rc + pos * 32 + i0 + 4), s0 = *(const f32x4*)(rs + pos * 32 + i0), s1 = *(const f32x4*)(rs + pos * 32 + i0 + 4);
    o1 = pack8(a0 * c0 - b0 * s0, a1 * c1 - b1 * s1); o2 = pack8(a0 * s0 + b0 * c0, a1 * s1 + b1 * c1);
}
#define PG8_EPI_ROWS(...) _Pragma("unroll") for (int ai = 0; ai < 2; ++ai) _Pragma("unroll") for (int m = 0; m < 4; ++m) { const int row = u.pm * BM + ai * HALF + wr * 64 + m * 16 + fr; __VA_ARGS__ }

struct FEpi1 {
    static constexpr bool PERM = true, AFTER_DRAIN = false; unsigned char* ws;
    __device__ __forceinline__ void operator()(const f32x4 (&acc)[2][2][4][2], const Unit& u, int wr, int wc, int fr, int fq) const {
        const int pn = u.pn, cw = wc * 32 + 8 * fq; const float* ssx = (const float*)(ws + WS_SSX);
        PG8_EPI_ROWS(
            const float rs = rsqrtf(ssx[row] * (1.0f / 2048.0f) + EPS);
            if (pn < 4) { bf16_t* dst = (bf16_t*)(ws + (pn < 2 ? WS_CQ : WS_CKV)) + (size_t)row * 512 + (pn & 1) * 256 + cw; float ss = 0.f;
                _Pragma("unroll") for (int bj = 0; bj < 2; ++bj) { const f32x4 v0 = acc[ai][bj][m][0] * rs, v1 = acc[ai][bj][m][1] * rs; ss += sumsq4(v0) + sumsq4(v1); *(u32x4*)(dst + bj * HALF) = pack8(v0, v1); }
                ss = quad_sum(ss); if (fq == 0) ((float*)(ws + WS_SSC))[(size_t)row * 16 + pn * 4 + wc] = ss; }
            else if (pn == 4) { if (wc == 0) { const float* rc = (const float*)(ws + WS_ROPE); u32x4 o1, o2;
                rope8(acc[ai][0][m][0] * rs, acc[ai][0][m][1] * rs, acc[ai][1][m][0] * rs, acc[ai][1][m][1] * rs, rc, rc + 4096 * 32, row % SEQ, 8 * fq, o1, o2);
                bf16_t* dst = (bf16_t*)(ws + WS_KR) + (size_t)row * 64 + 8 * fq; *(u32x4*)dst = o1; *(u32x4*)(dst + 32) = o2; } }
            else if (pn < 17) { const int t = pn - 5; bf16_t* dst = (bf16_t*)(ws + (t < 4 ? WS_QB : t < 8 ? WS_KB : WS_VB)) + (size_t)row * 1024 + (t & 3) * 256 + cw; const float sc = t < 4 ? rs * D128_QSCALE : rs;
                _Pragma("unroll") for (int bj = 0; bj < 2; ++bj) *(u32x4*)(dst + bj * HALF) = pack8(acc[ai][bj][m][0] * sc, acc[ai][bj][m][1] * sc); }
            else { bf16_t* dst = (bf16_t*)(ws + WS_SG) + (size_t)row * 2048 + (pn - 17) * 256 + cw;
                _Pragma("unroll") for (int bj = 0; bj < 2; ++bj) *(u32x4*)(dst + bj * HALF) = pack8(silu4(acc[ai][bj][m][0] * rs), silu4(acc[ai][bj][m][1] * rs)); }
        )
    }
};
struct FEpi2a {
    static constexpr bool PERM = true, AFTER_DRAIN = false; unsigned char* ws;
    __device__ __forceinline__ void operator()(const f32x4 (&acc)[2][2][4][2], const Unit& u, int wr, int wc, int fr, int fq) const {
        const int pn = u.pn, cw = wc * 32 + 8 * fq;
        PG8_EPI_ROWS(
            const f32x4* sp = (const f32x4*)((const float*)(ws + WS_SSC) + (size_t)row * 16); const f32x4 p0 = sp[0], p1 = sp[1];
            const float rs = rsqrtf(((p0[0] + p0[1]) + (p0[2] + p0[3]) + (p1[0] + p1[1]) + (p1[2] + p1[3])) * (1.0f / 512.0f) + EPS) * MLA_QSCALE;
            if (pn < 4) { bf16_t* dst = (bf16_t*)(ws + WS_QN) + (size_t)row * 1024 + pn * 256 + cw;
                _Pragma("unroll") for (int bj = 0; bj < 2; ++bj) *(u32x4*)(dst + bj * HALF) = pack8(acc[ai][bj][m][0] * rs, acc[ai][bj][m][1] * rs); }
            else { const float* rc = (const float*)(ws + WS_ROPE); u32x4 o1, o2; const int head = 4 * (pn - 4) + wc;
                rope8(acc[ai][0][m][0] * rs, acc[ai][0][m][1] * rs, acc[ai][1][m][0] * rs, acc[ai][1][m][1] * rs, rc, rc + 4096 * 32, row % SEQ, 8 * fq, o1, o2);
                bf16_t* dst = (bf16_t*)(ws + WS_QR) + (size_t)row * 512 + head * 64 + 8 * fq; *(u32x4*)dst = o1; *(u32x4*)(dst + 32) = o2; }
        )
    }
};
struct FEpi2b {
    static constexpr bool PERM = true, AFTER_DRAIN = false; unsigned char* ws;
    __device__ __forceinline__ void operator()(const f32x4 (&acc)[2][2][4][2], const Unit& u, int wr, int wc, int fr, int fq) const {
        const int pn = u.pn, cw = wc * 32 + 8 * fq;
        PG8_EPI_ROWS(
            const f32x4* sp = (const f32x4*)((const float*)(ws + WS_SSC) + (size_t)row * 16 + 8); const f32x4 p0 = sp[0], p1 = sp[1];
            const float rs = rsqrtf(((p0[0] + p0[1]) + (p0[2] + p0[3]) + (p1[0] + p1[1]) + (p1[2] + p1[3])) * (1.0f / 512.0f) + EPS);
            bf16_t* dst = (bf16_t*)(ws + (pn < 4 ? WS_KN : WS_VA)) + (size_t)row * 1024 + (pn & 3) * 256 + cw;
            _Pragma("unroll") for (int bj = 0; bj < 2; ++bj) *(u32x4*)(dst + bj * HALF) = pack8(acc[ai][bj][m][0] * rs, acc[ai][bj][m][1] * rs);
        )
    }
};
struct FEpi4 {
    static constexpr bool PERM = true, AFTER_DRAIN = false; unsigned char* ws; const float* x; float* out;
    __device__ __forceinline__ void operator()(const f32x4 (&acc)[2][2][4][2], const Unit& u, int wr, int wc, int fr, int fq) const {
        const int pn = u.pn, cw = pn * 256 + wc * 32 + 8 * fq;
        const size_t off0 = (size_t)(u.pm * BM + wr * 64 + fr) * 2048 + cw;
        f32x4 pre[2][4];
#define EPI4_LOAD(q, slot) { const float* p_ = x + off0 + (size_t)(((q) >> 2) * HALF + ((q) & 3) * 16) * 2048; pre[slot][0] = *(const f32x4*)p_; pre[slot][1] = *(const f32x4*)(p_ + 4); pre[slot][2] = *(const f32x4*)(p_ + HALF); pre[slot][3] = *(const f32x4*)(p_ + HALF + 4); }
        EPI4_LOAD(0, 0) EPI4_LOAD(1, 1)
#pragma unroll
        for (int q = 0; q < 8; ++q) { const int ai = q >> 2, m = q & 3; const size_t off = off0 + (size_t)(ai * HALF + m * 16) * 2048;
            const f32x4 v00 = pre[q & 1][0] + acc[ai][0][m][0], v01 = pre[q & 1][1] + acc[ai][0][m][1], v10 = pre[q & 1][2] + acc[ai][1][m][0], v11 = pre[q & 1][3] + acc[ai][1][m][1];
            if (q + 2 < 8) EPI4_LOAD(q + 2, q & 1)
            *(u32x4*)((bf16_t*)(ws + WS_X1BF) + off) = pack8(v00, v01); *(u32x4*)((bf16_t*)(ws + WS_X1BF) + off + HALF) = pack8(v10, v11);
            float ss = (sumsq4(v00) + sumsq4(v01)) + (sumsq4(v10) + sumsq4(v11));
            ss = quad_sum(ss); if (fq == 0) ((float*)(ws + WS_SSX1))[(size_t)(u.pm * BM + ai * HALF + wr * 64 + m * 16 + fr) * 32 + pn * 4 + wc] = ss; }
#undef EPI4_LOAD
    }
};
struct FEpi5 {
    static constexpr bool PERM = true, AFTER_DRAIN = false; unsigned char* ws;
    __device__ __forceinline__ void operator()(const f32x4 (&acc)[2][2][4][2], const Unit& u, int wr, int wc, int fr, int fq) const {
        const int pn = u.pn, cw = (pn & 7) * 256 + wc * 32 + 8 * fq; const int sel = pn >> 3;
        PG8_EPI_ROWS(
            const f32x4* sp = (const f32x4*)((const float*)(ws + WS_SSX1) + (size_t)row * 32 + 8 * fq); const f32x4 p0 = sp[0], p1 = sp[1];
            const float tot = quad_sum((p0[0] + p0[1]) + (p0[2] + p0[3]) + (p1[0] + p1[1]) + (p1[2] + p1[3]));
            const float rs = rsqrtf(tot * (1.0f / 2048.0f) + EPS);
            bf16_t* dst = (bf16_t*)(ws + (sel == 0 ? WS_Q2 : sel == 1 ? WS_K2 : sel == 2 ? WS_V2 : WS_SG2)) + (size_t)row * 2048 + cw;
            if (sel == 3) { _Pragma("unroll") for (int bj = 0; bj < 2; ++bj) *(u32x4*)(dst + bj * HALF) = pack8(silu4(acc[ai][bj][m][0] * rs), silu4(acc[ai][bj][m][1] * rs)); }
            else { const float sc = sel == 0 ? rs * D128_QSCALE : rs;
                _Pragma("unroll") for (int bj = 0; bj < 2; ++bj) *(u32x4*)(dst + bj * HALF) = pack8(acc[ai][bj][m][0] * sc, acc[ai][bj][m][1] * sc); }
        )
    }
};
struct FEpi7 {
    static constexpr bool PERM = true, AFTER_DRAIN = false; bf16_t* x2; const bf16_t* x1;
    __device__ __forceinline__ void operator()(const f32x4 (&acc)[2][2][4][2], const Unit& u, int wr, int wc, int fr, int fq) const {
        const int cw = u.pn * 256 + wc * 32 + 8 * fq;
        const size_t off0 = (size_t)(u.pm * BM + wr * 64 + fr) * 2048 + cw;
        u32x4 pre[2][2];
#define EPI7_LOAD(q, slot) { const bf16_t* p_ = x1 + off0 + (size_t)(((q) >> 2) * HALF + ((q) & 3) * 16) * 2048; pre[slot][0] = *(const u32x4*)p_; pre[slot][1] = *(const u32x4*)(p_ + HALF); }
        EPI7_LOAD(0, 0) EPI7_LOAD(1, 1)
#pragma unroll
        for (int q = 0; q < 8; ++q) { const int ai = q >> 2, m = q & 3; const size_t off = off0 + (size_t)(ai * HALF + m * 16) * 2048;
            const u32x4 r0 = pre[q & 1][0], r1 = pre[q & 1][1];
            if (q + 2 < 8) EPI7_LOAD(q + 2, q & 1)
#define BFLO(w) __uint_as_float((w) << 16)
#define BFHI(w) __uint_as_float((w) & 0xffff0000u)
            *(u32x4*)(x2 + off) = pack8((f32x4){BFLO(r0[0]), BFHI(r0[0]), BFLO(r0[1]), BFHI(r0[1])} + acc[ai][0][m][0], (f32x4){BFLO(r0[2]), BFHI(r0[2]), BFLO(r0[3]), BFHI(r0[3])} + acc[ai][0][m][1]);
            *(u32x4*)(x2 + off + HALF) = pack8((f32x4){BFLO(r1[0]), BFHI(r1[0]), BFLO(r1[1]), BFHI(r1[1])} + acc[ai][1][m][0], (f32x4){BFLO(r1[2]), BFHI(r1[2]), BFLO(r1[3]), BFHI(r1[3])} + acc[ai][1][m][1]); }
#undef BFLO
#undef BFHI
#undef EPI7_LOAD
    }
};
template <class Epi, class Sched, bool ALIGN_EPI = false, bool SP2 = false>
__device__ __forceinline__ void gemm_phase(PG8_LAS unsigned char* lds, const Gemm g, const Sched& S, const Epi& E, const int tid) {
    const int wid = __builtin_amdgcn_readfirstlane(tid >> 6), lane = tid & 63, wr = wid >> 2, wc = wid & 3, fr = lane & 15, fq = lane >> 4;
    const int K = g.K, nt = K / BK;
    unsigned voffA[2], voffB[2];
#pragma unroll
    for (int i = 0; i < 2; ++i) { int R, C; stage_rc(tid * 16 + i * 8192, R, C); const int Rb = Epi::PERM ? ((R & ~31) + perm32(R & 31)) : R;
        voffA[i] = (unsigned)(R * K + C) * 2u; voffB[i] = (unsigned)(Rb * K + C) * 2u; }
    const size_t kstep = (size_t)(BK * 2);
    const size_t hstep = (size_t)HALF * K * 2;
    const size_t tstep = 2 * hstep;
    const unsigned ldsw = (unsigned)wid * 1024u;
    const int aoff = lds_byte(wr * 64 + fr, fq * 8), boff = lds_byte(wc * 32 + fr, fq * 8);
#define PG8_SA(b, h) (((b) * 2 + (h)) * HTB)
#define PG8_SB(b, h) ((4 + (b) * 2 + (h)) * HTB)
#define PG8_STAGE(bufoff, gbase, voff) do { _Pragma("unroll") for (int _i = 0; _i < 2; ++_i) \
        __builtin_amdgcn_global_load_lds((const unsigned*)((const char*)(gbase) + (voff)[_i]), (PG8_LAS unsigned*)(lds + (bufoff) + ldsw + _i * 8192), 16, 0, 0); } while (0)
#define PG8_LDA(dst, b, h) do { _Pragma("unroll") for (int m = 0; m < 4; ++m) _Pragma("unroll") for (int k = 0; k < 2; ++k) dst[m][k] = *(const PG8_LAS bf16x8*)(lds + PG8_SA(b, h) + aoff + m * 2048 + k * 1024); } while (0)
#define PG8_LDB(dst, b, h) do { _Pragma("unroll") for (int n = 0; n < 2; ++n) _Pragma("unroll") for (int k = 0; k < 2; ++k) dst[n][k] = *(const PG8_LAS bf16x8*)(lds + PG8_SB(b, h) + boff + n * 2048 + k * 1024); } while (0)
#define PG8_MMA(ai, bj, At, Bt) do { __builtin_amdgcn_s_setprio(1); _Pragma("unroll") for (int m = 0; m < 4; ++m) _Pragma("unroll") for (int n = 0; n < 2; ++n) _Pragma("unroll") for (int k = 0; k < 2; ++k) \
        acc[ai][bj][m][n] = __builtin_amdgcn_mfma_f32_16x16x32_bf16(Bt[n][k], At[m][k], acc[ai][bj][m][n], 0, 0, 0); __builtin_amdgcn_s_setprio(0); } while (0)
#define PG8_WAIT_V(n) asm volatile("s_waitcnt vmcnt(" #n ")" ::: "memory")
#define PG8_WAIT_L(n) asm volatile("s_waitcnt lgkmcnt(" #n ")" ::: "memory")
#define PG8_BAR __builtin_amdgcn_s_barrier()
#define PG8_SCHED __builtin_amdgcn_sched_barrier(0)
    Unit cur, nxt; int ui = 0;
    if (!S.next(0, cur)) return;
    f32x4 acc[2][2][4][2];
#pragma unroll
    for (int a = 0; a < 2; ++a)
#pragma unroll
        for (int b = 0; b < 2; ++b)
#pragma unroll
            for (int m = 0; m < 4; ++m)
#pragma unroll
                for (int n = 0; n < 2; ++n) acc[a][b][m][n] = (f32x4){0.f, 0.f, 0.f, 0.f};
    bf16x8 At[4][2], B0[2][2], B1[2][2];
    const char* cA = (const char*)g.A + (size_t)cur.pm * tstep; const char* cB = (const char*)g.Bt + (size_t)cur.pn * tstep;
    S.a_ready(cur);
    if constexpr (SP2) {
        PG8_STAGE(PG8_SB(0, 0), cB, voffB); PG8_STAGE(PG8_SB(0, 1), cB + hstep, voffB); PG8_STAGE(PG8_SA(0, 0), cA, voffA); PG8_STAGE(PG8_SA(0, 1), cA + hstep, voffA);
        if (wr == 1) PG8_BAR;
        PG8_WAIT_V(2); PG8_BAR;
        PG8_STAGE(PG8_SB(1, 0), cB + kstep, voffB); PG8_STAGE(PG8_SA(1, 0), cA + kstep, voffA); PG8_STAGE(PG8_SB(1, 1), cB + hstep + kstep, voffB);
        PG8_WAIT_V(6); PG8_BAR;
    } else {
        PG8_STAGE(PG8_SB(0, 0), cB, voffB); PG8_STAGE(PG8_SA(0, 0), cA, voffA); PG8_STAGE(PG8_SB(0, 1), cB + hstep, voffB); PG8_STAGE(PG8_SA(0, 1), cA + hstep, voffA);
        if (wr == 1) PG8_BAR;
        PG8_WAIT_V(4); PG8_BAR;
        PG8_STAGE(PG8_SB(1, 0), cB + kstep, voffB); PG8_STAGE(PG8_SA(1, 0), cA + kstep, voffA); PG8_STAGE(PG8_SB(1, 1), cB + hstep + kstep, voffB);
        PG8_WAIT_V(6); PG8_BAR;
    }
    for (;;) {
        const bool has_next = S.next(ui + 1, nxt);
        const char* nA = has_next ? (const char*)g.A + (size_t)nxt.pm * tstep : cA; const char* nB = has_next ? (const char*)g.Bt + (size_t)nxt.pn * tstep : cB;
        for (int t = 0; t < nt; t += 2) {
            const bool last = (t == nt - 2);
            const char* a1 = cA + (size_t)(t + 1) * kstep;
            const char* a2 = last ? nA : cA + (size_t)(t + 2) * kstep; const char* b2 = last ? nB : cB + (size_t)(t + 2) * kstep;
            const char* a3 = a2 + kstep; const char* b3 = b2 + kstep;
            if (last && has_next) S.a_ready(nxt);
            if constexpr (SP2) {
            PG8_LDB(B0, 0, 0); PG8_LDB(B1, 0, 1); PG8_SCHED; PG8_LDA(At, 0, 0); PG8_STAGE(PG8_SA(1, 1), a1 + hstep, voffA);
            PG8_WAIT_V(8); PG8_WAIT_L(0); PG8_BAR; PG8_MMA(0, 0, At, B0); PG8_MMA(0, 1, At, B1); PG8_BAR; PG8_SCHED;
            PG8_LDA(At, 0, 1); PG8_STAGE(PG8_SB(0, 0), b2, voffB); PG8_STAGE(PG8_SB(0, 1), b2 + hstep, voffB); PG8_STAGE(PG8_SA(0, 0), a2, voffA);
            PG8_WAIT_V(8); PG8_WAIT_L(0); PG8_BAR; PG8_MMA(1, 0, At, B0); PG8_MMA(1, 1, At, B1); PG8_BAR; PG8_SCHED;
            PG8_LDB(B0, 1, 0); PG8_LDB(B1, 1, 1); PG8_SCHED; PG8_LDA(At, 1, 0); PG8_STAGE(PG8_SA(0, 1), a2 + hstep, voffA);
            PG8_WAIT_V(8); PG8_WAIT_L(0); PG8_BAR; PG8_MMA(0, 0, At, B0); PG8_MMA(0, 1, At, B1); PG8_BAR; PG8_SCHED;
            PG8_LDA(At, 1, 1); PG8_STAGE(PG8_SB(1, 0), b3, voffB); PG8_STAGE(PG8_SB(1, 1), b3 + hstep, voffB); PG8_STAGE(PG8_SA(1, 0), a3, voffA);
            PG8_WAIT_V(8); PG8_WAIT_L(0); PG8_BAR; PG8_MMA(1, 0, At, B0); PG8_MMA(1, 1, At, B1); PG8_BAR; PG8_SCHED;
            } else {
            PG8_LDB(B0, 0, 0); PG8_SCHED; PG8_LDA(At, 0, 0); PG8_STAGE(PG8_SA(1, 1), a1 + hstep, voffA);
            PG8_WAIT_L(8); PG8_BAR; PG8_WAIT_L(0); PG8_MMA(0, 0, At, B0); PG8_BAR; PG8_SCHED;
            PG8_LDB(B1, 0, 1); PG8_STAGE(PG8_SB(0, 0), b2, voffB);
            PG8_BAR; PG8_WAIT_L(0); PG8_MMA(0, 1, At, B1); PG8_BAR;
            PG8_LDA(At, 0, 1); PG8_STAGE(PG8_SA(0, 0), a2, voffA);
            PG8_BAR; PG8_WAIT_L(0); PG8_MMA(1, 0, At, B0); PG8_BAR; PG8_SCHED;
            PG8_STAGE(PG8_SB(0, 1), b2 + hstep, voffB);
            PG8_WAIT_V(6); PG8_BAR; PG8_MMA(1, 1, At, B1); PG8_BAR;
            PG8_LDB(B0, 1, 0); PG8_SCHED; PG8_LDA(At, 1, 0); PG8_STAGE(PG8_SA(0, 1), a2 + hstep, voffA);
            PG8_WAIT_L(8); PG8_BAR; PG8_WAIT_L(0); PG8_MMA(0, 0, At, B0); PG8_BAR; PG8_SCHED;
            PG8_LDB(B1, 1, 1); PG8_STAGE(PG8_SB(1, 0), b3, voffB);
            PG8_BAR; PG8_WAIT_L(0); PG8_MMA(0, 1, At, B1); PG8_BAR;
            PG8_LDA(At, 1, 1); PG8_STAGE(PG8_SA(1, 0), a3, voffA);
            PG8_BAR; PG8_WAIT_L(0); PG8_MMA(1, 0, At, B0); PG8_BAR; PG8_SCHED;
            PG8_STAGE(PG8_SB(1, 1), b3 + hstep, voffB);
            PG8_WAIT_V(6); PG8_BAR; PG8_MMA(1, 1, At, B1); PG8_BAR;
            }
        }
        if constexpr (ALIGN_EPI) { if (wr == 0) PG8_BAR; }
        if constexpr (!Epi::AFTER_DRAIN) { E(acc, cur, wr, wc, fr, fq); S.done(cur); }
        if (!has_next) break;
#pragma unroll
        for (int a = 0; a < 2; ++a)
#pragma unroll
            for (int b = 0; b < 2; ++b)
#pragma unroll
                for (int m = 0; m < 4; ++m)
#pragma unroll
                    for (int n = 0; n < 2; ++n) acc[a][b][m][n] = (f32x4){0.f, 0.f, 0.f, 0.f};
        cur = nxt; cA = nA; cB = nB; ++ui;
        if constexpr (ALIGN_EPI) { if (wr == 1) PG8_BAR; }
    }
    PG8_WAIT_V(0);
    if constexpr (!ALIGN_EPI) { if (wr == 0) PG8_BAR; }
    PG8_BAR;
    if constexpr (Epi::AFTER_DRAIN) { E.fused(acc, cur, wr, wc, fr, fq, lds, wid, lane); S.done(cur); }
#undef PG8_SA
#undef PG8_SB
#undef PG8_STAGE
#undef PG8_LDA
#undef PG8_LDB
#undef PG8_MMA
#undef PG8_WAIT_V
#undef PG8_WAIT_L
#undef PG8_BAR
#undef PG8_SCHED
}
}

#define LAS __attribute__((address_space(3)))
template <class Epi> __global__ void __launch_bounds__(512, 2) k_gemm_fast(pg8::Gemm g, Epi E) {
    extern __shared__ __attribute__((aligned(16))) unsigned char lds[];
    pg8::StaticOrder S; S.init(g.M, g.N, (int)gridDim.x, (int)blockIdx.x);
    pg8::gemm_phase<Epi, pg8::StaticOrder, true, true>((LAS unsigned char*)lds, g, S, E, (int)threadIdx.x);
}

template <class Epi>
__global__ void __launch_bounds__(256) k_gemm_naive(const bf16_t* A, const bf16_t* Bt, int N, int K, Epi epi) {
    __shared__ float As[64][33], Bs[64][33];
    const int tid = threadIdx.x, tx = tid & 15, ty = tid >> 4;
    const int nbn = N / 64; const int bm = blockIdx.x / nbn, bn = blockIdx.x % nbn;
    float acc[4][4] = {};
    const int lr = tid >> 2, lc = (tid & 3) * 8;
    for (int k0 = 0; k0 < K; k0 += 32) {
        const u32x4 av = *(const u32x4*)(A + (size_t)(bm * 64 + lr) * K + k0 + lc);
        const u32x4 bv = *(const u32x4*)(Bt + (size_t)(bn * 64 + lr) * K + k0 + lc);
        __syncthreads();
#pragma unroll
        for (int j = 0; j < 4; ++j) { As[lr][lc + 2 * j] = __uint_as_float(av[j] << 16); As[lr][lc + 2 * j + 1] = __uint_as_float(av[j] & 0xffff0000u);
                                      Bs[lr][lc + 2 * j] = __uint_as_float(bv[j] << 16); Bs[lr][lc + 2 * j + 1] = __uint_as_float(bv[j] & 0xffff0000u); }
        __syncthreads();
#pragma unroll 8
        for (int kk = 0; kk < 32; ++kk) { float a[4], b[4];
#pragma unroll
            for (int i = 0; i < 4; ++i) { a[i] = As[ty * 4 + i][kk]; b[i] = Bs[tx * 4 + i][kk]; }
#pragma unroll
            for (int i = 0; i < 4; ++i)
#pragma unroll
                for (int j = 0; j < 4; ++j) acc[i][j] += a[i] * b[j]; }
    }
#pragma unroll
    for (int i = 0; i < 4; ++i)
#pragma unroll
        for (int j = 0; j < 4; ++j) epi(bm * 64 + ty * 4 + i, bn * 64 + tx * 4 + j, acc[i][j]);
}

template <bool F32>
__global__ void __launch_bounds__(256) k_rowss(const void* src, int ld, int ncols, float* dst, int dst_ld, int nslots) {
    const int lane = threadIdx.x & 63, row = blockIdx.x * 4 + (threadIdx.x >> 6);
    float s = 0.f;
    for (int c = lane; c < ncols; c += 64) { const float v = F32 ? ((const float*)src)[(size_t)row * ld + c] : bf2f(((const bf16_t*)src)[(size_t)row * ld + c]); s += v * v; }
    s = wave_sum(s);
    if (lane < nslots) dst[(size_t)row * dst_ld + lane] = lane == 0 ? s : 0.f;
}

__global__ void __launch_bounds__(256) k_rope(bf16_t* buf, int nh, const float* rc, const float* rs) {
    const int idx = blockIdx.x * 256 + threadIdx.x; const int per_row = nh * 32; if (idx >= M * per_row) return;
    const int row = idx / per_row, t = idx % per_row, h = t >> 5, i = t & 31, pos = row % SEQ;
    bf16_t* p = buf + (size_t)row * nh * 64 + h * 64; const float x1 = bf2f(p[i]), x2 = bf2f(p[32 + i]); const float cs = rc[pos * 32 + i], sn = rs[pos * 32 + i];
    p[i] = f2bf(x1 * cs - x2 * sn); p[32 + i] = f2bf(x1 * sn + x2 * cs);
}

template <int D> DI float dot_row(const float* q, const bf16_t* k) {
    float s = 0.f;
#pragma unroll
    for (int d = 0; d < D; d += 8) { const u32x4 v = *(const u32x4*)(k + d);
#pragma unroll
        for (int j = 0; j < 4; ++j) { s += q[d + 2 * j] * __uint_as_float(v[j] << 16); s += q[d + 2 * j + 1] * __uint_as_float(v[j] & 0xffff0000u); } }
    return s;
}

__global__ void __launch_bounds__(256) k_mla_naive(Ctx c) {
    __shared__ float qs[4][192];
    const int lane = threadIdx.x & 63, w = threadIdx.x >> 6; const int gq = blockIdx.x * 4 + w;
    const int t = gq % SEQ, bh = gq / SEQ, h = bh % 8, b = bh / 8; const size_t row = (size_t)b * SEQ + t;
    unsigned char* ws = c.ws;
    const bf16_t *QN = (const bf16_t*)(ws + WS_QN), *QR = (const bf16_t*)(ws + WS_QR), *KN = (const bf16_t*)(ws + WS_KN), *KR = (const bf16_t*)(ws + WS_KR), *VA = (const bf16_t*)(ws + WS_VA), *SG = (const bf16_t*)(ws + WS_SG);
    for (int d = lane; d < 192; d += 64) qs[w][d] = d < 128 ? bf2f(QN[row * 1024 + h * 128 + d]) : bf2f(QR[row * 512 + h * 64 + d - 128]);
    __syncthreads();
    float m = -INFINITY, l = 0.f, o0 = 0.f, o1 = 0.f;
    for (int j0 = 0; j0 <= t; j0 += 64) {
        const int j = j0 + lane; const bool valid = j <= t; const size_t krow = (size_t)b * SEQ + (valid ? j : t);
        float s = dot_row<128>(qs[w], KN + krow * 1024 + h * 128) + dot_row<64>(qs[w] + 128, KR + krow * 64);
        if (!valid) s = -INFINITY;
        const float mn = fmaxf(m, wave_max(s)); const float alpha = exp2f(m - mn); const float p = valid ? exp2f(s - mn) : 0.f;
        l = l * alpha + wave_sum(p); o0 *= alpha; o1 *= alpha; m = mn;
        const int nj = min(64, t - j0 + 1);
        for (int jj = 0; jj < nj; ++jj) { const float pj = __shfl(p, jj); const bf16_t* vr = VA + ((size_t)b * SEQ + j0 + jj) * 1024 + h * 128; o0 += pj * bf2f(vr[lane]); o1 += pj * bf2f(vr[lane + 64]); }
    }
    bf16_t* MIX = (bf16_t*)(ws + WS_MIX); const float il = 1.0f / l;
    MIX[row * 2048 + h * 128 + lane] = f2bf(o0 * il * bf2f(SG[row * 2048 + h * 128 + lane]));
    MIX[row * 2048 + h * 128 + lane + 64] = f2bf(o1 * il * bf2f(SG[row * 2048 + h * 128 + lane + 64]));
}

__global__ void __launch_bounds__(256) k_dil_naive(Ctx c) {
    __shared__ float qs[4][128];
    const int lane = threadIdx.x & 63, w = threadIdx.x >> 6; const int gq = blockIdx.x * 4 + w;
    const int t = gq % SEQ, bh = gq / SEQ, h = bh % 8, b = bh / 8; const size_t row = (size_t)b * SEQ + t;
    unsigned char* ws = c.ws;
    const bf16_t *QB = (const bf16_t*)(ws + WS_QB), *KB = (const bf16_t*)(ws + WS_KB), *VB = (const bf16_t*)(ws + WS_VB);
    const float* bn = (const float*)(ws + WS_BIASN);
    for (int d = lane; d < 128; d += 64) qs[w][d] = bf2f(QB[row * 1024 + h * 128 + d]);
    __syncthreads();
    for (int p = 0; p < 3; ++p) { const int dil = p == 0 ? 1 : p == 1 ? 4 : 16;
        float m = -INFINITY, l = 0.f, o0 = 0.f, o1 = 0.f;
        for (int r0 = 0; r0 < 192; r0 += 64) {
            const int rel = r0 + lane; const int j = t - rel * dil; const bool valid = rel <= 128 && j >= 0; const size_t krow = (size_t)b * SEQ + (valid ? j : t);
            float s = dot_row<128>(qs[w], KB + krow * 1024 + h * 128) + bn[(p * 8 + h) * 132 + (valid ? rel : 0)];
            if (!valid) s = -INFINITY;
            const float mn = fmaxf(m, wave_max(s));
            const float alpha = exp2f(m - mn); const float pp = valid ? exp2f(s - mn) : 0.f;
            l = l * alpha + wave_sum(pp); o0 *= alpha; o1 *= alpha; m = mn;
            for (int jj = 0; jj < 64; ++jj) { const float pj = __shfl(pp, jj); if (pj != 0.f) { const int jr = t - (r0 + jj) * dil; const bf16_t* vr = VB + ((size_t)b * SEQ + jr) * 1024 + h * 128; o0 += pj * bf2f(vr[lane]); o1 += pj * bf2f(vr[lane + 64]); } }
        }
        bf16_t* OP = (bf16_t*)(ws + (p == 0 ? WS_OP0 : p == 1 ? WS_OP1 : WS_OP2)); const float il = 1.0f / l;
        OP[row * 1024 + h * 128 + lane] = f2bf(o0 * il); OP[row * 1024 + h * 128 + lane + 64] = f2bf(o1 * il);
        if (lane == 0) ((float*)(ws + WS_LSE))[((size_t)p * M + row) * 8 + h] = m + log2f(l);
    }
}

DI void dil_merge_item(unsigned char* ws, int row, int col) {
    const int h = col >> 7; const float* lse = (const float*)(ws + WS_LSE);
    const float l0 = lse[((size_t)0 * M + row) * 8 + h], l1 = lse[((size_t)1 * M + row) * 8 + h], l2 = lse[((size_t)2 * M + row) * 8 + h];
    const float mx = fmaxf(l0, fmaxf(l1, l2)); float w0 = exp2f(l0 - mx), w1 = exp2f(l1 - mx), w2 = exp2f(l2 - mx); const float inv = 1.0f / (w0 + w1 + w2); w0 *= inv; w1 *= inv; w2 *= inv;
    const u32x4 a0 = *(const u32x4*)((const bf16_t*)(ws + WS_OP0) + (size_t)row * 1024 + col), a1 = *(const u32x4*)((const bf16_t*)(ws + WS_OP1) + (size_t)row * 1024 + col),
                a2 = *(const u32x4*)((const bf16_t*)(ws + WS_OP2) + (size_t)row * 1024 + col), sg = *(const u32x4*)((const bf16_t*)(ws + WS_SG) + (size_t)row * 2048 + 1024 + col);
    u32x4 o;
#pragma unroll
    for (int j = 0; j < 4; ++j) {
        const float lo = (w0 * __uint_as_float(a0[j] << 16) + w1 * __uint_as_float(a1[j] << 16) + w2 * __uint_as_float(a2[j] << 16)) * __uint_as_float(sg[j] << 16);
        const float hi = (w0 * __uint_as_float(a0[j] & 0xffff0000u) + w1 * __uint_as_float(a1[j] & 0xffff0000u) + w2 * __uint_as_float(a2[j] & 0xffff0000u)) * __uint_as_float(sg[j] & 0xffff0000u);
        o[j] = (unsigned)f2bf(lo) | ((unsigned)f2bf(hi) << 16); }
    *(u32x4*)((bf16_t*)(ws + WS_MIX) + (size_t)row * 2048 + 1024 + col) = o;
}
__global__ void __launch_bounds__(128) k_dil_merge(Ctx c) { dil_merge_item(c.ws, blockIdx.x, threadIdx.x * 8); }

__global__ void __launch_bounds__(256) k_sb_naive(Ctx c) {
    __shared__ float qs[4][128];
    const int lane = threadIdx.x & 63, w = threadIdx.x >> 6; const int gq = blockIdx.x * 4 + w;
    const int t = gq % SEQ, bh = gq / SEQ, h = bh % 16, b = bh / 16; const size_t row = (size_t)b * SEQ + t;
    unsigned char* ws = c.ws;
    const bf16_t *Q2 = (const bf16_t*)(ws + WS_Q2), *K2 = (const bf16_t*)(ws + WS_K2), *V2 = (const bf16_t*)(ws + WS_V2), *SG2 = (const bf16_t*)(ws + WS_SG2);
    for (int d = lane; d < 128; d += 64) qs[w][d] = bf2f(Q2[row * 2048 + h * 128 + d]);
    __syncthreads();
    float carry = 0.f, o0 = 0.f, o1 = 0.f;
    for (int c0 = 0; c0 < t; c0 += 64) {
        const int j = t - 1 - c0 - lane; const bool valid = j >= 0; const size_t krow = (size_t)b * SEQ + (valid ? j : 0);
        const float z = dot_row<128>(qs[w], K2 + krow * 2048 + h * 128);
        const float sp = fmaxf(z, 0.f) + log2f(1.0f + exp2f(-fabsf(z)));
        const float L = valid ? -sp : 0.f;
        float incl = L;
#pragma unroll
        for (int o = 1; o < 64; o <<= 1) { const float v = __shfl_up(incl, o); if (lane >= o) incl += v; }
        const float between = carry + (incl - L);
        const float a = valid ? exp2f(z - sp + between) : 0.f;
        carry += __shfl(incl, 63);
        const int nj = min(64, t - c0);
        for (int jj = 0; jj < nj; ++jj) { const float aj = __shfl(a, jj); const bf16_t* vr = V2 + ((size_t)b * SEQ + t - 1 - c0 - jj) * 2048 + h * 128; o0 += aj * bf2f(vr[lane]); o1 += aj * bf2f(vr[lane + 64]); }
    }
    bf16_t* MIX2 = (bf16_t*)(ws + WS_MIX2);
    MIX2[row * 2048 + h * 128 + lane] = f2bf(o0 * bf2f(SG2[row * 2048 + h * 128 + lane]));
    MIX2[row * 2048 + h * 128 + lane + 64] = f2bf(o1 * bf2f(SG2[row * 2048 + h * 128 + lane + 64]));
}

#ifndef MLA_PIPE
#define MLA_PIPE 1
#endif
namespace att {
typedef short bf16x8 __attribute__((ext_vector_type(8)));
typedef short s16x4 __attribute__((ext_vector_type(4)));
typedef short v4i16_t __attribute__((ext_vector_type(4)));
typedef float f32x16 __attribute__((ext_vector_type(16)));
typedef _Float16 f16x8 __attribute__((ext_vector_type(8)));
typedef _Float16 f16x2 __attribute__((ext_vector_type(2)));
typedef float f32x2_t __attribute__((ext_vector_type(2))); typedef __bf16 bf16x2_t __attribute__((ext_vector_type(2)));
typedef LAS const unsigned char* lcp;
#define MFMA_BF16(a, b, c) __builtin_amdgcn_mfma_f32_32x32x16_bf16((a), (b), (c), 0, 0, 0)
#define MFMA_F16(a, b, c) __builtin_amdgcn_mfma_f32_32x32x16_f16((a), (b), (c), 0, 0, 0)
#define SBAR() __builtin_amdgcn_sched_barrier(0)
DI int crow(int g, int h) { return (g & 3) + 8 * (g >> 2) + 4 * h; }
DI unsigned off_b(unsigned row, unsigned ch) { return 256u * row + 16u * (ch ^ (((row & 3) << 2) | ((row >> 2) & 3))); }
DI unsigned cvtpk(float lo, float hi) { f32x2_t v = {lo, hi}; bf16x2_t b = __builtin_convertvector(v, bf16x2_t); return __builtin_bit_cast(unsigned, b); }
DI unsigned cvtpk_h(float lo, float hi) { f32x2_t v = {lo, hi}; f16x2 b = __builtin_convertvector(v, f16x2); return __builtin_bit_cast(unsigned, b); }
DI bf16x8 pack_bf(const f32x16& x, int s) { u32x4 p; p.x = cvtpk(x[8 * s], x[8 * s + 1]); p.y = cvtpk(x[8 * s + 2], x[8 * s + 3]); p.z = cvtpk(x[8 * s + 4], x[8 * s + 5]); p.w = cvtpk(x[8 * s + 6], x[8 * s + 7]); return __builtin_bit_cast(bf16x8, p); }
DI f16x8 pack_h(const f32x16& x, int s) { u32x4 p; p.x = cvtpk_h(x[8 * s], x[8 * s + 1]); p.y = cvtpk_h(x[8 * s + 2], x[8 * s + 3]); p.z = cvtpk_h(x[8 * s + 4], x[8 * s + 5]); p.w = cvtpk_h(x[8 * s + 6], x[8 * s + 7]); return __builtin_bit_cast(f16x8, p); }
DI s16x4 vtr(lcp p) { return __builtin_bit_cast(s16x4, __builtin_amdgcn_ds_read_tr16_b64_v4i16((LAS v4i16_t*)p)); }
DI float swap_max(float m) { auto rr = __builtin_amdgcn_permlane32_swap(__float_as_uint(m), __float_as_uint(m), false, false); return fmaxf(__uint_as_float(rr[0]), __uint_as_float(rr[1])); }
DI float swap_sum(float m) { auto rr = __builtin_amdgcn_permlane32_swap(__float_as_uint(m), __float_as_uint(m), false, false); return __uint_as_float(rr[0]) + __uint_as_float(rr[1]); }
DI float bcast_lo(float m) { auto rr = __builtin_amdgcn_permlane32_swap(__float_as_uint(m), __float_as_uint(m), false, false); return __uint_as_float(rr[0]); }
DI __amdgpu_buffer_rsrc_t mk_rsrc(const void* p, unsigned bytes) { return __builtin_amdgcn_make_buffer_rsrc((void*)p, 0, bytes, 0x00020000); }
DI u32x4 bload(__amdgpu_buffer_rsrc_t rs, unsigned voff, unsigned soff) { return __builtin_amdgcn_raw_buffer_load_b128(rs, voff, soff, 0); }
struct VAddr { unsigned a[2][4]; };
DI VAddr make_vaddr(int lane) { VAddr v; const unsigned hh = lane >> 5, blk = (lane >> 4) & 1, qq = (lane & 15) >> 2, p = lane & 3;
#pragma unroll
    for (int t = 0; t < 2; ++t)
#pragma unroll
        for (int d0 = 0; d0 < 4; ++d0) v.a[t][d0] = off_b(8 * t + 4 * hh + qq, 4 * d0 + 2 * blk + (p >> 1)) + 8 * (p & 1);
    return v; }
DI bf16x8 vfrag(lcp img, int s, int d0, const VAddr& va) {
    const s16x4 lo = vtr(img + 4096 * s + va.a[0][d0]);
    const s16x4 hi = vtr(img + 4096 * s + va.a[1][d0]);
    return (bf16x8){lo[0], lo[1], lo[2], lo[3], hi[0], hi[1], hi[2], hi[3]};
}
DI void softmax_tile(f32x16& s0, f32x16& s1, f32x16 (&o)[4], float& mrun, float& lrun) {
    float mt = fmaxf(s0[0], s1[0]);
#pragma unroll
    for (int g = 1; g < 16; ++g) mt = fmaxf(mt, fmaxf(s0[g], s1[g]));
    mt = swap_max(mt);
    const float mn = fmaxf(mrun, mt), alpha = __builtin_amdgcn_exp2f(mrun - mn); mrun = mn;
    float ps = 0.f;
#pragma unroll
    for (int g = 0; g < 16; ++g) { s0[g] = __builtin_amdgcn_exp2f(s0[g] - mn); s1[g] = __builtin_amdgcn_exp2f(s1[g] - mn); ps += s0[g] + s1[g]; }
    lrun = lrun * alpha + ps;
#pragma unroll
    for (int d0 = 0; d0 < 4; ++d0)
#pragma unroll
        for (int g = 0; g < 16; ++g) o[d0][g] *= alpha;
}

constexpr int MLA_KSTR = 400, MLA_KBUF = 64 * MLA_KSTR, VBUF = 16384, MLA_LDS_V = 2 * MLA_KBUF, MLA_LDS_BYTES = 2 * MLA_KBUF + 2 * VBUF;
template <bool MASKED>
DI void mla_tile(lcp kb, lcp vb, const bf16x8 (&qf)[12], f32x16 (&o)[4], float& mrun, float& lrun, const VAddr& va, int qrel, int hh) {
    f32x16 s0, s1;
#pragma unroll
    for (int g = 0; g < 16; ++g) { s0[g] = 0.f; s1[g] = 0.f; }
    bf16x8 f0a = *(LAS const bf16x8*)kb, f0b = *(LAS const bf16x8*)(kb + 32 * MLA_KSTR), f1a = *(LAS const bf16x8*)(kb + 32), f1b = *(LAS const bf16x8*)(kb + 32 * MLA_KSTR + 32), f2a, f2b;
#pragma unroll
    for (int d0 = 0; d0 < 12; ++d0) {
        if (d0 + 2 < 12) { const bf16x8 n0 = *(LAS const bf16x8*)(kb + (d0 + 2) * 32), n1 = *(LAS const bf16x8*)(kb + 32 * MLA_KSTR + (d0 + 2) * 32);
            if ((d0 + 2) % 3 == 0) { f0a = n0; f0b = n1; } else if ((d0 + 2) % 3 == 1) { f1a = n0; f1b = n1; } else { f2a = n0; f2b = n1; } }
        SBAR();
        s0 = MFMA_BF16(d0 % 3 == 0 ? f0a : d0 % 3 == 1 ? f1a : f2a, qf[d0], s0); s1 = MFMA_BF16(d0 % 3 == 0 ? f0b : d0 % 3 == 1 ? f1b : f2b, qf[d0], s1);
        SBAR();
    }
    if (MASKED) {
#pragma unroll
        for (int g = 0; g < 16; ++g) { const int kv = crow(g, 0); if (kv > qrel - 4 * hh) s0[g] = -INFINITY; if (kv + 32 > qrel - 4 * hh) s1[g] = -INFINITY; } }
    float mt = fmaxf(s0[0], s1[0]);
#pragma unroll
    for (int g = 1; g < 16; ++g) mt = fmaxf(mt, fmaxf(s0[g], s1[g]));
    mt = swap_max(mt);
    if (__builtin_amdgcn_ballot_w64(mt > mrun) != 0ull) {
        const float mn = fmaxf(mrun, mt), alpha = __builtin_amdgcn_exp2f(mrun - mn); mrun = mn; lrun *= alpha;
#pragma unroll
        for (int d0 = 0; d0 < 4; ++d0)
#pragma unroll
            for (int g = 0; g < 16; ++g) o[d0][g] *= alpha;
    }
    float ps = 0.f;
#pragma unroll
    for (int g = 0; g < 16; ++g) { s0[g] = __builtin_amdgcn_exp2f(s0[g] - mrun); s1[g] = __builtin_amdgcn_exp2f(s1[g] - mrun); ps += s0[g] + s1[g]; }
    lrun += ps;
    bf16x8 pf[4]; pf[0] = pack_bf(s0, 0); pf[1] = pack_bf(s0, 1); pf[2] = pack_bf(s1, 0); pf[3] = pack_bf(s1, 1);
    bf16x8 v0 = vfrag(vb, 0, 0, va), v1 = vfrag(vb, 0, 1, va), v2;
#pragma unroll
    for (int j = 0; j < 16; ++j) {
        if (j + 2 < 16) { const int ks = (j + 2) >> 2, d0 = (j + 2) & 3; const bf16x8 nx = vfrag(vb + (ks >> 1) * 8192, ks & 1, d0, va);
            if ((j + 2) % 3 == 0) v0 = nx; else if ((j + 2) % 3 == 1) v1 = nx; else v2 = nx; }
        SBAR();
        o[j & 3] = MFMA_BF16(j % 3 == 0 ? v0 : j % 3 == 1 ? v1 : v2, pf[j >> 2], o[j & 3]);
        SBAR();
    }
}
DI void mla_unit(LAS unsigned char* lds, unsigned char* ws, int b, int h, int qb, const int tid_in) {
    int tid = tid_in; asm volatile("" : "+v"(tid));
    const int lane = tid & 63, wid = __builtin_amdgcn_readfirstlane(tid >> 6), r = lane & 31, hh = lane >> 5;
    const bf16_t *QN = (const bf16_t*)(ws + WS_QN), *QR = (const bf16_t*)(ws + WS_QR), *KN = (const bf16_t*)(ws + WS_KN), *KR = (const bf16_t*)(ws + WS_KR), *VA = (const bf16_t*)(ws + WS_VA), *SG = (const bf16_t*)(ws + WS_SG);
    bf16_t* MIX = (bf16_t*)(ws + WS_MIX);
    const int q0 = qb * 256, NT = 4 * (qb + 1), tmax = (q0 + 32 * wid) >> 6; const size_t rowbase = (size_t)b * SEQ;
    bf16x8 qf[12];
    { const size_t qrow = rowbase + q0 + 32 * wid + r;
#pragma unroll
      for (int d0 = 0; d0 < 8; ++d0) qf[d0] = *(const bf16x8*)(QN + qrow * 1024 + h * 128 + d0 * 16 + hh * 8);
#pragma unroll
      for (int d0 = 0; d0 < 4; ++d0) qf[8 + d0] = *(const bf16x8*)(QR + qrow * 512 + h * 64 + d0 * 16 + hh * 8); }
    f32x16 o[4];
#pragma unroll
    for (int d0 = 0; d0 < 4; ++d0)
#pragma unroll
        for (int g = 0; g < 16; ++g) o[d0][g] = 0.f;
    float mrun = -INFINITY, lrun = 0.f;
    u32x4 kreg[3], vreg[2];
    const VAddr va = make_vaddr(lane);
    const __amdgpu_buffer_rsrc_t rKN = mk_rsrc(KN, M * 1024 * 2), rKR = mk_rsrc(KR, M * 64 * 2), rVA = mk_rsrc(VA, M * 1024 * 2);
    const unsigned vo0 = (tid >> 4) * 2048 + (tid & 15) * 16, vo1 = vo0 + 32 * 2048, vor = (tid >> 3) * 128 + (tid & 7) * 16;
    const unsigned so_n = ((unsigned)rowbase * 1024 + h * 128) * 2, so_r = (unsigned)rowbase * 64 * 2;
    const unsigned lk0 = (tid >> 4) * MLA_KSTR + (tid & 15) * 16, lk1 = lk0 + 32 * MLA_KSTR, lkr = (tid >> 3) * MLA_KSTR + 256 + (tid & 7) * 16;
    const unsigned lv0 = off_b((tid >> 4) & 31, tid & 15), lv1 = lv0 + 8192;
    const unsigned kfo = r * MLA_KSTR + hh * 16;
#define MLA_LOAD(t) do { const unsigned tn = so_n + (unsigned)(t) * (64 * 2048), tr_ = so_r + (unsigned)(t) * (64 * 128); \
        kreg[0] = bload(rKN, vo0, tn); kreg[1] = bload(rKN, vo1, tn); kreg[2] = bload(rKR, vor, tr_); vreg[0] = bload(rVA, vo0, tn); vreg[1] = bload(rVA, vo1, tn); } while (0)
#define MLA_STORE(buf) do { LAS unsigned char* kd = lds + (buf) * MLA_KBUF; LAS unsigned char* vd = lds + MLA_LDS_V + (buf) * VBUF; \
        *(LAS u32x4*)(kd + lk0) = kreg[0]; *(LAS u32x4*)(kd + lk1) = kreg[1]; *(LAS u32x4*)(kd + lkr) = kreg[2]; *(LAS u32x4*)(vd + lv0) = vreg[0]; *(LAS u32x4*)(vd + lv1) = vreg[1]; } while (0)
    MLA_LOAD(0); MLA_STORE(0); __builtin_amdgcn_s_waitcnt(0x0F70);   __syncthreads();
#define MLA_INTERVAL(MODE) { const int buf = t & 1; \
        if (t + 1 < NT) MLA_LOAD(t + 1); \
        if (MODE == 0) mla_tile<false>(lds + buf * MLA_KBUF + kfo, lds + MLA_LDS_V + buf * VBUF, qf, o, mrun, lrun, va, 0, hh); \
        if (MODE == 1) mla_tile<true>(lds + buf * MLA_KBUF + kfo, lds + MLA_LDS_V + buf * VBUF, qf, o, mrun, lrun, va, q0 + 32 * wid + r - 64 * t, hh); \
        if (t + 1 < NT) MLA_STORE(buf ^ 1); \
        __syncthreads(); }
    int t = 0;
    for (; t < tmax; ++t) MLA_INTERVAL(0)
    MLA_INTERVAL(1)
    for (++t; t < NT; ++t) MLA_INTERVAL(2)
#undef MLA_INTERVAL
#undef MLA_LOAD
#undef MLA_STORE
    const float inv = 1.0f / swap_sum(lrun);
    int t4 = tid; asm volatile("" : "+v"(t4)); const size_t qrow = rowbase + q0 + 32 * wid + (t4 & 31); const int hh2 = (t4 >> 5) & 1;
#pragma unroll
    for (int d0 = 0; d0 < 4; ++d0)
#pragma unroll
        for (int gg = 0; gg < 4; ++gg) { const size_t off = qrow * 2048 + h * 128 + 32 * d0 + 8 * gg + 4 * hh2;
            const unsigned long long sg = *(const unsigned long long*)(SG + off);
            const float g0 = __uint_as_float((unsigned)(sg << 16)), g1 = __uint_as_float((unsigned)sg & 0xffff0000u), g2 = __uint_as_float((unsigned)(sg >> 32) << 16), g3 = __uint_as_float((unsigned)(sg >> 32) & 0xffff0000u);
            const unsigned lo = cvtpk(o[d0][4 * gg] * inv * g0, o[d0][4 * gg + 1] * inv * g1), hi = cvtpk(o[d0][4 * gg + 2] * inv * g2, o[d0][4 * gg + 3] * inv * g3);
            *(unsigned long long*)(MIX + off) = (unsigned long long)lo | ((unsigned long long)hi << 32); }
}
DI float vmax3_s(float a, float b, float c) { float r; asm("v_max3_f32 %0, %1, %2, %3" : "=v"(r) : "v"(a), "v"(b), "v"(c)); return r; }
constexpr int M2_KBUF = 64 * 384, M2_LDS_V = 3 * M2_KBUF, M2_LDS_BYTES = M2_LDS_V + 3 * VBUF;
struct M2State { f32x16 o[4]; float mrun, lrun; };
template <int KIMM, int VIMM>
DI void mla2_iter(f32x16& zin, f32x16& zout, M2State& st, const u32x4& pi0, const u32x4& pi1, u32x4& po0, u32x4& po1, const bf16x8 (&qf)[12], const unsigned (&koff)[4], const unsigned (&voff)[2][4],
                  const bool masked, const int qrh) {
#define M2_KF(d0) (*(LAS const bf16x8*)(koff[(d0) & 3] + (unsigned)(KIMM + 128 * ((d0) >> 2))))
#define M2_VF(t, j) vtr((lcp)(voff[t][(j) & 3] + (unsigned)(VIMM + 4096 * ((j) >> 2))))
    if (masked) {
        asm volatile("" ::: "memory");
#pragma unroll
        for (int g = 0; g < 16; ++g) if (crow(g, 0) > qrh) zin[g] = -INFINITY;
    }
    bf16x8 kfA = M2_KF(0), kfB; s16x4 la, ha, lb, hb;
    float mt = 0.f, mnew = 0.f, alpha = 1.f, ps = 0.f; bool grow = false; float pe[16];
    SBAR();
#pragma unroll
    for (int i = 0; i < 20; ++i) {
        const int c5 = i % 5, blk5 = i / 5; const bool isP = (c5 == 2 || c5 == 4);
        const int qi = blk5 * 3 + (c5 < 2 ? c5 : 2), pj = blk5 * 2 + (c5 == 2 ? 0 : 1);
        if (isP) { const s16x4 lo = (pj & 1) ? lb : la, hi = (pj & 1) ? hb : ha; const bf16x8 vf = (bf16x8){lo[0], lo[1], lo[2], lo[3], hi[0], hi[1], hi[2], hi[3]};
            st.o[pj & 3] = MFMA_BF16(vf, __builtin_bit_cast(bf16x8, (pj >> 2) ? pi1 : pi0), st.o[pj & 3]); }
        else if (i == 0) { f32x16 zero_;
#pragma unroll
            for (int g = 0; g < 16; ++g) zero_[g] = 0.f;
            zout = MFMA_BF16(kfA, qf[0], zero_); }
        else zout = MFMA_BF16((qi & 1) ? kfB : kfA, qf[qi], zout);
        if (!isP && qi + 1 < 12) { const bf16x8 nx = M2_KF(qi + 1); if ((qi + 1) & 1) kfB = nx; else kfA = nx; }
        if (isP && pj + 1 < 8) { const s16x4 l_ = M2_VF(0, pj + 1), h_ = M2_VF(1, pj + 1); if ((pj + 1) & 1) { lb = l_; hb = h_; } else { la = l_; ha = h_; } }
        if (i == 0) { la = M2_VF(0, 0); ha = M2_VF(1, 0); }
        SBAR();
        if (i < 4) { float a = vmax3_s(zin[4 * i], zin[4 * i + 1], zin[4 * i + 2]); mt = i == 0 ? vmax3_s(a, zin[3], zin[3]) : vmax3_s(mt, a, zin[4 * i + 3]); asm volatile("" : "+v"(mt)); }
        if (i == 4) { mt = swap_max(mt); mnew = fmaxf(st.mrun, mt); alpha = __builtin_amdgcn_exp2f(st.mrun - mnew); grow = __builtin_amdgcn_ballot_w64(mt > st.mrun) != 0ull;
            st.mrun = mnew; st.lrun *= alpha; asm volatile("" : "+v"(mnew), "+v"(alpha)); }
        if (i >= 5 && i < 13) { const int g = 2 * (i - 5); float e0 = __builtin_amdgcn_exp2f(zin[g] - mnew), e1 = __builtin_amdgcn_exp2f(zin[g + 1] - mnew); ps += e0 + e1;
            asm volatile("" : "+v"(ps)); pe[g] = e0; pe[g + 1] = e1; }
        if (i >= 13 && i < 17) { const int w_ = i - 13; unsigned w0 = cvtpk(pe[4 * w_], pe[4 * w_ + 1]), w1 = cvtpk(pe[4 * w_ + 2], pe[4 * w_ + 3]); asm volatile("" : "+v"(w0), "+v"(w1));
            if (w_ < 2) { po0[2 * w_] = w0; po0[2 * w_ + 1] = w1; } else { po1[2 * (w_ - 2)] = w0; po1[2 * (w_ - 2) + 1] = w1; } }
        SBAR();
    }
    st.lrun += ps;
    if (grow) {
#pragma unroll
        for (int d0 = 0; d0 < 4; ++d0)
#pragma unroll
            for (int g = 0; g < 16; ++g) st.o[d0][g] *= alpha;
    }
#undef M2_KF
#undef M2_VF
}
DI void mla2_unit(LAS unsigned char* lds, unsigned char* ws, int b, int h, int qb, const int tid_in) {
    int tid = tid_in; asm volatile("" : "+v"(tid));
    const int lane = tid & 63, wid = __builtin_amdgcn_readfirstlane(tid >> 6), r = lane & 31, hh = lane >> 5;
    const bf16_t *QN = (const bf16_t*)(ws + WS_QN), *QR = (const bf16_t*)(ws + WS_QR), *KN = (const bf16_t*)(ws + WS_KN), *KR = (const bf16_t*)(ws + WS_KR), *VA = (const bf16_t*)(ws + WS_VA), *SG = (const bf16_t*)(ws + WS_SG);
    bf16_t* MIX = (bf16_t*)(ws + WS_MIX);
    const int q0 = qb * 256, NT = 4 * (qb + 1), tmax = (q0 + 32 * wid) >> 6; const size_t rowbase = (size_t)b * SEQ;
    bf16x8 qf[12];
    { const size_t qrow = rowbase + q0 + 32 * wid + r;
#pragma unroll
      for (int d0 = 0; d0 < 8; ++d0) qf[d0] = *(const bf16x8*)(QN + qrow * 1024 + h * 128 + d0 * 16 + hh * 8);
#pragma unroll
      for (int d0 = 0; d0 < 4; ++d0) qf[8 + d0] = *(const bf16x8*)(QR + qrow * 512 + h * 64 + d0 * 16 + hh * 8); }
    M2State st;
#pragma unroll
    for (int d0 = 0; d0 < 4; ++d0)
#pragma unroll
        for (int g = 0; g < 16; ++g) st.o[d0][g] = 0.f;
    st.mrun = -INFINITY; st.lrun = 0.f;
    unsigned koff[4], voff[2][4];
    { const unsigned blk = (lane >> 4) & 1, qq = (lane & 15) >> 2, p = lane & 3, f = (r >> 1) & 7;
      const unsigned kb_ = (unsigned)(size_t)lds + r * 384;
#pragma unroll
      for (int j = 0; j < 4; ++j) koff[j] = kb_ + 16 * ((2 * j + hh) ^ f);
      const unsigned vb0 = 256 * (4 * hh + qq) + 8 * (p & 1) + 16 * ((2 * blk + (p >> 1)) ^ hh), v0_ = (unsigned)(size_t)lds + M2_LDS_V + vb0, v1_ = (unsigned)(size_t)lds + M2_LDS_V + 2048 + (vb0 ^ 32);
#pragma unroll
      for (int d0 = 0; d0 < 4; ++d0) { voff[0][d0] = v0_ + ((64u * d0) ^ (64u * qq)); voff[1][d0] = v1_ + ((64u * d0) ^ (64u * qq)); } }
    const bf16_t* knb = KN + rowbase * 1024 + h * 128; const bf16_t* krb = KR + rowbase * 64; const bf16_t* vab = VA + rowbase * 1024 + h * 128;
    unsigned ksrc[3];
#pragma unroll
    for (int i_ = 0; i_ < 3; ++i_) { const int c_ = (3 * wid + i_) * 64 + lane, row_ = c_ / 24, ch_ = (c_ % 24) ^ ((row_ >> 1) & 7);
        ksrc[i_] = ch_ < 16 ? (unsigned)(row_ * 1024 + ch_ * 8) : (0x80000000u | (unsigned)(row_ * 64 + (ch_ - 16) * 8)); }
#define M2_DMAK(t, slot) do { _Pragma("unroll") for (int i_ = 0; i_ < 3; ++i_) { const unsigned o_ = ksrc[i_] & 0x7fffffffu; \
            const bf16_t* src_ = (ksrc[i_] >> 31) ? krb + (size_t)(t) * (64 * 64) + o_ : knb + (size_t)(t) * (64 * 1024) + o_; \
            __builtin_amdgcn_global_load_lds((const unsigned*)src_, (LAS unsigned*)(lds + (slot) * M2_KBUF + (3 * wid + i_) * 1024), 16, 0, 0); } } while (0)
#define M2_DMAV(t, slot) do { int t2_ = tid; asm volatile("" : "+v"(t2_)); const int ln_ = t2_ & 63, drow_ = 8 * wid + (ln_ >> 4), c15_ = ln_ & 15; \
        const unsigned s0_ = (unsigned)drow_ * 1024 + ((c15_ ^ (((drow_ & 3) << 2) | ((drow_ >> 2) & 3))) * 8), s1_ = (unsigned)(drow_ + 4) * 1024 + ((c15_ ^ ((((drow_ + 4) & 3) << 2) | (((drow_ + 4) >> 2) & 3))) * 8); \
        const bf16_t* vt = vab + (size_t)(t) * (64 * 1024); LAS unsigned char* vd = lds + M2_LDS_V + (slot) * VBUF + wid * 2048; \
        __builtin_amdgcn_global_load_lds((const unsigned*)(vt + s0_), (LAS unsigned*)vd, 16, 0, 0); __builtin_amdgcn_global_load_lds((const unsigned*)(vt + s1_), (LAS unsigned*)(vd + 1024), 16, 0, 0); } while (0)
    M2_DMAK(0, 0); M2_DMAV(0, 0); M2_DMAV(0, 2);
    if (NT > 1) M2_DMAK(1, 1);
    __builtin_amdgcn_s_waitcnt(0x0F70);
    __syncthreads();
    f32x16 za, zb;
#pragma unroll
    for (int g = 0; g < 16; ++g) { za[g] = 0.f; zb[g] = 0.f; }
#pragma unroll
    for (int d0 = 0; d0 < 12; ++d0) za = MFMA_BF16(*(LAS const bf16x8*)(koff[d0 & 3] + (unsigned)(128 * (d0 >> 2))), qf[d0], za);
    u32x4 pa[2], pb[2]; pa[0] = (u32x4){0u, 0u, 0u, 0u}; pa[1] = pa[0]; pb[0] = pa[0]; pb[1] = pa[0];
#define M2_INTERVAL(P) { if (t + 2 < NT) M2_DMAK(t + 2, ((P) + 2) % 3); if (t + 1 < NT) M2_DMAV(t + 1, ((P) + 1) % 3); \
        if (t <= tmax) {           \
            int qrh; { int t3 = tid; asm volatile("" : "+v"(t3)); qrh = q0 + 32 * wid + (t3 & 31) - 4 * ((t3 >> 5) & 1) - 64 * t; } const bool msk = t == tmax; \
            mla2_iter<(P) * M2_KBUF + 32 * 384, (((P) + 2) % 3) * VBUF + 8192>(za, zb, st, pa[0], pa[1], pb[0], pb[1], qf, koff, voff, msk, qrh); \
            mla2_iter<(((P) + 1) % 3) * M2_KBUF, (P) * VBUF>(zb, za, st, pb[0], pb[1], pa[0], pa[1], qf, koff, voff, msk, qrh - 32); \
            if (msk) {            \
                lcp vb_ = lds + M2_LDS_V + (P) * VBUF + 8192; const VAddr va_ = make_vaddr(tid & 63); \
                _Pragma("unroll") for (int j = 0; j < 8; ++j) st.o[j & 3] = MFMA_BF16(vfrag(vb_, j >> 2, j & 3, va_), __builtin_bit_cast(bf16x8, (j >> 2) ? pa[1] : pa[0]), st.o[j & 3]); } } \
        ++t; __syncthreads(); }
    int t = 0;
    for (;;) { M2_INTERVAL(0) if (t >= NT) break; M2_INTERVAL(1) if (t >= NT) break; M2_INTERVAL(2) if (t >= NT) break; }
#undef M2_INTERVAL
#undef M2_DMAK
#undef M2_DMAV
    const float inv = 1.0f / swap_sum(st.lrun);
    int t4 = tid; asm volatile("" : "+v"(t4)); const size_t qrow = rowbase + q0 + 32 * wid + (t4 & 31); const int hh2 = (t4 >> 5) & 1;
#pragma unroll
    for (int d0 = 0; d0 < 4; ++d0)
#pragma unroll
        for (int gg = 0; gg < 4; ++gg) { const size_t off = qrow * 2048 + h * 128 + 32 * d0 + 8 * gg + 4 * hh2;
            const unsigned long long sg = *(const unsigned long long*)(SG + off);
            const float g0 = __uint_as_float((unsigned)(sg << 16)), g1 = __uint_as_float((unsigned)sg & 0xffff0000u), g2 = __uint_as_float((unsigned)(sg >> 32) << 16), g3 = __uint_as_float((unsigned)(sg >> 32) & 0xffff0000u);
            const unsigned lo = cvtpk(st.o[d0][4 * gg] * inv * g0, st.o[d0][4 * gg + 1] * inv * g1), hi = cvtpk(st.o[d0][4 * gg + 2] * inv * g2, st.o[d0][4 * gg + 3] * inv * g3);
            *(unsigned long long*)(MIX + off) = (unsigned long long)lo | ((unsigned long long)hi << 32); }
}
DI void mla_phase(LAS unsigned char* lds, unsigned char* ws, const int tid) {
    const int G = gridDim.x, bx = blockIdx.x; const int vcu = (G % 8 == 0) ? (bx % 8) * (G / 8) + bx / 8 : bx;
    for (int p = vcu; p < 256; p += G) { const int bh = p >> 3, pr = p & 7;
#if MLA_PIPE
        mla2_unit(lds, ws, bh >> 3, bh & 7, 15 - pr, tid); mla2_unit(lds, ws, bh >> 3, bh & 7, pr, tid);
#else
        mla_unit(lds, ws, bh >> 3, bh & 7, 15 - pr, tid); mla_unit(lds, ws, bh >> 3, bh & 7, pr, tid);
#endif
 }
}

constexpr int SB_KBUF = 16384, SB_LDS_V = 3 * SB_KBUF, SB_LDS_UM = SB_LDS_V + 3 * VBUF, SB_LDS_BYTES = SB_LDS_UM + 2048 + 64;
DI float vmin_s(float a, float b) { float r; asm("v_min_f32 %0, %1, %2" : "=v"(r) : "v"(a), "v"(b)); return r; }
struct SbAddr { unsigned kx, vb0, vq; };
template <bool MASKED, int VAR>
DI void sb_iter(f32x16& zin, f32x16& zout, f32x16 (&o)[4], const u32x4& pi0, const u32x4& pi1, u32x4& po0, u32x4& po1, float& carry, const bf16x8 (&qf)[8], lcp ump, lcp knext, lcp vprev, const SbAddr& ad, int qrh) {
    u32x4 lw0, lw1; const float z0 = zin[0];
    unsigned kx = ad.kx, vq = ad.vq; asm volatile("" : "+v"(kx), "+v"(vq));
    bf16x8 kfa = *(LAS const bf16x8*)(knext + kx), kfb;
#pragma unroll
    for (int k = 0; k < 8; ++k) {
        if (k == 0) {
#pragma unroll
            for (int g = 0; g < 16; ++g) zout[g] = 0.f;
        }
        if (VAR == 2 || VAR == 4 || VAR == 11 || VAR == 13) { asm volatile("" :: "v"((k & 1) ? kfb : kfa)); } else zout = MFMA_BF16((k & 1) ? kfb : kfa, qf[k], zout);
        if (VAR == 12) { zout = MFMA_BF16((k & 1) ? kfb : kfa, qf[k], zout); zout = MFMA_BF16((k & 1) ? kfb : kfa, qf[k], zout); }
        if (k + 1 < 8) { bf16x8 nx; if (VAR == 3 || VAR == 4 || VAR == 9 || VAR == 11 || VAR == 12 || VAR == 13) nx = qf[k]; else nx = *(LAS const bf16x8*)(knext + ((32u * (k + 1)) ^ kx)); if (k & 1) kfa = nx; else kfb = nx; }
        SBAR();
        float lv[2];
#pragma unroll
        for (int i = 0; i < 2; ++i) { const int g = 2 * k + i;
            float sp; if (VAR == 8 || VAR == 9 || VAR == 12) sp = zin[g]; else if (VAR == 13) { sp = __builtin_amdgcn_logf(1.0f + __builtin_amdgcn_exp2f(vmin_s(zin[g], 64.0f))); sp = __builtin_amdgcn_logf(1.0f + __builtin_amdgcn_exp2f(vmin_s(sp, 64.0f))); sp = __builtin_amdgcn_logf(1.0f + __builtin_amdgcn_exp2f(vmin_s(sp, 64.0f))); } else if (VAR == 1 || VAR == 4) sp = vmin_s(zin[g], 64.0f) * 0.5f; else sp = __builtin_amdgcn_logf(1.0f + __builtin_amdgcn_exp2f(vmin_s(zin[g], 64.0f)));
            if (MASKED) lv[i] = (crow(g, 0) < qrh) ? sp : 0.f; else lv[i] = sp; }
        unsigned w = cvtpk_h(lv[0], lv[1]);
        asm volatile("" : "+v"(w));
        if (k < 4) lw0[k & 3] = w; else lw1[k & 3] = w;
        SBAR();
    }
    const f16x8 um0 = *(LAS const f16x8*)ump, um1 = *(LAS const f16x8*)(ump + 16);
    zin = MFMA_F16(um0, __builtin_bit_cast(f16x8, lw0), zin); zin = MFMA_F16(um1, __builtin_bit_cast(f16x8, lw1), zin);
    SBAR();
    s16x4 la, ha, lb, hb;
    const unsigned vb0 = ad.vb0, vb1 = 2048 + (vb0 ^ 32);
    { const unsigned dq = vq; la = vtr(vprev + vb0 + dq); ha = vtr(vprev + vb1 + dq); }
#pragma unroll
    for (int j = 0; j < 8; ++j) {
        { const s16x4 lo = (j & 1) ? lb : la, hi = (j & 1) ? hb : ha;
          const bf16x8 vf = (bf16x8){lo[0], lo[1], lo[2], lo[3], hi[0], hi[1], hi[2], hi[3]};
          if (VAR == 2 || VAR == 4 || VAR == 11 || VAR == 13) { asm volatile("" :: "v"(vf)); } else o[j & 3] = MFMA_BF16(vf, __builtin_bit_cast(bf16x8, (j >> 2) ? pi1 : pi0), o[j & 3]);
          if (VAR == 12) { o[(j + 1) & 3] = MFMA_BF16(vf, __builtin_bit_cast(bf16x8, (j >> 2) ? pi1 : pi0), o[(j + 1) & 3]); o[(j + 2) & 3] = MFMA_BF16(vf, __builtin_bit_cast(bf16x8, (j >> 2) ? pi1 : pi0), o[(j + 2) & 3]); } }
        if (j + 1 < 8) { const unsigned dq = (64u * ((j + 1) & 3)) ^ vq; s16x4 l_, h_; if (VAR == 3 || VAR == 4 || VAR == 9 || VAR == 11 || VAR == 12 || VAR == 13) { l_ = (s16x4){(short)pi0[0], (short)pi0[1], (short)pi0[2], (short)pi0[3]}; h_ = l_; } else { l_ = vtr(vprev + 4096 * ((j + 1) >> 2) + vb0 + dq); h_ = vtr(vprev + 4096 * ((j + 1) >> 2) + vb1 + dq); }
            if (j & 1) { la = l_; ha = h_; } else { lb = l_; hb = h_; } }
        SBAR();
        float av[2];
#pragma unroll
        for (int i = 0; i < 2; ++i) { const int g = 2 * j + i; float a; if (VAR == 8 || VAR == 9 || VAR == 12) a = zin[g]; else if (VAR == 13) { a = __builtin_amdgcn_exp2f(zin[g] + carry); a = __builtin_amdgcn_exp2f(a + carry); a = __builtin_amdgcn_exp2f(a + carry); } else if (VAR == 1 || VAR == 4) a = zin[g] + carry; else a = __builtin_amdgcn_exp2f(zin[g] + carry); if (MASKED) av[i] = (crow(g, 0) < qrh) ? a : 0.f; else av[i] = a; }
        unsigned w = cvtpk(av[0], av[1]);
        asm volatile("" : "+v"(w));
        if (j < 4) po0[j & 3] = w; else po1[j & 3] = w;
        SBAR();
    }
    carry += bcast_lo(zin[0] - z0);
}
template <int KIMM, int VIMM>
DI void sb_iter_s(f32x16& zin, f32x16& zout, f32x16 (&o)[4], const u32x4& pi0, const u32x4& pi1, u32x4& po0, u32x4& po1, float& carry, const bf16x8 (&qf)[8], lcp ump,
                  const unsigned (&koff)[8], const unsigned (&voff)[2][4]) {
    u32x4 lw0, lw1; const float z0 = zin[0];
#define SB_KF(k) (*(LAS const bf16x8*)(koff[k] + (unsigned)KIMM))
#define SB_VF(t, j) vtr((lcp)(voff[t][(j) & 3] + (unsigned)(VIMM + 4096 * ((j) >> 2))))
    bf16x8 kfa = SB_KF(0), kfb;
    const f16x8 um0 = *(LAS const f16x8*)ump, um1 = *(LAS const f16x8*)(ump + 16);
    SBAR();
#pragma unroll
    for (int k = 0; k < 8; ++k) {
        if (k == 0) {
#pragma unroll
            for (int g = 0; g < 16; ++g) zout[g] = 0.f;
        }
        zout = MFMA_BF16((k & 1) ? kfb : kfa, qf[k], zout);
        if (k + 1 < 8) { const bf16x8 nx = SB_KF(k + 1); if (k & 1) kfa = nx; else kfb = nx; }
        SBAR();
        float lv[2];
#pragma unroll
        for (int i = 0; i < 2; ++i) lv[i] = __builtin_amdgcn_logf(1.0f + __builtin_amdgcn_exp2f(vmin_s(zin[2 * k + i], 64.0f)));
        unsigned w = cvtpk_h(lv[0], lv[1]);
        asm volatile("" : "+v"(w));
        if (k < 4) lw0[k & 3] = w; else lw1[k & 3] = w;
        SBAR();
    }
    s16x4 la = SB_VF(0, 0), ha = SB_VF(1, 0), lb, hb;
    SBAR();
    zin = MFMA_F16(um0, __builtin_bit_cast(f16x8, lw0), zin); zin = MFMA_F16(um1, __builtin_bit_cast(f16x8, lw1), zin);
    SBAR();
#pragma unroll
    for (int j = 0; j < 8; ++j) {
        { const s16x4 lo = (j & 1) ? lb : la, hi = (j & 1) ? hb : ha;
          const bf16x8 vf = (bf16x8){lo[0], lo[1], lo[2], lo[3], hi[0], hi[1], hi[2], hi[3]};
          o[j & 3] = MFMA_BF16(vf, __builtin_bit_cast(bf16x8, (j >> 2) ? pi1 : pi0), o[j & 3]); }
        if (j + 1 < 8) { const s16x4 l_ = SB_VF(0, j + 1), h_ = SB_VF(1, j + 1); if (j & 1) { la = l_; ha = h_; } else { lb = l_; hb = h_; } }
        SBAR();
        float av[2];
#pragma unroll
        for (int i = 0; i < 2; ++i) av[i] = __builtin_amdgcn_exp2f(zin[2 * j + i] + carry);
        unsigned w = cvtpk(av[0], av[1]);
        asm volatile("" : "+v"(w));
        if (j < 4) po0[j & 3] = w; else po1[j & 3] = w;
        SBAR();
    }
#undef SB_KF
#undef SB_VF
    carry += bcast_lo(zin[0] - z0);
}
template <int P>
DI void sb_tile_s(f32x16& za, f32x16& zb, f32x16 (&o)[4], u32x4 (&pa)[2], u32x4 (&pb)[2], float& carry, const bf16x8 (&qf)[8], lcp ump, const unsigned (&koff)[8], const unsigned (&voff)[2][4]) {
    constexpr int KS = P, KSN = (P + 1) % 3, VS = P, VSP = (P + 2) % 3;
    sb_iter_s<KS * SB_KBUF, VSP * VBUF>(za, zb, o, pa[0], pa[1], pb[0], pb[1], carry, qf, ump, koff, voff);
    sb_iter_s<KSN * SB_KBUF + 8192, VS * VBUF + 8192>(zb, za, o, pb[0], pb[1], pa[0], pa[1], carry, qf, ump, koff, voff);
}
template <bool MASKED, int VAR>
DI void sb_tile(LAS unsigned char* lds, f32x16& za, f32x16& zb, f32x16 (&o)[4], u32x4 (&pa)[2], u32x4 (&pb)[2], float& carry, const bf16x8 (&qf)[8], lcp ump, const SbAddr& ad,
                unsigned krow_off, int ks, int ksn, int vs, int vsp, int qrh0) {
    sb_iter<MASKED, VAR>(za, zb, o, pa[0], pa[1], pb[0], pb[1], carry, qf, ump, lds + ks * SB_KBUF + krow_off, lds + SB_LDS_V + vsp * VBUF, ad, qrh0 - 32);
    sb_iter<MASKED, VAR>(zb, za, o, pb[0], pb[1], pa[0], pa[1], carry, qf, ump, lds + ksn * SB_KBUF + 8192 + krow_off, lds + SB_LDS_V + vs * VBUF + 8192, ad, qrh0);
}
template <int VAR> DI void sb_unit(LAS unsigned char* lds, unsigned char* ws, int b, int h, int qb, const int tid_in) {
    int tid = tid_in; asm volatile("" : "+v"(tid));
    const int lane = tid & 63, wid = __builtin_amdgcn_readfirstlane(tid >> 6), r = lane & 31, hh = lane >> 5;
    const bf16_t *Q2 = (const bf16_t*)(ws + WS_Q2), *K2 = (const bf16_t*)(ws + WS_K2), *V2 = (const bf16_t*)(ws + WS_V2), *SG2 = (const bf16_t*)(ws + WS_SG2);
    bf16_t* MIX2 = (bf16_t*)(ws + (VAR ? WS_A : WS_MIX2));
    const int q0 = qb * 256, NT = 4 * (qb + 1), tmax = (q0 + 32 * wid) >> 6; const size_t rowbase = (size_t)b * SEQ;
    bf16x8 qf[8];
    { const size_t qrow = rowbase + q0 + 32 * wid + r;
#pragma unroll
      for (int d0 = 0; d0 < 8; ++d0) qf[d0] = *(const bf16x8*)(Q2 + qrow * 2048 + h * 128 + d0 * 16 + hh * 8); }
    { f16x8 um[2];
#pragma unroll
      for (int s = 0; s < 2; ++s)
#pragma unroll
          for (int j = 0; j < 8; ++j) um[s][j] = (16 * s + 8 * (j >> 2) + 4 * hh + (j & 3)) >= r ? (_Float16)-1.0f : (_Float16)0.0f;
      *(LAS f16x8*)(lds + SB_LDS_UM + lane * 32) = um[0]; *(LAS f16x8*)(lds + SB_LDS_UM + lane * 32 + 16) = um[1]; }
    lcp ump = lds + SB_LDS_UM + lane * 32;
    f32x16 o[4];
#pragma unroll
    for (int d0 = 0; d0 < 4; ++d0)
#pragma unroll
        for (int g = 0; g < 16; ++g) o[d0][g] = 0.f;
    float carry = 0.f;
    SbAddr ad;
    { const unsigned blk = (lane >> 4) & 1, qq = (lane & 15) >> 2, p = lane & 3;
      ad.kx = ((r & 15) >> 1) << 5;
      ad.vb0 = 256 * (4 * hh + qq) + 8 * (p & 1) + 16 * ((2 * blk + (p >> 1)) ^ hh); ad.vq = 64 * qq; }
    const unsigned krow_off = r * 256 + ((hh ^ (r & 1)) << 4);
    const bf16_t* kbase = K2 + rowbase * 2048 + h * 128; const bf16_t* vbase = V2 + rowbase * 2048 + h * 128;
#define SB_DMA_SRC() int t2_ = tid; asm volatile("" : "+v"(t2_)); const int ln_ = t2_ & 63, drow_ = 8 * wid + (ln_ >> 4), c15_ = ln_ & 15;
#define SB_DMAK(tau, slot) do { SB_DMA_SRC(); const unsigned s0_ = (unsigned)drow_ * 2048 + ((c15_ ^ (drow_ & 15)) * 8), s1_ = (unsigned)(drow_ + 4) * 2048 + ((c15_ ^ ((drow_ + 4) & 15)) * 8); \
        const bf16_t* kt = kbase + (size_t)(NT - 1 - (tau)) * (64 * 2048); LAS unsigned char* kd = lds + (slot) * SB_KBUF + wid * 2048; \
        __builtin_amdgcn_global_load_lds((const unsigned*)(kt + s0_), (LAS unsigned*)kd, 16, 0, 0); __builtin_amdgcn_global_load_lds((const unsigned*)(kt + s1_), (LAS unsigned*)(kd + 1024), 16, 0, 0); } while (0)
#define SB_DMAV(tau, slot) do { SB_DMA_SRC(); const unsigned s0_ = (unsigned)drow_ * 2048 + ((c15_ ^ (((drow_ & 3) << 2) | ((drow_ >> 2) & 3))) * 8), s1_ = (unsigned)(drow_ + 4) * 2048 + ((c15_ ^ ((((drow_ + 4) & 3) << 2) | (((drow_ + 4) >> 2) & 3))) * 8); \
        const bf16_t* vt = vbase + (size_t)(NT - 1 - (tau)) * (64 * 2048); LAS unsigned char* vd = lds + SB_LDS_V + (slot) * VBUF + wid * 2048; \
        __builtin_amdgcn_global_load_lds((const unsigned*)(vt + s0_), (LAS unsigned*)vd, 16, 0, 0); __builtin_amdgcn_global_load_lds((const unsigned*)(vt + s1_), (LAS unsigned*)(vd + 1024), 16, 0, 0); } while (0)
    SB_DMAK(0, 0); SB_DMAV(0, 0);
    if (NT > 1) SB_DMAK(1, 1);
    __builtin_amdgcn_s_waitcnt(0x0F70);
    __syncthreads();
    f32x16 za, zb;
#pragma unroll
    for (int g = 0; g < 16; ++g) { za[g] = 0.f; zb[g] = 0.f; }
    u32x4 pa[2], pb[2]; pa[0] = (u32x4){0u, 0u, 0u, 0u}; pa[1] = pa[0]; pb[0] = pa[0]; pb[1] = pa[0];
    int ks = 0, ks1 = 1, vs = 0, vsp = 0;
    const int nmask = NT - tmax;
    constexpr float SB_STOP = -140.0f;
    LAS unsigned* flg = (LAS unsigned*)(lds + SB_LDS_UM + 2048);
    bool wdone = false, alldone = false; int par = 0, lim = NT;
#define SB_CLOSE() { wdone = wdone | (__builtin_amdgcn_ballot_w64(carry > SB_STOP) == 0ull); lim = wdone ? (lim < tau + 1 ? lim : tau + 1) : lim;        \
        { int t5 = tid; asm volatile("" : "+v"(t5)); if ((t5 & 63) == 0) flg[par * 8 + wid] = wdone ? 1u : 0u; } \
        __syncthreads();                            \
        { const u32x4 f0 = *(LAS const u32x4*)(flg + par * 8), f1 = *(LAS const u32x4*)(flg + par * 8 + 4); \
          alldone = __builtin_amdgcn_readfirstlane((int)(f0[0] & f0[1] & f0[2] & f0[3] & f1[0] & f1[1] & f1[2] & f1[3])) != 0; } par ^= 1; }
#define SB_INTERVAL(MASKED) { const int t = NT - 1 - tau; const int ks2 = (ks1 == 2) ? 0 : ks1 + 1, vs1 = (vs == 2) ? 0 : vs + 1; \
        if (tau + 2 < NT) SB_DMAK(tau + 2, ks2); \
        if (tau + 1 < NT) SB_DMAV(tau + 1, vs1); \
        int qrh0; { int t3 = tid; asm volatile("" : "+v"(t3)); qrh0 = q0 + 32 * wid + (t3 & 31) - 4 * ((t3 >> 5) & 1) - 64 * t; }        \
        sb_tile<MASKED, VAR>(lds, za, zb, o, pa, pb, carry, qf, ump, ad, krow_off, ks, (tau + 1 < NT ? ks1 : ks), vs, vsp, qrh0); \
        SB_CLOSE() \
        ks = ks1; ks1 = ks2; vsp = vs; vs = vs1; }
    int tau = 0;
    for (; tau < nmask - 1 && !alldone; ++tau) { const int ks2 = (ks1 == 2) ? 0 : ks1 + 1, vs1 = (vs == 2) ? 0 : vs + 1;
        if (tau + 2 < NT) SB_DMAK(tau + 2, ks2);
        if (tau + 1 < NT) SB_DMAV(tau + 1, vs1);
        SB_CLOSE()
        ks = ks1; ks1 = ks2; vsp = vs; vs = vs1; }
    { lcp kp = lds + ks * SB_KBUF + 8192 + krow_off;
#pragma unroll
      for (int k = 0; k < 8; ++k) za = MFMA_BF16(*(LAS const bf16x8*)(kp + ((32u * k) ^ ad.kx)), qf[k], za); }
    for (; tau < nmask && tau < lim; ++tau) SB_INTERVAL(true)
    for (; tau < lim; ++tau) SB_INTERVAL(false)
#undef SB_INTERVAL
    { lcp vp = lds + SB_LDS_V + vsp * VBUF;
#pragma unroll
      for (int j = 0; j < 8; ++j) { const unsigned dq = (64u * (j & 3)) ^ ad.vq;
          const s16x4 lo = vtr(vp + 4096 * (j >> 2) + ad.vb0 + dq), hi = vtr(vp + 4096 * (j >> 2) + 2048 + (ad.vb0 ^ 32) + dq);
          o[j & 3] = MFMA_BF16(((bf16x8){lo[0], lo[1], lo[2], lo[3], hi[0], hi[1], hi[2], hi[3]}), __builtin_bit_cast(bf16x8, (j >> 2) ? pa[1] : pa[0]), o[j & 3]); } }
    for (; tau < NT && !alldone; ++tau) { const int ks2 = (ks1 == 2) ? 0 : ks1 + 1, vs1 = (vs == 2) ? 0 : vs + 1;
        if (tau + 2 < NT) SB_DMAK(tau + 2, ks2);
        if (tau + 1 < NT) SB_DMAV(tau + 1, vs1);
        SB_CLOSE()
        ks = ks1; ks1 = ks2; vsp = vs; vs = vs1; }
#undef SB_CLOSE
    __syncthreads();
#undef SB_DMAK
#undef SB_DMAV
#undef SB_DMA_SRC
    int t4 = tid; asm volatile("" : "+v"(t4)); const size_t qrow = rowbase + q0 + 32 * wid + (t4 & 31); const int hh2 = (t4 >> 5) & 1;
#pragma unroll
    for (int d0 = 0; d0 < 4; ++d0)
#pragma unroll
        for (int gg = 0; gg < 4; ++gg) { const size_t off = qrow * 2048 + h * 128 + 32 * d0 + 8 * gg + 4 * hh2;
            const unsigned long long sg = *(const unsigned long long*)(SG2 + off);
            const float g0 = __uint_as_float((unsigned)(sg << 16)), g1 = __uint_as_float((unsigned)sg & 0xffff0000u), g2 = __uint_as_float((unsigned)(sg >> 32) << 16), g3 = __uint_as_float((unsigned)(sg >> 32) & 0xffff0000u);
            const unsigned lo = cvtpk(o[d0][4 * gg] * g0, o[d0][4 * gg + 1] * g1), hi = cvtpk(o[d0][4 * gg + 2] * g2, o[d0][4 * gg + 3] * g3);
            *(unsigned long long*)(MIX2 + off) = (unsigned long long)lo | ((unsigned long long)hi << 32); }
}
template <int VAR> DI void sb_phase(LAS unsigned char* lds, unsigned char* ws, const int tid) {
    const int G = gridDim.x, bx = blockIdx.x; const int vcu = (G % 8 == 0) ? (bx % 8) * (G / 8) + bx / 8 : bx;
    for (int p = vcu; p < 512; p += G) { const int bh = p >> 3, pr = p & 7; sb_unit<VAR>(lds, ws, bh >> 4, bh & 15, 15 - pr, tid); sb_unit<VAR>(lds, ws, bh >> 4, bh & 15, pr, tid); }
}

constexpr int DIL_KSTR = 272, DIL_WAVE_BYTES = 32 * DIL_KSTR + 8192, DIL_LDS_BYTES = 8 * DIL_WAVE_BYTES;
DI void softmax_blk(f32x16& s0, f32x16 (&o)[4], float& mrun, float& lrun) {
    float mt = s0[0];
#pragma unroll
    for (int g = 1; g < 16; ++g) mt = fmaxf(mt, s0[g]);
    mt = swap_max(mt);
    if (__builtin_amdgcn_ballot_w64(mt > mrun) != 0ull) {
        const float mn = fmaxf(mrun, mt), alpha = __builtin_amdgcn_exp2f(mrun - mn); mrun = mn; lrun *= alpha;
#pragma unroll
        for (int d0 = 0; d0 < 4; ++d0)
#pragma unroll
            for (int g = 0; g < 16; ++g) o[d0][g] *= alpha;
    }
    float ps = 0.f;
#pragma unroll
    for (int g = 0; g < 16; ++g) { s0[g] = __builtin_amdgcn_exp2f(s0[g] - mrun); ps += s0[g]; }
    lrun += ps;
}
DI void dil_wave_unit(LAS unsigned char* wl, unsigned char* ws, int p, int b, int h, int res, int m0w, const int tid_in) {
    int tid = tid_in; asm volatile("" : "+v"(tid));
    const int lane = tid & 63, r = lane & 31, hh = lane >> 5; const int dil = p == 0 ? 1 : p == 1 ? 4 : 16;
    const bf16_t *QB = (const bf16_t*)(ws + WS_QB), *KB = (const bf16_t*)(ws + WS_KB), *VB = (const bf16_t*)(ws + WS_VB);
    const size_t rowbase = (size_t)b * SEQ; const size_t qrow = rowbase + (size_t)(m0w + r) * dil + res;
    const __amdgpu_buffer_rsrc_t rK = mk_rsrc(KB, M * 1024 * 2), rV = mk_rsrc(VB, M * 1024 * 2);
    const unsigned vo = (unsigned)(lane >> 4) * dil * 2048 + (lane & 15) * 16;
    const unsigned so0 = (unsigned)((rowbase + res) * 1024 + h * 128) * 2;
    const float* biasc = (const float*)(ws + WS_BIASC) + (size_t)(p * 8 + h) * 5 * 1024 + lane * 16;
    u32x4 kr[8], vr[8]; f32x4 br[4];
    const int kb0 = m0w >> 5;
#define DIL_LOAD(di) do { const unsigned sb_ = so0 + (unsigned)(32 * (kb0 - (di))) * dil * 2048; \
        _Pragma("unroll") for (int i = 0; i < 8; ++i) { kr[i] = bload(rK, vo + (unsigned)(4 * i) * dil * 2048, sb_); vr[i] = bload(rV, vo + (unsigned)(4 * i) * dil * 2048, sb_); } \
        _Pragma("unroll") for (int j = 0; j < 4; ++j) br[j] = ((const f32x4*)(biasc + (di) * 1024))[j]; } while (0)
    DIL_LOAD(0);
    bf16x8 qf[8];
#pragma unroll
    for (int d0 = 0; d0 < 8; ++d0) qf[d0] = *(const bf16x8*)(QB + qrow * 1024 + h * 128 + d0 * 16 + hh * 8);
    f32x16 o[4];
#pragma unroll
    for (int d0 = 0; d0 < 4; ++d0)
#pragma unroll
        for (int g = 0; g < 16; ++g) o[d0][g] = 0.f;
    float mrun = -INFINITY, lrun = 0.f;
    const VAddr va = make_vaddr(lane);
    const unsigned lk = (lane >> 4) * DIL_KSTR + (lane & 15) * 16;
    for (int di = 0; di < 5; ++di) {
        if (kb0 - di < 0) break;
        asm volatile("s_waitcnt lgkmcnt(0)" ::: "memory");
#pragma unroll
        for (int i = 0; i < 8; ++i) { *(LAS u32x4*)(wl + lk + 4 * i * DIL_KSTR) = kr[i]; *(LAS u32x4*)(wl + 32 * DIL_KSTR + off_b((lane >> 4) + 4 * i, lane & 15)) = vr[i]; }
        f32x16 s0;
#pragma unroll
        for (int j = 0; j < 4; ++j) { s0[4 * j] = br[j][0]; s0[4 * j + 1] = br[j][1]; s0[4 * j + 2] = br[j][2]; s0[4 * j + 3] = br[j][3]; }
        if (di + 1 < 5 && kb0 - (di + 1) >= 0) DIL_LOAD(di + 1);
        asm volatile("s_waitcnt lgkmcnt(0)" ::: "memory");
        lcp kp = wl + r * DIL_KSTR + hh * 16;
#pragma unroll
        for (int d0 = 0; d0 < 8; ++d0) s0 = MFMA_BF16(*(LAS const bf16x8*)(kp + d0 * 32), qf[d0], s0);
        softmax_blk(s0, o, mrun, lrun);
        lcp vb = wl + 32 * DIL_KSTR;
#pragma unroll
        for (int s = 0; s < 2; ++s) { const bf16x8 pf = pack_bf(s0, s);
#pragma unroll
            for (int d0 = 0; d0 < 4; ++d0) o[d0] = MFMA_BF16(vfrag(vb, s, d0, va), pf, o[d0]); }
    }
#undef DIL_LOAD
    const float lt = swap_sum(lrun), inv = 1.0f / lt;
    bf16_t* OP = (bf16_t*)(ws + (p == 0 ? WS_OP0 : p == 1 ? WS_OP1 : WS_OP2));
#pragma unroll
    for (int d0 = 0; d0 < 4; ++d0)
#pragma unroll
        for (int gg = 0; gg < 4; ++gg) { const size_t off = qrow * 1024 + h * 128 + 32 * d0 + 8 * gg + 4 * hh;
            const unsigned lo = cvtpk(o[d0][4 * gg] * inv, o[d0][4 * gg + 1] * inv), hi = cvtpk(o[d0][4 * gg + 2] * inv, o[d0][4 * gg + 3] * inv);
            *(unsigned long long*)(OP + off) = (unsigned long long)lo | ((unsigned long long)hi << 32); }
    if (hh == 0) ((float*)(ws + WS_LSE))[((size_t)p * M + qrow) * 8 + h] = mrun + __builtin_amdgcn_logf(lt);
}
constexpr int DILW_LDS_BYTES = 12 * 8192;
DI void dil_wg_unit(LAS unsigned char* lds, unsigned char* ws, int p, int b, int h, int res, int m0, const int tid_in) {
    int tid = tid_in; asm volatile("" : "+v"(tid));
    const int lane = tid & 63, wid = __builtin_amdgcn_readfirstlane(tid >> 6), r = lane & 31, hh = lane >> 5; const int dil = p == 0 ? 1 : p == 1 ? 4 : 16;
    const bf16_t *QB = (const bf16_t*)(ws + WS_QB), *KB = (const bf16_t*)(ws + WS_KB), *VB = (const bf16_t*)(ws + WS_VB);
    const size_t rowbase = (size_t)b * SEQ; const size_t qrow = rowbase + (size_t)(m0 + 32 * wid + r) * dil + res;
    const int kbw = (m0 >> 5) - 4;
    const int prow = 4 * wid + (lane >> 4);
    const unsigned ksw = ((lane & 15) ^ (prow & 15)) * 8, vsw = ((lane & 15) ^ (((prow & 3) << 2) | ((prow >> 2) & 3))) * 8;
    const bf16_t* kg = KB + (rowbase + res) * 1024 + h * 128; const bf16_t* vg = VB + (rowbase + res) * 1024 + h * 128;
#pragma unroll
    for (int i = 0; i < 12; ++i) { const int kb = kbw + i; if (kb >= 0)
        __builtin_amdgcn_global_load_lds((const unsigned*)(kg + (size_t)(32 * kb + prow) * dil * 1024 + ksw), (LAS unsigned*)(lds + i * 8192 + wid * 1024), 16, 0, 0); }
    bf16x8 qf[8];
#pragma unroll
    for (int d0 = 0; d0 < 8; ++d0) qf[d0] = *(const bf16x8*)(QB + qrow * 1024 + h * 128 + d0 * 16 + hh * 8);
    const float* biasc = (const float*)(ws + WS_BIASC) + (size_t)(p * 8 + h) * 5 * 1024 + lane * 16;
    f32x16 sc[5];
#pragma unroll
    for (int di = 0; di < 5; ++di) { const f32x4* bp = (const f32x4*)(biasc + di * 1024);
#pragma unroll
        for (int j = 0; j < 4; ++j) { const f32x4 v = bp[j]; sc[di][4 * j] = v[0]; sc[di][4 * j + 1] = v[1]; sc[di][4 * j + 2] = v[2]; sc[di][4 * j + 3] = v[3]; } }
    __builtin_amdgcn_s_waitcnt(0x0F70);
    __syncthreads();
    const unsigned kx = ((r & 15) >> 1) << 5, krow_off = r * 256 + ((hh ^ (r & 1)) << 4);
#pragma unroll
    for (int di = 0; di < 5; ++di) { const int jj = wid + 4 - di;
        if (kbw + jj >= 0) { lcp kp = lds + jj * 8192 + krow_off;
#pragma unroll
            for (int k = 0; k < 8; ++k) sc[di] = MFMA_BF16(*(LAS const bf16x8*)(kp + ((32u * k) ^ kx)), qf[k], sc[di]); }
        else {
#pragma unroll
            for (int g = 0; g < 16; ++g) sc[di][g] = -INFINITY; } }
    float mx = sc[0][0];
#pragma unroll
    for (int di = 0; di < 5; ++di)
#pragma unroll
        for (int g = 0; g < 16; ++g) mx = fmaxf(mx, sc[di][g]);
    mx = swap_max(mx);
    float ps = 0.f; u32x4 pw[5][2];
#pragma unroll
    for (int di = 0; di < 5; ++di) {
#pragma unroll
        for (int g = 0; g < 16; ++g) { sc[di][g] = __builtin_amdgcn_exp2f(sc[di][g] - mx); ps += sc[di][g]; }
        pw[di][0] = __builtin_bit_cast(u32x4, pack_bf(sc[di], 0)); pw[di][1] = __builtin_bit_cast(u32x4, pack_bf(sc[di], 1)); }
    __syncthreads();
#pragma unroll
    for (int i = 0; i < 12; ++i) { const int kb = kbw + i; if (kb >= 0)
        __builtin_amdgcn_global_load_lds((const unsigned*)(vg + (size_t)(32 * kb + prow) * dil * 1024 + vsw), (LAS unsigned*)(lds + i * 8192 + wid * 1024), 16, 0, 0); }
    f32x16 o[4];
#pragma unroll
    for (int d0 = 0; d0 < 4; ++d0)
#pragma unroll
        for (int g = 0; g < 16; ++g) o[d0][g] = 0.f;
    const VAddr va = make_vaddr(lane);
    __builtin_amdgcn_s_waitcnt(0x0F70);
    __syncthreads();
#pragma unroll
    for (int di = 0; di < 5; ++di) { const int jj = wid + 4 - di;
        if (kbw + jj >= 0) { lcp vb = lds + jj * 8192;
#pragma unroll
            for (int s = 0; s < 2; ++s)
#pragma unroll
                for (int d0 = 0; d0 < 4; ++d0) o[d0] = MFMA_BF16(vfrag(vb, s, d0, va), __builtin_bit_cast(bf16x8, pw[di][s]), o[d0]); } }
    const float lt = swap_sum(ps), inv = 1.0f / lt;
    bf16_t* OP = (bf16_t*)(ws + (p == 0 ? WS_OP0 : p == 1 ? WS_OP1 : WS_OP2));
#pragma unroll
    for (int d0 = 0; d0 < 4; ++d0)
#pragma unroll
        for (int gg = 0; gg < 4; ++gg) { const size_t off = qrow * 1024 + h * 128 + 32 * d0 + 8 * gg + 4 * hh;
            const unsigned lo = cvtpk(o[d0][4 * gg] * inv, o[d0][4 * gg + 1] * inv), hi = cvtpk(o[d0][4 * gg + 2] * inv, o[d0][4 * gg + 3] * inv);
            *(unsigned long long*)(OP + off) = (unsigned long long)lo | ((unsigned long long)hi << 32); }
    if (hh == 0) ((float*)(ws + WS_LSE))[((size_t)p * M + qrow) * 8 + h] = mx + __builtin_amdgcn_logf(lt);
    __syncthreads();
}
DI void dil_phase(LAS unsigned char* lds, unsigned char* ws, const int tid) {
    for (int u = blockIdx.x; u < 1536; u += gridDim.x) {
        const int cidx = u & 15, h = (u >> 4) & 7, b = (u >> 7) & 3, p = u >> 9;
        const int res = p == 0 ? 0 : p == 1 ? (cidx & 3) : cidx, m0 = p == 0 ? 256 * cidx : p == 1 ? 256 * (cidx >> 2) : 0;
        dil_wg_unit(lds, ws, p, b, h, res, m0, tid);
    }
}
}

__global__ void __launch_bounds__(512, 2) k_mla_fast(Ctx c) { extern __shared__ __attribute__((aligned(16))) unsigned char lds[]; att::mla_phase((LAS unsigned char*)lds, c.ws, (int)threadIdx.x); }
__global__ void __launch_bounds__(512, 2) k_sb_fast(Ctx c) { extern __shared__ __attribute__((aligned(16))) unsigned char lds[]; att::sb_phase<0>((LAS unsigned char*)lds, c.ws, (int)threadIdx.x); }
__global__ void __launch_bounds__(512, 2) k_dil_fast(Ctx c) { extern __shared__ __attribute__((aligned(16))) unsigned char lds[]; att::dil_phase((LAS unsigned char*)lds, c.ws, (int)threadIdx.x); }

template <bool FROMBF>
DI void final_norm_row(float* out, const bf16_t* xb, const float* gain, int row, int lane) {
    f32x4* xr = (f32x4*)(out + (size_t)row * D_MODEL) + lane; const f32x4* g = (const f32x4*)gain + lane;
    f32x4 v[8]; float s = 0.f;
    if (FROMBF) { const u32x4* br = (const u32x4*)(xb + (size_t)row * D_MODEL) + lane;
#pragma unroll
        for (int j = 0; j < 4; ++j) { const u32x4 w = br[64 * j];
            v[2 * j] = (f32x4){__uint_as_float(w[0] << 16), __uint_as_float(w[0] & 0xffff0000u), __uint_as_float(w[1] << 16), __uint_as_float(w[1] & 0xffff0000u)};
            v[2 * j + 1] = (f32x4){__uint_as_float(w[2] << 16), __uint_as_float(w[2] & 0xffff0000u), __uint_as_float(w[3] << 16), __uint_as_float(w[3] & 0xffff0000u)}; }
#pragma unroll
        for (int j = 0; j < 8; ++j) s += v[j].x * v[j].x + v[j].y * v[j].y + v[j].z * v[j].z + v[j].w * v[j].w;
        const float r = rsqrtf(wave_sum(s) * (1.0f / D_MODEL) + EPS);
        f32x4* o4 = (f32x4*)(out + (size_t)row * D_MODEL); const f32x4* g4 = (const f32x4*)gain;
#pragma unroll
        for (int j = 0; j < 4; ++j) { const int i0 = 128 * j + 2 * lane; o4[i0] = v[2 * j] * r * g4[i0]; o4[i0 + 1] = v[2 * j + 1] * r * g4[i0 + 1]; }
    } else {
#pragma unroll
        for (int j = 0; j < 8; ++j) { v[j] = xr[64 * j]; s += v[j].x * v[j].x + v[j].y * v[j].y + v[j].z * v[j].z + v[j].w * v[j].w; }
        const float r = rsqrtf(wave_sum(s) * (1.0f / D_MODEL) + EPS);
#pragma unroll
        for (int j = 0; j < 8; ++j) xr[64 * j] = v[j] * r * g[64 * j];
    }
}
__global__ void __launch_bounds__(256) k_final_norm(float* out, const float* gain) { final_norm_row<false>(out, nullptr, gain, blockIdx.x * 4 + (threadIdx.x >> 6), threadIdx.x & 63); }
__global__ void __launch_bounds__(256) k_final_norm_bf(float* out, const bf16_t* xb, const float* gain) { final_norm_row<true>(out, xb, gain, blockIdx.x * 4 + (threadIdx.x >> 6), threadIdx.x & 63); }

#define XB_TMO      128
#define XB_XCNT(j)  (256  + 64 * (j))
#define XB_XSUB(j)  (1280 + 64 * (j))
#define XB_XGEN(j)  (2304 + 64 * (j))
#define XB_TOP      3328
#define XB_TOPGEN   3392
#define XCD_BAR_WORDS 3456
#define XB_SPIN_CAP (1u << 22)
DI unsigned xb_ld(unsigned* p)              { return __hip_atomic_load(p, __ATOMIC_RELAXED, __HIP_MEMORY_SCOPE_AGENT); }
DI unsigned xb_add(unsigned* p, unsigned v) { return __hip_atomic_fetch_add(p, v, __ATOMIC_RELAXED, __HIP_MEMORY_SCOPE_AGENT); }
DI unsigned xb_xcc_id() { return (unsigned)__builtin_amdgcn_s_getreg((3 << 11) | 20) & 0xFu; }
#define XB_SPIN(cond, bar) do { unsigned _sp = 0; while (cond) { __builtin_amdgcn_s_sleep(1); \
    if ((++_sp & 255u) == 0u) { if (xb_ld(&(bar)[XB_TMO])) break; if (_sp > XB_SPIN_CAP) { atomicAdd(&(bar)[XB_TMO], 1u); break; } } } } while (0)
struct XcdBarrier { unsigned* bar; unsigned x; volatile LAS unsigned* st; };
DI XcdBarrier xcd_barrier_post(unsigned* bar, volatile LAS unsigned* st, int tid) {
    XcdBarrier b; b.bar = bar; b.x = xb_xcc_id(); b.st = st;
    if (tid == 0) (void)xb_add(&bar[XB_XCNT(b.x)], 1u);
    return b;
}
DI void xcd_barrier_complete(unsigned* bar, unsigned x, unsigned& nloc, unsigned& nx) {
    const unsigned G = gridDim.x * gridDim.y * gridDim.z;
    unsigned sum, cnt, mine, sp = 0u;
    for (;;) {
        sum = 0u; cnt = 0u; mine = 0u;
#pragma unroll
        for (unsigned j = 0; j < 16; ++j) { const unsigned c = xb_ld(&bar[XB_XCNT(j)]); sum += c; cnt += (c > 0u) ? 1u : 0u; mine = (j == x) ? c : mine; }
        if (sum == G) break;
        __builtin_amdgcn_s_sleep(1);
        if ((++sp & 255u) == 0u) { if (xb_ld(&bar[XB_TMO])) break; if (sp > XB_SPIN_CAP) { atomicAdd(&bar[XB_TMO], 1u); break; } }
    }
    nloc = mine > 0u ? mine : 1u; nx = cnt > 0u ? cnt : 1u;
}
DI void xcd_barrier(const XcdBarrier& b, int tid) {
    asm volatile("s_waitcnt vmcnt(0)" ::: "memory");
    __syncthreads();
    if (tid == 0) {
        unsigned* bar = b.bar;
        __builtin_amdgcn_s_waitcnt(0);
        unsigned nloc = b.st[0], nx = b.st[1];
        if (nloc == 0u) { xcd_barrier_complete(bar, b.x, nloc, nx); b.st[0] = nloc; b.st[1] = nx; }
        const unsigned old = xb_add(&bar[XB_XSUB(b.x)], 1u);
        const unsigned gen = old / nloc;
        if (old + 1u == (gen + 1u) * nloc) {
            __builtin_amdgcn_fence(__ATOMIC_RELEASE, "agent");
            asm volatile("s_waitcnt vmcnt(0)" ::: "memory");
            const unsigned og = xb_add(&bar[XB_TOP], 1u);
            const unsigned tg = og / nx;
            if (og + 1u == (tg + 1u) * nx) xb_add(&bar[XB_TOPGEN], 1u);
            else XB_SPIN(xb_ld(&bar[XB_TOPGEN]) == tg, bar);
            __builtin_amdgcn_fence(__ATOMIC_ACQUIRE, "agent");
            xb_add(&bar[XB_XGEN(b.x)], 1u);
            asm volatile("s_waitcnt vmcnt(0)" ::: "memory");
        } else {
            XB_SPIN(xb_ld(&bar[XB_XGEN(b.x)]) == gen, bar);
            __builtin_amdgcn_fence(__ATOMIC_ACQUIRE, "agent");
            asm volatile("s_waitcnt vmcnt(0)" ::: "memory");
        }
    }
    __syncthreads();
}

constexpr int MEGA_LDS_PHASE = 135168, MEGA_LDS = MEGA_LDS_PHASE + 64;
#ifndef SYNC_PROBE
#define SYNC_PROBE 0
#endif
#ifndef SB_PROBE_VAR
#define SB_PROBE_VAR 0
#endif
#ifndef PROBE_MASK
#define PROBE_MASK 0
#endif
#define PREP(k) for (int rep_ = 0; rep_ < 1 + ((PROBE_MASK >> (k)) & 1); ++rep_)
__global__ void __launch_bounds__(512, 2) k_mega(Ctx c) {
    extern __shared__ __attribute__((aligned(16))) unsigned char lds_raw[];
    LAS unsigned char* lds = (LAS unsigned char*)lds_raw;
    unsigned char* ws = c.ws; const int G = gridDim.x, bx = blockIdx.x;
    const int wave_s = __builtin_amdgcn_readfirstlane((int)threadIdx.x >> 6);
    volatile LAS unsigned* bst = (volatile LAS unsigned*)(lds + MEGA_LDS_PHASE);
    if (threadIdx.x < 16) bst[threadIdx.x] = 0u;
    __syncthreads();
    const XcdBarrier xbar = xcd_barrier_post((unsigned*)(ws + WS_CTL), bst, (int)threadIdx.x);
#define GRID_BAR() xcd_barrier(xbar, phase_tid(wave_s))
    PREP(0) { prep_phase<8, 0>(c, (float*)lds_raw, phase_tid(wave_s)); __syncthreads(); }
    GRID_BAR();
    PREP(1) { pg8::Gemm g{(const bf16_t*)(ws + WS_H0), (const bf16_t*)(ws + WS_WT_IN_E), M, IN_EVEN_PAD, 2048}; pg8::StaticOrder S; S.init(g.M, g.N, G, bx);
      pg8::gemm_phase<pg8::FEpi1, pg8::StaticOrder, true, true>(lds, g, S, pg8::FEpi1{ws}, phase_tid(wave_s)); }
    { const int nlast = (M / 256) * (IN_EVEN_PAD / 256) % G; const int nfree = nlast ? G - nlast : G, me = nlast ? bx - nlast : bx;
      if (me >= 0) { const int tid = phase_tid(wave_s); prep_weights<1>(c, (float*)lds_raw + (tid >> 6) * 64 * 36, tid & 63, me * 8 + (tid >> 6), nfree * 8); } }
    GRID_BAR();
    PREP(2) { att::dil_phase(lds, ws, phase_tid(wave_s));
    __syncthreads(); }
    PREP(7) { pg8::Gemm g{(const bf16_t*)(ws + WS_CQ), (const bf16_t*)(ws + WS_WT_UQ), M, 1536, 512}; pg8::StaticOrder S; S.init(g.M, g.N, G, bx);
      pg8::gemm_phase<pg8::FEpi2a, pg8::StaticOrder, true, true>(lds, g, S, pg8::FEpi2a{ws}, phase_tid(wave_s)); }
    PREP(7) { pg8::Gemm g{(const bf16_t*)(ws + WS_CKV), (const bf16_t*)(ws + WS_WT_UKV), M, 2048, 512}; pg8::StaticOrder S; S.init(g.M, g.N, G, bx);
      pg8::gemm_phase<pg8::FEpi2b, pg8::StaticOrder, true, true>(lds, g, S, pg8::FEpi2b{ws}, phase_tid(wave_s)); }
    GRID_BAR();
    PREP(3) att::mla_phase(lds, ws, phase_tid(wave_s));
    PREP(8) { const int tid = phase_tid(wave_s); for (int it = bx * 512 + tid; it < M * 128; it += G * 512) dil_merge_item(ws, it >> 7, (it & 127) * 8); }
    GRID_BAR();
    PREP(4) { pg8::Gemm g{(const bf16_t*)(ws + WS_MIX), (const bf16_t*)(ws + WS_WT_OUT_E), M, 2048, 2048}; pg8::StaticOrder S; S.init(g.M, g.N, G, bx);
      pg8::gemm_phase<pg8::FEpi4, pg8::StaticOrder, false, true>(lds, g, S, pg8::FEpi4{ws, c.x, c.out}, phase_tid(wave_s)); }
    GRID_BAR();
    PREP(5) { pg8::Gemm g{(const bf16_t*)(ws + WS_X1BF), (const bf16_t*)(ws + WS_WT_IN_O), M, IN_ODD, 2048}; pg8::StaticOrder S; S.init(g.M, g.N, G, bx);
      pg8::gemm_phase<pg8::FEpi5, pg8::StaticOrder, true, true>(lds, g, S, pg8::FEpi5{ws}, phase_tid(wave_s)); }
    GRID_BAR();
    PREP(6) att::sb_phase<0>(lds, ws, phase_tid(wave_s));
#if SB_PROBE_VAR
    att::sb_phase<SB_PROBE_VAR>(lds, ws, phase_tid(wave_s));
#endif
    GRID_BAR();
    { pg8::Gemm g{(const bf16_t*)(ws + WS_MIX2), (const bf16_t*)(ws + WS_WT_OUT_O), M, 2048, 2048}; pg8::StaticOrder S; S.init(g.M, g.N, G, bx);
      pg8::gemm_phase<pg8::FEpi7, pg8::StaticOrder, false, true>(lds, g, S, pg8::FEpi7{(bf16_t*)(ws + WS_X2BF), (const bf16_t*)(ws + WS_X1BF)}, phase_tid(wave_s)); }
    GRID_BAR();
#if SYNC_PROBE
    for (int i_ = 0; i_ < 8; ++i_) GRID_BAR();
#endif
    { const int tid = phase_tid(wave_s); for (int row = bx * 8 + (tid >> 6); row < M; row += G * 8) final_norm_row<true>(c.out, (const bf16_t*)(ws + WS_X2BF), c.final_gain, row, tid & 63); }
}

#ifndef MK_ONE_LAUNCH
#define MK_ONE_LAUNCH 1
#endif
#ifndef FAST_G1
#define FAST_G1 1
#endif
#ifndef FAST_G2
#define FAST_G2 1
#endif
#ifndef FAST_G4
#define FAST_G4 1
#endif
#ifndef FAST_G5
#define FAST_G5 1
#endif
#ifndef FAST_G7
#define FAST_G7 1
#endif
#ifndef FAST_MLA
#define FAST_MLA 1
#endif
#ifndef FAST_SB
#define FAST_SB 1
#endif
#ifndef FAST_DIL
#define FAST_DIL 1
#endif
static void launch_att(void (*k)(Ctx), int lds_bytes, const Ctx& c, hipStream_t s) {
    (void)hipFuncSetAttribute((const void*)k, hipFuncAttributeMaxDynamicSharedMemorySize, lds_bytes);
    hipLaunchKernelGGL(k, dim3(256), dim3(512), lds_bytes, s, c);
}
template <class Epi> static void launch_gemm_fast(const bf16_t* A, const bf16_t* Bt, int N, int K, Epi E, hipStream_t s) {
    static bool attr = false; if (!attr) { (void)hipFuncSetAttribute((const void*)k_gemm_fast<Epi>, hipFuncAttributeMaxDynamicSharedMemorySize, 131072); attr = true; }
    pg8::Gemm g{A, Bt, M, N, K};
    k_gemm_fast<Epi><<<256, 512, 131072, s>>>(g, E);
}

extern "C" void kernel_launch(void* const* d_in, const int* in_sizes, int n_in, void* d_out, int out_size, void* d_ws, size_t ws_size, hipStream_t stream) {
    if (n_in != 12 || out_size != M * D_MODEL || ws_size < WS_END) { fprintf(stderr, "kernel_launch: unexpected shapes (n_in %d out %d ws %zu)\n", n_in, out_size, ws_size); return; }
    Ctx c{};
    c.x = (const float*)d_in[0]; c.norm_gain = (const float*)d_in[1]; c.w_in_even = (const float*)d_in[2]; c.q_norm_gain = (const float*)d_in[3]; c.kv_norm_gain = (const float*)d_in[4];
    c.w_uq = (const float*)d_in[5]; c.w_ukv = (const float*)d_in[6]; c.w_out_even = (const float*)d_in[7]; c.rel_bias = (const float*)d_in[8]; c.w_in_odd = (const float*)d_in[9];
    c.w_out_odd = (const float*)d_in[10]; c.final_gain = (const float*)d_in[11]; c.out = (float*)d_out; c.ws = (unsigned char*)d_ws;
#if MK_ONE_LAUNCH
    static int grid_blocks = 0;
    if (!grid_blocks) {
        int dev = 0, cus = 0, per_cu = 0;
        (void)hipGetDevice(&dev); (void)hipDeviceGetAttribute(&cus, hipDeviceAttributeMultiprocessorCount, dev);
        (void)hipFuncSetAttribute((const void*)k_mega, hipFuncAttributeMaxDynamicSharedMemorySize, MEGA_LDS);
        (void)hipOccupancyMaxActiveBlocksPerMultiprocessor(&per_cu, (const void*)k_mega, 512, MEGA_LDS);
        if (per_cu < 1) { fprintf(stderr, "kernel_launch: occupancy query says %d blocks/CU\n", per_cu); per_cu = 1; }
        grid_blocks = cus;
    }
    (void)hipMemsetAsync((char*)d_ws + WS_CTL, 0, 65536, stream);
    { void* args[] = {&c};
      hipError_t e = hipLaunchCooperativeKernel((void*)k_mega, dim3(grid_blocks), dim3(512), args, MEGA_LDS, stream);
      if (e != hipSuccess) fprintf(stderr, "cooperative launch failed: %s (grid %d)\n", hipGetErrorString(e), grid_blocks); }
    return;
#endif
    unsigned char* ws = c.ws;
    const float* rc = (const float*)(ws + WS_ROPE); const float* rs = rc + 4096 * 32;
    k_prep<<<2048, 256, 0, stream>>>(c);
#if FAST_G1
    launch_gemm_fast((const bf16_t*)(ws + WS_H0), (const bf16_t*)(ws + WS_WT_IN_E), IN_EVEN_PAD, 2048, pg8::FEpi1{ws}, stream);
#else
    k_gemm_naive<Epi1><<<(M / 64) * (IN_EVEN_PAD / 64), 256, 0, stream>>>((const bf16_t*)(ws + WS_H0), (const bf16_t*)(ws + WS_WT_IN_E), IN_EVEN_PAD, 2048, Epi1{ws});
    k_rowss<false><<<M / 4, 256, 0, stream>>>(ws + WS_CQ, 512, 512, (float*)(ws + WS_SSC), 16, 8);
    k_rowss<false><<<M / 4, 256, 0, stream>>>(ws + WS_CKV, 512, 512, (float*)(ws + WS_SSC) + 8, 16, 8);
    k_rope<<<(M * 32 + 255) / 256, 256, 0, stream>>>((bf16_t*)(ws + WS_KR), 1, rc, rs);
#endif
#if FAST_DIL
    launch_att(k_dil_fast, att::DIL_LDS_BYTES, c, stream);
#else
    k_dil_naive<<<BATCH * 8 * SEQ / 4, 256, 0, stream>>>(c);
#endif
#if FAST_G2
    launch_gemm_fast((const bf16_t*)(ws + WS_CQ), (const bf16_t*)(ws + WS_WT_UQ), 1536, 512, pg8::FEpi2a{ws}, stream);
    launch_gemm_fast((const bf16_t*)(ws + WS_CKV), (const bf16_t*)(ws + WS_WT_UKV), 2048, 512, pg8::FEpi2b{ws}, stream);
#else
    k_gemm_naive<Epi2a><<<(M / 64) * (1536 / 64), 256, 0, stream>>>((const bf16_t*)(ws + WS_CQ), (const bf16_t*)(ws + WS_WT_UQ), 1536, 512, Epi2a{ws});
    k_rope<<<(M * 256 + 255) / 256, 256, 0, stream>>>((bf16_t*)(ws + WS_QR), 8, rc, rs);
    k_gemm_naive<Epi2b><<<(M / 64) * (2048 / 64), 256, 0, stream>>>((const bf16_t*)(ws + WS_CKV), (const bf16_t*)(ws + WS_WT_UKV), 2048, 512, Epi2b{ws});
#endif
#if FAST_MLA
    launch_att(k_mla_fast, att::M2_LDS_BYTES > att::MLA_LDS_BYTES ? att::M2_LDS_BYTES : att::MLA_LDS_BYTES, c, stream);
#else
    k_mla_naive<<<BATCH * 8 * SEQ / 4, 256, 0, stream>>>(c);
#endif
    k_dil_merge<<<M, 128, 0, stream>>>(c);
#if FAST_G4
    launch_gemm_fast((const bf16_t*)(ws + WS_MIX), (const bf16_t*)(ws + WS_WT_OUT_E), 2048, 2048, pg8::FEpi4{ws, c.x, c.out}, stream);
#else
    k_gemm_naive<Epi4><<<(M / 64) * (2048 / 64), 256, 0, stream>>>((const bf16_t*)(ws + WS_MIX), (const bf16_t*)(ws + WS_WT_OUT_E), 2048, 2048, Epi4{ws, c.x, c.out});
    k_rowss<true><<<M / 4, 256, 0, stream>>>(c.out, 2048, 2048, (float*)(ws + WS_SSX1), 32, 32);
#endif
#if FAST_G5
    launch_gemm_fast((const bf16_t*)(ws + WS_X1BF), (const bf16_t*)(ws + WS_WT_IN_O), IN_ODD, 2048, pg8::FEpi5{ws}, stream);
#else
    k_gemm_naive<Epi5><<<(M / 64) * (IN_ODD / 64), 256, 0, stream>>>((const bf16_t*)(ws + WS_X1BF), (const bf16_t*)(ws + WS_WT_IN_O), IN_ODD, 2048, Epi5{ws});
#endif
#if FAST_SB
    launch_att(k_sb_fast, att::SB_LDS_BYTES, c, stream);
#else
    k_sb_naive<<<BATCH * 16 * SEQ / 4, 256, 0, stream>>>(c);
#endif
#if FAST_G7
    launch_gemm_fast((const bf16_t*)(ws + WS_MIX2), (const bf16_t*)(ws + WS_WT_OUT_O), 2048, 2048, pg8::FEpi7{(bf16_t*)(ws + WS_X2BF), (const bf16_t*)(ws + WS_X1BF)}, stream);
#else
    k_gemm_naive<Epi7><<<(M / 64) * (2048 / 64), 256, 0, stream>>>((const bf16_t*)(ws + WS_MIX2), (const bf16_t*)(ws + WS_WT_OUT_O), 2048, 2048, Epi7{c.out});
#endif
#if FAST_G7
    k_final_norm_bf<<<M / 4, 256, 0, stream>>>(c.out, (const bf16_t*)(ws + WS_X2BF), c.final_gain);
#else
    k_final_norm<<<M / 4, 256, 0, stream>>>(c.out, c.final_gain);
#endif
}
```

```cpp
#include <hip/hip_runtime.h>
#include <cstdio>
#include <cstdint>
#include <cmath>

typedef unsigned short bf16_t;
typedef unsigned u32x4 __attribute__((ext_vector_type(4)));
typedef float f32x4 __attribute__((ext_vector_type(4)));

constexpr int D_MODEL = 2048, BATCH = 4, SEQ = 4096, M = BATCH * SEQ;
constexpr int NH_MLA = 8, NH_DIL = 8, NH_SB = 16, HD = 128;
constexpr int IN_EVEN = 6208, IN_EVEN_PAD = 6400, IN_ODD = 8192;
constexpr float EPS = 1e-6f;
constexpr float LOG2E = 1.4426950408889634f;
constexpr float MLA_QSCALE = 0.07216878364870322f * LOG2E;
constexpr float D128_QSCALE = 0.08838834764831845f * LOG2E;

constexpr size_t MiB = 1u << 20;
constexpr size_t WS_CTL = 0;
constexpr size_t WS_ROPE = 1 * MiB;
constexpr size_t WS_BIASN = 2 * MiB;
constexpr size_t WS_BIASC = 2 * MiB + 65536;
constexpr size_t WS_SSX = 3 * MiB;
constexpr size_t WS_SSC = 4 * MiB;
constexpr size_t WS_SSX1 = 5 * MiB;
constexpr size_t WS_LSE = 9 * MiB;
constexpr size_t WS_WT_IN_E = 12 * MiB;
constexpr size_t WS_WT_UQ = 37 * MiB;
constexpr size_t WS_WT_UKV = 39 * MiB;
constexpr size_t WS_WT_OUT_E = 41 * MiB;
constexpr size_t WS_WT_IN_O = 49 * MiB;
constexpr size_t WS_WT_OUT_O = 81 * MiB;
constexpr size_t WS_A = 90 * MiB;
constexpr size_t WS_B = 154 * MiB;
constexpr size_t WS_C = 218 * MiB;
constexpr size_t WS_H0 = WS_A, WS_OP0 = WS_A, WS_OP1 = WS_A + 32 * MiB, WS_X1BF = WS_A;
constexpr size_t WS_CQ = WS_B, WS_CKV = WS_B + 16 * MiB, WS_QB = WS_B + 32 * MiB, WS_MIX = WS_B, WS_MIX2 = WS_B;
constexpr size_t WS_KB = WS_C, WS_VB = WS_C + 32 * MiB, WS_SG = WS_C + 64 * MiB, WS_QN = WS_C + 128 * MiB, WS_QR = WS_C + 160 * MiB,
                 WS_KN = WS_C + 176 * MiB, WS_VA = WS_C + 208 * MiB, WS_KR = WS_C + 240 * MiB, WS_OP2 = WS_C + 242 * MiB;
constexpr size_t WS_X2BF = WS_C;
constexpr size_t WS_Q2 = WS_C, WS_K2 = WS_C + 64 * MiB, WS_V2 = WS_C + 128 * MiB, WS_SG2 = WS_C + 192 * MiB;
constexpr size_t WS_END = WS_C + 274 * MiB;

struct Ctx {
    const float *x, *norm_gain, *w_in_even, *q_norm_gain, *kv_norm_gain, *w_uq, *w_ukv, *w_out_even, *rel_bias, *w_in_odd, *w_out_odd, *final_gain;
    float* out; unsigned char* ws;
};

#define DI __device__ __forceinline__
DI int phase_tid(int wave_s) { int lane; asm volatile("v_mbcnt_lo_u32_b32 %0, -1, 0\n\tv_mbcnt_hi_u32_b32 %0, -1, %0" : "=v"(lane)); return wave_s * 64 + lane; }
DI float bf2f(bf16_t v) { return __uint_as_float(((unsigned)v) << 16); }
DI bf16_t f2bf(float f) { unsigned u = __float_as_uint(f); return (bf16_t)((u + 0x7fffu + ((u >> 16) & 1u)) >> 16); }
DI float wave_sum(float v) {
#pragma unroll
    for (int o = 1; o < 64; o <<= 1) v += __shfl_xor(v, o);
    return v;
}
DI float wave_max(float v) {
#pragma unroll
    for (int o = 1; o < 64; o <<= 1) v = fmaxf(v, __shfl_xor(v, o));
    return v;
}
DI float silu_f(float v) { return v / (1.0f + __expf(-v)); }

DI int map_in_even(int n) { if (n < 1024) return n; if (n < 1056) return 1024 + (n - 1024); if (n < 1088) return 1152 + (n - 1056); return n - 1088 + 1280; }
DI int map_uq(int n) { const int h = n / 192, j = n % 192; if (j < 128) return h * 128 + j; if (j < 160) return 1024 + (h >> 2) * 256 + (h & 3) * 32 + (j - 128);
    return 1024 + (h >> 2) * 256 + 128 + (h & 3) * 32 + (j - 160); }
DI int map_ukv(int n) { const int h = n / 256, j = n % 256; if (j < 128) return h * 128 + j; return 1024 + h * 128 + (j - 128); }
DI int map_id(int n) { return n; }

template <int MAPID>
DI void transpose_item(const float* W, int K, int N, const float* gain, bf16_t* WT, float* scr  , int item, int lane) {
    const int nblk = N / 32, kb = item / nblk, nb = item % nblk, k0 = 64 * kb, n0 = 32 * nb;
    f32x4 v[8];
#pragma unroll
    for (int i = 0; i < 8; ++i) { const int kk = 8 * i + (lane >> 3); v[i] = *(const f32x4*)(W + (size_t)(k0 + kk) * N + n0 + 4 * (lane & 7)); }
#pragma unroll
    for (int i = 0; i < 8; ++i) { const int kk = 8 * i + (lane >> 3); const float g = gain ? gain[k0 + kk] : 1.0f; *(f32x4*)(scr + kk * 36 + 4 * (lane & 7)) = v[i] * g; }
    asm volatile("s_waitcnt lgkmcnt(0)" ::: "memory");
    const int d0 = MAPID == 0 ? map_in_even(n0) : MAPID == 1 ? map_uq(n0) : MAPID == 2 ? map_ukv(n0) : map_id(n0);
    const int c = lane & 7;
#pragma unroll
    for (int j = 0; j < 4; ++j) { const int n = (lane >> 3) + 8 * j; const float* s = scr + (8 * c) * 36 + n;
        u32x4 o; o.x = f2bf(s[0]) | ((unsigned)f2bf(s[36]) << 16); o.y = f2bf(s[72]) | ((unsigned)f2bf(s[108]) << 16);
        o.z = f2bf(s[144]) | ((unsigned)f2bf(s[180]) << 16); o.w = f2bf(s[216]) | ((unsigned)f2bf(s[252]) << 16);
        *(u32x4*)(WT + (size_t)(d0 + n) * K + k0 + 8 * c) = o; }
    asm volatile("s_waitcnt lgkmcnt(0)" ::: "memory");
}

DI int t5_bucket(int dist) {
    if (dist < 16) return dist;
    float d = (float)dist;
    int large = 16 + (int)(logf(d / 16.0f) / 4.852030263919617f * 16.0f);
    return large < 31 ? large : 31;
}

template <int PART> DI void prep_weights(const Ctx& c, float* scr, int lane, int gw, int NGW) {
    unsigned char* ws = c.ws;
    constexpr int I0 = (2048 / 64) * (IN_EVEN / 32), I1 = (512 / 64) * (1536 / 32), I2 = (512 / 64) * (2048 / 32), I3 = (2048 / 64) * (2048 / 32),
                  I4 = (2048 / 64) * (IN_ODD / 32), I5 = I3;
    constexpr int LO = PART == 1 ? I0 : 0, HI = PART == 0 ? I0 : I0 + I1 + I2 + I3 + I4 + I5;
    for (int it = LO + gw; it < HI; it += NGW) {
        int r = it;
        if (r < I0) { transpose_item<0>(c.w_in_even, 2048, IN_EVEN, c.norm_gain, (bf16_t*)(ws + WS_WT_IN_E), scr, r, lane); continue; } r -= I0;
        if (r < I1) { transpose_item<1>(c.w_uq, 512, 1536, c.q_norm_gain, (bf16_t*)(ws + WS_WT_UQ), scr, r, lane); continue; } r -= I1;
        if (r < I2) { transpose_item<2>(c.w_ukv, 512, 2048, c.kv_norm_gain, (bf16_t*)(ws + WS_WT_UKV), scr, r, lane); continue; } r -= I2;
        if (r < I3) { transpose_item<3>(c.w_out_even, 2048, 2048, nullptr, (bf16_t*)(ws + WS_WT_OUT_E), scr, r, lane); continue; } r -= I3;
        if (r < I4) { transpose_item<3>(c.w_in_odd, 2048, IN_ODD, c.norm_gain + 2048, (bf16_t*)(ws + WS_WT_IN_O), scr, r, lane); continue; } r -= I4;
        transpose_item<3>(c.w_out_odd, 2048, 2048, nullptr, (bf16_t*)(ws + WS_WT_OUT_O), scr, r, lane);
    }
}
template <int NW, int PART> DI void prep_phase(const Ctx& c, float* scr_all, const int tid) {
    const int lane = tid & 63, wave = tid >> 6;
    float* scr = scr_all + wave * 64 * 36;
    const int gw = blockIdx.x * NW + wave, NGW = gridDim.x * NW;
    unsigned char* ws = c.ws;
    prep_weights<PART>(c, scr, lane, gw, NGW);
    const int gt = blockIdx.x * (NW * 64) + tid, NGT = gridDim.x * (NW * 64);
    { bf16_t* wt = (bf16_t*)(ws + WS_WT_IN_E);
      for (int i = gt; i < 192 * 256; i += NGT) { const int rr = i / 256, cc = i % 256; const int row = rr < 96 ? 1056 + rr : 1184 + (rr - 96);
          *(u32x4*)(wt + (size_t)row * 2048 + cc * 8) = (u32x4){0u, 0u, 0u, 0u}; } }
    { float* rc = (float*)(ws + WS_ROPE); float* rs = rc + 4096 * 32;
      for (int i = gt; i < 4096 * 32; i += NGT) { const int pos = i >> 5, j = i & 31; const float inv = 1.0f / powf(10000.0f, (float)j / 32.0f); const float ang = (float)pos * inv;
          rc[i] = cosf(ang); rs[i] = sinf(ang); } }
    { float* bn = (float*)(ws + WS_BIASN);
      for (int i = gt; i < 3 * 8 * 132; i += NGT) { const int p = i / (8 * 132), h = (i / 132) % 8, rel = i % 132; const int dil = p == 0 ? 1 : p == 1 ? 4 : 16;
          bn[i] = rel <= 128 ? c.rel_bias[t5_bucket(rel * dil) * 8 + h] * LOG2E : 0.f; } }
    { float* bc = (float*)(ws + WS_BIASC);
      for (int i = gt; i < 3 * 8 * 5 * 1024; i += NGT) { const int g = i & 15, ln = (i >> 4) & 63, di = (i >> 10) % 5, ph = i / 5120, h = ph & 7, p = ph >> 3; const int dil = p == 0 ? 1 : p == 1 ? 4 : 16;
          const int rel = 32 * di + (ln & 31) - ((g & 3) + 8 * (g >> 2) + 4 * (ln >> 5));
          bc[i] = (rel >= 0 && rel <= 128) ? c.rel_bias[t5_bucket(rel * dil) * 8 + h] * LOG2E : -INFINITY; } }
    { bf16_t* h0 = (bf16_t*)(ws + WS_H0); float* ssx = (float*)(ws + WS_SSX);
      for (int m = gw; m < M; m += NGW) { const f32x4* xr = (const f32x4*)(c.x + (size_t)m * D_MODEL) + lane; float s = 0.f;
          unsigned long long* o8 = (unsigned long long*)(h0 + (size_t)m * D_MODEL) + lane;
          for (int j = 0; j < 8; ++j) { const f32x4 v = xr[64 * j]; s += v.x * v.x + v.y * v.y + v.z * v.z + v.w * v.w;
              o8[64 * j] = (unsigned long long)(f2bf(v.x) | ((unsigned)f2bf(v.y) << 16)) | ((unsigned long long)(f2bf(v.z) | ((unsigned)f2bf(v.w) << 16)) << 32); }
          s = wave_sum(s); if (lane == 0) ssx[m] = s; } }
}

__global__ void __launch_bounds__(256) k_prep(Ctx c) { __shared__ float scr_all[4 * 64 * 36]; prep_phase<4, 2>(c, scr_all, (int)threadIdx.x); }

DI float rscale(const float* part, int n, float inv_cols) { float s = 0.f; for (int i = 0; i < n; ++i) s += part[i]; return rsqrtf(s * inv_cols + EPS); }

struct Epi1 {
    unsigned char* ws;
    DI void operator()(int row, int col, float acc) const {
        const float v = acc * rsqrtf(((const float*)(ws + WS_SSX))[row] * (1.0f / 2048.0f) + EPS);
        if (col < 512) ((bf16_t*)(ws + WS_CQ))[(size_t)row * 512 + col] = f2bf(v);
        else if (col < 1024) ((bf16_t*)(ws + WS_CKV))[(size_t)row * 512 + col - 512] = f2bf(v);
        else if (col < 1280) { const int t = col - 1024; if (t < 32) ((bf16_t*)(ws + WS_KR))[(size_t)row * 64 + t] = f2bf(v); else if (t >= 128 && t < 160) ((bf16_t*)(ws + WS_KR))[(size_t)row * 64 + 32 + t - 128] = f2bf(v); }
        else if (col < 2304) ((bf16_t*)(ws + WS_QB))[(size_t)row * 1024 + col - 1280] = f2bf(v * D128_QSCALE);
        else if (col < 3328) ((bf16_t*)(ws + WS_KB))[(size_t)row * 1024 + col - 2304] = f2bf(v);
        else if (col < 4352) ((bf16_t*)(ws + WS_VB))[(size_t)row * 1024 + col - 3328] = f2bf(v);
        else ((bf16_t*)(ws + WS_SG))[(size_t)row * 2048 + col - 4352] = f2bf(silu_f(v));
    }
};
struct Epi2a {
    unsigned char* ws;
    DI void operator()(int row, int col, float acc) const {
        const float v = acc * rscale((const float*)(ws + WS_SSC) + (size_t)row * 16, 8, 1.0f / 512.0f) * MLA_QSCALE;
        if (col < 1024) ((bf16_t*)(ws + WS_QN))[(size_t)row * 1024 + col] = f2bf(v);
        else { const int t = col - 1024, grp = t >> 8, u = t & 255, half = u >> 7, hh = (u & 127) >> 5, i = u & 31;
            ((bf16_t*)(ws + WS_QR))[(size_t)row * 512 + (4 * grp + hh) * 64 + half * 32 + i] = f2bf(v); }
    }
};
struct Epi2b {
    unsigned char* ws;
    DI void operator()(int row, int col, float acc) const {
        const float v = acc * rscale((const float*)(ws + WS_SSC) + (size_t)row * 16 + 8, 8, 1.0f / 512.0f);
        if (col < 1024) ((bf16_t*)(ws + WS_KN))[(size_t)row * 1024 + col] = f2bf(v); else ((bf16_t*)(ws + WS_VA))[(size_t)row * 1024 + col - 1024] = f2bf(v);
    }
};
struct Epi4 {
    unsigned char* ws; const float* x; float* out;
    DI void operator()(int row, int col, float acc) const {
        const float v = x[(size_t)row * 2048 + col] + acc; out[(size_t)row * 2048 + col] = v; ((bf16_t*)(ws + WS_X1BF))[(size_t)row * 2048 + col] = f2bf(v);
    }
};
struct Epi5 {
    unsigned char* ws;
    DI void operator()(int row, int col, float acc) const {
        const float v = acc * rscale((const float*)(ws + WS_SSX1) + (size_t)row * 32, 32, 1.0f / 2048.0f);
        if (col < 2048) ((bf16_t*)(ws + WS_Q2))[(size_t)row * 2048 + col] = f2bf(v * D128_QSCALE);
        else if (col < 4096) ((bf16_t*)(ws + WS_K2))[(size_t)row * 2048 + col - 2048] = f2bf(v);
        else if (col < 6144) ((bf16_t*)(ws + WS_V2))[(size_t)row * 2048 + col - 4096] = f2bf(v);
        else ((bf16_t*)(ws + WS_SG2))[(size_t)row * 2048 + col - 6144] = f2bf(silu_f(v));
    }
};
struct Epi7 {
    float* out;
    DI void operator()(int row, int col, float acc) const { out[(size_t)row * 2048 + col] += acc; }
};

namespace pg8 {
#define PG8_LAS __attribute__((address_space(3)))
typedef short bf16x8 __attribute__((ext_vector_type(8)));
constexpr int BM = 256, BK = 64, HALF = 128, HTB = HALF * BK * 2  , STAGE_BYTES = 8 * HTB, NXCD = 8, WGM = 8;

__host__ __device__ __forceinline__ int lds_byte(int r, int c) { const int st = (r >> 4) * 2 + (c >> 5), rr = r & 15, cc = c & 31, ob = rr * 64 + cc * 2; return st * 1024 + (ob ^ (((ob >> 9) & 1) << 5)); }
__host__ __device__ __forceinline__ void stage_rc(int b, int& R, int& C) { const int st = b / 1024, sb = b % 1024, swz = sb ^ (((sb >> 9) & 1) << 5); R = (st >> 1) * 16 + swz / 64; C = (st & 1) * 32 + (swz % 64) / 2; }
__host__ __device__ __forceinline__ int perm32(int rho) { const int n = rho >> 4, i = rho & 15; return 8 * (i >> 2) + 4 * n + (i & 3); }

struct Unit { int pm, pn; };
struct Gemm { const bf16_t* A; const bf16_t* Bt; int M, N, K; };

struct StaticOrder {
    int nM, nN, nwg, G, c, rep = 1;
    __host__ __device__ void init(int M, int N, int G_, int c_) { nM = M / BM; nN = N / BM; nwg = nM * nN; G = G_; c = c_; }
    __host__ __device__ bool next(int i, Unit& u) const {
        long L = (long)i * G + c; if (L >= (long)nwg * rep) return false; L %= nwg;
        int wgid = (int)L; { const int q = nwg / NXCD, r = nwg % NXCD, xcd = wgid % NXCD, off = wgid / NXCD; wgid = (xcd < r ? xcd * (q + 1) : r * (q + 1) + (xcd - r) * q) + off; }
        const int nig = WGM * nN, gid = wgid / nig, fm = gid * WGM, gsz = (nM - fm) < WGM ? (nM - fm) : WGM;
        u.pm = fm + ((wgid % nig) % gsz); u.pn = (wgid % nig) / gsz; return true;
    }
    __device__ __forceinline__ void a_ready(const Unit&) const {}
    __device__ __forceinline__ void done(const Unit&) const {}
};


typedef float f32x2_t __attribute__((ext_vector_type(2))); typedef __bf16 bf16x2_t __attribute__((ext_vector_type(2)));
__device__ __forceinline__ unsigned cvtpk(float lo, float hi) { f32x2_t v = {lo, hi}; bf16x2_t b = __builtin_convertvector(v, bf16x2_t); return __builtin_bit_cast(unsigned, b); }
__device__ __forceinline__ u32x4 pack8(const f32x4& a, const f32x4& b) { u32x4 w; w.x = cvtpk(a[0], a[1]); w.y = cvtpk(a[2], a[3]); w.z = cvtpk(b[0], b[1]); w.w = cvtpk(b[2], b[3]); return w; }
__device__ __forceinline__ float sumsq4(const f32x4& a) { return (a[0] * a[0] + a[1] * a[1]) + (a[2] * a[2] + a[3] * a[3]); }
__device__ __forceinline__ float silu1(float v) { return v * __builtin_amdgcn_rcpf(1.0f + __builtin_amdgcn_exp2f(-v * LOG2E)); }
__device__ __forceinline__ f32x4 silu4(const f32x4& a) { return (f32x4){silu1(a[0]), silu1(a[1]), silu1(a[2]), silu1(a[3])}; }
__device__ __forceinline__ float quad_sum(float s) { s += __shfl_xor(s, 16); s += __shfl_xor(s, 32); return s; }
__device__ __forceinline__ void rope8(const f32x4& a0, const f32x4& a1, const f32x4& b0, const f32x4& b1, const float* rc, const float* rs, int pos, int i0, u32x4& o1, u32x4& o2) {
    const f32x4 c0 = *(const f32x4*)(rc + pos * 32 + i0), c1 = *(const f32x4*)(rc + pos * 32 + i0 + 4), s0 = *(const f32x4*)(rs + pos * 32 + i0), s1 = *(const f32x4*)(rs + pos * 32 + i0 + 4);
    o1 = pack8(a0 * c0 - b0 * s0, a1 * c1 - b1 * s1); o2 = pack8(a0 * s0 + b0 * c0, a1 * s1 + b1 * c1);
}
#define PG8_EPI_ROWS(...) _Pragma("unroll") for (int ai = 0; ai < 2; ++ai) _Pragma("unroll") for (int m = 0; m < 4; ++m) { const int row = u.pm * BM + ai * HALF + wr * 64 + m * 16 + fr; __VA_ARGS__ }

struct FEpi1 {
    static constexpr bool PERM = true, AFTER_DRAIN = false; unsigned char* ws;
    __device__ __forceinline__ void operator()(const f32x4 (&acc)[2][2][4][2], const Unit& u, int wr, int wc, int fr, int fq) const {
        const int pn = u.pn, cw = wc * 32 + 8 * fq; const float* ssx = (const float*)(ws + WS_SSX);
        PG8_EPI_ROWS(
            const float rs = rsqrtf(ssx[row] * (1.0f / 2048.0f) + EPS);
            if (pn < 4) { bf16_t* dst = (bf16_t*)(ws + (pn < 2 ? WS_CQ : WS_CKV)) + (size_t)row * 512 + (pn & 1) * 256 + cw; float ss = 0.f;
                _Pragma("unroll") for (int bj = 0; bj < 2; ++bj) { const f32x4 v0 = acc[ai][bj][m][0] * rs, v1 = acc[ai][bj][m][1] * rs; ss += sumsq4(v0) + sumsq4(v1); *(u32x4*)(dst + bj * HALF) = pack8(v0, v1); }
                ss = quad_sum(ss); if (fq == 0) ((float*)(ws + WS_SSC))[(size_t)row * 16 + pn * 4 + wc] = ss; }
            else if (pn == 4) { if (wc == 0) { const float* rc = (const float*)(ws + WS_ROPE); u32x4 o1, o2;
                rope8(acc[ai][0][m][0] * rs, acc[ai][0][m][1] * rs, acc[ai][1][m][0] * rs, acc[ai][1][m][1] * rs, rc, rc + 4096 * 32, row % SEQ, 8 * fq, o1, o2);
                bf16_t* dst = (bf16_t*)(ws + WS_KR) + (size_t)row * 64 + 8 * fq; *(u32x4*)dst = o1; *(u32x4*)(dst + 32) = o2; } }
            else if (pn < 17) { const int t = pn - 5; bf16_t* dst = (bf16_t*)(ws + (t < 4 ? WS_QB : t < 8 ? WS_KB : WS_VB)) + (size_t)row * 1024 + (t & 3) * 256 + cw; const float sc = t < 4 ? rs * D128_QSCALE : rs;
                _Pragma("unroll") for (int bj = 0; bj < 2; ++bj) *(u32x4*)(dst + bj * HALF) = pack8(acc[ai][bj][m][0] * sc, acc[ai][bj][m][1] * sc); }
            else { bf16_t* dst = (bf16_t*)(ws + WS_SG) + (size_t)row * 2048 + (pn - 17) * 256 + cw;
                _Pragma("unroll") for (int bj = 0; bj < 2; ++bj) *(u32x4*)(dst + bj * HALF) = pack8(silu4(acc[ai][bj][m][0] * rs), silu4(acc[ai][bj][m][1] * rs)); }
        )
    }
};
struct FEpi2a {
    static constexpr bool PERM = true, AFTER_DRAIN = false; unsigned char* ws;
    __device__ __forceinline__ void operator()(const f32x4 (&acc)[2][2][4][2], const Unit& u, int wr, int wc, int fr, int fq) const {
        const int pn = u.pn, cw = wc * 32 + 8 * fq;
        PG8_EPI_ROWS(
            const f32x4* sp = (const f32x4*)((const float*)(ws + WS_SSC) + (size_t)row * 16); const f32x4 p0 = sp[0], p1 = sp[1];
            const float rs = rsqrtf(((p0[0] + p0[1]) + (p0[2] + p0[3]) + (p1[0] + p1[1]) + (p1[2] + p1[3])) * (1.0f / 512.0f) + EPS) * MLA_QSCALE;
            if (pn < 4) { bf16_t* dst = (bf16_t*)(ws + WS_QN) + (size_t)row * 1024 + pn * 256 + cw;
                _Pragma("unroll") for (int bj = 0; bj < 2; ++bj) *(u32x4*)(dst + bj * HALF) = pack8(acc[ai][bj][m][0] * rs, acc[ai][bj][m][1] * rs); }
            else { const float* rc = (const float*)(ws + WS_ROPE); u32x4 o1, o2; const int head = 4 * (pn - 4) + wc;
                rope8(acc[ai][0][m][0] * rs, acc[ai][0][m][1] * rs, acc[ai][1][m][0] * rs, acc[ai][1][m][1] * rs, rc, rc + 4096 * 32, row % SEQ, 8 * fq, o1, o2);
                bf16_t* dst = (bf16_t*)(ws + WS_QR) + (size_t)row * 512 + head * 64 + 8 * fq; *(u32x4*)dst = o1; *(u32x4*)(dst + 32) = o2; }
        )
    }
};
struct FEpi2b {
    static constexpr bool PERM = true, AFTER_DRAIN = false; unsigned char* ws;
    __device__ __forceinline__ void operator()(const f32x4 (&acc)[2][2][4][2], const Unit& u, int wr, int wc, int fr, int fq) const {
        const int pn = u.pn, cw = wc * 32 + 8 * fq;
        PG8_EPI_ROWS(
            const f32x4* sp = (const f32x4*)((const float*)(ws + WS_SSC) + (size_t)row * 16 + 8); const f32x4 p0 = sp[0], p1 = sp[1];
            const float rs = rsqrtf(((p0[0] + p0[1]) + (p0[2] + p0[3]) + (p1[0] + p1[1]) + (p1[2] + p1[3])) * (1.0f / 512.0f) + EPS);
            bf16_t* dst = (bf16_t*)(ws + (pn < 4 ? WS_KN : WS_VA)) + (size_t)row * 1024 + (pn & 3) * 256 + cw;
            _Pragma("unroll") for (int bj = 0; bj < 2; ++bj) *(u32x4*)(dst + bj * HALF) = pack8(acc[ai][bj][m][0] * rs, acc[ai][bj][m][1] * rs);
        )
    }
};
struct FEpi4 {
    static constexpr bool PERM = true, AFTER_DRAIN = false; unsigned char* ws; const float* x; float* out;
    __device__ __forceinline__ void operator()(const f32x4 (&acc)[2][2][4][2], const Unit& u, int wr, int wc, int fr, int fq) const {
        const int pn = u.pn, cw = pn * 256 + wc * 32 + 8 * fq;
        const size_t off0 = (size_t)(u.pm * BM + wr * 64 + fr) * 2048 + cw;
        f32x4 pre[2][4];
#define EPI4_LOAD(q, slot) { const float* p_ = x + off0 + (size_t)(((q) >> 2) * HALF + ((q) & 3) * 16) * 2048; pre[slot][0] = *(const f32x4*)p_; pre[slot][1] = *(const f32x4*)(p_ + 4); pre[slot][2] = *(const f32x4*)(p_ + HALF); pre[slot][3] = *(const f32x4*)(p_ + HALF + 4); }
        EPI4_LOAD(0, 0) EPI4_LOAD(1, 1)
#pragma unroll
        for (int q = 0; q < 8; ++q) { const int ai = q >> 2, m = q & 3; const size_t off = off0 + (size_t)(ai * HALF + m * 16) * 2048;
            const f32x4 v00 = pre[q & 1][0] + acc[ai][0][m][0], v01 = pre[q & 1][1] + acc[ai][0][m][1], v10 = pre[q & 1][2] + acc[ai][1][m][0], v11 = pre[q & 1][3] + acc[ai][1][m][1];
            if (q + 2 < 8) EPI4_LOAD(q + 2, q & 1)
            *(u32x4*)((bf16_t*)(ws + WS_X1BF) + off) = pack8(v00, v01); *(u32x4*)((bf16_t*)(ws + WS_X1BF) + off + HALF) = pack8(v10, v11);
            float ss = (sumsq4(v00) + sumsq4(v01)) + (sumsq4(v10) + sumsq4(v11));
            ss = quad_sum(ss); if (fq == 0) ((float*)(ws + WS_SSX1))[(size_t)(u.pm * BM + ai * HALF + wr * 64 + m * 16 + fr) * 32 + pn * 4 + wc] = ss; }
#undef EPI4_LOAD
    }
};
struct FEpi5 {
    static constexpr bool PERM = true, AFTER_DRAIN = false; unsigned char* ws;
    __device__ __forceinline__ void operator()(const f32x4 (&acc)[2][2][4][2], const Unit& u, int wr, int wc, int fr, int fq) const {
        const int pn = u.pn, cw = (pn & 7) * 256 + wc * 32 + 8 * fq; const int sel = pn >> 3;
        PG8_EPI_ROWS(
            const f32x4* sp = (const f32x4*)((const float*)(ws + WS_SSX1) + (size_t)row * 32 + 8 * fq); const f32x4 p0 = sp[0], p1 = sp[1];
            const float tot = quad_sum((p0[0] + p0[1]) + (p0[2] + p0[3]) + (p1[0] + p1[1]) + (p1[2] + p1[3]));
            const float rs = rsqrtf(tot * (1.0f / 2048.0f) + EPS);
            bf16_t* dst = (bf16_t*)(ws + (sel == 0 ? WS_Q2 : sel == 1 ? WS_K2 : sel == 2 ? WS_V2 : WS_SG2)) + (size_t)row * 2048 + cw;
            if (sel == 3) { _Pragma("unroll") for (int bj = 0; bj < 2; ++bj) *(u32x4*)(dst + bj * HALF) = pack8(silu4(acc[ai][bj][m][0] * rs), silu4(acc[ai][bj][m][1] * rs)); }
            else { const float sc = sel == 0 ? rs * D128_QSCALE : rs;
                _Pragma("unroll") for (int bj = 0; bj < 2; ++bj) *(u32x4*)(dst + bj * HALF) = pack8(acc[ai][bj][m][0] * sc, acc[ai][bj][m][1] * sc); }
        )
    }
};
struct FEpi7 {
    static constexpr bool PERM = true, AFTER_DRAIN = false; bf16_t* x2; const bf16_t* x1;
    __device__ __forceinline__ void operator()(const f32x4 (&acc)[2][2][4][2], const Unit& u, int wr, int wc, int fr, int fq) const {
        const int cw = u.pn * 256 + wc * 32 + 8 * fq;
        const size_t off0 = (size_t)(u.pm * BM + wr * 64 + fr) * 2048 + cw;
        u32x4 pre[2][2];
#define EPI7_LOAD(q, slot) { const bf16_t* p_ = x1 + off0 + (size_t)(((q) >> 2) * HALF + ((q) & 3) * 16) * 2048; pre[slot][0] = *(const u32x4*)p_; pre[slot][1] = *(const u32x4*)(p_ + HALF); }
        EPI7_LOAD(0, 0) EPI7_LOAD(1, 1)
#pragma unroll
        for (int q = 0; q < 8; ++q) { const int ai = q >> 2, m = q & 3; const size_t off = off0 + (size_t)(ai * HALF + m * 16) * 2048;
            const u32x4 r0 = pre[q & 1][0], r1 = pre[q & 1][1];
            if (q + 2 < 8) EPI7_LOAD(q + 2, q & 1)
#define BFLO(w) __uint_as_float((w) << 16)
#define BFHI(w) __uint_as_float((w) & 0xffff0000u)
            *(u32x4*)(x2 + off) = pack8((f32x4){BFLO(r0[0]), BFHI(r0[0]), BFLO(r0[1]), BFHI(r0[1])} + acc[ai][0][m][0], (f32x4){BFLO(r0[2]), BFHI(r0[2]), BFLO(r0[3]), BFHI(r0[3])} + acc[ai][0][m][1]);
            *(u32x4*)(x2 + off + HALF) = pack8((f32x4){BFLO(r1[0]), BFHI(r1[0]), BFLO(r1[1]), BFHI(r1[1])} + acc[ai][1][m][0], (f32x4){BFLO(r1[2]), BFHI(r1[2]), BFLO(r1[3]), BFHI(r1[3])} + acc[ai][1][m][1]); }
#undef BFLO
#undef BFHI
#undef EPI7_LOAD
    }
};
template <class Epi, class Sched, bool ALIGN_EPI = false, bool SP2 = false>
__device__ __forceinline__ void gemm_phase(PG8_LAS unsigned char* lds, const Gemm g, const Sched& S, const Epi& E, const int tid) {
    const int wid = __builtin_amdgcn_readfirstlane(tid >> 6), lane = tid & 63, wr = wid >> 2, wc = wid & 3, fr = lane & 15, fq = lane >> 4;
    const int K = g.K, nt = K / BK;
    unsigned voffA[2], voffB[2];
#pragma unroll
    for (int i = 0; i < 2; ++i) { int R, C; stage_rc(tid * 16 + i * 8192, R, C); const int Rb = Epi::PERM ? ((R & ~31) + perm32(R & 31)) : R;
        voffA[i] = (unsigned)(R * K + C) * 2u; voffB[i] = (unsigned)(Rb * K + C) * 2u; }
    const size_t kstep = (size_t)(BK * 2);
    const size_t hstep = (size_t)HALF * K * 2;
    const size_t tstep = 2 * hstep;
    const unsigned ldsw = (unsigned)wid * 1024u;
    const int aoff = lds_byte(wr * 64 + fr, fq * 8), boff = lds_byte(wc * 32 + fr, fq * 8);
#define PG8_SA(b, h) (((b) * 2 + (h)) * HTB)
#define PG8_SB(b, h) ((4 + (b) * 2 + (h)) * HTB)
#define PG8_STAGE(bufoff, gbase, voff) do { _Pragma("unroll") for (int _i = 0; _i < 2; ++_i) \
        __builtin_amdgcn_global_load_lds((const unsigned*)((const char*)(gbase) + (voff)[_i]), (PG8_LAS unsigned*)(lds + (bufoff) + ldsw + _i * 8192), 16, 0, 0); } while (0)
#define PG8_LDA(dst, b, h) do { _Pragma("unroll") for (int m = 0; m < 4; ++m) _Pragma("unroll") for (int k = 0; k < 2; ++k) dst[m][k] = *(const PG8_LAS bf16x8*)(lds + PG8_SA(b, h) + aoff + m * 2048 + k * 1024); } while (0)
#define PG8_LDB(dst, b, h) do { _Pragma("unroll") for (int n = 0; n < 2; ++n) _Pragma("unroll") for (int k = 0; k < 2; ++k) dst[n][k] = *(const PG8_LAS bf16x8*)(lds + PG8_SB(b, h) + boff + n * 2048 + k * 1024); } while (0)
#define PG8_MMA(ai, bj, At, Bt) do { __builtin_amdgcn_s_setprio(1); _Pragma("unroll") for (int m = 0; m < 4; ++m) _Pragma("unroll") for (int n = 0; n < 2; ++n) _Pragma("unroll") for (int k = 0; k < 2; ++k) \
        acc[ai][bj][m][n] = __builtin_amdgcn_mfma_f32_16x16x32_bf16(Bt[n][k], At[m][k], acc[ai][bj][m][n], 0, 0, 0); __builtin_amdgcn_s_setprio(0); } while (0)
#define PG8_WAIT_V(n) asm volatile("s_waitcnt vmcnt(" #n ")" ::: "memory")
#define PG8_WAIT_L(n) asm volatile("s_waitcnt lgkmcnt(" #n ")" ::: "memory")
#define PG8_BAR __builtin_amdgcn_s_barrier()
#define PG8_SCHED __builtin_amdgcn_sched_barrier(0)
    Unit cur, nxt; int ui = 0;
    if (!S.next(0, cur)) return;
    f32x4 acc[2][2][4][2];
#pragma unroll
    for (int a = 0; a < 2; ++a)
#pragma unroll
        for (int b = 0; b < 2; ++b)
#pragma unroll
            for (int m = 0; m < 4; ++m)
#pragma unroll
                for (int n = 0; n < 2; ++n) acc[a][b][m][n] = (f32x4){0.f, 0.f, 0.f, 0.f};
    bf16x8 At[4][2], B0[2][2], B1[2][2];
    const char* cA = (const char*)g.A + (size_t)cur.pm * tstep; const char* cB = (const char*)g.Bt + (size_t)cur.pn * tstep;
    S.a_ready(cur);
    if constexpr (SP2) {
        PG8_STAGE(PG8_SB(0, 0), cB, voffB); PG8_STAGE(PG8_SB(0, 1), cB + hstep, voffB); PG8_STAGE(PG8_SA(0, 0), cA, voffA); PG8_STAGE(PG8_SA(0, 1), cA + hstep, voffA);
        if (wr == 1) PG8_BAR;
        PG8_WAIT_V(2); PG8_BAR;
        PG8_STAGE(PG8_SB(1, 0), cB + kstep, voffB); PG8_STAGE(PG8_SA(1, 0), cA + kstep, voffA); PG8_STAGE(PG8_SB(1, 1), cB + hstep + kstep, voffB);
        PG8_WAIT_V(6); PG8_BAR;
    } else {
        PG8_STAGE(PG8_SB(0, 0), cB, voffB); PG8_STAGE(PG8_SA(0, 0), cA, voffA); PG8_STAGE(PG8_SB(0, 1), cB + hstep, voffB); PG8_STAGE(PG8_SA(0, 1), cA + hstep, voffA);
        if (wr == 1) PG8_BAR;
        PG8_WAIT_V(4); PG8_BAR;
        PG8_STAGE(PG8_SB(1, 0), cB + kstep, voffB); PG8_STAGE(PG8_SA(1, 0), cA + kstep, voffA); PG8_STAGE(PG8_SB(1, 1), cB + hstep + kstep, voffB);
        PG8_WAIT_V(6); PG8_BAR;
    }
    for (;;) {
        const bool has_next = S.next(ui + 1, nxt);
        const char* nA = has_next ? (const char*)g.A + (size_t)nxt.pm * tstep : cA; const char* nB = has_next ? (const char*)g.Bt + (size_t)nxt.pn * tstep : cB;
        for (int t = 0; t < nt; t += 2) {
            const bool last = (t == nt - 2);
            const char* a1 = cA + (size_t)(t + 1) * kstep;
            const char* a2 = last ? nA : cA + (size_t)(t + 2) * kstep; const char* b2 = last ? nB : cB + (size_t)(t + 2) * kstep;
            const char* a3 = a2 + kstep; const char* b3 = b2 + kstep;
            if (last && has_next) S.a_ready(nxt);
            if constexpr (SP2) {
            PG8_LDB(B0, 0, 0); PG8_LDB(B1, 0, 1); PG8_SCHED; PG8_LDA(At, 0, 0); PG8_STAGE(PG8_SA(1, 1), a1 + hstep, voffA);
            PG8_WAIT_V(8); PG8_WAIT_L(0); PG8_BAR; PG8_MMA(0, 0, At, B0); PG8_MMA(0, 1, At, B1); PG8_BAR; PG8_SCHED;
            PG8_LDA(At, 0, 1); PG8_STAGE(PG8_SB(0, 0), b2, voffB); PG8_STAGE(PG8_SB(0, 1), b2 + hstep, voffB); PG8_STAGE(PG8_SA(0, 0), a2, voffA);
            PG8_WAIT_V(8); PG8_WAIT_L(0); PG8_BAR; PG8_MMA(1, 0, At, B0); PG8_MMA(1, 1, At, B1); PG8_BAR; PG8_SCHED;
            PG8_LDB(B0, 1, 0); PG8_LDB(B1, 1, 1); PG8_SCHED; PG8_LDA(At, 1, 0); PG8_STAGE(PG8_SA(0, 1), a2 + hstep, voffA);
            PG8_WAIT_V(8); PG8_WAIT_L(0); PG8_BAR; PG8_MMA(0, 0, At, B0); PG8_MMA(0, 1, At, B1); PG8_BAR; PG8_SCHED;
            PG8_LDA(At, 1, 1); PG8_STAGE(PG8_SB(1, 0), b3, voffB); PG8_STAGE(PG8_SB(1, 1), b3 + hstep, voffB); PG8_STAGE(PG8_SA(1, 0), a3, voffA);
            PG8_WAIT_V(8); PG8_WAIT_L(0); PG8_BAR; PG8_MMA(1, 0, At, B0); PG8_MMA(1, 1, At, B1); PG8_BAR; PG8_SCHED;
            } else {
            PG8_LDB(B0, 0, 0); PG8_SCHED; PG8_LDA(At, 0, 0); PG8_STAGE(PG8_SA(1, 1), a1 + hstep, voffA);
            PG8_WAIT_L(8); PG8_BAR; PG8_WAIT_L(0); PG8_MMA(0, 0, At, B0); PG8_BAR; PG8_SCHED;
            PG8_LDB(B1, 0, 1); PG8_STAGE(PG8_SB(0, 0), b2, voffB);
            PG8_BAR; PG8_WAIT_L(0); PG8_MMA(0, 1, At, B1); PG8_BAR;
            PG8_LDA(At, 0, 1); PG8_STAGE(PG8_SA(0, 0), a2, voffA);
            PG8_BAR; PG8_WAIT_L(0); PG8_MMA(1, 0, At, B0); PG8_BAR; PG8_SCHED;
            PG8_STAGE(PG8_SB(0, 1), b2 + hstep, voffB);
            PG8_WAIT_V(6); PG8_BAR; PG8_MMA(1, 1, At, B1); PG8_BAR;
            PG8_LDB(B0, 1, 0); PG8_SCHED; PG8_LDA(At, 1, 0); PG8_STAGE(PG8_SA(0, 1), a2 + hstep, voffA);
            PG8_WAIT_L(8); PG8_BAR; PG8_WAIT_L(0); PG8_MMA(0, 0, At, B0); PG8_BAR; PG8_SCHED;
            PG8_LDB(B1, 1, 1); PG8_STAGE(PG8_SB(1, 0), b3, voffB);
            PG8_BAR; PG8_WAIT_L(0); PG8_MMA(0, 1, At, B1); PG8_BAR;
            PG8_LDA(At, 1, 1); PG8_STAGE(PG8_SA(1, 0), a3, voffA);
            PG8_BAR; PG8_WAIT_L(0); PG8_MMA(1, 0, At, B0); PG8_BAR; PG8_SCHED;
            PG8_STAGE(PG8_SB(1, 1), b3 + hstep, voffB);
            PG8_WAIT_V(6); PG8_BAR; PG8_MMA(1, 1, At, B1); PG8_BAR;
            }
        }
        if constexpr (ALIGN_EPI) { if (wr == 0) PG8_BAR; }
        if constexpr (!Epi::AFTER_DRAIN) { E(acc, cur, wr, wc, fr, fq); S.done(cur); }
        if (!has_next) break;
#pragma unroll
        for (int a = 0; a < 2; ++a)
#pragma unroll
            for (int b = 0; b < 2; ++b)
#pragma unroll
                for (int m = 0; m < 4; ++m)
#pragma unroll
                    for (int n = 0; n < 2; ++n) acc[a][b][m][n] = (f32x4){0.f, 0.f, 0.f, 0.f};
        cur = nxt; cA = nA; cB = nB; ++ui;
        if constexpr (ALIGN_EPI) { if (wr == 1) PG8_BAR; }
    }
    PG8_WAIT_V(0);
    if constexpr (!ALIGN_EPI) { if (wr == 0) PG8_BAR; }
    PG8_BAR;
    if constexpr (Epi::AFTER_DRAIN) { E.fused(acc, cur, wr, wc, fr, fq, lds, wid, lane); S.done(cur); }
#undef PG8_SA
#undef PG8_SB
#undef PG8_STAGE
#undef PG8_LDA
#undef PG8_LDB
#undef PG8_MMA
#undef PG8_WAIT_V
#undef PG8_WAIT_L
#undef PG8_BAR
#undef PG8_SCHED
}
}

#define LAS __attribute__((address_space(3)))
template <class Epi> __global__ void __launch_bounds__(512, 2) k_gemm_fast(pg8::Gemm g, Epi E) {
    extern __shared__ __attribute__((aligned(16))) unsigned char lds[];
    pg8::StaticOrder S; S.init(g.M, g.N, (int)gridDim.x, (int)blockIdx.x);
    pg8::gemm_phase<Epi, pg8::StaticOrder, true, true>((LAS unsigned char*)lds, g, S, E, (int)threadIdx.x);
}

template <class Epi>
__global__ void __launch_bounds__(256) k_gemm_naive(const bf16_t* A, const bf16_t* Bt, int N, int K, Epi epi) {
    __shared__ float As[64][33], Bs[64][33];
    const int tid = threadIdx.x, tx = tid & 15, ty = tid >> 4;
    const int nbn = N / 64; const int bm = blockIdx.x / nbn, bn = blockIdx.x % nbn;
    float acc[4][4] = {};
    const int lr = tid >> 2, lc = (tid & 3) * 8;
    for (int k0 = 0; k0 < K; k0 += 32) {
        const u32x4 av = *(const u32x4*)(A + (size_t)(bm * 64 + lr) * K + k0 + lc);
        const u32x4 bv = *(const u32x4*)(Bt + (size_t)(bn * 64 + lr) * K + k0 + lc);
        __syncthreads();
#pragma unroll
        for (int j = 0; j < 4; ++j) { As[lr][lc + 2 * j] = __uint_as_float(av[j] << 16); As[lr][lc + 2 * j + 1] = __uint_as_float(av[j] & 0xffff0000u);
                                      Bs[lr][lc + 2 * j] = __uint_as_float(bv[j] << 16); Bs[lr][lc + 2 * j + 1] = __uint_as_float(bv[j] & 0xffff0000u); }
        __syncthreads();
#pragma unroll 8
        for (int kk = 0; kk < 32; ++kk) { float a[4], b[4];
#pragma unroll
            for (int i = 0; i < 4; ++i) { a[i] = As[ty * 4 + i][kk]; b[i] = Bs[tx * 4 + i][kk]; }
#pragma unroll
            for (int i = 0; i < 4; ++i)
#pragma unroll
                for (int j = 0; j < 4; ++j) acc[i][j] += a[i] * b[j]; }
    }
#pragma unroll
    for (int i = 0; i < 4; ++i)
#pragma unroll
        for (int j = 0; j < 4; ++j) epi(bm * 64 + ty * 4 + i, bn * 64 + tx * 4 + j, acc[i][j]);
}

template <bool F32>
__global__ void __launch_bounds__(256) k_rowss(const void* src, int ld, int ncols, float* dst, int dst_ld, int nslots) {
    const int lane = threadIdx.x & 63, row = blockIdx.x * 4 + (threadIdx.x >> 6);
    float s = 0.f;
    for (int c = lane; c < ncols; c += 64) { const float v = F32 ? ((const float*)src)[(size_t)row * ld + c] : bf2f(((const bf16_t*)src)[(size_t)row * ld + c]); s += v * v; }
    s = wave_sum(s);
    if (lane < nslots) dst[(size_t)row * dst_ld + lane] = lane == 0 ? s : 0.f;
}

__global__ void __launch_bounds__(256) k_rope(bf16_t* buf, int nh, const float* rc, const float* rs) {
    const int idx = blockIdx.x * 256 + threadIdx.x; const int per_row = nh * 32; if (idx >= M * per_row) return;
    const int row = idx / per_row, t = idx % per_row, h = t >> 5, i = t & 31, pos = row % SEQ;
    bf16_t* p = buf + (size_t)row * nh * 64 + h * 64; const float x1 = bf2f(p[i]), x2 = bf2f(p[32 + i]); const float cs = rc[pos * 32 + i], sn = rs[pos * 32 + i];
    p[i] = f2bf(x1 * cs - x2 * sn); p[32 + i] = f2bf(x1 * sn + x2 * cs);
}

template <int D> DI float dot_row(const float* q, const bf16_t* k) {
    float s = 0.f;
#pragma unroll
    for (int d = 0; d < D; d += 8) { const u32x4 v = *(const u32x4*)(k + d);
#pragma unroll
        for (int j = 0; j < 4; ++j) { s += q[d + 2 * j] * __uint_as_float(v[j] << 16); s += q[d + 2 * j + 1] * __uint_as_float(v[j] & 0xffff0000u); } }
    return s;
}

__global__ void __launch_bounds__(256) k_mla_naive(Ctx c) {
    __shared__ float qs[4][192];
    const int lane = threadIdx.x & 63, w = threadIdx.x >> 6; const int gq = blockIdx.x * 4 + w;
    const int t = gq % SEQ, bh = gq / SEQ, h = bh % 8, b = bh / 8; const size_t row = (size_t)b * SEQ + t;
    unsigned char* ws = c.ws;
    const bf16_t *QN = (const bf16_t*)(ws + WS_QN), *QR = (const bf16_t*)(ws + WS_QR), *KN = (const bf16_t*)(ws + WS_KN), *KR = (const bf16_t*)(ws + WS_KR), *VA = (const bf16_t*)(ws + WS_VA), *SG = (const bf16_t*)(ws + WS_SG);
    for (int d = lane; d < 192; d += 64) qs[w][d] = d < 128 ? bf2f(QN[row * 1024 + h * 128 + d]) : bf2f(QR[row * 512 + h * 64 + d - 128]);
    __syncthreads();
    float m = -INFINITY, l = 0.f, o0 = 0.f, o1 = 0.f;
    for (int j0 = 0; j0 <= t; j0 += 64) {
        const int j = j0 + lane; const bool valid = j <= t; const size_t krow = (size_t)b * SEQ + (valid ? j : t);
        float s = dot_row<128>(qs[w], KN + krow * 1024 + h * 128) + dot_row<64>(qs[w] + 128, KR + krow * 64);
        if (!valid) s = -INFINITY;
        const float mn = fmaxf(m, wave_max(s)); const float alpha = exp2f(m - mn); const float p = valid ? exp2f(s - mn) : 0.f;
        l = l * alpha + wave_sum(p); o0 *= alpha; o1 *= alpha; m = mn;
        const int nj = min(64, t - j0 + 1);
        for (int jj = 0; jj < nj; ++jj) { const float pj = __shfl(p, jj); const bf16_t* vr = VA + ((size_t)b * SEQ + j0 + jj) * 1024 + h * 128; o0 += pj * bf2f(vr[lane]); o1 += pj * bf2f(vr[lane + 64]); }
    }
    bf16_t* MIX = (bf16_t*)(ws + WS_MIX); const float il = 1.0f / l;
    MIX[row * 2048 + h * 128 + lane] = f2bf(o0 * il * bf2f(SG[row * 2048 + h * 128 + lane]));
    MIX[row * 2048 + h * 128 + lane + 64] = f2bf(o1 * il * bf2f(SG[row * 2048 + h * 128 + lane + 64]));
}

__global__ void __launch_bounds__(256) k_dil_naive(Ctx c) {
    __shared__ float qs[4][128];
    const int lane = threadIdx.x & 63, w = threadIdx.x >> 6; const int gq = blockIdx.x * 4 + w;
    const int t = gq % SEQ, bh = gq / SEQ, h = bh % 8, b = bh / 8; const size_t row = (size_t)b * SEQ + t;
    unsigned char* ws = c.ws;
    const bf16_t *QB = (const bf16_t*)(ws + WS_QB), *KB = (const bf16_t*)(ws + WS_KB), *VB = (const bf16_t*)(ws + WS_VB);
    const float* bn = (const float*)(ws + WS_BIASN);
    for (int d = lane; d < 128; d += 64) qs[w][d] = bf2f(QB[row * 1024 + h * 128 + d]);
    __syncthreads();
    for (int p = 0; p < 3; ++p) { const int dil = p == 0 ? 1 : p == 1 ? 4 : 16;
        float m = -INFINITY, l = 0.f, o0 = 0.f, o1 = 0.f;
        for (int r0 = 0; r0 < 192; r0 += 64) {
            const int rel = r0 + lane; const int j = t - rel * dil; const bool valid = rel <= 128 && j >= 0; const size_t krow = (size_t)b * SEQ + (valid ? j : t);
            float s = dot_row<128>(qs[w], KB + krow * 1024 + h * 128) + bn[(p * 8 + h) * 132 + (valid ? rel : 0)];
            if (!valid) s = -INFINITY;
            const float mn = fmaxf(m, wave_max(s));
            const float alpha = exp2f(m - mn); const float pp = valid ? exp2f(s - mn) : 0.f;
            l = l * alpha + wave_sum(pp); o0 *= alpha; o1 *= alpha; m = mn;
            for (int jj = 0; jj < 64; ++jj) { const float pj = __shfl(pp, jj); if (pj != 0.f) { const int jr = t - (r0 + jj) * dil; const bf16_t* vr = VB + ((size_t)b * SEQ + jr) * 1024 + h * 128; o0 += pj * bf2f(vr[lane]); o1 += pj * bf2f(vr[lane + 64]); } }
        }
        bf16_t* OP = (bf16_t*)(ws + (p == 0 ? WS_OP0 : p == 1 ? WS_OP1 : WS_OP2)); const float il = 1.0f / l;
        OP[row * 1024 + h * 128 + lane] = f2bf(o0 * il); OP[row * 1024 + h * 128 + lane + 64] = f2bf(o1 * il);
        if (lane == 0) ((float*)(ws + WS_LSE))[((size_t)p * M + row) * 8 + h] = m + log2f(l);
    }
}

DI void dil_merge_item(unsigned char* ws, int row, int col) {
    const int h = col >> 7; const float* lse = (const float*)(ws + WS_LSE);
    const float l0 = lse[((size_t)0 * M + row) * 8 + h], l1 = lse[((size_t)1 * M + row) * 8 + h], l2 = lse[((size_t)2 * M + row) * 8 + h];
    const float mx = fmaxf(l0, fmaxf(l1, l2)); float w0 = exp2f(l0 - mx), w1 = exp2f(l1 - mx), w2 = exp2f(l2 - mx); const float inv = 1.0f / (w0 + w1 + w2); w0 *= inv; w1 *= inv; w2 *= inv;
    const u32x4 a0 = *(const u32x4*)((const bf16_t*)(ws + WS_OP0) + (size_t)row * 1024 + col), a1 = *(const u32x4*)((const bf16_t*)(ws + WS_OP1) + (size_t)row * 1024 + col),
                a2 = *(const u32x4*)((const bf16_t*)(ws + WS_OP2) + (size_t)row * 1024 + col), sg = *(const u32x4*)((const bf16_t*)(ws + WS_SG) + (size_t)row * 2048 + 1024 + col);
    u32x4 o;
#pragma unroll
    for (int j = 0; j < 4; ++j) {
        const float lo = (w0 * __uint_as_float(a0[j] << 16) + w1 * __uint_as_float(a1[j] << 16) + w2 * __uint_as_float(a2[j] << 16)) * __uint_as_float(sg[j] << 16);
        const float hi = (w0 * __uint_as_float(a0[j] & 0xffff0000u) + w1 * __uint_as_float(a1[j] & 0xffff0000u) + w2 * __uint_as_float(a2[j] & 0xffff0000u)) * __uint_as_float(sg[j] & 0xffff0000u);
        o[j] = (unsigned)f2bf(lo) | ((unsigned)f2bf(hi) << 16); }
    *(u32x4*)((bf16_t*)(ws + WS_MIX) + (size_t)row * 2048 + 1024 + col) = o;
}
__global__ void __launch_bounds__(128) k_dil_merge(Ctx c) { dil_merge_item(c.ws, blockIdx.x, threadIdx.x * 8); }

__global__ void __launch_bounds__(256) k_sb_naive(Ctx c) {
    __shared__ float qs[4][128];
    const int lane = threadIdx.x & 63, w = threadIdx.x >> 6; const int gq = blockIdx.x * 4 + w;
    const int t = gq % SEQ, bh = gq / SEQ, h = bh % 16, b = bh / 16; const size_t row = (size_t)b * SEQ + t;
    unsigned char* ws = c.ws;
    const bf16_t *Q2 = (const bf16_t*)(ws + WS_Q2), *K2 = (const bf16_t*)(ws + WS_K2), *V2 = (const bf16_t*)(ws + WS_V2), *SG2 = (const bf16_t*)(ws + WS_SG2);
    for (int d = lane; d < 128; d += 64) qs[w][d] = bf2f(Q2[row * 2048 + h * 128 + d]);
    __syncthreads();
    float carry = 0.f, o0 = 0.f, o1 = 0.f;
    for (int c0 = 0; c0 < t; c0 += 64) {
        const int j = t - 1 - c0 - lane; const bool valid = j >= 0; const size_t krow = (size_t)b * SEQ + (valid ? j : 0);
        const float z = dot_row<128>(qs[w], K2 + krow * 2048 + h * 128);
        const float sp = fmaxf(z, 0.f) + log2f(1.0f + exp2f(-fabsf(z)));
        const float L = valid ? -sp : 0.f;
        float incl = L;
#pragma unroll
        for (int o = 1; o < 64; o <<= 1) { const float v = __shfl_up(incl, o); if (lane >= o) incl += v; }
        const float between = carry + (incl - L);
        const float a = valid ? exp2f(z - sp + between) : 0.f;
        carry += __shfl(incl, 63);
        const int nj = min(64, t - c0);
        for (int jj = 0; jj < nj; ++jj) { const float aj = __shfl(a, jj); const bf16_t* vr = V2 + ((size_t)b * SEQ + t - 1 - c0 - jj) * 2048 + h * 128; o0 += aj * bf2f(vr[lane]); o1 += aj * bf2f(vr[lane + 64]); }
    }
    bf16_t* MIX2 = (bf16_t*)(ws + WS_MIX2);
    MIX2[row * 2048 + h * 128 + lane] = f2bf(o0 * bf2f(SG2[row * 2048 + h * 128 + lane]));
    MIX2[row * 2048 + h * 128 + lane + 64] = f2bf(o1 * bf2f(SG2[row * 2048 + h * 128 + lane + 64]));
}

#ifndef MLA_PIPE
#define MLA_PIPE 1
#endif
namespace att {
typedef short bf16x8 __attribute__((ext_vector_type(8)));
typedef short s16x4 __attribute__((ext_vector_type(4)));
typedef short v4i16_t __attribute__((ext_vector_type(4)));
typedef float f32x16 __attribute__((ext_vector_type(16)));
typedef _Float16 f16x8 __attribute__((ext_vector_type(8)));
typedef _Float16 f16x2 __attribute__((ext_vector_type(2)));
typedef float f32x2_t __attribute__((ext_vector_type(2))); typedef __bf16 bf16x2_t __attribute__((ext_vector_type(2)));
typedef LAS const unsigned char* lcp;
#define MFMA_BF16(a, b, c) __builtin_amdgcn_mfma_f32_32x32x16_bf16((a), (b), (c), 0, 0, 0)
#define MFMA_F16(a, b, c) __builtin_amdgcn_mfma_f32_32x32x16_f16((a), (b), (c), 0, 0, 0)
#define SBAR() __builtin_amdgcn_sched_barrier(0)
DI int crow(int g, int h) { return (g & 3) + 8 * (g >> 2) + 4 * h; }
DI unsigned off_b(unsigned row, unsigned ch) { return 256u * row + 16u * (ch ^ (((row & 3) << 2) | ((row >> 2) & 3))); }
DI unsigned cvtpk(float lo, float hi) { f32x2_t v = {lo, hi}; bf16x2_t b = __builtin_convertvector(v, bf16x2_t); return __builtin_bit_cast(unsigned, b); }
DI unsigned cvtpk_h(float lo, float hi) { f32x2_t v = {lo, hi}; f16x2 b = __builtin_convertvector(v, f16x2); return __builtin_bit_cast(unsigned, b); }
DI bf16x8 pack_bf(const f32x16& x, int s) { u32x4 p; p.x = cvtpk(x[8 * s], x[8 * s + 1]); p.y = cvtpk(x[8 * s + 2], x[8 * s + 3]); p.z = cvtpk(x[8 * s + 4], x[8 * s + 5]); p.w = cvtpk(x[8 * s + 6], x[8 * s + 7]); return __builtin_bit_cast(bf16x8, p); }
DI f16x8 pack_h(const f32x16& x, int s) { u32x4 p; p.x = cvtpk_h(x[8 * s], x[8 * s + 1]); p.y = cvtpk_h(x[8 * s + 2], x[8 * s + 3]); p.z = cvtpk_h(x[8 * s + 4], x[8 * s + 5]); p.w = cvtpk_h(x[8 * s + 6], x[8 * s + 7]); return __builtin_bit_cast(f16x8, p); }
DI s16x4 vtr(lcp p) { return __builtin_bit_cast(s16x4, __builtin_amdgcn_ds_read_tr16_b64_v4i16((LAS v4i16_t*)p)); }
DI float swap_max(float m) { auto rr = __builtin_amdgcn_permlane32_swap(__float_as_uint(m), __float_as_uint(m), false, false); return fmaxf(__uint_as_float(rr[0]), __uint_as_float(rr[1])); }
DI float swap_sum(float m) { auto rr = __builtin_amdgcn_permlane32_swap(__float_as_uint(m), __float_as_uint(m), false, false); return __uint_as_float(rr[0]) + __uint_as_float(rr[1]); }
DI float bcast_lo(float m) { auto rr = __builtin_amdgcn_permlane32_swap(__float_as_uint(m), __float_as_uint(m), false, false); return __uint_as_float(rr[0]); }
DI void o_pair8(const f32x16& o, int p, float (&e)[8]) {
#pragma unroll
    for (int i = 0; i < 4; ++i) { auto rr = __builtin_amdgcn_permlane32_swap(__float_as_uint(o[8 * p + i]), __float_as_uint(o[8 * p + 4 + i]), false, false); e[i] = __uint_as_float(rr[0]); e[4 + i] = __uint_as_float(rr[1]); }
}
DI __amdgpu_buffer_rsrc_t mk_rsrc(const void* p, unsigned bytes) { return __builtin_amdgcn_make_buffer_rsrc((void*)p, 0, bytes, 0x00020000); }
DI u32x4 bload(__amdgpu_buffer_rsrc_t rs, unsigned voff, unsigned soff) { return __builtin_amdgcn_raw_buffer_load_b128(rs, voff, soff, 0); }
struct VAddr { unsigned a[2][4]; };
DI VAddr make_vaddr(int lane) { VAddr v; const unsigned hh = lane >> 5, blk = (lane >> 4) & 1, qq = (lane & 15) >> 2, p = lane & 3;
#pragma unroll
    for (int t = 0; t < 2; ++t)
#pragma unroll
        for (int d0 = 0; d0 < 4; ++d0) v.a[t][d0] = off_b(8 * t + 4 * hh + qq, 4 * d0 + 2 * blk + (p >> 1)) + 8 * (p & 1);
    return v; }
DI bf16x8 vfrag(lcp img, int s, int d0, const VAddr& va) {
    const s16x4 lo = vtr(img + 4096 * s + va.a[0][d0]);
    const s16x4 hi = vtr(img + 4096 * s + va.a[1][d0]);
    return (bf16x8){lo[0], lo[1], lo[2], lo[3], hi[0], hi[1], hi[2], hi[3]};
}
DI void softmax_tile(f32x16& s0, f32x16& s1, f32x16 (&o)[4], float& mrun, float& lrun) {
    float mt = fmaxf(s0[0], s1[0]);
#pragma unroll
    for (int g = 1; g < 16; ++g) mt = fmaxf(mt, fmaxf(s0[g], s1[g]));
    mt = swap_max(mt);
    const float mn = fmaxf(mrun, mt), alpha = __builtin_amdgcn_exp2f(mrun - mn); mrun = mn;
    float ps = 0.f;
#pragma unroll
    for (int g = 0; g < 16; ++g) { s0[g] = __builtin_amdgcn_exp2f(s0[g] - mn); s1[g] = __builtin_amdgcn_exp2f(s1[g] - mn); ps += s0[g] + s1[g]; }
    lrun = lrun * alpha + ps;
#pragma unroll
    for (int d0 = 0; d0 < 4; ++d0)
#pragma unroll
        for (int g = 0; g < 16; ++g) o[d0][g] *= alpha;
}

constexpr int MLA_KSTR = 400, MLA_KBUF = 64 * MLA_KSTR, VBUF = 16384, MLA_LDS_V = 2 * MLA_KBUF, MLA_LDS_BYTES = 2 * MLA_KBUF + 2 * VBUF;
template <bool MASKED>
DI void mla_tile(lcp kb, lcp vb, const bf16x8 (&qf)[12], f32x16 (&o)[4], float& mrun, float& lrun, const VAddr& va, int qrel, int hh) {
    f32x16 s0, s1;
#pragma unroll
    for (int g = 0; g < 16; ++g) { s0[g] = 0.f; s1[g] = 0.f; }
    bf16x8 f0a = *(LAS const bf16x8*)kb, f0b = *(LAS const bf16x8*)(kb + 32 * MLA_KSTR), f1a = *(LAS const bf16x8*)(kb + 32), f1b = *(LAS const bf16x8*)(kb + 32 * MLA_KSTR + 32), f2a, f2b;
#pragma unroll
    for (int d0 = 0; d0 < 12; ++d0) {
        if (d0 + 2 < 12) { const bf16x8 n0 = *(LAS const bf16x8*)(kb + (d0 + 2) * 32), n1 = *(LAS const bf16x8*)(kb + 32 * MLA_KSTR + (d0 + 2) * 32);
            if ((d0 + 2) % 3 == 0) { f0a = n0; f0b = n1; } else if ((d0 + 2) % 3 == 1) { f1a = n0; f1b = n1; } else { f2a = n0; f2b = n1; } }
        SBAR();
        s0 = MFMA_BF16(d0 % 3 == 0 ? f0a : d0 % 3 == 1 ? f1a : f2a, qf[d0], s0); s1 = MFMA_BF16(d0 % 3 == 0 ? f0b : d0 % 3 == 1 ? f1b : f2b, qf[d0], s1);
        SBAR();
    }
    if (MASKED) {
#pragma unroll
        for (int g = 0; g < 16; ++g) { const int kv = crow(g, 0); if (kv > qrel - 4 * hh) s0[g] = -INFINITY; if (kv + 32 > qrel - 4 * hh) s1[g] = -INFINITY; } }
    float mt = fmaxf(s0[0], s1[0]);
#pragma unroll
    for (int g = 1; g < 16; ++g) mt = fmaxf(mt, fmaxf(s0[g], s1[g]));
    mt = swap_max(mt);
    if (__builtin_amdgcn_ballot_w64(mt > mrun) != 0ull) {
        const float mn = fmaxf(mrun, mt), alpha = __builtin_amdgcn_exp2f(mrun - mn); mrun = mn; lrun *= alpha;
#pragma unroll
        for (int d0 = 0; d0 < 4; ++d0)
#pragma unroll
            for (int g = 0; g < 16; ++g) o[d0][g] *= alpha;
    }
    float ps = 0.f;
#pragma unroll
    for (int g = 0; g < 16; ++g) { s0[g] = __builtin_amdgcn_exp2f(s0[g] - mrun); s1[g] = __builtin_amdgcn_exp2f(s1[g] - mrun); ps += s0[g] + s1[g]; }
    lrun += ps;
    bf16x8 pf[4]; pf[0] = pack_bf(s0, 0); pf[1] = pack_bf(s0, 1); pf[2] = pack_bf(s1, 0); pf[3] = pack_bf(s1, 1);
    bf16x8 v0 = vfrag(vb, 0, 0, va), v1 = vfrag(vb, 0, 1, va), v2;
#pragma unroll
    for (int j = 0; j < 16; ++j) {
        if (j + 2 < 16) { const int ks = (j + 2) >> 2, d0 = (j + 2) & 3; const bf16x8 nx = vfrag(vb + (ks >> 1) * 8192, ks & 1, d0, va);
            if ((j + 2) % 3 == 0) v0 = nx; else if ((j + 2) % 3 == 1) v1 = nx; else v2 = nx; }
        SBAR();
        o[j & 3] = MFMA_BF16(j % 3 == 0 ? v0 : j % 3 == 1 ? v1 : v2, pf[j >> 2], o[j & 3]);
        SBAR();
    }
}
DI void mla_unit(LAS unsigned char* lds, unsigned char* ws, int b, int h, int qb, const int tid_in) {
    int tid = tid_in; asm volatile("" : "+v"(tid));
    const int lane = tid & 63, wid = __builtin_amdgcn_readfirstlane(tid >> 6), r = lane & 31, hh = lane >> 5;
    const bf16_t *QN = (const bf16_t*)(ws + WS_QN), *QR = (const bf16_t*)(ws + WS_QR), *KN = (const bf16_t*)(ws + WS_KN), *KR = (const bf16_t*)(ws + WS_KR), *VA = (const bf16_t*)(ws + WS_VA), *SG = (const bf16_t*)(ws + WS_SG);
    bf16_t* MIX = (bf16_t*)(ws + WS_MIX);
    const int q0 = qb * 256, NT = 4 * (qb + 1), tmax = (q0 + 32 * wid) >> 6; const size_t rowbase = (size_t)b * SEQ;
    bf16x8 qf[12];
    { const size_t qrow = rowbase + q0 + 32 * wid + r;
#pragma unroll
      for (int d0 = 0; d0 < 8; ++d0) qf[d0] = *(const bf16x8*)(QN + qrow * 1024 + h * 128 + d0 * 16 + hh * 8);
#pragma unroll
      for (int d0 = 0; d0 < 4; ++d0) qf[8 + d0] = *(const bf16x8*)(QR + qrow * 512 + h * 64 + d0 * 16 + hh * 8); }
    f32x16 o[4];
#pragma unroll
    for (int d0 = 0; d0 < 4; ++d0)
#pragma unroll
        for (int g = 0; g < 16; ++g) o[d0][g] = 0.f;
    float mrun = -INFINITY, lrun = 0.f;
    u32x4 kreg[3], vreg[2];
    const VAddr va = make_vaddr(lane);
    const __amdgpu_buffer_rsrc_t rKN = mk_rsrc(KN, M * 1024 * 2), rKR = mk_rsrc(KR, M * 64 * 2), rVA = mk_rsrc(VA, M * 1024 * 2);
    const unsigned vo0 = (tid >> 4) * 2048 + (tid & 15) * 16, vo1 = vo0 + 32 * 2048, vor = (tid >> 3) * 128 + (tid & 7) * 16;
    const unsigned so_n = ((unsigned)rowbase * 1024 + h * 128) * 2, so_r = (unsigned)rowbase * 64 * 2;
    const unsigned lk0 = (tid >> 4) * MLA_KSTR + (tid & 15) * 16, lk1 = lk0 + 32 * MLA_KSTR, lkr = (tid >> 3) * MLA_KSTR + 256 + (tid & 7) * 16;
    const unsigned lv0 = off_b((tid >> 4) & 31, tid & 15), lv1 = lv0 + 8192;
    const unsigned kfo = r * MLA_KSTR + hh * 16;
#define MLA_LOAD(t) do { const unsigned tn = so_n + (unsigned)(t) * (64 * 2048), tr_ = so_r + (unsigned)(t) * (64 * 128); \
        kreg[0] = bload(rKN, vo0, tn); kreg[1] = bload(rKN, vo1, tn); kreg[2] = bload(rKR, vor, tr_); vreg[0] = bload(rVA, vo0, tn); vreg[1] = bload(rVA, vo1, tn); } while (0)
#define MLA_STORE(buf) do { LAS unsigned char* kd = lds + (buf) * MLA_KBUF; LAS unsigned char* vd = lds + MLA_LDS_V + (buf) * VBUF; \
        *(LAS u32x4*)(kd + lk0) = kreg[0]; *(LAS u32x4*)(kd + lk1) = kreg[1]; *(LAS u32x4*)(kd + lkr) = kreg[2]; *(LAS u32x4*)(vd + lv0) = vreg[0]; *(LAS u32x4*)(vd + lv1) = vreg[1]; } while (0)
    MLA_LOAD(0); MLA_STORE(0); __builtin_amdgcn_s_waitcnt(0x0F70);   __syncthreads();
#define MLA_INTERVAL(MODE) { const int buf = t & 1; \
        if (t + 1 < NT) MLA_LOAD(t + 1); \
        if (MODE == 0) mla_tile<false>(lds + buf * MLA_KBUF + kfo, lds + MLA_LDS_V + buf * VBUF, qf, o, mrun, lrun, va, 0, hh); \
        if (MODE == 1) mla_tile<true>(lds + buf * MLA_KBUF + kfo, lds + MLA_LDS_V + buf * VBUF, qf, o, mrun, lrun, va, q0 + 32 * wid + r - 64 * t, hh); \
        if (t + 1 < NT) MLA_STORE(buf ^ 1); \
        __syncthreads(); }
    int t = 0;
    for (; t < tmax; ++t) MLA_INTERVAL(0)
    MLA_INTERVAL(1)
    for (++t; t < NT; ++t) MLA_INTERVAL(2)
#undef MLA_INTERVAL
#undef MLA_LOAD
#undef MLA_STORE
    const float inv = 1.0f / swap_sum(lrun);
    int t4 = tid; asm volatile("" : "+v"(t4)); const size_t qrow = rowbase + q0 + 32 * wid + (t4 & 31); const int hh2 = (t4 >> 5) & 1;
#pragma unroll
    for (int d0 = 0; d0 < 4; ++d0)
#pragma unroll
        for (int gg = 0; gg < 4; ++gg) { const size_t off = qrow * 2048 + h * 128 + 32 * d0 + 8 * gg + 4 * hh2;
            const unsigned long long sg = *(const unsigned long long*)(SG + off);
            const float g0 = __uint_as_float((unsigned)(sg << 16)), g1 = __uint_as_float((unsigned)sg & 0xffff0000u), g2 = __uint_as_float((unsigned)(sg >> 32) << 16), g3 = __uint_as_float((unsigned)(sg >> 32) & 0xffff0000u);
            const unsigned lo = cvtpk(o[d0][4 * gg] * inv * g0, o[d0][4 * gg + 1] * inv * g1), hi = cvtpk(o[d0][4 * gg + 2] * inv * g2, o[d0][4 * gg + 3] * inv * g3);
            *(unsigned long long*)(MIX + off) = (unsigned long long)lo | ((unsigned long long)hi << 32); }
}
DI float vmax3_s(float a, float b, float c) { float r; asm("v_max3_f32 %0, %1, %2, %3" : "=v"(r) : "v"(a), "v"(b), "v"(c)); return r; }
constexpr int M2_KBUF = 64 * 384, M2_LDS_V = 3 * M2_KBUF, M2_LDS_BYTES = M2_LDS_V + 3 * VBUF;
struct M2State { f32x16 o[4]; f32x16 negv; float mrun, lrun, nref; };
template <int KIMM, int VIMM>
DI void mla2_iter(f32x16& zin, float& rin, f32x16& zout, float& rout, M2State& st, const u32x4& pi0, const u32x4& pi1, u32x4& po0, u32x4& po1, const bf16x8 (&qf)[12], const unsigned (&koff)[4], const unsigned (&voff)[2][4],
                  const bool masked, const int qrh) {
#define M2_KF(d0) (*(LAS const bf16x8*)(koff[(d0) & 3] + (unsigned)(KIMM + 128 * ((d0) >> 2))))
#define M2_VF(t, j) vtr((lcp)(voff[t][(j) & 3] + (unsigned)(VIMM + 4096 * ((j) >> 2))))
    if (masked) {
        asm volatile("" ::: "memory");
#pragma unroll
        for (int g = 0; g < 16; ++g) if (crow(g, 0) > qrh) zin[g] = -INFINITY;
    }
    bf16x8 kfA = M2_KF(0), kfB; s16x4 la, ha, lb, hb;
    float mt = 0.f, mnew = 0.f, alpha = 1.f, ps = 0.f; bool grow = false; float pe[16];
    SBAR();
#pragma unroll
    for (int i = 0; i < 20; ++i) {
        const int c5 = i % 5, blk5 = i / 5; const bool isP = (c5 == 2 || c5 == 4);
        const int qi = blk5 * 3 + (c5 < 2 ? c5 : 2), pj = blk5 * 2 + (c5 == 2 ? 0 : 1);
        if (isP) { const s16x4 lo = (pj & 1) ? lb : la, hi = (pj & 1) ? hb : ha; const bf16x8 vf = (bf16x8){lo[0], lo[1], lo[2], lo[3], hi[0], hi[1], hi[2], hi[3]};
            st.o[pj & 3] = MFMA_BF16(vf, __builtin_bit_cast(bf16x8, (pj >> 2) ? pi1 : pi0), st.o[pj & 3]); }
        else if (i == 0) { f32x16 zero_;
#pragma unroll
            for (int g = 0; g < 16; ++g) zero_[g] = 0.f;
            (void)zero_; zout = MFMA_BF16(kfA, qf[0], st.negv); rout = st.nref; }
        else zout = MFMA_BF16((qi & 1) ? kfB : kfA, qf[qi], zout);
        if (!isP && qi + 1 < 12) { const bf16x8 nx = M2_KF(qi + 1); if ((qi + 1) & 1) kfB = nx; else kfA = nx; }
        if (isP && pj + 1 < 8) { const s16x4 l_ = M2_VF(0, pj + 1), h_ = M2_VF(1, pj + 1); if ((pj + 1) & 1) { lb = l_; hb = h_; } else { la = l_; ha = h_; } }
        if (i == 0) { la = M2_VF(0, 0); ha = M2_VF(1, 0); }
        SBAR();
        if (i < 4) { float a = vmax3_s(zin[4 * i], zin[4 * i + 1], zin[4 * i + 2]); mt = i == 0 ? vmax3_s(a, zin[3], zin[3]) : vmax3_s(mt, a, zin[4 * i + 3]); asm volatile("" : "+v"(mt)); }
        if (i == 4) { mt = swap_max(mt) + rin;
            grow = __builtin_amdgcn_ballot_w64((mt > st.mrun) || (rin != st.mrun)) != 0ull;
            if (grow) {
                mnew = fmaxf(st.mrun, mt); alpha = __builtin_amdgcn_exp2f(st.mrun - mnew); const float dl = mnew - rin;
#pragma unroll
                for (int g = 0; g < 16; ++g) zin[g] -= dl;
                st.mrun = mnew; st.lrun *= alpha; } }
        if (i >= 5 && i < 13) { const int g = 2 * (i - 5); float e0 = __builtin_amdgcn_exp2f(zin[g]), e1 = __builtin_amdgcn_exp2f(zin[g + 1]); ps += e0 + e1;
            asm volatile("" : "+v"(ps)); pe[g] = e0; pe[g + 1] = e1; }
        if (i >= 13 && i < 17) { const int w_ = i - 13; unsigned w0 = cvtpk(pe[4 * w_], pe[4 * w_ + 1]), w1 = cvtpk(pe[4 * w_ + 2], pe[4 * w_ + 3]); asm volatile("" : "+v"(w0), "+v"(w1));
            if (w_ < 2) { po0[2 * w_] = w0; po0[2 * w_ + 1] = w1; } else { po1[2 * (w_ - 2)] = w0; po1[2 * (w_ - 2) + 1] = w1; } }
        SBAR();
    }
    st.lrun += ps;
    if (grow) {
#pragma unroll
        for (int d0 = 0; d0 < 4; ++d0)
#pragma unroll
            for (int g = 0; g < 16; ++g) st.o[d0][g] *= alpha;
        st.nref = st.mrun;
#pragma unroll
        for (int g = 0; g < 16; ++g) st.negv[g] = -st.mrun;
    }
#undef M2_KF
#undef M2_VF
}
DI void mla2_unit(LAS unsigned char* lds, unsigned char* ws, int b, int h, int qb, const int tid_in) {
    int tid = tid_in; asm volatile("" : "+v"(tid));
    const int lane = tid & 63, wid = __builtin_amdgcn_readfirstlane(tid >> 6), r = lane & 31, hh = lane >> 5;
    const bf16_t *QN = (const bf16_t*)(ws + WS_QN), *QR = (const bf16_t*)(ws + WS_QR), *KN = (const bf16_t*)(ws + WS_KN), *KR = (const bf16_t*)(ws + WS_KR), *VA = (const bf16_t*)(ws + WS_VA), *SG = (const bf16_t*)(ws + WS_SG);
    bf16_t* MIX = (bf16_t*)(ws + WS_MIX);
    const int q0 = qb * 256, NT = 4 * (qb + 1), tmax = (q0 + 32 * wid) >> 6; const size_t rowbase = (size_t)b * SEQ;
    bf16x8 qf[12];
    { const size_t qrow = rowbase + q0 + 32 * wid + r;
#pragma unroll
      for (int d0 = 0; d0 < 8; ++d0) qf[d0] = *(const bf16x8*)(QN + qrow * 1024 + h * 128 + d0 * 16 + hh * 8);
#pragma unroll
      for (int d0 = 0; d0 < 4; ++d0) qf[8 + d0] = *(const bf16x8*)(QR + qrow * 512 + h * 64 + d0 * 16 + hh * 8); }
    M2State st;
#pragma unroll
    for (int d0 = 0; d0 < 4; ++d0)
#pragma unroll
        for (int g = 0; g < 16; ++g) st.o[d0][g] = 0.f;
    st.mrun = -INFINITY; st.lrun = 0.f; st.nref = 0.f;
#pragma unroll
    for (int g = 0; g < 16; ++g) st.negv[g] = 0.f;
    float ra = 0.f, rb = 0.f;
    unsigned koff[4], voff[2][4];
    { const unsigned blk = (lane >> 4) & 1, qq = (lane & 15) >> 2, p = lane & 3, f = (r >> 1) & 7;
      const unsigned kb_ = (unsigned)(size_t)lds + r * 384;
#pragma unroll
      for (int j = 0; j < 4; ++j) koff[j] = kb_ + 16 * ((2 * j + hh) ^ f);
      const unsigned vb0 = 256 * (4 * hh + qq) + 8 * (p & 1) + 16 * ((2 * blk + (p >> 1)) ^ hh), v0_ = (unsigned)(size_t)lds + M2_LDS_V + vb0, v1_ = (unsigned)(size_t)lds + M2_LDS_V + 2048 + (vb0 ^ 32);
#pragma unroll
      for (int d0 = 0; d0 < 4; ++d0) { voff[0][d0] = v0_ + ((64u * d0) ^ (64u * qq)); voff[1][d0] = v1_ + ((64u * d0) ^ (64u * qq)); } }
    const bf16_t* knb = KN + rowbase * 1024 + h * 128; const bf16_t* krb = KR + rowbase * 64; const bf16_t* vab = VA + rowbase * 1024 + h * 128;
    unsigned ksrc[3];
#pragma unroll
    for (int i_ = 0; i_ < 3; ++i_) { const int c_ = (3 * wid + i_) * 64 + lane, row_ = c_ / 24, ch_ = (c_ % 24) ^ ((row_ >> 1) & 7);
        ksrc[i_] = ch_ < 16 ? (unsigned)(row_ * 1024 + ch_ * 8) : (0x80000000u | (unsigned)(row_ * 64 + (ch_ - 16) * 8)); }
#define M2_DMAK(t, slot) do { _Pragma("unroll") for (int i_ = 0; i_ < 3; ++i_) { const unsigned o_ = ksrc[i_] & 0x7fffffffu; \
            const bf16_t* src_ = (ksrc[i_] >> 31) ? krb + (size_t)(t) * (64 * 64) + o_ : knb + (size_t)(t) * (64 * 1024) + o_; \
            __builtin_amdgcn_global_load_lds((const unsigned*)src_, (LAS unsigned*)(lds + (slot) * M2_KBUF + (3 * wid + i_) * 1024), 16, 0, 0); } } while (0)
#define M2_DMAV(t, slot) do { int t2_ = tid; asm volatile("" : "+v"(t2_)); const int ln_ = t2_ & 63, drow_ = 8 * wid + (ln_ >> 4), c15_ = ln_ & 15; \
        const unsigned s0_ = (unsigned)drow_ * 1024 + ((c15_ ^ (((drow_ & 3) << 2) | ((drow_ >> 2) & 3))) * 8), s1_ = (unsigned)(drow_ + 4) * 1024 + ((c15_ ^ ((((drow_ + 4) & 3) << 2) | (((drow_ + 4) >> 2) & 3))) * 8); \
        const bf16_t* vt = vab + (size_t)(t) * (64 * 1024); LAS unsigned char* vd = lds + M2_LDS_V + (slot) * VBUF + wid * 2048; \
        __builtin_amdgcn_global_load_lds((const unsigned*)(vt + s0_), (LAS unsigned*)vd, 16, 0, 0); __builtin_amdgcn_global_load_lds((const unsigned*)(vt + s1_), (LAS unsigned*)(vd + 1024), 16, 0, 0); } while (0)
    M2_DMAK(0, 0); M2_DMAV(0, 0); M2_DMAV(0, 2);
    if (NT > 1) M2_DMAK(1, 1);
    __builtin_amdgcn_s_waitcnt(0x0F70);
    __syncthreads();
    f32x16 za, zb;
#pragma unroll
    for (int g = 0; g < 16; ++g) { za[g] = 0.f; zb[g] = 0.f; }
#pragma unroll
    for (int d0 = 0; d0 < 12; ++d0) za = MFMA_BF16(*(LAS const bf16x8*)(koff[d0 & 3] + (unsigned)(128 * (d0 >> 2))), qf[d0], za);
    u32x4 pa[2], pb[2]; pa[0] = (u32x4){0u, 0u, 0u, 0u}; pa[1] = pa[0]; pb[0] = pa[0]; pb[1] = pa[0];
#define M2_INTERVAL(P) { if (t + 2 < NT) M2_DMAK(t + 2, ((P) + 2) % 3); if (t + 1 < NT) M2_DMAV(t + 1, ((P) + 1) % 3); \
        if (t <= tmax) {           \
            int qrh; { int t3 = tid; asm volatile("" : "+v"(t3)); qrh = q0 + 32 * wid + (t3 & 31) - 4 * ((t3 >> 5) & 1) - 64 * t; } const bool msk = t == tmax; \
            mla2_iter<(P) * M2_KBUF + 32 * 384, (((P) + 2) % 3) * VBUF + 8192>(za, ra, zb, rb, st, pa[0], pa[1], pb[0], pb[1], qf, koff, voff, msk, qrh); \
            mla2_iter<(((P) + 1) % 3) * M2_KBUF, (P) * VBUF>(zb, rb, za, ra, st, pb[0], pb[1], pa[0], pa[1], qf, koff, voff, msk, qrh - 32); \
            if (msk) {            \
                lcp vb_ = lds + M2_LDS_V + (P) * VBUF + 8192; const VAddr va_ = make_vaddr(tid & 63); \
                _Pragma("unroll") for (int j = 0; j < 8; ++j) st.o[j & 3] = MFMA_BF16(vfrag(vb_, j >> 2, j & 3, va_), __builtin_bit_cast(bf16x8, (j >> 2) ? pa[1] : pa[0]), st.o[j & 3]); } } \
        ++t; __syncthreads(); }
    int t = 0;
    for (;;) { M2_INTERVAL(0) if (t >= NT) break; M2_INTERVAL(1) if (t >= NT) break; M2_INTERVAL(2) if (t >= NT) break; }
#undef M2_INTERVAL
#undef M2_DMAK
#undef M2_DMAV
    const float inv = 1.0f / swap_sum(st.lrun);
    int t4 = tid; asm volatile("" : "+v"(t4)); const size_t qrow = rowbase + q0 + 32 * wid + (t4 & 31); const int hh2 = (t4 >> 5) & 1;
#pragma unroll
    for (int d0 = 0; d0 < 4; ++d0)
#pragma unroll
        for (int p = 0; p < 2; ++p) { const size_t off = qrow * 2048 + h * 128 + 32 * d0 + 16 * p + 8 * hh2; float e[8]; o_pair8(st.o[d0], p, e);
            const u32x4 sg = *(const u32x4*)(SG + off); u32x4 w;
#pragma unroll
            for (int j = 0; j < 4; ++j) w[j] = cvtpk(e[2 * j] * inv * __uint_as_float(sg[j] << 16), e[2 * j + 1] * inv * __uint_as_float(sg[j] & 0xffff0000u));
            *(u32x4*)(MIX + off) = w; }
}
DI void mla_phase(LAS unsigned char* lds, unsigned char* ws, const int tid) {
    const int G = gridDim.x, bx = blockIdx.x; const int vcu = (G % 8 == 0) ? (bx % 8) * (G / 8) + bx / 8 : bx;
    for (int p = vcu; p < 256; p += G) { const int bh = p >> 3, pr = p & 7;
#if MLA_PIPE
        mla2_unit(lds, ws, bh >> 3, bh & 7, 15 - pr, tid); mla2_unit(lds, ws, bh >> 3, bh & 7, pr, tid);
#else
        mla_unit(lds, ws, bh >> 3, bh & 7, 15 - pr, tid); mla_unit(lds, ws, bh >> 3, bh & 7, pr, tid);
#endif
 }
}

constexpr int SB_KBUF = 16384, SB_LDS_V = 3 * SB_KBUF, SB_LDS_UM = SB_LDS_V + 3 * VBUF, SB_LDS_BYTES = SB_LDS_UM + 2048 + 64;
DI float vmin_s(float a, float b) { float r; asm("v_min_f32 %0, %1, %2" : "=v"(r) : "v"(a), "v"(b)); return r; }
struct SbAddr { unsigned kx, vb0, vq; };
template <bool MASKED, int VAR>
DI void sb_iter(f32x16& zin, f32x16& zout, f32x16 (&o)[4], const u32x4& pi0, const u32x4& pi1, u32x4& po0, u32x4& po1, float& carry, const bf16x8 (&qf)[8], lcp ump, lcp knext, lcp vprev, const SbAddr& ad, int qrh) {
    u32x4 lw0, lw1; const float z0 = zin[0];
    unsigned kx = ad.kx, vq = ad.vq; asm volatile("" : "+v"(kx), "+v"(vq));
    bf16x8 kfa = *(LAS const bf16x8*)(knext + kx), kfb;
#pragma unroll
    for (int k = 0; k < 8; ++k) {
        if (k == 0) {
#pragma unroll
            for (int g = 0; g < 16; ++g) zout[g] = 0.f;
        }
        if (VAR == 2 || VAR == 4 || VAR == 11 || VAR == 13) { asm volatile("" :: "v"((k & 1) ? kfb : kfa)); } else zout = MFMA_BF16((k & 1) ? kfb : kfa, qf[k], zout);
        if (VAR == 12) { zout = MFMA_BF16((k & 1) ? kfb : kfa, qf[k], zout); zout = MFMA_BF16((k & 1) ? kfb : kfa, qf[k], zout); }
        if (k + 1 < 8) { bf16x8 nx; if (VAR == 3 || VAR == 4 || VAR == 9 || VAR == 11 || VAR == 12 || VAR == 13) nx = qf[k]; else nx = *(LAS const bf16x8*)(knext + ((32u * (k + 1)) ^ kx)); if (k & 1) kfa = nx; else kfb = nx; }
        SBAR();
        float lv[2];
#pragma unroll
        for (int i = 0; i < 2; ++i) { const int g = 2 * k + i;
            float sp; if (VAR == 8 || VAR == 9 || VAR == 12) sp = zin[g]; else if (VAR == 13) { sp = __builtin_amdgcn_logf(1.0f + __builtin_amdgcn_exp2f(vmin_s(zin[g], 64.0f))); sp = __builtin_amdgcn_logf(1.0f + __builtin_amdgcn_exp2f(vmin_s(sp, 64.0f))); sp = __builtin_amdgcn_logf(1.0f + __builtin_amdgcn_exp2f(vmin_s(sp, 64.0f))); } else if (VAR == 1 || VAR == 4) sp = vmin_s(zin[g], 64.0f) * 0.5f; else sp = __builtin_amdgcn_logf(1.0f + __builtin_amdgcn_exp2f(vmin_s(zin[g], 64.0f)));
            if (MASKED) lv[i] = (crow(g, 0) < qrh) ? sp : 0.f; else lv[i] = sp; }
        unsigned w = cvtpk_h(lv[0], lv[1]);
        asm volatile("" : "+v"(w));
        if (k < 4) lw0[k & 3] = w; else lw1[k & 3] = w;
        SBAR();
    }
    const f16x8 um0 = *(LAS const f16x8*)ump, um1 = *(LAS const f16x8*)(ump + 16);
    zin = MFMA_F16(um0, __builtin_bit_cast(f16x8, lw0), zin); zin = MFMA_F16(um1, __builtin_bit_cast(f16x8, lw1), zin);
    SBAR();
    s16x4 la, ha, lb, hb;
    const unsigned vb0 = ad.vb0, vb1 = 2048 + (vb0 ^ 32);
    { const unsigned dq = vq; la = vtr(vprev + vb0 + dq); ha = vtr(vprev + vb1 + dq); }
#pragma unroll
    for (int j = 0; j < 8; ++j) {
        { const s16x4 lo = (j & 1) ? lb : la, hi = (j & 1) ? hb : ha;
          const bf16x8 vf = (bf16x8){lo[0], lo[1], lo[2], lo[3], hi[0], hi[1], hi[2], hi[3]};
          if (VAR == 2 || VAR == 4 || VAR == 11 || VAR == 13) { asm volatile("" :: "v"(vf)); } else o[j & 3] = MFMA_BF16(vf, __builtin_bit_cast(bf16x8, (j >> 2) ? pi1 : pi0), o[j & 3]);
          if (VAR == 12) { o[(j + 1) & 3] = MFMA_BF16(vf, __builtin_bit_cast(bf16x8, (j >> 2) ? pi1 : pi0), o[(j + 1) & 3]); o[(j + 2) & 3] = MFMA_BF16(vf, __builtin_bit_cast(bf16x8, (j >> 2) ? pi1 : pi0), o[(j + 2) & 3]); } }
        if (j + 1 < 8) { const unsigned dq = (64u * ((j + 1) & 3)) ^ vq; s16x4 l_, h_; if (VAR == 3 || VAR == 4 || VAR == 9 || VAR == 11 || VAR == 12 || VAR == 13) { l_ = (s16x4){(short)pi0[0], (short)pi0[1], (short)pi0[2], (short)pi0[3]}; h_ = l_; } else { l_ = vtr(vprev + 4096 * ((j + 1) >> 2) + vb0 + dq); h_ = vtr(vprev + 4096 * ((j + 1) >> 2) + vb1 + dq); }
            if (j & 1) { la = l_; ha = h_; } else { lb = l_; hb = h_; } }
        SBAR();
        float av[2];
#pragma unroll
        for (int i = 0; i < 2; ++i) { const int g = 2 * j + i; float a; if (VAR == 8 || VAR == 9 || VAR == 12) a = zin[g]; else if (VAR == 13) { a = __builtin_amdgcn_exp2f(zin[g] + carry); a = __builtin_amdgcn_exp2f(a + carry); a = __builtin_amdgcn_exp2f(a + carry); } else if (VAR == 1 || VAR == 4) a = zin[g] + carry; else a = __builtin_amdgcn_exp2f(zin[g] + carry); if (MASKED) av[i] = (crow(g, 0) < qrh) ? a : 0.f; else av[i] = a; }
        unsigned w = cvtpk(av[0], av[1]);
        asm volatile("" : "+v"(w));
        if (j < 4) po0[j & 3] = w; else po1[j & 3] = w;
        SBAR();
    }
    carry += bcast_lo(zin[0] - z0);
}
template <int KIMM, int VIMM>
DI void sb_iter_s(f32x16& zin, f32x16& zout, f32x16 (&o)[4], const u32x4& pi0, const u32x4& pi1, u32x4& po0, u32x4& po1, float& carry, const bf16x8 (&qf)[8], lcp ump,
                  const unsigned (&koff)[8], const unsigned (&voff)[2][4]) {
    u32x4 lw0, lw1; const float z0 = zin[0];
#define SB_KF(k) (*(LAS const bf16x8*)(koff[k] + (unsigned)KIMM))
#define SB_VF(t, j) vtr((lcp)(voff[t][(j) & 3] + (unsigned)(VIMM + 4096 * ((j) >> 2))))
    bf16x8 kfa = SB_KF(0), kfb;
    const f16x8 um0 = *(LAS const f16x8*)ump, um1 = *(LAS const f16x8*)(ump + 16);
    SBAR();
#pragma unroll
    for (int k = 0; k < 8; ++k) {
        if (k == 0) {
#pragma unroll
            for (int g = 0; g < 16; ++g) zout[g] = 0.f;
        }
        zout = MFMA_BF16((k & 1) ? kfb : kfa, qf[k], zout);
        if (k + 1 < 8) { const bf16x8 nx = SB_KF(k + 1); if (k & 1) kfa = nx; else kfb = nx; }
        SBAR();
        float lv[2];
#pragma unroll
        for (int i = 0; i < 2; ++i) lv[i] = __builtin_amdgcn_logf(1.0f + __builtin_amdgcn_exp2f(vmin_s(zin[2 * k + i], 64.0f)));
        unsigned w = cvtpk_h(lv[0], lv[1]);
        asm volatile("" : "+v"(w));
        if (k < 4) lw0[k & 3] = w; else lw1[k & 3] = w;
        SBAR();
    }
    s16x4 la = SB_VF(0, 0), ha = SB_VF(1, 0), lb, hb;
    SBAR();
    zin = MFMA_F16(um0, __builtin_bit_cast(f16x8, lw0), zin); zin = MFMA_F16(um1, __builtin_bit_cast(f16x8, lw1), zin);
    SBAR();
#pragma unroll
    for (int j = 0; j < 8; ++j) {
        { const s16x4 lo = (j & 1) ? lb : la, hi = (j & 1) ? hb : ha;
          const bf16x8 vf = (bf16x8){lo[0], lo[1], lo[2], lo[3], hi[0], hi[1], hi[2], hi[3]};
          o[j & 3] = MFMA_BF16(vf, __builtin_bit_cast(bf16x8, (j >> 2) ? pi1 : pi0), o[j & 3]); }
        if (j + 1 < 8) { const s16x4 l_ = SB_VF(0, j + 1), h_ = SB_VF(1, j + 1); if (j & 1) { la = l_; ha = h_; } else { lb = l_; hb = h_; } }
        SBAR();
        float av[2];
#pragma unroll
        for (int i = 0; i < 2; ++i) av[i] = __builtin_amdgcn_exp2f(zin[2 * j + i] + carry);
        unsigned w = cvtpk(av[0], av[1]);
        asm volatile("" : "+v"(w));
        if (j < 4) po0[j & 3] = w; else po1[j & 3] = w;
        SBAR();
    }
#undef SB_KF
#undef SB_VF
    carry += bcast_lo(zin[0] - z0);
}
template <int P>
DI void sb_tile_s(f32x16& za, f32x16& zb, f32x16 (&o)[4], u32x4 (&pa)[2], u32x4 (&pb)[2], float& carry, const bf16x8 (&qf)[8], lcp ump, const unsigned (&koff)[8], const unsigned (&voff)[2][4]) {
    constexpr int KS = P, KSN = (P + 1) % 3, VS = P, VSP = (P + 2) % 3;
    sb_iter_s<KS * SB_KBUF, VSP * VBUF>(za, zb, o, pa[0], pa[1], pb[0], pb[1], carry, qf, ump, koff, voff);
    sb_iter_s<KSN * SB_KBUF + 8192, VS * VBUF + 8192>(zb, za, o, pb[0], pb[1], pa[0], pa[1], carry, qf, ump, koff, voff);
}
template <bool MASKED, int VAR>
DI void sb_tile(LAS unsigned char* lds, f32x16& za, f32x16& zb, f32x16 (&o)[4], u32x4 (&pa)[2], u32x4 (&pb)[2], float& carry, const bf16x8 (&qf)[8], lcp ump, const SbAddr& ad,
                unsigned krow_off, int ks, int ksn, int vs, int vsp, int qrh0) {
    sb_iter<MASKED, VAR>(za, zb, o, pa[0], pa[1], pb[0], pb[1], carry, qf, ump, lds + ks * SB_KBUF + krow_off, lds + SB_LDS_V + vsp * VBUF, ad, qrh0 - 32);
    sb_iter<MASKED, VAR>(zb, za, o, pb[0], pb[1], pa[0], pa[1], carry, qf, ump, lds + ksn * SB_KBUF + 8192 + krow_off, lds + SB_LDS_V + vs * VBUF + 8192, ad, qrh0);
}
template <int VAR> DI void sb_unit(LAS unsigned char* lds, unsigned char* ws, int b, int h, int qb, const int tid_in) {
    int tid = tid_in; asm volatile("" : "+v"(tid));
    const int lane = tid & 63, wid = __builtin_amdgcn_readfirstlane(tid >> 6), r = lane & 31, hh = lane >> 5;
    const bf16_t *Q2 = (const bf16_t*)(ws + WS_Q2), *K2 = (const bf16_t*)(ws + WS_K2), *V2 = (const bf16_t*)(ws + WS_V2), *SG2 = (const bf16_t*)(ws + WS_SG2);
    bf16_t* MIX2 = (bf16_t*)(ws + (VAR ? WS_A : WS_MIX2));
    const int q0 = qb * 256, NT = 4 * (qb + 1), tmax = (q0 + 32 * wid) >> 6; const size_t rowbase = (size_t)b * SEQ;
    bf16x8 qf[8];
    { const size_t qrow = rowbase + q0 + 32 * wid + r;
#pragma unroll
      for (int d0 = 0; d0 < 8; ++d0) qf[d0] = *(const bf16x8*)(Q2 + qrow * 2048 + h * 128 + d0 * 16 + hh * 8); }
    { f16x8 um[2];
#pragma unroll
      for (int s = 0; s < 2; ++s)
#pragma unroll
          for (int j = 0; j < 8; ++j) um[s][j] = (16 * s + 8 * (j >> 2) + 4 * hh + (j & 3)) >= r ? (_Float16)-1.0f : (_Float16)0.0f;
      *(LAS f16x8*)(lds + SB_LDS_UM + lane * 32) = um[0]; *(LAS f16x8*)(lds + SB_LDS_UM + lane * 32 + 16) = um[1]; }
    lcp ump = lds + SB_LDS_UM + lane * 32;
    f32x16 o[4];
#pragma unroll
    for (int d0 = 0; d0 < 4; ++d0)
#pragma unroll
        for (int g = 0; g < 16; ++g) o[d0][g] = 0.f;
    float carry = 0.f;
    SbAddr ad;
    { const unsigned blk = (lane >> 4) & 1, qq = (lane & 15) >> 2, p = lane & 3;
      ad.kx = ((r & 15) >> 1) << 5;
      ad.vb0 = 256 * (4 * hh + qq) + 8 * (p & 1) + 16 * ((2 * blk + (p >> 1)) ^ hh); ad.vq = 64 * qq; }
    const unsigned krow_off = r * 256 + ((hh ^ (r & 1)) << 4);
    const bf16_t* kbase = K2 + rowbase * 2048 + h * 128; const bf16_t* vbase = V2 + rowbase * 2048 + h * 128;
#define SB_DMA_SRC() int t2_ = tid; asm volatile("" : "+v"(t2_)); const int ln_ = t2_ & 63, drow_ = 8 * wid + (ln_ >> 4), c15_ = ln_ & 15;
#define SB_DMAK(tau, slot) do { SB_DMA_SRC(); const unsigned s0_ = (unsigned)drow_ * 2048 + ((c15_ ^ (drow_ & 15)) * 8), s1_ = (unsigned)(drow_ + 4) * 2048 + ((c15_ ^ ((drow_ + 4) & 15)) * 8); \
        const bf16_t* kt = kbase + (size_t)(NT - 1 - (tau)) * (64 * 2048); LAS unsigned char* kd = lds + (slot) * SB_KBUF + wid * 2048; \
        __builtin_amdgcn_global_load_lds((const unsigned*)(kt + s0_), (LAS unsigned*)kd, 16, 0, 0); __builtin_amdgcn_global_load_lds((const unsigned*)(kt + s1_), (LAS unsigned*)(kd + 1024), 16, 0, 0); } while (0)
#define SB_DMAV(tau, slot) do { SB_DMA_SRC(); const unsigned s0_ = (unsigned)drow_ * 2048 + ((c15_ ^ (((drow_ & 3) << 2) | ((drow_ >> 2) & 3))) * 8), s1_ = (unsigned)(drow_ + 4) * 2048 + ((c15_ ^ ((((drow_ + 4) & 3) << 2) | (((drow_ + 4) >> 2) & 3))) * 8); \
        const bf16_t* vt = vbase + (size_t)(NT - 1 - (tau)) * (64 * 2048); LAS unsigned char* vd = lds + SB_LDS_V + (slot) * VBUF + wid * 2048; \
        __builtin_amdgcn_global_load_lds((const unsigned*)(vt + s0_), (LAS unsigned*)vd, 16, 0, 0); __builtin_amdgcn_global_load_lds((const unsigned*)(vt + s1_), (LAS unsigned*)(vd + 1024), 16, 0, 0); } while (0)
    SB_DMAK(0, 0); SB_DMAV(0, 0);
    if (NT > 1) SB_DMAK(1, 1);
    __builtin_amdgcn_s_waitcnt(0x0F70);
    __syncthreads();
    f32x16 za, zb;
#pragma unroll
    for (int g = 0; g < 16; ++g) { za[g] = 0.f; zb[g] = 0.f; }
    u32x4 pa[2], pb[2]; pa[0] = (u32x4){0u, 0u, 0u, 0u}; pa[1] = pa[0]; pb[0] = pa[0]; pb[1] = pa[0];
    int ks = 0, ks1 = 1, vs = 0, vsp = 0;
    const int nmask = NT - tmax;
    constexpr float SB_STOP = -140.0f;
    LAS unsigned* flg = (LAS unsigned*)(lds + SB_LDS_UM + 2048);
    bool wdone = false, alldone = false; int par = 0, lim = NT;
#define SB_CLOSE() { wdone = wdone | (__builtin_amdgcn_ballot_w64(carry > SB_STOP) == 0ull); lim = wdone ? (lim < tau + 1 ? lim : tau + 1) : lim;        \
        { int t5 = tid; asm volatile("" : "+v"(t5)); if ((t5 & 63) == 0) flg[par * 8 + wid] = wdone ? 1u : 0u; } \
        __syncthreads();                            \
        { const u32x4 f0 = *(LAS const u32x4*)(flg + par * 8), f1 = *(LAS const u32x4*)(flg + par * 8 + 4); \
          alldone = __builtin_amdgcn_readfirstlane((int)(f0[0] & f0[1] & f0[2] & f0[3] & f1[0] & f1[1] & f1[2] & f1[3])) != 0; } par ^= 1; }
#define SB_INTERVAL(MASKED) { const int t = NT - 1 - tau; const int ks2 = (ks1 == 2) ? 0 : ks1 + 1, vs1 = (vs == 2) ? 0 : vs + 1; \
        if (tau + 2 < NT) SB_DMAK(tau + 2, ks2); \
        if (tau + 1 < NT) SB_DMAV(tau + 1, vs1); \
        int qrh0; { int t3 = tid; asm volatile("" : "+v"(t3)); qrh0 = q0 + 32 * wid + (t3 & 31) - 4 * ((t3 >> 5) & 1) - 64 * t; }        \
        sb_tile<MASKED, VAR>(lds, za, zb, o, pa, pb, carry, qf, ump, ad, krow_off, ks, (tau + 1 < NT ? ks1 : ks), vs, vsp, qrh0); \
        SB_CLOSE() \
        ks = ks1; ks1 = ks2; vsp = vs; vs = vs1; }
    int tau = 0;
    for (; tau < nmask - 1 && !alldone; ++tau) { const int ks2 = (ks1 == 2) ? 0 : ks1 + 1, vs1 = (vs == 2) ? 0 : vs + 1;
        if (tau + 2 < NT) SB_DMAK(tau + 2, ks2);
        if (tau + 1 < NT) SB_DMAV(tau + 1, vs1);
        SB_CLOSE()
        ks = ks1; ks1 = ks2; vsp = vs; vs = vs1; }
    { lcp kp = lds + ks * SB_KBUF + 8192 + krow_off;
#pragma unroll
      for (int k = 0; k < 8; ++k) za = MFMA_BF16(*(LAS const bf16x8*)(kp + ((32u * k) ^ ad.kx)), qf[k], za); }
    for (; tau < nmask && tau < lim; ++tau) SB_INTERVAL(true)
    for (; tau < lim; ++tau) SB_INTERVAL(false)
#undef SB_INTERVAL
    { lcp vp = lds + SB_LDS_V + vsp * VBUF;
#pragma unroll
      for (int j = 0; j < 8; ++j) { const unsigned dq = (64u * (j & 3)) ^ ad.vq;
          const s16x4 lo = vtr(vp + 4096 * (j >> 2) + ad.vb0 + dq), hi = vtr(vp + 4096 * (j >> 2) + 2048 + (ad.vb0 ^ 32) + dq);
          o[j & 3] = MFMA_BF16(((bf16x8){lo[0], lo[1], lo[2], lo[3], hi[0], hi[1], hi[2], hi[3]}), __builtin_bit_cast(bf16x8, (j >> 2) ? pa[1] : pa[0]), o[j & 3]); } }
    for (; tau < NT && !alldone; ++tau) { const int ks2 = (ks1 == 2) ? 0 : ks1 + 1, vs1 = (vs == 2) ? 0 : vs + 1;
        if (tau + 2 < NT) SB_DMAK(tau + 2, ks2);
        if (tau + 1 < NT) SB_DMAV(tau + 1, vs1);
        SB_CLOSE()
        ks = ks1; ks1 = ks2; vsp = vs; vs = vs1; }
#undef SB_CLOSE
    __syncthreads();
#undef SB_DMAK
#undef SB_DMAV
#undef SB_DMA_SRC
    int t4 = tid; asm volatile("" : "+v"(t4)); const size_t qrow = rowbase + q0 + 32 * wid + (t4 & 31); const int hh2 = (t4 >> 5) & 1;
#pragma unroll
    for (int d0 = 0; d0 < 4; ++d0)
#pragma unroll
        for (int p = 0; p < 2; ++p) { const size_t off = qrow * 2048 + h * 128 + 32 * d0 + 16 * p + 8 * hh2; float e[8]; o_pair8(o[d0], p, e);
            const u32x4 sg = *(const u32x4*)(SG2 + off); u32x4 w;
#pragma unroll
            for (int j = 0; j < 4; ++j) w[j] = cvtpk(e[2 * j] * __uint_as_float(sg[j] << 16), e[2 * j + 1] * __uint_as_float(sg[j] & 0xffff0000u));
            *(u32x4*)(MIX2 + off) = w; }
}
template <int VAR> DI void sb_phase(LAS unsigned char* lds, unsigned char* ws, const int tid) {
    const int G = gridDim.x, bx = blockIdx.x; const int vcu = (G % 8 == 0) ? (bx % 8) * (G / 8) + bx / 8 : bx;
    for (int p = vcu; p < 512; p += G) { const int bh = p >> 3, pr = p & 7; sb_unit<VAR>(lds, ws, bh >> 4, bh & 15, 15 - pr, tid); sb_unit<VAR>(lds, ws, bh >> 4, bh & 15, pr, tid); }
}

constexpr int DIL_KSTR = 272, DIL_WAVE_BYTES = 32 * DIL_KSTR + 8192, DIL_LDS_BYTES = 8 * DIL_WAVE_BYTES;
DI void softmax_blk(f32x16& s0, f32x16 (&o)[4], float& mrun, float& lrun) {
    float mt = s0[0];
#pragma unroll
    for (int g = 1; g < 16; ++g) mt = fmaxf(mt, s0[g]);
    mt = swap_max(mt);
    if (__builtin_amdgcn_ballot_w64(mt > mrun) != 0ull) {
        const float mn = fmaxf(mrun, mt), alpha = __builtin_amdgcn_exp2f(mrun - mn); mrun = mn; lrun *= alpha;
#pragma unroll
        for (int d0 = 0; d0 < 4; ++d0)
#pragma unroll
            for (int g = 0; g < 16; ++g) o[d0][g] *= alpha;
    }
    float ps = 0.f;
#pragma unroll
    for (int g = 0; g < 16; ++g) { s0[g] = __builtin_amdgcn_exp2f(s0[g] - mrun); ps += s0[g]; }
    lrun += ps;
}
DI void dil_wave_unit(LAS unsigned char* wl, unsigned char* ws, int p, int b, int h, int res, int m0w, const int tid_in) {
    int tid = tid_in; asm volatile("" : "+v"(tid));
    const int lane = tid & 63, r = lane & 31, hh = lane >> 5; const int dil = p == 0 ? 1 : p == 1 ? 4 : 16;
    const bf16_t *QB = (const bf16_t*)(ws + WS_QB), *KB = (const bf16_t*)(ws + WS_KB), *VB = (const bf16_t*)(ws + WS_VB);
    const size_t rowbase = (size_t)b * SEQ; const size_t qrow = rowbase + (size_t)(m0w + r) * dil + res;
    const __amdgpu_buffer_rsrc_t rK = mk_rsrc(KB, M * 1024 * 2), rV = mk_rsrc(VB, M * 1024 * 2);
    const unsigned vo = (unsigned)(lane >> 4) * dil * 2048 + (lane & 15) * 16;
    const unsigned so0 = (unsigned)((rowbase + res) * 1024 + h * 128) * 2;
    const float* biasc = (const float*)(ws + WS_BIASC) + (size_t)(p * 8 + h) * 5 * 1024 + lane * 16;
    u32x4 kr[8], vr[8]; f32x4 br[4];
    const int kb0 = m0w >> 5;
#define DIL_LOAD(di) do { const unsigned sb_ = so0 + (unsigned)(32 * (kb0 - (di))) * dil * 2048; \
        _Pragma("unroll") for (int i = 0; i < 8; ++i) { kr[i] = bload(rK, vo + (unsigned)(4 * i) * dil * 2048, sb_); vr[i] = bload(rV, vo + (unsigned)(4 * i) * dil * 2048, sb_); } \
        _Pragma("unroll") for (int j = 0; j < 4; ++j) br[j] = ((const f32x4*)(biasc + (di) * 1024))[j]; } while (0)
    DIL_LOAD(0);
    bf16x8 qf[8];
#pragma unroll
    for (int d0 = 0; d0 < 8; ++d0) qf[d0] = *(const bf16x8*)(QB + qrow * 1024 + h * 128 + d0 * 16 + hh * 8);
    f32x16 o[4];
#pragma unroll
    for (int d0 = 0; d0 < 4; ++d0)
#pragma unroll
        for (int g = 0; g < 16; ++g) o[d0][g] = 0.f;
    float mrun = -INFINITY, lrun = 0.f;
    const VAddr va = make_vaddr(lane);
    const unsigned lk = (lane >> 4) * DIL_KSTR + (lane & 15) * 16;
    for (int di = 0; di < 5; ++di) {
        if (kb0 - di < 0) break;
        asm volatile("s_waitcnt lgkmcnt(0)" ::: "memory");
#pragma unroll
        for (int i = 0; i < 8; ++i) { *(LAS u32x4*)(wl + lk + 4 * i * DIL_KSTR) = kr[i]; *(LAS u32x4*)(wl + 32 * DIL_KSTR + off_b((lane >> 4) + 4 * i, lane & 15)) = vr[i]; }
        f32x16 s0;
#pragma unroll
        for (int j = 0; j < 4; ++j) { s0[4 * j] = br[j][0]; s0[4 * j + 1] = br[j][1]; s0[4 * j + 2] = br[j][2]; s0[4 * j + 3] = br[j][3]; }
        if (di + 1 < 5 && kb0 - (di + 1) >= 0) DIL_LOAD(di + 1);
        asm volatile("s_waitcnt lgkmcnt(0)" ::: "memory");
        lcp kp = wl + r * DIL_KSTR + hh * 16;
#pragma unroll
        for (int d0 = 0; d0 < 8; ++d0) s0 = MFMA_BF16(*(LAS const bf16x8*)(kp + d0 * 32), qf[d0], s0);
        softmax_blk(s0, o, mrun, lrun);
        lcp vb = wl + 32 * DIL_KSTR;
#pragma unroll
        for (int s = 0; s < 2; ++s) { const bf16x8 pf = pack_bf(s0, s);
#pragma unroll
            for (int d0 = 0; d0 < 4; ++d0) o[d0] = MFMA_BF16(vfrag(vb, s, d0, va), pf, o[d0]); }
    }
#undef DIL_LOAD
    const float lt = swap_sum(lrun), inv = 1.0f / lt;
    bf16_t* OP = (bf16_t*)(ws + (p == 0 ? WS_OP0 : p == 1 ? WS_OP1 : WS_OP2));
#pragma unroll
    for (int d0 = 0; d0 < 4; ++d0)
#pragma unroll
        for (int gg = 0; gg < 4; ++gg) { const size_t off = qrow * 1024 + h * 128 + 32 * d0 + 8 * gg + 4 * hh;
            const unsigned lo = cvtpk(o[d0][4 * gg] * inv, o[d0][4 * gg + 1] * inv), hi = cvtpk(o[d0][4 * gg + 2] * inv, o[d0][4 * gg + 3] * inv);
            *(unsigned long long*)(OP + off) = (unsigned long long)lo | ((unsigned long long)hi << 32); }
    if (hh == 0) ((float*)(ws + WS_LSE))[((size_t)p * M + qrow) * 8 + h] = mrun + __builtin_amdgcn_logf(lt);
}
constexpr int DILW_LDS_BYTES = 12 * 8192;
DI void dil_wg_unit(LAS unsigned char* lds, unsigned char* ws, int p, int b, int h, int res, int m0, const int tid_in) {
    int tid = tid_in; asm volatile("" : "+v"(tid));
    const int lane = tid & 63, wid = __builtin_amdgcn_readfirstlane(tid >> 6), r = lane & 31, hh = lane >> 5; const int dil = p == 0 ? 1 : p == 1 ? 4 : 16;
    const bf16_t *QB = (const bf16_t*)(ws + WS_QB), *KB = (const bf16_t*)(ws + WS_KB), *VB = (const bf16_t*)(ws + WS_VB);
    const size_t rowbase = (size_t)b * SEQ; const size_t qrow = rowbase + (size_t)(m0 + 32 * wid + r) * dil + res;
    const int kbw = (m0 >> 5) - 4;
    const int prow = 4 * wid + (lane >> 4);
    const unsigned ksw = ((lane & 15) ^ (prow & 15)) * 8, vsw = ((lane & 15) ^ (((prow & 3) << 2) | ((prow >> 2) & 3))) * 8;
    const bf16_t* kg = KB + (rowbase + res) * 1024 + h * 128; const bf16_t* vg = VB + (rowbase + res) * 1024 + h * 128;
#pragma unroll
    for (int i = 0; i < 12; ++i) { const int kb = kbw + i; if (kb >= 0)
        __builtin_amdgcn_global_load_lds((const unsigned*)(kg + (size_t)(32 * kb + prow) * dil * 1024 + ksw), (LAS unsigned*)(lds + i * 8192 + wid * 1024), 16, 0, 0); }
    bf16x8 qf[8];
#pragma unroll
    for (int d0 = 0; d0 < 8; ++d0) qf[d0] = *(const bf16x8*)(QB + qrow * 1024 + h * 128 + d0 * 16 + hh * 8);
    const float* biasc = (const float*)(ws + WS_BIASC) + (size_t)(p * 8 + h) * 5 * 1024 + lane * 16;
    f32x16 sc[5];
#pragma unroll
    for (int di = 0; di < 5; ++di) { const f32x4* bp = (const f32x4*)(biasc + di * 1024);
#pragma unroll
        for (int j = 0; j < 4; ++j) { const f32x4 v = bp[j]; sc[di][4 * j] = v[0]; sc[di][4 * j + 1] = v[1]; sc[di][4 * j + 2] = v[2]; sc[di][4 * j + 3] = v[3]; } }
    __builtin_amdgcn_s_waitcnt(0x0F70);
    __syncthreads();
    const unsigned kx = ((r & 15) >> 1) << 5, krow_off = r * 256 + ((hh ^ (r & 1)) << 4);
#pragma unroll
    for (int di = 0; di < 5; ++di) { const int jj = wid + 4 - di;
        if (kbw + jj >= 0) { lcp kp = lds + jj * 8192 + krow_off;
#pragma unroll
            for (int k = 0; k < 8; ++k) sc[di] = MFMA_BF16(*(LAS const bf16x8*)(kp + ((32u * k) ^ kx)), qf[k], sc[di]); }
        else {
#pragma unroll
            for (int g = 0; g < 16; ++g) sc[di][g] = -INFINITY; } }
    float mx = sc[0][0];
#pragma unroll
    for (int di = 0; di < 5; ++di)
#pragma unroll
        for (int g = 0; g < 16; ++g) mx = fmaxf(mx, sc[di][g]);
    mx = swap_max(mx);
    float ps = 0.f; u32x4 pw[5][2];
#pragma unroll
    for (int di = 0; di < 5; ++di) {
#pragma unroll
        for (int g = 0; g < 16; ++g) { sc[di][g] = __builtin_amdgcn_exp2f(sc[di][g] - mx); ps += sc[di][g]; }
        pw[di][0] = __builtin_bit_cast(u32x4, pack_bf(sc[di], 0)); pw[di][1] = __builtin_bit_cast(u32x4, pack_bf(sc[di], 1)); }
    __syncthreads();
#pragma unroll
    for (int i = 0; i < 12; ++i) { const int kb = kbw + i; if (kb >= 0)
        __builtin_amdgcn_global_load_lds((const unsigned*)(vg + (size_t)(32 * kb + prow) * dil * 1024 + vsw), (LAS unsigned*)(lds + i * 8192 + wid * 1024), 16, 0, 0); }
    f32x16 o[4];
#pragma unroll
    for (int d0 = 0; d0 < 4; ++d0)
#pragma unroll
        for (int g = 0; g < 16; ++g) o[d0][g] = 0.f;
    const VAddr va = make_vaddr(lane);
    __builtin_amdgcn_s_waitcnt(0x0F70);
    __syncthreads();
#pragma unroll
    for (int di = 0; di < 5; ++di) { const int jj = wid + 4 - di;
        if (kbw + jj >= 0) { lcp vb = lds + jj * 8192;
#pragma unroll
            for (int s = 0; s < 2; ++s)
#pragma unroll
                for (int d0 = 0; d0 < 4; ++d0) o[d0] = MFMA_BF16(vfrag(vb, s, d0, va), __builtin_bit_cast(bf16x8, pw[di][s]), o[d0]); } }
    const float lt = swap_sum(ps), inv = 1.0f / lt;
    bf16_t* OP = (bf16_t*)(ws + (p == 0 ? WS_OP0 : p == 1 ? WS_OP1 : WS_OP2));
#pragma unroll
    for (int d0 = 0; d0 < 4; ++d0)
#pragma unroll
        for (int pp = 0; pp < 2; ++pp) { const size_t off = qrow * 1024 + h * 128 + 32 * d0 + 16 * pp + 8 * hh; float e[8]; o_pair8(o[d0], pp, e); u32x4 w;
#pragma unroll
            for (int j = 0; j < 4; ++j) w[j] = cvtpk(e[2 * j] * inv, e[2 * j + 1] * inv);
            *(u32x4*)(OP + off) = w; }
    if (hh == 0) ((float*)(ws + WS_LSE))[((size_t)p * M + qrow) * 8 + h] = mx + __builtin_amdgcn_logf(lt);
    __syncthreads();
}
DI void dil_phase(LAS unsigned char* lds, unsigned char* ws, const int tid) {
    for (int u = blockIdx.x; u < 1536; u += gridDim.x) {
        const int cidx = u & 15, h = (u >> 4) & 7, b = (u >> 7) & 3, p = u >> 9;
        const int res = p == 0 ? 0 : p == 1 ? (cidx & 3) : cidx, m0 = p == 0 ? 256 * cidx : p == 1 ? 256 * (cidx >> 2) : 0;
        dil_wg_unit(lds, ws, p, b, h, res, m0, tid);
    }
}
}

__global__ void __launch_bounds__(512, 2) k_mla_fast(Ctx c) { extern __shared__ __attribute__((aligned(16))) unsigned char lds[]; att::mla_phase((LAS unsigned char*)lds, c.ws, (int)threadIdx.x); }
__global__ void __launch_bounds__(512, 2) k_sb_fast(Ctx c) { extern __shared__ __attribute__((aligned(16))) unsigned char lds[]; att::sb_phase<0>((LAS unsigned char*)lds, c.ws, (int)threadIdx.x); }
__global__ void __launch_bounds__(512, 2) k_dil_fast(Ctx c) { extern __shared__ __attribute__((aligned(16))) unsigned char lds[]; att::dil_phase((LAS unsigned char*)lds, c.ws, (int)threadIdx.x); }

template <bool FROMBF>
DI void final_norm_row(float* out, const bf16_t* xb, const float* gain, int row, int lane) {
    f32x4* xr = (f32x4*)(out + (size_t)row * D_MODEL) + lane; const f32x4* g = (const f32x4*)gain + lane;
    f32x4 v[8]; float s = 0.f;
    if (FROMBF) { const u32x4* br = (const u32x4*)(xb + (size_t)row * D_MODEL) + lane;
#pragma unroll
        for (int j = 0; j < 4; ++j) { const u32x4 w = br[64 * j];
            v[2 * j] = (f32x4){__uint_as_float(w[0] << 16), __uint_as_float(w[0] & 0xffff0000u), __uint_as_float(w[1] << 16), __uint_as_float(w[1] & 0xffff0000u)};
            v[2 * j + 1] = (f32x4){__uint_as_float(w[2] << 16), __uint_as_float(w[2] & 0xffff0000u), __uint_as_float(w[3] << 16), __uint_as_float(w[3] & 0xffff0000u)}; }
#pragma unroll
        for (int j = 0; j < 8; ++j) s += v[j].x * v[j].x + v[j].y * v[j].y + v[j].z * v[j].z + v[j].w * v[j].w;
        const float r = rsqrtf(wave_sum(s) * (1.0f / D_MODEL) + EPS);
        f32x4* o4 = (f32x4*)(out + (size_t)row * D_MODEL); const f32x4* g4 = (const f32x4*)gain;
#pragma unroll
        for (int j = 0; j < 4; ++j) { const int i0 = 128 * j + 2 * lane; o4[i0] = v[2 * j] * r * g4[i0]; o4[i0 + 1] = v[2 * j + 1] * r * g4[i0 + 1]; }
    } else {
#pragma unroll
        for (int j = 0; j < 8; ++j) { v[j] = xr[64 * j]; s += v[j].x * v[j].x + v[j].y * v[j].y + v[j].z * v[j].z + v[j].w * v[j].w; }
        const float r = rsqrtf(wave_sum(s) * (1.0f / D_MODEL) + EPS);
#pragma unroll
        for (int j = 0; j < 8; ++j) xr[64 * j] = v[j] * r * g[64 * j];
    }
}
__global__ void __launch_bounds__(256) k_final_norm(float* out, const float* gain) { final_norm_row<false>(out, nullptr, gain, blockIdx.x * 4 + (threadIdx.x >> 6), threadIdx.x & 63); }
__global__ void __launch_bounds__(256) k_final_norm_bf(float* out, const bf16_t* xb, const float* gain) { final_norm_row<true>(out, xb, gain, blockIdx.x * 4 + (threadIdx.x >> 6), threadIdx.x & 63); }

#define XB_TMO      128
#define XB_XCNT(j)  (256  + 64 * (j))
#define XB_XSUB(j)  (1280 + 64 * (j))
#define XB_XGEN(j)  (2304 + 64 * (j))
#define XB_TOP      3328
#define XB_TOPGEN   3392
#define XCD_BAR_WORDS 3456
#define XB_SPIN_CAP (1u << 22)
DI unsigned xb_ld(unsigned* p)              { return __hip_atomic_load(p, __ATOMIC_RELAXED, __HIP_MEMORY_SCOPE_AGENT); }
DI unsigned xb_add(unsigned* p, unsigned v) { return __hip_atomic_fetch_add(p, v, __ATOMIC_RELAXED, __HIP_MEMORY_SCOPE_AGENT); }
DI unsigned xb_xcc_id() { return (unsigned)__builtin_amdgcn_s_getreg((3 << 11) | 20) & 0xFu; }
#define XB_SPIN(cond, bar) do { unsigned _sp = 0; while (cond) { __builtin_amdgcn_s_sleep(1); \
    if ((++_sp & 255u) == 0u) { if (xb_ld(&(bar)[XB_TMO])) break; if (_sp > XB_SPIN_CAP) { atomicAdd(&(bar)[XB_TMO], 1u); break; } } } } while (0)
struct XcdBarrier { unsigned* bar; unsigned x; volatile LAS unsigned* st; };
DI XcdBarrier xcd_barrier_post(unsigned* bar, volatile LAS unsigned* st, int tid) {
    XcdBarrier b; b.bar = bar; b.x = xb_xcc_id(); b.st = st;
    if (tid == 0) (void)xb_add(&bar[XB_XCNT(b.x)], 1u);
    return b;
}
DI void xcd_barrier_complete(unsigned* bar, unsigned x, unsigned& nloc, unsigned& nx) {
    const unsigned G = gridDim.x * gridDim.y * gridDim.z;
    unsigned sum, cnt, mine, sp = 0u;
    for (;;) {
        sum = 0u; cnt = 0u; mine = 0u;
#pragma unroll
        for (unsigned j = 0; j < 16; ++j) { const unsigned c = xb_ld(&bar[XB_XCNT(j)]); sum += c; cnt += (c > 0u) ? 1u : 0u; mine = (j == x) ? c : mine; }
        if (sum == G) break;
        __builtin_amdgcn_s_sleep(1);
        if ((++sp & 255u) == 0u) { if (xb_ld(&bar[XB_TMO])) break; if (sp > XB_SPIN_CAP) { atomicAdd(&bar[XB_TMO], 1u); break; } }
    }
    nloc = mine > 0u ? mine : 1u; nx = cnt > 0u ? cnt : 1u;
}
DI void xcd_barrier(const XcdBarrier& b, int tid) {
    asm volatile("s_waitcnt vmcnt(0)" ::: "memory");
    __syncthreads();
    if (tid == 0) {
        unsigned* bar = b.bar;
        __builtin_amdgcn_s_waitcnt(0);
        unsigned nloc = b.st[0], nx = b.st[1];
        if (nloc == 0u) { xcd_barrier_complete(bar, b.x, nloc, nx); b.st[0] = nloc; b.st[1] = nx; }
        const unsigned old = xb_add(&bar[XB_XSUB(b.x)], 1u);
        const unsigned gen = old / nloc;
        if (old + 1u == (gen + 1u) * nloc) {
            __builtin_amdgcn_fence(__ATOMIC_RELEASE, "agent");
            asm volatile("s_waitcnt vmcnt(0)" ::: "memory");
            const unsigned og = xb_add(&bar[XB_TOP], 1u);
            const unsigned tg = og / nx;
            if (og + 1u == (tg + 1u) * nx) xb_add(&bar[XB_TOPGEN], 1u);
            else XB_SPIN(xb_ld(&bar[XB_TOPGEN]) == tg, bar);
            __builtin_amdgcn_fence(__ATOMIC_ACQUIRE, "agent");
            xb_add(&bar[XB_XGEN(b.x)], 1u);
            asm volatile("s_waitcnt vmcnt(0)" ::: "memory");
        } else {
            XB_SPIN(xb_ld(&bar[XB_XGEN(b.x)]) == gen, bar);
            __builtin_amdgcn_fence(__ATOMIC_ACQUIRE, "agent");
            asm volatile("s_waitcnt vmcnt(0)" ::: "memory");
        }
    }
    __syncthreads();
}

constexpr int MEGA_LDS_PHASE = 135168, MEGA_LDS = MEGA_LDS_PHASE + 64;
#ifndef P4_REP
#define P4_REP 1
#endif
#ifndef SYNC_PROBE
#define SYNC_PROBE 0
#endif
#ifndef SB_PROBE_VAR
#define SB_PROBE_VAR 0
#endif
#ifndef PROBE_MASK
#define PROBE_MASK 0
#endif
#define PREP(k) for (int rep_ = 0; rep_ < 1 + ((PROBE_MASK >> (k)) & 1); ++rep_)
__global__ void __launch_bounds__(512, 2) k_mega(Ctx c) {
    extern __shared__ __attribute__((aligned(16))) unsigned char lds_raw[];
    LAS unsigned char* lds = (LAS unsigned char*)lds_raw;
    unsigned char* ws = c.ws; const int G = gridDim.x, bx = blockIdx.x;
    const int wave_s = __builtin_amdgcn_readfirstlane((int)threadIdx.x >> 6);
    volatile LAS unsigned* bst = (volatile LAS unsigned*)(lds + MEGA_LDS_PHASE);
    if (threadIdx.x < 16) bst[threadIdx.x] = 0u;
    __syncthreads();
    const XcdBarrier xbar = xcd_barrier_post((unsigned*)(ws + WS_CTL), bst, (int)threadIdx.x);
#define GRID_BAR() xcd_barrier(xbar, phase_tid(wave_s))
    PREP(0) { prep_phase<8, 0>(c, (float*)lds_raw, phase_tid(wave_s)); __syncthreads(); }
    GRID_BAR();
    PREP(1) { pg8::Gemm g{(const bf16_t*)(ws + WS_H0), (const bf16_t*)(ws + WS_WT_IN_E), M, IN_EVEN_PAD, 2048}; pg8::StaticOrder S; S.init(g.M, g.N, G, bx);
      pg8::gemm_phase<pg8::FEpi1, pg8::StaticOrder, true, true>(lds, g, S, pg8::FEpi1{ws}, phase_tid(wave_s)); }
    { const int nlast = (M / 256) * (IN_EVEN_PAD / 256) % G; const int nfree = nlast ? G - nlast : G, me = nlast ? bx - nlast : bx;
      if (me >= 0) { const int tid = phase_tid(wave_s); prep_weights<1>(c, (float*)lds_raw + (tid >> 6) * 64 * 36, tid & 63, me * 8 + (tid >> 6), nfree * 8); } }
    GRID_BAR();
    PREP(2) { att::dil_phase(lds, ws, phase_tid(wave_s));
    __syncthreads(); }
    PREP(7) { pg8::Gemm g{(const bf16_t*)(ws + WS_CQ), (const bf16_t*)(ws + WS_WT_UQ), M, 1536, 512}; pg8::StaticOrder S; S.init(g.M, g.N, G, bx);
      pg8::gemm_phase<pg8::FEpi2a, pg8::StaticOrder, true, true>(lds, g, S, pg8::FEpi2a{ws}, phase_tid(wave_s)); }
    PREP(7) { pg8::Gemm g{(const bf16_t*)(ws + WS_CKV), (const bf16_t*)(ws + WS_WT_UKV), M, 2048, 512}; pg8::StaticOrder S; S.init(g.M, g.N, G, bx);
      pg8::gemm_phase<pg8::FEpi2b, pg8::StaticOrder, true, true>(lds, g, S, pg8::FEpi2b{ws}, phase_tid(wave_s)); }
    GRID_BAR();
    PREP(3) att::mla_phase(lds, ws, phase_tid(wave_s));
    PREP(8) { const int tid = phase_tid(wave_s); for (int it = bx * 512 + tid; it < M * 128; it += G * 512) dil_merge_item(ws, it >> 7, (it & 127) * 8); }
    GRID_BAR();
    PREP(4) { pg8::Gemm g{(const bf16_t*)(ws + WS_MIX), (const bf16_t*)(ws + WS_WT_OUT_E), M, 2048, 2048}; pg8::StaticOrder S; S.init(g.M, g.N, G, bx); S.rep = P4_REP;
      pg8::gemm_phase<pg8::FEpi4, pg8::StaticOrder, false, true>(lds, g, S, pg8::FEpi4{ws, c.x, c.out}, phase_tid(wave_s)); }
    GRID_BAR();
    PREP(5) { pg8::Gemm g{(const bf16_t*)(ws + WS_X1BF), (const bf16_t*)(ws + WS_WT_IN_O), M, IN_ODD, 2048}; pg8::StaticOrder S; S.init(g.M, g.N, G, bx);
      pg8::gemm_phase<pg8::FEpi5, pg8::StaticOrder, true, true>(lds, g, S, pg8::FEpi5{ws}, phase_tid(wave_s)); }
    GRID_BAR();
    PREP(6) att::sb_phase<0>(lds, ws, phase_tid(wave_s));
#if SB_PROBE_VAR
    att::sb_phase<SB_PROBE_VAR>(lds, ws, phase_tid(wave_s));
#endif
    GRID_BAR();
    { pg8::Gemm g{(const bf16_t*)(ws + WS_MIX2), (const bf16_t*)(ws + WS_WT_OUT_O), M, 2048, 2048}; pg8::StaticOrder S; S.init(g.M, g.N, G, bx);
      pg8::gemm_phase<pg8::FEpi7, pg8::StaticOrder, false, true>(lds, g, S, pg8::FEpi7{(bf16_t*)(ws + WS_X2BF), (const bf16_t*)(ws + WS_X1BF)}, phase_tid(wave_s)); }
    GRID_BAR();
#if SYNC_PROBE
    for (int i_ = 0; i_ < 8; ++i_) GRID_BAR();
#endif
    { const int tid = phase_tid(wave_s); for (int row = bx * 8 + (tid >> 6); row < M; row += G * 8) final_norm_row<true>(c.out, (const bf16_t*)(ws + WS_X2BF), c.final_gain, row, tid & 63); }
}

#ifndef MK_ONE_LAUNCH
#define MK_ONE_LAUNCH 1
#endif
#ifndef FAST_G1
#define FAST_G1 1
#endif
#ifndef FAST_G2
#define FAST_G2 1
#endif
#ifndef FAST_G4
#define FAST_G4 1
#endif
#ifndef FAST_G5
#define FAST_G5 1
#endif
#ifndef FAST_G7
#define FAST_G7 1
#endif
#ifndef FAST_MLA
#define FAST_MLA 1
#endif
#ifndef FAST_SB
#define FAST_SB 1
#endif
#ifndef FAST_DIL
#define FAST_DIL 1
#endif
static void launch_att(void (*k)(Ctx), int lds_bytes, const Ctx& c, hipStream_t s) {
    (void)hipFuncSetAttribute((const void*)k, hipFuncAttributeMaxDynamicSharedMemorySize, lds_bytes);
    hipLaunchKernelGGL(k, dim3(256), dim3(512), lds_bytes, s, c);
}
template <class Epi> static void launch_gemm_fast(const bf16_t* A, const bf16_t* Bt, int N, int K, Epi E, hipStream_t s) {
    static bool attr = false; if (!attr) { (void)hipFuncSetAttribute((const void*)k_gemm_fast<Epi>, hipFuncAttributeMaxDynamicSharedMemorySize, 131072); attr = true; }
    pg8::Gemm g{A, Bt, M, N, K};
    k_gemm_fast<Epi><<<256, 512, 131072, s>>>(g, E);
}

extern "C" void kernel_launch(void* const* d_in, const int* in_sizes, int n_in, void* d_out, int out_size, void* d_ws, size_t ws_size, hipStream_t stream) {
    if (n_in != 12 || out_size != M * D_MODEL || ws_size < WS_END) { fprintf(stderr, "kernel_launch: unexpected shapes (n_in %d out %d ws %zu)\n", n_in, out_size, ws_size); return; }
    Ctx c{};
    c.x = (const float*)d_in[0]; c.norm_gain = (const float*)d_in[1]; c.w_in_even = (const float*)d_in[2]; c.q_norm_gain = (const float*)d_in[3]; c.kv_norm_gain = (const float*)d_in[4];
    c.w_uq = (const float*)d_in[5]; c.w_ukv = (const float*)d_in[6]; c.w_out_even = (const float*)d_in[7]; c.rel_bias = (const float*)d_in[8]; c.w_in_odd = (const float*)d_in[9];
    c.w_out_odd = (const float*)d_in[10]; c.final_gain = (const float*)d_in[11]; c.out = (float*)d_out; c.ws = (unsigned char*)d_ws;
#if MK_ONE_LAUNCH
    static int grid_blocks = 0;
    if (!grid_blocks) {
        int dev = 0, cus = 0, per_cu = 0;
        (void)hipGetDevice(&dev); (void)hipDeviceGetAttribute(&cus, hipDeviceAttributeMultiprocessorCount, dev);
        (void)hipFuncSetAttribute((const void*)k_mega, hipFuncAttributeMaxDynamicSharedMemorySize, MEGA_LDS);
        (void)hipOccupancyMaxActiveBlocksPerMultiprocessor(&per_cu, (const void*)k_mega, 512, MEGA_LDS);
        if (per_cu < 1) { fprintf(stderr, "kernel_launch: occupancy query says %d blocks/CU\n", per_cu); per_cu = 1; }
        grid_blocks = cus;
    }
    (void)hipMemsetAsync((char*)d_ws + WS_CTL, 0, 65536, stream);
    { void* args[] = {&c};
      hipError_t e = hipLaunchCooperativeKernel((void*)k_mega, dim3(grid_blocks), dim3(512), args, MEGA_LDS, stream);
      if (e != hipSuccess) fprintf(stderr, "cooperative launch failed: %s (grid %d)\n", hipGetErrorString(e), grid_blocks); }
    return;
#endif
    unsigned char* ws = c.ws;
    const float* rc = (const float*)(ws + WS_ROPE); const float* rs = rc + 4096 * 32;
    k_prep<<<2048, 256, 0, stream>>>(c);
#if FAST_G1
    launch_gemm_fast((const bf16_t*)(ws + WS_H0), (const bf16_t*)(ws + WS_WT_IN_E), IN_EVEN_PAD, 2048, pg8::FEpi1{ws}, stream);
#else
    k_gemm_naive<Epi1><<<(M / 64) * (IN_EVEN_PAD / 64), 256, 0, stream>>>((const bf16_t*)(ws + WS_H0), (const bf16_t*)(ws + WS_WT_IN_E), IN_EVEN_PAD, 2048, Epi1{ws});
    k_rowss<false><<<M / 4, 256, 0, stream>>>(ws + WS_CQ, 512, 512, (float*)(ws + WS_SSC), 16, 8);
    k_rowss<false><<<M / 4, 256, 0, stream>>>(ws + WS_CKV, 512, 512, (float*)(ws + WS_SSC) + 8, 16, 8);
    k_rope<<<(M * 32 + 255) / 256, 256, 0, stream>>>((bf16_t*)(ws + WS_KR), 1, rc, rs);
#endif
#if FAST_DIL
    launch_att(k_dil_fast, att::DIL_LDS_BYTES, c, stream);
#else
    k_dil_naive<<<BATCH * 8 * SEQ / 4, 256, 0, stream>>>(c);
#endif
#if FAST_G2
    launch_gemm_fast((const bf16_t*)(ws + WS_CQ), (const bf16_t*)(ws + WS_WT_UQ), 1536, 512, pg8::FEpi2a{ws}, stream);
    launch_gemm_fast((const bf16_t*)(ws + WS_CKV), (const bf16_t*)(ws + WS_WT_UKV), 2048, 512, pg8::FEpi2b{ws}, stream);
#else
    k_gemm_naive<Epi2a><<<(M / 64) * (1536 / 64), 256, 0, stream>>>((const bf16_t*)(ws + WS_CQ), (const bf16_t*)(ws + WS_WT_UQ), 1536, 512, Epi2a{ws});
    k_rope<<<(M * 256 + 255) / 256, 256, 0, stream>>>((bf16_t*)(ws + WS_QR), 8, rc, rs);
    k_gemm_naive<Epi2b><<<(M / 64) * (2048 / 64), 256, 0, stream>>>((const bf16_t*)(ws + WS_CKV), (const bf16_t*)(ws + WS_WT_UKV), 2048, 512, Epi2b{ws});
#endif
#if FAST_MLA
    launch_att(k_mla_fast, att::M2_LDS_BYTES > att::MLA_LDS_BYTES ? att::M2_LDS_BYTES : att::MLA_LDS_BYTES, c, stream);
#else
    k_mla_naive<<<BATCH * 8 * SEQ / 4, 256, 0, stream>>>(c);
#endif
    k_dil_merge<<<M, 128, 0, stream>>>(c);
#if FAST_G4
    launch_gemm_fast((const bf16_t*)(ws + WS_MIX), (const bf16_t*)(ws + WS_WT_OUT_E), 2048, 2048, pg8::FEpi4{ws, c.x, c.out}, stream);
#else
    k_gemm_naive<Epi4><<<(M / 64) * (2048 / 64), 256, 0, stream>>>((const bf16_t*)(ws + WS_MIX), (const bf16_t*)(ws + WS_WT_OUT_E), 2048, 2048, Epi4{ws, c.x, c.out});
    k_rowss<true><<<M / 4, 256, 0, stream>>>(c.out, 2048, 2048, (float*)(ws + WS_SSX1), 32, 32);
#endif
#if FAST_G5
    launch_gemm_fast((const bf16_t*)(ws + WS_X1BF), (const bf16_t*)(ws + WS_WT_IN_O), IN_ODD, 2048, pg8::FEpi5{ws}, stream);
#else
    k_gemm_naive<Epi5><<<(M / 64) * (IN_ODD / 64), 256, 0, stream>>>((const bf16_t*)(ws + WS_X1BF), (const bf16_t*)(ws + WS_WT_IN_O), IN_ODD, 2048, Epi5{ws});
#endif
#if FAST_SB
    launch_att(k_sb_fast, att::SB_LDS_BYTES, c, stream);
#else
    k_sb_naive<<<BATCH * 16 * SEQ / 4, 256, 0, stream>>>(c);
#endif
#if FAST_G7
    launch_gemm_fast((const bf16_t*)(ws + WS_MIX2), (const bf16_t*)(ws + WS_WT_OUT_O), 2048, 2048, pg8::FEpi7{(bf16_t*)(ws + WS_X2BF), (const bf16_t*)(ws + WS_X1BF)}, stream);
#else
    k_gemm_naive<Epi7><<<(M / 64) * (2048 / 64), 256, 0, stream>>>((const bf16_t*)(ws + WS_MIX2), (const bf16_t*)(ws + WS_WT_OUT_O), 2048, 2048, Epi7{c.out});
#endif
#if FAST_G7
    k_final_norm_bf<<<M / 4, 256, 0, stream>>>(c.out, (const bf16_t*)(ws + WS_X2BF), c.final_gain);
#else
    k_final_norm<<<M / 4, 256, 0, stream>>>(c.out, c.final_gain);
#endif
}
```

```cpp
#include <hip/hip_runtime.h>
#include <cstdio>
#include <cstdint>
#include <cmath>

typedef unsigned short bf16_t;
typedef unsigned u32x4 __attribute__((ext_vector_type(4)));
typedef float f32x4 __attribute__((ext_vector_type(4)));

constexpr int D_MODEL = 2048, BATCH = 4, SEQ = 4096, M = BATCH * SEQ;
constexpr int NH_MLA = 8, NH_DIL = 8, NH_SB = 16, HD = 128;
constexpr int IN_EVEN = 6208, IN_EVEN_PAD = 6400, IN_ODD = 8192;
constexpr float EPS = 1e-6f;
constexpr float LOG2E = 1.4426950408889634f;
constexpr float MLA_QSCALE = 0.07216878364870322f * LOG2E;
constexpr float D128_QSCALE = 0.08838834764831845f * LOG2E;

constexpr size_t MiB = 1u << 20;
constexpr size_t WS_CTL = 0;
constexpr size_t WS_ROPE = 1 * MiB;
constexpr size_t WS_BIASN = 2 * MiB;
constexpr size_t WS_BIASC = 2 * MiB + 65536;
constexpr size_t WS_SSX = 3 * MiB;
constexpr size_t WS_SSC = 4 * MiB;
constexpr size_t WS_SSX1 = 5 * MiB;
constexpr size_t WS_LSE = 9 * MiB;
constexpr size_t WS_WT_IN_E = 12 * MiB;
constexpr size_t WS_WT_UQ = 37 * MiB;
constexpr size_t WS_WT_UKV = 39 * MiB;
constexpr size_t WS_WT_OUT_E = 41 * MiB;
constexpr size_t WS_WT_IN_O = 49 * MiB;
constexpr size_t WS_WT_OUT_O = 81 * MiB;
constexpr size_t WS_A = 90 * MiB;
constexpr size_t WS_B = 154 * MiB;
constexpr size_t WS_C = 218 * MiB;
constexpr size_t WS_H0 = WS_A, WS_OP0 = WS_A, WS_OP1 = WS_A + 32 * MiB, WS_X1BF = WS_A;
constexpr size_t WS_CQ = WS_B, WS_CKV = WS_B + 16 * MiB, WS_QB = WS_B + 32 * MiB, WS_MIX = WS_B, WS_MIX2 = WS_B;
constexpr size_t WS_KB = WS_C, WS_VB = WS_C + 32 * MiB, WS_SG = WS_C + 64 * MiB, WS_QN = WS_C + 128 * MiB, WS_QR = WS_C + 160 * MiB,
                 WS_KN = WS_C + 176 * MiB, WS_VA = WS_C + 208 * MiB, WS_KR = WS_C + 240 * MiB, WS_OP2 = WS_C + 242 * MiB;
constexpr size_t WS_X2BF = WS_C;
constexpr size_t WS_Q2 = WS_C, WS_K2 = WS_C + 64 * MiB, WS_V2 = WS_C + 128 * MiB, WS_SG2 = WS_C + 192 * MiB;
constexpr size_t WS_END = WS_C + 274 * MiB;

struct Ctx {
    const float *x, *norm_gain, *w_in_even, *q_norm_gain, *kv_norm_gain, *w_uq, *w_ukv, *w_out_even, *rel_bias, *w_in_odd, *w_out_odd, *final_gain;
    float* out; unsigned char* ws;
};

#define DI __device__ __forceinline__
DI int phase_tid(int wave_s) { int lane; asm volatile("v_mbcnt_lo_u32_b32 %0, -1, 0\n\tv_mbcnt_hi_u32_b32 %0, -1, %0" : "=v"(lane)); return wave_s * 64 + lane; }
DI float bf2f(bf16_t v) { return __uint_as_float(((unsigned)v) << 16); }
DI bf16_t f2bf(float f) { unsigned u = __float_as_uint(f); return (bf16_t)((u + 0x7fffu + ((u >> 16) & 1u)) >> 16); }
DI float wave_sum(float v) {
#pragma unroll
    for (int o = 1; o < 64; o <<= 1) v += __shfl_xor(v, o);
    return v;
}
DI float wave_max(float v) {
#pragma unroll
    for (int o = 1; o < 64; o <<= 1) v = fmaxf(v, __shfl_xor(v, o));
    return v;
}
DI float silu_f(float v) { return v / (1.0f + __expf(-v)); }

DI int map_in_even(int n) { if (n < 1024) return n; if (n < 1056) return 1024 + (n - 1024); if (n < 1088) return 1152 + (n - 1056); return n - 1088 + 1280; }
DI int map_uq(int n) { const int h = n / 192, j = n % 192; if (j < 128) return h * 128 + j; if (j < 160) return 1024 + (h >> 2) * 256 + (h & 3) * 32 + (j - 128);
    return 1024 + (h >> 2) * 256 + 128 + (h & 3) * 32 + (j - 160); }
DI int map_ukv(int n) { const int h = n / 256, j = n % 256; if (j < 128) return h * 128 + j; return 1024 + h * 128 + (j - 128); }
DI int map_id(int n) { return n; }

template <int MAPID>
DI void transpose_item(const float* W, int K, int N, const float* gain, bf16_t* WT, float* scr  , int item, int lane) {
    const int nblk = N / 32, kb = item / nblk, nb = item % nblk, k0 = 64 * kb, n0 = 32 * nb;
    f32x4 v[8];
#pragma unroll
    for (int i = 0; i < 8; ++i) { const int kk = 8 * i + (lane >> 3); v[i] = *(const f32x4*)(W + (size_t)(k0 + kk) * N + n0 + 4 * (lane & 7)); }
#pragma unroll
    for (int i = 0; i < 8; ++i) { const int kk = 8 * i + (lane >> 3); const float g = gain ? gain[k0 + kk] : 1.0f; *(f32x4*)(scr + kk * 36 + 4 * (lane & 7)) = v[i] * g; }
    asm volatile("s_waitcnt lgkmcnt(0)" ::: "memory");
    const int d0 = MAPID == 0 ? map_in_even(n0) : MAPID == 1 ? map_uq(n0) : MAPID == 2 ? map_ukv(n0) : map_id(n0);
    const int c = lane & 7;
#pragma unroll
    for (int j = 0; j < 4; ++j) { const int n = (lane >> 3) + 8 * j; const float* s = scr + (8 * c) * 36 + n;
        u32x4 o; o.x = f2bf(s[0]) | ((unsigned)f2bf(s[36]) << 16); o.y = f2bf(s[72]) | ((unsigned)f2bf(s[108]) << 16);
        o.z = f2bf(s[144]) | ((unsigned)f2bf(s[180]) << 16); o.w = f2bf(s[216]) | ((unsigned)f2bf(s[252]) << 16);
        *(u32x4*)(WT + (size_t)(d0 + n) * K + k0 + 8 * c) = o; }
    asm volatile("s_waitcnt lgkmcnt(0)" ::: "memory");
}

DI int t5_bucket(int dist) {
    if (dist < 16) return dist;
    float d = (float)dist;
    int large = 16 + (int)(logf(d / 16.0f) / 4.852030263919617f * 16.0f);
    return large < 31 ? large : 31;
}

template <int PART> DI void prep_weights(const Ctx& c, float* scr, int lane, int gw, int NGW) {
    unsigned char* ws = c.ws;
    constexpr int I0 = (2048 / 64) * (IN_EVEN / 32), I1 = (512 / 64) * (1536 / 32), I2 = (512 / 64) * (2048 / 32), I3 = (2048 / 64) * (2048 / 32),
                  I4 = (2048 / 64) * (IN_ODD / 32), I5 = I3;
    constexpr int LO = PART == 1 ? I0 : 0, HI = PART == 0 ? I0 : I0 + I1 + I2 + I3 + I4 + I5;
    for (int it = LO + gw; it < HI; it += NGW) {
        int r = it;
        if (r < I0) { transpose_item<0>(c.w_in_even, 2048, IN_EVEN, c.norm_gain, (bf16_t*)(ws + WS_WT_IN_E), scr, r, lane); continue; } r -= I0;
        if (r < I1) { transpose_item<1>(c.w_uq, 512, 1536, c.q_norm_gain, (bf16_t*)(ws + WS_WT_UQ), scr, r, lane); continue; } r -= I1;
        if (r < I2) { transpose_item<2>(c.w_ukv, 512, 2048, c.kv_norm_gain, (bf16_t*)(ws + WS_WT_UKV), scr, r, lane); continue; } r -= I2;
        if (r < I3) { transpose_item<3>(c.w_out_even, 2048, 2048, nullptr, (bf16_t*)(ws + WS_WT_OUT_E), scr, r, lane); continue; } r -= I3;
        if (r < I4) { transpose_item<3>(c.w_in_odd, 2048, IN_ODD, c.norm_gain + 2048, (bf16_t*)(ws + WS_WT_IN_O), scr, r, lane); continue; } r -= I4;
        transpose_item<3>(c.w_out_odd, 2048, 2048, nullptr, (bf16_t*)(ws + WS_WT_OUT_O), scr, r, lane);
    }
}
template <int NW, int PART> DI void prep_phase(const Ctx& c, float* scr_all, const int tid) {
    const int lane = tid & 63, wave = tid >> 6;
    float* scr = scr_all + wave * 64 * 36;
    const int gw = blockIdx.x * NW + wave, NGW = gridDim.x * NW;
    unsigned char* ws = c.ws;
    prep_weights<PART>(c, scr, lane, gw, NGW);
    const int gt = blockIdx.x * (NW * 64) + tid, NGT = gridDim.x * (NW * 64);
    { bf16_t* wt = (bf16_t*)(ws + WS_WT_IN_E);
      for (int i = gt; i < 192 * 256; i += NGT) { const int rr = i / 256, cc = i % 256; const int row = rr < 96 ? 1056 + rr : 1184 + (rr - 96);
          *(u32x4*)(wt + (size_t)row * 2048 + cc * 8) = (u32x4){0u, 0u, 0u, 0u}; } }
    { float* rc = (float*)(ws + WS_ROPE); float* rs = rc + 4096 * 32;
      for (int i = gt; i < 4096 * 32; i += NGT) { const int pos = i >> 5, j = i & 31; const float inv = 1.0f / powf(10000.0f, (float)j / 32.0f); const float ang = (float)pos * inv;
          rc[i] = cosf(ang); rs[i] = sinf(ang); } }
    { float* bn = (float*)(ws + WS_BIASN);
      for (int i = gt; i < 3 * 8 * 132; i += NGT) { const int p = i / (8 * 132), h = (i / 132) % 8, rel = i % 132; const int dil = p == 0 ? 1 : p == 1 ? 4 : 16;
          bn[i] = rel <= 128 ? c.rel_bias[t5_bucket(rel * dil) * 8 + h] * LOG2E : 0.f; } }
    { float* bc = (float*)(ws + WS_BIASC);
      for (int i = gt; i < 3 * 8 * 5 * 1024; i += NGT) { const int g = i & 15, ln = (i >> 4) & 63, di = (i >> 10) % 5, ph = i / 5120, h = ph & 7, p = ph >> 3; const int dil = p == 0 ? 1 : p == 1 ? 4 : 16;
          const int rel = 32 * di + (ln & 31) - ((g & 3) + 8 * (g >> 2) + 4 * (ln >> 5));
          bc[i] = (rel >= 0 && rel <= 128) ? c.rel_bias[t5_bucket(rel * dil) * 8 + h] * LOG2E : -INFINITY; } }
    { bf16_t* h0 = (bf16_t*)(ws + WS_H0); float* ssx = (float*)(ws + WS_SSX);
      for (int m = gw; m < M; m += NGW) { const f32x4* xr = (const f32x4*)(c.x + (size_t)m * D_MODEL) + lane; float s = 0.f;
          unsigned long long* o8 = (unsigned long long*)(h0 + (size_t)m * D_MODEL) + lane;
          for (int j = 0; j < 8; ++j) { const f32x4 v = xr[64 * j]; s += v.x * v.x + v.y * v.y + v.z * v.z + v.w * v.w;
              o8[64 * j] = (unsigned long long)(f2bf(v.x) | ((unsigned)f2bf(v.y) << 16)) | ((unsigned long long)(f2bf(v.z) | ((unsigned)f2bf(v.w) << 16)) << 32); }
          s = wave_sum(s); if (lane == 0) ssx[m] = s; } }
}

__global__ void __launch_bounds__(256) k_prep(Ctx c) { __shared__ float scr_all[4 * 64 * 36]; prep_phase<4, 2>(c, scr_all, (int)threadIdx.x); }

DI float rscale(const float* part, int n, float inv_cols) { float s = 0.f; for (int i = 0; i < n; ++i) s += part[i]; return rsqrtf(s * inv_cols + EPS); }

struct Epi1 {
    unsigned char* ws;
    DI void operator()(int row, int col, float acc) const {
        const float v = acc * rsqrtf(((const float*)(ws + WS_SSX))[row] * (1.0f / 2048.0f) + EPS);
        if (col < 512) ((bf16_t*)(ws + WS_CQ))[(size_t)row * 512 + col] = f2bf(v);
        else if (col < 1024) ((bf16_t*)(ws + WS_CKV))[(size_t)row * 512 + col - 512] = f2bf(v);
        else if (col < 1280) { const int t = col - 1024; if (t < 32) ((bf16_t*)(ws + WS_KR))[(size_t)row * 64 + t] = f2bf(v); else if (t >= 128 && t < 160) ((bf16_t*)(ws + WS_KR))[(size_t)row * 64 + 32 + t - 128] = f2bf(v); }
        else if (col < 2304) ((bf16_t*)(ws + WS_QB))[(size_t)row * 1024 + col - 1280] = f2bf(v * D128_QSCALE);
        else if (col < 3328) ((bf16_t*)(ws + WS_KB))[(size_t)row * 1024 + col - 2304] = f2bf(v);
        else if (col < 4352) ((bf16_t*)(ws + WS_VB))[(size_t)row * 1024 + col - 3328] = f2bf(v);
        else ((bf16_t*)(ws + WS_SG))[(size_t)row * 2048 + col - 4352] = f2bf(silu_f(v));
    }
};
struct Epi2a {
    unsigned char* ws;
    DI void operator()(int row, int col, float acc) const {
        const float v = acc * rscale((const float*)(ws + WS_SSC) + (size_t)row * 16, 8, 1.0f / 512.0f) * MLA_QSCALE;
        if (col < 1024) ((bf16_t*)(ws + WS_QN))[(size_t)row * 1024 + col] = f2bf(v);
        else { const int t = col - 1024, grp = t >> 8, u = t & 255, half = u >> 7, hh = (u & 127) >> 5, i = u & 31;
            ((bf16_t*)(ws + WS_QR))[(size_t)row * 512 + (4 * grp + hh) * 64 + half * 32 + i] = f2bf(v); }
    }
};
struct Epi2b {
    unsigned char* ws;
    DI void operator()(int row, int col, float acc) const {
        const float v = acc * rscale((const float*)(ws + WS_SSC) + (size_t)row * 16 + 8, 8, 1.0f / 512.0f);
        if (col < 1024) ((bf16_t*)(ws + WS_KN))[(size_t)row * 1024 + col] = f2bf(v); else ((bf16_t*)(ws + WS_VA))[(size_t)row * 1024 + col - 1024] = f2bf(v);
    }
};
struct Epi4 {
    unsigned char* ws; const float* x; float* out;
    DI void operator()(int row, int col, float acc) const {
        const float v = x[(size_t)row * 2048 + col] + acc; out[(size_t)row * 2048 + col] = v; ((bf16_t*)(ws + WS_X1BF))[(size_t)row * 2048 + col] = f2bf(v);
    }
};
struct Epi5 {
    unsigned char* ws;
    DI void operator()(int row, int col, float acc) const {
        const float v = acc * rscale((const float*)(ws + WS_SSX1) + (size_t)row * 32, 32, 1.0f / 2048.0f);
        if (col < 2048) ((bf16_t*)(ws + WS_Q2))[(size_t)row * 2048 + col] = f2bf(v * D128_QSCALE);
        else if (col < 4096) ((bf16_t*)(ws + WS_K2))[(size_t)row * 2048 + col - 2048] = f2bf(v);
        else if (col < 6144) ((bf16_t*)(ws + WS_V2))[(size_t)row * 2048 + col - 4096] = f2bf(v);
        else ((bf16_t*)(ws + WS_SG2))[(size_t)row * 2048 + col - 6144] = f2bf(silu_f(v));
    }
};
struct Epi7 {
    float* out;
    DI void operator()(int row, int col, float acc) const { out[(size_t)row * 2048 + col] += acc; }
};

namespace pg8 {
#define PG8_LAS __attribute__((address_space(3)))
typedef short bf16x8 __attribute__((ext_vector_type(8)));
constexpr int BM = 256, BK = 64, HALF = 128, HTB = HALF * BK * 2  , STAGE_BYTES = 8 * HTB, NXCD = 8, WGM = 8;

__host__ __device__ __forceinline__ int lds_byte(int r, int c) { const int st = (r >> 4) * 2 + (c >> 5), rr = r & 15, cc = c & 31, ob = rr * 64 + cc * 2; return st * 1024 + (ob ^ (((ob >> 9) & 1) << 5)); }
__host__ __device__ __forceinline__ void stage_rc(int b, int& R, int& C) { const int st = b / 1024, sb = b % 1024, swz = sb ^ (((sb >> 9) & 1) << 5); R = (st >> 1) * 16 + swz / 64; C = (st & 1) * 32 + (swz % 64) / 2; }
__host__ __device__ __forceinline__ int perm32(int rho) { const int n = rho >> 4, i = rho & 15; return 8 * (i >> 2) + 4 * n + (i & 3); }

struct Unit { int pm, pn; };
struct Gemm { const bf16_t* A; const bf16_t* Bt; int M, N, K; };

struct StaticOrder {
    int nM, nN, nwg, G, c, rep = 1;
    __host__ __device__ void init(int M, int N, int G_, int c_) { nM = M / BM; nN = N / BM; nwg = nM * nN; G = G_; c = c_; }
    __host__ __device__ bool next(int i, Unit& u) const {
        long L = (long)i * G + c; if (L >= (long)nwg * rep) return false; L %= nwg;
        int wgid = (int)L; { const int q = nwg / NXCD, r = nwg % NXCD, xcd = wgid % NXCD, off = wgid / NXCD; wgid = (xcd < r ? xcd * (q + 1) : r * (q + 1) + (xcd - r) * q) + off; }
        const int nig = WGM * nN, gid = wgid / nig, fm = gid * WGM, gsz = (nM - fm) < WGM ? (nM - fm) : WGM;
        u.pm = fm + ((wgid % nig) % gsz); u.pn = (wgid % nig) / gsz; return true;
    }
    __device__ __forceinline__ void a_ready(const Unit&) const {}
    __device__ __forceinline__ void done(const Unit&) const {}
};


typedef float f32x2_t __attribute__((ext_vector_type(2))); typedef __bf16 bf16x2_t __attribute__((ext_vector_type(2)));
__device__ __forceinline__ unsigned cvtpk(float lo, float hi) { f32x2_t v = {lo, hi}; bf16x2_t b = __builtin_convertvector(v, bf16x2_t); return __builtin_bit_cast(unsigned, b); }
__device__ __forceinline__ u32x4 pack8(const f32x4& a, const f32x4& b) { u32x4 w; w.x = cvtpk(a[0], a[1]); w.y = cvtpk(a[2], a[3]); w.z = cvtpk(b[0], b[1]); w.w = cvtpk(b[2], b[3]); return w; }
__device__ __forceinline__ float sumsq4(const f32x4& a) { return (a[0] * a[0] + a[1] * a[1]) + (a[2] * a[2] + a[3] * a[3]); }
__device__ __forceinline__ float silu1(float v) { return v * __builtin_amdgcn_rcpf(1.0f + __builtin_amdgcn_exp2f(-v * LOG2E)); }
__device__ __forceinline__ f32x4 silu4(const f32x4& a) { return (f32x4){silu1(a[0]), silu1(a[1]), silu1(a[2]), silu1(a[3])}; }
__device__ __forceinline__ float quad_sum(float s) { s += __shfl_xor(s, 16); s += __shfl_xor(s, 32); return s; }
__device__ __forceinline__ void rope8(const f32x4& a0, const f32x4& a1, const f32x4& b0, const f32x4& b1, const float* rc, const float* rs, int pos, int i0, u32x4& o1, u32x4& o2) {
    const f32x4 c0 = *(const f32x4*)(rc + pos * 32 + i0), c1 = *(const f32x4*)(rc + pos * 32 + i0 + 4), s0 = *(const f32x4*)(rs + pos * 32 + i0), s1 = *(const f32x4*)(rs + pos * 32 + i0 + 4);
    o1 = pack8(a0 * c0 - b0 * s0, a1 * c1 - b1 * s1); o2 = pack8(a0 * s0 + b0 * c0, a1 * s1 + b1 * c1);
}
#define PG8_EPI_ROWS(...) _Pragma("unroll") for (int ai = 0; ai < 2; ++ai) _Pragma("unroll") for (int m = 0; m < 4; ++m) { const int row = u.pm * BM + ai * HALF + wr * 64 + m * 16 + fr; __VA_ARGS__ }

struct FEpi1 {
    static constexpr bool PERM = true, AFTER_DRAIN = false; unsigned char* ws;
    __device__ __forceinline__ void operator()(const f32x4 (&acc)[2][2][4][2], const Unit& u, int wr, int wc, int fr, int fq) const {
        const int pn = u.pn, cw = wc * 32 + 8 * fq; const float* ssx = (const float*)(ws + WS_SSX);
        PG8_EPI_ROWS(
            const float rs = rsqrtf(ssx[row] * (1.0f / 2048.0f) + EPS);
            if (pn < 4) { bf16_t* dst = (bf16_t*)(ws + (pn < 2 ? WS_CQ : WS_CKV)) + (size_t)row * 512 + (pn & 1) * 256 + cw; float ss = 0.f;
                _Pragma("unroll") for (int bj = 0; bj < 2; ++bj) { const f32x4 v0 = acc[ai][bj][m][0] * rs, v1 = acc[ai][bj][m][1] * rs; ss += sumsq4(v0) + sumsq4(v1); *(u32x4*)(dst + bj * HALF) = pack8(v0, v1); }
                ss = quad_sum(ss); if (fq == 0) ((float*)(ws + WS_SSC))[(size_t)row * 16 + pn * 4 + wc] = ss; }
            else if (pn == 4) { if (wc == 0) { const float* rc = (const float*)(ws + WS_ROPE); u32x4 o1, o2;
                rope8(acc[ai][0][m][0] * rs, acc[ai][0][m][1] * rs, acc[ai][1][m][0] * rs, acc[ai][1][m][1] * rs, rc, rc + 4096 * 32, row % SEQ, 8 * fq, o1, o2);
                bf16_t* dst = (bf16_t*)(ws + WS_KR) + (size_t)row * 64 + 8 * fq; *(u32x4*)dst = o1; *(u32x4*)(dst + 32) = o2; } }
            else if (pn < 17) { const int t = pn - 5; bf16_t* dst = (bf16_t*)(ws + (t < 4 ? WS_QB : t < 8 ? WS_KB : WS_VB)) + (size_t)row * 1024 + (t & 3) * 256 + cw; const float sc = t < 4 ? rs * D128_QSCALE : rs;
                _Pragma("unroll") for (int bj = 0; bj < 2; ++bj) *(u32x4*)(dst + bj * HALF) = pack8(acc[ai][bj][m][0] * sc, acc[ai][bj][m][1] * sc); }
            else { bf16_t* dst = (bf16_t*)(ws + WS_SG) + (size_t)row * 2048 + (pn - 17) * 256 + cw;
                _Pragma("unroll") for (int bj = 0; bj < 2; ++bj) *(u32x4*)(dst + bj * HALF) = pack8(silu4(acc[ai][bj][m][0] * rs), silu4(acc[ai][bj][m][1] * rs)); }
        )
    }
};
struct FEpi2a {
    static constexpr bool PERM = true, AFTER_DRAIN = false; unsigned char* ws;
    __device__ __forceinline__ void operator()(const f32x4 (&acc)[2][2][4][2], const Unit& u, int wr, int wc, int fr, int fq) const {
        const int pn = u.pn, cw = wc * 32 + 8 * fq;
        PG8_EPI_ROWS(
            const f32x4* sp = (const f32x4*)((const float*)(ws + WS_SSC) + (size_t)row * 16); const f32x4 p0 = sp[0], p1 = sp[1];
            const float rs = rsqrtf(((p0[0] + p0[1]) + (p0[2] + p0[3]) + (p1[0] + p1[1]) + (p1[2] + p1[3])) * (1.0f / 512.0f) + EPS) * MLA_QSCALE;
            if (pn < 4) { bf16_t* dst = (bf16_t*)(ws + WS_QN) + (size_t)row * 1024 + pn * 256 + cw;
                _Pragma("unroll") for (int bj = 0; bj < 2; ++bj) *(u32x4*)(dst + bj * HALF) = pack8(acc[ai][bj][m][0] * rs, acc[ai][bj][m][1] * rs); }
            else { const float* rc = (const float*)(ws + WS_ROPE); u32x4 o1, o2; const int head = 4 * (pn - 4) + wc;
                rope8(acc[ai][0][m][0] * rs, acc[ai][0][m][1] * rs, acc[ai][1][m][0] * rs, acc[ai][1][m][1] * rs, rc, rc + 4096 * 32, row % SEQ, 8 * fq, o1, o2);
                bf16_t* dst = (bf16_t*)(ws + WS_QR) + (size_t)row * 512 + head * 64 + 8 * fq; *(u32x4*)dst = o1; *(u32x4*)(dst + 32) = o2; }
        )
    }
};
struct FEpi2b {
    static constexpr bool PERM = true, AFTER_DRAIN = false; unsigned char* ws;
    __device__ __forceinline__ void operator()(const f32x4 (&acc)[2][2][4][2], const Unit& u, int wr, int wc, int fr, int fq) const {
        const int pn = u.pn, cw = wc * 32 + 8 * fq;
        PG8_EPI_ROWS(
            const f32x4* sp = (const f32x4*)((const float*)(ws + WS_SSC) + (size_t)row * 16 + 8); const f32x4 p0 = sp[0], p1 = sp[1];
            const float rs = rsqrtf(((p0[0] + p0[1]) + (p0[2] + p0[3]) + (p1[0] + p1[1]) + (p1[2] + p1[3])) * (1.0f / 512.0f) + EPS);
            bf16_t* dst = (bf16_t*)(ws + (pn < 4 ? WS_KN : WS_VA)) + (size_t)row * 1024 + (pn & 3) * 256 + cw;
            _Pragma("unroll") for (int bj = 0; bj < 2; ++bj) *(u32x4*)(dst + bj * HALF) = pack8(acc[ai][bj][m][0] * rs, acc[ai][bj][m][1] * rs);
        )
    }
};
struct FEpi4 {
    static constexpr bool PERM = true, AFTER_DRAIN = false; unsigned char* ws; const float* x; float* out;
    __device__ __forceinline__ void operator()(const f32x4 (&acc)[2][2][4][2], const Unit& u, int wr, int wc, int fr, int fq) const {
        const int pn = u.pn, cw = pn * 256 + wc * 32 + 8 * fq;
        const size_t off0 = (size_t)(u.pm * BM + wr * 64 + fr) * 2048 + cw;
        f32x4 pre[2][4];
#define EPI4_LOAD(q, slot) { const float* p_ = x + off0 + (size_t)(((q) >> 2) * HALF + ((q) & 3) * 16) * 2048; pre[slot][0] = *(const f32x4*)p_; pre[slot][1] = *(const f32x4*)(p_ + 4); pre[slot][2] = *(const f32x4*)(p_ + HALF); pre[slot][3] = *(const f32x4*)(p_ + HALF + 4); }
        EPI4_LOAD(0, 0) EPI4_LOAD(1, 1)
#pragma unroll
        for (int q = 0; q < 8; ++q) { const int ai = q >> 2, m = q & 3; const size_t off = off0 + (size_t)(ai * HALF + m * 16) * 2048;
            const f32x4 v00 = pre[q & 1][0] + acc[ai][0][m][0], v01 = pre[q & 1][1] + acc[ai][0][m][1], v10 = pre[q & 1][2] + acc[ai][1][m][0], v11 = pre[q & 1][3] + acc[ai][1][m][1];
            if (q + 2 < 8) EPI4_LOAD(q + 2, q & 1)
            *(u32x4*)((bf16_t*)(ws + WS_X1BF) + off) = pack8(v00, v01); *(u32x4*)((bf16_t*)(ws + WS_X1BF) + off + HALF) = pack8(v10, v11);
            float ss = (sumsq4(v00) + sumsq4(v01)) + (sumsq4(v10) + sumsq4(v11));
            ss = quad_sum(ss); if (fq == 0) ((float*)(ws + WS_SSX1))[(size_t)(u.pm * BM + ai * HALF + wr * 64 + m * 16 + fr) * 32 + pn * 4 + wc] = ss; }
#undef EPI4_LOAD
    }
};
struct FEpi5 {
    static constexpr bool PERM = true, AFTER_DRAIN = false; unsigned char* ws;
    __device__ __forceinline__ void operator()(const f32x4 (&acc)[2][2][4][2], const Unit& u, int wr, int wc, int fr, int fq) const {
        const int pn = u.pn, cw = (pn & 7) * 256 + wc * 32 + 8 * fq; const int sel = pn >> 3;
        PG8_EPI_ROWS(
            const f32x4* sp = (const f32x4*)((const float*)(ws + WS_SSX1) + (size_t)row * 32 + 8 * fq); const f32x4 p0 = sp[0], p1 = sp[1];
            const float tot = quad_sum((p0[0] + p0[1]) + (p0[2] + p0[3]) + (p1[0] + p1[1]) + (p1[2] + p1[3]));
            const float rs = rsqrtf(tot * (1.0f / 2048.0f) + EPS);
            bf16_t* dst = (bf16_t*)(ws + (sel == 0 ? WS_Q2 : sel == 1 ? WS_K2 : sel == 2 ? WS_V2 : WS_SG2)) + (size_t)row * 2048 + cw;
            if (sel == 3) { _Pragma("unroll") for (int bj = 0; bj < 2; ++bj) *(u32x4*)(dst + bj * HALF) = pack8(silu4(acc[ai][bj][m][0] * rs), silu4(acc[ai][bj][m][1] * rs)); }
            else { const float sc = sel == 0 ? rs * D128_QSCALE : rs;
                _Pragma("unroll") for (int bj = 0; bj < 2; ++bj) *(u32x4*)(dst + bj * HALF) = pack8(acc[ai][bj][m][0] * sc, acc[ai][bj][m][1] * sc); }
        )
    }
};
struct FEpi7 {
    static constexpr bool PERM = true, AFTER_DRAIN = false; bf16_t* x2; const bf16_t* x1;
    __device__ __forceinline__ void operator()(const f32x4 (&acc)[2][2][4][2], const Unit& u, int wr, int wc, int fr, int fq) const {
        const int cw = u.pn * 256 + wc * 32 + 8 * fq;
        const size_t off0 = (size_t)(u.pm * BM + wr * 64 + fr) * 2048 + cw;
        u32x4 pre[2][2];
#define EPI7_LOAD(q, slot) { const bf16_t* p_ = x1 + off0 + (size_t)(((q) >> 2) * HALF + ((q) & 3) * 16) * 2048; pre[slot][0] = *(const u32x4*)p_; pre[slot][1] = *(const u32x4*)(p_ + HALF); }
        EPI7_LOAD(0, 0) EPI7_LOAD(1, 1)
#pragma unroll
        for (int q = 0; q < 8; ++q) { const int ai = q >> 2, m = q & 3; const size_t off = off0 + (size_t)(ai * HALF + m * 16) * 2048;
            const u32x4 r0 = pre[q & 1][0], r1 = pre[q & 1][1];
            if (q + 2 < 8) EPI7_LOAD(q + 2, q & 1)
#define BFLO(w) __uint_as_float((w) << 16)
#define BFHI(w) __uint_as_float((w) & 0xffff0000u)
            *(u32x4*)(x2 + off) = pack8((f32x4){BFLO(r0[0]), BFHI(r0[0]), BFLO(r0[1]), BFHI(r0[1])} + acc[ai][0][m][0], (f32x4){BFLO(r0[2]), BFHI(r0[2]), BFLO(r0[3]), BFHI(r0[3])} + acc[ai][0][m][1]);
            *(u32x4*)(x2 + off + HALF) = pack8((f32x4){BFLO(r1[0]), BFHI(r1[0]), BFLO(r1[1]), BFHI(r1[1])} + acc[ai][1][m][0], (f32x4){BFLO(r1[2]), BFHI(r1[2]), BFLO(r1[3]), BFHI(r1[3])} + acc[ai][1][m][1]); }
#undef BFLO
#undef BFHI
#undef EPI7_LOAD
    }
};
template <class Epi, class Sched, bool ALIGN_EPI = false, bool SP2 = false>
__device__ __forceinline__ void gemm_phase(PG8_LAS unsigned char* lds, const Gemm g, const Sched& S, const Epi& E, const int tid) {
    const int wid = __builtin_amdgcn_readfirstlane(tid >> 6), lane = tid & 63, wr = wid >> 2, wc = wid & 3, fr = lane & 15, fq = lane >> 4;
    const int K = g.K, nt = K / BK;
    unsigned voffA[2], voffB[2];
#pragma unroll
    for (int i = 0; i < 2; ++i) { int R, C; stage_rc(tid * 16 + i * 8192, R, C); const int Rb = Epi::PERM ? ((R & ~31) + perm32(R & 31)) : R;
        voffA[i] = (unsigned)(R * K + C) * 2u; voffB[i] = (unsigned)(Rb * K + C) * 2u; }
    const size_t kstep = (size_t)(BK * 2);
    const size_t hstep = (size_t)HALF * K * 2;
    const size_t tstep = 2 * hstep;
    const unsigned ldsw = (unsigned)wid * 1024u;
    const int aoff = lds_byte(wr * 64 + fr, fq * 8), boff = lds_byte(wc * 32 + fr, fq * 8);
#define PG8_SA(b, h) (((b) * 2 + (h)) * HTB)
#define PG8_SB(b, h) ((4 + (b) * 2 + (h)) * HTB)
#define PG8_STAGE(bufoff, gbase, voff) do { _Pragma("unroll") for (int _i = 0; _i < 2; ++_i) \
        __builtin_amdgcn_global_load_lds((const unsigned*)((const char*)(gbase) + (voff)[_i]), (PG8_LAS unsigned*)(lds + (bufoff) + ldsw + _i * 8192), 16, 0, 0); } while (0)
#define PG8_LDA(dst, b, h) do { _Pragma("unroll") for (int m = 0; m < 4; ++m) _Pragma("unroll") for (int k = 0; k < 2; ++k) dst[m][k] = *(const PG8_LAS bf16x8*)(lds + PG8_SA(b, h) + aoff + m * 2048 + k * 1024); } while (0)
#define PG8_LDB(dst, b, h) do { _Pragma("unroll") for (int n = 0; n < 2; ++n) _Pragma("unroll") for (int k = 0; k < 2; ++k) dst[n][k] = *(const PG8_LAS bf16x8*)(lds + PG8_SB(b, h) + boff + n * 2048 + k * 1024); } while (0)
#define PG8_MMA(ai, bj, At, Bt) do { __builtin_amdgcn_s_setprio(1); _Pragma("unroll") for (int m = 0; m < 4; ++m) _Pragma("unroll") for (int n = 0; n < 2; ++n) _Pragma("unroll") for (int k = 0; k < 2; ++k) \
        acc[ai][bj][m][n] = __builtin_amdgcn_mfma_f32_16x16x32_bf16(Bt[n][k], At[m][k], acc[ai][bj][m][n], 0, 0, 0); __builtin_amdgcn_s_setprio(0); } while (0)
#define PG8_WAIT_V(n) asm volatile("s_waitcnt vmcnt(" #n ")" ::: "memory")
#define PG8_WAIT_L(n) asm volatile("s_waitcnt lgkmcnt(" #n ")" ::: "memory")
#define PG8_BAR __builtin_amdgcn_s_barrier()
#define PG8_SCHED __builtin_amdgcn_sched_barrier(0)
    Unit cur, nxt; int ui = 0;
    if (!S.next(0, cur)) return;
    f32x4 acc[2][2][4][2];
#pragma unroll
    for (int a = 0; a < 2; ++a)
#pragma unroll
        for (int b = 0; b < 2; ++b)
#pragma unroll
            for (int m = 0; m < 4; ++m)
#pragma unroll
                for (int n = 0; n < 2; ++n) acc[a][b][m][n] = (f32x4){0.f, 0.f, 0.f, 0.f};
    bf16x8 At[4][2], B0[2][2], B1[2][2];
    const char* cA = (const char*)g.A + (size_t)cur.pm * tstep; const char* cB = (const char*)g.Bt + (size_t)cur.pn * tstep;
    S.a_ready(cur);
    if constexpr (SP2) {
        PG8_STAGE(PG8_SB(0, 0), cB, voffB); PG8_STAGE(PG8_SB(0, 1), cB + hstep, voffB); PG8_STAGE(PG8_SA(0, 0), cA, voffA); PG8_STAGE(PG8_SA(0, 1), cA + hstep, voffA);
        if (wr == 1) PG8_BAR;
        PG8_WAIT_V(2); PG8_BAR;
        PG8_STAGE(PG8_SB(1, 0), cB + kstep, voffB); PG8_STAGE(PG8_SA(1, 0), cA + kstep, voffA); PG8_STAGE(PG8_SB(1, 1), cB + hstep + kstep, voffB);
        PG8_WAIT_V(6); PG8_BAR;
    } else {
        PG8_STAGE(PG8_SB(0, 0), cB, voffB); PG8_STAGE(PG8_SA(0, 0), cA, voffA); PG8_STAGE(PG8_SB(0, 1), cB + hstep, voffB); PG8_STAGE(PG8_SA(0, 1), cA + hstep, voffA);
        if (wr == 1) PG8_BAR;
        PG8_WAIT_V(4); PG8_BAR;
        PG8_STAGE(PG8_SB(1, 0), cB + kstep, voffB); PG8_STAGE(PG8_SA(1, 0), cA + kstep, voffA); PG8_STAGE(PG8_SB(1, 1), cB + hstep + kstep, voffB);
        PG8_WAIT_V(6); PG8_BAR;
    }
    for (;;) {
        const bool has_next = S.next(ui + 1, nxt);
        const char* nA = has_next ? (const char*)g.A + (size_t)nxt.pm * tstep : cA; const char* nB = has_next ? (const char*)g.Bt + (size_t)nxt.pn * tstep : cB;
        for (int t = 0; t < nt; t += 2) {
            const bool last = (t == nt - 2);
            const char* a1 = cA + (size_t)(t + 1) * kstep;
            const char* a2 = last ? nA : cA + (size_t)(t + 2) * kstep; const char* b2 = last ? nB : cB + (size_t)(t + 2) * kstep;
            const char* a3 = a2 + kstep; const char* b3 = b2 + kstep;
            if (last && has_next) S.a_ready(nxt);
            if constexpr (SP2) {
            PG8_LDB(B0, 0, 0); PG8_LDB(B1, 0, 1); PG8_SCHED; PG8_LDA(At, 0, 0); PG8_STAGE(PG8_SA(1, 1), a1 + hstep, voffA);
            PG8_WAIT_V(8); PG8_WAIT_L(0); PG8_BAR; PG8_MMA(0, 0, At, B0); PG8_MMA(0, 1, At, B1); PG8_BAR; PG8_SCHED;
            PG8_LDA(At, 0, 1); PG8_STAGE(PG8_SB(0, 0), b2, voffB); PG8_STAGE(PG8_SB(0, 1), b2 + hstep, voffB); PG8_STAGE(PG8_SA(0, 0), a2, voffA);
            PG8_WAIT_V(8); PG8_WAIT_L(0); PG8_BAR; PG8_MMA(1, 0, At, B0); PG8_MMA(1, 1, At, B1); PG8_BAR; PG8_SCHED;
            PG8_LDB(B0, 1, 0); PG8_LDB(B1, 1, 1); PG8_SCHED; PG8_LDA(At, 1, 0); PG8_STAGE(PG8_SA(0, 1), a2 + hstep, voffA);
            PG8_WAIT_V(8); PG8_WAIT_L(0); PG8_BAR; PG8_MMA(0, 0, At, B0); PG8_MMA(0, 1, At, B1); PG8_BAR; PG8_SCHED;
            PG8_LDA(At, 1, 1); PG8_STAGE(PG8_SB(1, 0), b3, voffB); PG8_STAGE(PG8_SB(1, 1), b3 + hstep, voffB); PG8_STAGE(PG8_SA(1, 0), a3, voffA);
            PG8_WAIT_V(8); PG8_WAIT_L(0); PG8_BAR; PG8_MMA(1, 0, At, B0); PG8_MMA(1, 1, At, B1); PG8_BAR; PG8_SCHED;
            } else {
            PG8_LDB(B0, 0, 0); PG8_SCHED; PG8_LDA(At, 0, 0); PG8_STAGE(PG8_SA(1, 1), a1 + hstep, voffA);
            PG8_WAIT_L(8); PG8_BAR; PG8_WAIT_L(0); PG8_MMA(0, 0, At, B0); PG8_BAR; PG8_SCHED;
            PG8_LDB(B1, 0, 1); PG8_STAGE(PG8_SB(0, 0), b2, voffB);
            PG8_BAR; PG8_WAIT_L(0); PG8_MMA(0, 1, At, B1); PG8_BAR;
            PG8_LDA(At, 0, 1); PG8_STAGE(PG8_SA(0, 0), a2, voffA);
            PG8_BAR; PG8_WAIT_L(0); PG8_MMA(1, 0, At, B0); PG8_BAR; PG8_SCHED;
            PG8_STAGE(PG8_SB(0, 1), b2 + hstep, voffB);
            PG8_WAIT_V(6); PG8_BAR; PG8_MMA(1, 1, At, B1); PG8_BAR;
            PG8_LDB(B0, 1, 0); PG8_SCHED; PG8_LDA(At, 1, 0); PG8_STAGE(PG8_SA(0, 1), a2 + hstep, voffA);
            PG8_WAIT_L(8); PG8_BAR; PG8_WAIT_L(0); PG8_MMA(0, 0, At, B0); PG8_BAR; PG8_SCHED;
            PG8_LDB(B1, 1, 1); PG8_STAGE(PG8_SB(1, 0), b3, voffB);
            PG8_BAR; PG8_WAIT_L(0); PG8_MMA(0, 1, At, B1); PG8_BAR;
            PG8_LDA(At, 1, 1); PG8_STAGE(PG8_SA(1, 0), a3, voffA);
            PG8_BAR; PG8_WAIT_L(0); PG8_MMA(1, 0, At, B0); PG8_BAR; PG8_SCHED;
            PG8_STAGE(PG8_SB(1, 1), b3 + hstep, voffB);
            PG8_WAIT_V(6); PG8_BAR; PG8_MMA(1, 1, At, B1); PG8_BAR;
            }
        }
        if constexpr (ALIGN_EPI) { if (wr == 0) PG8_BAR; }
        if constexpr (!Epi::AFTER_DRAIN) { E(acc, cur, wr, wc, fr, fq); S.done(cur); }
        if (!has_next) break;
#pragma unroll
        for (int a = 0; a < 2; ++a)
#pragma unroll
            for (int b = 0; b < 2; ++b)
#pragma unroll
                for (int m = 0; m < 4; ++m)
#pragma unroll
                    for (int n = 0; n < 2; ++n) acc[a][b][m][n] = (f32x4){0.f, 0.f, 0.f, 0.f};
        cur = nxt; cA = nA; cB = nB; ++ui;
        if constexpr (ALIGN_EPI) { if (wr == 1) PG8_BAR; }
    }
    PG8_WAIT_V(0);
    if constexpr (!ALIGN_EPI) { if (wr == 0) PG8_BAR; }
    PG8_BAR;
    if constexpr (Epi::AFTER_DRAIN) { E.fused(acc, cur, wr, wc, fr, fq, lds, wid, lane); S.done(cur); }
#undef PG8_SA
#undef PG8_SB
#undef PG8_STAGE
#undef PG8_LDA
#undef PG8_LDB
#undef PG8_MMA
#undef PG8_WAIT_V
#undef PG8_WAIT_L
#undef PG8_BAR
#undef PG8_SCHED
}
}

#define LAS __attribute__((address_space(3)))
template <class Epi> __global__ void __launch_bounds__(512, 2) k_gemm_fast(pg8::Gemm g, Epi E) {
    extern __shared__ __attribute__((aligned(16))) unsigned char lds[];
    pg8::StaticOrder S; S.init(g.M, g.N, (int)gridDim.x, (int)blockIdx.x);
    pg8::gemm_phase<Epi, pg8::StaticOrder, true, true>((LAS unsigned char*)lds, g, S, E, (int)threadIdx.x);
}

template <class Epi>
__global__ void __launch_bounds__(256) k_gemm_naive(const bf16_t* A, const bf16_t* Bt, int N, int K, Epi epi) {
    __shared__ float As[64][33], Bs[64][33];
    const int tid = threadIdx.x, tx = tid & 15, ty = tid >> 4;
    const int nbn = N / 64; const int bm = blockIdx.x / nbn, bn = blockIdx.x % nbn;
    float acc[4][4] = {};
    const int lr = tid >> 2, lc = (tid & 3) * 8;
    for (int k0 = 0; k0 < K; k0 += 32) {
        const u32x4 av = *(const u32x4*)(A + (size_t)(bm * 64 + lr) * K + k0 + lc);
        const u32x4 bv = *(const u32x4*)(Bt + (size_t)(bn * 64 + lr) * K + k0 + lc);
        __syncthreads();
#pragma unroll
        for (int j = 0; j < 4; ++j) { As[lr][lc + 2 * j] = __uint_as_float(av[j] << 16); As[lr][lc + 2 * j + 1] = __uint_as_float(av[j] & 0xffff0000u);
                                      Bs[lr][lc + 2 * j] = __uint_as_float(bv[j] << 16); Bs[lr][lc + 2 * j + 1] = __uint_as_float(bv[j] & 0xffff0000u); }
        __syncthreads();
#pragma unroll 8
        for (int kk = 0; kk < 32; ++kk) { float a[4], b[4];
#pragma unroll
            for (int i = 0; i < 4; ++i) { a[i] = As[ty * 4 + i][kk]; b[i] = Bs[tx * 4 + i][kk]; }
#pragma unroll
            for (int i = 0; i < 4; ++i)
#pragma unroll
                for (int j = 0; j < 4; ++j) acc[i][j] += a[i] * b[j]; }
    }
#pragma unroll
    for (int i = 0; i < 4; ++i)
#pragma unroll
        for (int j = 0; j < 4; ++j) epi(bm * 64 + ty * 4 + i, bn * 64 + tx * 4 + j, acc[i][j]);
}

template <bool F32>
__global__ void __launch_bounds__(256) k_rowss(const void* src, int ld, int ncols, float* dst, int dst_ld, int nslots) {
    const int lane = threadIdx.x & 63, row = blockIdx.x * 4 + (threadIdx.x >> 6);
    float s = 0.f;
    for (int c = lane; c < ncols; c += 64) { const float v = F32 ? ((const float*)src)[(size_t)row * ld + c] : bf2f(((const bf16_t*)src)[(size_t)row * ld + c]); s += v * v; }
    s = wave_sum(s);
    if (lane < nslots) dst[(size_t)row * dst_ld + lane] = lane == 0 ? s : 0.f;
}

__global__ void __launch_bounds__(256) k_rope(bf16_t* buf, int nh, const float* rc, const float* rs) {
    const int idx = blockIdx.x * 256 + threadIdx.x; const int per_row = nh * 32; if (idx >= M * per_row) return;
    const int row = idx / per_row, t = idx % per_row, h = t >> 5, i = t & 31, pos = row % SEQ;
    bf16_t* p = buf + (size_t)row * nh * 64 + h * 64; const float x1 = bf2f(p[i]), x2 = bf2f(p[32 + i]); const float cs = rc[pos * 32 + i], sn = rs[pos * 32 + i];
    p[i] = f2bf(x1 * cs - x2 * sn); p[32 + i] = f2bf(x1 * sn + x2 * cs);
}

template <int D> DI float dot_row(const float* q, const bf16_t* k) {
    float s = 0.f;
#pragma unroll
    for (int d = 0; d < D; d += 8) { const u32x4 v = *(const u32x4*)(k + d);
#pragma unroll
        for (int j = 0; j < 4; ++j) { s += q[d + 2 * j] * __uint_as_float(v[j] << 16); s += q[d + 2 * j + 1] * __uint_as_float(v[j] & 0xffff0000u); } }
    return s;
}

__global__ void __launch_bounds__(256) k_mla_naive(Ctx c) {
    __shared__ float qs[4][192];
    const int lane = threadIdx.x & 63, w = threadIdx.x >> 6; const int gq = blockIdx.x * 4 + w;
    const int t = gq % SEQ, bh = gq / SEQ, h = bh % 8, b = bh / 8; const size_t row = (size_t)b * SEQ + t;
    unsigned char* ws = c.ws;
    const bf16_t *QN = (const bf16_t*)(ws + WS_QN), *QR = (const bf16_t*)(ws + WS_QR), *KN = (const bf16_t*)(ws + WS_KN), *KR = (const bf16_t*)(ws + WS_KR), *VA = (const bf16_t*)(ws + WS_VA), *SG = (const bf16_t*)(ws + WS_SG);
    for (int d = lane; d < 192; d += 64) qs[w][d] = d < 128 ? bf2f(QN[row * 1024 + h * 128 + d]) : bf2f(QR[row * 512 + h * 64 + d - 128]);
    __syncthreads();
    float m = -INFINITY, l = 0.f, o0 = 0.f, o1 = 0.f;
    for (int j0 = 0; j0 <= t; j0 += 64) {
        const int j = j0 + lane; const bool valid = j <= t; const size_t krow = (size_t)b * SEQ + (valid ? j : t);
        float s = dot_row<128>(qs[w], KN + krow * 1024 + h * 128) + dot_row<64>(qs[w] + 128, KR + krow * 64);
        if (!valid) s = -INFINITY;
        const float mn = fmaxf(m, wave_max(s)); const float alpha = exp2f(m - mn); const float p = valid ? exp2f(s - mn) : 0.f;
        l = l * alpha + wave_sum(p); o0 *= alpha; o1 *= alpha; m = mn;
        const int nj = min(64, t - j0 + 1);
        for (int jj = 0; jj < nj; ++jj) { const float pj = __shfl(p, jj); const bf16_t* vr = VA + ((size_t)b * SEQ + j0 + jj) * 1024 + h * 128; o0 += pj * bf2f(vr[lane]); o1 += pj * bf2f(vr[lane + 64]); }
    }
    bf16_t* MIX = (bf16_t*)(ws + WS_MIX); const float il = 1.0f / l;
    MIX[row * 2048 + h * 128 + lane] = f2bf(o0 * il * bf2f(SG[row * 2048 + h * 128 + lane]));
    MIX[row * 2048 + h * 128 + lane + 64] = f2bf(o1 * il * bf2f(SG[row * 2048 + h * 128 + lane + 64]));
}

__global__ void __launch_bounds__(256) k_dil_naive(Ctx c) {
    __shared__ float qs[4][128];
    const int lane = threadIdx.x & 63, w = threadIdx.x >> 6; const int gq = blockIdx.x * 4 + w;
    const int t = gq % SEQ, bh = gq / SEQ, h = bh % 8, b = bh / 8; const size_t row = (size_t)b * SEQ + t;
    unsigned char* ws = c.ws;
    const bf16_t *QB = (const bf16_t*)(ws + WS_QB), *KB = (const bf16_t*)(ws + WS_KB), *VB = (const bf16_t*)(ws + WS_VB);
    const float* bn = (const float*)(ws + WS_BIASN);
    for (int d = lane; d < 128; d += 64) qs[w][d] = bf2f(QB[row * 1024 + h * 128 + d]);
    __syncthreads();
    for (int p = 0; p < 3; ++p) { const int dil = p == 0 ? 1 : p == 1 ? 4 : 16;
        float m = -INFINITY, l = 0.f, o0 = 0.f, o1 = 0.f;
        for (int r0 = 0; r0 < 192; r0 += 64) {
            const int rel = r0 + lane; const int j = t - rel * dil; const bool valid = rel <= 128 && j >= 0; const size_t krow = (size_t)b * SEQ + (valid ? j : t);
            float s = dot_row<128>(qs[w], KB + krow * 1024 + h * 128) + bn[(p * 8 + h) * 132 + (valid ? rel : 0)];
            if (!valid) s = -INFINITY;
            const float mn = fmaxf(m, wave_max(s));
            const float alpha = exp2f(m - mn); const float pp = valid ? exp2f(s - mn) : 0.f;
            l = l * alpha + wave_sum(pp); o0 *= alpha; o1 *= alpha; m = mn;
            for (int jj = 0; jj < 64; ++jj) { const float pj = __shfl(pp, jj); if (pj != 0.f) { const int jr = t - (r0 + jj) * dil; const bf16_t* vr = VB + ((size_t)b * SEQ + jr) * 1024 + h * 128; o0 += pj * bf2f(vr[lane]); o1 += pj * bf2f(vr[lane + 64]); } }
        }
        bf16_t* OP = (bf16_t*)(ws + (p == 0 ? WS_OP0 : p == 1 ? WS_OP1 : WS_OP2)); const float il = 1.0f / l;
        OP[row * 1024 + h * 128 + lane] = f2bf(o0 * il); OP[row * 1024 + h * 128 + lane + 64] = f2bf(o1 * il);
        if (lane == 0) ((float*)(ws + WS_LSE))[((size_t)p * M + row) * 8 + h] = m + log2f(l);
    }
}

DI void dil_merge_item(unsigned char* ws, int row, int col) {
    const int h = col >> 7; const float* lse = (const float*)(ws + WS_LSE);
    const float l0 = lse[((size_t)0 * M + row) * 8 + h], l1 = lse[((size_t)1 * M + row) * 8 + h], l2 = lse[((size_t)2 * M + row) * 8 + h];
    const float mx = fmaxf(l0, fmaxf(l1, l2)); float w0 = exp2f(l0 - mx), w1 = exp2f(l1 - mx), w2 = exp2f(l2 - mx); const float inv = 1.0f / (w0 + w1 + w2); w0 *= inv; w1 *= inv; w2 *= inv;
    const u32x4 a0 = *(const u32x4*)((const bf16_t*)(ws + WS_OP0) + (size_t)row * 1024 + col), a1 = *(const u32x4*)((const bf16_t*)(ws + WS_OP1) + (size_t)row * 1024 + col),
                a2 = *(const u32x4*)((const bf16_t*)(ws + WS_OP2) + (size_t)row * 1024 + col), sg = *(const u32x4*)((const bf16_t*)(ws + WS_SG) + (size_t)row * 2048 + 1024 + col);
    u32x4 o;
#pragma unroll
    for (int j = 0; j < 4; ++j) {
        const float lo = (w0 * __uint_as_float(a0[j] << 16) + w1 * __uint_as_float(a1[j] << 16) + w2 * __uint_as_float(a2[j] << 16)) * __uint_as_float(sg[j] << 16);
        const float hi = (w0 * __uint_as_float(a0[j] & 0xffff0000u) + w1 * __uint_as_float(a1[j] & 0xffff0000u) + w2 * __uint_as_float(a2[j] & 0xffff0000u)) * __uint_as_float(sg[j] & 0xffff0000u);
        o[j] = (unsigned)f2bf(lo) | ((unsigned)f2bf(hi) << 16); }
    *(u32x4*)((bf16_t*)(ws + WS_MIX) + (size_t)row * 2048 + 1024 + col) = o;
}
__global__ void __launch_bounds__(128) k_dil_merge(Ctx c) { dil_merge_item(c.ws, blockIdx.x, threadIdx.x * 8); }

__global__ void __launch_bounds__(256) k_sb_naive(Ctx c) {
    __shared__ float qs[4][128];
    const int lane = threadIdx.x & 63, w = threadIdx.x >> 6; const int gq = blockIdx.x * 4 + w;
    const int t = gq % SEQ, bh = gq / SEQ, h = bh % 16, b = bh / 16; const size_t row = (size_t)b * SEQ + t;
    unsigned char* ws = c.ws;
    const bf16_t *Q2 = (const bf16_t*)(ws + WS_Q2), *K2 = (const bf16_t*)(ws + WS_K2), *V2 = (const bf16_t*)(ws + WS_V2), *SG2 = (const bf16_t*)(ws + WS_SG2);
    for (int d = lane; d < 128; d += 64) qs[w][d] = bf2f(Q2[row * 2048 + h * 128 + d]);
    __syncthreads();
    float carry = 0.f, o0 = 0.f, o1 = 0.f;
    for (int c0 = 0; c0 < t; c0 += 64) {
        const int j = t - 1 - c0 - lane; const bool valid = j >= 0; const size_t krow = (size_t)b * SEQ + (valid ? j : 0);
        const float z = dot_row<128>(qs[w], K2 + krow * 2048 + h * 128);
        const float sp = fmaxf(z, 0.f) + log2f(1.0f + exp2f(-fabsf(z)));
        const float L = valid ? -sp : 0.f;
        float incl = L;
#pragma unroll
        for (int o = 1; o < 64; o <<= 1) { const float v = __shfl_up(incl, o); if (lane >= o) incl += v; }
        const float between = carry + (incl - L);
        const float a = valid ? exp2f(z - sp + between) : 0.f;
        carry += __shfl(incl, 63);
        const int nj = min(64, t - c0);
        for (int jj = 0; jj < nj; ++jj) { const float aj = __shfl(a, jj); const bf16_t* vr = V2 + ((size_t)b * SEQ + t - 1 - c0 - jj) * 2048 + h * 128; o0 += aj * bf2f(vr[lane]); o1 += aj * bf2f(vr[lane + 64]); }
    }
    bf16_t* MIX2 = (bf16_t*)(ws + WS_MIX2);
    MIX2[row * 2048 + h * 128 + lane] = f2bf(o0 * bf2f(SG2[row * 2048 + h * 128 + lane]));
    MIX2[row * 2048 + h * 128 + lane + 64] = f2bf(o1 * bf2f(SG2[row * 2048 + h * 128 + lane + 64]));
}

#ifndef MLA_PIPE
#define MLA_PIPE 1
#endif
namespace att {
typedef short bf16x8 __attribute__((ext_vector_type(8)));
typedef short s16x4 __attribute__((ext_vector_type(4)));
typedef short v4i16_t __attribute__((ext_vector_type(4)));
typedef float f32x16 __attribute__((ext_vector_type(16)));
typedef _Float16 f16x8 __attribute__((ext_vector_type(8)));
typedef _Float16 f16x2 __attribute__((ext_vector_type(2)));
typedef float f32x2_t __attribute__((ext_vector_type(2))); typedef __bf16 bf16x2_t __attribute__((ext_vector_type(2)));
typedef LAS const unsigned char* lcp;
#define MFMA_BF16(a, b, c) __builtin_amdgcn_mfma_f32_32x32x16_bf16((a), (b), (c), 0, 0, 0)
#define MFMA_F16(a, b, c) __builtin_amdgcn_mfma_f32_32x32x16_f16((a), (b), (c), 0, 0, 0)
#define SBAR() __builtin_amdgcn_sched_barrier(0)
DI int crow(int g, int h) { return (g & 3) + 8 * (g >> 2) + 4 * h; }
DI unsigned off_b(unsigned row, unsigned ch) { return 256u * row + 16u * (ch ^ (((row & 3) << 2) | ((row >> 2) & 3))); }
DI unsigned cvtpk(float lo, float hi) { f32x2_t v = {lo, hi}; bf16x2_t b = __builtin_convertvector(v, bf16x2_t); return __builtin_bit_cast(unsigned, b); }
DI unsigned cvtpk_h(float lo, float hi) { f32x2_t v = {lo, hi}; f16x2 b = __builtin_convertvector(v, f16x2); return __builtin_bit_cast(unsigned, b); }
DI bf16x8 pack_bf(const f32x16& x, int s) { u32x4 p; p.x = cvtpk(x[8 * s], x[8 * s + 1]); p.y = cvtpk(x[8 * s + 2], x[8 * s + 3]); p.z = cvtpk(x[8 * s + 4], x[8 * s + 5]); p.w = cvtpk(x[8 * s + 6], x[8 * s + 7]); return __builtin_bit_cast(bf16x8, p); }
DI f16x8 pack_h(const f32x16& x, int s) { u32x4 p; p.x = cvtpk_h(x[8 * s], x[8 * s + 1]); p.y = cvtpk_h(x[8 * s + 2], x[8 * s + 3]); p.z = cvtpk_h(x[8 * s + 4], x[8 * s + 5]); p.w = cvtpk_h(x[8 * s + 6], x[8 * s + 7]); return __builtin_bit_cast(f16x8, p); }
DI s16x4 vtr(lcp p) { return __builtin_bit_cast(s16x4, __builtin_amdgcn_ds_read_tr16_b64_v4i16((LAS v4i16_t*)p)); }
DI float swap_max(float m) { auto rr = __builtin_amdgcn_permlane32_swap(__float_as_uint(m), __float_as_uint(m), false, false); return fmaxf(__uint_as_float(rr[0]), __uint_as_float(rr[1])); }
DI float swap_sum(float m) { auto rr = __builtin_amdgcn_permlane32_swap(__float_as_uint(m), __float_as_uint(m), false, false); return __uint_as_float(rr[0]) + __uint_as_float(rr[1]); }
DI float bcast_lo(float m) { auto rr = __builtin_amdgcn_permlane32_swap(__float_as_uint(m), __float_as_uint(m), false, false); return __uint_as_float(rr[0]); }
DI void o_pair8(const f32x16& o, int p, float (&e)[8]) {
#pragma unroll
    for (int i = 0; i < 4; ++i) { auto rr = __builtin_amdgcn_permlane32_swap(__float_as_uint(o[8 * p + i]), __float_as_uint(o[8 * p + 4 + i]), false, false); e[i] = __uint_as_float(rr[0]); e[4 + i] = __uint_as_float(rr[1]); }
}
DI __amdgpu_buffer_rsrc_t mk_rsrc(const void* p, unsigned bytes) { return __builtin_amdgcn_make_buffer_rsrc((void*)p, 0, bytes, 0x00020000); }
DI u32x4 bload(__amdgpu_buffer_rsrc_t rs, unsigned voff, unsigned soff) { return __builtin_amdgcn_raw_buffer_load_b128(rs, voff, soff, 0); }
struct VAddr { unsigned a[2][4]; };
DI VAddr make_vaddr(int lane) { VAddr v; const unsigned hh = lane >> 5, blk = (lane >> 4) & 1, qq = (lane & 15) >> 2, p = lane & 3;
#pragma unroll
    for (int t = 0; t < 2; ++t)
#pragma unroll
        for (int d0 = 0; d0 < 4; ++d0) v.a[t][d0] = off_b(8 * t + 4 * hh + qq, 4 * d0 + 2 * blk + (p >> 1)) + 8 * (p & 1);
    return v; }
DI bf16x8 vfrag(lcp img, int s, int d0, const VAddr& va) {
    const s16x4 lo = vtr(img + 4096 * s + va.a[0][d0]);
    const s16x4 hi = vtr(img + 4096 * s + va.a[1][d0]);
    return (bf16x8){lo[0], lo[1], lo[2], lo[3], hi[0], hi[1], hi[2], hi[3]};
}
DI void softmax_tile(f32x16& s0, f32x16& s1, f32x16 (&o)[4], float& mrun, float& lrun) {
    float mt = fmaxf(s0[0], s1[0]);
#pragma unroll
    for (int g = 1; g < 16; ++g) mt = fmaxf(mt, fmaxf(s0[g], s1[g]));
    mt = swap_max(mt);
    const float mn = fmaxf(mrun, mt), alpha = __builtin_amdgcn_exp2f(mrun - mn); mrun = mn;
    float ps = 0.f;
#pragma unroll
    for (int g = 0; g < 16; ++g) { s0[g] = __builtin_amdgcn_exp2f(s0[g] - mn); s1[g] = __builtin_amdgcn_exp2f(s1[g] - mn); ps += s0[g] + s1[g]; }
    lrun = lrun * alpha + ps;
#pragma unroll
    for (int d0 = 0; d0 < 4; ++d0)
#pragma unroll
        for (int g = 0; g < 16; ++g) o[d0][g] *= alpha;
}

constexpr int MLA_KSTR = 400, MLA_KBUF = 64 * MLA_KSTR, VBUF = 16384, MLA_LDS_V = 2 * MLA_KBUF, MLA_LDS_BYTES = 2 * MLA_KBUF + 2 * VBUF;
template <bool MASKED>
DI void mla_tile(lcp kb, lcp vb, const bf16x8 (&qf)[12], f32x16 (&o)[4], float& mrun, float& lrun, const VAddr& va, int qrel, int hh) {
    f32x16 s0, s1;
#pragma unroll
    for (int g = 0; g < 16; ++g) { s0[g] = 0.f; s1[g] = 0.f; }
    bf16x8 f0a = *(LAS const bf16x8*)kb, f0b = *(LAS const bf16x8*)(kb + 32 * MLA_KSTR), f1a = *(LAS const bf16x8*)(kb + 32), f1b = *(LAS const bf16x8*)(kb + 32 * MLA_KSTR + 32), f2a, f2b;
#pragma unroll
    for (int d0 = 0; d0 < 12; ++d0) {
        if (d0 + 2 < 12) { const bf16x8 n0 = *(LAS const bf16x8*)(kb + (d0 + 2) * 32), n1 = *(LAS const bf16x8*)(kb + 32 * MLA_KSTR + (d0 + 2) * 32);
            if ((d0 + 2) % 3 == 0) { f0a = n0; f0b = n1; } else if ((d0 + 2) % 3 == 1) { f1a = n0; f1b = n1; } else { f2a = n0; f2b = n1; } }
        SBAR();
        s0 = MFMA_BF16(d0 % 3 == 0 ? f0a : d0 % 3 == 1 ? f1a : f2a, qf[d0], s0); s1 = MFMA_BF16(d0 % 3 == 0 ? f0b : d0 % 3 == 1 ? f1b : f2b, qf[d0], s1);
        SBAR();
    }
    if (MASKED) {
#pragma unroll
        for (int g = 0; g < 16; ++g) { const int kv = crow(g, 0); if (kv > qrel - 4 * hh) s0[g] = -INFINITY; if (kv + 32 > qrel - 4 * hh) s1[g] = -INFINITY; } }
    float mt = fmaxf(s0[0], s1[0]);
#pragma unroll
    for (int g = 1; g < 16; ++g) mt = fmaxf(mt, fmaxf(s0[g], s1[g]));
    mt = swap_max(mt);
    if (__builtin_amdgcn_ballot_w64(mt > mrun) != 0ull) {
        const float mn = fmaxf(mrun, mt), alpha = __builtin_amdgcn_exp2f(mrun - mn); mrun = mn; lrun *= alpha;
#pragma unroll
        for (int d0 = 0; d0 < 4; ++d0)
#pragma unroll
            for (int g = 0; g < 16; ++g) o[d0][g] *= alpha;
    }
    float ps = 0.f;
#pragma unroll
    for (int g = 0; g < 16; ++g) { s0[g] = __builtin_amdgcn_exp2f(s0[g] - mrun); s1[g] = __builtin_amdgcn_exp2f(s1[g] - mrun); ps += s0[g] + s1[g]; }
    lrun += ps;
    bf16x8 pf[4]; pf[0] = pack_bf(s0, 0); pf[1] = pack_bf(s0, 1); pf[2] = pack_bf(s1, 0); pf[3] = pack_bf(s1, 1);
    bf16x8 v0 = vfrag(vb, 0, 0, va), v1 = vfrag(vb, 0, 1, va), v2;
#pragma unroll
    for (int j = 0; j < 16; ++j) {
        if (j + 2 < 16) { const int ks = (j + 2) >> 2, d0 = (j + 2) & 3; const bf16x8 nx = vfrag(vb + (ks >> 1) * 8192, ks & 1, d0, va);
            if ((j + 2) % 3 == 0) v0 = nx; else if ((j + 2) % 3 == 1) v1 = nx; else v2 = nx; }
        SBAR();
        o[j & 3] = MFMA_BF16(j % 3 == 0 ? v0 : j % 3 == 1 ? v1 : v2, pf[j >> 2], o[j & 3]);
        SBAR();
    }
}
DI void mla_unit(LAS unsigned char* lds, unsigned char* ws, int b, int h, int qb, const int tid_in) {
    int tid = tid_in; asm volatile("" : "+v"(tid));
    const int lane = tid & 63, wid = __builtin_amdgcn_readfirstlane(tid >> 6), r = lane & 31, hh = lane >> 5;
    const bf16_t *QN = (const bf16_t*)(ws + WS_QN), *QR = (const bf16_t*)(ws + WS_QR), *KN = (const bf16_t*)(ws + WS_KN), *KR = (const bf16_t*)(ws + WS_KR), *VA = (const bf16_t*)(ws + WS_VA), *SG = (const bf16_t*)(ws + WS_SG);
    bf16_t* MIX = (bf16_t*)(ws + WS_MIX);
    const int q0 = qb * 256, NT = 4 * (qb + 1), tmax = (q0 + 32 * wid) >> 6; const size_t rowbase = (size_t)b * SEQ;
    bf16x8 qf[12];
    { const size_t qrow = rowbase + q0 + 32 * wid + r;
#pragma unroll
      for (int d0 = 0; d0 < 8; ++d0) qf[d0] = *(const bf16x8*)(QN + qrow * 1024 + h * 128 + d0 * 16 + hh * 8);
#pragma unroll
      for (int d0 = 0; d0 < 4; ++d0) qf[8 + d0] = *(const bf16x8*)(QR + qrow * 512 + h * 64 + d0 * 16 + hh * 8); }
    f32x16 o[4];
#pragma unroll
    for (int d0 = 0; d0 < 4; ++d0)
#pragma unroll
        for (int g = 0; g < 16; ++g) o[d0][g] = 0.f;
    float mrun = -INFINITY, lrun = 0.f;
    u32x4 kreg[3], vreg[2];
    const VAddr va = make_vaddr(lane);
    const __amdgpu_buffer_rsrc_t rKN = mk_rsrc(KN, M * 1024 * 2), rKR = mk_rsrc(KR, M * 64 * 2), rVA = mk_rsrc(VA, M * 1024 * 2);
    const unsigned vo0 = (tid >> 4) * 2048 + (tid & 15) * 16, vo1 = vo0 + 32 * 2048, vor = (tid >> 3) * 128 + (tid & 7) * 16;
    const unsigned so_n = ((unsigned)rowbase * 1024 + h * 128) * 2, so_r = (unsigned)rowbase * 64 * 2;
    const unsigned lk0 = (tid >> 4) * MLA_KSTR + (tid & 15) * 16, lk1 = lk0 + 32 * MLA_KSTR, lkr = (tid >> 3) * MLA_KSTR + 256 + (tid & 7) * 16;
    const unsigned lv0 = off_b((tid >> 4) & 31, tid & 15), lv1 = lv0 + 8192;
    const unsigned kfo = r * MLA_KSTR + hh * 16;
#define MLA_LOAD(t) do { const unsigned tn = so_n + (unsigned)(t) * (64 * 2048), tr_ = so_r + (unsigned)(t) * (64 * 128); \
        kreg[0] = bload(rKN, vo0, tn); kreg[1] = bload(rKN, vo1, tn); kreg[2] = bload(rKR, vor, tr_); vreg[0] = bload(rVA, vo0, tn); vreg[1] = bload(rVA, vo1, tn); } while (0)
#define MLA_STORE(buf) do { LAS unsigned char* kd = lds + (buf) * MLA_KBUF; LAS unsigned char* vd = lds + MLA_LDS_V + (buf) * VBUF; \
        *(LAS u32x4*)(kd + lk0) = kreg[0]; *(LAS u32x4*)(kd + lk1) = kreg[1]; *(LAS u32x4*)(kd + lkr) = kreg[2]; *(LAS u32x4*)(vd + lv0) = vreg[0]; *(LAS u32x4*)(vd + lv1) = vreg[1]; } while (0)
    MLA_LOAD(0); MLA_STORE(0); __builtin_amdgcn_s_waitcnt(0x0F70);   __syncthreads();
#define MLA_INTERVAL(MODE) { const int buf = t & 1; \
        if (t + 1 < NT) MLA_LOAD(t + 1); \
        if (MODE == 0) mla_tile<false>(lds + buf * MLA_KBUF + kfo, lds + MLA_LDS_V + buf * VBUF, qf, o, mrun, lrun, va, 0, hh); \
        if (MODE == 1) mla_tile<true>(lds + buf * MLA_KBUF + kfo, lds + MLA_LDS_V + buf * VBUF, qf, o, mrun, lrun, va, q0 + 32 * wid + r - 64 * t, hh); \
        if (t + 1 < NT) MLA_STORE(buf ^ 1); \
        __syncthreads(); }
    int t = 0;
    for (; t < tmax; ++t) MLA_INTERVAL(0)
    MLA_INTERVAL(1)
    for (++t; t < NT; ++t) MLA_INTERVAL(2)
#undef MLA_INTERVAL
#undef MLA_LOAD
#undef MLA_STORE
    const float inv = 1.0f / swap_sum(lrun);
    int t4 = tid; asm volatile("" : "+v"(t4)); const size_t qrow = rowbase + q0 + 32 * wid + (t4 & 31); const int hh2 = (t4 >> 5) & 1;
#pragma unroll
    for (int d0 = 0; d0 < 4; ++d0)
#pragma unroll
        for (int gg = 0; gg < 4; ++gg) { const size_t off = qrow * 2048 + h * 128 + 32 * d0 + 8 * gg + 4 * hh2;
            const unsigned long long sg = *(const unsigned long long*)(SG + off);
            const float g0 = __uint_as_float((unsigned)(sg << 16)), g1 = __uint_as_float((unsigned)sg & 0xffff0000u), g2 = __uint_as_float((unsigned)(sg >> 32) << 16), g3 = __uint_as_float((unsigned)(sg >> 32) & 0xffff0000u);
            const unsigned lo = cvtpk(o[d0][4 * gg] * inv * g0, o[d0][4 * gg + 1] * inv * g1), hi = cvtpk(o[d0][4 * gg + 2] * inv * g2, o[d0][4 * gg + 3] * inv * g3);
            *(unsigned long long*)(MIX + off) = (unsigned long long)lo | ((unsigned long long)hi << 32); }
}
DI float vmax3_s(float a, float b, float c) { float r; asm("v_max3_f32 %0, %1, %2, %3" : "=v"(r) : "v"(a), "v"(b), "v"(c)); return r; }
constexpr int M2_KBUF = 64 * 384, M2_LDS_V = 3 * M2_KBUF, M2_LDS_BYTES = M2_LDS_V + 3 * VBUF;
struct M2State { f32x16 o[4]; f32x16 negv; float mrun, lrun, nref; };
template <int KIMM, int VIMM>
DI void mla2_iter(f32x16& zin, float& rin, f32x16& zout, float& rout, M2State& st, const u32x4& pi0, const u32x4& pi1, u32x4& po0, u32x4& po1, const bf16x8 (&qf)[12], const unsigned (&koff)[4], const unsigned (&voff)[2][4],
                  const bool masked, const int qrh) {
#define M2_KF(d0) (*(LAS const bf16x8*)(koff[(d0) & 3] + (unsigned)(KIMM + 128 * ((d0) >> 2))))
#define M2_VF(t, j) vtr((lcp)(voff[t][(j) & 3] + (unsigned)(VIMM + 4096 * ((j) >> 2))))
    if (masked) {
        asm volatile("" ::: "memory");
#pragma unroll
        for (int g = 0; g < 16; ++g) if (crow(g, 0) > qrh) zin[g] = -INFINITY;
    }
    bf16x8 kfA = M2_KF(0), kfB; s16x4 la, ha, lb, hb;
    float mt = 0.f, mnew = 0.f, alpha = 1.f, ps = 0.f; bool grow = false; float pe[16];
    SBAR();
#pragma unroll
    for (int i = 0; i < 20; ++i) {
        const int c5 = i % 5, blk5 = i / 5; const bool isP = (c5 == 2 || c5 == 4);
        const int qi = blk5 * 3 + (c5 < 2 ? c5 : 2), pj = blk5 * 2 + (c5 == 2 ? 0 : 1);
        if (isP) { const s16x4 lo = (pj & 1) ? lb : la, hi = (pj & 1) ? hb : ha; const bf16x8 vf = (bf16x8){lo[0], lo[1], lo[2], lo[3], hi[0], hi[1], hi[2], hi[3]};
            st.o[pj & 3] = MFMA_BF16(vf, __builtin_bit_cast(bf16x8, (pj >> 2) ? pi1 : pi0), st.o[pj & 3]); }
        else if (i == 0) { f32x16 zero_;
#pragma unroll
            for (int g = 0; g < 16; ++g) zero_[g] = 0.f;
            (void)zero_; zout = MFMA_BF16(kfA, qf[0], st.negv); rout = st.nref; }
        else zout = MFMA_BF16((qi & 1) ? kfB : kfA, qf[qi], zout);
        if (!isP && qi + 1 < 12) { const bf16x8 nx = M2_KF(qi + 1); if ((qi + 1) & 1) kfB = nx; else kfA = nx; }
        if (isP && pj + 1 < 8) { const s16x4 l_ = M2_VF(0, pj + 1), h_ = M2_VF(1, pj + 1); if ((pj + 1) & 1) { lb = l_; hb = h_; } else { la = l_; ha = h_; } }
        if (i == 0) { la = M2_VF(0, 0); ha = M2_VF(1, 0); }
        SBAR();
        if (i < 4) { float a = vmax3_s(zin[4 * i], zin[4 * i + 1], zin[4 * i + 2]); mt = i == 0 ? vmax3_s(a, zin[3], zin[3]) : vmax3_s(mt, a, zin[4 * i + 3]); asm volatile("" : "+v"(mt)); }
        if (i == 4) { mt = swap_max(mt) + rin;
            grow = __builtin_amdgcn_ballot_w64((mt > st.mrun) || (rin != st.mrun)) != 0ull;
            if (grow) {
                mnew = fmaxf(st.mrun, mt); alpha = __builtin_amdgcn_exp2f(st.mrun - mnew); const float dl = mnew - rin;
#pragma unroll
                for (int g = 0; g < 16; ++g) zin[g] -= dl;
                st.mrun = mnew; st.lrun *= alpha; } }
        if (i >= 5 && i < 13) { const int g = 2 * (i - 5); float e0 = __builtin_amdgcn_exp2f(zin[g]), e1 = __builtin_amdgcn_exp2f(zin[g + 1]); ps += e0 + e1;
            asm volatile("" : "+v"(ps)); pe[g] = e0; pe[g + 1] = e1; }
        if (i >= 13 && i < 17) { const int w_ = i - 13; unsigned w0 = cvtpk(pe[4 * w_], pe[4 * w_ + 1]), w1 = cvtpk(pe[4 * w_ + 2], pe[4 * w_ + 3]); asm volatile("" : "+v"(w0), "+v"(w1));
            if (w_ < 2) { po0[2 * w_] = w0; po0[2 * w_ + 1] = w1; } else { po1[2 * (w_ - 2)] = w0; po1[2 * (w_ - 2) + 1] = w1; } }
        SBAR();
    }
    st.lrun += ps;
    if (grow) {
#pragma unroll
        for (int d0 = 0; d0 < 4; ++d0)
#pragma unroll
            for (int g = 0; g < 16; ++g) st.o[d0][g] *= alpha;
        st.nref = st.mrun;
#pragma unroll
        for (int g = 0; g < 16; ++g) st.negv[g] = -st.mrun;
    }
#undef M2_KF
#undef M2_VF
}
DI void mla2_unit(LAS unsigned char* lds, unsigned char* ws, int b, int h, int qb, const int tid_in) {
    int tid = tid_in; asm volatile("" : "+v"(tid));
    const int lane = tid & 63, wid = __builtin_amdgcn_readfirstlane(tid >> 6), r = lane & 31, hh = lane >> 5;
    const bf16_t *QN = (const bf16_t*)(ws + WS_QN), *QR = (const bf16_t*)(ws + WS_QR), *KN = (const bf16_t*)(ws + WS_KN), *KR = (const bf16_t*)(ws + WS_KR), *VA = (const bf16_t*)(ws + WS_VA), *SG = (const bf16_t*)(ws + WS_SG);
    bf16_t* MIX = (bf16_t*)(ws + WS_MIX);
    const int q0 = qb * 256, NT = 4 * (qb + 1), tmax = (q0 + 32 * wid) >> 6; const size_t rowbase = (size_t)b * SEQ;
    bf16x8 qf[12];
    { const size_t qrow = rowbase + q0 + 32 * wid + r;
#pragma unroll
      for (int d0 = 0; d0 < 8; ++d0) qf[d0] = *(const bf16x8*)(QN + qrow * 1024 + h * 128 + d0 * 16 + hh * 8);
#pragma unroll
      for (int d0 = 0; d0 < 4; ++d0) qf[8 + d0] = *(const bf16x8*)(QR + qrow * 512 + h * 64 + d0 * 16 + hh * 8); }
    M2State st;
#pragma unroll
    for (int d0 = 0; d0 < 4; ++d0)
#pragma unroll
        for (int g = 0; g < 16; ++g) st.o[d0][g] = 0.f;
    st.mrun = -INFINITY; st.lrun = 0.f; st.nref = 0.f;
#pragma unroll
    for (int g = 0; g < 16; ++g) st.negv[g] = 0.f;
    float ra = 0.f, rb = 0.f;
    unsigned koff[4], voff[2][4];
    { const unsigned blk = (lane >> 4) & 1, qq = (lane & 15) >> 2, p = lane & 3, f = (r >> 1) & 7;
      const unsigned kb_ = (unsigned)(size_t)lds + r * 384;
#pragma unroll
      for (int j = 0; j < 4; ++j) koff[j] = kb_ + 16 * ((2 * j + hh) ^ f);
      const unsigned vb0 = 256 * (4 * hh + qq) + 8 * (p & 1) + 16 * ((2 * blk + (p >> 1)) ^ hh), v0_ = (unsigned)(size_t)lds + M2_LDS_V + vb0, v1_ = (unsigned)(size_t)lds + M2_LDS_V + 2048 + (vb0 ^ 32);
#pragma unroll
      for (int d0 = 0; d0 < 4; ++d0) { voff[0][d0] = v0_ + ((64u * d0) ^ (64u * qq)); voff[1][d0] = v1_ + ((64u * d0) ^ (64u * qq)); } }
    const bf16_t* knb = KN + rowbase * 1024 + h * 128; const bf16_t* krb = KR + rowbase * 64; const bf16_t* vab = VA + rowbase * 1024 + h * 128;
    unsigned ksrc[3];
#pragma unroll
    for (int i_ = 0; i_ < 3; ++i_) { const int c_ = (3 * wid + i_) * 64 + lane, row_ = c_ / 24, ch_ = (c_ % 24) ^ ((row_ >> 1) & 7);
        ksrc[i_] = ch_ < 16 ? (unsigned)(row_ * 1024 + ch_ * 8) : (0x80000000u | (unsigned)(row_ * 64 + (ch_ - 16) * 8)); }
#define M2_DMAK(t, slot) do { _Pragma("unroll") for (int i_ = 0; i_ < 3; ++i_) { const unsigned o_ = ksrc[i_] & 0x7fffffffu; \
            const bf16_t* src_ = (ksrc[i_] >> 31) ? krb + (size_t)(t) * (64 * 64) + o_ : knb + (size_t)(t) * (64 * 1024) + o_; \
            __builtin_amdgcn_global_load_lds((const unsigned*)src_, (LAS unsigned*)(lds + (slot) * M2_KBUF + (3 * wid + i_) * 1024), 16, 0, 0); } } while (0)
#define M2_DMAV(t, slot) do { int t2_ = tid; asm volatile("" : "+v"(t2_)); const int ln_ = t2_ & 63, drow_ = 8 * wid + (ln_ >> 4), c15_ = ln_ & 15; \
        const unsigned s0_ = (unsigned)drow_ * 1024 + ((c15_ ^ (((drow_ & 3) << 2) | ((drow_ >> 2) & 3))) * 8), s1_ = (unsigned)(drow_ + 4) * 1024 + ((c15_ ^ ((((drow_ + 4) & 3) << 2) | (((drow_ + 4) >> 2) & 3))) * 8); \
        const bf16_t* vt = vab + (size_t)(t) * (64 * 1024); LAS unsigned char* vd = lds + M2_LDS_V + (slot) * VBUF + wid * 2048; \
        __builtin_amdgcn_global_load_lds((const unsigned*)(vt + s0_), (LAS unsigned*)vd, 16, 0, 0); __builtin_amdgcn_global_load_lds((const unsigned*)(vt + s1_), (LAS unsigned*)(vd + 1024), 16, 0, 0); } while (0)
    M2_DMAK(0, 0); M2_DMAV(0, 0); M2_DMAV(0, 2);
    if (NT > 1) M2_DMAK(1, 1);
    __builtin_amdgcn_s_waitcnt(0x0F70);
    __syncthreads();
    f32x16 za, zb;
#pragma unroll
    for (int g = 0; g < 16; ++g) { za[g] = 0.f; zb[g] = 0.f; }
#pragma unroll
    for (int d0 = 0; d0 < 12; ++d0) za = MFMA_BF16(*(LAS const bf16x8*)(koff[d0 & 3] + (unsigned)(128 * (d0 >> 2))), qf[d0], za);
    u32x4 pa[2], pb[2]; pa[0] = (u32x4){0u, 0u, 0u, 0u}; pa[1] = pa[0]; pb[0] = pa[0]; pb[1] = pa[0];
#define M2_INTERVAL(P) { if (t + 2 < NT) M2_DMAK(t + 2, ((P) + 2) % 3); if (t + 1 < NT) M2_DMAV(t + 1, ((P) + 1) % 3); \
        if (t <= tmax) {           \
            int qrh; { int t3 = tid; asm volatile("" : "+v"(t3)); qrh = q0 + 32 * wid + (t3 & 31) - 4 * ((t3 >> 5) & 1) - 64 * t; } const bool msk = t == tmax; \
            mla2_iter<(P) * M2_KBUF + 32 * 384, (((P) + 2) % 3) * VBUF + 8192>(za, ra, zb, rb, st, pa[0], pa[1], pb[0], pb[1], qf, koff, voff, msk, qrh); \
            mla2_iter<(((P) + 1) % 3) * M2_KBUF, (P) * VBUF>(zb, rb, za, ra, st, pb[0], pb[1], pa[0], pa[1], qf, koff, voff, msk, qrh - 32); \
            if (msk) {            \
                lcp vb_ = lds + M2_LDS_V + (P) * VBUF + 8192; const VAddr va_ = make_vaddr(tid & 63); \
                _Pragma("unroll") for (int j = 0; j < 8; ++j) st.o[j & 3] = MFMA_BF16(vfrag(vb_, j >> 2, j & 3, va_), __builtin_bit_cast(bf16x8, (j >> 2) ? pa[1] : pa[0]), st.o[j & 3]); } } \
        ++t; __syncthreads(); }
    int t = 0;
    for (;;) { M2_INTERVAL(0) if (t >= NT) break; M2_INTERVAL(1) if (t >= NT) break; M2_INTERVAL(2) if (t >= NT) break; }
#undef M2_INTERVAL
#undef M2_DMAK
#undef M2_DMAV
    const float inv = 1.0f / swap_sum(st.lrun);
    int t4 = tid; asm volatile("" : "+v"(t4)); const size_t qrow = rowbase + q0 + 32 * wid + (t4 & 31); const int hh2 = (t4 >> 5) & 1;
#pragma unroll
    for (int d0 = 0; d0 < 4; ++d0)
#pragma unroll
        for (int p = 0; p < 2; ++p) { const size_t off = qrow * 2048 + h * 128 + 32 * d0 + 16 * p + 8 * hh2; float e[8]; o_pair8(st.o[d0], p, e);
            const u32x4 sg = *(const u32x4*)(SG + off); u32x4 w;
#pragma unroll
            for (int j = 0; j < 4; ++j) w[j] = cvtpk(e[2 * j] * inv * __uint_as_float(sg[j] << 16), e[2 * j + 1] * inv * __uint_as_float(sg[j] & 0xffff0000u));
            *(u32x4*)(MIX + off) = w; }
}
DI void mla_phase(LAS unsigned char* lds, unsigned char* ws, const int tid) {
    const int G = gridDim.x, bx = blockIdx.x; const int vcu = (G % 8 == 0) ? (bx % 8) * (G / 8) + bx / 8 : bx;
    for (int p = vcu; p < 256; p += G) { const int bh = p >> 3, pr = p & 7;
#if MLA_PIPE
        mla2_unit(lds, ws, bh >> 3, bh & 7, 15 - pr, tid); mla2_unit(lds, ws, bh >> 3, bh & 7, pr, tid);
#else
        mla_unit(lds, ws, bh >> 3, bh & 7, 15 - pr, tid); mla_unit(lds, ws, bh >> 3, bh & 7, pr, tid);
#endif
 }
}

constexpr int SB_KBUF = 16384, SB_LDS_V = 3 * SB_KBUF, SB_LDS_UM = SB_LDS_V + 3 * VBUF, SB_LDS_BYTES = SB_LDS_UM + 2048 + 64;
DI float vmin_s(float a, float b) { float r; asm("v_min_f32 %0, %1, %2" : "=v"(r) : "v"(a), "v"(b)); return r; }
struct SbAddr { unsigned kx, vb0, vq; };
template <bool MASKED, int VAR>
DI void sb_iter(f32x16& zin, f32x16& zout, f32x16 (&o)[4], const u32x4& pi0, const u32x4& pi1, u32x4& po0, u32x4& po1, float& carry, const bf16x8 (&qf)[8], lcp ump, lcp knext, lcp vprev, const SbAddr& ad, int qrh) {
    u32x4 lw0, lw1; const float z0 = zin[0];
    unsigned kx = ad.kx, vq = ad.vq; asm volatile("" : "+v"(kx), "+v"(vq));
    bf16x8 kfa = *(LAS const bf16x8*)(knext + kx), kfb;
#pragma unroll
    for (int k = 0; k < 8; ++k) {
        if (k == 0) {
#pragma unroll
            for (int g = 0; g < 16; ++g) zout[g] = 0.f;
        }
        if (VAR == 2 || VAR == 4 || VAR == 11 || VAR == 13) { asm volatile("" :: "v"((k & 1) ? kfb : kfa)); } else zout = MFMA_BF16((k & 1) ? kfb : kfa, qf[k], zout);
        if (VAR == 12) { zout = MFMA_BF16((k & 1) ? kfb : kfa, qf[k], zout); zout = MFMA_BF16((k & 1) ? kfb : kfa, qf[k], zout); }
        if (k + 1 < 8) { bf16x8 nx; if (VAR == 3 || VAR == 4 || VAR == 9 || VAR == 11 || VAR == 12 || VAR == 13) nx = qf[k]; else nx = *(LAS const bf16x8*)(knext + ((32u * (k + 1)) ^ kx)); if (k & 1) kfa = nx; else kfb = nx; }
        SBAR();
        float lv[2];
#pragma unroll
        for (int i = 0; i < 2; ++i) { const int g = 2 * k + i;
            float sp; if (VAR == 8 || VAR == 9 || VAR == 12) sp = zin[g]; else if (VAR == 13) { sp = __builtin_amdgcn_logf(1.0f + __builtin_amdgcn_exp2f(vmin_s(zin[g], 64.0f))); sp = __builtin_amdgcn_logf(1.0f + __builtin_amdgcn_exp2f(vmin_s(sp, 64.0f))); sp = __builtin_amdgcn_logf(1.0f + __builtin_amdgcn_exp2f(vmin_s(sp, 64.0f))); } else if (VAR == 1 || VAR == 4) sp = vmin_s(zin[g], 64.0f) * 0.5f; else sp = __builtin_amdgcn_logf(1.0f + __builtin_amdgcn_exp2f(vmin_s(zin[g], 64.0f)));
            if (MASKED) lv[i] = (crow(g, 0) < qrh) ? sp : 0.f; else lv[i] = sp; }
        unsigned w = cvtpk_h(lv[0], lv[1]);
        asm volatile("" : "+v"(w));
        if (k < 4) lw0[k & 3] = w; else lw1[k & 3] = w;
        SBAR();
    }
    const f16x8 um0 = *(LAS const f16x8*)ump, um1 = *(LAS const f16x8*)(ump + 16);
    zin = MFMA_F16(um0, __builtin_bit_cast(f16x8, lw0), zin); zin = MFMA_F16(um1, __builtin_bit_cast(f16x8, lw1), zin);
    SBAR();
    s16x4 la, ha, lb, hb;
    const unsigned vb0 = ad.vb0, vb1 = 2048 + (vb0 ^ 32);
    { const unsigned dq = vq; la = vtr(vprev + vb0 + dq); ha = vtr(vprev + vb1 + dq); }
#pragma unroll
    for (int j = 0; j < 8; ++j) {
        { const s16x4 lo = (j & 1) ? lb : la, hi = (j & 1) ? hb : ha;
          const bf16x8 vf = (bf16x8){lo[0], lo[1], lo[2], lo[3], hi[0], hi[1], hi[2], hi[3]};
          if (VAR == 2 || VAR == 4 || VAR == 11 || VAR == 13) { asm volatile("" :: "v"(vf)); } else o[j & 3] = MFMA_BF16(vf, __builtin_bit_cast(bf16x8, (j >> 2) ? pi1 : pi0), o[j & 3]);
          if (VAR == 12) { o[(j + 1) & 3] = MFMA_BF16(vf, __builtin_bit_cast(bf16x8, (j >> 2) ? pi1 : pi0), o[(j + 1) & 3]); o[(j + 2) & 3] = MFMA_BF16(vf, __builtin_bit_cast(bf16x8, (j >> 2) ? pi1 : pi0), o[(j + 2) & 3]); } }
        if (j + 1 < 8) { const unsigned dq = (64u * ((j + 1) & 3)) ^ vq; s16x4 l_, h_; if (VAR == 3 || VAR == 4 || VAR == 9 || VAR == 11 || VAR == 12 || VAR == 13) { l_ = (s16x4){(short)pi0[0], (short)pi0[1], (short)pi0[2], (short)pi0[3]}; h_ = l_; } else { l_ = vtr(vprev + 4096 * ((j + 1) >> 2) + vb0 + dq); h_ = vtr(vprev + 4096 * ((j + 1) >> 2) + vb1 + dq); }
            if (j & 1) { la = l_; ha = h_; } else { lb = l_; hb = h_; } }
        SBAR();
        float av[2];
#pragma unroll
        for (int i = 0; i < 2; ++i) { const int g = 2 * j + i; float a; if (VAR == 8 || VAR == 9 || VAR == 12) a = zin[g]; else if (VAR == 13) { a = __builtin_amdgcn_exp2f(zin[g] + carry); a = __builtin_amdgcn_exp2f(a + carry); a = __builtin_amdgcn_exp2f(a + carry); } else if (VAR == 1 || VAR == 4) a = zin[g] + carry; else a = __builtin_amdgcn_exp2f(zin[g] + carry); if (MASKED) av[i] = (crow(g, 0) < qrh) ? a : 0.f; else av[i] = a; }
        unsigned w = cvtpk(av[0], av[1]);
        asm volatile("" : "+v"(w));
        if (j < 4) po0[j & 3] = w; else po1[j & 3] = w;
        SBAR();
    }
    carry += bcast_lo(zin[0] - z0);
}
template <int KIMM, int VIMM>
DI void sb_iter_s(f32x16& zin, f32x16& zout, f32x16 (&o)[4], const u32x4& pi0, const u32x4& pi1, u32x4& po0, u32x4& po1, float& carry, const bf16x8 (&qf)[8], lcp ump,
                  const unsigned (&koff)[8], const unsigned (&voff)[2][4]) {
    u32x4 lw0, lw1; const float z0 = zin[0];
#define SB_KF(k) (*(LAS const bf16x8*)(koff[k] + (unsigned)KIMM))
#define SB_VF(t, j) vtr((lcp)(voff[t][(j) & 3] + (unsigned)(VIMM + 4096 * ((j) >> 2))))
    bf16x8 kfa = SB_KF(0), kfb;
    const f16x8 um0 = *(LAS const f16x8*)ump, um1 = *(LAS const f16x8*)(ump + 16);
    SBAR();
#pragma unroll
    for (int k = 0; k < 8; ++k) {
        if (k == 0) {
#pragma unroll
            for (int g = 0; g < 16; ++g) zout[g] = 0.f;
        }
        zout = MFMA_BF16((k & 1) ? kfb : kfa, qf[k], zout);
        if (k + 1 < 8) { const bf16x8 nx = SB_KF(k + 1); if (k & 1) kfa = nx; else kfb = nx; }
        SBAR();
        float lv[2];
#pragma unroll
        for (int i = 0; i < 2; ++i) lv[i] = __builtin_amdgcn_logf(1.0f + __builtin_amdgcn_exp2f(vmin_s(zin[2 * k + i], 64.0f)));
        unsigned w = cvtpk_h(lv[0], lv[1]);
        asm volatile("" : "+v"(w));
        if (k < 4) lw0[k & 3] = w; else lw1[k & 3] = w;
        SBAR();
    }
    s16x4 la = SB_VF(0, 0), ha = SB_VF(1, 0), lb, hb;
    SBAR();
    zin = MFMA_F16(um0, __builtin_bit_cast(f16x8, lw0), zin); zin = MFMA_F16(um1, __builtin_bit_cast(f16x8, lw1), zin);
    SBAR();
#pragma unroll
    for (int j = 0; j < 8; ++j) {
        { const s16x4 lo = (j & 1) ? lb : la, hi = (j & 1) ? hb : ha;
          const bf16x8 vf = (bf16x8){lo[0], lo[1], lo[2], lo[3], hi[0], hi[1], hi[2], hi[3]};
          o[j & 3] = MFMA_BF16(vf, __builtin_bit_cast(bf16x8, (j >> 2) ? pi1 : pi0), o[j & 3]); }
        if (j + 1 < 8) { const s16x4 l_ = SB_VF(0, j + 1), h_ = SB_VF(1, j + 1); if (j & 1) { la = l_; ha = h_; } else { lb = l_; hb = h_; } }
        SBAR();
        float av[2];
#pragma unroll
        for (int i = 0; i < 2; ++i) av[i] = __builtin_amdgcn_exp2f(zin[2 * j + i] + carry);
        unsigned w = cvtpk(av[0], av[1]);
        asm volatile("" : "+v"(w));
        if (j < 4) po0[j & 3] = w; else po1[j & 3] = w;
        SBAR();
    }
#undef SB_KF
#undef SB_VF
    carry += bcast_lo(zin[0] - z0);
}
template <int P>
DI void sb_tile_s(f32x16& za, f32x16& zb, f32x16 (&o)[4], u32x4 (&pa)[2], u32x4 (&pb)[2], float& carry, const bf16x8 (&qf)[8], lcp ump, const unsigned (&koff)[8], const unsigned (&voff)[2][4]) {
    constexpr int KS = P, KSN = (P + 1) % 3, VS = P, VSP = (P + 2) % 3;
    sb_iter_s<KS * SB_KBUF, VSP * VBUF>(za, zb, o, pa[0], pa[1], pb[0], pb[1], carry, qf, ump, koff, voff);
    sb_iter_s<KSN * SB_KBUF + 8192, VS * VBUF + 8192>(zb, za, o, pb[0], pb[1], pa[0], pa[1], carry, qf, ump, koff, voff);
}
template <bool MASKED, int VAR>
DI void sb_tile(LAS unsigned char* lds, f32x16& za, f32x16& zb, f32x16 (&o)[4], u32x4 (&pa)[2], u32x4 (&pb)[2], float& carry, const bf16x8 (&qf)[8], lcp ump, const SbAddr& ad,
                unsigned krow_off, int ks, int ksn, int vs, int vsp, int qrh0) {
    sb_iter<MASKED, VAR>(za, zb, o, pa[0], pa[1], pb[0], pb[1], carry, qf, ump, lds + ks * SB_KBUF + krow_off, lds + SB_LDS_V + vsp * VBUF, ad, qrh0 - 32);
    sb_iter<MASKED, VAR>(zb, za, o, pb[0], pb[1], pa[0], pa[1], carry, qf, ump, lds + ksn * SB_KBUF + 8192 + krow_off, lds + SB_LDS_V + vs * VBUF + 8192, ad, qrh0);
}
template <int VAR> DI void sb_unit(LAS unsigned char* lds, unsigned char* ws, int b, int h, int qb, const int tid_in) {
    int tid = tid_in; asm volatile("" : "+v"(tid));
    const int lane = tid & 63, wid = __builtin_amdgcn_readfirstlane(tid >> 6), r = lane & 31, hh = lane >> 5;
    const bf16_t *Q2 = (const bf16_t*)(ws + WS_Q2), *K2 = (const bf16_t*)(ws + WS_K2), *V2 = (const bf16_t*)(ws + WS_V2), *SG2 = (const bf16_t*)(ws + WS_SG2);
    bf16_t* MIX2 = (bf16_t*)(ws + (VAR ? WS_A : WS_MIX2));
    const int q0 = qb * 256, NT = 4 * (qb + 1), tmax = (q0 + 32 * wid) >> 6; const size_t rowbase = (size_t)b * SEQ;
    bf16x8 qf[8];
    { const size_t qrow = rowbase + q0 + 32 * wid + r;
#pragma unroll
      for (int d0 = 0; d0 < 8; ++d0) qf[d0] = *(const bf16x8*)(Q2 + qrow * 2048 + h * 128 + d0 * 16 + hh * 8); }
    { f16x8 um[2];
#pragma unroll
      for (int s = 0; s < 2; ++s)
#pragma unroll
          for (int j = 0; j < 8; ++j) um[s][j] = (16 * s + 8 * (j >> 2) + 4 * hh + (j & 3)) >= r ? (_Float16)-1.0f : (_Float16)0.0f;
      *(LAS f16x8*)(lds + SB_LDS_UM + lane * 32) = um[0]; *(LAS f16x8*)(lds + SB_LDS_UM + lane * 32 + 16) = um[1]; }
    lcp ump = lds + SB_LDS_UM + lane * 32;
    f32x16 o[4];
#pragma unroll
    for (int d0 = 0; d0 < 4; ++d0)
#pragma unroll
        for (int g = 0; g < 16; ++g) o[d0][g] = 0.f;
    float carry = 0.f;
    SbAddr ad;
    { const unsigned blk = (lane >> 4) & 1, qq = (lane & 15) >> 2, p = lane & 3;
      ad.kx = ((r & 15) >> 1) << 5;
      ad.vb0 = 256 * (4 * hh + qq) + 8 * (p & 1) + 16 * ((2 * blk + (p >> 1)) ^ hh); ad.vq = 64 * qq; }
    const unsigned krow_off = r * 256 + ((hh ^ (r & 1)) << 4);
    const bf16_t* kbase = K2 + rowbase * 2048 + h * 128; const bf16_t* vbase = V2 + rowbase * 2048 + h * 128;
#define SB_DMA_SRC() int t2_ = tid; asm volatile("" : "+v"(t2_)); const int ln_ = t2_ & 63, drow_ = 8 * wid + (ln_ >> 4), c15_ = ln_ & 15;
#define SB_DMAK(tau, slot) do { SB_DMA_SRC(); const unsigned s0_ = (unsigned)drow_ * 2048 + ((c15_ ^ (drow_ & 15)) * 8), s1_ = (unsigned)(drow_ + 4) * 2048 + ((c15_ ^ ((drow_ + 4) & 15)) * 8); \
        const bf16_t* kt = kbase + (size_t)(NT - 1 - (tau)) * (64 * 2048); LAS unsigned char* kd = lds + (slot) * SB_KBUF + wid * 2048; \
        __builtin_amdgcn_global_load_lds((const unsigned*)(kt + s0_), (LAS unsigned*)kd, 16, 0, 0); __builtin_amdgcn_global_load_lds((const unsigned*)(kt + s1_), (LAS unsigned*)(kd + 1024), 16, 0, 0); } while (0)
#define SB_DMAV(tau, slot) do { SB_DMA_SRC(); const unsigned s0_ = (unsigned)drow_ * 2048 + ((c15_ ^ (((drow_ & 3) << 2) | ((drow_ >> 2) & 3))) * 8), s1_ = (unsigned)(drow_ + 4) * 2048 + ((c15_ ^ ((((drow_ + 4) & 3) << 2) | (((drow_ + 4) >> 2) & 3))) * 8); \
        const bf16_t* vt = vbase + (size_t)(NT - 1 - (tau)) * (64 * 2048); LAS unsigned char* vd = lds + SB_LDS_V + (slot) * VBUF + wid * 2048; \
        __builtin_amdgcn_global_load_lds((const unsigned*)(vt + s0_), (LAS unsigned*)vd, 16, 0, 0); __builtin_amdgcn_global_load_lds((const unsigned*)(vt + s1_), (LAS unsigned*)(vd + 1024), 16, 0, 0); } while (0)
    SB_DMAK(0, 0); SB_DMAV(0, 0);
    if (NT > 1) SB_DMAK(1, 1);
    __builtin_amdgcn_s_waitcnt(0x0F70);
    __syncthreads();
    f32x16 za, zb;
#pragma unroll
    for (int g = 0; g < 16; ++g) { za[g] = 0.f; zb[g] = 0.f; }
    u32x4 pa[2], pb[2]; pa[0] = (u32x4){0u, 0u, 0u, 0u}; pa[1] = pa[0]; pb[0] = pa[0]; pb[1] = pa[0];
    int ks = 0, ks1 = 1, vs = 0, vsp = 0;
    const int nmask = NT - tmax;
    constexpr float SB_STOP = -140.0f;
    LAS unsigned* flg = (LAS unsigned*)(lds + SB_LDS_UM + 2048);
    bool wdone = false, alldone = false; int par = 0, lim = NT;
#define SB_CLOSE() { wdone = wdone | (__builtin_amdgcn_ballot_w64(carry > SB_STOP) == 0ull); lim = wdone ? (lim < tau + 1 ? lim : tau + 1) : lim;        \
        { int t5 = tid; asm volatile("" : "+v"(t5)); if ((t5 & 63) == 0) flg[par * 8 + wid] = wdone ? 1u : 0u; } \
        __syncthreads();                            \
        { const u32x4 f0 = *(LAS const u32x4*)(flg + par * 8), f1 = *(LAS const u32x4*)(flg + par * 8 + 4); \
          alldone = __builtin_amdgcn_readfirstlane((int)(f0[0] & f0[1] & f0[2] & f0[3] & f1[0] & f1[1] & f1[2] & f1[3])) != 0; } par ^= 1; }
#define SB_INTERVAL(MASKED) { const int t = NT - 1 - tau; const int ks2 = (ks1 == 2) ? 0 : ks1 + 1, vs1 = (vs == 2) ? 0 : vs + 1; \
        if (tau + 2 < NT) SB_DMAK(tau + 2, ks2); \
        if (tau + 1 < NT) SB_DMAV(tau + 1, vs1); \
        int qrh0; { int t3 = tid; asm volatile("" : "+v"(t3)); qrh0 = q0 + 32 * wid + (t3 & 31) - 4 * ((t3 >> 5) & 1) - 64 * t; }        \
        sb_tile<MASKED, VAR>(lds, za, zb, o, pa, pb, carry, qf, ump, ad, krow_off, ks, (tau + 1 < NT ? ks1 : ks), vs, vsp, qrh0); \
        SB_CLOSE() \
        ks = ks1; ks1 = ks2; vsp = vs; vs = vs1; }
    int tau = 0;
    for (; tau < nmask - 1 && !alldone; ++tau) { const int ks2 = (ks1 == 2) ? 0 : ks1 + 1, vs1 = (vs == 2) ? 0 : vs + 1;
        if (tau + 2 < NT) SB_DMAK(tau + 2, ks2);
        if (tau + 1 < NT) SB_DMAV(tau + 1, vs1);
        SB_CLOSE()
        ks = ks1; ks1 = ks2; vsp = vs; vs = vs1; }
    { lcp kp = lds + ks * SB_KBUF + 8192 + krow_off;
#pragma unroll
      for (int k = 0; k < 8; ++k) za = MFMA_BF16(*(LAS const bf16x8*)(kp + ((32u * k) ^ ad.kx)), qf[k], za); }
    for (; tau < nmask && tau < lim; ++tau) SB_INTERVAL(true)
    for (; tau < lim; ++tau) SB_INTERVAL(false)
#undef SB_INTERVAL
    { lcp vp = lds + SB_LDS_V + vsp * VBUF;
#pragma unroll
      for (int j = 0; j < 8; ++j) { const unsigned dq = (64u * (j & 3)) ^ ad.vq;
          const s16x4 lo = vtr(vp + 4096 * (j >> 2) + ad.vb0 + dq), hi = vtr(vp + 4096 * (j >> 2) + 2048 + (ad.vb0 ^ 32) + dq);
          o[j & 3] = MFMA_BF16(((bf16x8){lo[0], lo[1], lo[2], lo[3], hi[0], hi[1], hi[2], hi[3]}), __builtin_bit_cast(bf16x8, (j >> 2) ? pa[1] : pa[0]), o[j & 3]); } }
    for (; tau < NT && !alldone; ++tau) { const int ks2 = (ks1 == 2) ? 0 : ks1 + 1, vs1 = (vs == 2) ? 0 : vs + 1;
        if (tau + 2 < NT) SB_DMAK(tau + 2, ks2);
        if (tau + 1 < NT) SB_DMAV(tau + 1, vs1);
        SB_CLOSE()
        ks = ks1; ks1 = ks2; vsp = vs; vs = vs1; }
#undef SB_CLOSE
    __syncthreads();
#undef SB_DMAK
#undef SB_DMAV
#undef SB_DMA_SRC
    int t4 = tid; asm volatile("" : "+v"(t4)); const size_t qrow = rowbase + q0 + 32 * wid + (t4 & 31); const int hh2 = (t4 >> 5) & 1;
#pragma unroll
    for (int d0 = 0; d0 < 4; ++d0)
#pragma unroll
        for (int p = 0; p < 2; ++p) { const size_t off = qrow * 2048 + h * 128 + 32 * d0 + 16 * p + 8 * hh2; float e[8]; o_pair8(o[d0], p, e);
            const u32x4 sg = *(const u32x4*)(SG2 + off); u32x4 w;
#pragma unroll
            for (int j = 0; j < 4; ++j) w[j] = cvtpk(e[2 * j] * __uint_as_float(sg[j] << 16), e[2 * j + 1] * __uint_as_float(sg[j] & 0xffff0000u));
            *(u32x4*)(MIX2 + off) = w; }
}
template <int VAR> DI void sb_phase(LAS unsigned char* lds, unsigned char* ws, const int tid) {
    const int G = gridDim.x, bx = blockIdx.x; const int vcu = (G % 8 == 0) ? (bx % 8) * (G / 8) + bx / 8 : bx;
    for (int p = vcu; p < 512; p += G) { const int bh = p >> 3, pr = p & 7; sb_unit<VAR>(lds, ws, bh >> 4, bh & 15, 15 - pr, tid); sb_unit<VAR>(lds, ws, bh >> 4, bh & 15, pr, tid); }
}

constexpr int DIL_KSTR = 272, DIL_WAVE_BYTES = 32 * DIL_KSTR + 8192, DIL_LDS_BYTES = 8 * DIL_WAVE_BYTES;
DI void softmax_blk(f32x16& s0, f32x16 (&o)[4], float& mrun, float& lrun) {
    float mt = s0[0];
#pragma unroll
    for (int g = 1; g < 16; ++g) mt = fmaxf(mt, s0[g]);
    mt = swap_max(mt);
    if (__builtin_amdgcn_ballot_w64(mt > mrun) != 0ull) {
        const float mn = fmaxf(mrun, mt), alpha = __builtin_amdgcn_exp2f(mrun - mn); mrun = mn; lrun *= alpha;
#pragma unroll
        for (int d0 = 0; d0 < 4; ++d0)
#pragma unroll
            for (int g = 0; g < 16; ++g) o[d0][g] *= alpha;
    }
    float ps = 0.f;
#pragma unroll
    for (int g = 0; g < 16; ++g) { s0[g] = __builtin_amdgcn_exp2f(s0[g] - mrun); ps += s0[g]; }
    lrun += ps;
}
DI void dil_wave_unit(LAS unsigned char* wl, unsigned char* ws, int p, int b, int h, int res, int m0w, const int tid_in) {
    int tid = tid_in; asm volatile("" : "+v"(tid));
    const int lane = tid & 63, r = lane & 31, hh = lane >> 5; const int dil = p == 0 ? 1 : p == 1 ? 4 : 16;
    const bf16_t *QB = (const bf16_t*)(ws + WS_QB), *KB = (const bf16_t*)(ws + WS_KB), *VB = (const bf16_t*)(ws + WS_VB);
    const size_t rowbase = (size_t)b * SEQ; const size_t qrow = rowbase + (size_t)(m0w + r) * dil + res;
    const __amdgpu_buffer_rsrc_t rK = mk_rsrc(KB, M * 1024 * 2), rV = mk_rsrc(VB, M * 1024 * 2);
    const unsigned vo = (unsigned)(lane >> 4) * dil * 2048 + (lane & 15) * 16;
    const unsigned so0 = (unsigned)((rowbase + res) * 1024 + h * 128) * 2;
    const float* biasc = (const float*)(ws + WS_BIASC) + (size_t)(p * 8 + h) * 5 * 1024 + lane * 16;
    u32x4 kr[8], vr[8]; f32x4 br[4];
    const int kb0 = m0w >> 5;
#define DIL_LOAD(di) do { const unsigned sb_ = so0 + (unsigned)(32 * (kb0 - (di))) * dil * 2048; \
        _Pragma("unroll") for (int i = 0; i < 8; ++i) { kr[i] = bload(rK, vo + (unsigned)(4 * i) * dil * 2048, sb_); vr[i] = bload(rV, vo + (unsigned)(4 * i) * dil * 2048, sb_); } \
        _Pragma("unroll") for (int j = 0; j < 4; ++j) br[j] = ((const f32x4*)(biasc + (di) * 1024))[j]; } while (0)
    DIL_LOAD(0);
    bf16x8 qf[8];
#pragma unroll
    for (int d0 = 0; d0 < 8; ++d0) qf[d0] = *(const bf16x8*)(QB + qrow * 1024 + h * 128 + d0 * 16 + hh * 8);
    f32x16 o[4];
#pragma unroll
    for (int d0 = 0; d0 < 4; ++d0)
#pragma unroll
        for (int g = 0; g < 16; ++g) o[d0][g] = 0.f;
    float mrun = -INFINITY, lrun = 0.f;
    const VAddr va = make_vaddr(lane);
    const unsigned lk = (lane >> 4) * DIL_KSTR + (lane & 15) * 16;
    for (int di = 0; di < 5; ++di) {
        if (kb0 - di < 0) break;
        asm volatile("s_waitcnt lgkmcnt(0)" ::: "memory");
#pragma unroll
        for (int i = 0; i < 8; ++i) { *(LAS u32x4*)(wl + lk + 4 * i * DIL_KSTR) = kr[i]; *(LAS u32x4*)(wl + 32 * DIL_KSTR + off_b((lane >> 4) + 4 * i, lane & 15)) = vr[i]; }
        f32x16 s0;
#pragma unroll
        for (int j = 0; j < 4; ++j) { s0[4 * j] = br[j][0]; s0[4 * j + 1] = br[j][1]; s0[4 * j + 2] = br[j][2]; s0[4 * j + 3] = br[j][3]; }
        if (di + 1 < 5 && kb0 - (di + 1) >= 0) DIL_LOAD(di + 1);
        asm volatile("s_waitcnt lgkmcnt(0)" ::: "memory");
        lcp kp = wl + r * DIL_KSTR + hh * 16;
#pragma unroll
        for (int d0 = 0; d0 < 8; ++d0) s0 = MFMA_BF16(*(LAS const bf16x8*)(kp + d0 * 32), qf[d0], s0);
        softmax_blk(s0, o, mrun, lrun);
        lcp vb = wl + 32 * DIL_KSTR;
#pragma unroll
        for (int s = 0; s < 2; ++s) { const bf16x8 pf = pack_bf(s0, s);
#pragma unroll
            for (int d0 = 0; d0 < 4; ++d0) o[d0] = MFMA_BF16(vfrag(vb, s, d0, va), pf, o[d0]); }
    }
#undef DIL_LOAD
    const float lt = swap_sum(lrun), inv = 1.0f / lt;
    bf16_t* OP = (bf16_t*)(ws + (p == 0 ? WS_OP0 : p == 1 ? WS_OP1 : WS_OP2));
#pragma unroll
    for (int d0 = 0; d0 < 4; ++d0)
#pragma unroll
        for (int gg = 0; gg < 4; ++gg) { const size_t off = qrow * 1024 + h * 128 + 32 * d0 + 8 * gg + 4 * hh;
            const unsigned lo = cvtpk(o[d0][4 * gg] * inv, o[d0][4 * gg + 1] * inv), hi = cvtpk(o[d0][4 * gg + 2] * inv, o[d0][4 * gg + 3] * inv);
            *(unsigned long long*)(OP + off) = (unsigned long long)lo | ((unsigned long long)hi << 32); }
    if (hh == 0) ((float*)(ws + WS_LSE))[((size_t)p * M + qrow) * 8 + h] = mrun + __builtin_amdgcn_logf(lt);
}
constexpr int DILW_LDS_BYTES = 12 * 8192;
DI void dil_wg_unit(LAS unsigned char* lds, unsigned char* ws, int p, int b, int h, int res, int m0, const int tid_in) {
    int tid = tid_in; asm volatile("" : "+v"(tid));
    const int lane = tid & 63, wid = __builtin_amdgcn_readfirstlane(tid >> 6), r = lane & 31, hh = lane >> 5; const int dil = p == 0 ? 1 : p == 1 ? 4 : 16;
    const bf16_t *QB = (const bf16_t*)(ws + WS_QB), *KB = (const bf16_t*)(ws + WS_KB), *VB = (const bf16_t*)(ws + WS_VB);
    const size_t rowbase = (size_t)b * SEQ; const size_t qrow = rowbase + (size_t)(m0 + 32 * wid + r) * dil + res;
    const int kbw = (m0 >> 5) - 4;
    const int prow = 4 * wid + (lane >> 4);
    const unsigned ksw = ((lane & 15) ^ (prow & 15)) * 8, vsw = ((lane & 15) ^ (((prow & 3) << 2) | ((prow >> 2) & 3))) * 8;
    const bf16_t* kg = KB + (rowbase + res) * 1024 + h * 128; const bf16_t* vg = VB + (rowbase + res) * 1024 + h * 128;
#pragma unroll
    for (int i = 0; i < 12; ++i) { const int kb = kbw + i; if (kb >= 0)
        __builtin_amdgcn_global_load_lds((const unsigned*)(kg + (size_t)(32 * kb + prow) * dil * 1024 + ksw), (LAS unsigned*)(lds + i * 8192 + wid * 1024), 16, 0, 0); }
    bf16x8 qf[8];
#pragma unroll
    for (int d0 = 0; d0 < 8; ++d0) qf[d0] = *(const bf16x8*)(QB + qrow * 1024 + h * 128 + d0 * 16 + hh * 8);
    const float* biasc = (const float*)(ws + WS_BIASC) + (size_t)(p * 8 + h) * 5 * 1024 + lane * 16;
    f32x16 sc[5];
#pragma unroll
    for (int di = 0; di < 5; ++di) { const f32x4* bp = (const f32x4*)(biasc + di * 1024);
#pragma unroll
        for (int j = 0; j < 4; ++j) { const f32x4 v = bp[j]; sc[di][4 * j] = v[0]; sc[di][4 * j + 1] = v[1]; sc[di][4 * j + 2] = v[2]; sc[di][4 * j + 3] = v[3]; } }
    __builtin_amdgcn_s_waitcnt(0x0F70);
    __syncthreads();
    const unsigned kx = ((r & 15) >> 1) << 5, krow_off = r * 256 + ((hh ^ (r & 1)) << 4);
#pragma unroll
    for (int di = 0; di < 5; ++di) { const int jj = wid + 4 - di;
        if (kbw + jj >= 0) { lcp kp = lds + jj * 8192 + krow_off;
#pragma unroll
            for (int k = 0; k < 8; ++k) sc[di] = MFMA_BF16(*(LAS const bf16x8*)(kp + ((32u * k) ^ kx)), qf[k], sc[di]); }
        else {
#pragma unroll
            for (int g = 0; g < 16; ++g) sc[di][g] = -INFINITY; } }
    float mx = sc[0][0];
#pragma unroll
    for (int di = 0; di < 5; ++di)
#pragma unroll
        for (int g = 0; g < 16; ++g) mx = fmaxf(mx, sc[di][g]);
    mx = swap_max(mx);
    float ps = 0.f; u32x4 pw[5][2];
#pragma unroll
    for (int di = 0; di < 5; ++di) {
#pragma unroll
        for (int g = 0; g < 16; ++g) { sc[di][g] = __builtin_amdgcn_exp2f(sc[di][g] - mx); ps += sc[di][g]; }
        pw[di][0] = __builtin_bit_cast(u32x4, pack_bf(sc[di], 0)); pw[di][1] = __builtin_bit_cast(u32x4, pack_bf(sc[di], 1)); }
    __syncthreads();
#pragma unroll
    for (int i = 0; i < 12; ++i) { const int kb = kbw + i; if (kb >= 0)
        __builtin_amdgcn_global_load_lds((const unsigned*)(vg + (size_t)(32 * kb + prow) * dil * 1024 + vsw), (LAS unsigned*)(lds + i * 8192 + wid * 1024), 16, 0, 0); }
    f32x16 o[4];
#pragma unroll
    for (int d0 = 0; d0 < 4; ++d0)
#pragma unroll
        for (int g = 0; g < 16; ++g) o[d0][g] = 0.f;
    const VAddr va = make_vaddr(lane);
    __builtin_amdgcn_s_waitcnt(0x0F70);
    __syncthreads();
#pragma unroll
    for (int di = 0; di < 5; ++di) { const int jj = wid + 4 - di;
        if (kbw + jj >= 0) { lcp vb = lds + jj * 8192;
#pragma unroll
            for (int s = 0; s < 2; ++s)
#pragma unroll
                for (int d0 = 0; d0 < 4; ++d0) o[d0] = MFMA_BF16(vfrag(vb, s, d0, va), __builtin_bit_cast(bf16x8, pw[di][s]), o[d0]); } }
    const float lt = swap_sum(ps), inv = 1.0f / lt;
    bf16_t* OP = (bf16_t*)(ws + (p == 0 ? WS_OP0 : p == 1 ? WS_OP1 : WS_OP2));
    { LAS unsigned char* stg = lds + DILW_LDS_BYTES + wid * 4608; const int rl = lane >> 3, ch = lane & 7;
#pragma unroll
      for (int half = 0; half < 2; ++half) {
#pragma unroll
        for (int dd = 0; dd < 2; ++dd)
#pragma unroll
            for (int gg = 0; gg < 4; ++gg) { const int d0 = 2 * half + dd;
                const unsigned lo = cvtpk(o[d0][4 * gg] * inv, o[d0][4 * gg + 1] * inv), hi = cvtpk(o[d0][4 * gg + 2] * inv, o[d0][4 * gg + 3] * inv);
                *(LAS unsigned long long*)(stg + r * 144 + (32 * dd + 8 * gg + 4 * hh) * 2) = (unsigned long long)lo | ((unsigned long long)hi << 32); }
#pragma unroll
        for (int j = 0; j < 4; ++j) { const u32x4 w = *(LAS const u32x4*)(stg + (8 * j + rl) * 144 + ch * 16);
            const size_t grow = rowbase + (size_t)(m0 + 32 * wid + 8 * j + rl) * dil + res;
            *(u32x4*)(OP + grow * 1024 + h * 128 + half * 64 + ch * 8) = w; } } }
    if (hh == 0) ((float*)(ws + WS_LSE))[((size_t)p * M + qrow) * 8 + h] = mx + __builtin_amdgcn_logf(lt);
    __syncthreads();
}
DI void dil_phase(LAS unsigned char* lds, unsigned char* ws, const int tid) {
    for (int u = blockIdx.x; u < 1536; u += gridDim.x) {
        const int cidx = u & 15, h = (u >> 4) & 7, b = (u >> 7) & 3, p = u >> 9;
        const int res = p == 0 ? 0 : p == 1 ? (cidx & 3) : cidx, m0 = p == 0 ? 256 * cidx : p == 1 ? 256 * (cidx >> 2) : 0;
        dil_wg_unit(lds, ws, p, b, h, res, m0, tid);
    }
}
}

__global__ void __launch_bounds__(512, 2) k_mla_fast(Ctx c) { extern __shared__ __attribute__((aligned(16))) unsigned char lds[]; att::mla_phase((LAS unsigned char*)lds, c.ws, (int)threadIdx.x); }
__global__ void __launch_bounds__(512, 2) k_sb_fast(Ctx c) { extern __shared__ __attribute__((aligned(16))) unsigned char lds[]; att::sb_phase<0>((LAS unsigned char*)lds, c.ws, (int)threadIdx.x); }
__global__ void __launch_bounds__(512, 2) k_dil_fast(Ctx c) { extern __shared__ __attribute__((aligned(16))) unsigned char lds[]; att::dil_phase((LAS unsigned char*)lds, c.ws, (int)threadIdx.x); }

template <bool FROMBF>
DI void final_norm_row(float* out, const bf16_t* xb, const float* gain, int row, int lane) {
    f32x4* xr = (f32x4*)(out + (size_t)row * D_MODEL) + lane; const f32x4* g = (const f32x4*)gain + lane;
    f32x4 v[8]; float s = 0.f;
    if (FROMBF) { const u32x4* br = (const u32x4*)(xb + (size_t)row * D_MODEL) + lane;
#pragma unroll
        for (int j = 0; j < 4; ++j) { const u32x4 w = br[64 * j];
            v[2 * j] = (f32x4){__uint_as_float(w[0] << 16), __uint_as_float(w[0] & 0xffff0000u), __uint_as_float(w[1] << 16), __uint_as_float(w[1] & 0xffff0000u)};
            v[2 * j + 1] = (f32x4){__uint_as_float(w[2] << 16), __uint_as_float(w[2] & 0xffff0000u), __uint_as_float(w[3] << 16), __uint_as_float(w[3] & 0xffff0000u)}; }
#pragma unroll
        for (int j = 0; j < 8; ++j) s += v[j].x * v[j].x + v[j].y * v[j].y + v[j].z * v[j].z + v[j].w * v[j].w;
        const float r = rsqrtf(wave_sum(s) * (1.0f / D_MODEL) + EPS);
        f32x4* o4 = (f32x4*)(out + (size_t)row * D_MODEL); const f32x4* g4 = (const f32x4*)gain;
#pragma unroll
        for (int j = 0; j < 4; ++j) { const int i0 = 128 * j + 2 * lane; o4[i0] = v[2 * j] * r * g4[i0]; o4[i0 + 1] = v[2 * j + 1] * r * g4[i0 + 1]; }
    } else {
#pragma unroll
        for (int j = 0; j < 8; ++j) { v[j] = xr[64 * j]; s += v[j].x * v[j].x + v[j].y * v[j].y + v[j].z * v[j].z + v[j].w * v[j].w; }
        const float r = rsqrtf(wave_sum(s) * (1.0f / D_MODEL) + EPS);
#pragma unroll
        for (int j = 0; j < 8; ++j) xr[64 * j] = v[j] * r * g[64 * j];
    }
}
__global__ void __launch_bounds__(256) k_final_norm(float* out, const float* gain) { final_norm_row<false>(out, nullptr, gain, blockIdx.x * 4 + (threadIdx.x >> 6), threadIdx.x & 63); }
__global__ void __launch_bounds__(256) k_final_norm_bf(float* out, const bf16_t* xb, const float* gain) { final_norm_row<true>(out, xb, gain, blockIdx.x * 4 + (threadIdx.x >> 6), threadIdx.x & 63); }

#define XB_TMO      128
#define XB_XCNT(j)  (256  + 64 * (j))
#define XB_XSUB(j)  (1280 + 64 * (j))
#define XB_XGEN(j)  (2304 + 64 * (j))
#define XB_TOP      3328
#define XB_TOPGEN   3392
#define XCD_BAR_WORDS 3456
#define XB_SPIN_CAP (1u << 22)
DI unsigned xb_ld(unsigned* p)              { return __hip_atomic_load(p, __ATOMIC_RELAXED, __HIP_MEMORY_SCOPE_AGENT); }
DI unsigned xb_add(unsigned* p, unsigned v) { return __hip_atomic_fetch_add(p, v, __ATOMIC_RELAXED, __HIP_MEMORY_SCOPE_AGENT); }
DI unsigned xb_xcc_id() { return (unsigned)__builtin_amdgcn_s_getreg((3 << 11) | 20) & 0xFu; }
#define XB_SPIN(cond, bar) do { unsigned _sp = 0; while (cond) { __builtin_amdgcn_s_sleep(1); \
    if ((++_sp & 255u) == 0u) { if (xb_ld(&(bar)[XB_TMO])) break; if (_sp > XB_SPIN_CAP) { atomicAdd(&(bar)[XB_TMO], 1u); break; } } } } while (0)
struct XcdBarrier { unsigned* bar; unsigned x; volatile LAS unsigned* st; };
DI XcdBarrier xcd_barrier_post(unsigned* bar, volatile LAS unsigned* st, int tid) {
    XcdBarrier b; b.bar = bar; b.x = xb_xcc_id(); b.st = st;
    if (tid == 0) (void)xb_add(&bar[XB_XCNT(b.x)], 1u);
    return b;
}
DI void xcd_barrier_complete(unsigned* bar, unsigned x, unsigned& nloc, unsigned& nx) {
    const unsigned G = gridDim.x * gridDim.y * gridDim.z;
    unsigned sum, cnt, mine, sp = 0u;
    for (;;) {
        sum = 0u; cnt = 0u; mine = 0u;
#pragma unroll
        for (unsigned j = 0; j < 16; ++j) { const unsigned c = xb_ld(&bar[XB_XCNT(j)]); sum += c; cnt += (c > 0u) ? 1u : 0u; mine = (j == x) ? c : mine; }
        if (sum == G) break;
        __builtin_amdgcn_s_sleep(1);
        if ((++sp & 255u) == 0u) { if (xb_ld(&bar[XB_TMO])) break; if (sp > XB_SPIN_CAP) { atomicAdd(&bar[XB_TMO], 1u); break; } }
    }
    nloc = mine > 0u ? mine : 1u; nx = cnt > 0u ? cnt : 1u;
}
DI void xcd_barrier(const XcdBarrier& b, int tid) {
    asm volatile("s_waitcnt vmcnt(0)" ::: "memory");
    __syncthreads();
    if (tid == 0) {
        unsigned* bar = b.bar;
        __builtin_amdgcn_s_waitcnt(0);
        unsigned nloc = b.st[0], nx = b.st[1];
        if (nloc == 0u) { xcd_barrier_complete(bar, b.x, nloc, nx); b.st[0] = nloc; b.st[1] = nx; }
        const unsigned old = xb_add(&bar[XB_XSUB(b.x)], 1u);
        const unsigned gen = old / nloc;
        if (old + 1u == (gen + 1u) * nloc) {
            __builtin_amdgcn_fence(__ATOMIC_RELEASE, "agent");
            asm volatile("s_waitcnt vmcnt(0)" ::: "memory");
            const unsigned og = xb_add(&bar[XB_TOP], 1u);
            const unsigned tg = og / nx;
            if (og + 1u == (tg + 1u) * nx) xb_add(&bar[XB_TOPGEN], 1u);
            else XB_SPIN(xb_ld(&bar[XB_TOPGEN]) == tg, bar);
            __builtin_amdgcn_fence(__ATOMIC_ACQUIRE, "agent");
            xb_add(&bar[XB_XGEN(b.x)], 1u);
            asm volatile("s_waitcnt vmcnt(0)" ::: "memory");
        } else {
            XB_SPIN(xb_ld(&bar[XB_XGEN(b.x)]) == gen, bar);
            __builtin_amdgcn_fence(__ATOMIC_ACQUIRE, "agent");
            asm volatile("s_waitcnt vmcnt(0)" ::: "memory");
        }
    }
    __syncthreads();
}

constexpr int MEGA_LDS_PHASE = 135168, MEGA_LDS = MEGA_LDS_PHASE + 64;
#ifndef P4_REP
#define P4_REP 1
#endif
#ifndef SYNC_PROBE
#define SYNC_PROBE 0
#endif
#ifndef SB_PROBE_VAR
#define SB_PROBE_VAR 0
#endif
#ifndef PROBE_MASK
#define PROBE_MASK 0
#endif
#define PREP(k) for (int rep_ = 0; rep_ < 1 + ((PROBE_MASK >> (k)) & 1); ++rep_)
__global__ void __launch_bounds__(512, 2) k_mega(Ctx c) {
    extern __shared__ __attribute__((aligned(16))) unsigned char lds_raw[];
    LAS unsigned char* lds = (LAS unsigned char*)lds_raw;
    unsigned char* ws = c.ws; const int G = gridDim.x, bx = blockIdx.x;
    const int wave_s = __builtin_amdgcn_readfirstlane((int)threadIdx.x >> 6);
    volatile LAS unsigned* bst = (volatile LAS unsigned*)(lds + MEGA_LDS_PHASE);
    if (threadIdx.x < 16) bst[threadIdx.x] = 0u;
    __syncthreads();
    const XcdBarrier xbar = xcd_barrier_post((unsigned*)(ws + WS_CTL), bst, (int)threadIdx.x);
#define GRID_BAR() xcd_barrier(xbar, phase_tid(wave_s))
    PREP(0) { prep_phase<8, 0>(c, (float*)lds_raw, phase_tid(wave_s)); __syncthreads(); }
    GRID_BAR();
    PREP(1) { pg8::Gemm g{(const bf16_t*)(ws + WS_H0), (const bf16_t*)(ws + WS_WT_IN_E), M, IN_EVEN_PAD, 2048}; pg8::StaticOrder S; S.init(g.M, g.N, G, bx);
      pg8::gemm_phase<pg8::FEpi1, pg8::StaticOrder, true, true>(lds, g, S, pg8::FEpi1{ws}, phase_tid(wave_s)); }
    { const int nlast = (M / 256) * (IN_EVEN_PAD / 256) % G; const int nfree = nlast ? G - nlast : G, me = nlast ? bx - nlast : bx;
      if (me >= 0) { const int tid = phase_tid(wave_s); prep_weights<1>(c, (float*)lds_raw + (tid >> 6) * 64 * 36, tid & 63, me * 8 + (tid >> 6), nfree * 8); } }
    GRID_BAR();
    PREP(2) { att::dil_phase(lds, ws, phase_tid(wave_s));
    __syncthreads(); }
    PREP(7) { pg8::Gemm g{(const bf16_t*)(ws + WS_CQ), (const bf16_t*)(ws + WS_WT_UQ), M, 1536, 512}; pg8::StaticOrder S; S.init(g.M, g.N, G, bx);
      pg8::gemm_phase<pg8::FEpi2a, pg8::StaticOrder, true, true>(lds, g, S, pg8::FEpi2a{ws}, phase_tid(wave_s)); }
    PREP(7) { pg8::Gemm g{(const bf16_t*)(ws + WS_CKV), (const bf16_t*)(ws + WS_WT_UKV), M, 2048, 512}; pg8::StaticOrder S; S.init(g.M, g.N, G, bx);
      pg8::gemm_phase<pg8::FEpi2b, pg8::StaticOrder, true, true>(lds, g, S, pg8::FEpi2b{ws}, phase_tid(wave_s)); }
    GRID_BAR();
    PREP(3) att::mla_phase(lds, ws, phase_tid(wave_s));
    PREP(8) { const int tid = phase_tid(wave_s); for (int it = bx * 512 + tid; it < M * 128; it += G * 512) dil_merge_item(ws, it >> 7, (it & 127) * 8); }
    GRID_BAR();
    PREP(4) { pg8::Gemm g{(const bf16_t*)(ws + WS_MIX), (const bf16_t*)(ws + WS_WT_OUT_E), M, 2048, 2048}; pg8::StaticOrder S; S.init(g.M, g.N, G, bx); S.rep = P4_REP;
      pg8::gemm_phase<pg8::FEpi4, pg8::StaticOrder, false, true>(lds, g, S, pg8::FEpi4{ws, c.x, c.out}, phase_tid(wave_s)); }
    GRID_BAR();
    PREP(5) { pg8::Gemm g{(const bf16_t*)(ws + WS_X1BF), (const bf16_t*)(ws + WS_WT_IN_O), M, IN_ODD, 2048}; pg8::StaticOrder S; S.init(g.M, g.N, G, bx);
      pg8::gemm_phase<pg8::FEpi5, pg8::StaticOrder, true, true>(lds, g, S, pg8::FEpi5{ws}, phase_tid(wave_s)); }
    GRID_BAR();
    PREP(6) att::sb_phase<0>(lds, ws, phase_tid(wave_s));
#if SB_PROBE_VAR
    att::sb_phase<SB_PROBE_VAR>(lds, ws, phase_tid(wave_s));
#endif
    GRID_BAR();
    { pg8::Gemm g{(const bf16_t*)(ws + WS_MIX2), (const bf16_t*)(ws + WS_WT_OUT_O), M, 2048, 2048}; pg8::StaticOrder S; S.init(g.M, g.N, G, bx);
      pg8::gemm_phase<pg8::FEpi7, pg8::StaticOrder, false, true>(lds, g, S, pg8::FEpi7{(bf16_t*)(ws + WS_X2BF), (const bf16_t*)(ws + WS_X1BF)}, phase_tid(wave_s)); }
    GRID_BAR();
#if SYNC_PROBE
    for (int i_ = 0; i_ < 8; ++i_) GRID_BAR();
#endif
    { const int tid = phase_tid(wave_s); for (int row = bx * 8 + (tid >> 6); row < M; row += G * 8) final_norm_row<true>(c.out, (const bf16_t*)(ws + WS_X2BF), c.final_gain, row, tid & 63); }
}

#ifndef MK_ONE_LAUNCH
#define MK_ONE_LAUNCH 1
#endif
#ifndef FAST_G1
#define FAST_G1 1
#endif
#ifndef FAST_G2
#define FAST_G2 1
#endif
#ifndef FAST_G4
#define FAST_G4 1
#endif
#ifndef FAST_G5
#define FAST_G5 1
#endif
#ifndef FAST_G7
#define FAST_G7 1
#endif
#ifndef FAST_MLA
#define FAST_MLA 1
#endif
#ifndef FAST_SB
#define FAST_SB 1
#endif
#ifndef FAST_DIL
#define FAST_DIL 1
#endif
static void launch_att(void (*k)(Ctx), int lds_bytes, const Ctx& c, hipStream_t s) {
    (void)hipFuncSetAttribute((const void*)k, hipFuncAttributeMaxDynamicSharedMemorySize, lds_bytes);
    hipLaunchKernelGGL(k, dim3(256), dim3(512), lds_bytes, s, c);
}
template <class Epi> static void launch_gemm_fast(const bf16_t* A, const bf16_t* Bt, int N, int K, Epi E, hipStream_t s) {
    static bool attr = false; if (!attr) { (void)hipFuncSetAttribute((const void*)k_gemm_fast<Epi>, hipFuncAttributeMaxDynamicSharedMemorySize, 131072); attr = true; }
    pg8::Gemm g{A, Bt, M, N, K};
    k_gemm_fast<Epi><<<256, 512, 131072, s>>>(g, E);
}

extern "C" void kernel_launch(void* const* d_in, const int* in_sizes, int n_in, void* d_out, int out_size, void* d_ws, size_t ws_size, hipStream_t stream) {
    if (n_in != 12 || out_size != M * D_MODEL || ws_size < WS_END) { fprintf(stderr, "kernel_launch: unexpected shapes (n_in %d out %d ws %zu)\n", n_in, out_size, ws_size); return; }
    Ctx c{};
    c.x = (const float*)d_in[0]; c.norm_gain = (const float*)d_in[1]; c.w_in_even = (const float*)d_in[2]; c.q_norm_gain = (const float*)d_in[3]; c.kv_norm_gain = (const float*)d_in[4];
    c.w_uq = (const float*)d_in[5]; c.w_ukv = (const float*)d_in[6]; c.w_out_even = (const float*)d_in[7]; c.rel_bias = (const float*)d_in[8]; c.w_in_odd = (const float*)d_in[9];
    c.w_out_odd = (const float*)d_in[10]; c.final_gain = (const float*)d_in[11]; c.out = (float*)d_out; c.ws = (unsigned char*)d_ws;
#if MK_ONE_LAUNCH
    static int grid_blocks = 0;
    if (!grid_blocks) {
        int dev = 0, cus = 0, per_cu = 0;
        (void)hipGetDevice(&dev); (void)hipDeviceGetAttribute(&cus, hipDeviceAttributeMultiprocessorCount, dev);
        (void)hipFuncSetAttribute((const void*)k_mega, hipFuncAttributeMaxDynamicSharedMemorySize, MEGA_LDS);
        (void)hipOccupancyMaxActiveBlocksPerMultiprocessor(&per_cu, (const void*)k_mega, 512, MEGA_LDS);
        if (per_cu < 1) { fprintf(stderr, "kernel_launch: occupancy query says %d blocks/CU\n", per_cu); per_cu = 1; }
        grid_blocks = cus;
    }
    (void)hipMemsetAsync((char*)d_ws + WS_CTL, 0, 65536, stream);
    { void* args[] = {&c};
      hipError_t e = hipLaunchCooperativeKernel((void*)k_mega, dim3(grid_blocks), dim3(512), args, MEGA_LDS, stream);
      if (e != hipSuccess) fprintf(stderr, "cooperative launch failed: %s (grid %d)\n", hipGetErrorString(e), grid_blocks); }
    return;
#endif
    unsigned char* ws = c.ws;
    const float* rc = (const float*)(ws + WS_ROPE); const float* rs = rc + 4096 * 32;
    k_prep<<<2048, 256, 0, stream>>>(c);
#if FAST_G1
    launch_gemm_fast((const bf16_t*)(ws + WS_H0), (const bf16_t*)(ws + WS_WT_IN_E), IN_EVEN_PAD, 2048, pg8::FEpi1{ws}, stream);
#else
    k_gemm_naive<Epi1><<<(M / 64) * (IN_EVEN_PAD / 64), 256, 0, stream>>>((const bf16_t*)(ws + WS_H0), (const bf16_t*)(ws + WS_WT_IN_E), IN_EVEN_PAD, 2048, Epi1{ws});
    k_rowss<false><<<M / 4, 256, 0, stream>>>(ws + WS_CQ, 512, 512, (float*)(ws + WS_SSC), 16, 8);
    k_rowss<false><<<M / 4, 256, 0, stream>>>(ws + WS_CKV, 512, 512, (float*)(ws + WS_SSC) + 8, 16, 8);
    k_rope<<<(M * 32 + 255) / 256, 256, 0, stream>>>((bf16_t*)(ws + WS_KR), 1, rc, rs);
#endif
#if FAST_DIL
    launch_att(k_dil_fast, att::DIL_LDS_BYTES, c, stream);
#else
    k_dil_naive<<<BATCH * 8 * SEQ / 4, 256, 0, stream>>>(c);
#endif
#if FAST_G2
    launch_gemm_fast((const bf16_t*)(ws + WS_CQ), (const bf16_t*)(ws + WS_WT_UQ), 1536, 512, pg8::FEpi2a{ws}, stream);
    launch_gemm_fast((const bf16_t*)(ws + WS_CKV), (const bf16_t*)(ws + WS_WT_UKV), 2048, 512, pg8::FEpi2b{ws}, stream);
#else
    k_gemm_naive<Epi2a><<<(M / 64) * (1536 / 64), 256, 0, stream>>>((const bf16_t*)(ws + WS_CQ), (const bf16_t*)(ws + WS_WT_UQ), 1536, 512, Epi2a{ws});
    k_rope<<<(M * 256 + 255) / 256, 256, 0, stream>>>((bf16_t*)(ws + WS_QR), 8, rc, rs);
    k_gemm_naive<Epi2b><<<(M / 64) * (2048 / 64), 256, 0, stream>>>((const bf16_t*)(ws + WS_CKV), (const bf16_t*)(ws + WS_WT_UKV), 2048, 512, Epi2b{ws});
#endif
#if FAST_MLA
    launch_att(k_mla_fast, att::M2_LDS_BYTES > att::MLA_LDS_BYTES ? att::M2_LDS_BYTES : att::MLA_LDS_BYTES, c, stream);
#else
    k_mla_naive<<<BATCH * 8 * SEQ / 4, 256, 0, stream>>>(c);
#endif
    k_dil_merge<<<M, 128, 0, stream>>>(c);
#if FAST_G4
    launch_gemm_fast((const bf16_t*)(ws + WS_MIX), (const bf16_t*)(ws + WS_WT_OUT_E), 2048, 2048, pg8::FEpi4{ws, c.x, c.out}, stream);
#else
    k_gemm_naive<Epi4><<<(M / 64) * (2048 / 64), 256, 0, stream>>>((const bf16_t*)(ws + WS_MIX), (const bf16_t*)(ws + WS_WT_OUT_E), 2048, 2048, Epi4{ws, c.x, c.out});
    k_rowss<true><<<M / 4, 256, 0, stream>>>(c.out, 2048, 2048, (float*)(ws + WS_SSX1), 32, 32);
#endif
#if FAST_G5
    launch_gemm_fast((const bf16_t*)(ws + WS_X1BF), (const bf16_t*)(ws + WS_WT_IN_O), IN_ODD, 2048, pg8::FEpi5{ws}, stream);
#else
    k_gemm_naive<Epi5><<<(M / 64) * (IN_ODD / 64), 256, 0, stream>>>((const bf16_t*)(ws + WS_X1BF), (const bf16_t*)(ws + WS_WT_IN_O), IN_ODD, 2048, Epi5{ws});
#endif
#if FAST_SB
    launch_att(k_sb_fast, att::SB_LDS_BYTES, c, stream);
#else
    k_sb_naive<<<BATCH * 16 * SEQ / 4, 256, 0, stream>>>(c);
#endif
#if FAST_G7
    launch_gemm_fast((const bf16_t*)(ws + WS_MIX2), (const bf16_t*)(ws + WS_WT_OUT_O), 2048, 2048, pg8::FEpi7{(bf16_t*)(ws + WS_X2BF), (const bf16_t*)(ws + WS_X1BF)}, stream);
#else
    k_gemm_naive<Epi7><<<(M / 64) * (2048 / 64), 256, 0, stream>>>((const bf16_t*)(ws + WS_MIX2), (const bf16_t*)(ws + WS_WT_OUT_O), 2048, 2048, Epi7{c.out});
#endif
#if FAST_G7
    k_final_norm_bf<<<M / 4, 256, 0, stream>>>(c.out, (const bf16_t*)(ws + WS_X2BF), c.final_gain);
#else
    k_final_norm<<<M / 4, 256, 0, stream>>>(c.out, c.final_gain);
#endif
}
```

```cpp
#include <hip/hip_runtime.h>
#include <cstdio>
#include <cstdint>
#include <cmath>

typedef unsigned short bf16_t;
typedef unsigned u32x4 __attribute__((ext_vector_type(4)));
typedef float f32x4 __attribute__((ext_vector_type(4)));

constexpr int D_MODEL = 2048, BATCH = 4, SEQ = 4096, M = BATCH * SEQ;
constexpr int NH_MLA = 8, NH_DIL = 8, NH_SB = 16, HD = 128;
constexpr int IN_EVEN = 6208, IN_EVEN_PAD = 6400, IN_ODD = 8192;
constexpr float EPS = 1e-6f;
constexpr float LOG2E = 1.4426950408889634f;
constexpr float MLA_QSCALE = 0.07216878364870322f * LOG2E;
constexpr float D128_QSCALE = 0.08838834764831845f * LOG2E;

constexpr size_t MiB = 1u << 20;
constexpr size_t WS_CTL = 0;
constexpr size_t WS_ROPE = 1 * MiB;
constexpr size_t WS_BIASN = 2 * MiB;
constexpr size_t WS_BIASC = 2 * MiB + 65536;
constexpr size_t WS_SSX = 3 * MiB;
constexpr size_t WS_SSC = 4 * MiB;
constexpr size_t WS_SSX1 = 5 * MiB;
constexpr size_t WS_LSE = 9 * MiB;
constexpr size_t WS_WT_IN_E = 12 * MiB;
constexpr size_t WS_WT_UQ = 37 * MiB;
constexpr size_t WS_WT_UKV = 39 * MiB;
constexpr size_t WS_WT_OUT_E = 41 * MiB;
constexpr size_t WS_WT_IN_O = 49 * MiB;
constexpr size_t WS_WT_OUT_O = 81 * MiB;
constexpr size_t WS_A = 90 * MiB;
constexpr size_t WS_B = 154 * MiB;
constexpr size_t WS_C = 218 * MiB;
constexpr size_t WS_H0 = WS_A, WS_OP0 = WS_A, WS_OP1 = WS_A + 32 * MiB, WS_X1BF = WS_A;
constexpr size_t WS_CQ = WS_B, WS_CKV = WS_B + 16 * MiB, WS_QB = WS_B + 32 * MiB, WS_MIX = WS_B, WS_MIX2 = WS_B;
constexpr size_t WS_KB = WS_C, WS_VB = WS_C + 32 * MiB, WS_SG = WS_C + 64 * MiB, WS_QN = WS_C + 128 * MiB, WS_QR = WS_C + 160 * MiB,
                 WS_KN = WS_C + 176 * MiB, WS_VA = WS_C + 208 * MiB, WS_KR = WS_C + 240 * MiB, WS_OP2 = WS_C + 242 * MiB;
constexpr size_t WS_X2BF = WS_C;
constexpr size_t WS_Q2 = WS_C, WS_K2 = WS_C + 64 * MiB, WS_V2 = WS_C + 128 * MiB, WS_SG2 = WS_C + 192 * MiB;
constexpr size_t WS_END = WS_C + 274 * MiB;

struct Ctx {
    const float *x, *norm_gain, *w_in_even, *q_norm_gain, *kv_norm_gain, *w_uq, *w_ukv, *w_out_even, *rel_bias, *w_in_odd, *w_out_odd, *final_gain;
    float* out; unsigned char* ws;
};

#define DI __device__ __forceinline__
DI int phase_tid(int wave_s) { int lane; asm volatile("v_mbcnt_lo_u32_b32 %0, -1, 0\n\tv_mbcnt_hi_u32_b32 %0, -1, %0" : "=v"(lane)); return wave_s * 64 + lane; }
DI float bf2f(bf16_t v) { return __uint_as_float(((unsigned)v) << 16); }
DI bf16_t f2bf(float f) { unsigned u = __float_as_uint(f); return (bf16_t)((u + 0x7fffu + ((u >> 16) & 1u)) >> 16); }
DI float wave_sum(float v) {
#pragma unroll
    for (int o = 1; o < 64; o <<= 1) v += __shfl_xor(v, o);
    return v;
}
DI float wave_max(float v) {
#pragma unroll
    for (int o = 1; o < 64; o <<= 1) v = fmaxf(v, __shfl_xor(v, o));
    return v;
}
DI float silu_f(float v) { return v / (1.0f + __expf(-v)); }

DI int map_in_even(int n) { if (n < 1024) return n; if (n < 1056) return 1024 + (n - 1024); if (n < 1088) return 1152 + (n - 1056); return n - 1088 + 1280; }
DI int map_uq(int n) { const int h = n / 192, j = n % 192; if (j < 128) return h * 128 + j; if (j < 160) return 1024 + (h >> 2) * 256 + (h & 3) * 32 + (j - 128);
    return 1024 + (h >> 2) * 256 + 128 + (h & 3) * 32 + (j - 160); }
DI int map_ukv(int n) { const int h = n / 256, j = n % 256; if (j < 128) return h * 128 + j; return 1024 + h * 128 + (j - 128); }
DI int map_id(int n) { return n; }

template <int MAPID>
DI void transpose_item(const float* W, int K, int N, const float* gain, bf16_t* WT, float* scr  , int item, int lane) {
    const int nblk = N / 32, kb = item / nblk, nb = item % nblk, k0 = 64 * kb, n0 = 32 * nb;
    f32x4 v[8];
#pragma unroll
    for (int i = 0; i < 8; ++i) { const int kk = 8 * i + (lane >> 3); v[i] = *(const f32x4*)(W + (size_t)(k0 + kk) * N + n0 + 4 * (lane & 7)); }
#pragma unroll
    for (int i = 0; i < 8; ++i) { const int kk = 8 * i + (lane >> 3); const float g = gain ? gain[k0 + kk] : 1.0f; *(f32x4*)(scr + kk * 36 + 4 * (lane & 7)) = v[i] * g; }
    asm volatile("s_waitcnt lgkmcnt(0)" ::: "memory");
    const int d0 = MAPID == 0 ? map_in_even(n0) : MAPID == 1 ? map_uq(n0) : MAPID == 2 ? map_ukv(n0) : map_id(n0);
    const int c = lane & 7;
#pragma unroll
    for (int j = 0; j < 4; ++j) { const int n = (lane >> 3) + 8 * j; const float* s = scr + (8 * c) * 36 + n;
        u32x4 o; o.x = f2bf(s[0]) | ((unsigned)f2bf(s[36]) << 16); o.y = f2bf(s[72]) | ((unsigned)f2bf(s[108]) << 16);
        o.z = f2bf(s[144]) | ((unsigned)f2bf(s[180]) << 16); o.w = f2bf(s[216]) | ((unsigned)f2bf(s[252]) << 16);
        *(u32x4*)(WT + (size_t)(d0 + n) * K + k0 + 8 * c) = o; }
    asm volatile("s_waitcnt lgkmcnt(0)" ::: "memory");
}

DI int t5_bucket(int dist) {
    if (dist < 16) return dist;
    float d = (float)dist;
    int large = 16 + (int)(logf(d / 16.0f) / 4.852030263919617f * 16.0f);
    return large < 31 ? large : 31;
}

template <int PART> DI void prep_weights(const Ctx& c, float* scr, int lane, int gw, int NGW) {
    unsigned char* ws = c.ws;
    constexpr int I0 = (2048 / 64) * (IN_EVEN / 32), I1 = (512 / 64) * (1536 / 32), I2 = (512 / 64) * (2048 / 32), I3 = (2048 / 64) * (2048 / 32),
                  I4 = (2048 / 64) * (IN_ODD / 32), I5 = I3;
    constexpr int LO = PART == 1 ? I0 : 0, HI = PART == 0 ? I0 : I0 + I1 + I2 + I3 + I4 + I5;
    for (int it = LO + gw; it < HI; it += NGW) {
        int r = it;
        if (r < I0) { transpose_item<0>(c.w_in_even, 2048, IN_EVEN, c.norm_gain, (bf16_t*)(ws + WS_WT_IN_E), scr, r, lane); continue; } r -= I0;
        if (r < I1) { transpose_item<1>(c.w_uq, 512, 1536, c.q_norm_gain, (bf16_t*)(ws + WS_WT_UQ), scr, r, lane); continue; } r -= I1;
        if (r < I2) { transpose_item<2>(c.w_ukv, 512, 2048, c.kv_norm_gain, (bf16_t*)(ws + WS_WT_UKV), scr, r, lane); continue; } r -= I2;
        if (r < I3) { transpose_item<3>(c.w_out_even, 2048, 2048, nullptr, (bf16_t*)(ws + WS_WT_OUT_E), scr, r, lane); continue; } r -= I3;
        if (r < I4) { transpose_item<3>(c.w_in_odd, 2048, IN_ODD, c.norm_gain + 2048, (bf16_t*)(ws + WS_WT_IN_O), scr, r, lane); continue; } r -= I4;
        transpose_item<3>(c.w_out_odd, 2048, 2048, nullptr, (bf16_t*)(ws + WS_WT_OUT_O), scr, r, lane);
    }
}
template <int NW, int PART> DI void prep_phase(const Ctx& c, float* scr_all, const int tid) {
    const int lane = tid & 63, wave = tid >> 6;
    float* scr = scr_all + wave * 64 * 36;
    const int gw = blockIdx.x * NW + wave, NGW = gridDim.x * NW;
    unsigned char* ws = c.ws;
    prep_weights<PART>(c, scr, lane, gw, NGW);
    const int gt = blockIdx.x * (NW * 64) + tid, NGT = gridDim.x * (NW * 64);
    { bf16_t* wt = (bf16_t*)(ws + WS_WT_IN_E);
      for (int i = gt; i < 192 * 256; i += NGT) { const int rr = i / 256, cc = i % 256; const int row = rr < 96 ? 1056 + rr : 1184 + (rr - 96);
          *(u32x4*)(wt + (size_t)row * 2048 + cc * 8) = (u32x4){0u, 0u, 0u, 0u}; } }
    { float* rc = (float*)(ws + WS_ROPE); float* rs = rc + 4096 * 32;
      for (int i = gt; i < 4096 * 32; i += NGT) { const int pos = i >> 5, j = i & 31; const float inv = 1.0f / powf(10000.0f, (float)j / 32.0f); const float ang = (float)pos * inv;
          rc[i] = cosf(ang); rs[i] = sinf(ang); } }
    { float* bn = (float*)(ws + WS_BIASN);
      for (int i = gt; i < 3 * 8 * 132; i += NGT) { const int p = i / (8 * 132), h = (i / 132) % 8, rel = i % 132; const int dil = p == 0 ? 1 : p == 1 ? 4 : 16;
          bn[i] = rel <= 128 ? c.rel_bias[t5_bucket(rel * dil) * 8 + h] * LOG2E : 0.f; } }
    { float* bc = (float*)(ws + WS_BIASC);
      for (int i = gt; i < 3 * 8 * 5 * 1024; i += NGT) { const int g = i & 15, ln = (i >> 4) & 63, di = (i >> 10) % 5, ph = i / 5120, h = ph & 7, p = ph >> 3; const int dil = p == 0 ? 1 : p == 1 ? 4 : 16;
          const int rel = 32 * di + (ln & 31) - ((g & 3) + 8 * (g >> 2) + 4 * (ln >> 5));
          bc[i] = (rel >= 0 && rel <= 128) ? c.rel_bias[t5_bucket(rel * dil) * 8 + h] * LOG2E : -INFINITY; } }
    { bf16_t* h0 = (bf16_t*)(ws + WS_H0); float* ssx = (float*)(ws + WS_SSX);
      for (int m = gw; m < M; m += NGW) { const f32x4* xr = (const f32x4*)(c.x + (size_t)m * D_MODEL) + 2 * lane; float s = 0.f;
          u32x4* o16 = (u32x4*)(h0 + (size_t)m * D_MODEL) + lane;
#pragma unroll
          for (int j = 0; j < 4; ++j) { const f32x4 v = xr[128 * j], w = xr[128 * j + 1];
              s += (v.x * v.x + v.y * v.y + v.z * v.z + v.w * v.w) + (w.x * w.x + w.y * w.y + w.z * w.z + w.w * w.w);
              o16[64 * j] = (u32x4){f2bf(v.x) | ((unsigned)f2bf(v.y) << 16), f2bf(v.z) | ((unsigned)f2bf(v.w) << 16), f2bf(w.x) | ((unsigned)f2bf(w.y) << 16), f2bf(w.z) | ((unsigned)f2bf(w.w) << 16)}; }
          s = wave_sum(s); if (lane == 0) ssx[m] = s; } }
}

__global__ void __launch_bounds__(256) k_prep(Ctx c) { __shared__ float scr_all[4 * 64 * 36]; prep_phase<4, 2>(c, scr_all, (int)threadIdx.x); }

DI float rscale(const float* part, int n, float inv_cols) { float s = 0.f; for (int i = 0; i < n; ++i) s += part[i]; return rsqrtf(s * inv_cols + EPS); }

struct Epi1 {
    unsigned char* ws;
    DI void operator()(int row, int col, float acc) const {
        const float v = acc * rsqrtf(((const float*)(ws + WS_SSX))[row] * (1.0f / 2048.0f) + EPS);
        if (col < 512) ((bf16_t*)(ws + WS_CQ))[(size_t)row * 512 + col] = f2bf(v);
        else if (col < 1024) ((bf16_t*)(ws + WS_CKV))[(size_t)row * 512 + col - 512] = f2bf(v);
        else if (col < 1280) { const int t = col - 1024; if (t < 32) ((bf16_t*)(ws + WS_KR))[(size_t)row * 64 + t] = f2bf(v); else if (t >= 128 && t < 160) ((bf16_t*)(ws + WS_KR))[(size_t)row * 64 + 32 + t - 128] = f2bf(v); }
        else if (col < 2304) ((bf16_t*)(ws + WS_QB))[(size_t)row * 1024 + col - 1280] = f2bf(v * D128_QSCALE);
        else if (col < 3328) ((bf16_t*)(ws + WS_KB))[(size_t)row * 1024 + col - 2304] = f2bf(v);
        else if (col < 4352) ((bf16_t*)(ws + WS_VB))[(size_t)row * 1024 + col - 3328] = f2bf(v);
        else ((bf16_t*)(ws + WS_SG))[(size_t)row * 2048 + col - 4352] = f2bf(silu_f(v));
    }
};
struct Epi2a {
    unsigned char* ws;
    DI void operator()(int row, int col, float acc) const {
        const float v = acc * rscale((const float*)(ws + WS_SSC) + (size_t)row * 16, 8, 1.0f / 512.0f) * MLA_QSCALE;
        if (col < 1024) ((bf16_t*)(ws + WS_QN))[(size_t)row * 1024 + col] = f2bf(v);
        else { const int t = col - 1024, grp = t >> 8, u = t & 255, half = u >> 7, hh = (u & 127) >> 5, i = u & 31;
            ((bf16_t*)(ws + WS_QR))[(size_t)row * 512 + (4 * grp + hh) * 64 + half * 32 + i] = f2bf(v); }
    }
};
struct Epi2b {
    unsigned char* ws;
    DI void operator()(int row, int col, float acc) const {
        const float v = acc * rscale((const float*)(ws + WS_SSC) + (size_t)row * 16 + 8, 8, 1.0f / 512.0f);
        if (col < 1024) ((bf16_t*)(ws + WS_KN))[(size_t)row * 1024 + col] = f2bf(v); else ((bf16_t*)(ws + WS_VA))[(size_t)row * 1024 + col - 1024] = f2bf(v);
    }
};
struct Epi4 {
    unsigned char* ws; const float* x; float* out;
    DI void operator()(int row, int col, float acc) const {
        const float v = x[(size_t)row * 2048 + col] + acc; out[(size_t)row * 2048 + col] = v; ((bf16_t*)(ws + WS_X1BF))[(size_t)row * 2048 + col] = f2bf(v);
    }
};
struct Epi5 {
    unsigned char* ws;
    DI void operator()(int row, int col, float acc) const {
        const float v = acc * rscale((const float*)(ws + WS_SSX1) + (size_t)row * 32, 32, 1.0f / 2048.0f);
        if (col < 2048) ((bf16_t*)(ws + WS_Q2))[(size_t)row * 2048 + col] = f2bf(v * D128_QSCALE);
        else if (col < 4096) ((bf16_t*)(ws + WS_K2))[(size_t)row * 2048 + col - 2048] = f2bf(v);
        else if (col < 6144) ((bf16_t*)(ws + WS_V2))[(size_t)row * 2048 + col - 4096] = f2bf(v);
        else ((bf16_t*)(ws + WS_SG2))[(size_t)row * 2048 + col - 6144] = f2bf(silu_f(v));
    }
};
struct Epi7 {
    float* out;
    DI void operator()(int row, int col, float acc) const { out[(size_t)row * 2048 + col] += acc; }
};

namespace pg8 {
#define PG8_LAS __attribute__((address_space(3)))
typedef short bf16x8 __attribute__((ext_vector_type(8)));
constexpr int BM = 256, BK = 64, HALF = 128, HTB = HALF * BK * 2  , STAGE_BYTES = 8 * HTB, NXCD = 8, WGM = 8;

__host__ __device__ __forceinline__ int lds_byte(int r, int c) { const int st = (r >> 4) * 2 + (c >> 5), rr = r & 15, cc = c & 31, ob = rr * 64 + cc * 2; return st * 1024 + (ob ^ (((ob >> 9) & 1) << 5)); }
__host__ __device__ __forceinline__ void stage_rc(int b, int& R, int& C) { const int st = b / 1024, sb = b % 1024, swz = sb ^ (((sb >> 9) & 1) << 5); R = (st >> 1) * 16 + swz / 64; C = (st & 1) * 32 + (swz % 64) / 2; }
__host__ __device__ __forceinline__ int perm32(int rho) { const int n = rho >> 4, i = rho & 15; return 8 * (i >> 2) + 4 * n + (i & 3); }

struct Unit { int pm, pn; };
struct Gemm { const bf16_t* A; const bf16_t* Bt; int M, N, K; };

struct StaticOrder {
    int nM, nN, nwg, G, c, rep = 1;
    __host__ __device__ void init(int M, int N, int G_, int c_) { nM = M / BM; nN = N / BM; nwg = nM * nN; G = G_; c = c_; }
    __host__ __device__ bool next(int i, Unit& u) const {
        long L = (long)i * G + c; if (L >= (long)nwg * rep) return false; L %= nwg;
        int wgid = (int)L; { const int q = nwg / NXCD, r = nwg % NXCD, xcd = wgid % NXCD, off = wgid / NXCD; wgid = (xcd < r ? xcd * (q + 1) : r * (q + 1) + (xcd - r) * q) + off; }
        const int nig = WGM * nN, gid = wgid / nig, fm = gid * WGM, gsz = (nM - fm) < WGM ? (nM - fm) : WGM;
        u.pm = fm + ((wgid % nig) % gsz); u.pn = (wgid % nig) / gsz; return true;
    }
    __device__ __forceinline__ void a_ready(const Unit&) const {}
    __device__ __forceinline__ void done(const Unit&) const {}
};


typedef float f32x2_t __attribute__((ext_vector_type(2))); typedef __bf16 bf16x2_t __attribute__((ext_vector_type(2)));
__device__ __forceinline__ unsigned cvtpk(float lo, float hi) { f32x2_t v = {lo, hi}; bf16x2_t b = __builtin_convertvector(v, bf16x2_t); return __builtin_bit_cast(unsigned, b); }
__device__ __forceinline__ u32x4 pack8(const f32x4& a, const f32x4& b) { u32x4 w; w.x = cvtpk(a[0], a[1]); w.y = cvtpk(a[2], a[3]); w.z = cvtpk(b[0], b[1]); w.w = cvtpk(b[2], b[3]); return w; }
__device__ __forceinline__ float sumsq4(const f32x4& a) { return (a[0] * a[0] + a[1] * a[1]) + (a[2] * a[2] + a[3] * a[3]); }
__device__ __forceinline__ float silu1(float v) { return v * __builtin_amdgcn_rcpf(1.0f + __builtin_amdgcn_exp2f(-v * LOG2E)); }
__device__ __forceinline__ f32x4 silu4(const f32x4& a) { return (f32x4){silu1(a[0]), silu1(a[1]), silu1(a[2]), silu1(a[3])}; }
__device__ __forceinline__ float quad_sum(float s) { s += __shfl_xor(s, 16); s += __shfl_xor(s, 32); return s; }
__device__ __forceinline__ void rope8(const f32x4& a0, const f32x4& a1, const f32x4& b0, const f32x4& b1, const float* rc, const float* rs, int pos, int i0, u32x4& o1, u32x4& o2) {
    const f32x4 c0 = *(const f32x4*)(rc + pos * 32 + i0), c1 = *(const f32x4*)(rc + pos * 32 + i0 + 4), s0 = *(const f32x4*)(rs + pos * 32 + i0), s1 = *(const f32x4*)(rs + pos * 32 + i0 + 4);
    o1 = pack8(a0 * c0 - b0 * s0, a1 * c1 - b1 * s1); o2 = pack8(a0 * s0 + b0 * c0, a1 * s1 + b1 * c1);
}
#define PG8_EPI_ROWS(...) _Pragma("unroll") for (int ai = 0; ai < 2; ++ai) _Pragma("unroll") for (int m = 0; m < 4; ++m) { const int row = u.pm * BM + ai * HALF + wr * 64 + m * 16 + fr; __VA_ARGS__ }

struct FEpi1 {
    static constexpr bool PERM = true, AFTER_DRAIN = false; unsigned char* ws;
    __device__ __forceinline__ void operator()(const f32x4 (&acc)[2][2][4][2], const Unit& u, int wr, int wc, int fr, int fq) const {
        const int pn = u.pn, cw = wc * 32 + 8 * fq; const float* ssx = (const float*)(ws + WS_SSX);
        PG8_EPI_ROWS(
            const float rs = rsqrtf(ssx[row] * (1.0f / 2048.0f) + EPS);
            if (pn < 4) { bf16_t* dst = (bf16_t*)(ws + (pn < 2 ? WS_CQ : WS_CKV)) + (size_t)row * 512 + (pn & 1) * 256 + cw; float ss = 0.f;
                _Pragma("unroll") for (int bj = 0; bj < 2; ++bj) { const f32x4 v0 = acc[ai][bj][m][0] * rs, v1 = acc[ai][bj][m][1] * rs; ss += sumsq4(v0) + sumsq4(v1); *(u32x4*)(dst + bj * HALF) = pack8(v0, v1); }
                ss = quad_sum(ss); if (fq == 0) ((float*)(ws + WS_SSC))[(size_t)row * 16 + pn * 4 + wc] = ss; }
            else if (pn == 4) { if (wc == 0) { const float* rc = (const float*)(ws + WS_ROPE); u32x4 o1, o2;
                rope8(acc[ai][0][m][0] * rs, acc[ai][0][m][1] * rs, acc[ai][1][m][0] * rs, acc[ai][1][m][1] * rs, rc, rc + 4096 * 32, row % SEQ, 8 * fq, o1, o2);
                bf16_t* dst = (bf16_t*)(ws + WS_KR) + (size_t)row * 64 + 8 * fq; *(u32x4*)dst = o1; *(u32x4*)(dst + 32) = o2; } }
            else if (pn < 17) { const int t = pn - 5; bf16_t* dst = (bf16_t*)(ws + (t < 4 ? WS_QB : t < 8 ? WS_KB : WS_VB)) + (size_t)row * 1024 + (t & 3) * 256 + cw; const float sc = t < 4 ? rs * D128_QSCALE : rs;
                _Pragma("unroll") for (int bj = 0; bj < 2; ++bj) *(u32x4*)(dst + bj * HALF) = pack8(acc[ai][bj][m][0] * sc, acc[ai][bj][m][1] * sc); }
            else { bf16_t* dst = (bf16_t*)(ws + WS_SG) + (size_t)row * 2048 + (pn - 17) * 256 + cw;
                _Pragma("unroll") for (int bj = 0; bj < 2; ++bj) *(u32x4*)(dst + bj * HALF) = pack8(silu4(acc[ai][bj][m][0] * rs), silu4(acc[ai][bj][m][1] * rs)); }
        )
    }
};
struct FEpi2a {
    static constexpr bool PERM = true, AFTER_DRAIN = false; unsigned char* ws;
    __device__ __forceinline__ void operator()(const f32x4 (&acc)[2][2][4][2], const Unit& u, int wr, int wc, int fr, int fq) const {
        const int pn = u.pn, cw = wc * 32 + 8 * fq;
        PG8_EPI_ROWS(
            const f32x4* sp = (const f32x4*)((const float*)(ws + WS_SSC) + (size_t)row * 16); const f32x4 p0 = sp[0], p1 = sp[1];
            const float rs = rsqrtf(((p0[0] + p0[1]) + (p0[2] + p0[3]) + (p1[0] + p1[1]) + (p1[2] + p1[3])) * (1.0f / 512.0f) + EPS) * MLA_QSCALE;
            if (pn < 4) { bf16_t* dst = (bf16_t*)(ws + WS_QN) + (size_t)row * 1024 + pn * 256 + cw;
                _Pragma("unroll") for (int bj = 0; bj < 2; ++bj) *(u32x4*)(dst + bj * HALF) = pack8(acc[ai][bj][m][0] * rs, acc[ai][bj][m][1] * rs); }
            else { const float* rc = (const float*)(ws + WS_ROPE); u32x4 o1, o2; const int head = 4 * (pn - 4) + wc;
                rope8(acc[ai][0][m][0] * rs, acc[ai][0][m][1] * rs, acc[ai][1][m][0] * rs, acc[ai][1][m][1] * rs, rc, rc + 4096 * 32, row % SEQ, 8 * fq, o1, o2);
                bf16_t* dst = (bf16_t*)(ws + WS_QR) + (size_t)row * 512 + head * 64 + 8 * fq; *(u32x4*)dst = o1; *(u32x4*)(dst + 32) = o2; }
        )
    }
};
struct FEpi2b {
    static constexpr bool PERM = true, AFTER_DRAIN = false; unsigned char* ws;
    __device__ __forceinline__ void operator()(const f32x4 (&acc)[2][2][4][2], const Unit& u, int wr, int wc, int fr, int fq) const {
        const int pn = u.pn, cw = wc * 32 + 8 * fq;
        PG8_EPI_ROWS(
            const f32x4* sp = (const f32x4*)((const float*)(ws + WS_SSC) + (size_t)row * 16 + 8); const f32x4 p0 = sp[0], p1 = sp[1];
            const float rs = rsqrtf(((p0[0] + p0[1]) + (p0[2] + p0[3]) + (p1[0] + p1[1]) + (p1[2] + p1[3])) * (1.0f / 512.0f) + EPS);
            bf16_t* dst = (bf16_t*)(ws + (pn < 4 ? WS_KN : WS_VA)) + (size_t)row * 1024 + (pn & 3) * 256 + cw;
            _Pragma("unroll") for (int bj = 0; bj < 2; ++bj) *(u32x4*)(dst + bj * HALF) = pack8(acc[ai][bj][m][0] * rs, acc[ai][bj][m][1] * rs);
        )
    }
};
struct FEpi4 {
    static constexpr bool PERM = true, AFTER_DRAIN = false; unsigned char* ws; const float* x; float* out;
    __device__ __forceinline__ void operator()(const f32x4 (&acc)[2][2][4][2], const Unit& u, int wr, int wc, int fr, int fq) const {
        const int pn = u.pn, cw = pn * 256 + wc * 32 + 8 * fq;
        const size_t off0 = (size_t)(u.pm * BM + wr * 64 + fr) * 2048 + cw;
        f32x4 pre[2][4];
#define EPI4_LOAD(q, slot) { const float* p_ = x + off0 + (size_t)(((q) >> 2) * HALF + ((q) & 3) * 16) * 2048; pre[slot][0] = *(const f32x4*)p_; pre[slot][1] = *(const f32x4*)(p_ + 4); pre[slot][2] = *(const f32x4*)(p_ + HALF); pre[slot][3] = *(const f32x4*)(p_ + HALF + 4); }
        EPI4_LOAD(0, 0) EPI4_LOAD(1, 1)
#pragma unroll
        for (int q = 0; q < 8; ++q) { const int ai = q >> 2, m = q & 3; const size_t off = off0 + (size_t)(ai * HALF + m * 16) * 2048;
            const f32x4 v00 = pre[q & 1][0] + acc[ai][0][m][0], v01 = pre[q & 1][1] + acc[ai][0][m][1], v10 = pre[q & 1][2] + acc[ai][1][m][0], v11 = pre[q & 1][3] + acc[ai][1][m][1];
            if (q + 2 < 8) EPI4_LOAD(q + 2, q & 1)
            *(u32x4*)((bf16_t*)(ws + WS_X1BF) + off) = pack8(v00, v01); *(u32x4*)((bf16_t*)(ws + WS_X1BF) + off + HALF) = pack8(v10, v11);
            float ss = (sumsq4(v00) + sumsq4(v01)) + (sumsq4(v10) + sumsq4(v11));
            ss = quad_sum(ss); if (fq == 0) ((float*)(ws + WS_SSX1))[(size_t)(u.pm * BM + ai * HALF + wr * 64 + m * 16 + fr) * 32 + pn * 4 + wc] = ss; }
#undef EPI4_LOAD
    }
};
struct FEpi5 {
    static constexpr bool PERM = true, AFTER_DRAIN = false; unsigned char* ws;
    __device__ __forceinline__ void operator()(const f32x4 (&acc)[2][2][4][2], const Unit& u, int wr, int wc, int fr, int fq) const {
        const int pn = u.pn, cw = (pn & 7) * 256 + wc * 32 + 8 * fq; const int sel = pn >> 3;
        PG8_EPI_ROWS(
            const f32x4* sp = (const f32x4*)((const float*)(ws + WS_SSX1) + (size_t)row * 32 + 8 * fq); const f32x4 p0 = sp[0], p1 = sp[1];
            const float tot = quad_sum((p0[0] + p0[1]) + (p0[2] + p0[3]) + (p1[0] + p1[1]) + (p1[2] + p1[3]));
            const float rs = rsqrtf(tot * (1.0f / 2048.0f) + EPS);
            bf16_t* dst = (bf16_t*)(ws + (sel == 0 ? WS_Q2 : sel == 1 ? WS_K2 : sel == 2 ? WS_V2 : WS_SG2)) + (size_t)row * 2048 + cw;
            if (sel == 3) { _Pragma("unroll") for (int bj = 0; bj < 2; ++bj) *(u32x4*)(dst + bj * HALF) = pack8(silu4(acc[ai][bj][m][0] * rs), silu4(acc[ai][bj][m][1] * rs)); }
            else { const float sc = sel == 0 ? rs * D128_QSCALE : rs;
                _Pragma("unroll") for (int bj = 0; bj < 2; ++bj) *(u32x4*)(dst + bj * HALF) = pack8(acc[ai][bj][m][0] * sc, acc[ai][bj][m][1] * sc); }
        )
    }
};
struct FEpi7 {
    static constexpr bool PERM = true, AFTER_DRAIN = false; bf16_t* x2; const bf16_t* x1;
    __device__ __forceinline__ void operator()(const f32x4 (&acc)[2][2][4][2], const Unit& u, int wr, int wc, int fr, int fq) const {
        const int cw = u.pn * 256 + wc * 32 + 8 * fq;
        const size_t off0 = (size_t)(u.pm * BM + wr * 64 + fr) * 2048 + cw;
        u32x4 pre[2][2];
#define EPI7_LOAD(q, slot) { const bf16_t* p_ = x1 + off0 + (size_t)(((q) >> 2) * HALF + ((q) & 3) * 16) * 2048; pre[slot][0] = *(const u32x4*)p_; pre[slot][1] = *(const u32x4*)(p_ + HALF); }
        EPI7_LOAD(0, 0) EPI7_LOAD(1, 1)
#pragma unroll
        for (int q = 0; q < 8; ++q) { const int ai = q >> 2, m = q & 3; const size_t off = off0 + (size_t)(ai * HALF + m * 16) * 2048;
            const u32x4 r0 = pre[q & 1][0], r1 = pre[q & 1][1];
            if (q + 2 < 8) EPI7_LOAD(q + 2, q & 1)
#define BFLO(w) __uint_as_float((w) << 16)
#define BFHI(w) __uint_as_float((w) & 0xffff0000u)
            *(u32x4*)(x2 + off) = pack8((f32x4){BFLO(r0[0]), BFHI(r0[0]), BFLO(r0[1]), BFHI(r0[1])} + acc[ai][0][m][0], (f32x4){BFLO(r0[2]), BFHI(r0[2]), BFLO(r0[3]), BFHI(r0[3])} + acc[ai][0][m][1]);
            *(u32x4*)(x2 + off + HALF) = pack8((f32x4){BFLO(r1[0]), BFHI(r1[0]), BFLO(r1[1]), BFHI(r1[1])} + acc[ai][1][m][0], (f32x4){BFLO(r1[2]), BFHI(r1[2]), BFLO(r1[3]), BFHI(r1[3])} + acc[ai][1][m][1]); }
#undef BFLO
#undef BFHI
#undef EPI7_LOAD
    }
};
template <class Epi, class Sched, bool ALIGN_EPI = false, bool SP2 = false>
__device__ __forceinline__ void gemm_phase(PG8_LAS unsigned char* lds, const Gemm g, const Sched& S, const Epi& E, const int tid) {
    const int wid = __builtin_amdgcn_readfirstlane(tid >> 6), lane = tid & 63, wr = wid >> 2, wc = wid & 3, fr = lane & 15, fq = lane >> 4;
    const int K = g.K, nt = K / BK;
    unsigned voffA[2], voffB[2];
#pragma unroll
    for (int i = 0; i < 2; ++i) { int R, C; stage_rc(tid * 16 + i * 8192, R, C); const int Rb = Epi::PERM ? ((R & ~31) + perm32(R & 31)) : R;
        voffA[i] = (unsigned)(R * K + C) * 2u; voffB[i] = (unsigned)(Rb * K + C) * 2u; }
    const size_t kstep = (size_t)(BK * 2);
    const size_t hstep = (size_t)HALF * K * 2;
    const size_t tstep = 2 * hstep;
    const unsigned ldsw = (unsigned)wid * 1024u;
    const int aoff = lds_byte(wr * 64 + fr, fq * 8), boff = lds_byte(wc * 32 + fr, fq * 8);
#define PG8_SA(b, h) (((b) * 2 + (h)) * HTB)
#define PG8_SB(b, h) ((4 + (b) * 2 + (h)) * HTB)
#define PG8_STAGE(bufoff, gbase, voff) do { _Pragma("unroll") for (int _i = 0; _i < 2; ++_i) \
        __builtin_amdgcn_global_load_lds((const unsigned*)((const char*)(gbase) + (voff)[_i]), (PG8_LAS unsigned*)(lds + (bufoff) + ldsw + _i * 8192), 16, 0, 0); } while (0)
#define PG8_LDA(dst, b, h) do { _Pragma("unroll") for (int m = 0; m < 4; ++m) _Pragma("unroll") for (int k = 0; k < 2; ++k) dst[m][k] = *(const PG8_LAS bf16x8*)(lds + PG8_SA(b, h) + aoff + m * 2048 + k * 1024); } while (0)
#define PG8_LDB(dst, b, h) do { _Pragma("unroll") for (int n = 0; n < 2; ++n) _Pragma("unroll") for (int k = 0; k < 2; ++k) dst[n][k] = *(const PG8_LAS bf16x8*)(lds + PG8_SB(b, h) + boff + n * 2048 + k * 1024); } while (0)
#define PG8_MMA(ai, bj, At, Bt) do { __builtin_amdgcn_s_setprio(1); _Pragma("unroll") for (int m = 0; m < 4; ++m) _Pragma("unroll") for (int n = 0; n < 2; ++n) _Pragma("unroll") for (int k = 0; k < 2; ++k) \
        acc[ai][bj][m][n] = __builtin_amdgcn_mfma_f32_16x16x32_bf16(Bt[n][k], At[m][k], acc[ai][bj][m][n], 0, 0, 0); __builtin_amdgcn_s_setprio(0); } while (0)
#define PG8_WAIT_V(n) asm volatile("s_waitcnt vmcnt(" #n ")" ::: "memory")
#define PG8_WAIT_L(n) asm volatile("s_waitcnt lgkmcnt(" #n ")" ::: "memory")
#define PG8_BAR __builtin_amdgcn_s_barrier()
#define PG8_SCHED __builtin_amdgcn_sched_barrier(0)
    Unit cur, nxt; int ui = 0;
    if (!S.next(0, cur)) return;
    f32x4 acc[2][2][4][2];
#pragma unroll
    for (int a = 0; a < 2; ++a)
#pragma unroll
        for (int b = 0; b < 2; ++b)
#pragma unroll
            for (int m = 0; m < 4; ++m)
#pragma unroll
                for (int n = 0; n < 2; ++n) acc[a][b][m][n] = (f32x4){0.f, 0.f, 0.f, 0.f};
    bf16x8 At[4][2], B0[2][2], B1[2][2];
    const char* cA = (const char*)g.A + (size_t)cur.pm * tstep; const char* cB = (const char*)g.Bt + (size_t)cur.pn * tstep;
    S.a_ready(cur);
    if constexpr (SP2) {
        PG8_STAGE(PG8_SB(0, 0), cB, voffB); PG8_STAGE(PG8_SB(0, 1), cB + hstep, voffB); PG8_STAGE(PG8_SA(0, 0), cA, voffA); PG8_STAGE(PG8_SA(0, 1), cA + hstep, voffA);
        if (wr == 1) PG8_BAR;
        PG8_WAIT_V(2); PG8_BAR;
        PG8_STAGE(PG8_SB(1, 0), cB + kstep, voffB); PG8_STAGE(PG8_SA(1, 0), cA + kstep, voffA); PG8_STAGE(PG8_SB(1, 1), cB + hstep + kstep, voffB);
        PG8_WAIT_V(6); PG8_BAR;
    } else {
        PG8_STAGE(PG8_SB(0, 0), cB, voffB); PG8_STAGE(PG8_SA(0, 0), cA, voffA); PG8_STAGE(PG8_SB(0, 1), cB + hstep, voffB); PG8_STAGE(PG8_SA(0, 1), cA + hstep, voffA);
        if (wr == 1) PG8_BAR;
        PG8_WAIT_V(4); PG8_BAR;
        PG8_STAGE(PG8_SB(1, 0), cB + kstep, voffB); PG8_STAGE(PG8_SA(1, 0), cA + kstep, voffA); PG8_STAGE(PG8_SB(1, 1), cB + hstep + kstep, voffB);
        PG8_WAIT_V(6); PG8_BAR;
    }
    for (;;) {
        const bool has_next = S.next(ui + 1, nxt);
        const char* nA = has_next ? (const char*)g.A + (size_t)nxt.pm * tstep : cA; const char* nB = has_next ? (const char*)g.Bt + (size_t)nxt.pn * tstep : cB;
        for (int t = 0; t < nt; t += 2) {
            const bool last = (t == nt - 2);
            const char* a1 = cA + (size_t)(t + 1) * kstep;
            const char* a2 = last ? nA : cA + (size_t)(t + 2) * kstep; const char* b2 = last ? nB : cB + (size_t)(t + 2) * kstep;
            const char* a3 = a2 + kstep; const char* b3 = b2 + kstep;
            if (last && has_next) S.a_ready(nxt);
            if constexpr (SP2) {
            PG8_LDB(B0, 0, 0); PG8_LDB(B1, 0, 1); PG8_SCHED; PG8_LDA(At, 0, 0); PG8_STAGE(PG8_SA(1, 1), a1 + hstep, voffA);
            PG8_WAIT_V(8); PG8_WAIT_L(0); PG8_BAR; PG8_MMA(0, 0, At, B0); PG8_MMA(0, 1, At, B1); PG8_BAR; PG8_SCHED;
            PG8_LDA(At, 0, 1); PG8_STAGE(PG8_SB(0, 0), b2, voffB); PG8_STAGE(PG8_SB(0, 1), b2 + hstep, voffB); PG8_STAGE(PG8_SA(0, 0), a2, voffA);
            PG8_WAIT_V(8); PG8_WAIT_L(0); PG8_BAR; PG8_MMA(1, 0, At, B0); PG8_MMA(1, 1, At, B1); PG8_BAR; PG8_SCHED;
            PG8_LDB(B0, 1, 0); PG8_LDB(B1, 1, 1); PG8_SCHED; PG8_LDA(At, 1, 0); PG8_STAGE(PG8_SA(0, 1), a2 + hstep, voffA);
            PG8_WAIT_V(8); PG8_WAIT_L(0); PG8_BAR; PG8_MMA(0, 0, At, B0); PG8_MMA(0, 1, At, B1); PG8_BAR; PG8_SCHED;
            PG8_LDA(At, 1, 1); PG8_STAGE(PG8_SB(1, 0), b3, voffB); PG8_STAGE(PG8_SB(1, 1), b3 + hstep, voffB); PG8_STAGE(PG8_SA(1, 0), a3, voffA);
            PG8_WAIT_V(8); PG8_WAIT_L(0); PG8_BAR; PG8_MMA(1, 0, At, B0); PG8_MMA(1, 1, At, B1); PG8_BAR; PG8_SCHED;
            } else {
            PG8_LDB(B0, 0, 0); PG8_SCHED; PG8_LDA(At, 0, 0); PG8_STAGE(PG8_SA(1, 1), a1 + hstep, voffA);
            PG8_WAIT_L(8); PG8_BAR; PG8_WAIT_L(0); PG8_MMA(0, 0, At, B0); PG8_BAR; PG8_SCHED;
            PG8_LDB(B1, 0, 1); PG8_STAGE(PG8_SB(0, 0), b2, voffB);
            PG8_BAR; PG8_WAIT_L(0); PG8_MMA(0, 1, At, B1); PG8_BAR;
            PG8_LDA(At, 0, 1); PG8_STAGE(PG8_SA(0, 0), a2, voffA);
            PG8_BAR; PG8_WAIT_L(0); PG8_MMA(1, 0, At, B0); PG8_BAR; PG8_SCHED;
            PG8_STAGE(PG8_SB(0, 1), b2 + hstep, voffB);
            PG8_WAIT_V(6); PG8_BAR; PG8_MMA(1, 1, At, B1); PG8_BAR;
            PG8_LDB(B0, 1, 0); PG8_SCHED; PG8_LDA(At, 1, 0); PG8_STAGE(PG8_SA(0, 1), a2 + hstep, voffA);
            PG8_WAIT_L(8); PG8_BAR; PG8_WAIT_L(0); PG8_MMA(0, 0, At, B0); PG8_BAR; PG8_SCHED;
            PG8_LDB(B1, 1, 1); PG8_STAGE(PG8_SB(1, 0), b3, voffB);
            PG8_BAR; PG8_WAIT_L(0); PG8_MMA(0, 1, At, B1); PG8_BAR;
            PG8_LDA(At, 1, 1); PG8_STAGE(PG8_SA(1, 0), a3, voffA);
            PG8_BAR; PG8_WAIT_L(0); PG8_MMA(1, 0, At, B0); PG8_BAR; PG8_SCHED;
            PG8_STAGE(PG8_SB(1, 1), b3 + hstep, voffB);
            PG8_WAIT_V(6); PG8_BAR; PG8_MMA(1, 1, At, B1); PG8_BAR;
            }
        }
        if constexpr (ALIGN_EPI) { if (wr == 0) PG8_BAR; }
        if constexpr (!Epi::AFTER_DRAIN) { E(acc, cur, wr, wc, fr, fq); S.done(cur); }
        if (!has_next) break;
#pragma unroll
        for (int a = 0; a < 2; ++a)
#pragma unroll
            for (int b = 0; b < 2; ++b)
#pragma unroll
                for (int m = 0; m < 4; ++m)
#pragma unroll
                    for (int n = 0; n < 2; ++n) acc[a][b][m][n] = (f32x4){0.f, 0.f, 0.f, 0.f};
        cur = nxt; cA = nA; cB = nB; ++ui;
        if constexpr (ALIGN_EPI) { if (wr == 1) PG8_BAR; }
    }
    PG8_WAIT_V(0);
    if constexpr (!ALIGN_EPI) { if (wr == 0) PG8_BAR; }
    PG8_BAR;
    if constexpr (Epi::AFTER_DRAIN) { E.fused(acc, cur, wr, wc, fr, fq, lds, wid, lane); S.done(cur); }
#undef PG8_SA
#undef PG8_SB
#undef PG8_STAGE
#undef PG8_LDA
#undef PG8_LDB
#undef PG8_MMA
#undef PG8_WAIT_V
#undef PG8_WAIT_L
#undef PG8_BAR
#undef PG8_SCHED
}
}

#define LAS __attribute__((address_space(3)))
template <class Epi> __global__ void __launch_bounds__(512, 2) k_gemm_fast(pg8::Gemm g, Epi E) {
    extern __shared__ __attribute__((aligned(16))) unsigned char lds[];
    pg8::StaticOrder S; S.init(g.M, g.N, (int)gridDim.x, (int)blockIdx.x);
    pg8::gemm_phase<Epi, pg8::StaticOrder, true, true>((LAS unsigned char*)lds, g, S, E, (int)threadIdx.x);
}

template <class Epi>
__global__ void __launch_bounds__(256) k_gemm_naive(const bf16_t* A, const bf16_t* Bt, int N, int K, Epi epi) {
    __shared__ float As[64][33], Bs[64][33];
    const int tid = threadIdx.x, tx = tid & 15, ty = tid >> 4;
    const int nbn = N / 64; const int bm = blockIdx.x / nbn, bn = blockIdx.x % nbn;
    float acc[4][4] = {};
    const int lr = tid >> 2, lc = (tid & 3) * 8;
    for (int k0 = 0; k0 < K; k0 += 32) {
        const u32x4 av = *(const u32x4*)(A + (size_t)(bm * 64 + lr) * K + k0 + lc);
        const u32x4 bv = *(const u32x4*)(Bt + (size_t)(bn * 64 + lr) * K + k0 + lc);
        __syncthreads();
#pragma unroll
        for (int j = 0; j < 4; ++j) { As[lr][lc + 2 * j] = __uint_as_float(av[j] << 16); As[lr][lc + 2 * j + 1] = __uint_as_float(av[j] & 0xffff0000u);
                                      Bs[lr][lc + 2 * j] = __uint_as_float(bv[j] << 16); Bs[lr][lc + 2 * j + 1] = __uint_as_float(bv[j] & 0xffff0000u); }
        __syncthreads();
#pragma unroll 8
        for (int kk = 0; kk < 32; ++kk) { float a[4], b[4];
#pragma unroll
            for (int i = 0; i < 4; ++i) { a[i] = As[ty * 4 + i][kk]; b[i] = Bs[tx * 4 + i][kk]; }
#pragma unroll
            for (int i = 0; i < 4; ++i)
#pragma unroll
                for (int j = 0; j < 4; ++j) acc[i][j] += a[i] * b[j]; }
    }
#pragma unroll
    for (int i = 0; i < 4; ++i)
#pragma unroll
        for (int j = 0; j < 4; ++j) epi(bm * 64 + ty * 4 + i, bn * 64 + tx * 4 + j, acc[i][j]);
}

template <bool F32>
__global__ void __launch_bounds__(256) k_rowss(const void* src, int ld, int ncols, float* dst, int dst_ld, int nslots) {
    const int lane = threadIdx.x & 63, row = blockIdx.x * 4 + (threadIdx.x >> 6);
    float s = 0.f;
    for (int c = lane; c < ncols; c += 64) { const float v = F32 ? ((const float*)src)[(size_t)row * ld + c] : bf2f(((const bf16_t*)src)[(size_t)row * ld + c]); s += v * v; }
    s = wave_sum(s);
    if (lane < nslots) dst[(size_t)row * dst_ld + lane] = lane == 0 ? s : 0.f;
}

__global__ void __launch_bounds__(256) k_rope(bf16_t* buf, int nh, const float* rc, const float* rs) {
    const int idx = blockIdx.x * 256 + threadIdx.x; const int per_row = nh * 32; if (idx >= M * per_row) return;
    const int row = idx / per_row, t = idx % per_row, h = t >> 5, i = t & 31, pos = row % SEQ;
    bf16_t* p = buf + (size_t)row * nh * 64 + h * 64; const float x1 = bf2f(p[i]), x2 = bf2f(p[32 + i]); const float cs = rc[pos * 32 + i], sn = rs[pos * 32 + i];
    p[i] = f2bf(x1 * cs - x2 * sn); p[32 + i] = f2bf(x1 * sn + x2 * cs);
}

template <int D> DI float dot_row(const float* q, const bf16_t* k) {
    float s = 0.f;
#pragma unroll
    for (int d = 0; d < D; d += 8) { const u32x4 v = *(const u32x4*)(k + d);
#pragma unroll
        for (int j = 0; j < 4; ++j) { s += q[d + 2 * j] * __uint_as_float(v[j] << 16); s += q[d + 2 * j + 1] * __uint_as_float(v[j] & 0xffff0000u); } }
    return s;
}

__global__ void __launch_bounds__(256) k_mla_naive(Ctx c) {
    __shared__ float qs[4][192];
    const int lane = threadIdx.x & 63, w = threadIdx.x >> 6; const int gq = blockIdx.x * 4 + w;
    const int t = gq % SEQ, bh = gq / SEQ, h = bh % 8, b = bh / 8; const size_t row = (size_t)b * SEQ + t;
    unsigned char* ws = c.ws;
    const bf16_t *QN = (const bf16_t*)(ws + WS_QN), *QR = (const bf16_t*)(ws + WS_QR), *KN = (const bf16_t*)(ws + WS_KN), *KR = (const bf16_t*)(ws + WS_KR), *VA = (const bf16_t*)(ws + WS_VA), *SG = (const bf16_t*)(ws + WS_SG);
    for (int d = lane; d < 192; d += 64) qs[w][d] = d < 128 ? bf2f(QN[row * 1024 + h * 128 + d]) : bf2f(QR[row * 512 + h * 64 + d - 128]);
    __syncthreads();
    float m = -INFINITY, l = 0.f, o0 = 0.f, o1 = 0.f;
    for (int j0 = 0; j0 <= t; j0 += 64) {
        const int j = j0 + lane; const bool valid = j <= t; const size_t krow = (size_t)b * SEQ + (valid ? j : t);
        float s = dot_row<128>(qs[w], KN + krow * 1024 + h * 128) + dot_row<64>(qs[w] + 128, KR + krow * 64);
        if (!valid) s = -INFINITY;
        const float mn = fmaxf(m, wave_max(s)); const float alpha = exp2f(m - mn); const float p = valid ? exp2f(s - mn) : 0.f;
        l = l * alpha + wave_sum(p); o0 *= alpha; o1 *= alpha; m = mn;
        const int nj = min(64, t - j0 + 1);
        for (int jj = 0; jj < nj; ++jj) { const float pj = __shfl(p, jj); const bf16_t* vr = VA + ((size_t)b * SEQ + j0 + jj) * 1024 + h * 128; o0 += pj * bf2f(vr[lane]); o1 += pj * bf2f(vr[lane + 64]); }
    }
    bf16_t* MIX = (bf16_t*)(ws + WS_MIX); const float il = 1.0f / l;
    MIX[row * 2048 + h * 128 + lane] = f2bf(o0 * il * bf2f(SG[row * 2048 + h * 128 + lane]));
    MIX[row * 2048 + h * 128 + lane + 64] = f2bf(o1 * il * bf2f(SG[row * 2048 + h * 128 + lane + 64]));
}

__global__ void __launch_bounds__(256) k_dil_naive(Ctx c) {
    __shared__ float qs[4][128];
    const int lane = threadIdx.x & 63, w = threadIdx.x >> 6; const int gq = blockIdx.x * 4 + w;
    const int t = gq % SEQ, bh = gq / SEQ, h = bh % 8, b = bh / 8; const size_t row = (size_t)b * SEQ + t;
    unsigned char* ws = c.ws;
    const bf16_t *QB = (const bf16_t*)(ws + WS_QB), *KB = (const bf16_t*)(ws + WS_KB), *VB = (const bf16_t*)(ws + WS_VB);
    const float* bn = (const float*)(ws + WS_BIASN);
    for (int d = lane; d < 128; d += 64) qs[w][d] = bf2f(QB[row * 1024 + h * 128 + d]);
    __syncthreads();
    for (int p = 0; p < 3; ++p) { const int dil = p == 0 ? 1 : p == 1 ? 4 : 16;
        float m = -INFINITY, l = 0.f, o0 = 0.f, o1 = 0.f;
        for (int r0 = 0; r0 < 192; r0 += 64) {
            const int rel = r0 + lane; const int j = t - rel * dil; const bool valid = rel <= 128 && j >= 0; const size_t krow = (size_t)b * SEQ + (valid ? j : t);
            float s = dot_row<128>(qs[w], KB + krow * 1024 + h * 128) + bn[(p * 8 + h) * 132 + (valid ? rel : 0)];
            if (!valid) s = -INFINITY;
            const float mn = fmaxf(m, wave_max(s));
            const float alpha = exp2f(m - mn); const float pp = valid ? exp2f(s - mn) : 0.f;
            l = l * alpha + wave_sum(pp); o0 *= alpha; o1 *= alpha; m = mn;
            for (int jj = 0; jj < 64; ++jj) { const float pj = __shfl(pp, jj); if (pj != 0.f) { const int jr = t - (r0 + jj) * dil; const bf16_t* vr = VB + ((size_t)b * SEQ + jr) * 1024 + h * 128; o0 += pj * bf2f(vr[lane]); o1 += pj * bf2f(vr[lane + 64]); } }
        }
        bf16_t* OP = (bf16_t*)(ws + (p == 0 ? WS_OP0 : p == 1 ? WS_OP1 : WS_OP2)); const float il = 1.0f / l;
        OP[row * 1024 + h * 128 + lane] = f2bf(o0 * il); OP[row * 1024 + h * 128 + lane + 64] = f2bf(o1 * il);
        if (lane == 0) ((float*)(ws + WS_LSE))[((size_t)p * M + row) * 8 + h] = m + log2f(l);
    }
}

DI void dil_merge_item(unsigned char* ws, int row, int col) {
    const int h = col >> 7; const float* lse = (const float*)(ws + WS_LSE);
    const float l0 = lse[((size_t)0 * M + row) * 8 + h], l1 = lse[((size_t)1 * M + row) * 8 + h], l2 = lse[((size_t)2 * M + row) * 8 + h];
    const float mx = fmaxf(l0, fmaxf(l1, l2)); float w0 = exp2f(l0 - mx), w1 = exp2f(l1 - mx), w2 = exp2f(l2 - mx); const float inv = 1.0f / (w0 + w1 + w2); w0 *= inv; w1 *= inv; w2 *= inv;
    const u32x4 a0 = *(const u32x4*)((const bf16_t*)(ws + WS_OP0) + (size_t)row * 1024 + col), a1 = *(const u32x4*)((const bf16_t*)(ws + WS_OP1) + (size_t)row * 1024 + col),
                a2 = *(const u32x4*)((const bf16_t*)(ws + WS_OP2) + (size_t)row * 1024 + col), sg = *(const u32x4*)((const bf16_t*)(ws + WS_SG) + (size_t)row * 2048 + 1024 + col);
    u32x4 o;
#pragma unroll
    for (int j = 0; j < 4; ++j) {
        const float lo = (w0 * __uint_as_float(a0[j] << 16) + w1 * __uint_as_float(a1[j] << 16) + w2 * __uint_as_float(a2[j] << 16)) * __uint_as_float(sg[j] << 16);
        const float hi = (w0 * __uint_as_float(a0[j] & 0xffff0000u) + w1 * __uint_as_float(a1[j] & 0xffff0000u) + w2 * __uint_as_float(a2[j] & 0xffff0000u)) * __uint_as_float(sg[j] & 0xffff0000u);
        o[j] = (unsigned)f2bf(lo) | ((unsigned)f2bf(hi) << 16); }
    *(u32x4*)((bf16_t*)(ws + WS_MIX) + (size_t)row * 2048 + 1024 + col) = o;
}
__global__ void __launch_bounds__(128) k_dil_merge(Ctx c) { dil_merge_item(c.ws, blockIdx.x, threadIdx.x * 8); }

__global__ void __launch_bounds__(256) k_sb_naive(Ctx c) {
    __shared__ float qs[4][128];
    const int lane = threadIdx.x & 63, w = threadIdx.x >> 6; const int gq = blockIdx.x * 4 + w;
    const int t = gq % SEQ, bh = gq / SEQ, h = bh % 16, b = bh / 16; const size_t row = (size_t)b * SEQ + t;
    unsigned char* ws = c.ws;
    const bf16_t *Q2 = (const bf16_t*)(ws + WS_Q2), *K2 = (const bf16_t*)(ws + WS_K2), *V2 = (const bf16_t*)(ws + WS_V2), *SG2 = (const bf16_t*)(ws + WS_SG2);
    for (int d = lane; d < 128; d += 64) qs[w][d] = bf2f(Q2[row * 2048 + h * 128 + d]);
    __syncthreads();
    float carry = 0.f, o0 = 0.f, o1 = 0.f;
    for (int c0 = 0; c0 < t; c0 += 64) {
        const int j = t - 1 - c0 - lane; const bool valid = j >= 0; const size_t krow = (size_t)b * SEQ + (valid ? j : 0);
        const float z = dot_row<128>(qs[w], K2 + krow * 2048 + h * 128);
        const float sp = fmaxf(z, 0.f) + log2f(1.0f + exp2f(-fabsf(z)));
        const float L = valid ? -sp : 0.f;
        float incl = L;
#pragma unroll
        for (int o = 1; o < 64; o <<= 1) { const float v = __shfl_up(incl, o); if (lane >= o) incl += v; }
        const float between = carry + (incl - L);
        const float a = valid ? exp2f(z - sp + between) : 0.f;
        carry += __shfl(incl, 63);
        const int nj = min(64, t - c0);
        for (int jj = 0; jj < nj; ++jj) { const float aj = __shfl(a, jj); const bf16_t* vr = V2 + ((size_t)b * SEQ + t - 1 - c0 - jj) * 2048 + h * 128; o0 += aj * bf2f(vr[lane]); o1 += aj * bf2f(vr[lane + 64]); }
    }
    bf16_t* MIX2 = (bf16_t*)(ws + WS_MIX2);
    MIX2[row * 2048 + h * 128 + lane] = f2bf(o0 * bf2f(SG2[row * 2048 + h * 128 + lane]));
    MIX2[row * 2048 + h * 128 + lane + 64] = f2bf(o1 * bf2f(SG2[row * 2048 + h * 128 + lane + 64]));
}

#ifndef MLA_PIPE
#define MLA_PIPE 1
#endif
namespace att {
typedef short bf16x8 __attribute__((ext_vector_type(8)));
typedef short s16x4 __attribute__((ext_vector_type(4)));
typedef short v4i16_t __attribute__((ext_vector_type(4)));
typedef float f32x16 __attribute__((ext_vector_type(16)));
typedef _Float16 f16x8 __attribute__((ext_vector_type(8)));
typedef _Float16 f16x2 __attribute__((ext_vector_type(2)));
typedef float f32x2_t __attribute__((ext_vector_type(2))); typedef __bf16 bf16x2_t __attribute__((ext_vector_type(2)));
typedef LAS const unsigned char* lcp;
#define MFMA_BF16(a, b, c) __builtin_amdgcn_mfma_f32_32x32x16_bf16((a), (b), (c), 0, 0, 0)
#define MFMA_F16(a, b, c) __builtin_amdgcn_mfma_f32_32x32x16_f16((a), (b), (c), 0, 0, 0)
#define SBAR() __builtin_amdgcn_sched_barrier(0)
DI int crow(int g, int h) { return (g & 3) + 8 * (g >> 2) + 4 * h; }
DI unsigned off_b(unsigned row, unsigned ch) { return 256u * row + 16u * (ch ^ (((row & 3) << 2) | ((row >> 2) & 3))); }
DI unsigned cvtpk(float lo, float hi) { f32x2_t v = {lo, hi}; bf16x2_t b = __builtin_convertvector(v, bf16x2_t); return __builtin_bit_cast(unsigned, b); }
DI unsigned cvtpk_h(float lo, float hi) { f32x2_t v = {lo, hi}; f16x2 b = __builtin_convertvector(v, f16x2); return __builtin_bit_cast(unsigned, b); }
DI bf16x8 pack_bf(const f32x16& x, int s) { u32x4 p; p.x = cvtpk(x[8 * s], x[8 * s + 1]); p.y = cvtpk(x[8 * s + 2], x[8 * s + 3]); p.z = cvtpk(x[8 * s + 4], x[8 * s + 5]); p.w = cvtpk(x[8 * s + 6], x[8 * s + 7]); return __builtin_bit_cast(bf16x8, p); }
DI f16x8 pack_h(const f32x16& x, int s) { u32x4 p; p.x = cvtpk_h(x[8 * s], x[8 * s + 1]); p.y = cvtpk_h(x[8 * s + 2], x[8 * s + 3]); p.z = cvtpk_h(x[8 * s + 4], x[8 * s + 5]); p.w = cvtpk_h(x[8 * s + 6], x[8 * s + 7]); return __builtin_bit_cast(f16x8, p); }
DI s16x4 vtr(lcp p) { return __builtin_bit_cast(s16x4, __builtin_amdgcn_ds_read_tr16_b64_v4i16((LAS v4i16_t*)p)); }
DI float swap_max(float m) { auto rr = __builtin_amdgcn_permlane32_swap(__float_as_uint(m), __float_as_uint(m), false, false); return fmaxf(__uint_as_float(rr[0]), __uint_as_float(rr[1])); }
DI float swap_sum(float m) { auto rr = __builtin_amdgcn_permlane32_swap(__float_as_uint(m), __float_as_uint(m), false, false); return __uint_as_float(rr[0]) + __uint_as_float(rr[1]); }
DI float bcast_lo(float m) { auto rr = __builtin_amdgcn_permlane32_swap(__float_as_uint(m), __float_as_uint(m), false, false); return __uint_as_float(rr[0]); }
DI void o_pair8(const f32x16& o, int p, float (&e)[8]) {
#pragma unroll
    for (int i = 0; i < 4; ++i) { auto rr = __builtin_amdgcn_permlane32_swap(__float_as_uint(o[8 * p + i]), __float_as_uint(o[8 * p + 4 + i]), false, false); e[i] = __uint_as_float(rr[0]); e[4 + i] = __uint_as_float(rr[1]); }
}
DI __amdgpu_buffer_rsrc_t mk_rsrc(const void* p, unsigned bytes) { return __builtin_amdgcn_make_buffer_rsrc((void*)p, 0, bytes, 0x00020000); }
DI u32x4 bload(__amdgpu_buffer_rsrc_t rs, unsigned voff, unsigned soff) { return __builtin_amdgcn_raw_buffer_load_b128(rs, voff, soff, 0); }
struct VAddr { unsigned a[2][4]; };
DI VAddr make_vaddr(int lane) { VAddr v; const unsigned hh = lane >> 5, blk = (lane >> 4) & 1, qq = (lane & 15) >> 2, p = lane & 3;
#pragma unroll
    for (int t = 0; t < 2; ++t)
#pragma unroll
        for (int d0 = 0; d0 < 4; ++d0) v.a[t][d0] = off_b(8 * t + 4 * hh + qq, 4 * d0 + 2 * blk + (p >> 1)) + 8 * (p & 1);
    return v; }
DI bf16x8 vfrag(lcp img, int s, int d0, const VAddr& va) {
    const s16x4 lo = vtr(img + 4096 * s + va.a[0][d0]);
    const s16x4 hi = vtr(img + 4096 * s + va.a[1][d0]);
    return (bf16x8){lo[0], lo[1], lo[2], lo[3], hi[0], hi[1], hi[2], hi[3]};
}
DI void softmax_tile(f32x16& s0, f32x16& s1, f32x16 (&o)[4], float& mrun, float& lrun) {
    float mt = fmaxf(s0[0], s1[0]);
#pragma unroll
    for (int g = 1; g < 16; ++g) mt = fmaxf(mt, fmaxf(s0[g], s1[g]));
    mt = swap_max(mt);
    const float mn = fmaxf(mrun, mt), alpha = __builtin_amdgcn_exp2f(mrun - mn); mrun = mn;
    float ps = 0.f;
#pragma unroll
    for (int g = 0; g < 16; ++g) { s0[g] = __builtin_amdgcn_exp2f(s0[g] - mn); s1[g] = __builtin_amdgcn_exp2f(s1[g] - mn); ps += s0[g] + s1[g]; }
    lrun = lrun * alpha + ps;
#pragma unroll
    for (int d0 = 0; d0 < 4; ++d0)
#pragma unroll
        for (int g = 0; g < 16; ++g) o[d0][g] *= alpha;
}

constexpr int MLA_KSTR = 400, MLA_KBUF = 64 * MLA_KSTR, VBUF = 16384, MLA_LDS_V = 2 * MLA_KBUF, MLA_LDS_BYTES = 2 * MLA_KBUF + 2 * VBUF;
template <bool MASKED>
DI void mla_tile(lcp kb, lcp vb, const bf16x8 (&qf)[12], f32x16 (&o)[4], float& mrun, float& lrun, const VAddr& va, int qrel, int hh) {
    f32x16 s0, s1;
#pragma unroll
    for (int g = 0; g < 16; ++g) { s0[g] = 0.f; s1[g] = 0.f; }
    bf16x8 f0a = *(LAS const bf16x8*)kb, f0b = *(LAS const bf16x8*)(kb + 32 * MLA_KSTR), f1a = *(LAS const bf16x8*)(kb + 32), f1b = *(LAS const bf16x8*)(kb + 32 * MLA_KSTR + 32), f2a, f2b;
#pragma unroll
    for (int d0 = 0; d0 < 12; ++d0) {
        if (d0 + 2 < 12) { const bf16x8 n0 = *(LAS const bf16x8*)(kb + (d0 + 2) * 32), n1 = *(LAS const bf16x8*)(kb + 32 * MLA_KSTR + (d0 + 2) * 32);
            if ((d0 + 2) % 3 == 0) { f0a = n0; f0b = n1; } else if ((d0 + 2) % 3 == 1) { f1a = n0; f1b = n1; } else { f2a = n0; f2b = n1; } }
        SBAR();
        s0 = MFMA_BF16(d0 % 3 == 0 ? f0a : d0 % 3 == 1 ? f1a : f2a, qf[d0], s0); s1 = MFMA_BF16(d0 % 3 == 0 ? f0b : d0 % 3 == 1 ? f1b : f2b, qf[d0], s1);
        SBAR();
    }
    if (MASKED) {
#pragma unroll
        for (int g = 0; g < 16; ++g) { const int kv = crow(g, 0); if (kv > qrel - 4 * hh) s0[g] = -INFINITY; if (kv + 32 > qrel - 4 * hh) s1[g] = -INFINITY; } }
    float mt = fmaxf(s0[0], s1[0]);
#pragma unroll
    for (int g = 1; g < 16; ++g) mt = fmaxf(mt, fmaxf(s0[g], s1[g]));
    mt = swap_max(mt);
    if (__builtin_amdgcn_ballot_w64(mt > mrun) != 0ull) {
        const float mn = fmaxf(mrun, mt), alpha = __builtin_amdgcn_exp2f(mrun - mn); mrun = mn; lrun *= alpha;
#pragma unroll
        for (int d0 = 0; d0 < 4; ++d0)
#pragma unroll
            for (int g = 0; g < 16; ++g) o[d0][g] *= alpha;
    }
    float ps = 0.f;
#pragma unroll
    for (int g = 0; g < 16; ++g) { s0[g] = __builtin_amdgcn_exp2f(s0[g] - mrun); s1[g] = __builtin_amdgcn_exp2f(s1[g] - mrun); ps += s0[g] + s1[g]; }
    lrun += ps;
    bf16x8 pf[4]; pf[0] = pack_bf(s0, 0); pf[1] = pack_bf(s0, 1); pf[2] = pack_bf(s1, 0); pf[3] = pack_bf(s1, 1);
    bf16x8 v0 = vfrag(vb, 0, 0, va), v1 = vfrag(vb, 0, 1, va), v2;
#pragma unroll
    for (int j = 0; j < 16; ++j) {
        if (j + 2 < 16) { const int ks = (j + 2) >> 2, d0 = (j + 2) & 3; const bf16x8 nx = vfrag(vb + (ks >> 1) * 8192, ks & 1, d0, va);
            if ((j + 2) % 3 == 0) v0 = nx; else if ((j + 2) % 3 == 1) v1 = nx; else v2 = nx; }
        SBAR();
        o[j & 3] = MFMA_BF16(j % 3 == 0 ? v0 : j % 3 == 1 ? v1 : v2, pf[j >> 2], o[j & 3]);
        SBAR();
    }
}
DI void mla_unit(LAS unsigned char* lds, unsigned char* ws, int b, int h, int qb, const int tid_in) {
    int tid = tid_in; asm volatile("" : "+v"(tid));
    const int lane = tid & 63, wid = __builtin_amdgcn_readfirstlane(tid >> 6), r = lane & 31, hh = lane >> 5;
    const bf16_t *QN = (const bf16_t*)(ws + WS_QN), *QR = (const bf16_t*)(ws + WS_QR), *KN = (const bf16_t*)(ws + WS_KN), *KR = (const bf16_t*)(ws + WS_KR), *VA = (const bf16_t*)(ws + WS_VA), *SG = (const bf16_t*)(ws + WS_SG);
    bf16_t* MIX = (bf16_t*)(ws + WS_MIX);
    const int q0 = qb * 256, NT = 4 * (qb + 1), tmax = (q0 + 32 * wid) >> 6; const size_t rowbase = (size_t)b * SEQ;
    bf16x8 qf[12];
    { const size_t qrow = rowbase + q0 + 32 * wid + r;
#pragma unroll
      for (int d0 = 0; d0 < 8; ++d0) qf[d0] = *(const bf16x8*)(QN + qrow * 1024 + h * 128 + d0 * 16 + hh * 8);
#pragma unroll
      for (int d0 = 0; d0 < 4; ++d0) qf[8 + d0] = *(const bf16x8*)(QR + qrow * 512 + h * 64 + d0 * 16 + hh * 8); }
    f32x16 o[4];
#pragma unroll
    for (int d0 = 0; d0 < 4; ++d0)
#pragma unroll
        for (int g = 0; g < 16; ++g) o[d0][g] = 0.f;
    float mrun = -INFINITY, lrun = 0.f;
    u32x4 kreg[3], vreg[2];
    const VAddr va = make_vaddr(lane);
    const __amdgpu_buffer_rsrc_t rKN = mk_rsrc(KN, M * 1024 * 2), rKR = mk_rsrc(KR, M * 64 * 2), rVA = mk_rsrc(VA, M * 1024 * 2);
    const unsigned vo0 = (tid >> 4) * 2048 + (tid & 15) * 16, vo1 = vo0 + 32 * 2048, vor = (tid >> 3) * 128 + (tid & 7) * 16;
    const unsigned so_n = ((unsigned)rowbase * 1024 + h * 128) * 2, so_r = (unsigned)rowbase * 64 * 2;
    const unsigned lk0 = (tid >> 4) * MLA_KSTR + (tid & 15) * 16, lk1 = lk0 + 32 * MLA_KSTR, lkr = (tid >> 3) * MLA_KSTR + 256 + (tid & 7) * 16;
    const unsigned lv0 = off_b((tid >> 4) & 31, tid & 15), lv1 = lv0 + 8192;
    const unsigned kfo = r * MLA_KSTR + hh * 16;
#define MLA_LOAD(t) do { const unsigned tn = so_n + (unsigned)(t) * (64 * 2048), tr_ = so_r + (unsigned)(t) * (64 * 128); \
        kreg[0] = bload(rKN, vo0, tn); kreg[1] = bload(rKN, vo1, tn); kreg[2] = bload(rKR, vor, tr_); vreg[0] = bload(rVA, vo0, tn); vreg[1] = bload(rVA, vo1, tn); } while (0)
#define MLA_STORE(buf) do { LAS unsigned char* kd = lds + (buf) * MLA_KBUF; LAS unsigned char* vd = lds + MLA_LDS_V + (buf) * VBUF; \
        *(LAS u32x4*)(kd + lk0) = kreg[0]; *(LAS u32x4*)(kd + lk1) = kreg[1]; *(LAS u32x4*)(kd + lkr) = kreg[2]; *(LAS u32x4*)(vd + lv0) = vreg[0]; *(LAS u32x4*)(vd + lv1) = vreg[1]; } while (0)
    MLA_LOAD(0); MLA_STORE(0); __builtin_amdgcn_s_waitcnt(0x0F70);   __syncthreads();
#define MLA_INTERVAL(MODE) { const int buf = t & 1; \
        if (t + 1 < NT) MLA_LOAD(t + 1); \
        if (MODE == 0) mla_tile<false>(lds + buf * MLA_KBUF + kfo, lds + MLA_LDS_V + buf * VBUF, qf, o, mrun, lrun, va, 0, hh); \
        if (MODE == 1) mla_tile<true>(lds + buf * MLA_KBUF + kfo, lds + MLA_LDS_V + buf * VBUF, qf, o, mrun, lrun, va, q0 + 32 * wid + r - 64 * t, hh); \
        if (t + 1 < NT) MLA_STORE(buf ^ 1); \
        __syncthreads(); }
    int t = 0;
    for (; t < tmax; ++t) MLA_INTERVAL(0)
    MLA_INTERVAL(1)
    for (++t; t < NT; ++t) MLA_INTERVAL(2)
#undef MLA_INTERVAL
#undef MLA_LOAD
#undef MLA_STORE
    const float inv = 1.0f / swap_sum(lrun);
    int t4 = tid; asm volatile("" : "+v"(t4)); const size_t qrow = rowbase + q0 + 32 * wid + (t4 & 31); const int hh2 = (t4 >> 5) & 1;
#pragma unroll
    for (int d0 = 0; d0 < 4; ++d0)
#pragma unroll
        for (int gg = 0; gg < 4; ++gg) { const size_t off = qrow * 2048 + h * 128 + 32 * d0 + 8 * gg + 4 * hh2;
            const unsigned long long sg = *(const unsigned long long*)(SG + off);
            const float g0 = __uint_as_float((unsigned)(sg << 16)), g1 = __uint_as_float((unsigned)sg & 0xffff0000u), g2 = __uint_as_float((unsigned)(sg >> 32) << 16), g3 = __uint_as_float((unsigned)(sg >> 32) & 0xffff0000u);
            const unsigned lo = cvtpk(o[d0][4 * gg] * inv * g0, o[d0][4 * gg + 1] * inv * g1), hi = cvtpk(o[d0][4 * gg + 2] * inv * g2, o[d0][4 * gg + 3] * inv * g3);
            *(unsigned long long*)(MIX + off) = (unsigned long long)lo | ((unsigned long long)hi << 32); }
}
DI float vmax3_s(float a, float b, float c) { float r; asm("v_max3_f32 %0, %1, %2, %3" : "=v"(r) : "v"(a), "v"(b), "v"(c)); return r; }
constexpr int M2_KBUF = 64 * 384, M2_LDS_V = 3 * M2_KBUF, M2_LDS_BYTES = M2_LDS_V + 3 * VBUF;
struct M2State { f32x16 o[4]; f32x16 negv; float mrun, lrun, nref; };
template <int KIMM, int VIMM>
DI void mla2_iter(f32x16& zin, float& rin, f32x16& zout, float& rout, M2State& st, const u32x4& pi0, const u32x4& pi1, u32x4& po0, u32x4& po1, const bf16x8 (&qf)[12], const unsigned (&koff)[4], const unsigned (&voff)[2][4],
                  const bool masked, const int qrh) {
#define M2_KF(d0) (*(LAS const bf16x8*)(koff[(d0) & 3] + (unsigned)(KIMM + 128 * ((d0) >> 2))))
#define M2_VF(t, j) vtr((lcp)(voff[t][(j) & 3] + (unsigned)(VIMM + 4096 * ((j) >> 2))))
    if (masked) {
        asm volatile("" ::: "memory");
#pragma unroll
        for (int g = 0; g < 16; ++g) if (crow(g, 0) > qrh) zin[g] = -INFINITY;
    }
    bf16x8 kfA = M2_KF(0), kfB; s16x4 la, ha, lb, hb;
    float mt = 0.f, mnew = 0.f, alpha = 1.f, ps = 0.f; bool grow = false; float pe[16];
    SBAR();
#pragma unroll
    for (int i = 0; i < 20; ++i) {
        const int c5 = i % 5, blk5 = i / 5; const bool isP = (c5 == 2 || c5 == 4);
        const int qi = blk5 * 3 + (c5 < 2 ? c5 : 2), pj = blk5 * 2 + (c5 == 2 ? 0 : 1);
        if (isP) { const s16x4 lo = (pj & 1) ? lb : la, hi = (pj & 1) ? hb : ha; const bf16x8 vf = (bf16x8){lo[0], lo[1], lo[2], lo[3], hi[0], hi[1], hi[2], hi[3]};
            st.o[pj & 3] = MFMA_BF16(vf, __builtin_bit_cast(bf16x8, (pj >> 2) ? pi1 : pi0), st.o[pj & 3]); }
        else if (i == 0) { f32x16 zero_;
#pragma unroll
            for (int g = 0; g < 16; ++g) zero_[g] = 0.f;
            (void)zero_; zout = MFMA_BF16(kfA, qf[0], st.negv); rout = st.nref; }
        else zout = MFMA_BF16((qi & 1) ? kfB : kfA, qf[qi], zout);
        if (!isP && qi + 1 < 12) { const bf16x8 nx = M2_KF(qi + 1); if ((qi + 1) & 1) kfB = nx; else kfA = nx; }
        if (isP && pj + 1 < 8) { const s16x4 l_ = M2_VF(0, pj + 1), h_ = M2_VF(1, pj + 1); if ((pj + 1) & 1) { lb = l_; hb = h_; } else { la = l_; ha = h_; } }
        if (i == 0) { la = M2_VF(0, 0); ha = M2_VF(1, 0); }
        SBAR();
        if (i < 4) { float a = vmax3_s(zin[4 * i], zin[4 * i + 1], zin[4 * i + 2]); mt = i == 0 ? vmax3_s(a, zin[3], zin[3]) : vmax3_s(mt, a, zin[4 * i + 3]); asm volatile("" : "+v"(mt)); }
        if (i == 4) { mt = swap_max(mt) + rin;
            grow = __builtin_amdgcn_ballot_w64((mt > st.mrun) || (rin != st.mrun)) != 0ull;
            if (grow) {
                mnew = fmaxf(st.mrun, mt); alpha = __builtin_amdgcn_exp2f(st.mrun - mnew); const float dl = mnew - rin;
#pragma unroll
                for (int g = 0; g < 16; ++g) zin[g] -= dl;
                st.mrun = mnew; st.lrun *= alpha; } }
        if (i >= 5 && i < 13) { const int g = 2 * (i - 5); float e0 = __builtin_amdgcn_exp2f(zin[g]), e1 = __builtin_amdgcn_exp2f(zin[g + 1]); ps += e0 + e1;
            asm volatile("" : "+v"(ps)); pe[g] = e0; pe[g + 1] = e1; }
        if (i >= 13 && i < 17) { const int w_ = i - 13; unsigned w0 = cvtpk(pe[4 * w_], pe[4 * w_ + 1]), w1 = cvtpk(pe[4 * w_ + 2], pe[4 * w_ + 3]); asm volatile("" : "+v"(w0), "+v"(w1));
            if (w_ < 2) { po0[2 * w_] = w0; po0[2 * w_ + 1] = w1; } else { po1[2 * (w_ - 2)] = w0; po1[2 * (w_ - 2) + 1] = w1; } }
        SBAR();
    }
    st.lrun += ps;
    if (grow) {
#pragma unroll
        for (int d0 = 0; d0 < 4; ++d0)
#pragma unroll
            for (int g = 0; g < 16; ++g) st.o[d0][g] *= alpha;
        st.nref = st.mrun;
#pragma unroll
        for (int g = 0; g < 16; ++g) st.negv[g] = -st.mrun;
    }
#undef M2_KF
#undef M2_VF
}
DI void mla2_unit(LAS unsigned char* lds, unsigned char* ws, int b, int h, int qb, const int tid_in) {
    int tid = tid_in; asm volatile("" : "+v"(tid));
    const int lane = tid & 63, wid = __builtin_amdgcn_readfirstlane(tid >> 6), r = lane & 31, hh = lane >> 5;
    const bf16_t *QN = (const bf16_t*)(ws + WS_QN), *QR = (const bf16_t*)(ws + WS_QR), *KN = (const bf16_t*)(ws + WS_KN), *KR = (const bf16_t*)(ws + WS_KR), *VA = (const bf16_t*)(ws + WS_VA), *SG = (const bf16_t*)(ws + WS_SG);
    bf16_t* MIX = (bf16_t*)(ws + WS_MIX);
    const int q0 = qb * 256, NT = 4 * (qb + 1), tmax = (q0 + 32 * wid) >> 6; const size_t rowbase = (size_t)b * SEQ;
    bf16x8 qf[12];
    { const size_t qrow = rowbase + q0 + 32 * wid + r;
#pragma unroll
      for (int d0 = 0; d0 < 8; ++d0) qf[d0] = *(const bf16x8*)(QN + qrow * 1024 + h * 128 + d0 * 16 + hh * 8);
#pragma unroll
      for (int d0 = 0; d0 < 4; ++d0) qf[8 + d0] = *(const bf16x8*)(QR + qrow * 512 + h * 64 + d0 * 16 + hh * 8); }
    M2State st;
#pragma unroll
    for (int d0 = 0; d0 < 4; ++d0)
#pragma unroll
        for (int g = 0; g < 16; ++g) st.o[d0][g] = 0.f;
    st.mrun = -INFINITY; st.lrun = 0.f; st.nref = 0.f;
#pragma unroll
    for (int g = 0; g < 16; ++g) st.negv[g] = 0.f;
    float ra = 0.f, rb = 0.f;
    unsigned koff[4], voff[2][4];
    { const unsigned blk = (lane >> 4) & 1, qq = (lane & 15) >> 2, p = lane & 3, f = (r >> 1) & 7;
      const unsigned kb_ = (unsigned)(size_t)lds + r * 384;
#pragma unroll
      for (int j = 0; j < 4; ++j) koff[j] = kb_ + 16 * ((2 * j + hh) ^ f);
      const unsigned vb0 = 256 * (4 * hh + qq) + 8 * (p & 1) + 16 * ((2 * blk + (p >> 1)) ^ hh), v0_ = (unsigned)(size_t)lds + M2_LDS_V + vb0, v1_ = (unsigned)(size_t)lds + M2_LDS_V + 2048 + (vb0 ^ 32);
#pragma unroll
      for (int d0 = 0; d0 < 4; ++d0) { voff[0][d0] = v0_ + ((64u * d0) ^ (64u * qq)); voff[1][d0] = v1_ + ((64u * d0) ^ (64u * qq)); } }
    const bf16_t* knb = KN + rowbase * 1024 + h * 128; const bf16_t* krb = KR + rowbase * 64; const bf16_t* vab = VA + rowbase * 1024 + h * 128;
    unsigned ksrc[3];
#pragma unroll
    for (int i_ = 0; i_ < 3; ++i_) { const int c_ = (3 * wid + i_) * 64 + lane, row_ = c_ / 24, ch_ = (c_ % 24) ^ ((row_ >> 1) & 7);
        ksrc[i_] = ch_ < 16 ? (unsigned)(row_ * 1024 + ch_ * 8) : (0x80000000u | (unsigned)(row_ * 64 + (ch_ - 16) * 8)); }
#define M2_DMAK(t, slot) do { _Pragma("unroll") for (int i_ = 0; i_ < 3; ++i_) { const unsigned o_ = ksrc[i_] & 0x7fffffffu; \
            const bf16_t* src_ = (ksrc[i_] >> 31) ? krb + (size_t)(t) * (64 * 64) + o_ : knb + (size_t)(t) * (64 * 1024) + o_; \
            __builtin_amdgcn_global_load_lds((const unsigned*)src_, (LAS unsigned*)(lds + (slot) * M2_KBUF + (3 * wid + i_) * 1024), 16, 0, 0); } } while (0)
#define M2_DMAV(t, slot) do { int t2_ = tid; asm volatile("" : "+v"(t2_)); const int ln_ = t2_ & 63, drow_ = 8 * wid + (ln_ >> 4), c15_ = ln_ & 15; \
        const unsigned s0_ = (unsigned)drow_ * 1024 + ((c15_ ^ (((drow_ & 3) << 2) | ((drow_ >> 2) & 3))) * 8), s1_ = (unsigned)(drow_ + 4) * 1024 + ((c15_ ^ ((((drow_ + 4) & 3) << 2) | (((drow_ + 4) >> 2) & 3))) * 8); \
        const bf16_t* vt = vab + (size_t)(t) * (64 * 1024); LAS unsigned char* vd = lds + M2_LDS_V + (slot) * VBUF + wid * 2048; \
        __builtin_amdgcn_global_load_lds((const unsigned*)(vt + s0_), (LAS unsigned*)vd, 16, 0, 0); __builtin_amdgcn_global_load_lds((const unsigned*)(vt + s1_), (LAS unsigned*)(vd + 1024), 16, 0, 0); } while (0)
    M2_DMAK(0, 0); M2_DMAV(0, 0); M2_DMAV(0, 2);
    if (NT > 1) M2_DMAK(1, 1);
    __builtin_amdgcn_s_waitcnt(0x0F70);
    __syncthreads();
    f32x16 za, zb;
#pragma unroll
    for (int g = 0; g < 16; ++g) { za[g] = 0.f; zb[g] = 0.f; }
#pragma unroll
    for (int d0 = 0; d0 < 12; ++d0) za = MFMA_BF16(*(LAS const bf16x8*)(koff[d0 & 3] + (unsigned)(128 * (d0 >> 2))), qf[d0], za);
    u32x4 pa[2], pb[2]; pa[0] = (u32x4){0u, 0u, 0u, 0u}; pa[1] = pa[0]; pb[0] = pa[0]; pb[1] = pa[0];
#define M2_INTERVAL(P) { if (t + 2 < NT) M2_DMAK(t + 2, ((P) + 2) % 3); if (t + 1 < NT) M2_DMAV(t + 1, ((P) + 1) % 3); \
        if (t <= tmax) {           \
            int qrh; { int t3 = tid; asm volatile("" : "+v"(t3)); qrh = q0 + 32 * wid + (t3 & 31) - 4 * ((t3 >> 5) & 1) - 64 * t; } const bool msk = t == tmax; \
            mla2_iter<(P) * M2_KBUF + 32 * 384, (((P) + 2) % 3) * VBUF + 8192>(za, ra, zb, rb, st, pa[0], pa[1], pb[0], pb[1], qf, koff, voff, msk, qrh); \
            mla2_iter<(((P) + 1) % 3) * M2_KBUF, (P) * VBUF>(zb, rb, za, ra, st, pb[0], pb[1], pa[0], pa[1], qf, koff, voff, msk, qrh - 32); \
            if (msk) {            \
                lcp vb_ = lds + M2_LDS_V + (P) * VBUF + 8192; const VAddr va_ = make_vaddr(tid & 63); \
                _Pragma("unroll") for (int j = 0; j < 8; ++j) st.o[j & 3] = MFMA_BF16(vfrag(vb_, j >> 2, j & 3, va_), __builtin_bit_cast(bf16x8, (j >> 2) ? pa[1] : pa[0]), st.o[j & 3]); } } \
        ++t; __syncthreads(); }
    int t = 0;
    for (;;) { M2_INTERVAL(0) if (t >= NT) break; M2_INTERVAL(1) if (t >= NT) break; M2_INTERVAL(2) if (t >= NT) break; }
#undef M2_INTERVAL
#undef M2_DMAK
#undef M2_DMAV
    const float inv = 1.0f / swap_sum(st.lrun);
    int t4 = tid; asm volatile("" : "+v"(t4)); const size_t qrow = rowbase + q0 + 32 * wid + (t4 & 31); const int hh2 = (t4 >> 5) & 1;
#pragma unroll
    for (int d0 = 0; d0 < 4; ++d0)
#pragma unroll
        for (int p = 0; p < 2; ++p) { const size_t off = qrow * 2048 + h * 128 + 32 * d0 + 16 * p + 8 * hh2; float e[8]; o_pair8(st.o[d0], p, e);
            const u32x4 sg = *(const u32x4*)(SG + off); u32x4 w;
#pragma unroll
            for (int j = 0; j < 4; ++j) w[j] = cvtpk(e[2 * j] * inv * __uint_as_float(sg[j] << 16), e[2 * j + 1] * inv * __uint_as_float(sg[j] & 0xffff0000u));
            *(u32x4*)(MIX + off) = w; }
}
DI void mla_phase(LAS unsigned char* lds, unsigned char* ws, const int tid) {
    const int G = gridDim.x, bx = blockIdx.x; const int vcu = (G % 8 == 0) ? (bx % 8) * (G / 8) + bx / 8 : bx;
    for (int p = vcu; p < 256; p += G) { const int bh = p >> 3, pr = p & 7;
#if MLA_PIPE
        mla2_unit(lds, ws, bh >> 3, bh & 7, 15 - pr, tid); mla2_unit(lds, ws, bh >> 3, bh & 7, pr, tid);
#else
        mla_unit(lds, ws, bh >> 3, bh & 7, 15 - pr, tid); mla_unit(lds, ws, bh >> 3, bh & 7, pr, tid);
#endif
 }
}

constexpr int SB_KBUF = 16384, SB_LDS_V = 3 * SB_KBUF, SB_LDS_UM = SB_LDS_V + 3 * VBUF, SB_LDS_BYTES = SB_LDS_UM + 2048 + 64;
DI float vmin_s(float a, float b) { float r; asm("v_min_f32 %0, %1, %2" : "=v"(r) : "v"(a), "v"(b)); return r; }
struct SbAddr { unsigned kx, vb0, vq; };
template <bool MASKED, int VAR>
DI void sb_iter(f32x16& zin, f32x16& zout, f32x16 (&o)[4], const u32x4& pi0, const u32x4& pi1, u32x4& po0, u32x4& po1, float& carry, const bf16x8 (&qf)[8], lcp ump, lcp knext, lcp vprev, const SbAddr& ad, int qrh) {
    u32x4 lw0, lw1; const float z0 = zin[0];
    unsigned kx = ad.kx, vq = ad.vq; asm volatile("" : "+v"(kx), "+v"(vq));
    bf16x8 kfa = *(LAS const bf16x8*)(knext + kx), kfb;
#pragma unroll
    for (int k = 0; k < 8; ++k) {
        if (k == 0) {
#pragma unroll
            for (int g = 0; g < 16; ++g) zout[g] = 0.f;
        }
        if (VAR == 2 || VAR == 4 || VAR == 11 || VAR == 13) { asm volatile("" :: "v"((k & 1) ? kfb : kfa)); } else zout = MFMA_BF16((k & 1) ? kfb : kfa, qf[k], zout);
        if (VAR == 12) { zout = MFMA_BF16((k & 1) ? kfb : kfa, qf[k], zout); zout = MFMA_BF16((k & 1) ? kfb : kfa, qf[k], zout); }
        if (k + 1 < 8) { bf16x8 nx; if (VAR == 3 || VAR == 4 || VAR == 9 || VAR == 11 || VAR == 12 || VAR == 13) nx = qf[k]; else nx = *(LAS const bf16x8*)(knext + ((32u * (k + 1)) ^ kx)); if (k & 1) kfa = nx; else kfb = nx; }
        SBAR();
        float lv[2];
#pragma unroll
        for (int i = 0; i < 2; ++i) { const int g = 2 * k + i;
            float sp; if (VAR == 8 || VAR == 9 || VAR == 12) sp = zin[g]; else if (VAR == 13) { sp = __builtin_amdgcn_logf(1.0f + __builtin_amdgcn_exp2f(vmin_s(zin[g], 64.0f))); sp = __builtin_amdgcn_logf(1.0f + __builtin_amdgcn_exp2f(vmin_s(sp, 64.0f))); sp = __builtin_amdgcn_logf(1.0f + __builtin_amdgcn_exp2f(vmin_s(sp, 64.0f))); } else if (VAR == 1 || VAR == 4) sp = vmin_s(zin[g], 64.0f) * 0.5f; else sp = __builtin_amdgcn_logf(1.0f + __builtin_amdgcn_exp2f(vmin_s(zin[g], 64.0f)));
            if (MASKED) lv[i] = (crow(g, 0) < qrh) ? sp : 0.f; else lv[i] = sp; }
        unsigned w = cvtpk_h(lv[0], lv[1]);
        asm volatile("" : "+v"(w));
        if (k < 4) lw0[k & 3] = w; else lw1[k & 3] = w;
        SBAR();
    }
    const f16x8 um0 = *(LAS const f16x8*)ump, um1 = *(LAS const f16x8*)(ump + 16);
    zin = MFMA_F16(um0, __builtin_bit_cast(f16x8, lw0), zin); zin = MFMA_F16(um1, __builtin_bit_cast(f16x8, lw1), zin);
    SBAR();
    s16x4 la, ha, lb, hb;
    const unsigned vb0 = ad.vb0, vb1 = 2048 + (vb0 ^ 32);
    { const unsigned dq = vq; la = vtr(vprev + vb0 + dq); ha = vtr(vprev + vb1 + dq); }
#pragma unroll
    for (int j = 0; j < 8; ++j) {
        { const s16x4 lo = (j & 1) ? lb : la, hi = (j & 1) ? hb : ha;
          const bf16x8 vf = (bf16x8){lo[0], lo[1], lo[2], lo[3], hi[0], hi[1], hi[2], hi[3]};
          if (VAR == 2 || VAR == 4 || VAR == 11 || VAR == 13) { asm volatile("" :: "v"(vf)); } else o[j & 3] = MFMA_BF16(vf, __builtin_bit_cast(bf16x8, (j >> 2) ? pi1 : pi0), o[j & 3]);
          if (VAR == 12) { o[(j + 1) & 3] = MFMA_BF16(vf, __builtin_bit_cast(bf16x8, (j >> 2) ? pi1 : pi0), o[(j + 1) & 3]); o[(j + 2) & 3] = MFMA_BF16(vf, __builtin_bit_cast(bf16x8, (j >> 2) ? pi1 : pi0), o[(j + 2) & 3]); } }
        if (j + 1 < 8) { const unsigned dq = (64u * ((j + 1) & 3)) ^ vq; s16x4 l_, h_; if (VAR == 3 || VAR == 4 || VAR == 9 || VAR == 11 || VAR == 12 || VAR == 13) { l_ = (s16x4){(short)pi0[0], (short)pi0[1], (short)pi0[2], (short)pi0[3]}; h_ = l_; } else { l_ = vtr(vprev + 4096 * ((j + 1) >> 2) + vb0 + dq); h_ = vtr(vprev + 4096 * ((j + 1) >> 2) + vb1 + dq); }
            if (j & 1) { la = l_; ha = h_; } else { lb = l_; hb = h_; } }
        SBAR();
        float av[2];
#pragma unroll
        for (int i = 0; i < 2; ++i) { const int g = 2 * j + i; float a; if (VAR == 8 || VAR == 9 || VAR == 12) a = zin[g]; else if (VAR == 13) { a = __builtin_amdgcn_exp2f(zin[g] + carry); a = __builtin_amdgcn_exp2f(a + carry); a = __builtin_amdgcn_exp2f(a + carry); } else if (VAR == 1 || VAR == 4) a = zin[g] + carry; else a = __builtin_amdgcn_exp2f(zin[g] + carry); if (MASKED) av[i] = (crow(g, 0) < qrh) ? a : 0.f; else av[i] = a; }
        unsigned w = cvtpk(av[0], av[1]);
        asm volatile("" : "+v"(w));
        if (j < 4) po0[j & 3] = w; else po1[j & 3] = w;
        SBAR();
    }
    carry += bcast_lo(zin[0] - z0);
}
template <int KIMM, int VIMM>
DI void sb_iter_s(f32x16& zin, f32x16& zout, f32x16 (&o)[4], const u32x4& pi0, const u32x4& pi1, u32x4& po0, u32x4& po1, float& carry, const bf16x8 (&qf)[8], lcp ump,
                  const unsigned (&koff)[8], const unsigned (&voff)[2][4]) {
    u32x4 lw0, lw1; const float z0 = zin[0];
#define SB_KF(k) (*(LAS const bf16x8*)(koff[k] + (unsigned)KIMM))
#define SB_VF(t, j) vtr((lcp)(voff[t][(j) & 3] + (unsigned)(VIMM + 4096 * ((j) >> 2))))
    bf16x8 kfa = SB_KF(0), kfb;
    const f16x8 um0 = *(LAS const f16x8*)ump, um1 = *(LAS const f16x8*)(ump + 16);
    SBAR();
#pragma unroll
    for (int k = 0; k < 8; ++k) {
        if (k == 0) {
#pragma unroll
            for (int g = 0; g < 16; ++g) zout[g] = 0.f;
        }
        zout = MFMA_BF16((k & 1) ? kfb : kfa, qf[k], zout);
        if (k + 1 < 8) { const bf16x8 nx = SB_KF(k + 1); if (k & 1) kfa = nx; else kfb = nx; }
        SBAR();
        float lv[2];
#pragma unroll
        for (int i = 0; i < 2; ++i) lv[i] = __builtin_amdgcn_logf(1.0f + __builtin_amdgcn_exp2f(vmin_s(zin[2 * k + i], 64.0f)));
        unsigned w = cvtpk_h(lv[0], lv[1]);
        asm volatile("" : "+v"(w));
        if (k < 4) lw0[k & 3] = w; else lw1[k & 3] = w;
        SBAR();
    }
    s16x4 la = SB_VF(0, 0), ha = SB_VF(1, 0), lb, hb;
    SBAR();
    zin = MFMA_F16(um0, __builtin_bit_cast(f16x8, lw0), zin); zin = MFMA_F16(um1, __builtin_bit_cast(f16x8, lw1), zin);
    SBAR();
#pragma unroll
    for (int j = 0; j < 8; ++j) {
        { const s16x4 lo = (j & 1) ? lb : la, hi = (j & 1) ? hb : ha;
          const bf16x8 vf = (bf16x8){lo[0], lo[1], lo[2], lo[3], hi[0], hi[1], hi[2], hi[3]};
          o[j & 3] = MFMA_BF16(vf, __builtin_bit_cast(bf16x8, (j >> 2) ? pi1 : pi0), o[j & 3]); }
        if (j + 1 < 8) { const s16x4 l_ = SB_VF(0, j + 1), h_ = SB_VF(1, j + 1); if (j & 1) { la = l_; ha = h_; } else { lb = l_; hb = h_; } }
        SBAR();
        float av[2];
#pragma unroll
        for (int i = 0; i < 2; ++i) av[i] = __builtin_amdgcn_exp2f(zin[2 * j + i] + carry);
        unsigned w = cvtpk(av[0], av[1]);
        asm volatile("" : "+v"(w));
        if (j < 4) po0[j & 3] = w; else po1[j & 3] = w;
        SBAR();
    }
#undef SB_KF
#undef SB_VF
    carry += bcast_lo(zin[0] - z0);
}
template <int P>
DI void sb_tile_s(f32x16& za, f32x16& zb, f32x16 (&o)[4], u32x4 (&pa)[2], u32x4 (&pb)[2], float& carry, const bf16x8 (&qf)[8], lcp ump, const unsigned (&koff)[8], const unsigned (&voff)[2][4]) {
    constexpr int KS = P, KSN = (P + 1) % 3, VS = P, VSP = (P + 2) % 3;
    sb_iter_s<KS * SB_KBUF, VSP * VBUF>(za, zb, o, pa[0], pa[1], pb[0], pb[1], carry, qf, ump, koff, voff);
    sb_iter_s<KSN * SB_KBUF + 8192, VS * VBUF + 8192>(zb, za, o, pb[0], pb[1], pa[0], pa[1], carry, qf, ump, koff, voff);
}
template <bool MASKED, int VAR>
DI void sb_tile(LAS unsigned char* lds, f32x16& za, f32x16& zb, f32x16 (&o)[4], u32x4 (&pa)[2], u32x4 (&pb)[2], float& carry, const bf16x8 (&qf)[8], lcp ump, const SbAddr& ad,
                unsigned krow_off, int ks, int ksn, int vs, int vsp, int qrh0) {
    sb_iter<MASKED, VAR>(za, zb, o, pa[0], pa[1], pb[0], pb[1], carry, qf, ump, lds + ks * SB_KBUF + krow_off, lds + SB_LDS_V + vsp * VBUF, ad, qrh0 - 32);
    sb_iter<MASKED, VAR>(zb, za, o, pb[0], pb[1], pa[0], pa[1], carry, qf, ump, lds + ksn * SB_KBUF + 8192 + krow_off, lds + SB_LDS_V + vs * VBUF + 8192, ad, qrh0);
}
template <int VAR> DI void sb_unit(LAS unsigned char* lds, unsigned char* ws, int b, int h, int qb, const int tid_in) {
    int tid = tid_in; asm volatile("" : "+v"(tid));
    const int lane = tid & 63, wid = __builtin_amdgcn_readfirstlane(tid >> 6), r = lane & 31, hh = lane >> 5;
    const bf16_t *Q2 = (const bf16_t*)(ws + WS_Q2), *K2 = (const bf16_t*)(ws + WS_K2), *V2 = (const bf16_t*)(ws + WS_V2), *SG2 = (const bf16_t*)(ws + WS_SG2);
    bf16_t* MIX2 = (bf16_t*)(ws + (VAR ? WS_A : WS_MIX2));
    const int q0 = qb * 256, NT = 4 * (qb + 1), tmax = (q0 + 32 * wid) >> 6; const size_t rowbase = (size_t)b * SEQ;
    bf16x8 qf[8];
    { const size_t qrow = rowbase + q0 + 32 * wid + r;
#pragma unroll
      for (int d0 = 0; d0 < 8; ++d0) qf[d0] = *(const bf16x8*)(Q2 + qrow * 2048 + h * 128 + d0 * 16 + hh * 8); }
    { f16x8 um[2];
#pragma unroll
      for (int s = 0; s < 2; ++s)
#pragma unroll
          for (int j = 0; j < 8; ++j) um[s][j] = (16 * s + 8 * (j >> 2) + 4 * hh + (j & 3)) >= r ? (_Float16)-1.0f : (_Float16)0.0f;
      *(LAS f16x8*)(lds + SB_LDS_UM + lane * 32) = um[0]; *(LAS f16x8*)(lds + SB_LDS_UM + lane * 32 + 16) = um[1]; }
    lcp ump = lds + SB_LDS_UM + lane * 32;
    f32x16 o[4];
#pragma unroll
    for (int d0 = 0; d0 < 4; ++d0)
#pragma unroll
        for (int g = 0; g < 16; ++g) o[d0][g] = 0.f;
    float carry = 0.f;
    SbAddr ad;
    { const unsigned blk = (lane >> 4) & 1, qq = (lane & 15) >> 2, p = lane & 3;
      ad.kx = ((r & 15) >> 1) << 5;
      ad.vb0 = 256 * (4 * hh + qq) + 8 * (p & 1) + 16 * ((2 * blk + (p >> 1)) ^ hh); ad.vq = 64 * qq; }
    const unsigned krow_off = r * 256 + ((hh ^ (r & 1)) << 4);
    const bf16_t* kbase = K2 + rowbase * 2048 + h * 128; const bf16_t* vbase = V2 + rowbase * 2048 + h * 128;
#define SB_DMA_SRC() int t2_ = tid; asm volatile("" : "+v"(t2_)); const int ln_ = t2_ & 63, drow_ = 8 * wid + (ln_ >> 4), c15_ = ln_ & 15;
#define SB_DMAK(tau, slot) do { SB_DMA_SRC(); const unsigned s0_ = (unsigned)drow_ * 2048 + ((c15_ ^ (drow_ & 15)) * 8), s1_ = (unsigned)(drow_ + 4) * 2048 + ((c15_ ^ ((drow_ + 4) & 15)) * 8); \
        const bf16_t* kt = kbase + (size_t)(NT - 1 - (tau)) * (64 * 2048); LAS unsigned char* kd = lds + (slot) * SB_KBUF + wid * 2048; \
        __builtin_amdgcn_global_load_lds((const unsigned*)(kt + s0_), (LAS unsigned*)kd, 16, 0, 0); __builtin_amdgcn_global_load_lds((const unsigned*)(kt + s1_), (LAS unsigned*)(kd + 1024), 16, 0, 0); } while (0)
#define SB_DMAV(tau, slot) do { SB_DMA_SRC(); const unsigned s0_ = (unsigned)drow_ * 2048 + ((c15_ ^ (((drow_ & 3) << 2) | ((drow_ >> 2) & 3))) * 8), s1_ = (unsigned)(drow_ + 4) * 2048 + ((c15_ ^ ((((drow_ + 4) & 3) << 2) | (((drow_ + 4) >> 2) & 3))) * 8); \
        const bf16_t* vt = vbase + (size_t)(NT - 1 - (tau)) * (64 * 2048); LAS unsigned char* vd = lds + SB_LDS_V + (slot) * VBUF + wid * 2048; \
        __builtin_amdgcn_global_load_lds((const unsigned*)(vt + s0_), (LAS unsigned*)vd, 16, 0, 0); __builtin_amdgcn_global_load_lds((const unsigned*)(vt + s1_), (LAS unsigned*)(vd + 1024), 16, 0, 0); } while (0)
    SB_DMAK(0, 0); SB_DMAV(0, 0);
    if (NT > 1) SB_DMAK(1, 1);
    __builtin_amdgcn_s_waitcnt(0x0F70);
    __syncthreads();
    f32x16 za, zb;
#pragma unroll
    for (int g = 0; g < 16; ++g) { za[g] = 0.f; zb[g] = 0.f; }
    u32x4 pa[2], pb[2]; pa[0] = (u32x4){0u, 0u, 0u, 0u}; pa[1] = pa[0]; pb[0] = pa[0]; pb[1] = pa[0];
    int ks = 0, ks1 = 1, vs = 0, vsp = 0;
    const int nmask = NT - tmax;
    constexpr float SB_STOP = -140.0f;
    LAS unsigned* flg = (LAS unsigned*)(lds + SB_LDS_UM + 2048);
    bool wdone = false, alldone = false; int par = 0, lim = NT;
#define SB_CLOSE() { wdone = wdone | (__builtin_amdgcn_ballot_w64(carry > SB_STOP) == 0ull); lim = wdone ? (lim < tau + 1 ? lim : tau + 1) : lim;        \
        { int t5 = tid; asm volatile("" : "+v"(t5)); if ((t5 & 63) == 0) flg[par * 8 + wid] = wdone ? 1u : 0u; } \
        __syncthreads();                            \
        { const u32x4 f0 = *(LAS const u32x4*)(flg + par * 8), f1 = *(LAS const u32x4*)(flg + par * 8 + 4); \
          alldone = __builtin_amdgcn_readfirstlane((int)(f0[0] & f0[1] & f0[2] & f0[3] & f1[0] & f1[1] & f1[2] & f1[3])) != 0; } par ^= 1; }
#define SB_INTERVAL(MASKED) { const int t = NT - 1 - tau; const int ks2 = (ks1 == 2) ? 0 : ks1 + 1, vs1 = (vs == 2) ? 0 : vs + 1; \
        if (tau + 2 < NT) SB_DMAK(tau + 2, ks2); \
        if (tau + 1 < NT) SB_DMAV(tau + 1, vs1); \
        int qrh0; { int t3 = tid; asm volatile("" : "+v"(t3)); qrh0 = q0 + 32 * wid + (t3 & 31) - 4 * ((t3 >> 5) & 1) - 64 * t; }        \
        sb_tile<MASKED, VAR>(lds, za, zb, o, pa, pb, carry, qf, ump, ad, krow_off, ks, (tau + 1 < NT ? ks1 : ks), vs, vsp, qrh0); \
        SB_CLOSE() \
        ks = ks1; ks1 = ks2; vsp = vs; vs = vs1; }
    int tau = 0;
    for (; tau < nmask - 1 && !alldone; ++tau) { const int ks2 = (ks1 == 2) ? 0 : ks1 + 1, vs1 = (vs == 2) ? 0 : vs + 1;
        if (tau + 2 < NT) SB_DMAK(tau + 2, ks2);
        if (tau + 1 < NT) SB_DMAV(tau + 1, vs1);
        SB_CLOSE()
        ks = ks1; ks1 = ks2; vsp = vs; vs = vs1; }
    { lcp kp = lds + ks * SB_KBUF + 8192 + krow_off;
#pragma unroll
      for (int k = 0; k < 8; ++k) za = MFMA_BF16(*(LAS const bf16x8*)(kp + ((32u * k) ^ ad.kx)), qf[k], za); }
    for (; tau < nmask && tau < lim; ++tau) SB_INTERVAL(true)
    for (; tau < lim; ++tau) SB_INTERVAL(false)
#undef SB_INTERVAL
    { lcp vp = lds + SB_LDS_V + vsp * VBUF;
#pragma unroll
      for (int j = 0; j < 8; ++j) { const unsigned dq = (64u * (j & 3)) ^ ad.vq;
          const s16x4 lo = vtr(vp + 4096 * (j >> 2) + ad.vb0 + dq), hi = vtr(vp + 4096 * (j >> 2) + 2048 + (ad.vb0 ^ 32) + dq);
          o[j & 3] = MFMA_BF16(((bf16x8){lo[0], lo[1], lo[2], lo[3], hi[0], hi[1], hi[2], hi[3]}), __builtin_bit_cast(bf16x8, (j >> 2) ? pa[1] : pa[0]), o[j & 3]); } }
    for (; tau < NT && !alldone; ++tau) { const int ks2 = (ks1 == 2) ? 0 : ks1 + 1, vs1 = (vs == 2) ? 0 : vs + 1;
        if (tau + 2 < NT) SB_DMAK(tau + 2, ks2);
        if (tau + 1 < NT) SB_DMAV(tau + 1, vs1);
        SB_CLOSE()
        ks = ks1; ks1 = ks2; vsp = vs; vs = vs1; }
#undef SB_CLOSE
    __syncthreads();
#undef SB_DMAK
#undef SB_DMAV
#undef SB_DMA_SRC
    int t4 = tid; asm volatile("" : "+v"(t4)); const size_t qrow = rowbase + q0 + 32 * wid + (t4 & 31); const int hh2 = (t4 >> 5) & 1;
#pragma unroll
    for (int d0 = 0; d0 < 4; ++d0)
#pragma unroll
        for (int p = 0; p < 2; ++p) { const size_t off = qrow * 2048 + h * 128 + 32 * d0 + 16 * p + 8 * hh2; float e[8]; o_pair8(o[d0], p, e);
            const u32x4 sg = *(const u32x4*)(SG2 + off); u32x4 w;
#pragma unroll
            for (int j = 0; j < 4; ++j) w[j] = cvtpk(e[2 * j] * __uint_as_float(sg[j] << 16), e[2 * j + 1] * __uint_as_float(sg[j] & 0xffff0000u));
            *(u32x4*)(MIX2 + off) = w; }
}
template <int VAR> DI void sb_phase(LAS unsigned char* lds, unsigned char* ws, const int tid) {
    const int G = gridDim.x, bx = blockIdx.x; const int vcu = (G % 8 == 0) ? (bx % 8) * (G / 8) + bx / 8 : bx;
    for (int p = vcu; p < 512; p += G) { const int bh = p >> 3, pr = p & 7; sb_unit<VAR>(lds, ws, bh >> 4, bh & 15, 15 - pr, tid); sb_unit<VAR>(lds, ws, bh >> 4, bh & 15, pr, tid); }
}

constexpr int DIL_KSTR = 272, DIL_WAVE_BYTES = 32 * DIL_KSTR + 8192, DIL_LDS_BYTES = 8 * DIL_WAVE_BYTES;
DI void softmax_blk(f32x16& s0, f32x16 (&o)[4], float& mrun, float& lrun) {
    float mt = s0[0];
#pragma unroll
    for (int g = 1; g < 16; ++g) mt = fmaxf(mt, s0[g]);
    mt = swap_max(mt);
    if (__builtin_amdgcn_ballot_w64(mt > mrun) != 0ull) {
        const float mn = fmaxf(mrun, mt), alpha = __builtin_amdgcn_exp2f(mrun - mn); mrun = mn; lrun *= alpha;
#pragma unroll
        for (int d0 = 0; d0 < 4; ++d0)
#pragma unroll
            for (int g = 0; g < 16; ++g) o[d0][g] *= alpha;
    }
    float ps = 0.f;
#pragma unroll
    for (int g = 0; g < 16; ++g) { s0[g] = __builtin_amdgcn_exp2f(s0[g] - mrun); ps += s0[g]; }
    lrun += ps;
}
DI void dil_wave_unit(LAS unsigned char* wl, unsigned char* ws, int p, int b, int h, int res, int m0w, const int tid_in) {
    int tid = tid_in; asm volatile("" : "+v"(tid));
    const int lane = tid & 63, r = lane & 31, hh = lane >> 5; const int dil = p == 0 ? 1 : p == 1 ? 4 : 16;
    const bf16_t *QB = (const bf16_t*)(ws + WS_QB), *KB = (const bf16_t*)(ws + WS_KB), *VB = (const bf16_t*)(ws + WS_VB);
    const size_t rowbase = (size_t)b * SEQ; const size_t qrow = rowbase + (size_t)(m0w + r) * dil + res;
    const __amdgpu_buffer_rsrc_t rK = mk_rsrc(KB, M * 1024 * 2), rV = mk_rsrc(VB, M * 1024 * 2);
    const unsigned vo = (unsigned)(lane >> 4) * dil * 2048 + (lane & 15) * 16;
    const unsigned so0 = (unsigned)((rowbase + res) * 1024 + h * 128) * 2;
    const float* biasc = (const float*)(ws + WS_BIASC) + (size_t)(p * 8 + h) * 5 * 1024 + lane * 16;
    u32x4 kr[8], vr[8]; f32x4 br[4];
    const int kb0 = m0w >> 5;
#define DIL_LOAD(di) do { const unsigned sb_ = so0 + (unsigned)(32 * (kb0 - (di))) * dil * 2048; \
        _Pragma("unroll") for (int i = 0; i < 8; ++i) { kr[i] = bload(rK, vo + (unsigned)(4 * i) * dil * 2048, sb_); vr[i] = bload(rV, vo + (unsigned)(4 * i) * dil * 2048, sb_); } \
        _Pragma("unroll") for (int j = 0; j < 4; ++j) br[j] = ((const f32x4*)(biasc + (di) * 1024))[j]; } while (0)
    DIL_LOAD(0);
    bf16x8 qf[8];
#pragma unroll
    for (int d0 = 0; d0 < 8; ++d0) qf[d0] = *(const bf16x8*)(QB + qrow * 1024 + h * 128 + d0 * 16 + hh * 8);
    f32x16 o[4];
#pragma unroll
    for (int d0 = 0; d0 < 4; ++d0)
#pragma unroll
        for (int g = 0; g < 16; ++g) o[d0][g] = 0.f;
    float mrun = -INFINITY, lrun = 0.f;
    const VAddr va = make_vaddr(lane);
    const unsigned lk = (lane >> 4) * DIL_KSTR + (lane & 15) * 16;
    for (int di = 0; di < 5; ++di) {
        if (kb0 - di < 0) break;
        asm volatile("s_waitcnt lgkmcnt(0)" ::: "memory");
#pragma unroll
        for (int i = 0; i < 8; ++i) { *(LAS u32x4*)(wl + lk + 4 * i * DIL_KSTR) = kr[i]; *(LAS u32x4*)(wl + 32 * DIL_KSTR + off_b((lane >> 4) + 4 * i, lane & 15)) = vr[i]; }
        f32x16 s0;
#pragma unroll
        for (int j = 0; j < 4; ++j) { s0[4 * j] = br[j][0]; s0[4 * j + 1] = br[j][1]; s0[4 * j + 2] = br[j][2]; s0[4 * j + 3] = br[j][3]; }
        if (di + 1 < 5 && kb0 - (di + 1) >= 0) DIL_LOAD(di + 1);
        asm volatile("s_waitcnt lgkmcnt(0)" ::: "memory");
        lcp kp = wl + r * DIL_KSTR + hh * 16;
#pragma unroll
        for (int d0 = 0; d0 < 8; ++d0) s0 = MFMA_BF16(*(LAS const bf16x8*)(kp + d0 * 32), qf[d0], s0);
        softmax_blk(s0, o, mrun, lrun);
        lcp vb = wl + 32 * DIL_KSTR;
#pragma unroll
        for (int s = 0; s < 2; ++s) { const bf16x8 pf = pack_bf(s0, s);
#pragma unroll
            for (int d0 = 0; d0 < 4; ++d0) o[d0] = MFMA_BF16(vfrag(vb, s, d0, va), pf, o[d0]); }
    }
#undef DIL_LOAD
    const float lt = swap_sum(lrun), inv = 1.0f / lt;
    bf16_t* OP = (bf16_t*)(ws + (p == 0 ? WS_OP0 : p == 1 ? WS_OP1 : WS_OP2));
#pragma unroll
    for (int d0 = 0; d0 < 4; ++d0)
#pragma unroll
        for (int gg = 0; gg < 4; ++gg) { const size_t off = qrow * 1024 + h * 128 + 32 * d0 + 8 * gg + 4 * hh;
            const unsigned lo = cvtpk(o[d0][4 * gg] * inv, o[d0][4 * gg + 1] * inv), hi = cvtpk(o[d0][4 * gg + 2] * inv, o[d0][4 * gg + 3] * inv);
            *(unsigned long long*)(OP + off) = (unsigned long long)lo | ((unsigned long long)hi << 32); }
    if (hh == 0) ((float*)(ws + WS_LSE))[((size_t)p * M + qrow) * 8 + h] = mrun + __builtin_amdgcn_logf(lt);
}
constexpr int DILW_LDS_BYTES = 12 * 8192;
DI void dil_wg_unit(LAS unsigned char* lds, unsigned char* ws, int p, int b, int h, int res, int m0, const int tid_in) {
    int tid = tid_in; asm volatile("" : "+v"(tid));
    const int lane = tid & 63, wid = __builtin_amdgcn_readfirstlane(tid >> 6), r = lane & 31, hh = lane >> 5; const int dil = p == 0 ? 1 : p == 1 ? 4 : 16;
    const bf16_t *QB = (const bf16_t*)(ws + WS_QB), *KB = (const bf16_t*)(ws + WS_KB), *VB = (const bf16_t*)(ws + WS_VB);
    const size_t rowbase = (size_t)b * SEQ; const size_t qrow = rowbase + (size_t)(m0 + 32 * wid + r) * dil + res;
    const int kbw = (m0 >> 5) - 4;
    const int prow = 4 * wid + (lane >> 4);
    const unsigned ksw = ((lane & 15) ^ (prow & 15)) * 8, vsw = ((lane & 15) ^ (((prow & 3) << 2) | ((prow >> 2) & 3))) * 8;
    const bf16_t* kg = KB + (rowbase + res) * 1024 + h * 128; const bf16_t* vg = VB + (rowbase + res) * 1024 + h * 128;
#pragma unroll
    for (int i = 0; i < 12; ++i) { const int kb = kbw + i; if (kb >= 0)
        __builtin_amdgcn_global_load_lds((const unsigned*)(kg + (size_t)(32 * kb + prow) * dil * 1024 + ksw), (LAS unsigned*)(lds + i * 8192 + wid * 1024), 16, 0, 0); }
    bf16x8 qf[8];
#pragma unroll
    for (int d0 = 0; d0 < 8; ++d0) qf[d0] = *(const bf16x8*)(QB + qrow * 1024 + h * 128 + d0 * 16 + hh * 8);
    const float* biasc = (const float*)(ws + WS_BIASC) + (size_t)(p * 8 + h) * 5 * 1024 + lane * 16;
    f32x16 sc[5];
#pragma unroll
    for (int di = 0; di < 5; ++di) { const f32x4* bp = (const f32x4*)(biasc + di * 1024);
#pragma unroll
        for (int j = 0; j < 4; ++j) { const f32x4 v = bp[j]; sc[di][4 * j] = v[0]; sc[di][4 * j + 1] = v[1]; sc[di][4 * j + 2] = v[2]; sc[di][4 * j + 3] = v[3]; } }
    __builtin_amdgcn_s_waitcnt(0x0F70);
    __syncthreads();
    const unsigned kx = ((r & 15) >> 1) << 5, krow_off = r * 256 + ((hh ^ (r & 1)) << 4);
#pragma unroll
    for (int di = 0; di < 5; ++di) { const int jj = wid + 4 - di;
        if (kbw + jj >= 0) { lcp kp = lds + jj * 8192 + krow_off;
#pragma unroll
            for (int k = 0; k < 8; ++k) sc[di] = MFMA_BF16(*(LAS const bf16x8*)(kp + ((32u * k) ^ kx)), qf[k], sc[di]); }
        else {
#pragma unroll
            for (int g = 0; g < 16; ++g) sc[di][g] = -INFINITY; } }
    float mx = sc[0][0];
#pragma unroll
    for (int di = 0; di < 5; ++di)
#pragma unroll
        for (int g = 0; g < 16; ++g) mx = fmaxf(mx, sc[di][g]);
    mx = swap_max(mx);
    float ps = 0.f; u32x4 pw[5][2];
#pragma unroll
    for (int di = 0; di < 5; ++di) {
#pragma unroll
        for (int g = 0; g < 16; ++g) { sc[di][g] = __builtin_amdgcn_exp2f(sc[di][g] - mx); ps += sc[di][g]; }
        pw[di][0] = __builtin_bit_cast(u32x4, pack_bf(sc[di], 0)); pw[di][1] = __builtin_bit_cast(u32x4, pack_bf(sc[di], 1)); }
    __syncthreads();
#pragma unroll
    for (int i = 0; i < 12; ++i) { const int kb = kbw + i; if (kb >= 0)
        __builtin_amdgcn_global_load_lds((const unsigned*)(vg + (size_t)(32 * kb + prow) * dil * 1024 + vsw), (LAS unsigned*)(lds + i * 8192 + wid * 1024), 16, 0, 0); }
    f32x16 o[4];
#pragma unroll
    for (int d0 = 0; d0 < 4; ++d0)
#pragma unroll
        for (int g = 0; g < 16; ++g) o[d0][g] = 0.f;
    const VAddr va = make_vaddr(lane);
    __builtin_amdgcn_s_waitcnt(0x0F70);
    __syncthreads();
#pragma unroll
    for (int di = 0; di < 5; ++di) { const int jj = wid + 4 - di;
        if (kbw + jj >= 0) { lcp vb = lds + jj * 8192;
#pragma unroll
            for (int s = 0; s < 2; ++s)
#pragma unroll
                for (int d0 = 0; d0 < 4; ++d0) o[d0] = MFMA_BF16(vfrag(vb, s, d0, va), __builtin_bit_cast(bf16x8, pw[di][s]), o[d0]); } }
    const float lt = swap_sum(ps), inv = 1.0f / lt;
    bf16_t* OP = (bf16_t*)(ws + (p == 0 ? WS_OP0 : p == 1 ? WS_OP1 : WS_OP2));
    { LAS unsigned char* stg = lds + DILW_LDS_BYTES + wid * 4608; const int rl = lane >> 3, ch = lane & 7;
#pragma unroll
      for (int half = 0; half < 2; ++half) {
#pragma unroll
        for (int dd = 0; dd < 2; ++dd)
#pragma unroll
            for (int gg = 0; gg < 4; ++gg) { const int d0 = 2 * half + dd;
                const unsigned lo = cvtpk(o[d0][4 * gg] * inv, o[d0][4 * gg + 1] * inv), hi = cvtpk(o[d0][4 * gg + 2] * inv, o[d0][4 * gg + 3] * inv);
                *(LAS unsigned long long*)(stg + r * 144 + (32 * dd + 8 * gg + 4 * hh) * 2) = (unsigned long long)lo | ((unsigned long long)hi << 32); }
#pragma unroll
        for (int j = 0; j < 4; ++j) { const u32x4 w = *(LAS const u32x4*)(stg + (8 * j + rl) * 144 + ch * 16);
            const size_t grow = rowbase + (size_t)(m0 + 32 * wid + 8 * j + rl) * dil + res;
            *(u32x4*)(OP + grow * 1024 + h * 128 + half * 64 + ch * 8) = w; } } }
    if (hh == 0) ((float*)(ws + WS_LSE))[((size_t)p * M + qrow) * 8 + h] = mx + __builtin_amdgcn_logf(lt);
    __syncthreads();
}
DI void dil_phase(LAS unsigned char* lds, unsigned char* ws, const int tid) {
    for (int u = blockIdx.x; u < 1536; u += gridDim.x) {
        const int cidx = u & 15, h = (u >> 4) & 7, b = (u >> 7) & 3, p = u >> 9;
        const int res = p == 0 ? 0 : p == 1 ? (cidx & 3) : cidx, m0 = p == 0 ? 256 * cidx : p == 1 ? 256 * (cidx >> 2) : 0;
        dil_wg_unit(lds, ws, p, b, h, res, m0, tid);
    }
}
}

__global__ void __launch_bounds__(512, 2) k_mla_fast(Ctx c) { extern __shared__ __attribute__((aligned(16))) unsigned char lds[]; att::mla_phase((LAS unsigned char*)lds, c.ws, (int)threadIdx.x); }
__global__ void __launch_bounds__(512, 2) k_sb_fast(Ctx c) { extern __shared__ __attribute__((aligned(16))) unsigned char lds[]; att::sb_phase<0>((LAS unsigned char*)lds, c.ws, (int)threadIdx.x); }
__global__ void __launch_bounds__(512, 2) k_dil_fast(Ctx c) { extern __shared__ __attribute__((aligned(16))) unsigned char lds[]; att::dil_phase((LAS unsigned char*)lds, c.ws, (int)threadIdx.x); }

template <bool FROMBF>
DI void final_norm_row(float* out, const bf16_t* xb, const float* gain, int row, int lane) {
    f32x4* xr = (f32x4*)(out + (size_t)row * D_MODEL) + lane; const f32x4* g = (const f32x4*)gain + lane;
    f32x4 v[8]; float s = 0.f;
    if (FROMBF) { const u32x4* br = (const u32x4*)(xb + (size_t)row * D_MODEL) + lane;
#pragma unroll
        for (int j = 0; j < 4; ++j) { const u32x4 w = br[64 * j];
            v[2 * j] = (f32x4){__uint_as_float(w[0] << 16), __uint_as_float(w[0] & 0xffff0000u), __uint_as_float(w[1] << 16), __uint_as_float(w[1] & 0xffff0000u)};
            v[2 * j + 1] = (f32x4){__uint_as_float(w[2] << 16), __uint_as_float(w[2] & 0xffff0000u), __uint_as_float(w[3] << 16), __uint_as_float(w[3] & 0xffff0000u)}; }
#pragma unroll
        for (int j = 0; j < 8; ++j) s += v[j].x * v[j].x + v[j].y * v[j].y + v[j].z * v[j].z + v[j].w * v[j].w;
        const float r = rsqrtf(wave_sum(s) * (1.0f / D_MODEL) + EPS);
        f32x4* o4 = (f32x4*)(out + (size_t)row * D_MODEL); const f32x4* g4 = (const f32x4*)gain;
#pragma unroll
        for (int j = 0; j < 4; ++j) { const int i0 = 128 * j + 2 * lane; o4[i0] = v[2 * j] * r * g4[i0]; o4[i0 + 1] = v[2 * j + 1] * r * g4[i0 + 1]; }
    } else {
#pragma unroll
        for (int j = 0; j < 8; ++j) { v[j] = xr[64 * j]; s += v[j].x * v[j].x + v[j].y * v[j].y + v[j].z * v[j].z + v[j].w * v[j].w; }
        const float r = rsqrtf(wave_sum(s) * (1.0f / D_MODEL) + EPS);
#pragma unroll
        for (int j = 0; j < 8; ++j) xr[64 * j] = v[j] * r * g[64 * j];
    }
}
__global__ void __launch_bounds__(256) k_final_norm(float* out, const float* gain) { final_norm_row<false>(out, nullptr, gain, blockIdx.x * 4 + (threadIdx.x >> 6), threadIdx.x & 63); }
__global__ void __launch_bounds__(256) k_final_norm_bf(float* out, const bf16_t* xb, const float* gain) { final_norm_row<true>(out, xb, gain, blockIdx.x * 4 + (threadIdx.x >> 6), threadIdx.x & 63); }

#define XB_TMO      128
#define XB_XCNT(j)  (256  + 64 * (j))
#define XB_XSUB(j)  (1280 + 64 * (j))
#define XB_XGEN(j)  (2304 + 64 * (j))
#define XB_TOP      3328
#define XB_TOPGEN   3392
#define XCD_BAR_WORDS 3456
#define XB_SPIN_CAP (1u << 22)
DI unsigned xb_ld(unsigned* p)              { return __hip_atomic_load(p, __ATOMIC_RELAXED, __HIP_MEMORY_SCOPE_AGENT); }
DI unsigned xb_add(unsigned* p, unsigned v) { return __hip_atomic_fetch_add(p, v, __ATOMIC_RELAXED, __HIP_MEMORY_SCOPE_AGENT); }
DI unsigned xb_xcc_id() { return (unsigned)__builtin_amdgcn_s_getreg((3 << 11) | 20) & 0xFu; }
#define XB_SPIN(cond, bar) do { unsigned _sp = 0; while (cond) { __builtin_amdgcn_s_sleep(1); \
    if ((++_sp & 255u) == 0u) { if (xb_ld(&(bar)[XB_TMO])) break; if (_sp > XB_SPIN_CAP) { atomicAdd(&(bar)[XB_TMO], 1u); break; } } } } while (0)
struct XcdBarrier { unsigned* bar; unsigned x; volatile LAS unsigned* st; };
DI XcdBarrier xcd_barrier_post(unsigned* bar, volatile LAS unsigned* st, int tid) {
    XcdBarrier b; b.bar = bar; b.x = xb_xcc_id(); b.st = st;
    if (tid == 0) (void)xb_add(&bar[XB_XCNT(b.x)], 1u);
    return b;
}
DI void xcd_barrier_complete(unsigned* bar, unsigned x, unsigned& nloc, unsigned& nx) {
    const unsigned G = gridDim.x * gridDim.y * gridDim.z;
    unsigned sum, cnt, mine, sp = 0u;
    for (;;) {
        sum = 0u; cnt = 0u; mine = 0u;
#pragma unroll
        for (unsigned j = 0; j < 16; ++j) { const unsigned c = xb_ld(&bar[XB_XCNT(j)]); sum += c; cnt += (c > 0u) ? 1u : 0u; mine = (j == x) ? c : mine; }
        if (sum == G) break;
        __builtin_amdgcn_s_sleep(1);
        if ((++sp & 255u) == 0u) { if (xb_ld(&bar[XB_TMO])) break; if (sp > XB_SPIN_CAP) { atomicAdd(&bar[XB_TMO], 1u); break; } }
    }
    nloc = mine > 0u ? mine : 1u; nx = cnt > 0u ? cnt : 1u;
}
DI void xcd_barrier(const XcdBarrier& b, int tid) {
    asm volatile("s_waitcnt vmcnt(0)" ::: "memory");
    __syncthreads();
    if (tid == 0) {
        unsigned* bar = b.bar;
        __builtin_amdgcn_s_waitcnt(0);
        unsigned nloc = b.st[0], nx = b.st[1];
        if (nloc == 0u) { xcd_barrier_complete(bar, b.x, nloc, nx); b.st[0] = nloc; b.st[1] = nx; }
        const unsigned old = xb_add(&bar[XB_XSUB(b.x)], 1u);
        const unsigned gen = old / nloc;
        if (old + 1u == (gen + 1u) * nloc) {
            __builtin_amdgcn_fence(__ATOMIC_RELEASE, "agent");
            asm volatile("s_waitcnt vmcnt(0)" ::: "memory");
            const unsigned og = xb_add(&bar[XB_TOP], 1u);
            const unsigned tg = og / nx;
            if (og + 1u == (tg + 1u) * nx) xb_add(&bar[XB_TOPGEN], 1u);
            else XB_SPIN(xb_ld(&bar[XB_TOPGEN]) == tg, bar);
            __builtin_amdgcn_fence(__ATOMIC_ACQUIRE, "agent");
            xb_add(&bar[XB_XGEN(b.x)], 1u);
            asm volatile("s_waitcnt vmcnt(0)" ::: "memory");
        } else {
            XB_SPIN(xb_ld(&bar[XB_XGEN(b.x)]) == gen, bar);
            __builtin_amdgcn_fence(__ATOMIC_ACQUIRE, "agent");
            asm volatile("s_waitcnt vmcnt(0)" ::: "memory");
        }
    }
    __syncthreads();
}

constexpr int MEGA_LDS_PHASE = 135168, MEGA_LDS = MEGA_LDS_PHASE + 64;
#ifndef P4_REP
#define P4_REP 1
#endif
#ifndef SYNC_PROBE
#define SYNC_PROBE 0
#endif
#ifndef SB_PROBE_VAR
#define SB_PROBE_VAR 0
#endif
#ifndef PROBE_MASK
#define PROBE_MASK 0
#endif
#define PREP(k) for (int rep_ = 0; rep_ < 1 + ((PROBE_MASK >> (k)) & 1); ++rep_)
__global__ void __launch_bounds__(512, 2) k_mega(Ctx c) {
    extern __shared__ __attribute__((aligned(16))) unsigned char lds_raw[];
    LAS unsigned char* lds = (LAS unsigned char*)lds_raw;
    unsigned char* ws = c.ws; const int G = gridDim.x, bx = blockIdx.x;
    const int wave_s = __builtin_amdgcn_readfirstlane((int)threadIdx.x >> 6);
    volatile LAS unsigned* bst = (volatile LAS unsigned*)(lds + MEGA_LDS_PHASE);
    if (threadIdx.x < 16) bst[threadIdx.x] = 0u;
    __syncthreads();
    const XcdBarrier xbar = xcd_barrier_post((unsigned*)(ws + WS_CTL), bst, (int)threadIdx.x);
#define GRID_BAR() xcd_barrier(xbar, phase_tid(wave_s))
    PREP(0) { prep_phase<8, 0>(c, (float*)lds_raw, phase_tid(wave_s)); __syncthreads(); }
    GRID_BAR();
    PREP(1) { pg8::Gemm g{(const bf16_t*)(ws + WS_H0), (const bf16_t*)(ws + WS_WT_IN_E), M, IN_EVEN_PAD, 2048}; pg8::StaticOrder S; S.init(g.M, g.N, G, bx);
      pg8::gemm_phase<pg8::FEpi1, pg8::StaticOrder, true, true>(lds, g, S, pg8::FEpi1{ws}, phase_tid(wave_s)); }
    { const int nlast = (M / 256) * (IN_EVEN_PAD / 256) % G; const int nfree = nlast ? G - nlast : G, me = nlast ? bx - nlast : bx;
      if (me >= 0) { const int tid = phase_tid(wave_s); prep_weights<1>(c, (float*)lds_raw + (tid >> 6) * 64 * 36, tid & 63, me * 8 + (tid >> 6), nfree * 8); } }
    GRID_BAR();
    PREP(2) { att::dil_phase(lds, ws, phase_tid(wave_s));
    __syncthreads(); }
    PREP(7) { pg8::Gemm g{(const bf16_t*)(ws + WS_CQ), (const bf16_t*)(ws + WS_WT_UQ), M, 1536, 512}; pg8::StaticOrder S; S.init(g.M, g.N, G, bx);
      pg8::gemm_phase<pg8::FEpi2a, pg8::StaticOrder, true, true>(lds, g, S, pg8::FEpi2a{ws}, phase_tid(wave_s)); }
    PREP(7) { pg8::Gemm g{(const bf16_t*)(ws + WS_CKV), (const bf16_t*)(ws + WS_WT_UKV), M, 2048, 512}; pg8::StaticOrder S; S.init(g.M, g.N, G, bx);
      pg8::gemm_phase<pg8::FEpi2b, pg8::StaticOrder, true, true>(lds, g, S, pg8::FEpi2b{ws}, phase_tid(wave_s)); }
    GRID_BAR();
    PREP(3) att::mla_phase(lds, ws, phase_tid(wave_s));
    PREP(8) { const int tid = phase_tid(wave_s); for (int it = bx * 512 + tid; it < M * 128; it += G * 512) dil_merge_item(ws, it >> 7, (it & 127) * 8); }
    GRID_BAR();
    PREP(4) { pg8::Gemm g{(const bf16_t*)(ws + WS_MIX), (const bf16_t*)(ws + WS_WT_OUT_E), M, 2048, 2048}; pg8::StaticOrder S; S.init(g.M, g.N, G, bx); S.rep = P4_REP;
      pg8::gemm_phase<pg8::FEpi4, pg8::StaticOrder, false, true>(lds, g, S, pg8::FEpi4{ws, c.x, c.out}, phase_tid(wave_s)); }
    GRID_BAR();
    PREP(5) { pg8::Gemm g{(const bf16_t*)(ws + WS_X1BF), (const bf16_t*)(ws + WS_WT_IN_O), M, IN_ODD, 2048}; pg8::StaticOrder S; S.init(g.M, g.N, G, bx);
      pg8::gemm_phase<pg8::FEpi5, pg8::StaticOrder, true, true>(lds, g, S, pg8::FEpi5{ws}, phase_tid(wave_s)); }
    GRID_BAR();
    PREP(6) att::sb_phase<0>(lds, ws, phase_tid(wave_s));
#if SB_PROBE_VAR
    att::sb_phase<SB_PROBE_VAR>(lds, ws, phase_tid(wave_s));
#endif
    GRID_BAR();
    { pg8::Gemm g{(const bf16_t*)(ws + WS_MIX2), (const bf16_t*)(ws + WS_WT_OUT_O), M, 2048, 2048}; pg8::StaticOrder S; S.init(g.M, g.N, G, bx);
      pg8::gemm_phase<pg8::FEpi7, pg8::StaticOrder, false, true>(lds, g, S, pg8::FEpi7{(bf16_t*)(ws + WS_X2BF), (const bf16_t*)(ws + WS_X1BF)}, phase_tid(wave_s)); }
    GRID_BAR();
#if SYNC_PROBE
    for (int i_ = 0; i_ < 8; ++i_) GRID_BAR();
#endif
    { const int tid = phase_tid(wave_s); for (int row = bx * 8 + (tid >> 6); row < M; row += G * 8) final_norm_row<true>(c.out, (const bf16_t*)(ws + WS_X2BF), c.final_gain, row, tid & 63); }
}

#ifndef MK_ONE_LAUNCH
#define MK_ONE_LAUNCH 1
#endif
#ifndef FAST_G1
#define FAST_G1 1
#endif
#ifndef FAST_G2
#define FAST_G2 1
#endif
#ifndef FAST_G4
#define FAST_G4 1
#endif
#ifndef FAST_G5
#define FAST_G5 1
#endif
#ifndef FAST_G7
#define FAST_G7 1
#endif
#ifndef FAST_MLA
#define FAST_MLA 1
#endif
#ifndef FAST_SB
#define FAST_SB 1
#endif
#ifndef FAST_DIL
#define FAST_DIL 1
#endif
static void launch_att(void (*k)(Ctx), int lds_bytes, const Ctx& c, hipStream_t s) {
    (void)hipFuncSetAttribute((const void*)k, hipFuncAttributeMaxDynamicSharedMemorySize, lds_bytes);
    hipLaunchKernelGGL(k, dim3(256), dim3(512), lds_bytes, s, c);
}
template <class Epi> static void launch_gemm_fast(const bf16_t* A, const bf16_t* Bt, int N, int K, Epi E, hipStream_t s) {
    static bool attr = false; if (!attr) { (void)hipFuncSetAttribute((const void*)k_gemm_fast<Epi>, hipFuncAttributeMaxDynamicSharedMemorySize, 131072); attr = true; }
    pg8::Gemm g{A, Bt, M, N, K};
    k_gemm_fast<Epi><<<256, 512, 131072, s>>>(g, E);
}

extern "C" void kernel_launch(void* const* d_in, const int* in_sizes, int n_in, void* d_out, int out_size, void* d_ws, size_t ws_size, hipStream_t stream) {
    if (n_in != 12 || out_size != M * D_MODEL || ws_size < WS_END) { fprintf(stderr, "kernel_launch: unexpected shapes (n_in %d out %d ws %zu)\n", n_in, out_size, ws_size); return; }
    Ctx c{};
    c.x = (const float*)d_in[0]; c.norm_gain = (const float*)d_in[1]; c.w_in_even = (const float*)d_in[2]; c.q_norm_gain = (const float*)d_in[3]; c.kv_norm_gain = (const float*)d_in[4];
    c.w_uq = (const float*)d_in[5]; c.w_ukv = (const float*)d_in[6]; c.w_out_even = (const float*)d_in[7]; c.rel_bias = (const float*)d_in[8]; c.w_in_odd = (const float*)d_in[9];
    c.w_out_odd = (const float*)d_in[10]; c.final_gain = (const float*)d_in[11]; c.out = (float*)d_out; c.ws = (unsigned char*)d_ws;
#if MK_ONE_LAUNCH
    static int grid_blocks = 0;
    if (!grid_blocks) {
        int dev = 0, cus = 0, per_cu = 0;
        (void)hipGetDevice(&dev); (void)hipDeviceGetAttribute(&cus, hipDeviceAttributeMultiprocessorCount, dev);
        (void)hipFuncSetAttribute((const void*)k_mega, hipFuncAttributeMaxDynamicSharedMemorySize, MEGA_LDS);
        (void)hipOccupancyMaxActiveBlocksPerMultiprocessor(&per_cu, (const void*)k_mega, 512, MEGA_LDS);
        if (per_cu < 1) { fprintf(stderr, "kernel_launch: occupancy query says %d blocks/CU\n", per_cu); per_cu = 1; }
        grid_blocks = cus;
    }
    (void)hipMemsetAsync((char*)d_ws + WS_CTL, 0, 65536, stream);
    { void* args[] = {&c};
      hipError_t e = hipLaunchCooperativeKernel((void*)k_mega, dim3(grid_blocks), dim3(512), args, MEGA_LDS, stream);
      if (e != hipSuccess) fprintf(stderr, "cooperative launch failed: %s (grid %d)\n", hipGetErrorString(e), grid_blocks); }
    return;
#endif
    unsigned char* ws = c.ws;
    const float* rc = (const float*)(ws + WS_ROPE); const float* rs = rc + 4096 * 32;
    k_prep<<<2048, 256, 0, stream>>>(c);
#if FAST_G1
    launch_gemm_fast((const bf16_t*)(ws + WS_H0), (const bf16_t*)(ws + WS_WT_IN_E), IN_EVEN_PAD, 2048, pg8::FEpi1{ws}, stream);
#else
    k_gemm_naive<Epi1><<<(M / 64) * (IN_EVEN_PAD / 64), 256, 0, stream>>>((const bf16_t*)(ws + WS_H0), (const bf16_t*)(ws + WS_WT_IN_E), IN_EVEN_PAD, 2048, Epi1{ws});
    k_rowss<false><<<M / 4, 256, 0, stream>>>(ws + WS_CQ, 512, 512, (float*)(ws + WS_SSC), 16, 8);
    k_rowss<false><<<M / 4, 256, 0, stream>>>(ws + WS_CKV, 512, 512, (float*)(ws + WS_SSC) + 8, 16, 8);
    k_rope<<<(M * 32 + 255) / 256, 256, 0, stream>>>((bf16_t*)(ws + WS_KR), 1, rc, rs);
#endif
#if FAST_DIL
    launch_att(k_dil_fast, att::DIL_LDS_BYTES, c, stream);
#else
    k_dil_naive<<<BATCH * 8 * SEQ / 4, 256, 0, stream>>>(c);
#endif
#if FAST_G2
    launch_gemm_fast((const bf16_t*)(ws + WS_CQ), (const bf16_t*)(ws + WS_WT_UQ), 1536, 512, pg8::FEpi2a{ws}, stream);
    launch_gemm_fast((const bf16_t*)(ws + WS_CKV), (const bf16_t*)(ws + WS_WT_UKV), 2048, 512, pg8::FEpi2b{ws}, stream);
#else
    k_gemm_naive<Epi2a><<<(M / 64) * (1536 / 64), 256, 0, stream>>>((const bf16_t*)(ws + WS_CQ), (const bf16_t*)(ws + WS_WT_UQ), 1536, 512, Epi2a{ws});
    k_rope<<<(M * 256 + 255) / 256, 256, 0, stream>>>((bf16_t*)(ws + WS_QR), 8, rc, rs);
    k_gemm_naive<Epi2b><<<(M / 64) * (2048 / 64), 256, 0, stream>>>((const bf16_t*)(ws + WS_CKV), (const bf16_t*)(ws + WS_WT_UKV), 2048, 512, Epi2b{ws});
#endif
#if FAST_MLA
    launch_att(k_mla_fast, att::M2_LDS_BYTES > att::MLA_LDS_BYTES ? att::M2_LDS_BYTES : att::MLA_LDS_BYTES, c, stream);
#else
    k_mla_naive<<<BATCH * 8 * SEQ / 4, 256, 0, stream>>>(c);
#endif
    k_dil_merge<<<M, 128, 0, stream>>>(c);
#if FAST_G4
    launch_gemm_fast((const bf16_t*)(ws + WS_MIX), (const bf16_t*)(ws + WS_WT_OUT_E), 2048, 2048, pg8::FEpi4{ws, c.x, c.out}, stream);
#else
    k_gemm_naive<Epi4><<<(M / 64) * (2048 / 64), 256, 0, stream>>>((const bf16_t*)(ws + WS_MIX), (const bf16_t*)(ws + WS_WT_OUT_E), 2048, 2048, Epi4{ws, c.x, c.out});
    k_rowss<true><<<M / 4, 256, 0, stream>>>(c.out, 2048, 2048, (float*)(ws + WS_SSX1), 32, 32);
#endif
#if FAST_G5
    launch_gemm_fast((const bf16_t*)(ws + WS_X1BF), (const bf16_t*)(ws + WS_WT_IN_O), IN_ODD, 2048, pg8::FEpi5{ws}, stream);
#else
    k_gemm_naive<Epi5><<<(M / 64) * (IN_ODD / 64), 256, 0, stream>>>((const bf16_t*)(ws + WS_X1BF), (const bf16_t*)(ws + WS_WT_IN_O), IN_ODD, 2048, Epi5{ws});
#endif
#if FAST_SB
    launch_att(k_sb_fast, att::SB_LDS_BYTES, c, stream);
#else
    k_sb_naive<<<BATCH * 16 * SEQ / 4, 256, 0, stream>>>(c);
#endif
#if FAST_G7
    launch_gemm_fast((const bf16_t*)(ws + WS_MIX2), (const bf16_t*)(ws + WS_WT_OUT_O), 2048, 2048, pg8::FEpi7{(bf16_t*)(ws + WS_X2BF), (const bf16_t*)(ws + WS_X1BF)}, stream);
#else
    k_gemm_naive<Epi7><<<(M / 64) * (2048 / 64), 256, 0, stream>>>((const bf16_t*)(ws + WS_MIX2), (const bf16_t*)(ws + WS_WT_OUT_O), 2048, 2048, Epi7{c.out});
#endif
#if FAST_G7
    k_final_norm_bf<<<M / 4, 256, 0, stream>>>(c.out, (const bf16_t*)(ws + WS_X2BF), c.final_gain);
#else
    k_final_norm<<<M / 4, 256, 0, stream>>>(c.out, c.final_gain);
#endif
}
```

```cpp
#include <hip/hip_runtime.h>
#include <cstdio>
#include <cstdint>
#include <cmath>

typedef unsigned short bf16_t;
typedef unsigned u32x4 __attribute__((ext_vector_type(4)));
typedef float f32x4 __attribute__((ext_vector_type(4)));

constexpr int D_MODEL = 2048, BATCH = 4, SEQ = 4096, M = BATCH * SEQ;
constexpr int NH_MLA = 8, NH_DIL = 8, NH_SB = 16, HD = 128;
constexpr int IN_EVEN = 6208, IN_EVEN_PAD = 6400, IN_ODD = 8192;
constexpr float EPS = 1e-6f;
constexpr float LOG2E = 1.4426950408889634f;
constexpr float MLA_QSCALE = 0.07216878364870322f * LOG2E;
constexpr float D128_QSCALE = 0.08838834764831845f * LOG2E;

constexpr size_t MiB = 1u << 20;
constexpr size_t WS_CTL = 0;
constexpr size_t WS_ROPE = 1 * MiB;
constexpr size_t WS_BIASN = 2 * MiB;
constexpr size_t WS_BIASC = 2 * MiB + 65536;
constexpr size_t WS_SSX = 3 * MiB;
constexpr size_t WS_SSC = 4 * MiB;
constexpr size_t WS_SSX1 = 5 * MiB;
constexpr size_t WS_LSE = 9 * MiB;
constexpr size_t WS_WT_IN_E = 12 * MiB;
constexpr size_t WS_WT_UQ = 37 * MiB;
constexpr size_t WS_WT_UKV = 39 * MiB;
constexpr size_t WS_WT_OUT_E = 41 * MiB;
constexpr size_t WS_WT_IN_O = 49 * MiB;
constexpr size_t WS_WT_OUT_O = 81 * MiB;
constexpr size_t WS_A = 90 * MiB;
constexpr size_t WS_B = 154 * MiB;
constexpr size_t WS_C = 218 * MiB;
constexpr size_t WS_H0 = WS_A, WS_OP0 = WS_A, WS_OP1 = WS_A + 32 * MiB, WS_X1BF = WS_A;
constexpr size_t WS_CQ = WS_B, WS_CKV = WS_B + 16 * MiB, WS_QB = WS_B + 32 * MiB, WS_MIX = WS_B, WS_MIX2 = WS_B;
constexpr size_t WS_KB = WS_C, WS_VB = WS_C + 32 * MiB, WS_SG = WS_C + 64 * MiB, WS_QN = WS_C + 128 * MiB, WS_QR = WS_C + 160 * MiB,
                 WS_KN = WS_C + 176 * MiB, WS_VA = WS_C + 208 * MiB, WS_KR = WS_C + 240 * MiB, WS_OP2 = WS_C + 242 * MiB;
constexpr size_t WS_X2BF = WS_C;
constexpr size_t WS_Q2 = WS_C, WS_K2 = WS_C + 64 * MiB, WS_V2 = WS_C + 128 * MiB, WS_SG2 = WS_C + 192 * MiB;
constexpr size_t WS_END = WS_C + 274 * MiB;

struct Ctx {
    const float *x, *norm_gain, *w_in_even, *q_norm_gain, *kv_norm_gain, *w_uq, *w_ukv, *w_out_even, *rel_bias, *w_in_odd, *w_out_odd, *final_gain;
    float* out; unsigned char* ws;
};

#define DI __device__ __forceinline__
DI int phase_tid(int wave_s) { int lane; asm volatile("v_mbcnt_lo_u32_b32 %0, -1, 0\n\tv_mbcnt_hi_u32_b32 %0, -1, %0" : "=v"(lane)); return wave_s * 64 + lane; }
DI float bf2f(bf16_t v) { return __uint_as_float(((unsigned)v) << 16); }
DI bf16_t f2bf(float f) { unsigned u = __float_as_uint(f); return (bf16_t)((u + 0x7fffu + ((u >> 16) & 1u)) >> 16); }
DI float wave_sum(float v) {
#pragma unroll
    for (int o = 1; o < 64; o <<= 1) v += __shfl_xor(v, o);
    return v;
}
DI float wave_max(float v) {
#pragma unroll
    for (int o = 1; o < 64; o <<= 1) v = fmaxf(v, __shfl_xor(v, o));
    return v;
}
DI float silu_f(float v) { return v / (1.0f + __expf(-v)); }

DI int map_in_even(int n) { if (n < 1024) return n; if (n < 1056) return 1024 + (n - 1024); if (n < 1088) return 1152 + (n - 1056); return n - 1088 + 1280; }
DI int map_uq(int n) { const int h = n / 192, j = n % 192; if (j < 128) return h * 128 + j; if (j < 160) return 1024 + (h >> 2) * 256 + (h & 3) * 32 + (j - 128);
    return 1024 + (h >> 2) * 256 + 128 + (h & 3) * 32 + (j - 160); }
DI int map_ukv(int n) { const int h = n / 256, j = n % 256; if (j < 128) return h * 128 + j; return 1024 + h * 128 + (j - 128); }
DI int map_id(int n) { return n; }

template <int MAPID>
DI void transpose_item(const float* W, int K, int N, const float* gain, bf16_t* WT, float* scr  , int item, int lane) {
    const int nblk = N / 32, kb = item / nblk, nb = item % nblk, k0 = 64 * kb, n0 = 32 * nb;
    f32x4 v[8];
#pragma unroll
    for (int i = 0; i < 8; ++i) { const int kk = 8 * i + (lane >> 3); v[i] = *(const f32x4*)(W + (size_t)(k0 + kk) * N + n0 + 4 * (lane & 7)); }
#pragma unroll
    for (int i = 0; i < 8; ++i) { const int kk = 8 * i + (lane >> 3); const float g = gain ? gain[k0 + kk] : 1.0f; *(f32x4*)(scr + kk * 36 + 4 * (lane & 7)) = v[i] * g; }
    asm volatile("s_waitcnt lgkmcnt(0)" ::: "memory");
    const int d0 = MAPID == 0 ? map_in_even(n0) : MAPID == 1 ? map_uq(n0) : MAPID == 2 ? map_ukv(n0) : map_id(n0);
    const int c = lane & 7;
#pragma unroll
    for (int j = 0; j < 4; ++j) { const int n = (lane >> 3) + 8 * j; const float* s = scr + (8 * c) * 36 + n;
        u32x4 o; o.x = f2bf(s[0]) | ((unsigned)f2bf(s[36]) << 16); o.y = f2bf(s[72]) | ((unsigned)f2bf(s[108]) << 16);
        o.z = f2bf(s[144]) | ((unsigned)f2bf(s[180]) << 16); o.w = f2bf(s[216]) | ((unsigned)f2bf(s[252]) << 16);
        *(u32x4*)(WT + (size_t)(d0 + n) * K + k0 + 8 * c) = o; }
    asm volatile("s_waitcnt lgkmcnt(0)" ::: "memory");
}

DI int t5_bucket(int dist) {
    if (dist < 16) return dist;
    float d = (float)dist;
    int large = 16 + (int)(logf(d / 16.0f) / 4.852030263919617f * 16.0f);
    return large < 31 ? large : 31;
}

template <int PART> DI void prep_weights(const Ctx& c, float* scr, int lane, int gw, int NGW) {
    unsigned char* ws = c.ws;
    constexpr int I0 = (2048 / 64) * (IN_EVEN / 32), I1 = (512 / 64) * (1536 / 32), I2 = (512 / 64) * (2048 / 32), I3 = (2048 / 64) * (2048 / 32),
                  I4 = (2048 / 64) * (IN_ODD / 32), I5 = I3;
    constexpr int LO = PART == 1 ? I0 : 0, HI = PART == 0 ? I0 : I0 + I1 + I2 + I3 + I4 + I5;
    for (int it = LO + gw; it < HI; it += NGW) {
        int r = it;
        if (r < I0) { transpose_item<0>(c.w_in_even, 2048, IN_EVEN, c.norm_gain, (bf16_t*)(ws + WS_WT_IN_E), scr, r, lane); continue; } r -= I0;
        if (r < I1) { transpose_item<1>(c.w_uq, 512, 1536, c.q_norm_gain, (bf16_t*)(ws + WS_WT_UQ), scr, r, lane); continue; } r -= I1;
        if (r < I2) { transpose_item<2>(c.w_ukv, 512, 2048, c.kv_norm_gain, (bf16_t*)(ws + WS_WT_UKV), scr, r, lane); continue; } r -= I2;
        if (r < I3) { transpose_item<3>(c.w_out_even, 2048, 2048, nullptr, (bf16_t*)(ws + WS_WT_OUT_E), scr, r, lane); continue; } r -= I3;
        if (r < I4) { transpose_item<3>(c.w_in_odd, 2048, IN_ODD, c.norm_gain + 2048, (bf16_t*)(ws + WS_WT_IN_O), scr, r, lane); continue; } r -= I4;
        transpose_item<3>(c.w_out_odd, 2048, 2048, nullptr, (bf16_t*)(ws + WS_WT_OUT_O), scr, r, lane);
    }
}
template <int NW, int PART> DI void prep_phase(const Ctx& c, float* scr_all, const int tid) {
    const int lane = tid & 63, wave = tid >> 6;
    float* scr = scr_all + wave * 64 * 36;
    const int gw = blockIdx.x * NW + wave, NGW = gridDim.x * NW;
    unsigned char* ws = c.ws;
    prep_weights<PART>(c, scr, lane, gw, NGW);
    const int gt = blockIdx.x * (NW * 64) + tid, NGT = gridDim.x * (NW * 64);
    { bf16_t* wt = (bf16_t*)(ws + WS_WT_IN_E);
      for (int i = gt; i < 192 * 256; i += NGT) { const int rr = i / 256, cc = i % 256; const int row = rr < 96 ? 1056 + rr : 1184 + (rr - 96);
          *(u32x4*)(wt + (size_t)row * 2048 + cc * 8) = (u32x4){0u, 0u, 0u, 0u}; } }
    { float* rc = (float*)(ws + WS_ROPE); float* rs = rc + 4096 * 32;
      for (int i = gt; i < 4096 * 32; i += NGT) { const int pos = i >> 5, j = i & 31; const float inv = 1.0f / powf(10000.0f, (float)j / 32.0f); const float ang = (float)pos * inv;
          rc[i] = cosf(ang); rs[i] = sinf(ang); } }
    { float* bn = (float*)(ws + WS_BIASN);
      for (int i = gt; i < 3 * 8 * 132; i += NGT) { const int p = i / (8 * 132), h = (i / 132) % 8, rel = i % 132; const int dil = p == 0 ? 1 : p == 1 ? 4 : 16;
          bn[i] = rel <= 128 ? c.rel_bias[t5_bucket(rel * dil) * 8 + h] * LOG2E : 0.f; } }
    { float* bc = (float*)(ws + WS_BIASC);
      for (int i = gt; i < 3 * 8 * 5 * 1024; i += NGT) { const int g = i & 15, ln = (i >> 4) & 63, di = (i >> 10) % 5, ph = i / 5120, h = ph & 7, p = ph >> 3; const int dil = p == 0 ? 1 : p == 1 ? 4 : 16;
          const int rel = 32 * di + (ln & 31) - ((g & 3) + 8 * (g >> 2) + 4 * (ln >> 5));
          bc[i] = (rel >= 0 && rel <= 128) ? c.rel_bias[t5_bucket(rel * dil) * 8 + h] * LOG2E : -INFINITY; } }
    { bf16_t* h0 = (bf16_t*)(ws + WS_H0); float* ssx = (float*)(ws + WS_SSX);
      for (int m = gw; m < M; m += NGW) { const f32x4* xr = (const f32x4*)(c.x + (size_t)m * D_MODEL) + 2 * lane; float s = 0.f;
          u32x4* o16 = (u32x4*)(h0 + (size_t)m * D_MODEL) + lane;
#pragma unroll
          for (int j = 0; j < 4; ++j) { const f32x4 v = xr[128 * j], w = xr[128 * j + 1];
              s += (v.x * v.x + v.y * v.y + v.z * v.z + v.w * v.w) + (w.x * w.x + w.y * w.y + w.z * w.z + w.w * w.w);
              o16[64 * j] = (u32x4){f2bf(v.x) | ((unsigned)f2bf(v.y) << 16), f2bf(v.z) | ((unsigned)f2bf(v.w) << 16), f2bf(w.x) | ((unsigned)f2bf(w.y) << 16), f2bf(w.z) | ((unsigned)f2bf(w.w) << 16)}; }
          s = wave_sum(s); if (lane == 0) ssx[m] = s; } }
}

__global__ void __launch_bounds__(256) k_prep(Ctx c) { __shared__ float scr_all[4 * 64 * 36]; prep_phase<4, 2>(c, scr_all, (int)threadIdx.x); }

DI float rscale(const float* part, int n, float inv_cols) { float s = 0.f; for (int i = 0; i < n; ++i) s += part[i]; return rsqrtf(s * inv_cols + EPS); }

struct Epi1 {
    unsigned char* ws;
    DI void operator()(int row, int col, float acc) const {
        const float v = acc * rsqrtf(((const float*)(ws + WS_SSX))[row] * (1.0f / 2048.0f) + EPS);
        if (col < 512) ((bf16_t*)(ws + WS_CQ))[(size_t)row * 512 + col] = f2bf(v);
        else if (col < 1024) ((bf16_t*)(ws + WS_CKV))[(size_t)row * 512 + col - 512] = f2bf(v);
        else if (col < 1280) { const int t = col - 1024; if (t < 32) ((bf16_t*)(ws + WS_KR))[(size_t)row * 64 + t] = f2bf(v); else if (t >= 128 && t < 160) ((bf16_t*)(ws + WS_KR))[(size_t)row * 64 + 32 + t - 128] = f2bf(v); }
        else if (col < 2304) ((bf16_t*)(ws + WS_QB))[(size_t)row * 1024 + col - 1280] = f2bf(v * D128_QSCALE);
        else if (col < 3328) ((bf16_t*)(ws + WS_KB))[(size_t)row * 1024 + col - 2304] = f2bf(v);
        else if (col < 4352) ((bf16_t*)(ws + WS_VB))[(size_t)row * 1024 + col - 3328] = f2bf(v);
        else ((bf16_t*)(ws + WS_SG))[(size_t)row * 2048 + col - 4352] = f2bf(silu_f(v));
    }
};
struct Epi2a {
    unsigned char* ws;
    DI void operator()(int row, int col, float acc) const {
        const float v = acc * rscale((const float*)(ws + WS_SSC) + (size_t)row * 16, 8, 1.0f / 512.0f) * MLA_QSCALE;
        if (col < 1024) ((bf16_t*)(ws + WS_QN))[(size_t)row * 1024 + col] = f2bf(v);
        else { const int t = col - 1024, grp = t >> 8, u = t & 255, half = u >> 7, hh = (u & 127) >> 5, i = u & 31;
            ((bf16_t*)(ws + WS_QR))[(size_t)row * 512 + (4 * grp + hh) * 64 + half * 32 + i] = f2bf(v); }
    }
};
struct Epi2b {
    unsigned char* ws;
    DI void operator()(int row, int col, float acc) const {
        const float v = acc * rscale((const float*)(ws + WS_SSC) + (size_t)row * 16 + 8, 8, 1.0f / 512.0f);
        if (col < 1024) ((bf16_t*)(ws + WS_KN))[(size_t)row * 1024 + col] = f2bf(v); else ((bf16_t*)(ws + WS_VA))[(size_t)row * 1024 + col - 1024] = f2bf(v);
    }
};
struct Epi4 {
    unsigned char* ws; const float* x; float* out;
    DI void operator()(int row, int col, float acc) const {
        const float v = x[(size_t)row * 2048 + col] + acc; out[(size_t)row * 2048 + col] = v; ((bf16_t*)(ws + WS_X1BF))[(size_t)row * 2048 + col] = f2bf(v);
    }
};
struct Epi5 {
    unsigned char* ws;
    DI void operator()(int row, int col, float acc) const {
        const float v = acc * rscale((const float*)(ws + WS_SSX1) + (size_t)row * 32, 32, 1.0f / 2048.0f);
        if (col < 2048) ((bf16_t*)(ws + WS_Q2))[(size_t)row * 2048 + col] = f2bf(v * D128_QSCALE);
        else if (col < 4096) ((bf16_t*)(ws + WS_K2))[(size_t)row * 2048 + col - 2048] = f2bf(v);
        else if (col < 6144) ((bf16_t*)(ws + WS_V2))[(size_t)row * 2048 + col - 4096] = f2bf(v);
        else ((bf16_t*)(ws + WS_SG2))[(size_t)row * 2048 + col - 6144] = f2bf(silu_f(v));
    }
};
struct Epi7 {
    float* out;
    DI void operator()(int row, int col, float acc) const { out[(size_t)row * 2048 + col] += acc; }
};

namespace pg8 {
#define PG8_LAS __attribute__((address_space(3)))
typedef short bf16x8 __attribute__((ext_vector_type(8)));
constexpr int BM = 256, BK = 64, HALF = 128, HTB = HALF * BK * 2  , STAGE_BYTES = 8 * HTB, NXCD = 8, WGM = 8;

__host__ __device__ __forceinline__ int lds_byte(int r, int c) { const int st = (r >> 4) * 2 + (c >> 5), rr = r & 15, cc = c & 31, ob = rr * 64 + cc * 2; return st * 1024 + (ob ^ (((ob >> 9) & 1) << 5)); }
__host__ __device__ __forceinline__ void stage_rc(int b, int& R, int& C) { const int st = b / 1024, sb = b % 1024, swz = sb ^ (((sb >> 9) & 1) << 5); R = (st >> 1) * 16 + swz / 64; C = (st & 1) * 32 + (swz % 64) / 2; }
__host__ __device__ __forceinline__ int perm32(int rho) { const int n = rho >> 4, i = rho & 15; return 8 * (i >> 2) + 4 * n + (i & 3); }

struct Unit { int pm, pn; };
struct Gemm { const bf16_t* A; const bf16_t* Bt; int M, N, K; };

struct StaticOrder {
    int nM, nN, nwg, G, c, rep = 1;
    __host__ __device__ void init(int M, int N, int G_, int c_) { nM = M / BM; nN = N / BM; nwg = nM * nN; G = G_; c = c_; }
    __host__ __device__ bool next(int i, Unit& u) const {
        long L = (long)i * G + c; if (L >= (long)nwg * rep) return false; L %= nwg;
        int wgid = (int)L; { const int q = nwg / NXCD, r = nwg % NXCD, xcd = wgid % NXCD, off = wgid / NXCD; wgid = (xcd < r ? xcd * (q + 1) : r * (q + 1) + (xcd - r) * q) + off; }
        const int nig = WGM * nN, gid = wgid / nig, fm = gid * WGM, gsz = (nM - fm) < WGM ? (nM - fm) : WGM;
        u.pm = fm + ((wgid % nig) % gsz); u.pn = (wgid % nig) / gsz; return true;
    }
    __device__ __forceinline__ void a_ready(const Unit&) const {}
    __device__ __forceinline__ void done(const Unit&) const {}
};


typedef float f32x2_t __attribute__((ext_vector_type(2))); typedef __bf16 bf16x2_t __attribute__((ext_vector_type(2)));
__device__ __forceinline__ unsigned cvtpk(float lo, float hi) { f32x2_t v = {lo, hi}; bf16x2_t b = __builtin_convertvector(v, bf16x2_t); return __builtin_bit_cast(unsigned, b); }
__device__ __forceinline__ u32x4 pack8(const f32x4& a, const f32x4& b) { u32x4 w; w.x = cvtpk(a[0], a[1]); w.y = cvtpk(a[2], a[3]); w.z = cvtpk(b[0], b[1]); w.w = cvtpk(b[2], b[3]); return w; }
__device__ __forceinline__ float sumsq4(const f32x4& a) { return (a[0] * a[0] + a[1] * a[1]) + (a[2] * a[2] + a[3] * a[3]); }
__device__ __forceinline__ float silu1(float v) { return v * __builtin_amdgcn_rcpf(1.0f + __builtin_amdgcn_exp2f(-v * LOG2E)); }
__device__ __forceinline__ f32x4 silu4(const f32x4& a) { return (f32x4){silu1(a[0]), silu1(a[1]), silu1(a[2]), silu1(a[3])}; }
__device__ __forceinline__ float quad_sum(float s) { s += __shfl_xor(s, 16); s += __shfl_xor(s, 32); return s; }
__device__ __forceinline__ void rope8(const f32x4& a0, const f32x4& a1, const f32x4& b0, const f32x4& b1, const float* rc, const float* rs, int pos, int i0, u32x4& o1, u32x4& o2) {
    const f32x4 c0 = *(const f32x4*)(rc + pos * 32 + i0), c1 = *(const f32x4*)(rc + pos * 32 + i0 + 4), s0 = *(const f32x4*)(rs + pos * 32 + i0), s1 = *(const f32x4*)(rs + pos * 32 + i0 + 4);
    o1 = pack8(a0 * c0 - b0 * s0, a1 * c1 - b1 * s1); o2 = pack8(a0 * s0 + b0 * c0, a1 * s1 + b1 * c1);
}
#define PG8_EPI_ROWS(...) _Pragma("unroll") for (int ai = 0; ai < 2; ++ai) _Pragma("unroll") for (int m = 0; m < 4; ++m) { const int row = u.pm * BM + ai * HALF + wr * 64 + m * 16 + fr; __VA_ARGS__ }

struct FEpi1 {
    static constexpr bool PERM = true, AFTER_DRAIN = false; unsigned char* ws;
    __device__ __forceinline__ void operator()(const f32x4 (&acc)[2][2][4][2], const Unit& u, int wr, int wc, int fr, int fq) const {
        const int pn = u.pn, cw = wc * 32 + 8 * fq; const float* ssx = (const float*)(ws + WS_SSX);
        PG8_EPI_ROWS(
            const float rs = rsqrtf(ssx[row] * (1.0f / 2048.0f) + EPS);
            if (pn < 4) { bf16_t* dst = (bf16_t*)(ws + (pn < 2 ? WS_CQ : WS_CKV)) + (size_t)row * 512 + (pn & 1) * 256 + cw; float ss = 0.f;
                _Pragma("unroll") for (int bj = 0; bj < 2; ++bj) { const f32x4 v0 = acc[ai][bj][m][0] * rs, v1 = acc[ai][bj][m][1] * rs; ss += sumsq4(v0) + sumsq4(v1); *(u32x4*)(dst + bj * HALF) = pack8(v0, v1); }
                ss = quad_sum(ss); if (fq == 0) ((float*)(ws + WS_SSC))[(size_t)row * 16 + pn * 4 + wc] = ss; }
            else if (pn == 4) { if (wc == 0) { const float* rc = (const float*)(ws + WS_ROPE); u32x4 o1, o2;
                rope8(acc[ai][0][m][0] * rs, acc[ai][0][m][1] * rs, acc[ai][1][m][0] * rs, acc[ai][1][m][1] * rs, rc, rc + 4096 * 32, row % SEQ, 8 * fq, o1, o2);
                bf16_t* dst = (bf16_t*)(ws + WS_KR) + (size_t)row * 64 + 8 * fq; *(u32x4*)dst = o1; *(u32x4*)(dst + 32) = o2; } }
            else if (pn < 17) { const int t = pn - 5; bf16_t* dst = (bf16_t*)(ws + (t < 4 ? WS_QB : t < 8 ? WS_KB : WS_VB)) + (size_t)row * 1024 + (t & 3) * 256 + cw; const float sc = t < 4 ? rs * D128_QSCALE : rs;
                _Pragma("unroll") for (int bj = 0; bj < 2; ++bj) *(u32x4*)(dst + bj * HALF) = pack8(acc[ai][bj][m][0] * sc, acc[ai][bj][m][1] * sc); }
            else { bf16_t* dst = (bf16_t*)(ws + WS_SG) + (size_t)row * 2048 + (pn - 17) * 256 + cw;
                _Pragma("unroll") for (int bj = 0; bj < 2; ++bj) *(u32x4*)(dst + bj * HALF) = pack8(silu4(acc[ai][bj][m][0] * rs), silu4(acc[ai][bj][m][1] * rs)); }
        )
    }
};
struct FEpi2a {
    static constexpr bool PERM = true, AFTER_DRAIN = false; unsigned char* ws;
    __device__ __forceinline__ void operator()(const f32x4 (&acc)[2][2][4][2], const Unit& u, int wr, int wc, int fr, int fq) const {
        const int pn = u.pn, cw = wc * 32 + 8 * fq;
        PG8_EPI_ROWS(
            const f32x4* sp = (const f32x4*)((const float*)(ws + WS_SSC) + (size_t)row * 16); const f32x4 p0 = sp[0], p1 = sp[1];
            const float rs = rsqrtf(((p0[0] + p0[1]) + (p0[2] + p0[3]) + (p1[0] + p1[1]) + (p1[2] + p1[3])) * (1.0f / 512.0f) + EPS) * MLA_QSCALE;
            if (pn < 4) { bf16_t* dst = (bf16_t*)(ws + WS_QN) + (size_t)row * 1024 + pn * 256 + cw;
                _Pragma("unroll") for (int bj = 0; bj < 2; ++bj) *(u32x4*)(dst + bj * HALF) = pack8(acc[ai][bj][m][0] * rs, acc[ai][bj][m][1] * rs); }
            else { const float* rc = (const float*)(ws + WS_ROPE); u32x4 o1, o2; const int head = 4 * (pn - 4) + wc;
                rope8(acc[ai][0][m][0] * rs, acc[ai][0][m][1] * rs, acc[ai][1][m][0] * rs, acc[ai][1][m][1] * rs, rc, rc + 4096 * 32, row % SEQ, 8 * fq, o1, o2);
                bf16_t* dst = (bf16_t*)(ws + WS_QR) + (size_t)row * 512 + head * 64 + 8 * fq; *(u32x4*)dst = o1; *(u32x4*)(dst + 32) = o2; }
        )
    }
};
struct FEpi2b {
    static constexpr bool PERM = true, AFTER_DRAIN = false; unsigned char* ws;
    __device__ __forceinline__ void operator()(const f32x4 (&acc)[2][2][4][2], const Unit& u, int wr, int wc, int fr, int fq) const {
        const int pn = u.pn, cw = wc * 32 + 8 * fq;
        PG8_EPI_ROWS(
            const f32x4* sp = (const f32x4*)((const float*)(ws + WS_SSC) + (size_t)row * 16 + 8); const f32x4 p0 = sp[0], p1 = sp[1];
            const float rs = rsqrtf(((p0[0] + p0[1]) + (p0[2] + p0[3]) + (p1[0] + p1[1]) + (p1[2] + p1[3])) * (1.0f / 512.0f) + EPS);
            bf16_t* dst = (bf16_t*)(ws + (pn < 4 ? WS_KN : WS_VA)) + (size_t)row * 1024 + (pn & 3) * 256 + cw;
            _Pragma("unroll") for (int bj = 0; bj < 2; ++bj) *(u32x4*)(dst + bj * HALF) = pack8(acc[ai][bj][m][0] * rs, acc[ai][bj][m][1] * rs);
        )
    }
};
struct FEpi4 {
    static constexpr bool PERM = true, AFTER_DRAIN = false; unsigned char* ws; const float* x; float* out;
    __device__ __forceinline__ void operator()(const f32x4 (&acc)[2][2][4][2], const Unit& u, int wr, int wc, int fr, int fq) const {
        const int pn = u.pn, cw = pn * 256 + wc * 32 + 8 * fq;
        const size_t off0 = (size_t)(u.pm * BM + wr * 64 + fr) * 2048 + cw;
        f32x4 pre[2][4];
#define EPI4_LOAD(q, slot) { const float* p_ = x + off0 + (size_t)(((q) >> 2) * HALF + ((q) & 3) * 16) * 2048; pre[slot][0] = *(const f32x4*)p_; pre[slot][1] = *(const f32x4*)(p_ + 4); pre[slot][2] = *(const f32x4*)(p_ + HALF); pre[slot][3] = *(const f32x4*)(p_ + HALF + 4); }
        EPI4_LOAD(0, 0) EPI4_LOAD(1, 1)
#pragma unroll
        for (int q = 0; q < 8; ++q) { const int ai = q >> 2, m = q & 3; const size_t off = off0 + (size_t)(ai * HALF + m * 16) * 2048;
            const f32x4 v00 = pre[q & 1][0] + acc[ai][0][m][0], v01 = pre[q & 1][1] + acc[ai][0][m][1], v10 = pre[q & 1][2] + acc[ai][1][m][0], v11 = pre[q & 1][3] + acc[ai][1][m][1];
            if (q + 2 < 8) EPI4_LOAD(q + 2, q & 1)
            *(u32x4*)((bf16_t*)(ws + WS_X1BF) + off) = pack8(v00, v01); *(u32x4*)((bf16_t*)(ws + WS_X1BF) + off + HALF) = pack8(v10, v11);
            float ss = (sumsq4(v00) + sumsq4(v01)) + (sumsq4(v10) + sumsq4(v11));
            ss = quad_sum(ss); if (fq == 0) ((float*)(ws + WS_SSX1))[(size_t)(u.pm * BM + ai * HALF + wr * 64 + m * 16 + fr) * 32 + pn * 4 + wc] = ss; }
#undef EPI4_LOAD
    }
};
struct FEpi5 {
    static constexpr bool PERM = true, AFTER_DRAIN = false; unsigned char* ws;
    __device__ __forceinline__ void operator()(const f32x4 (&acc)[2][2][4][2], const Unit& u, int wr, int wc, int fr, int fq) const {
        const int pn = u.pn, cw = (pn & 7) * 256 + wc * 32 + 8 * fq; const int sel = pn >> 3;
        PG8_EPI_ROWS(
            const f32x4* sp = (const f32x4*)((const float*)(ws + WS_SSX1) + (size_t)row * 32 + 8 * fq); const f32x4 p0 = sp[0], p1 = sp[1];
            const float tot = quad_sum((p0[0] + p0[1]) + (p0[2] + p0[3]) + (p1[0] + p1[1]) + (p1[2] + p1[3]));
            const float rs = rsqrtf(tot * (1.0f / 2048.0f) + EPS);
            bf16_t* dst = (bf16_t*)(ws + (sel == 0 ? WS_Q2 : sel == 1 ? WS_K2 : sel == 2 ? WS_V2 : WS_SG2)) + (size_t)row * 2048 + cw;
            if (sel == 3) { _Pragma("unroll") for (int bj = 0; bj < 2; ++bj) *(u32x4*)(dst + bj * HALF) = pack8(silu4(acc[ai][bj][m][0] * rs), silu4(acc[ai][bj][m][1] * rs)); }
            else { const float sc = sel == 0 ? rs * D128_QSCALE : rs;
                _Pragma("unroll") for (int bj = 0; bj < 2; ++bj) *(u32x4*)(dst + bj * HALF) = pack8(acc[ai][bj][m][0] * sc, acc[ai][bj][m][1] * sc); }
        )
    }
};
struct FEpi7 {
    static constexpr bool PERM = true, AFTER_DRAIN = false; bf16_t* x2; const bf16_t* x1;
    __device__ __forceinline__ void operator()(const f32x4 (&acc)[2][2][4][2], const Unit& u, int wr, int wc, int fr, int fq) const {
        const int cw = u.pn * 256 + wc * 32 + 8 * fq;
        const size_t off0 = (size_t)(u.pm * BM + wr * 64 + fr) * 2048 + cw;
        u32x4 pre[2][2];
#define EPI7_LOAD(q, slot) { const bf16_t* p_ = x1 + off0 + (size_t)(((q) >> 2) * HALF + ((q) & 3) * 16) * 2048; pre[slot][0] = *(const u32x4*)p_; pre[slot][1] = *(const u32x4*)(p_ + HALF); }
        EPI7_LOAD(0, 0) EPI7_LOAD(1, 1)
#pragma unroll
        for (int q = 0; q < 8; ++q) { const int ai = q >> 2, m = q & 3; const size_t off = off0 + (size_t)(ai * HALF + m * 16) * 2048;
            const u32x4 r0 = pre[q & 1][0], r1 = pre[q & 1][1];
            if (q + 2 < 8) EPI7_LOAD(q + 2, q & 1)
#define BFLO(w) __uint_as_float((w) << 16)
#define BFHI(w) __uint_as_float((w) & 0xffff0000u)
            *(u32x4*)(x2 + off) = pack8((f32x4){BFLO(r0[0]), BFHI(r0[0]), BFLO(r0[1]), BFHI(r0[1])} + acc[ai][0][m][0], (f32x4){BFLO(r0[2]), BFHI(r0[2]), BFLO(r0[3]), BFHI(r0[3])} + acc[ai][0][m][1]);
            *(u32x4*)(x2 + off + HALF) = pack8((f32x4){BFLO(r1[0]), BFHI(r1[0]), BFLO(r1[1]), BFHI(r1[1])} + acc[ai][1][m][0], (f32x4){BFLO(r1[2]), BFHI(r1[2]), BFLO(r1[3]), BFHI(r1[3])} + acc[ai][1][m][1]); }
#undef BFLO
#undef BFHI
#undef EPI7_LOAD
    }
};
template <class Epi, class Sched, bool ALIGN_EPI = false, bool SP2 = false>
__device__ __forceinline__ void gemm_phase(PG8_LAS unsigned char* lds, const Gemm g, const Sched& S, const Epi& E, const int tid) {
    const int wid = __builtin_amdgcn_readfirstlane(tid >> 6), lane = tid & 63, wr = wid >> 2, wc = wid & 3, fr = lane & 15, fq = lane >> 4;
    const int K = g.K, nt = K / BK;
    unsigned voffA[2], voffB[2];
#pragma unroll
    for (int i = 0; i < 2; ++i) { int R, C; stage_rc(tid * 16 + i * 8192, R, C); const int Rb = Epi::PERM ? ((R & ~31) + perm32(R & 31)) : R;
        voffA[i] = (unsigned)(R * K + C) * 2u; voffB[i] = (unsigned)(Rb * K + C) * 2u; }
    const size_t kstep = (size_t)(BK * 2);
    const size_t hstep = (size_t)HALF * K * 2;
    const size_t tstep = 2 * hstep;
    const unsigned ldsw = (unsigned)wid * 1024u;
    const int aoff = lds_byte(wr * 64 + fr, fq * 8), boff = lds_byte(wc * 32 + fr, fq * 8);
#define PG8_SA(b, h) (((b) * 2 + (h)) * HTB)
#define PG8_SB(b, h) ((4 + (b) * 2 + (h)) * HTB)
#define PG8_STAGE(bufoff, gbase, voff) do { _Pragma("unroll") for (int _i = 0; _i < 2; ++_i) \
        __builtin_amdgcn_global_load_lds((const unsigned*)((const char*)(gbase) + (voff)[_i]), (PG8_LAS unsigned*)(lds + (bufoff) + ldsw + _i * 8192), 16, 0, 0); } while (0)
#define PG8_LDA(dst, b, h) do { _Pragma("unroll") for (int m = 0; m < 4; ++m) _Pragma("unroll") for (int k = 0; k < 2; ++k) dst[m][k] = *(const PG8_LAS bf16x8*)(lds + PG8_SA(b, h) + aoff + m * 2048 + k * 1024); } while (0)
#define PG8_LDB(dst, b, h) do { _Pragma("unroll") for (int n = 0; n < 2; ++n) _Pragma("unroll") for (int k = 0; k < 2; ++k) dst[n][k] = *(const PG8_LAS bf16x8*)(lds + PG8_SB(b, h) + boff + n * 2048 + k * 1024); } while (0)
#define PG8_MMA(ai, bj, At, Bt) do { __builtin_amdgcn_s_setprio(1); _Pragma("unroll") for (int m = 0; m < 4; ++m) _Pragma("unroll") for (int n = 0; n < 2; ++n) _Pragma("unroll") for (int k = 0; k < 2; ++k) \
        acc[ai][bj][m][n] = __builtin_amdgcn_mfma_f32_16x16x32_bf16(Bt[n][k], At[m][k], acc[ai][bj][m][n], 0, 0, 0); __builtin_amdgcn_s_setprio(0); } while (0)
#define PG8_WAIT_V(n) asm volatile("s_waitcnt vmcnt(" #n ")" ::: "memory")
#define PG8_WAIT_L(n) asm volatile("s_waitcnt lgkmcnt(" #n ")" ::: "memory")
#define PG8_BAR __builtin_amdgcn_s_barrier()
#define PG8_SCHED __builtin_amdgcn_sched_barrier(0)
    Unit cur, nxt; int ui = 0;
    if (!S.next(0, cur)) return;
    f32x4 acc[2][2][4][2];
#pragma unroll
    for (int a = 0; a < 2; ++a)
#pragma unroll
        for (int b = 0; b < 2; ++b)
#pragma unroll
            for (int m = 0; m < 4; ++m)
#pragma unroll
                for (int n = 0; n < 2; ++n) acc[a][b][m][n] = (f32x4){0.f, 0.f, 0.f, 0.f};
    bf16x8 At[4][2], B0[2][2], B1[2][2];
    const char* cA = (const char*)g.A + (size_t)cur.pm * tstep; const char* cB = (const char*)g.Bt + (size_t)cur.pn * tstep;
    S.a_ready(cur);
    if constexpr (SP2) {
        PG8_STAGE(PG8_SB(0, 0), cB, voffB); PG8_STAGE(PG8_SB(0, 1), cB + hstep, voffB); PG8_STAGE(PG8_SA(0, 0), cA, voffA); PG8_STAGE(PG8_SA(0, 1), cA + hstep, voffA);
        if (wr == 1) PG8_BAR;
        PG8_WAIT_V(2); PG8_BAR;
        PG8_STAGE(PG8_SB(1, 0), cB + kstep, voffB); PG8_STAGE(PG8_SA(1, 0), cA + kstep, voffA); PG8_STAGE(PG8_SB(1, 1), cB + hstep + kstep, voffB);
        PG8_WAIT_V(6); PG8_BAR;
    } else {
        PG8_STAGE(PG8_SB(0, 0), cB, voffB); PG8_STAGE(PG8_SA(0, 0), cA, voffA); PG8_STAGE(PG8_SB(0, 1), cB + hstep, voffB); PG8_STAGE(PG8_SA(0, 1), cA + hstep, voffA);
        if (wr == 1) PG8_BAR;
        PG8_WAIT_V(4); PG8_BAR;
        PG8_STAGE(PG8_SB(1, 0), cB + kstep, voffB); PG8_STAGE(PG8_SA(1, 0), cA + kstep, voffA); PG8_STAGE(PG8_SB(1, 1), cB + hstep + kstep, voffB);
        PG8_WAIT_V(6); PG8_BAR;
    }
    for (;;) {
        const bool has_next = S.next(ui + 1, nxt);
        const char* nA = has_next ? (const char*)g.A + (size_t)nxt.pm * tstep : cA; const char* nB = has_next ? (const char*)g.Bt + (size_t)nxt.pn * tstep : cB;
        for (int t = 0; t < nt; t += 2) {
            const bool last = (t == nt - 2);
            const char* a1 = cA + (size_t)(t + 1) * kstep;
            const char* a2 = last ? nA : cA + (size_t)(t + 2) * kstep; const char* b2 = last ? nB : cB + (size_t)(t + 2) * kstep;
            const char* a3 = a2 + kstep; const char* b3 = b2 + kstep;
            if (last && has_next) S.a_ready(nxt);
            if constexpr (SP2) {
            PG8_LDB(B0, 0, 0); PG8_LDB(B1, 0, 1); PG8_SCHED; PG8_LDA(At, 0, 0); PG8_STAGE(PG8_SA(1, 1), a1 + hstep, voffA);
            PG8_WAIT_V(8); PG8_WAIT_L(0); PG8_BAR; PG8_MMA(0, 0, At, B0); PG8_MMA(0, 1, At, B1); PG8_BAR; PG8_SCHED;
            PG8_LDA(At, 0, 1); PG8_STAGE(PG8_SB(0, 0), b2, voffB); PG8_STAGE(PG8_SB(0, 1), b2 + hstep, voffB); PG8_STAGE(PG8_SA(0, 0), a2, voffA);
            PG8_WAIT_V(8); PG8_WAIT_L(0); PG8_BAR; PG8_MMA(1, 0, At, B0); PG8_MMA(1, 1, At, B1); PG8_BAR; PG8_SCHED;
            PG8_LDB(B0, 1, 0); PG8_LDB(B1, 1, 1); PG8_SCHED; PG8_LDA(At, 1, 0); PG8_STAGE(PG8_SA(0, 1), a2 + hstep, voffA);
            PG8_WAIT_V(8); PG8_WAIT_L(0); PG8_BAR; PG8_MMA(0, 0, At, B0); PG8_MMA(0, 1, At, B1); PG8_BAR; PG8_SCHED;
            PG8_LDA(At, 1, 1); PG8_STAGE(PG8_SB(1, 0), b3, voffB); PG8_STAGE(PG8_SB(1, 1), b3 + hstep, voffB); PG8_STAGE(PG8_SA(1, 0), a3, voffA);
            PG8_WAIT_V(8); PG8_WAIT_L(0); PG8_BAR; PG8_MMA(1, 0, At, B0); PG8_MMA(1, 1, At, B1); PG8_BAR; PG8_SCHED;
            } else {
            PG8_LDB(B0, 0, 0); PG8_SCHED; PG8_LDA(At, 0, 0); PG8_STAGE(PG8_SA(1, 1), a1 + hstep, voffA);
            PG8_WAIT_L(8); PG8_BAR; PG8_WAIT_L(0); PG8_MMA(0, 0, At, B0); PG8_BAR; PG8_SCHED;
            PG8_LDB(B1, 0, 1); PG8_STAGE(PG8_SB(0, 0), b2, voffB);
            PG8_BAR; PG8_WAIT_L(0); PG8_MMA(0, 1, At, B1); PG8_BAR;
            PG8_LDA(At, 0, 1); PG8_STAGE(PG8_SA(0, 0), a2, voffA);
            PG8_BAR; PG8_WAIT_L(0); PG8_MMA(1, 0, At, B0); PG8_BAR; PG8_SCHED;
            PG8_STAGE(PG8_SB(0, 1), b2 + hstep, voffB);
            PG8_WAIT_V(6); PG8_BAR; PG8_MMA(1, 1, At, B1); PG8_BAR;
            PG8_LDB(B0, 1, 0); PG8_SCHED; PG8_LDA(At, 1, 0); PG8_STAGE(PG8_SA(0, 1), a2 + hstep, voffA);
            PG8_WAIT_L(8); PG8_BAR; PG8_WAIT_L(0); PG8_MMA(0, 0, At, B0); PG8_BAR; PG8_SCHED;
            PG8_LDB(B1, 1, 1); PG8_STAGE(PG8_SB(1, 0), b3, voffB);
            PG8_BAR; PG8_WAIT_L(0); PG8_MMA(0, 1, At, B1); PG8_BAR;
            PG8_LDA(At, 1, 1); PG8_STAGE(PG8_SA(1, 0), a3, voffA);
            PG8_BAR; PG8_WAIT_L(0); PG8_MMA(1, 0, At, B0); PG8_BAR; PG8_SCHED;
            PG8_STAGE(PG8_SB(1, 1), b3 + hstep, voffB);
            PG8_WAIT_V(6); PG8_BAR; PG8_MMA(1, 1, At, B1); PG8_BAR;
            }
        }
        if constexpr (ALIGN_EPI) { if (wr == 0) PG8_BAR; }
        if constexpr (!Epi::AFTER_DRAIN) { E(acc, cur, wr, wc, fr, fq); S.done(cur); }
        if (!has_next) break;
#pragma unroll
        for (int a = 0; a < 2; ++a)
#pragma unroll
            for (int b = 0; b < 2; ++b)
#pragma unroll
                for (int m = 0; m < 4; ++m)
#pragma unroll
                    for (int n = 0; n < 2; ++n) acc[a][b][m][n] = (f32x4){0.f, 0.f, 0.f, 0.f};
        cur = nxt; cA = nA; cB = nB; ++ui;
        if constexpr (ALIGN_EPI) { if (wr == 1) PG8_BAR; }
    }
    PG8_WAIT_V(0);
    if constexpr (!ALIGN_EPI) { if (wr == 0) PG8_BAR; }
    PG8_BAR;
    if constexpr (Epi::AFTER_DRAIN) { E.fused(acc, cur, wr, wc, fr, fq, lds, wid, lane); S.done(cur); }
#undef PG8_SA
#undef PG8_SB
#undef PG8_STAGE
#undef PG8_LDA
#undef PG8_LDB
#undef PG8_MMA
#undef PG8_WAIT_V
#undef PG8_WAIT_L
#undef PG8_BAR
#undef PG8_SCHED
}
}

#define LAS __attribute__((address_space(3)))
template <class Epi> __global__ void __launch_bounds__(512, 2) k_gemm_fast(pg8::Gemm g, Epi E) {
    extern __shared__ __attribute__((aligned(16))) unsigned char lds[];
    pg8::StaticOrder S; S.init(g.M, g.N, (int)gridDim.x, (int)blockIdx.x);
    pg8::gemm_phase<Epi, pg8::StaticOrder, true, true>((LAS unsigned char*)lds, g, S, E, (int)threadIdx.x);
}

template <class Epi>
__global__ void __launch_bounds__(256) k_gemm_naive(const bf16_t* A, const bf16_t* Bt, int N, int K, Epi epi) {
    __shared__ float As[64][33], Bs[64][33];
    const int tid = threadIdx.x, tx = tid & 15, ty = tid >> 4;
    const int nbn = N / 64; const int bm = blockIdx.x / nbn, bn = blockIdx.x % nbn;
    float acc[4][4] = {};
    const int lr = tid >> 2, lc = (tid & 3) * 8;
    for (int k0 = 0; k0 < K; k0 += 32) {
        const u32x4 av = *(const u32x4*)(A + (size_t)(bm * 64 + lr) * K + k0 + lc);
        const u32x4 bv = *(const u32x4*)(Bt + (size_t)(bn * 64 + lr) * K + k0 + lc);
        __syncthreads();
#pragma unroll
        for (int j = 0; j < 4; ++j) { As[lr][lc + 2 * j] = __uint_as_float(av[j] << 16); As[lr][lc + 2 * j + 1] = __uint_as_float(av[j] & 0xffff0000u);
                                      Bs[lr][lc + 2 * j] = __uint_as_float(bv[j] << 16); Bs[lr][lc + 2 * j + 1] = __uint_as_float(bv[j] & 0xffff0000u); }
        __syncthreads();
#pragma unroll 8
        for (int kk = 0; kk < 32; ++kk) { float a[4], b[4];
#pragma unroll
            for (int i = 0; i < 4; ++i) { a[i] = As[ty * 4 + i][kk]; b[i] = Bs[tx * 4 + i][kk]; }
#pragma unroll
            for (int i = 0; i < 4; ++i)
#pragma unroll
                for (int j = 0; j < 4; ++j) acc[i][j] += a[i] * b[j]; }
    }
#pragma unroll
    for (int i = 0; i < 4; ++i)
#pragma unroll
        for (int j = 0; j < 4; ++j) epi(bm * 64 + ty * 4 + i, bn * 64 + tx * 4 + j, acc[i][j]);
}

template <bool F32>
__global__ void __launch_bounds__(256) k_rowss(const void* src, int ld, int ncols, float* dst, int dst_ld, int nslots) {
    const int lane = threadIdx.x & 63, row = blockIdx.x * 4 + (threadIdx.x >> 6);
    float s = 0.f;
    for (int c = lane; c < ncols; c += 64) { const float v = F32 ? ((const float*)src)[(size_t)row * ld + c] : bf2f(((const bf16_t*)src)[(size_t)row * ld + c]); s += v * v; }
    s = wave_sum(s);
    if (lane < nslots) dst[(size_t)row * dst_ld + lane] = lane == 0 ? s : 0.f;
}

__global__ void __launch_bounds__(256) k_rope(bf16_t* buf, int nh, const float* rc, const float* rs) {
    const int idx = blockIdx.x * 256 + threadIdx.x; const int per_row = nh * 32; if (idx >= M * per_row) return;
    const int row = idx / per_row, t = idx % per_row, h = t >> 5, i = t & 31, pos = row % SEQ;
    bf16_t* p = buf + (size_t)row * nh * 64 + h * 64; const float x1 = bf2f(p[i]), x2 = bf2f(p[32 + i]); const float cs = rc[pos * 32 + i], sn = rs[pos * 32 + i];
    p[i] = f2bf(x1 * cs - x2 * sn); p[32 + i] = f2bf(x1 * sn + x2 * cs);
}

template <int D> DI float dot_row(const float* q, const bf16_t* k) {
    float s = 0.f;
#pragma unroll
    for (int d = 0; d < D; d += 8) { const u32x4 v = *(const u32x4*)(k + d);
#pragma unroll
        for (int j = 0; j < 4; ++j) { s += q[d + 2 * j] * __uint_as_float(v[j] << 16); s += q[d + 2 * j + 1] * __uint_as_float(v[j] & 0xffff0000u); } }
    return s;
}

__global__ void __launch_bounds__(256) k_mla_naive(Ctx c) {
    __shared__ float qs[4][192];
    const int lane = threadIdx.x & 63, w = threadIdx.x >> 6; const int gq = blockIdx.x * 4 + w;
    const int t = gq % SEQ, bh = gq / SEQ, h = bh % 8, b = bh / 8; const size_t row = (size_t)b * SEQ + t;
    unsigned char* ws = c.ws;
    const bf16_t *QN = (const bf16_t*)(ws + WS_QN), *QR = (const bf16_t*)(ws + WS_QR), *KN = (const bf16_t*)(ws + WS_KN), *KR = (const bf16_t*)(ws + WS_KR), *VA = (const bf16_t*)(ws + WS_VA), *SG = (const bf16_t*)(ws + WS_SG);
    for (int d = lane; d < 192; d += 64) qs[w][d] = d < 128 ? bf2f(QN[row * 1024 + h * 128 + d]) : bf2f(QR[row * 512 + h * 64 + d - 128]);
    __syncthreads();
    float m = -INFINITY, l = 0.f, o0 = 0.f, o1 = 0.f;
    for (int j0 = 0; j0 <= t; j0 += 64) {
        const int j = j0 + lane; const bool valid = j <= t; const size_t krow = (size_t)b * SEQ + (valid ? j : t);
        float s = dot_row<128>(qs[w], KN + krow * 1024 + h * 128) + dot_row<64>(qs[w] + 128, KR + krow * 64);
        if (!valid) s = -INFINITY;
        const float mn = fmaxf(m, wave_max(s)); const float alpha = exp2f(m - mn); const float p = valid ? exp2f(s - mn) : 0.f;
        l = l * alpha + wave_sum(p); o0 *= alpha; o1 *= alpha; m = mn;
        const int nj = min(64, t - j0 + 1);
        for (int jj = 0; jj < nj; ++jj) { const float pj = __shfl(p, jj); const bf16_t* vr = VA + ((size_t)b * SEQ + j0 + jj) * 1024 + h * 128; o0 += pj * bf2f(vr[lane]); o1 += pj * bf2f(vr[lane + 64]); }
    }
    bf16_t* MIX = (bf16_t*)(ws + WS_MIX); const float il = 1.0f / l;
    MIX[row * 2048 + h * 128 + lane] = f2bf(o0 * il * bf2f(SG[row * 2048 + h * 128 + lane]));
    MIX[row * 2048 + h * 128 + lane + 64] = f2bf(o1 * il * bf2f(SG[row * 2048 + h * 128 + lane + 64]));
}

__global__ void __launch_bounds__(256) k_dil_naive(Ctx c) {
    __shared__ float qs[4][128];
    const int lane = threadIdx.x & 63, w = threadIdx.x >> 6; const int gq = blockIdx.x * 4 + w;
    const int t = gq % SEQ, bh = gq / SEQ, h = bh % 8, b = bh / 8; const size_t row = (size_t)b * SEQ + t;
    unsigned char* ws = c.ws;
    const bf16_t *QB = (const bf16_t*)(ws + WS_QB), *KB = (const bf16_t*)(ws + WS_KB), *VB = (const bf16_t*)(ws + WS_VB);
    const float* bn = (const float*)(ws + WS_BIASN);
    for (int d = lane; d < 128; d += 64) qs[w][d] = bf2f(QB[row * 1024 + h * 128 + d]);
    __syncthreads();
    for (int p = 0; p < 3; ++p) { const int dil = p == 0 ? 1 : p == 1 ? 4 : 16;
        float m = -INFINITY, l = 0.f, o0 = 0.f, o1 = 0.f;
        for (int r0 = 0; r0 < 192; r0 += 64) {
            const int rel = r0 + lane; const int j = t - rel * dil; const bool valid = rel <= 128 && j >= 0; const size_t krow = (size_t)b * SEQ + (valid ? j : t);
            float s = dot_row<128>(qs[w], KB + krow * 1024 + h * 128) + bn[(p * 8 + h) * 132 + (valid ? rel : 0)];
            if (!valid) s = -INFINITY;
            const float mn = fmaxf(m, wave_max(s));
            const float alpha = exp2f(m - mn); const float pp = valid ? exp2f(s - mn) : 0.f;
            l = l * alpha + wave_sum(pp); o0 *= alpha; o1 *= alpha; m = mn;
            for (int jj = 0; jj < 64; ++jj) { const float pj = __shfl(pp, jj); if (pj != 0.f) { const int jr = t - (r0 + jj) * dil; const bf16_t* vr = VB + ((size_t)b * SEQ + jr) * 1024 + h * 128; o0 += pj * bf2f(vr[lane]); o1 += pj * bf2f(vr[lane + 64]); } }
        }
        bf16_t* OP = (bf16_t*)(ws + (p == 0 ? WS_OP0 : p == 1 ? WS_OP1 : WS_OP2)); const float il = 1.0f / l;
        OP[row * 1024 + h * 128 + lane] = f2bf(o0 * il); OP[row * 1024 + h * 128 + lane + 64] = f2bf(o1 * il);
        if (lane == 0) ((float*)(ws + WS_LSE))[((size_t)p * M + row) * 8 + h] = m + log2f(l);
    }
}

DI void dil_merge_item(unsigned char* ws, int row, int col) {
    const int h = col >> 7; const float* lse = (const float*)(ws + WS_LSE);
    const float l0 = lse[((size_t)0 * M + row) * 8 + h], l1 = lse[((size_t)1 * M + row) * 8 + h], l2 = lse[((size_t)2 * M + row) * 8 + h];
    const float mx = fmaxf(l0, fmaxf(l1, l2)); float w0 = exp2f(l0 - mx), w1 = exp2f(l1 - mx), w2 = exp2f(l2 - mx); const float inv = 1.0f / (w0 + w1 + w2); w0 *= inv; w1 *= inv; w2 *= inv;
    const u32x4 a0 = *(const u32x4*)((const bf16_t*)(ws + WS_OP0) + (size_t)row * 1024 + col), a1 = *(const u32x4*)((const bf16_t*)(ws + WS_OP1) + (size_t)row * 1024 + col),
                a2 = *(const u32x4*)((const bf16_t*)(ws + WS_OP2) + (size_t)row * 1024 + col), sg = *(const u32x4*)((const bf16_t*)(ws + WS_SG) + (size_t)row * 2048 + 1024 + col);
    u32x4 o;
#pragma unroll
    for (int j = 0; j < 4; ++j) {
        const float lo = (w0 * __uint_as_float(a0[j] << 16) + w1 * __uint_as_float(a1[j] << 16) + w2 * __uint_as_float(a2[j] << 16)) * __uint_as_float(sg[j] << 16);
        const float hi = (w0 * __uint_as_float(a0[j] & 0xffff0000u) + w1 * __uint_as_float(a1[j] & 0xffff0000u) + w2 * __uint_as_float(a2[j] & 0xffff0000u)) * __uint_as_float(sg[j] & 0xffff0000u);
        o[j] = (unsigned)f2bf(lo) | ((unsigned)f2bf(hi) << 16); }
    *(u32x4*)((bf16_t*)(ws + WS_MIX) + (size_t)row * 2048 + 1024 + col) = o;
}
__global__ void __launch_bounds__(128) k_dil_merge(Ctx c) { dil_merge_item(c.ws, blockIdx.x, threadIdx.x * 8); }

__global__ void __launch_bounds__(256) k_sb_naive(Ctx c) {
    __shared__ float qs[4][128];
    const int lane = threadIdx.x & 63, w = threadIdx.x >> 6; const int gq = blockIdx.x * 4 + w;
    const int t = gq % SEQ, bh = gq / SEQ, h = bh % 16, b = bh / 16; const size_t row = (size_t)b * SEQ + t;
    unsigned char* ws = c.ws;
    const bf16_t *Q2 = (const bf16_t*)(ws + WS_Q2), *K2 = (const bf16_t*)(ws + WS_K2), *V2 = (const bf16_t*)(ws + WS_V2), *SG2 = (const bf16_t*)(ws + WS_SG2);
    for (int d = lane; d < 128; d += 64) qs[w][d] = bf2f(Q2[row * 2048 + h * 128 + d]);
    __syncthreads();
    float carry = 0.f, o0 = 0.f, o1 = 0.f;
    for (int c0 = 0; c0 < t; c0 += 64) {
        const int j = t - 1 - c0 - lane; const bool valid = j >= 0; const size_t krow = (size_t)b * SEQ + (valid ? j : 0);
        const float z = dot_row<128>(qs[w], K2 + krow * 2048 + h * 128);
        const float sp = fmaxf(z, 0.f) + log2f(1.0f + exp2f(-fabsf(z)));
        const float L = valid ? -sp : 0.f;
        float incl = L;
#pragma unroll
        for (int o = 1; o < 64; o <<= 1) { const float v = __shfl_up(incl, o); if (lane >= o) incl += v; }
        const float between = carry + (incl - L);
        const float a = valid ? exp2f(z - sp + between) : 0.f;
        carry += __shfl(incl, 63);
        const int nj = min(64, t - c0);
        for (int jj = 0; jj < nj; ++jj) { const float aj = __shfl(a, jj); const bf16_t* vr = V2 + ((size_t)b * SEQ + t - 1 - c0 - jj) * 2048 + h * 128; o0 += aj * bf2f(vr[lane]); o1 += aj * bf2f(vr[lane + 64]); }
    }
    bf16_t* MIX2 = (bf16_t*)(ws + WS_MIX2);
    MIX2[row * 2048 + h * 128 + lane] = f2bf(o0 * bf2f(SG2[row * 2048 + h * 128 + lane]));
    MIX2[row * 2048 + h * 128 + lane + 64] = f2bf(o1 * bf2f(SG2[row * 2048 + h * 128 + lane + 64]));
}

#ifndef MLA_PIPE
#define MLA_PIPE 1
#endif
namespace att {
typedef short bf16x8 __attribute__((ext_vector_type(8)));
typedef short s16x4 __attribute__((ext_vector_type(4)));
typedef short v4i16_t __attribute__((ext_vector_type(4)));
typedef float f32x16 __attribute__((ext_vector_type(16)));
typedef _Float16 f16x8 __attribute__((ext_vector_type(8)));
typedef _Float16 f16x2 __attribute__((ext_vector_type(2)));
typedef float f32x2_t __attribute__((ext_vector_type(2))); typedef __bf16 bf16x2_t __attribute__((ext_vector_type(2)));
typedef LAS const unsigned char* lcp;
#define MFMA_BF16(a, b, c) __builtin_amdgcn_mfma_f32_32x32x16_bf16((a), (b), (c), 0, 0, 0)
#define MFMA_F16(a, b, c) __builtin_amdgcn_mfma_f32_32x32x16_f16((a), (b), (c), 0, 0, 0)
#define SBAR() __builtin_amdgcn_sched_barrier(0)
DI int crow(int g, int h) { return (g & 3) + 8 * (g >> 2) + 4 * h; }
DI unsigned off_b(unsigned row, unsigned ch) { return 256u * row + 16u * (ch ^ (((row & 3) << 2) | ((row >> 2) & 3))); }
DI unsigned cvtpk(float lo, float hi) { f32x2_t v = {lo, hi}; bf16x2_t b = __builtin_convertvector(v, bf16x2_t); return __builtin_bit_cast(unsigned, b); }
DI unsigned cvtpk_h(float lo, float hi) { f32x2_t v = {lo, hi}; f16x2 b = __builtin_convertvector(v, f16x2); return __builtin_bit_cast(unsigned, b); }
DI bf16x8 pack_bf(const f32x16& x, int s) { u32x4 p; p.x = cvtpk(x[8 * s], x[8 * s + 1]); p.y = cvtpk(x[8 * s + 2], x[8 * s + 3]); p.z = cvtpk(x[8 * s + 4], x[8 * s + 5]); p.w = cvtpk(x[8 * s + 6], x[8 * s + 7]); return __builtin_bit_cast(bf16x8, p); }
DI f16x8 pack_h(const f32x16& x, int s) { u32x4 p; p.x = cvtpk_h(x[8 * s], x[8 * s + 1]); p.y = cvtpk_h(x[8 * s + 2], x[8 * s + 3]); p.z = cvtpk_h(x[8 * s + 4], x[8 * s + 5]); p.w = cvtpk_h(x[8 * s + 6], x[8 * s + 7]); return __builtin_bit_cast(f16x8, p); }
#pragma clang diagnostic push
#pragma clang diagnostic ignored "-Winline-asm"
DI void lds_dma16(const void* g, LAS unsigned char* l) {
    const unsigned la = (unsigned)__builtin_amdgcn_readfirstlane((int)(unsigned)(size_t)l);
    asm volatile("s_mov_b32 m0, %0\n\ts_nop 0\n\tglobal_load_lds_dwordx4 %1, off" :: "s"(la), "v"(g) : "memory", "m0");
}
#pragma clang diagnostic pop
#define DMA_WAIT_ALL() asm volatile("s_waitcnt vmcnt(0)" ::: "memory")
DI s16x4 vtr(lcp p) { return __builtin_bit_cast(s16x4, __builtin_amdgcn_ds_read_tr16_b64_v4i16((LAS v4i16_t*)p)); }
DI float swap_max(float m) { auto rr = __builtin_amdgcn_permlane32_swap(__float_as_uint(m), __float_as_uint(m), false, false); return fmaxf(__uint_as_float(rr[0]), __uint_as_float(rr[1])); }
DI float swap_sum(float m) { auto rr = __builtin_amdgcn_permlane32_swap(__float_as_uint(m), __float_as_uint(m), false, false); return __uint_as_float(rr[0]) + __uint_as_float(rr[1]); }
DI float bcast_lo(float m) { auto rr = __builtin_amdgcn_permlane32_swap(__float_as_uint(m), __float_as_uint(m), false, false); return __uint_as_float(rr[0]); }
DI void o_pair8(const f32x16& o, int p, float (&e)[8]) {
#pragma unroll
    for (int i = 0; i < 4; ++i) { auto rr = __builtin_amdgcn_permlane32_swap(__float_as_uint(o[8 * p + i]), __float_as_uint(o[8 * p + 4 + i]), false, false); e[i] = __uint_as_float(rr[0]); e[4 + i] = __uint_as_float(rr[1]); }
}
DI __amdgpu_buffer_rsrc_t mk_rsrc(const void* p, unsigned bytes) { return __builtin_amdgcn_make_buffer_rsrc((void*)p, 0, bytes, 0x00020000); }
DI u32x4 bload(__amdgpu_buffer_rsrc_t rs, unsigned voff, unsigned soff) { return __builtin_amdgcn_raw_buffer_load_b128(rs, voff, soff, 0); }
struct VAddr { unsigned a[2][4]; };
DI VAddr make_vaddr(int lane) { VAddr v; const unsigned hh = lane >> 5, blk = (lane >> 4) & 1, qq = (lane & 15) >> 2, p = lane & 3;
#pragma unroll
    for (int t = 0; t < 2; ++t)
#pragma unroll
        for (int d0 = 0; d0 < 4; ++d0) v.a[t][d0] = off_b(8 * t + 4 * hh + qq, 4 * d0 + 2 * blk + (p >> 1)) + 8 * (p & 1);
    return v; }
DI bf16x8 vfrag(lcp img, int s, int d0, const VAddr& va) {
    const s16x4 lo = vtr(img + 4096 * s + va.a[0][d0]);
    const s16x4 hi = vtr(img + 4096 * s + va.a[1][d0]);
    return (bf16x8){lo[0], lo[1], lo[2], lo[3], hi[0], hi[1], hi[2], hi[3]};
}
DI void softmax_tile(f32x16& s0, f32x16& s1, f32x16 (&o)[4], float& mrun, float& lrun) {
    float mt = fmaxf(s0[0], s1[0]);
#pragma unroll
    for (int g = 1; g < 16; ++g) mt = fmaxf(mt, fmaxf(s0[g], s1[g]));
    mt = swap_max(mt);
    const float mn = fmaxf(mrun, mt), alpha = __builtin_amdgcn_exp2f(mrun - mn); mrun = mn;
    float ps = 0.f;
#pragma unroll
    for (int g = 0; g < 16; ++g) { s0[g] = __builtin_amdgcn_exp2f(s0[g] - mn); s1[g] = __builtin_amdgcn_exp2f(s1[g] - mn); ps += s0[g] + s1[g]; }
    lrun = lrun * alpha + ps;
#pragma unroll
    for (int d0 = 0; d0 < 4; ++d0)
#pragma unroll
        for (int g = 0; g < 16; ++g) o[d0][g] *= alpha;
}

constexpr int MLA_KSTR = 400, MLA_KBUF = 64 * MLA_KSTR, VBUF = 16384, MLA_LDS_V = 2 * MLA_KBUF, MLA_LDS_BYTES = 2 * MLA_KBUF + 2 * VBUF;
template <bool MASKED>
DI void mla_tile(lcp kb, lcp vb, const bf16x8 (&qf)[12], f32x16 (&o)[4], float& mrun, float& lrun, const VAddr& va, int qrel, int hh) {
    f32x16 s0, s1;
#pragma unroll
    for (int g = 0; g < 16; ++g) { s0[g] = 0.f; s1[g] = 0.f; }
    bf16x8 f0a = *(LAS const bf16x8*)kb, f0b = *(LAS const bf16x8*)(kb + 32 * MLA_KSTR), f1a = *(LAS const bf16x8*)(kb + 32), f1b = *(LAS const bf16x8*)(kb + 32 * MLA_KSTR + 32), f2a, f2b;
#pragma unroll
    for (int d0 = 0; d0 < 12; ++d0) {
        if (d0 + 2 < 12) { const bf16x8 n0 = *(LAS const bf16x8*)(kb + (d0 + 2) * 32), n1 = *(LAS const bf16x8*)(kb + 32 * MLA_KSTR + (d0 + 2) * 32);
            if ((d0 + 2) % 3 == 0) { f0a = n0; f0b = n1; } else if ((d0 + 2) % 3 == 1) { f1a = n0; f1b = n1; } else { f2a = n0; f2b = n1; } }
        SBAR();
        s0 = MFMA_BF16(d0 % 3 == 0 ? f0a : d0 % 3 == 1 ? f1a : f2a, qf[d0], s0); s1 = MFMA_BF16(d0 % 3 == 0 ? f0b : d0 % 3 == 1 ? f1b : f2b, qf[d0], s1);
        SBAR();
    }
    if (MASKED) {
#pragma unroll
        for (int g = 0; g < 16; ++g) { const int kv = crow(g, 0); if (kv > qrel - 4 * hh) s0[g] = -INFINITY; if (kv + 32 > qrel - 4 * hh) s1[g] = -INFINITY; } }
    float mt = fmaxf(s0[0], s1[0]);
#pragma unroll
    for (int g = 1; g < 16; ++g) mt = fmaxf(mt, fmaxf(s0[g], s1[g]));
    mt = swap_max(mt);
    if (__builtin_amdgcn_ballot_w64(mt > mrun) != 0ull) {
        const float mn = fmaxf(mrun, mt), alpha = __builtin_amdgcn_exp2f(mrun - mn); mrun = mn; lrun *= alpha;
#pragma unroll
        for (int d0 = 0; d0 < 4; ++d0)
#pragma unroll
            for (int g = 0; g < 16; ++g) o[d0][g] *= alpha;
    }
    float ps = 0.f;
#pragma unroll
    for (int g = 0; g < 16; ++g) { s0[g] = __builtin_amdgcn_exp2f(s0[g] - mrun); s1[g] = __builtin_amdgcn_exp2f(s1[g] - mrun); ps += s0[g] + s1[g]; }
    lrun += ps;
    bf16x8 pf[4]; pf[0] = pack_bf(s0, 0); pf[1] = pack_bf(s0, 1); pf[2] = pack_bf(s1, 0); pf[3] = pack_bf(s1, 1);
    bf16x8 v0 = vfrag(vb, 0, 0, va), v1 = vfrag(vb, 0, 1, va), v2;
#pragma unroll
    for (int j = 0; j < 16; ++j) {
        if (j + 2 < 16) { const int ks = (j + 2) >> 2, d0 = (j + 2) & 3; const bf16x8 nx = vfrag(vb + (ks >> 1) * 8192, ks & 1, d0, va);
            if ((j + 2) % 3 == 0) v0 = nx; else if ((j + 2) % 3 == 1) v1 = nx; else v2 = nx; }
        SBAR();
        o[j & 3] = MFMA_BF16(j % 3 == 0 ? v0 : j % 3 == 1 ? v1 : v2, pf[j >> 2], o[j & 3]);
        SBAR();
    }
}
DI void mla_unit(LAS unsigned char* lds, unsigned char* ws, int b, int h, int qb, const int tid_in) {
    int tid = tid_in; asm volatile("" : "+v"(tid));
    const int lane = tid & 63, wid = __builtin_amdgcn_readfirstlane(tid >> 6), r = lane & 31, hh = lane >> 5;
    const bf16_t *QN = (const bf16_t*)(ws + WS_QN), *QR = (const bf16_t*)(ws + WS_QR), *KN = (const bf16_t*)(ws + WS_KN), *KR = (const bf16_t*)(ws + WS_KR), *VA = (const bf16_t*)(ws + WS_VA), *SG = (const bf16_t*)(ws + WS_SG);
    bf16_t* MIX = (bf16_t*)(ws + WS_MIX);
    const int q0 = qb * 256, NT = 4 * (qb + 1), tmax = (q0 + 32 * wid) >> 6; const size_t rowbase = (size_t)b * SEQ;
    bf16x8 qf[12];
    { const size_t qrow = rowbase + q0 + 32 * wid + r;
#pragma unroll
      for (int d0 = 0; d0 < 8; ++d0) qf[d0] = *(const bf16x8*)(QN + qrow * 1024 + h * 128 + d0 * 16 + hh * 8);
#pragma unroll
      for (int d0 = 0; d0 < 4; ++d0) qf[8 + d0] = *(const bf16x8*)(QR + qrow * 512 + h * 64 + d0 * 16 + hh * 8); }
    f32x16 o[4];
#pragma unroll
    for (int d0 = 0; d0 < 4; ++d0)
#pragma unroll
        for (int g = 0; g < 16; ++g) o[d0][g] = 0.f;
    float mrun = -INFINITY, lrun = 0.f;
    u32x4 kreg[3], vreg[2];
    const VAddr va = make_vaddr(lane);
    const __amdgpu_buffer_rsrc_t rKN = mk_rsrc(KN, M * 1024 * 2), rKR = mk_rsrc(KR, M * 64 * 2), rVA = mk_rsrc(VA, M * 1024 * 2);
    const unsigned vo0 = (tid >> 4) * 2048 + (tid & 15) * 16, vo1 = vo0 + 32 * 2048, vor = (tid >> 3) * 128 + (tid & 7) * 16;
    const unsigned so_n = ((unsigned)rowbase * 1024 + h * 128) * 2, so_r = (unsigned)rowbase * 64 * 2;
    const unsigned lk0 = (tid >> 4) * MLA_KSTR + (tid & 15) * 16, lk1 = lk0 + 32 * MLA_KSTR, lkr = (tid >> 3) * MLA_KSTR + 256 + (tid & 7) * 16;
    const unsigned lv0 = off_b((tid >> 4) & 31, tid & 15), lv1 = lv0 + 8192;
    const unsigned kfo = r * MLA_KSTR + hh * 16;
#define MLA_LOAD(t) do { const unsigned tn = so_n + (unsigned)(t) * (64 * 2048), tr_ = so_r + (unsigned)(t) * (64 * 128); \
        kreg[0] = bload(rKN, vo0, tn); kreg[1] = bload(rKN, vo1, tn); kreg[2] = bload(rKR, vor, tr_); vreg[0] = bload(rVA, vo0, tn); vreg[1] = bload(rVA, vo1, tn); } while (0)
#define MLA_STORE(buf) do { LAS unsigned char* kd = lds + (buf) * MLA_KBUF; LAS unsigned char* vd = lds + MLA_LDS_V + (buf) * VBUF; \
        *(LAS u32x4*)(kd + lk0) = kreg[0]; *(LAS u32x4*)(kd + lk1) = kreg[1]; *(LAS u32x4*)(kd + lkr) = kreg[2]; *(LAS u32x4*)(vd + lv0) = vreg[0]; *(LAS u32x4*)(vd + lv1) = vreg[1]; } while (0)
    MLA_LOAD(0); MLA_STORE(0); __builtin_amdgcn_s_waitcnt(0x0F70);   __syncthreads();
#define MLA_INTERVAL(MODE) { const int buf = t & 1; \
        if (t + 1 < NT) MLA_LOAD(t + 1); \
        if (MODE == 0) mla_tile<false>(lds + buf * MLA_KBUF + kfo, lds + MLA_LDS_V + buf * VBUF, qf, o, mrun, lrun, va, 0, hh); \
        if (MODE == 1) mla_tile<true>(lds + buf * MLA_KBUF + kfo, lds + MLA_LDS_V + buf * VBUF, qf, o, mrun, lrun, va, q0 + 32 * wid + r - 64 * t, hh); \
        if (t + 1 < NT) MLA_STORE(buf ^ 1); \
        __syncthreads(); }
    int t = 0;
    for (; t < tmax; ++t) MLA_INTERVAL(0)
    MLA_INTERVAL(1)
    for (++t; t < NT; ++t) MLA_INTERVAL(2)
#undef MLA_INTERVAL
#undef MLA_LOAD
#undef MLA_STORE
    const float inv = 1.0f / swap_sum(lrun);
    int t4 = tid; asm volatile("" : "+v"(t4)); const size_t qrow = rowbase + q0 + 32 * wid + (t4 & 31); const int hh2 = (t4 >> 5) & 1;
#pragma unroll
    for (int d0 = 0; d0 < 4; ++d0)
#pragma unroll
        for (int gg = 0; gg < 4; ++gg) { const size_t off = qrow * 2048 + h * 128 + 32 * d0 + 8 * gg + 4 * hh2;
            const unsigned long long sg = *(const unsigned long long*)(SG + off);
            const float g0 = __uint_as_float((unsigned)(sg << 16)), g1 = __uint_as_float((unsigned)sg & 0xffff0000u), g2 = __uint_as_float((unsigned)(sg >> 32) << 16), g3 = __uint_as_float((unsigned)(sg >> 32) & 0xffff0000u);
            const unsigned lo = cvtpk(o[d0][4 * gg] * inv * g0, o[d0][4 * gg + 1] * inv * g1), hi = cvtpk(o[d0][4 * gg + 2] * inv * g2, o[d0][4 * gg + 3] * inv * g3);
            *(unsigned long long*)(MIX + off) = (unsigned long long)lo | ((unsigned long long)hi << 32); }
}
DI float vmax3_s(float a, float b, float c) { float r; asm("v_max3_f32 %0, %1, %2, %3" : "=v"(r) : "v"(a), "v"(b), "v"(c)); return r; }
constexpr int M2_KBUF = 64 * 384, M2_LDS_V = 3 * M2_KBUF, M2_LDS_BYTES = M2_LDS_V + 3 * VBUF;
struct M2State { f32x16 o[4]; f32x16 negv; float mrun, lrun, nref; };
template <int KIMM, int VIMM>
DI void mla2_iter(f32x16& zin, float& rin, f32x16& zout, float& rout, M2State& st, const u32x4& pi0, const u32x4& pi1, u32x4& po0, u32x4& po1, const bf16x8 (&qf)[12], const unsigned (&koff)[4], const unsigned (&voff)[2][4],
                  const bool masked, const int qrh) {
#define M2_KF(d0) (*(LAS const bf16x8*)(koff[(d0) & 3] + (unsigned)(KIMM + 128 * ((d0) >> 2))))
#define M2_VF(t, j) vtr((lcp)(voff[t][(j) & 3] + (unsigned)(VIMM + 4096 * ((j) >> 2))))
    if (masked) {
        asm volatile("" ::: "memory");
#pragma unroll
        for (int g = 0; g < 16; ++g) if (crow(g, 0) > qrh) zin[g] = -INFINITY;
    }
    bf16x8 kfA = M2_KF(0), kfB; s16x4 la, ha, lb, hb;
    float mt = 0.f, mnew = 0.f, alpha = 1.f, ps = 0.f; bool grow = false; float pe[16];
    SBAR();
#pragma unroll
    for (int i = 0; i < 20; ++i) {
        const int c5 = i % 5, blk5 = i / 5; const bool isP = (c5 == 2 || c5 == 4);
        const int qi = blk5 * 3 + (c5 < 2 ? c5 : 2), pj = blk5 * 2 + (c5 == 2 ? 0 : 1);
        if (isP) { const s16x4 lo = (pj & 1) ? lb : la, hi = (pj & 1) ? hb : ha; const bf16x8 vf = (bf16x8){lo[0], lo[1], lo[2], lo[3], hi[0], hi[1], hi[2], hi[3]};
            st.o[pj & 3] = MFMA_BF16(vf, __builtin_bit_cast(bf16x8, (pj >> 2) ? pi1 : pi0), st.o[pj & 3]); }
        else if (i == 0) { f32x16 zero_;
#pragma unroll
            for (int g = 0; g < 16; ++g) zero_[g] = 0.f;
            (void)zero_; zout = MFMA_BF16(kfA, qf[0], st.negv); rout = st.nref; }
        else zout = MFMA_BF16((qi & 1) ? kfB : kfA, qf[qi], zout);
        if (!isP && qi + 1 < 12) { const bf16x8 nx = M2_KF(qi + 1); if ((qi + 1) & 1) kfB = nx; else kfA = nx; }
        if (isP && pj + 1 < 8) { const s16x4 l_ = M2_VF(0, pj + 1), h_ = M2_VF(1, pj + 1); if ((pj + 1) & 1) { lb = l_; hb = h_; } else { la = l_; ha = h_; } }
        if (i == 0) { la = M2_VF(0, 0); ha = M2_VF(1, 0); }
        SBAR();
        if (i < 4) { float a = vmax3_s(zin[4 * i], zin[4 * i + 1], zin[4 * i + 2]); mt = i == 0 ? vmax3_s(a, zin[3], zin[3]) : vmax3_s(mt, a, zin[4 * i + 3]); asm volatile("" : "+v"(mt)); }
        if (i == 4) { mt = swap_max(mt) + rin;
            grow = __builtin_amdgcn_ballot_w64((mt > st.mrun) || (rin != st.mrun)) != 0ull;
            if (grow) {
                mnew = fmaxf(st.mrun, mt); alpha = __builtin_amdgcn_exp2f(st.mrun - mnew); const float dl = mnew - rin;
#pragma unroll
                for (int g = 0; g < 16; ++g) zin[g] -= dl;
                st.mrun = mnew; st.lrun *= alpha; } }
        if (i >= 5 && i < 13) { const int g = 2 * (i - 5); float e0 = __builtin_amdgcn_exp2f(zin[g]), e1 = __builtin_amdgcn_exp2f(zin[g + 1]); ps += e0 + e1;
            asm volatile("" : "+v"(ps)); pe[g] = e0; pe[g + 1] = e1; }
        if (i >= 13 && i < 17) { const int w_ = i - 13; unsigned w0 = cvtpk(pe[4 * w_], pe[4 * w_ + 1]), w1 = cvtpk(pe[4 * w_ + 2], pe[4 * w_ + 3]); asm volatile("" : "+v"(w0), "+v"(w1));
            if (w_ < 2) { po0[2 * w_] = w0; po0[2 * w_ + 1] = w1; } else { po1[2 * (w_ - 2)] = w0; po1[2 * (w_ - 2) + 1] = w1; } }
        SBAR();
    }
    st.lrun += ps;
    if (grow) {
#pragma unroll
        for (int d0 = 0; d0 < 4; ++d0)
#pragma unroll
            for (int g = 0; g < 16; ++g) st.o[d0][g] *= alpha;
        st.nref = st.mrun;
#pragma unroll
        for (int g = 0; g < 16; ++g) st.negv[g] = -st.mrun;
    }
#undef M2_KF
#undef M2_VF
}
DI void mla2_unit(LAS unsigned char* lds, unsigned char* ws, int b, int h, int qb, const int tid_in) {
    int tid = tid_in; asm volatile("" : "+v"(tid));
    const int lane = tid & 63, wid = __builtin_amdgcn_readfirstlane(tid >> 6), r = lane & 31, hh = lane >> 5;
    const bf16_t *QN = (const bf16_t*)(ws + WS_QN), *QR = (const bf16_t*)(ws + WS_QR), *KN = (const bf16_t*)(ws + WS_KN), *KR = (const bf16_t*)(ws + WS_KR), *VA = (const bf16_t*)(ws + WS_VA), *SG = (const bf16_t*)(ws + WS_SG);
    bf16_t* MIX = (bf16_t*)(ws + WS_MIX);
    const int q0 = qb * 256, NT = 4 * (qb + 1), tmax = (q0 + 32 * wid) >> 6; const size_t rowbase = (size_t)b * SEQ;
    bf16x8 qf[12];
    { const size_t qrow = rowbase + q0 + 32 * wid + r;
#pragma unroll
      for (int d0 = 0; d0 < 8; ++d0) qf[d0] = *(const bf16x8*)(QN + qrow * 1024 + h * 128 + d0 * 16 + hh * 8);
#pragma unroll
      for (int d0 = 0; d0 < 4; ++d0) qf[8 + d0] = *(const bf16x8*)(QR + qrow * 512 + h * 64 + d0 * 16 + hh * 8); }
    M2State st;
#pragma unroll
    for (int d0 = 0; d0 < 4; ++d0)
#pragma unroll
        for (int g = 0; g < 16; ++g) st.o[d0][g] = 0.f;
    st.mrun = -INFINITY; st.lrun = 0.f; st.nref = 0.f;
#pragma unroll
    for (int g = 0; g < 16; ++g) st.negv[g] = 0.f;
    float ra = 0.f, rb = 0.f;
    unsigned koff[4], voff[2][4];
    { const unsigned blk = (lane >> 4) & 1, qq = (lane & 15) >> 2, p = lane & 3, f = (r >> 1) & 7;
      const unsigned kb_ = (unsigned)(size_t)lds + r * 384;
#pragma unroll
      for (int j = 0; j < 4; ++j) koff[j] = kb_ + 16 * ((2 * j + hh) ^ f);
      const unsigned vb0 = 256 * (4 * hh + qq) + 8 * (p & 1) + 16 * ((2 * blk + (p >> 1)) ^ hh), v0_ = (unsigned)(size_t)lds + M2_LDS_V + vb0, v1_ = (unsigned)(size_t)lds + M2_LDS_V + 2048 + (vb0 ^ 32);
#pragma unroll
      for (int d0 = 0; d0 < 4; ++d0) { voff[0][d0] = v0_ + ((64u * d0) ^ (64u * qq)); voff[1][d0] = v1_ + ((64u * d0) ^ (64u * qq)); } }
    const bf16_t* knb = KN + rowbase * 1024 + h * 128; const bf16_t* krb = KR + rowbase * 64; const bf16_t* vab = VA + rowbase * 1024 + h * 128;
    unsigned ksrc[3];
#pragma unroll
    for (int i_ = 0; i_ < 3; ++i_) { const int c_ = (3 * wid + i_) * 64 + lane, row_ = c_ / 24, ch_ = (c_ % 24) ^ ((row_ >> 1) & 7);
        ksrc[i_] = ch_ < 16 ? (unsigned)(row_ * 1024 + ch_ * 8) : (0x80000000u | (unsigned)(row_ * 64 + (ch_ - 16) * 8)); }
#define M2_DMAK(t, slot) do { _Pragma("unroll") for (int i_ = 0; i_ < 3; ++i_) { const unsigned o_ = ksrc[i_] & 0x7fffffffu; \
            const bf16_t* src_ = (ksrc[i_] >> 31) ? krb + (size_t)(t) * (64 * 64) + o_ : knb + (size_t)(t) * (64 * 1024) + o_; \
            lds_dma16(src_, lds + (slot) * M2_KBUF + (3 * wid + i_) * 1024); } } while (0)
#define M2_DMAV(t, slot) do { int t2_ = tid; asm volatile("" : "+v"(t2_)); const int ln_ = t2_ & 63, drow_ = 8 * wid + (ln_ >> 4), c15_ = ln_ & 15; \
        const unsigned s0_ = (unsigned)drow_ * 1024 + ((c15_ ^ (((drow_ & 3) << 2) | ((drow_ >> 2) & 3))) * 8), s1_ = (unsigned)(drow_ + 4) * 1024 + ((c15_ ^ ((((drow_ + 4) & 3) << 2) | (((drow_ + 4) >> 2) & 3))) * 8); \
        const bf16_t* vt = vab + (size_t)(t) * (64 * 1024); LAS unsigned char* vd = lds + M2_LDS_V + (slot) * VBUF + wid * 2048; \
        lds_dma16(vt + s0_, vd); lds_dma16(vt + s1_, vd + 1024); } while (0)
    M2_DMAK(0, 0); M2_DMAV(0, 0); M2_DMAV(0, 2);
    if (NT > 1) M2_DMAK(1, 1);
    __builtin_amdgcn_s_waitcnt(0x0F70);
    __syncthreads();
    f32x16 za, zb;
#pragma unroll
    for (int g = 0; g < 16; ++g) { za[g] = 0.f; zb[g] = 0.f; }
#pragma unroll
    for (int d0 = 0; d0 < 12; ++d0) za = MFMA_BF16(*(LAS const bf16x8*)(koff[d0 & 3] + (unsigned)(128 * (d0 >> 2))), qf[d0], za);
    u32x4 pa[2], pb[2]; pa[0] = (u32x4){0u, 0u, 0u, 0u}; pa[1] = pa[0]; pb[0] = pa[0]; pb[1] = pa[0];
#define M2_INTERVAL(P) { if (t + 2 < NT) M2_DMAK(t + 2, ((P) + 2) % 3); if (t + 1 < NT) M2_DMAV(t + 1, ((P) + 1) % 3); \
        if (t <= tmax) {           \
            int qrh; { int t3 = tid; asm volatile("" : "+v"(t3)); qrh = q0 + 32 * wid + (t3 & 31) - 4 * ((t3 >> 5) & 1) - 64 * t; } const bool msk = t == tmax; \
            mla2_iter<(P) * M2_KBUF + 32 * 384, (((P) + 2) % 3) * VBUF + 8192>(za, ra, zb, rb, st, pa[0], pa[1], pb[0], pb[1], qf, koff, voff, msk, qrh); \
            mla2_iter<(((P) + 1) % 3) * M2_KBUF, (P) * VBUF>(zb, rb, za, ra, st, pb[0], pb[1], pa[0], pa[1], qf, koff, voff, msk, qrh - 32); \
            if (msk) {            \
                lcp vb_ = lds + M2_LDS_V + (P) * VBUF + 8192; const VAddr va_ = make_vaddr(tid & 63); \
                _Pragma("unroll") for (int j = 0; j < 8; ++j) st.o[j & 3] = MFMA_BF16(vfrag(vb_, j >> 2, j & 3, va_), __builtin_bit_cast(bf16x8, (j >> 2) ? pa[1] : pa[0]), st.o[j & 3]); } } \
        ++t; DMA_WAIT_ALL(); __syncthreads(); }
    int t = 0;
    for (;;) { M2_INTERVAL(0) if (t >= NT) break; M2_INTERVAL(1) if (t >= NT) break; M2_INTERVAL(2) if (t >= NT) break; }
#undef M2_INTERVAL
#undef M2_DMAK
#undef M2_DMAV
    const float inv = 1.0f / swap_sum(st.lrun);
    int t4 = tid; asm volatile("" : "+v"(t4)); const size_t qrow = rowbase + q0 + 32 * wid + (t4 & 31); const int hh2 = (t4 >> 5) & 1;
#pragma unroll
    for (int d0 = 0; d0 < 4; ++d0)
#pragma unroll
        for (int p = 0; p < 2; ++p) { const size_t off = qrow * 2048 + h * 128 + 32 * d0 + 16 * p + 8 * hh2; float e[8]; o_pair8(st.o[d0], p, e);
            const u32x4 sg = *(const u32x4*)(SG + off); u32x4 w;
#pragma unroll
            for (int j = 0; j < 4; ++j) w[j] = cvtpk(e[2 * j] * inv * __uint_as_float(sg[j] << 16), e[2 * j + 1] * inv * __uint_as_float(sg[j] & 0xffff0000u));
            *(u32x4*)(MIX + off) = w; }
}
DI void mla_phase(LAS unsigned char* lds, unsigned char* ws, const int tid) {
    const int G = gridDim.x, bx = blockIdx.x; const int vcu = (G % 8 == 0) ? (bx % 8) * (G / 8) + bx / 8 : bx;
    for (int p = vcu; p < 256; p += G) { const int bh = p >> 3, pr = p & 7;
#if MLA_PIPE
        mla2_unit(lds, ws, bh >> 3, bh & 7, 15 - pr, tid); mla2_unit(lds, ws, bh >> 3, bh & 7, pr, tid);
#else
        mla_unit(lds, ws, bh >> 3, bh & 7, 15 - pr, tid); mla_unit(lds, ws, bh >> 3, bh & 7, pr, tid);
#endif
 }
}

constexpr int SB_KBUF = 16384, SB_LDS_V = 3 * SB_KBUF, SB_LDS_UM = SB_LDS_V + 3 * VBUF, SB_LDS_BYTES = SB_LDS_UM + 2048 + 64;
DI float vmin_s(float a, float b) { float r; asm("v_min_f32 %0, %1, %2" : "=v"(r) : "v"(a), "v"(b)); return r; }
struct SbAddr { unsigned kx, vb0, vq; };
template <bool MASKED, int VAR>
DI void sb_iter(f32x16& zin, f32x16& zout, f32x16 (&o)[4], const u32x4& pi0, const u32x4& pi1, u32x4& po0, u32x4& po1, float& carry, const bf16x8 (&qf)[8], lcp ump, lcp knext, lcp vprev, const SbAddr& ad, int qrh) {
    u32x4 lw0, lw1; const float z0 = zin[0];
    unsigned kx = ad.kx, vq = ad.vq; asm volatile("" : "+v"(kx), "+v"(vq));
    bf16x8 kfa = *(LAS const bf16x8*)(knext + kx), kfb;
#pragma unroll
    for (int k = 0; k < 8; ++k) {
        if (k == 0) {
#pragma unroll
            for (int g = 0; g < 16; ++g) zout[g] = 0.f;
        }
        if (VAR == 2 || VAR == 4 || VAR == 11 || VAR == 13) { asm volatile("" :: "v"((k & 1) ? kfb : kfa)); } else zout = MFMA_BF16((k & 1) ? kfb : kfa, qf[k], zout);
        if (VAR == 12) { zout = MFMA_BF16((k & 1) ? kfb : kfa, qf[k], zout); zout = MFMA_BF16((k & 1) ? kfb : kfa, qf[k], zout); }
        if (k + 1 < 8) { bf16x8 nx; if (VAR == 3 || VAR == 4 || VAR == 9 || VAR == 11 || VAR == 12 || VAR == 13) nx = qf[k]; else nx = *(LAS const bf16x8*)(knext + ((32u * (k + 1)) ^ kx)); if (k & 1) kfa = nx; else kfb = nx; }
        SBAR();
        float lv[2];
#pragma unroll
        for (int i = 0; i < 2; ++i) { const int g = 2 * k + i;
            float sp; if (VAR == 8 || VAR == 9 || VAR == 12) sp = zin[g]; else if (VAR == 13) { sp = __builtin_amdgcn_logf(1.0f + __builtin_amdgcn_exp2f(vmin_s(zin[g], 64.0f))); sp = __builtin_amdgcn_logf(1.0f + __builtin_amdgcn_exp2f(vmin_s(sp, 64.0f))); sp = __builtin_amdgcn_logf(1.0f + __builtin_amdgcn_exp2f(vmin_s(sp, 64.0f))); } else if (VAR == 1 || VAR == 4) sp = vmin_s(zin[g], 64.0f) * 0.5f; else sp = __builtin_amdgcn_logf(1.0f + __builtin_amdgcn_exp2f(vmin_s(zin[g], 64.0f)));
            if (MASKED) lv[i] = (crow(g, 0) < qrh) ? sp : 0.f; else lv[i] = sp; }
        unsigned w = cvtpk_h(lv[0], lv[1]);
        asm volatile("" : "+v"(w));
        if (k < 4) lw0[k & 3] = w; else lw1[k & 3] = w;
        SBAR();
    }
    const f16x8 um0 = *(LAS const f16x8*)ump, um1 = *(LAS const f16x8*)(ump + 16);
    zin = MFMA_F16(um0, __builtin_bit_cast(f16x8, lw0), zin); zin = MFMA_F16(um1, __builtin_bit_cast(f16x8, lw1), zin);
    SBAR();
    s16x4 la, ha, lb, hb;
    const unsigned vb0 = ad.vb0, vb1 = 2048 + (vb0 ^ 32);
    { const unsigned dq = vq; la = vtr(vprev + vb0 + dq); ha = vtr(vprev + vb1 + dq); }
#pragma unroll
    for (int j = 0; j < 8; ++j) {
        { const s16x4 lo = (j & 1) ? lb : la, hi = (j & 1) ? hb : ha;
          const bf16x8 vf = (bf16x8){lo[0], lo[1], lo[2], lo[3], hi[0], hi[1], hi[2], hi[3]};
          if (VAR == 2 || VAR == 4 || VAR == 11 || VAR == 13) { asm volatile("" :: "v"(vf)); } else o[j & 3] = MFMA_BF16(vf, __builtin_bit_cast(bf16x8, (j >> 2) ? pi1 : pi0), o[j & 3]);
          if (VAR == 12) { o[(j + 1) & 3] = MFMA_BF16(vf, __builtin_bit_cast(bf16x8, (j >> 2) ? pi1 : pi0), o[(j + 1) & 3]); o[(j + 2) & 3] = MFMA_BF16(vf, __builtin_bit_cast(bf16x8, (j >> 2) ? pi1 : pi0), o[(j + 2) & 3]); } }
        if (j + 1 < 8) { const unsigned dq = (64u * ((j + 1) & 3)) ^ vq; s16x4 l_, h_; if (VAR == 3 || VAR == 4 || VAR == 9 || VAR == 11 || VAR == 12 || VAR == 13) { l_ = (s16x4){(short)pi0[0], (short)pi0[1], (short)pi0[2], (short)pi0[3]}; h_ = l_; } else { l_ = vtr(vprev + 4096 * ((j + 1) >> 2) + vb0 + dq); h_ = vtr(vprev + 4096 * ((j + 1) >> 2) + vb1 + dq); }
            if (j & 1) { la = l_; ha = h_; } else { lb = l_; hb = h_; } }
        SBAR();
        float av[2];
#pragma unroll
        for (int i = 0; i < 2; ++i) { const int g = 2 * j + i; float a; if (VAR == 8 || VAR == 9 || VAR == 12) a = zin[g]; else if (VAR == 13) { a = __builtin_amdgcn_exp2f(zin[g] + carry); a = __builtin_amdgcn_exp2f(a + carry); a = __builtin_amdgcn_exp2f(a + carry); } else if (VAR == 1 || VAR == 4) a = zin[g] + carry; else a = __builtin_amdgcn_exp2f(zin[g] + carry); if (MASKED) av[i] = (crow(g, 0) < qrh) ? a : 0.f; else av[i] = a; }
        unsigned w = cvtpk(av[0], av[1]);
        asm volatile("" : "+v"(w));
        if (j < 4) po0[j & 3] = w; else po1[j & 3] = w;
        SBAR();
    }
    carry += bcast_lo(zin[0] - z0);
}
template <int KIMM, int VIMM>
DI void sb_iter_s(f32x16& zin, f32x16& zout, f32x16 (&o)[4], const u32x4& pi0, const u32x4& pi1, u32x4& po0, u32x4& po1, float& carry, const bf16x8 (&qf)[8], lcp ump,
                  const unsigned (&koff)[8], const unsigned (&voff)[2][4]) {
    u32x4 lw0, lw1; const float z0 = zin[0];
#define SB_KF(k) (*(LAS const bf16x8*)(koff[k] + (unsigned)KIMM))
#define SB_VF(t, j) vtr((lcp)(voff[t][(j) & 3] + (unsigned)(VIMM + 4096 * ((j) >> 2))))
    bf16x8 kfa = SB_KF(0), kfb;
    const f16x8 um0 = *(LAS const f16x8*)ump, um1 = *(LAS const f16x8*)(ump + 16);
    SBAR();
#pragma unroll
    for (int k = 0; k < 8; ++k) {
        if (k == 0) {
#pragma unroll
            for (int g = 0; g < 16; ++g) zout[g] = 0.f;
        }
        zout = MFMA_BF16((k & 1) ? kfb : kfa, qf[k], zout);
        if (k + 1 < 8) { const bf16x8 nx = SB_KF(k + 1); if (k & 1) kfa = nx; else kfb = nx; }
        SBAR();
        float lv[2];
#pragma unroll
        for (int i = 0; i < 2; ++i) lv[i] = __builtin_amdgcn_logf(1.0f + __builtin_amdgcn_exp2f(vmin_s(zin[2 * k + i], 64.0f)));
        unsigned w = cvtpk_h(lv[0], lv[1]);
        asm volatile("" : "+v"(w));
        if (k < 4) lw0[k & 3] = w; else lw1[k & 3] = w;
        SBAR();
    }
    s16x4 la = SB_VF(0, 0), ha = SB_VF(1, 0), lb, hb;
    SBAR();
    zin = MFMA_F16(um0, __builtin_bit_cast(f16x8, lw0), zin); zin = MFMA_F16(um1, __builtin_bit_cast(f16x8, lw1), zin);
    SBAR();
#pragma unroll
    for (int j = 0; j < 8; ++j) {
        { const s16x4 lo = (j & 1) ? lb : la, hi = (j & 1) ? hb : ha;
          const bf16x8 vf = (bf16x8){lo[0], lo[1], lo[2], lo[3], hi[0], hi[1], hi[2], hi[3]};
          o[j & 3] = MFMA_BF16(vf, __builtin_bit_cast(bf16x8, (j >> 2) ? pi1 : pi0), o[j & 3]); }
        if (j + 1 < 8) { const s16x4 l_ = SB_VF(0, j + 1), h_ = SB_VF(1, j + 1); if (j & 1) { la = l_; ha = h_; } else { lb = l_; hb = h_; } }
        SBAR();
        float av[2];
#pragma unroll
        for (int i = 0; i < 2; ++i) av[i] = __builtin_amdgcn_exp2f(zin[2 * j + i] + carry);
        unsigned w = cvtpk(av[0], av[1]);
        asm volatile("" : "+v"(w));
        if (j < 4) po0[j & 3] = w; else po1[j & 3] = w;
        SBAR();
    }
#undef SB_KF
#undef SB_VF
    carry += bcast_lo(zin[0] - z0);
}
template <int P>
DI void sb_tile_s(f32x16& za, f32x16& zb, f32x16 (&o)[4], u32x4 (&pa)[2], u32x4 (&pb)[2], float& carry, const bf16x8 (&qf)[8], lcp ump, const unsigned (&koff)[8], const unsigned (&voff)[2][4]) {
    constexpr int KS = P, KSN = (P + 1) % 3, VS = P, VSP = (P + 2) % 3;
    sb_iter_s<KS * SB_KBUF, VSP * VBUF>(za, zb, o, pa[0], pa[1], pb[0], pb[1], carry, qf, ump, koff, voff);
    sb_iter_s<KSN * SB_KBUF + 8192, VS * VBUF + 8192>(zb, za, o, pb[0], pb[1], pa[0], pa[1], carry, qf, ump, koff, voff);
}
template <bool MASKED, int VAR>
DI void sb_tile(LAS unsigned char* lds, f32x16& za, f32x16& zb, f32x16 (&o)[4], u32x4 (&pa)[2], u32x4 (&pb)[2], float& carry, const bf16x8 (&qf)[8], lcp ump, const SbAddr& ad,
                unsigned krow_off, int ks, int ksn, int vs, int vsp, int qrh0) {
    sb_iter<MASKED, VAR>(za, zb, o, pa[0], pa[1], pb[0], pb[1], carry, qf, ump, lds + ks * SB_KBUF + krow_off, lds + SB_LDS_V + vsp * VBUF, ad, qrh0 - 32);
    sb_iter<MASKED, VAR>(zb, za, o, pb[0], pb[1], pa[0], pa[1], carry, qf, ump, lds + ksn * SB_KBUF + 8192 + krow_off, lds + SB_LDS_V + vs * VBUF + 8192, ad, qrh0);
}
template <int VAR> DI void sb_unit(LAS unsigned char* lds, unsigned char* ws, int b, int h, int qb, const int tid_in) {
    int tid = tid_in; asm volatile("" : "+v"(tid));
    const int lane = tid & 63, wid = __builtin_amdgcn_readfirstlane(tid >> 6), r = lane & 31, hh = lane >> 5;
    const bf16_t *Q2 = (const bf16_t*)(ws + WS_Q2), *K2 = (const bf16_t*)(ws + WS_K2), *V2 = (const bf16_t*)(ws + WS_V2), *SG2 = (const bf16_t*)(ws + WS_SG2);
    bf16_t* MIX2 = (bf16_t*)(ws + (VAR ? WS_A : WS_MIX2));
    const int q0 = qb * 256, NT = 4 * (qb + 1), tmax = (q0 + 32 * wid) >> 6; const size_t rowbase = (size_t)b * SEQ;
    bf16x8 qf[8];
    { const size_t qrow = rowbase + q0 + 32 * wid + r;
#pragma unroll
      for (int d0 = 0; d0 < 8; ++d0) qf[d0] = *(const bf16x8*)(Q2 + qrow * 2048 + h * 128 + d0 * 16 + hh * 8); }
    { f16x8 um[2];
#pragma unroll
      for (int s = 0; s < 2; ++s)
#pragma unroll
          for (int j = 0; j < 8; ++j) um[s][j] = (16 * s + 8 * (j >> 2) + 4 * hh + (j & 3)) >= r ? (_Float16)-1.0f : (_Float16)0.0f;
      *(LAS f16x8*)(lds + SB_LDS_UM + lane * 32) = um[0]; *(LAS f16x8*)(lds + SB_LDS_UM + lane * 32 + 16) = um[1]; }
    lcp ump = lds + SB_LDS_UM + lane * 32;
    f32x16 o[4];
#pragma unroll
    for (int d0 = 0; d0 < 4; ++d0)
#pragma unroll
        for (int g = 0; g < 16; ++g) o[d0][g] = 0.f;
    float carry = 0.f;
    SbAddr ad;
    { const unsigned blk = (lane >> 4) & 1, qq = (lane & 15) >> 2, p = lane & 3;
      ad.kx = ((r & 15) >> 1) << 5;
      ad.vb0 = 256 * (4 * hh + qq) + 8 * (p & 1) + 16 * ((2 * blk + (p >> 1)) ^ hh); ad.vq = 64 * qq; }
    const unsigned krow_off = r * 256 + ((hh ^ (r & 1)) << 4);
    const bf16_t* kbase = K2 + rowbase * 2048 + h * 128; const bf16_t* vbase = V2 + rowbase * 2048 + h * 128;
#define SB_DMA_SRC() int t2_ = tid; asm volatile("" : "+v"(t2_)); const int ln_ = t2_ & 63, drow_ = 8 * wid + (ln_ >> 4), c15_ = ln_ & 15;
#define SB_DMAK(tau, slot) do { SB_DMA_SRC(); const unsigned s0_ = (unsigned)drow_ * 2048 + ((c15_ ^ (drow_ & 15)) * 8), s1_ = (unsigned)(drow_ + 4) * 2048 + ((c15_ ^ ((drow_ + 4) & 15)) * 8); \
        const bf16_t* kt = kbase + (size_t)(NT - 1 - (tau)) * (64 * 2048); LAS unsigned char* kd = lds + (slot) * SB_KBUF + wid * 2048; \
        lds_dma16(kt + s0_, kd); lds_dma16(kt + s1_, kd + 1024); } while (0)
#define SB_DMAV(tau, slot) do { SB_DMA_SRC(); const unsigned s0_ = (unsigned)drow_ * 2048 + ((c15_ ^ (((drow_ & 3) << 2) | ((drow_ >> 2) & 3))) * 8), s1_ = (unsigned)(drow_ + 4) * 2048 + ((c15_ ^ ((((drow_ + 4) & 3) << 2) | (((drow_ + 4) >> 2) & 3))) * 8); \
        const bf16_t* vt = vbase + (size_t)(NT - 1 - (tau)) * (64 * 2048); LAS unsigned char* vd = lds + SB_LDS_V + (slot) * VBUF + wid * 2048; \
        lds_dma16(vt + s0_, vd); lds_dma16(vt + s1_, vd + 1024); } while (0)
    SB_DMAK(0, 0); SB_DMAV(0, 0);
    if (NT > 1) SB_DMAK(1, 1);
    __builtin_amdgcn_s_waitcnt(0x0F70);
    __syncthreads();
    f32x16 za, zb;
#pragma unroll
    for (int g = 0; g < 16; ++g) { za[g] = 0.f; zb[g] = 0.f; }
    u32x4 pa[2], pb[2]; pa[0] = (u32x4){0u, 0u, 0u, 0u}; pa[1] = pa[0]; pb[0] = pa[0]; pb[1] = pa[0];
    int ks = 0, ks1 = 1, vs = 0, vsp = 0;
    const int nmask = NT - tmax;
    constexpr float SB_STOP = -140.0f;
    LAS unsigned* flg = (LAS unsigned*)(lds + SB_LDS_UM + 2048);
    bool wdone = false, alldone = false; int par = 0, lim = NT;
#define SB_CLOSE() { wdone = wdone | (__builtin_amdgcn_ballot_w64(carry > SB_STOP) == 0ull); lim = wdone ? (lim < tau + 1 ? lim : tau + 1) : lim;        \
        { int t5 = tid; asm volatile("" : "+v"(t5)); if ((t5 & 63) == 0) flg[par * 8 + wid] = wdone ? 1u : 0u; } \
        DMA_WAIT_ALL(); __syncthreads();            \
        { const u32x4 f0 = *(LAS const u32x4*)(flg + par * 8), f1 = *(LAS const u32x4*)(flg + par * 8 + 4); \
          alldone = __builtin_amdgcn_readfirstlane((int)(f0[0] & f0[1] & f0[2] & f0[3] & f1[0] & f1[1] & f1[2] & f1[3])) != 0; } par ^= 1; }
#define SB_INTERVAL(MASKED) { const int t = NT - 1 - tau; const int ks2 = (ks1 == 2) ? 0 : ks1 + 1, vs1 = (vs == 2) ? 0 : vs + 1; \
        if (tau + 2 < NT) SB_DMAK(tau + 2, ks2); \
        if (tau + 1 < NT) SB_DMAV(tau + 1, vs1); \
        int qrh0; { int t3 = tid; asm volatile("" : "+v"(t3)); qrh0 = q0 + 32 * wid + (t3 & 31) - 4 * ((t3 >> 5) & 1) - 64 * t; }        \
        sb_tile<MASKED, VAR>(lds, za, zb, o, pa, pb, carry, qf, ump, ad, krow_off, ks, (tau + 1 < NT ? ks1 : ks), vs, vsp, qrh0); \
        SB_CLOSE() \
        ks = ks1; ks1 = ks2; vsp = vs; vs = vs1; }
    int tau = 0;
    for (; tau < nmask - 1 && !alldone; ++tau) { const int ks2 = (ks1 == 2) ? 0 : ks1 + 1, vs1 = (vs == 2) ? 0 : vs + 1;
        if (tau + 2 < NT) SB_DMAK(tau + 2, ks2);
        if (tau + 1 < NT) SB_DMAV(tau + 1, vs1);
        SB_CLOSE()
        ks = ks1; ks1 = ks2; vsp = vs; vs = vs1; }
    { lcp kp = lds + ks * SB_KBUF + 8192 + krow_off;
#pragma unroll
      for (int k = 0; k < 8; ++k) za = MFMA_BF16(*(LAS const bf16x8*)(kp + ((32u * k) ^ ad.kx)), qf[k], za); }
    for (; tau < nmask && tau < lim; ++tau) SB_INTERVAL(true)
    for (; tau < lim; ++tau) SB_INTERVAL(false)
#undef SB_INTERVAL
    { lcp vp = lds + SB_LDS_V + vsp * VBUF;
#pragma unroll
      for (int j = 0; j < 8; ++j) { const unsigned dq = (64u * (j & 3)) ^ ad.vq;
          const s16x4 lo = vtr(vp + 4096 * (j >> 2) + ad.vb0 + dq), hi = vtr(vp + 4096 * (j >> 2) + 2048 + (ad.vb0 ^ 32) + dq);
          o[j & 3] = MFMA_BF16(((bf16x8){lo[0], lo[1], lo[2], lo[3], hi[0], hi[1], hi[2], hi[3]}), __builtin_bit_cast(bf16x8, (j >> 2) ? pa[1] : pa[0]), o[j & 3]); } }
    for (; tau < NT && !alldone; ++tau) { const int ks2 = (ks1 == 2) ? 0 : ks1 + 1, vs1 = (vs == 2) ? 0 : vs + 1;
        if (tau + 2 < NT) SB_DMAK(tau + 2, ks2);
        if (tau + 1 < NT) SB_DMAV(tau + 1, vs1);
        SB_CLOSE()
        ks = ks1; ks1 = ks2; vsp = vs; vs = vs1; }
#undef SB_CLOSE
    DMA_WAIT_ALL(); __syncthreads();
#undef SB_DMAK
#undef SB_DMAV
#undef SB_DMA_SRC
    int t4 = tid; asm volatile("" : "+v"(t4)); const size_t qrow = rowbase + q0 + 32 * wid + (t4 & 31); const int hh2 = (t4 >> 5) & 1;
#pragma unroll
    for (int d0 = 0; d0 < 4; ++d0)
#pragma unroll
        for (int p = 0; p < 2; ++p) { const size_t off = qrow * 2048 + h * 128 + 32 * d0 + 16 * p + 8 * hh2; float e[8]; o_pair8(o[d0], p, e);
            const u32x4 sg = *(const u32x4*)(SG2 + off); u32x4 w;
#pragma unroll
            for (int j = 0; j < 4; ++j) w[j] = cvtpk(e[2 * j] * __uint_as_float(sg[j] << 16), e[2 * j + 1] * __uint_as_float(sg[j] & 0xffff0000u));
            *(u32x4*)(MIX2 + off) = w; }
}
template <int VAR> DI void sb_phase(LAS unsigned char* lds, unsigned char* ws, const int tid) {
    const int G = gridDim.x, bx = blockIdx.x; const int vcu = (G % 8 == 0) ? (bx % 8) * (G / 8) + bx / 8 : bx;
    for (int p = vcu; p < 512; p += G) { const int bh = p >> 3, pr = p & 7; sb_unit<VAR>(lds, ws, bh >> 4, bh & 15, 15 - pr, tid); sb_unit<VAR>(lds, ws, bh >> 4, bh & 15, pr, tid); }
}

constexpr int DIL_KSTR = 272, DIL_WAVE_BYTES = 32 * DIL_KSTR + 8192, DIL_LDS_BYTES = 8 * DIL_WAVE_BYTES;
DI void softmax_blk(f32x16& s0, f32x16 (&o)[4], float& mrun, float& lrun) {
    float mt = s0[0];
#pragma unroll
    for (int g = 1; g < 16; ++g) mt = fmaxf(mt, s0[g]);
    mt = swap_max(mt);
    if (__builtin_amdgcn_ballot_w64(mt > mrun) != 0ull) {
        const float mn = fmaxf(mrun, mt), alpha = __builtin_amdgcn_exp2f(mrun - mn); mrun = mn; lrun *= alpha;
#pragma unroll
        for (int d0 = 0; d0 < 4; ++d0)
#pragma unroll
            for (int g = 0; g < 16; ++g) o[d0][g] *= alpha;
    }
    float ps = 0.f;
#pragma unroll
    for (int g = 0; g < 16; ++g) { s0[g] = __builtin_amdgcn_exp2f(s0[g] - mrun); ps += s0[g]; }
    lrun += ps;
}
DI void dil_wave_unit(LAS unsigned char* wl, unsigned char* ws, int p, int b, int h, int res, int m0w, const int tid_in) {
    int tid = tid_in; asm volatile("" : "+v"(tid));
    const int lane = tid & 63, r = lane & 31, hh = lane >> 5; const int dil = p == 0 ? 1 : p == 1 ? 4 : 16;
    const bf16_t *QB = (const bf16_t*)(ws + WS_QB), *KB = (const bf16_t*)(ws + WS_KB), *VB = (const bf16_t*)(ws + WS_VB);
    const size_t rowbase = (size_t)b * SEQ; const size_t qrow = rowbase + (size_t)(m0w + r) * dil + res;
    const __amdgpu_buffer_rsrc_t rK = mk_rsrc(KB, M * 1024 * 2), rV = mk_rsrc(VB, M * 1024 * 2);
    const unsigned vo = (unsigned)(lane >> 4) * dil * 2048 + (lane & 15) * 16;
    const unsigned so0 = (unsigned)((rowbase + res) * 1024 + h * 128) * 2;
    const float* biasc = (const float*)(ws + WS_BIASC) + (size_t)(p * 8 + h) * 5 * 1024 + lane * 16;
    u32x4 kr[8], vr[8]; f32x4 br[4];
    const int kb0 = m0w >> 5;
#define DIL_LOAD(di) do { const unsigned sb_ = so0 + (unsigned)(32 * (kb0 - (di))) * dil * 2048; \
        _Pragma("unroll") for (int i = 0; i < 8; ++i) { kr[i] = bload(rK, vo + (unsigned)(4 * i) * dil * 2048, sb_); vr[i] = bload(rV, vo + (unsigned)(4 * i) * dil * 2048, sb_); } \
        _Pragma("unroll") for (int j = 0; j < 4; ++j) br[j] = ((const f32x4*)(biasc + (di) * 1024))[j]; } while (0)
    DIL_LOAD(0);
    bf16x8 qf[8];
#pragma unroll
    for (int d0 = 0; d0 < 8; ++d0) qf[d0] = *(const bf16x8*)(QB + qrow * 1024 + h * 128 + d0 * 16 + hh * 8);
    f32x16 o[4];
#pragma unroll
    for (int d0 = 0; d0 < 4; ++d0)
#pragma unroll
        for (int g = 0; g < 16; ++g) o[d0][g] = 0.f;
    float mrun = -INFINITY, lrun = 0.f;
    const VAddr va = make_vaddr(lane);
    const unsigned lk = (lane >> 4) * DIL_KSTR + (lane & 15) * 16;
    for (int di = 0; di < 5; ++di) {
        if (kb0 - di < 0) break;
        asm volatile("s_waitcnt lgkmcnt(0)" ::: "memory");
#pragma unroll
        for (int i = 0; i < 8; ++i) { *(LAS u32x4*)(wl + lk + 4 * i * DIL_KSTR) = kr[i]; *(LAS u32x4*)(wl + 32 * DIL_KSTR + off_b((lane >> 4) + 4 * i, lane & 15)) = vr[i]; }
        f32x16 s0;
#pragma unroll
        for (int j = 0; j < 4; ++j) { s0[4 * j] = br[j][0]; s0[4 * j + 1] = br[j][1]; s0[4 * j + 2] = br[j][2]; s0[4 * j + 3] = br[j][3]; }
        if (di + 1 < 5 && kb0 - (di + 1) >= 0) DIL_LOAD(di + 1);
        asm volatile("s_waitcnt lgkmcnt(0)" ::: "memory");
        lcp kp = wl + r * DIL_KSTR + hh * 16;
#pragma unroll
        for (int d0 = 0; d0 < 8; ++d0) s0 = MFMA_BF16(*(LAS const bf16x8*)(kp + d0 * 32), qf[d0], s0);
        softmax_blk(s0, o, mrun, lrun);
        lcp vb = wl + 32 * DIL_KSTR;
#pragma unroll
        for (int s = 0; s < 2; ++s) { const bf16x8 pf = pack_bf(s0, s);
#pragma unroll
            for (int d0 = 0; d0 < 4; ++d0) o[d0] = MFMA_BF16(vfrag(vb, s, d0, va), pf, o[d0]); }
    }
#undef DIL_LOAD
    const float lt = swap_sum(lrun), inv = 1.0f / lt;
    bf16_t* OP = (bf16_t*)(ws + (p == 0 ? WS_OP0 : p == 1 ? WS_OP1 : WS_OP2));
#pragma unroll
    for (int d0 = 0; d0 < 4; ++d0)
#pragma unroll
        for (int gg = 0; gg < 4; ++gg) { const size_t off = qrow * 1024 + h * 128 + 32 * d0 + 8 * gg + 4 * hh;
            const unsigned lo = cvtpk(o[d0][4 * gg] * inv, o[d0][4 * gg + 1] * inv), hi = cvtpk(o[d0][4 * gg + 2] * inv, o[d0][4 * gg + 3] * inv);
            *(unsigned long long*)(OP + off) = (unsigned long long)lo | ((unsigned long long)hi << 32); }
    if (hh == 0) ((float*)(ws + WS_LSE))[((size_t)p * M + qrow) * 8 + h] = mrun + __builtin_amdgcn_logf(lt);
}
constexpr int DILW_LDS_BYTES = 12 * 8192;
DI void dil_wg_unit(LAS unsigned char* lds, unsigned char* ws, int p, int b, int h, int res, int m0, const int tid_in) {
    int tid = tid_in; asm volatile("" : "+v"(tid));
    const int lane = tid & 63, wid = __builtin_amdgcn_readfirstlane(tid >> 6), r = lane & 31, hh = lane >> 5; const int dil = p == 0 ? 1 : p == 1 ? 4 : 16;
    const bf16_t *QB = (const bf16_t*)(ws + WS_QB), *KB = (const bf16_t*)(ws + WS_KB), *VB = (const bf16_t*)(ws + WS_VB);
    const size_t rowbase = (size_t)b * SEQ; const size_t qrow = rowbase + (size_t)(m0 + 32 * wid + r) * dil + res;
    const int kbw = (m0 >> 5) - 4;
    const int prow = 4 * wid + (lane >> 4);
    const unsigned ksw = ((lane & 15) ^ (prow & 15)) * 8, vsw = ((lane & 15) ^ (((prow & 3) << 2) | ((prow >> 2) & 3))) * 8;
    const bf16_t* kg = KB + (rowbase + res) * 1024 + h * 128; const bf16_t* vg = VB + (rowbase + res) * 1024 + h * 128;
#pragma unroll
    for (int i = 0; i < 12; ++i) { const int kb = kbw + i; if (kb >= 0)
        __builtin_amdgcn_global_load_lds((const unsigned*)(kg + (size_t)(32 * kb + prow) * dil * 1024 + ksw), (LAS unsigned*)(lds + i * 8192 + wid * 1024), 16, 0, 0); }
    bf16x8 qf[8];
#pragma unroll
    for (int d0 = 0; d0 < 8; ++d0) qf[d0] = *(const bf16x8*)(QB + qrow * 1024 + h * 128 + d0 * 16 + hh * 8);
    const float* biasc = (const float*)(ws + WS_BIASC) + (size_t)(p * 8 + h) * 5 * 1024 + lane * 16;
    f32x16 sc[5];
#pragma unroll
    for (int di = 0; di < 5; ++di) { const f32x4* bp = (const f32x4*)(biasc + di * 1024);
#pragma unroll
        for (int j = 0; j < 4; ++j) { const f32x4 v = bp[j]; sc[di][4 * j] = v[0]; sc[di][4 * j + 1] = v[1]; sc[di][4 * j + 2] = v[2]; sc[di][4 * j + 3] = v[3]; } }
    __builtin_amdgcn_s_waitcnt(0x0F70);
    __syncthreads();
    const unsigned kx = ((r & 15) >> 1) << 5, krow_off = r * 256 + ((hh ^ (r & 1)) << 4);
#pragma unroll
    for (int di = 0; di < 5; ++di) { const int jj = wid + 4 - di;
        if (kbw + jj >= 0) { lcp kp = lds + jj * 8192 + krow_off;
#pragma unroll
            for (int k = 0; k < 8; ++k) sc[di] = MFMA_BF16(*(LAS const bf16x8*)(kp + ((32u * k) ^ kx)), qf[k], sc[di]); }
        else {
#pragma unroll
            for (int g = 0; g < 16; ++g) sc[di][g] = -INFINITY; } }
    float mx = sc[0][0];
#pragma unroll
    for (int di = 0; di < 5; ++di)
#pragma unroll
        for (int g = 0; g < 16; ++g) mx = fmaxf(mx, sc[di][g]);
    mx = swap_max(mx);
    float ps = 0.f; u32x4 pw[5][2];
#pragma unroll
    for (int di = 0; di < 5; ++di) {
#pragma unroll
        for (int g = 0; g < 16; ++g) { sc[di][g] = __builtin_amdgcn_exp2f(sc[di][g] - mx); ps += sc[di][g]; }
        pw[di][0] = __builtin_bit_cast(u32x4, pack_bf(sc[di], 0)); pw[di][1] = __builtin_bit_cast(u32x4, pack_bf(sc[di], 1)); }
    __syncthreads();
#pragma unroll
    for (int i = 0; i < 12; ++i) { const int kb = kbw + i; if (kb >= 0)
        __builtin_amdgcn_global_load_lds((const unsigned*)(vg + (size_t)(32 * kb + prow) * dil * 1024 + vsw), (LAS unsigned*)(lds + i * 8192 + wid * 1024), 16, 0, 0); }
    f32x16 o[4];
#pragma unroll
    for (int d0 = 0; d0 < 4; ++d0)
#pragma unroll
        for (int g = 0; g < 16; ++g) o[d0][g] = 0.f;
    const VAddr va = make_vaddr(lane);
    __builtin_amdgcn_s_waitcnt(0x0F70);
    __syncthreads();
#pragma unroll
    for (int di = 0; di < 5; ++di) { const int jj = wid + 4 - di;
        if (kbw + jj >= 0) { lcp vb = lds + jj * 8192;
#pragma unroll
            for (int s = 0; s < 2; ++s)
#pragma unroll
                for (int d0 = 0; d0 < 4; ++d0) o[d0] = MFMA_BF16(vfrag(vb, s, d0, va), __builtin_bit_cast(bf16x8, pw[di][s]), o[d0]); } }
    const float lt = swap_sum(ps), inv = 1.0f / lt;
    bf16_t* OP = (bf16_t*)(ws + (p == 0 ? WS_OP0 : p == 1 ? WS_OP1 : WS_OP2));
    { LAS unsigned char* stg = lds + DILW_LDS_BYTES + wid * 4608; const int rl = lane >> 3, ch = lane & 7;
#pragma unroll
      for (int half = 0; half < 2; ++half) {
#pragma unroll
        for (int dd = 0; dd < 2; ++dd)
#pragma unroll
            for (int gg = 0; gg < 4; ++gg) { const int d0 = 2 * half + dd;
                const unsigned lo = cvtpk(o[d0][4 * gg] * inv, o[d0][4 * gg + 1] * inv), hi = cvtpk(o[d0][4 * gg + 2] * inv, o[d0][4 * gg + 3] * inv);
                *(LAS unsigned long long*)(stg + r * 144 + (32 * dd + 8 * gg + 4 * hh) * 2) = (unsigned long long)lo | ((unsigned long long)hi << 32); }
#pragma unroll
        for (int j = 0; j < 4; ++j) { const u32x4 w = *(LAS const u32x4*)(stg + (8 * j + rl) * 144 + ch * 16);
            const size_t grow = rowbase + (size_t)(m0 + 32 * wid + 8 * j + rl) * dil + res;
            *(u32x4*)(OP + grow * 1024 + h * 128 + half * 64 + ch * 8) = w; } } }
    if (hh == 0) ((float*)(ws + WS_LSE))[((size_t)p * M + qrow) * 8 + h] = mx + __builtin_amdgcn_logf(lt);
    __syncthreads();
}
DI void dil_phase(LAS unsigned char* lds, unsigned char* ws, const int tid) {
    for (int u = blockIdx.x; u < 1536; u += gridDim.x) {
        const int cidx = u & 15, h = (u >> 4) & 7, b = (u >> 7) & 3, p = u >> 9;
        const int res = p == 0 ? 0 : p == 1 ? (cidx & 3) : cidx, m0 = p == 0 ? 256 * cidx : p == 1 ? 256 * (cidx >> 2) : 0;
        dil_wg_unit(lds, ws, p, b, h, res, m0, tid);
    }
}
}

__global__ void __launch_bounds__(512, 2) k_mla_fast(Ctx c) { extern __shared__ __attribute__((aligned(16))) unsigned char lds[]; att::mla_phase((LAS unsigned char*)lds, c.ws, (int)threadIdx.x); }
__global__ void __launch_bounds__(512, 2) k_sb_fast(Ctx c) { extern __shared__ __attribute__((aligned(16))) unsigned char lds[]; att::sb_phase<0>((LAS unsigned char*)lds, c.ws, (int)threadIdx.x); }
__global__ void __launch_bounds__(512, 2) k_dil_fast(Ctx c) { extern __shared__ __attribute__((aligned(16))) unsigned char lds[]; att::dil_phase((LAS unsigned char*)lds, c.ws, (int)threadIdx.x); }

template <bool FROMBF>
DI void final_norm_row(float* out, const bf16_t* xb, const float* gain, int row, int lane) {
    f32x4* xr = (f32x4*)(out + (size_t)row * D_MODEL) + lane; const f32x4* g = (const f32x4*)gain + lane;
    f32x4 v[8]; float s = 0.f;
    if (FROMBF) { const u32x4* br = (const u32x4*)(xb + (size_t)row * D_MODEL) + lane;
#pragma unroll
        for (int j = 0; j < 4; ++j) { const u32x4 w = br[64 * j];
            v[2 * j] = (f32x4){__uint_as_float(w[0] << 16), __uint_as_float(w[0] & 0xffff0000u), __uint_as_float(w[1] << 16), __uint_as_float(w[1] & 0xffff0000u)};
            v[2 * j + 1] = (f32x4){__uint_as_float(w[2] << 16), __uint_as_float(w[2] & 0xffff0000u), __uint_as_float(w[3] << 16), __uint_as_float(w[3] & 0xffff0000u)}; }
#pragma unroll
        for (int j = 0; j < 8; ++j) s += v[j].x * v[j].x + v[j].y * v[j].y + v[j].z * v[j].z + v[j].w * v[j].w;
        const float r = rsqrtf(wave_sum(s) * (1.0f / D_MODEL) + EPS);
        f32x4* o4 = (f32x4*)(out + (size_t)row * D_MODEL); const f32x4* g4 = (const f32x4*)gain;
#pragma unroll
        for (int j = 0; j < 4; ++j) { const int i0 = 128 * j + 2 * lane; o4[i0] = v[2 * j] * r * g4[i0]; o4[i0 + 1] = v[2 * j + 1] * r * g4[i0 + 1]; }
    } else {
#pragma unroll
        for (int j = 0; j < 8; ++j) { v[j] = xr[64 * j]; s += v[j].x * v[j].x + v[j].y * v[j].y + v[j].z * v[j].z + v[j].w * v[j].w; }
        const float r = rsqrtf(wave_sum(s) * (1.0f / D_MODEL) + EPS);
#pragma unroll
        for (int j = 0; j < 8; ++j) xr[64 * j] = v[j] * r * g[64 * j];
    }
}
__global__ void __launch_bounds__(256) k_final_norm(float* out, const float* gain) { final_norm_row<false>(out, nullptr, gain, blockIdx.x * 4 + (threadIdx.x >> 6), threadIdx.x & 63); }
__global__ void __launch_bounds__(256) k_final_norm_bf(float* out, const bf16_t* xb, const float* gain) { final_norm_row<true>(out, xb, gain, blockIdx.x * 4 + (threadIdx.x >> 6), threadIdx.x & 63); }

#define XB_TMO      128
#define XB_XCNT(j)  (256  + 64 * (j))
#define XB_XSUB(j)  (1280 + 64 * (j))
#define XB_XGEN(j)  (2304 + 64 * (j))
#define XB_TOP      3328
#define XB_TOPGEN   3392
#define XCD_BAR_WORDS 3456
#define XB_SPIN_CAP (1u << 22)
DI unsigned xb_ld(unsigned* p)              { return __hip_atomic_load(p, __ATOMIC_RELAXED, __HIP_MEMORY_SCOPE_AGENT); }
DI unsigned xb_add(unsigned* p, unsigned v) { return __hip_atomic_fetch_add(p, v, __ATOMIC_RELAXED, __HIP_MEMORY_SCOPE_AGENT); }
DI unsigned xb_xcc_id() { return (unsigned)__builtin_amdgcn_s_getreg((3 << 11) | 20) & 0xFu; }
#define XB_SPIN(cond, bar) do { unsigned _sp = 0; while (cond) { __builtin_amdgcn_s_sleep(1); \
    if ((++_sp & 255u) == 0u) { if (xb_ld(&(bar)[XB_TMO])) break; if (_sp > XB_SPIN_CAP) { atomicAdd(&(bar)[XB_TMO], 1u); break; } } } } while (0)
struct XcdBarrier { unsigned* bar; unsigned x; volatile LAS unsigned* st; };
DI XcdBarrier xcd_barrier_post(unsigned* bar, volatile LAS unsigned* st, int tid) {
    XcdBarrier b; b.bar = bar; b.x = xb_xcc_id(); b.st = st;
    if (tid == 0) (void)xb_add(&bar[XB_XCNT(b.x)], 1u);
    return b;
}
DI void xcd_barrier_complete(unsigned* bar, unsigned x, unsigned& nloc, unsigned& nx) {
    const unsigned G = gridDim.x * gridDim.y * gridDim.z;
    unsigned sum, cnt, mine, sp = 0u;
    for (;;) {
        sum = 0u; cnt = 0u; mine = 0u;
#pragma unroll
        for (unsigned j = 0; j < 16; ++j) { const unsigned c = xb_ld(&bar[XB_XCNT(j)]); sum += c; cnt += (c > 0u) ? 1u : 0u; mine = (j == x) ? c : mine; }
        if (sum == G) break;
        __builtin_amdgcn_s_sleep(1);
        if ((++sp & 255u) == 0u) { if (xb_ld(&bar[XB_TMO])) break; if (sp > XB_SPIN_CAP) { atomicAdd(&bar[XB_TMO], 1u); break; } }
    }
    nloc = mine > 0u ? mine : 1u; nx = cnt > 0u ? cnt : 1u;
}
DI void xcd_barrier(const XcdBarrier& b, int tid) {
    asm volatile("s_waitcnt vmcnt(0)" ::: "memory");
    __syncthreads();
    if (tid == 0) {
        unsigned* bar = b.bar;
        __builtin_amdgcn_s_waitcnt(0);
        unsigned nloc = b.st[0], nx = b.st[1];
        if (nloc == 0u) { xcd_barrier_complete(bar, b.x, nloc, nx); b.st[0] = nloc; b.st[1] = nx; }
        const unsigned old = xb_add(&bar[XB_XSUB(b.x)], 1u);
        const unsigned gen = old / nloc;
        if (old + 1u == (gen + 1u) * nloc) {
            __builtin_amdgcn_fence(__ATOMIC_RELEASE, "agent");
            asm volatile("s_waitcnt vmcnt(0)" ::: "memory");
            const unsigned og = xb_add(&bar[XB_TOP], 1u);
            const unsigned tg = og / nx;
            if (og + 1u == (tg + 1u) * nx) xb_add(&bar[XB_TOPGEN], 1u);
            else XB_SPIN(xb_ld(&bar[XB_TOPGEN]) == tg, bar);
            __builtin_amdgcn_fence(__ATOMIC_ACQUIRE, "agent");
            xb_add(&bar[XB_XGEN(b.x)], 1u);
            asm volatile("s_waitcnt vmcnt(0)" ::: "memory");
        } else {
            XB_SPIN(xb_ld(&bar[XB_XGEN(b.x)]) == gen, bar);
            __builtin_amdgcn_fence(__ATOMIC_ACQUIRE, "agent");
            asm volatile("s_waitcnt vmcnt(0)" ::: "memory");
        }
    }
    __syncthreads();
}

constexpr int MEGA_LDS_PHASE = 135168, MEGA_LDS = MEGA_LDS_PHASE + 64;
#ifndef P4_REP
#define P4_REP 1
#endif
#ifndef SYNC_PROBE
#define SYNC_PROBE 0
#endif
#ifndef SB_PROBE_VAR
#define SB_PROBE_VAR 0
#endif
#ifndef PROBE_MASK
#define PROBE_MASK 0
#endif
#define PREP(k) for (int rep_ = 0; rep_ < 1 + ((PROBE_MASK >> (k)) & 1); ++rep_)
__global__ void __launch_bounds__(512, 2) k_mega(Ctx c) {
    extern __shared__ __attribute__((aligned(16))) unsigned char lds_raw[];
    LAS unsigned char* lds = (LAS unsigned char*)lds_raw;
    unsigned char* ws = c.ws; const int G = gridDim.x, bx = blockIdx.x;
    const int wave_s = __builtin_amdgcn_readfirstlane((int)threadIdx.x >> 6);
    volatile LAS unsigned* bst = (volatile LAS unsigned*)(lds + MEGA_LDS_PHASE);
    if (threadIdx.x < 16) bst[threadIdx.x] = 0u;
    __syncthreads();
    const XcdBarrier xbar = xcd_barrier_post((unsigned*)(ws + WS_CTL), bst, (int)threadIdx.x);
#define GRID_BAR() xcd_barrier(xbar, phase_tid(wave_s))
    PREP(0) { prep_phase<8, 0>(c, (float*)lds_raw, phase_tid(wave_s)); __syncthreads(); }
    GRID_BAR();
    PREP(1) { pg8::Gemm g{(const bf16_t*)(ws + WS_H0), (const bf16_t*)(ws + WS_WT_IN_E), M, IN_EVEN_PAD, 2048}; pg8::StaticOrder S; S.init(g.M, g.N, G, bx);
      pg8::gemm_phase<pg8::FEpi1, pg8::StaticOrder, true, true>(lds, g, S, pg8::FEpi1{ws}, phase_tid(wave_s)); }
    { const int nlast = (M / 256) * (IN_EVEN_PAD / 256) % G; const int nfree = nlast ? G - nlast : G, me = nlast ? bx - nlast : bx;
      if (me >= 0) { const int tid = phase_tid(wave_s); prep_weights<1>(c, (float*)lds_raw + (tid >> 6) * 64 * 36, tid & 63, me * 8 + (tid >> 6), nfree * 8); } }
    GRID_BAR();
    PREP(2) { att::dil_phase(lds, ws, phase_tid(wave_s));
    __syncthreads(); }
    PREP(7) { pg8::Gemm g{(const bf16_t*)(ws + WS_CQ), (const bf16_t*)(ws + WS_WT_UQ), M, 1536, 512}; pg8::StaticOrder S; S.init(g.M, g.N, G, bx);
      pg8::gemm_phase<pg8::FEpi2a, pg8::StaticOrder, true, true>(lds, g, S, pg8::FEpi2a{ws}, phase_tid(wave_s)); }
    PREP(7) { pg8::Gemm g{(const bf16_t*)(ws + WS_CKV), (const bf16_t*)(ws + WS_WT_UKV), M, 2048, 512}; pg8::StaticOrder S; S.init(g.M, g.N, G, bx);
      pg8::gemm_phase<pg8::FEpi2b, pg8::StaticOrder, true, true>(lds, g, S, pg8::FEpi2b{ws}, phase_tid(wave_s)); }
    GRID_BAR();
    PREP(3) att::mla_phase(lds, ws, phase_tid(wave_s));
    PREP(8) { const int tid = phase_tid(wave_s); for (int it = bx * 512 + tid; it < M * 128; it += G * 512) dil_merge_item(ws, it >> 7, (it & 127) * 8); }
    GRID_BAR();
    PREP(4) { pg8::Gemm g{(const bf16_t*)(ws + WS_MIX), (const bf16_t*)(ws + WS_WT_OUT_E), M, 2048, 2048}; pg8::StaticOrder S; S.init(g.M, g.N, G, bx); S.rep = P4_REP;
      pg8::gemm_phase<pg8::FEpi4, pg8::StaticOrder, false, true>(lds, g, S, pg8::FEpi4{ws, c.x, c.out}, phase_tid(wave_s)); }
    GRID_BAR();
    PREP(5) { pg8::Gemm g{(const bf16_t*)(ws + WS_X1BF), (const bf16_t*)(ws + WS_WT_IN_O), M, IN_ODD, 2048}; pg8::StaticOrder S; S.init(g.M, g.N, G, bx);
      pg8::gemm_phase<pg8::FEpi5, pg8::StaticOrder, true, true>(lds, g, S, pg8::FEpi5{ws}, phase_tid(wave_s)); }
    GRID_BAR();
    PREP(6) att::sb_phase<0>(lds, ws, phase_tid(wave_s));
#if SB_PROBE_VAR
    att::sb_phase<SB_PROBE_VAR>(lds, ws, phase_tid(wave_s));
#endif
    GRID_BAR();
    { pg8::Gemm g{(const bf16_t*)(ws + WS_MIX2), (const bf16_t*)(ws + WS_WT_OUT_O), M, 2048, 2048}; pg8::StaticOrder S; S.init(g.M, g.N, G, bx);
      pg8::gemm_phase<pg8::FEpi7, pg8::StaticOrder, false, true>(lds, g, S, pg8::FEpi7{(bf16_t*)(ws + WS_X2BF), (const bf16_t*)(ws + WS_X1BF)}, phase_tid(wave_s)); }
    GRID_BAR();
#if SYNC_PROBE
    for (int i_ = 0; i_ < 8; ++i_) GRID_BAR();
#endif
    { const int tid = phase_tid(wave_s); for (int row = bx * 8 + (tid >> 6); row < M; row += G * 8) final_norm_row<true>(c.out, (const bf16_t*)(ws + WS_X2BF), c.final_gain, row, tid & 63); }
}

#ifndef MK_ONE_LAUNCH
#define MK_ONE_LAUNCH 1
#endif
#ifndef FAST_G1
#define FAST_G1 1
#endif
#ifndef FAST_G2
#define FAST_G2 1
#endif
#ifndef FAST_G4
#define FAST_G4 1
#endif
#ifndef FAST_G5
#define FAST_G5 1
#endif
#ifndef FAST_G7
#define FAST_G7 1
#endif
#ifndef FAST_MLA
#define FAST_MLA 1
#endif
#ifndef FAST_SB
#define FAST_SB 1
#endif
#ifndef FAST_DIL
#define FAST_DIL 1
#endif
static void launch_att(void (*k)(Ctx), int lds_bytes, const Ctx& c, hipStream_t s) {
    (void)hipFuncSetAttribute((const void*)k, hipFuncAttributeMaxDynamicSharedMemorySize, lds_bytes);
    hipLaunchKernelGGL(k, dim3(256), dim3(512), lds_bytes, s, c);
}
template <class Epi> static void launch_gemm_fast(const bf16_t* A, const bf16_t* Bt, int N, int K, Epi E, hipStream_t s) {
    static bool attr = false; if (!attr) { (void)hipFuncSetAttribute((const void*)k_gemm_fast<Epi>, hipFuncAttributeMaxDynamicSharedMemorySize, 131072); attr = true; }
    pg8::Gemm g{A, Bt, M, N, K};
    k_gemm_fast<Epi><<<256, 512, 131072, s>>>(g, E);
}

extern "C" void kernel_launch(void* const* d_in, const int* in_sizes, int n_in, void* d_out, int out_size, void* d_ws, size_t ws_size, hipStream_t stream) {
    if (n_in != 12 || out_size != M * D_MODEL || ws_size < WS_END) { fprintf(stderr, "kernel_launch: unexpected shapes (n_in %d out %d ws %zu)\n", n_in, out_size, ws_size); return; }
    Ctx c{};
    c.x = (const float*)d_in[0]; c.norm_gain = (const float*)d_in[1]; c.w_in_even = (const float*)d_in[2]; c.q_norm_gain = (const float*)d_in[3]; c.kv_norm_gain = (const float*)d_in[4];
    c.w_uq = (const float*)d_in[5]; c.w_ukv = (const float*)d_in[6]; c.w_out_even = (const float*)d_in[7]; c.rel_bias = (const float*)d_in[8]; c.w_in_odd = (const float*)d_in[9];
    c.w_out_odd = (const float*)d_in[10]; c.final_gain = (const float*)d_in[11]; c.out = (float*)d_out; c.ws = (unsigned char*)d_ws;
#if MK_ONE_LAUNCH
    static int grid_blocks = 0;
    if (!grid_blocks) {
        int dev = 0, cus = 0, per_cu = 0;
        (void)hipGetDevice(&dev); (void)hipDeviceGetAttribute(&cus, hipDeviceAttributeMultiprocessorCount, dev);
        (void)hipFuncSetAttribute((const void*)k_mega, hipFuncAttributeMaxDynamicSharedMemorySize, MEGA_LDS);
        (void)hipOccupancyMaxActiveBlocksPerMultiprocessor(&per_cu, (const void*)k_mega, 512, MEGA_LDS);
        if (per_cu < 1) { fprintf(stderr, "kernel_launch: occupancy query says %d blocks/CU\n", per_cu); per_cu = 1; }
        grid_blocks = cus;
    }
    (void)hipMemsetAsync((char*)d_ws + WS_CTL, 0, 65536, stream);
    { void* args[] = {&c};
      hipError_t e = hipLaunchCooperativeKernel((void*)k_mega, dim3(grid_blocks), dim3(512), args, MEGA_LDS, stream);
      if (e != hipSuccess) fprintf(stderr, "cooperative launch failed: %s (grid %d)\n", hipGetErrorString(e), grid_blocks); }
    return;
#endif
    unsigned char* ws = c.ws;
    const float* rc = (const float*)(ws + WS_ROPE); const float* rs = rc + 4096 * 32;
    k_prep<<<2048, 256, 0, stream>>>(c);
#if FAST_G1
    launch_gemm_fast((const bf16_t*)(ws + WS_H0), (const bf16_t*)(ws + WS_WT_IN_E), IN_EVEN_PAD, 2048, pg8::FEpi1{ws}, stream);
#else
    k_gemm_naive<Epi1><<<(M / 64) * (IN_EVEN_PAD / 64), 256, 0, stream>>>((const bf16_t*)(ws + WS_H0), (const bf16_t*)(ws + WS_WT_IN_E), IN_EVEN_PAD, 2048, Epi1{ws});
    k_rowss<false><<<M / 4, 256, 0, stream>>>(ws + WS_CQ, 512, 512, (float*)(ws + WS_SSC), 16, 8);
    k_rowss<false><<<M / 4, 256, 0, stream>>>(ws + WS_CKV, 512, 512, (float*)(ws + WS_SSC) + 8, 16, 8);
    k_rope<<<(M * 32 + 255) / 256, 256, 0, stream>>>((bf16_t*)(ws + WS_KR), 1, rc, rs);
#endif
#if FAST_DIL
    launch_att(k_dil_fast, att::DIL_LDS_BYTES, c, stream);
#else
    k_dil_naive<<<BATCH * 8 * SEQ / 4, 256, 0, stream>>>(c);
#endif
#if FAST_G2
    launch_gemm_fast((const bf16_t*)(ws + WS_CQ), (const bf16_t*)(ws + WS_WT_UQ), 1536, 512, pg8::FEpi2a{ws}, stream);
    launch_gemm_fast((const bf16_t*)(ws + WS_CKV), (const bf16_t*)(ws + WS_WT_UKV), 2048, 512, pg8::FEpi2b{ws}, stream);
#else
    k_gemm_naive<Epi2a><<<(M / 64) * (1536 / 64), 256, 0, stream>>>((const bf16_t*)(ws + WS_CQ), (const bf16_t*)(ws + WS_WT_UQ), 1536, 512, Epi2a{ws});
    k_rope<<<(M * 256 + 255) / 256, 256, 0, stream>>>((bf16_t*)(ws + WS_QR), 8, rc, rs);
    k_gemm_naive<Epi2b><<<(M / 64) * (2048 / 64), 256, 0, stream>>>((const bf16_t*)(ws + WS_CKV), (const bf16_t*)(ws + WS_WT_UKV), 2048, 512, Epi2b{ws});
#endif
#if FAST_MLA
    launch_att(k_mla_fast, att::M2_LDS_BYTES > att::MLA_LDS_BYTES ? att::M2_LDS_BYTES : att::MLA_LDS_BYTES, c, stream);
#else
    k_mla_naive<<<BATCH * 8 * SEQ / 4, 256, 0, stream>>>(c);
#endif
    k_dil_merge<<<M, 128, 0, stream>>>(c);
#if FAST_G4
    launch_gemm_fast((const bf16_t*)(ws + WS_MIX), (const bf16_t*)(ws + WS_WT_OUT_E), 2048, 2048, pg8::FEpi4{ws, c.x, c.out}, stream);
#else
    k_gemm_naive<Epi4><<<(M / 64) * (2048 / 64), 256, 0, stream>>>((const bf16_t*)(ws + WS_MIX), (const bf16_t*)(ws + WS_WT_OUT_E), 2048, 2048, Epi4{ws, c.x, c.out});
    k_rowss<true><<<M / 4, 256, 0, stream>>>(c.out, 2048, 2048, (float*)(ws + WS_SSX1), 32, 32);
#endif
#if FAST_G5
    launch_gemm_fast((const bf16_t*)(ws + WS_X1BF), (const bf16_t*)(ws + WS_WT_IN_O), IN_ODD, 2048, pg8::FEpi5{ws}, stream);
#else
    k_gemm_naive<Epi5><<<(M / 64) * (IN_ODD / 64), 256, 0, stream>>>((const bf16_t*)(ws + WS_X1BF), (const bf16_t*)(ws + WS_WT_IN_O), IN_ODD, 2048, Epi5{ws});
#endif
#if FAST_SB
    launch_att(k_sb_fast, att::SB_LDS_BYTES, c, stream);
#else
    k_sb_naive<<<BATCH * 16 * SEQ / 4, 256, 0, stream>>>(c);
#endif
#if FAST_G7
    launch_gemm_fast((const bf16_t*)(ws + WS_MIX2), (const bf16_t*)(ws + WS_WT_OUT_O), 2048, 2048, pg8::FEpi7{(bf16_t*)(ws + WS_X2BF), (const bf16_t*)(ws + WS_X1BF)}, stream);
#else
    k_gemm_naive<Epi7><<<(M / 64) * (2048 / 64), 256, 0, stream>>>((const bf16_t*)(ws + WS_MIX2), (const bf16_t*)(ws + WS_WT_OUT_O), 2048, 2048, Epi7{c.out});
#endif
#if FAST_G7
    k_final_norm_bf<<<M / 4, 256, 0, stream>>>(c.out, (const bf16_t*)(ws + WS_X2BF), c.final_gain);
#else
    k_final_norm<<<M / 4, 256, 0, stream>>>(c.out, c.final_gain);
#endif
}
```

```cpp
#include <hip/hip_runtime.h>
#include <cstdio>
#include <cstdint>
#include <cmath>

typedef unsigned short bf16_t;
typedef unsigned u32x4 __attribute__((ext_vector_type(4)));
typedef float f32x4 __attribute__((ext_vector_type(4)));

constexpr int D_MODEL = 2048, BATCH = 4, SEQ = 4096, M = BATCH * SEQ;
constexpr int NH_MLA = 8, NH_DIL = 8, NH_SB = 16, HD = 128;
constexpr int IN_EVEN = 6208, IN_EVEN_PAD = 6400, IN_ODD = 8192;
constexpr float EPS = 1e-6f;
constexpr float LOG2E = 1.4426950408889634f;
constexpr float MLA_QSCALE = 0.07216878364870322f * LOG2E;
constexpr float D128_QSCALE = 0.08838834764831845f * LOG2E;

constexpr size_t MiB = 1u << 20;
constexpr size_t WS_CTL = 0;
constexpr size_t WS_ROPE = 1 * MiB;
constexpr size_t WS_BIASN = 2 * MiB;
constexpr size_t WS_BIASC = 2 * MiB + 65536;
constexpr size_t WS_SSX = 3 * MiB;
constexpr size_t WS_SSC = 4 * MiB;
constexpr size_t WS_SSX1 = 5 * MiB;
constexpr size_t WS_LSE = 9 * MiB;
constexpr size_t WS_WT_IN_E = 12 * MiB;
constexpr size_t WS_WT_UQ = 37 * MiB;
constexpr size_t WS_WT_UKV = 39 * MiB;
constexpr size_t WS_WT_OUT_E = 41 * MiB;
constexpr size_t WS_WT_IN_O = 49 * MiB;
constexpr size_t WS_WT_OUT_O = 81 * MiB;
constexpr size_t WS_A = 90 * MiB;
constexpr size_t WS_B = 154 * MiB;
constexpr size_t WS_C = 218 * MiB;
constexpr size_t WS_H0 = WS_A, WS_OP0 = WS_A, WS_OP1 = WS_A + 32 * MiB, WS_X1BF = WS_A;
constexpr size_t WS_CQ = WS_B, WS_CKV = WS_B + 16 * MiB, WS_QB = WS_B + 32 * MiB, WS_MIX = WS_B, WS_MIX2 = WS_B;
constexpr size_t WS_KB = WS_C, WS_VB = WS_C + 32 * MiB, WS_SG = WS_C + 64 * MiB, WS_QN = WS_C + 128 * MiB, WS_QR = WS_C + 160 * MiB,
                 WS_KN = WS_C + 176 * MiB, WS_VA = WS_C + 208 * MiB, WS_KR = WS_C + 240 * MiB, WS_OP2 = WS_C + 242 * MiB;
constexpr size_t WS_X2BF = WS_C;
constexpr size_t WS_Q2 = WS_C, WS_K2 = WS_C + 64 * MiB, WS_V2 = WS_C + 128 * MiB, WS_SG2 = WS_C + 192 * MiB;
constexpr size_t WS_END = WS_C + 274 * MiB;

struct Ctx {
    const float *x, *norm_gain, *w_in_even, *q_norm_gain, *kv_norm_gain, *w_uq, *w_ukv, *w_out_even, *rel_bias, *w_in_odd, *w_out_odd, *final_gain;
    float* out; unsigned char* ws;
};

#define DI __device__ __forceinline__
DI int phase_tid(int wave_s) { int lane; asm volatile("v_mbcnt_lo_u32_b32 %0, -1, 0\n\tv_mbcnt_hi_u32_b32 %0, -1, %0" : "=v"(lane)); return wave_s * 64 + lane; }
DI float bf2f(bf16_t v) { return __uint_as_float(((unsigned)v) << 16); }
DI bf16_t f2bf(float f) { unsigned u = __float_as_uint(f); return (bf16_t)((u + 0x7fffu + ((u >> 16) & 1u)) >> 16); }
DI float wave_sum(float v) {
#pragma unroll
    for (int o = 1; o < 64; o <<= 1) v += __shfl_xor(v, o);
    return v;
}
DI float wave_max(float v) {
#pragma unroll
    for (int o = 1; o < 64; o <<= 1) v = fmaxf(v, __shfl_xor(v, o));
    return v;
}
DI float silu_f(float v) { return v / (1.0f + __expf(-v)); }

DI int map_in_even(int n) { if (n < 1024) return n; if (n < 1056) return 1024 + (n - 1024); if (n < 1088) return 1152 + (n - 1056); return n - 1088 + 1280; }
DI int map_uq(int n) { const int h = n / 192, j = n % 192; if (j < 128) return h * 128 + j; if (j < 160) return 1024 + (h >> 2) * 256 + (h & 3) * 32 + (j - 128);
    return 1024 + (h >> 2) * 256 + 128 + (h & 3) * 32 + (j - 160); }
DI int map_ukv(int n) { const int h = n / 256, j = n % 256; if (j < 128) return h * 128 + j; return 1024 + h * 128 + (j - 128); }
DI int map_id(int n) { return n; }

template <int MAPID>
DI void transpose_item(const float* W, int K, int N, const float* gain, bf16_t* WT, float* scr  , int item, int lane) {
    const int nblk = N / 32, kb = item / nblk, nb = item % nblk, k0 = 64 * kb, n0 = 32 * nb;
    f32x4 v[8];
#pragma unroll
    for (int i = 0; i < 8; ++i) { const int kk = 8 * i + (lane >> 3); v[i] = *(const f32x4*)(W + (size_t)(k0 + kk) * N + n0 + 4 * (lane & 7)); }
#pragma unroll
    for (int i = 0; i < 8; ++i) { const int kk = 8 * i + (lane >> 3); const float g = gain ? gain[k0 + kk] : 1.0f; *(f32x4*)(scr + kk * 36 + 4 * (lane & 7)) = v[i] * g; }
    asm volatile("s_waitcnt lgkmcnt(0)" ::: "memory");
    const int d0 = MAPID == 0 ? map_in_even(n0) : MAPID == 1 ? map_uq(n0) : MAPID == 2 ? map_ukv(n0) : map_id(n0);
    const int c = lane & 7;
#pragma unroll
    for (int j = 0; j < 4; ++j) { const int n = (lane >> 3) + 8 * j; const float* s = scr + (8 * c) * 36 + n;
        u32x4 o; o.x = f2bf(s[0]) | ((unsigned)f2bf(s[36]) << 16); o.y = f2bf(s[72]) | ((unsigned)f2bf(s[108]) << 16);
        o.z = f2bf(s[144]) | ((unsigned)f2bf(s[180]) << 16); o.w = f2bf(s[216]) | ((unsigned)f2bf(s[252]) << 16);
        *(u32x4*)(WT + (size_t)(d0 + n) * K + k0 + 8 * c) = o; }
    asm volatile("s_waitcnt lgkmcnt(0)" ::: "memory");
}

DI int t5_bucket(int dist) {
    if (dist < 16) return dist;
    float d = (float)dist;
    int large = 16 + (int)(logf(d / 16.0f) / 4.852030263919617f * 16.0f);
    return large < 31 ? large : 31;
}

template <int PART> DI void prep_weights(const Ctx& c, float* scr, int lane, int gw, int NGW) {
    unsigned char* ws = c.ws;
    constexpr int I0 = (2048 / 64) * (IN_EVEN / 32), I1 = (512 / 64) * (1536 / 32), I2 = (512 / 64) * (2048 / 32), I3 = (2048 / 64) * (2048 / 32),
                  I4 = (2048 / 64) * (IN_ODD / 32), I5 = I3;
    constexpr int LO = PART == 1 ? I0 : 0, HI = PART == 0 ? I0 : I0 + I1 + I2 + I3 + I4 + I5;
    for (int it = LO + gw; it < HI; it += NGW) {
        int r = it;
        if (r < I0) { transpose_item<0>(c.w_in_even, 2048, IN_EVEN, c.norm_gain, (bf16_t*)(ws + WS_WT_IN_E), scr, r, lane); continue; } r -= I0;
        if (r < I1) { transpose_item<1>(c.w_uq, 512, 1536, c.q_norm_gain, (bf16_t*)(ws + WS_WT_UQ), scr, r, lane); continue; } r -= I1;
        if (r < I2) { transpose_item<2>(c.w_ukv, 512, 2048, c.kv_norm_gain, (bf16_t*)(ws + WS_WT_UKV), scr, r, lane); continue; } r -= I2;
        if (r < I3) { transpose_item<3>(c.w_out_even, 2048, 2048, nullptr, (bf16_t*)(ws + WS_WT_OUT_E), scr, r, lane); continue; } r -= I3;
        if (r < I4) { transpose_item<3>(c.w_in_odd, 2048, IN_ODD, c.norm_gain + 2048, (bf16_t*)(ws + WS_WT_IN_O), scr, r, lane); continue; } r -= I4;
        transpose_item<3>(c.w_out_odd, 2048, 2048, nullptr, (bf16_t*)(ws + WS_WT_OUT_O), scr, r, lane);
    }
}
template <int NW, int PART> DI void prep_phase(const Ctx& c, float* scr_all, const int tid) {
    const int lane = tid & 63, wave = tid >> 6;
    float* scr = scr_all + wave * 64 * 36;
    const int gw = blockIdx.x * NW + wave, NGW = gridDim.x * NW;
    unsigned char* ws = c.ws;
    prep_weights<PART>(c, scr, lane, gw, NGW);
    const int gt = blockIdx.x * (NW * 64) + tid, NGT = gridDim.x * (NW * 64);
    { bf16_t* wt = (bf16_t*)(ws + WS_WT_IN_E);
      for (int i = gt; i < 192 * 256; i += NGT) { const int rr = i / 256, cc = i % 256; const int row = rr < 96 ? 1056 + rr : 1184 + (rr - 96);
          *(u32x4*)(wt + (size_t)row * 2048 + cc * 8) = (u32x4){0u, 0u, 0u, 0u}; } }
    { float* rc = (float*)(ws + WS_ROPE); float* rs = rc + 4096 * 32;
      for (int i = gt; i < 4096 * 32; i += NGT) { const int pos = i >> 5, j = i & 31; const float inv = 1.0f / powf(10000.0f, (float)j / 32.0f); const float ang = (float)pos * inv;
          rc[i] = cosf(ang); rs[i] = sinf(ang); } }
    { float* bn = (float*)(ws + WS_BIASN);
      for (int i = gt; i < 3 * 8 * 132; i += NGT) { const int p = i / (8 * 132), h = (i / 132) % 8, rel = i % 132; const int dil = p == 0 ? 1 : p == 1 ? 4 : 16;
          bn[i] = rel <= 128 ? c.rel_bias[t5_bucket(rel * dil) * 8 + h] * LOG2E : 0.f; } }
    { float* bc = (float*)(ws + WS_BIASC);
      for (int i = gt; i < 3 * 8 * 5 * 1024; i += NGT) { const int g = i & 15, ln = (i >> 4) & 63, di = (i >> 10) % 5, ph = i / 5120, h = ph & 7, p = ph >> 3; const int dil = p == 0 ? 1 : p == 1 ? 4 : 16;
          const int rel = 32 * di + (ln & 31) - ((g & 3) + 8 * (g >> 2) + 4 * (ln >> 5));
          bc[i] = (rel >= 0 && rel <= 128) ? c.rel_bias[t5_bucket(rel * dil) * 8 + h] * LOG2E : -INFINITY; } }
    { bf16_t* h0 = (bf16_t*)c.out  ; float* ssx = (float*)(ws + WS_SSX);
      for (int m = gw; m < M; m += NGW) { const f32x4* xr = (const f32x4*)(c.x + (size_t)m * D_MODEL) + 2 * lane; float s = 0.f;
          u32x4* o16 = (u32x4*)(h0 + (size_t)m * D_MODEL) + lane;
#pragma unroll
          for (int j = 0; j < 4; ++j) { const f32x4 v = xr[128 * j], w = xr[128 * j + 1];
              s += (v.x * v.x + v.y * v.y + v.z * v.z + v.w * v.w) + (w.x * w.x + w.y * w.y + w.z * w.z + w.w * w.w);
              o16[64 * j] = (u32x4){f2bf(v.x) | ((unsigned)f2bf(v.y) << 16), f2bf(v.z) | ((unsigned)f2bf(v.w) << 16), f2bf(w.x) | ((unsigned)f2bf(w.y) << 16), f2bf(w.z) | ((unsigned)f2bf(w.w) << 16)}; }
          s = wave_sum(s); if (lane == 0) ssx[m] = s; } }
}

__global__ void __launch_bounds__(256) k_prep(Ctx c) { __shared__ float scr_all[4 * 64 * 36]; prep_phase<4, 2>(c, scr_all, (int)threadIdx.x); }

DI float rscale(const float* part, int n, float inv_cols) { float s = 0.f; for (int i = 0; i < n; ++i) s += part[i]; return rsqrtf(s * inv_cols + EPS); }

struct Epi1 {
    unsigned char* ws;
    DI void operator()(int row, int col, float acc) const {
        const float v = acc * rsqrtf(((const float*)(ws + WS_SSX))[row] * (1.0f / 2048.0f) + EPS);
        if (col < 512) ((bf16_t*)(ws + WS_CQ))[(size_t)row * 512 + col] = f2bf(v);
        else if (col < 1024) ((bf16_t*)(ws + WS_CKV))[(size_t)row * 512 + col - 512] = f2bf(v);
        else if (col < 1280) { const int t = col - 1024; if (t < 32) ((bf16_t*)(ws + WS_KR))[(size_t)row * 64 + t] = f2bf(v); else if (t >= 128 && t < 160) ((bf16_t*)(ws + WS_KR))[(size_t)row * 64 + 32 + t - 128] = f2bf(v); }
        else if (col < 2304) ((bf16_t*)(ws + WS_QB))[(size_t)row * 1024 + col - 1280] = f2bf(v * D128_QSCALE);
        else if (col < 3328) ((bf16_t*)(ws + WS_KB))[(size_t)row * 1024 + col - 2304] = f2bf(v);
        else if (col < 4352) ((bf16_t*)(ws + WS_VB))[(size_t)row * 1024 + col - 3328] = f2bf(v);
        else ((bf16_t*)(ws + WS_SG))[(size_t)row * 2048 + col - 4352] = f2bf(silu_f(v));
    }
};
struct Epi2a {
    unsigned char* ws;
    DI void operator()(int row, int col, float acc) const {
        const float v = acc * rscale((const float*)(ws + WS_SSC) + (size_t)row * 16, 8, 1.0f / 512.0f) * MLA_QSCALE;
        if (col < 1024) ((bf16_t*)(ws + WS_QN))[(size_t)row * 1024 + col] = f2bf(v);
        else { const int t = col - 1024, grp = t >> 8, u = t & 255, half = u >> 7, hh = (u & 127) >> 5, i = u & 31;
            ((bf16_t*)(ws + WS_QR))[(size_t)row * 512 + (4 * grp + hh) * 64 + half * 32 + i] = f2bf(v); }
    }
};
struct Epi2b {
    unsigned char* ws;
    DI void operator()(int row, int col, float acc) const {
        const float v = acc * rscale((const float*)(ws + WS_SSC) + (size_t)row * 16 + 8, 8, 1.0f / 512.0f);
        if (col < 1024) ((bf16_t*)(ws + WS_KN))[(size_t)row * 1024 + col] = f2bf(v); else ((bf16_t*)(ws + WS_VA))[(size_t)row * 1024 + col - 1024] = f2bf(v);
    }
};
struct Epi4 {
    unsigned char* ws; const float* x; float* out;
    DI void operator()(int row, int col, float acc) const {
        const float v = x[(size_t)row * 2048 + col] + acc; out[(size_t)row * 2048 + col] = v; ((bf16_t*)(ws + WS_X1BF))[(size_t)row * 2048 + col] = f2bf(v);
    }
};
struct Epi5 {
    unsigned char* ws;
    DI void operator()(int row, int col, float acc) const {
        const float v = acc * rscale((const float*)(ws + WS_SSX1) + (size_t)row * 32, 32, 1.0f / 2048.0f);
        if (col < 2048) ((bf16_t*)(ws + WS_Q2))[(size_t)row * 2048 + col] = f2bf(v * D128_QSCALE);
        else if (col < 4096) ((bf16_t*)(ws + WS_K2))[(size_t)row * 2048 + col - 2048] = f2bf(v);
        else if (col < 6144) ((bf16_t*)(ws + WS_V2))[(size_t)row * 2048 + col - 4096] = f2bf(v);
        else ((bf16_t*)(ws + WS_SG2))[(size_t)row * 2048 + col - 6144] = f2bf(silu_f(v));
    }
};
struct Epi7 {
    float* out;
    DI void operator()(int row, int col, float acc) const { out[(size_t)row * 2048 + col] += acc; }
};

namespace pg8 {
#define PG8_LAS __attribute__((address_space(3)))
typedef short bf16x8 __attribute__((ext_vector_type(8)));
constexpr int BM = 256, BK = 64, HALF = 128, HTB = HALF * BK * 2  , STAGE_BYTES = 8 * HTB, NXCD = 8, WGM = 8;

__host__ __device__ __forceinline__ int lds_byte(int r, int c) { const int st = (r >> 4) * 2 + (c >> 5), rr = r & 15, cc = c & 31, ob = rr * 64 + cc * 2; return st * 1024 + (ob ^ (((ob >> 9) & 1) << 5)); }
__host__ __device__ __forceinline__ void stage_rc(int b, int& R, int& C) { const int st = b / 1024, sb = b % 1024, swz = sb ^ (((sb >> 9) & 1) << 5); R = (st >> 1) * 16 + swz / 64; C = (st & 1) * 32 + (swz % 64) / 2; }
__host__ __device__ __forceinline__ int perm32(int rho) { const int n = rho >> 4, i = rho & 15; return 8 * (i >> 2) + 4 * n + (i & 3); }

struct Unit { int pm, pn; };
struct Gemm { const bf16_t* A; const bf16_t* Bt; int M, N, K; };

struct StaticOrder {
    int nM, nN, nwg, G, c, rep = 1;
    __host__ __device__ void init(int M, int N, int G_, int c_) { nM = M / BM; nN = N / BM; nwg = nM * nN; G = G_; c = c_; }
    __host__ __device__ bool next(int i, Unit& u) const {
        long L = (long)i * G + c; if (L >= (long)nwg * rep) return false; L %= nwg;
        int wgid = (int)L; { const int q = nwg / NXCD, r = nwg % NXCD, xcd = wgid % NXCD, off = wgid / NXCD; wgid = (xcd < r ? xcd * (q + 1) : r * (q + 1) + (xcd - r) * q) + off; }
        const int nig = WGM * nN, gid = wgid / nig, fm = gid * WGM, gsz = (nM - fm) < WGM ? (nM - fm) : WGM;
        u.pm = fm + ((wgid % nig) % gsz); u.pn = (wgid % nig) / gsz; return true;
    }
    __device__ __forceinline__ void a_ready(const Unit&) const {}
    __device__ __forceinline__ void done(const Unit&) const {}
};


typedef float f32x2_t __attribute__((ext_vector_type(2))); typedef __bf16 bf16x2_t __attribute__((ext_vector_type(2)));
__device__ __forceinline__ unsigned cvtpk(float lo, float hi) { f32x2_t v = {lo, hi}; bf16x2_t b = __builtin_convertvector(v, bf16x2_t); return __builtin_bit_cast(unsigned, b); }
__device__ __forceinline__ u32x4 pack8(const f32x4& a, const f32x4& b) { u32x4 w; w.x = cvtpk(a[0], a[1]); w.y = cvtpk(a[2], a[3]); w.z = cvtpk(b[0], b[1]); w.w = cvtpk(b[2], b[3]); return w; }
__device__ __forceinline__ float sumsq4(const f32x4& a) { return (a[0] * a[0] + a[1] * a[1]) + (a[2] * a[2] + a[3] * a[3]); }
__device__ __forceinline__ float silu1(float v) { return v * __builtin_amdgcn_rcpf(1.0f + __builtin_amdgcn_exp2f(-v * LOG2E)); }
__device__ __forceinline__ f32x4 silu4(const f32x4& a) { return (f32x4){silu1(a[0]), silu1(a[1]), silu1(a[2]), silu1(a[3])}; }
__device__ __forceinline__ float quad_sum(float s) { s += __shfl_xor(s, 16); s += __shfl_xor(s, 32); return s; }
__device__ __forceinline__ void rope8(const f32x4& a0, const f32x4& a1, const f32x4& b0, const f32x4& b1, const float* rc, const float* rs, int pos, int i0, u32x4& o1, u32x4& o2) {
    const f32x4 c0 = *(const f32x4*)(rc + pos * 32 + i0), c1 = *(const f32x4*)(rc + pos * 32 + i0 + 4), s0 = *(const f32x4*)(rs + pos * 32 + i0), s1 = *(const f32x4*)(rs + pos * 32 + i0 + 4);
    o1 = pack8(a0 * c0 - b0 * s0, a1 * c1 - b1 * s1); o2 = pack8(a0 * s0 + b0 * c0, a1 * s1 + b1 * c1);
}
#define PG8_EPI_ROWS(...) _Pragma("unroll") for (int ai = 0; ai < 2; ++ai) _Pragma("unroll") for (int m = 0; m < 4; ++m) { const int row = u.pm * BM + ai * HALF + wr * 64 + m * 16 + fr; __VA_ARGS__ }

struct FEpi1 {
    static constexpr bool PERM = true, AFTER_DRAIN = false; unsigned char* ws;
    __device__ __forceinline__ void operator()(const f32x4 (&acc)[2][2][4][2], const Unit& u, int wr, int wc, int fr, int fq) const {
        const int pn = u.pn, cw = wc * 32 + 8 * fq; const float* ssx = (const float*)(ws + WS_SSX);
        PG8_EPI_ROWS(
            const float rs = rsqrtf(ssx[row] * (1.0f / 2048.0f) + EPS);
            if (pn < 4) { bf16_t* dst = (bf16_t*)(ws + (pn < 2 ? WS_CQ : WS_CKV)) + (size_t)row * 512 + (pn & 1) * 256 + cw; float ss = 0.f;
                _Pragma("unroll") for (int bj = 0; bj < 2; ++bj) { const f32x4 v0 = acc[ai][bj][m][0] * rs, v1 = acc[ai][bj][m][1] * rs; ss += sumsq4(v0) + sumsq4(v1); *(u32x4*)(dst + bj * HALF) = pack8(v0, v1); }
                ss = quad_sum(ss); if (fq == 0) ((float*)(ws + WS_SSC))[(size_t)row * 16 + pn * 4 + wc] = ss; }
            else if (pn == 4) { if (wc == 0) { const float* rc = (const float*)(ws + WS_ROPE); u32x4 o1, o2;
                rope8(acc[ai][0][m][0] * rs, acc[ai][0][m][1] * rs, acc[ai][1][m][0] * rs, acc[ai][1][m][1] * rs, rc, rc + 4096 * 32, row % SEQ, 8 * fq, o1, o2);
                bf16_t* dst = (bf16_t*)(ws + WS_KR) + (size_t)row * 64 + 8 * fq; *(u32x4*)dst = o1; *(u32x4*)(dst + 32) = o2; } }
            else if (pn < 17) { const int t = pn - 5; bf16_t* dst = (bf16_t*)(ws + (t < 4 ? WS_QB : t < 8 ? WS_KB : WS_VB)) + (size_t)row * 1024 + (t & 3) * 256 + cw; const float sc = t < 4 ? rs * D128_QSCALE : rs;
                _Pragma("unroll") for (int bj = 0; bj < 2; ++bj) *(u32x4*)(dst + bj * HALF) = pack8(acc[ai][bj][m][0] * sc, acc[ai][bj][m][1] * sc); }
            else { bf16_t* dst = (bf16_t*)(ws + WS_SG) + (size_t)row * 2048 + (pn - 17) * 256 + cw;
                _Pragma("unroll") for (int bj = 0; bj < 2; ++bj) *(u32x4*)(dst + bj * HALF) = pack8(silu4(acc[ai][bj][m][0] * rs), silu4(acc[ai][bj][m][1] * rs)); }
        )
    }
};
struct FEpi2a {
    static constexpr bool PERM = true, AFTER_DRAIN = false; unsigned char* ws;
    __device__ __forceinline__ void operator()(const f32x4 (&acc)[2][2][4][2], const Unit& u, int wr, int wc, int fr, int fq) const {
        const int pn = u.pn, cw = wc * 32 + 8 * fq;
        PG8_EPI_ROWS(
            const f32x4* sp = (const f32x4*)((const float*)(ws + WS_SSC) + (size_t)row * 16); const f32x4 p0 = sp[0], p1 = sp[1];
            const float rs = rsqrtf(((p0[0] + p0[1]) + (p0[2] + p0[3]) + (p1[0] + p1[1]) + (p1[2] + p1[3])) * (1.0f / 512.0f) + EPS) * MLA_QSCALE;
            if (pn < 4) { bf16_t* dst = (bf16_t*)(ws + WS_QN) + (size_t)row * 1024 + pn * 256 + cw;
                _Pragma("unroll") for (int bj = 0; bj < 2; ++bj) *(u32x4*)(dst + bj * HALF) = pack8(acc[ai][bj][m][0] * rs, acc[ai][bj][m][1] * rs); }
            else { const float* rc = (const float*)(ws + WS_ROPE); u32x4 o1, o2; const int head = 4 * (pn - 4) + wc;
                rope8(acc[ai][0][m][0] * rs, acc[ai][0][m][1] * rs, acc[ai][1][m][0] * rs, acc[ai][1][m][1] * rs, rc, rc + 4096 * 32, row % SEQ, 8 * fq, o1, o2);
                bf16_t* dst = (bf16_t*)(ws + WS_QR) + (size_t)row * 512 + head * 64 + 8 * fq; *(u32x4*)dst = o1; *(u32x4*)(dst + 32) = o2; }
        )
    }
};
struct FEpi2b {
    static constexpr bool PERM = true, AFTER_DRAIN = false; unsigned char* ws;
    __device__ __forceinline__ void operator()(const f32x4 (&acc)[2][2][4][2], const Unit& u, int wr, int wc, int fr, int fq) const {
        const int pn = u.pn, cw = wc * 32 + 8 * fq;
        PG8_EPI_ROWS(
            const f32x4* sp = (const f32x4*)((const float*)(ws + WS_SSC) + (size_t)row * 16 + 8); const f32x4 p0 = sp[0], p1 = sp[1];
            const float rs = rsqrtf(((p0[0] + p0[1]) + (p0[2] + p0[3]) + (p1[0] + p1[1]) + (p1[2] + p1[3])) * (1.0f / 512.0f) + EPS);
            bf16_t* dst = (bf16_t*)(ws + (pn < 4 ? WS_KN : WS_VA)) + (size_t)row * 1024 + (pn & 3) * 256 + cw;
            _Pragma("unroll") for (int bj = 0; bj < 2; ++bj) *(u32x4*)(dst + bj * HALF) = pack8(acc[ai][bj][m][0] * rs, acc[ai][bj][m][1] * rs);
        )
    }
};
struct FEpi4 {
    static constexpr bool PERM = true, AFTER_DRAIN = false; unsigned char* ws; const bf16_t* xb;
    __device__ __forceinline__ void operator()(const f32x4 (&acc)[2][2][4][2], const Unit& u, int wr, int wc, int fr, int fq) const {
        const int pn = u.pn, cw = pn * 256 + wc * 32 + 8 * fq;
        const size_t off0 = (size_t)(u.pm * BM + wr * 64 + fr) * 2048 + cw;
        u32x4 pre[2][2];
#define EPI4_LOAD(q, slot) { const bf16_t* p_ = xb + off0 + (size_t)(((q) >> 2) * HALF + ((q) & 3) * 16) * 2048; pre[slot][0] = *(const u32x4*)p_; pre[slot][1] = *(const u32x4*)(p_ + HALF); }
#define BFLO(w) __uint_as_float((w) << 16)
#define BFHI(w) __uint_as_float((w) & 0xffff0000u)
        EPI4_LOAD(0, 0) EPI4_LOAD(1, 1)
#pragma unroll
        for (int q = 0; q < 8; ++q) { const int ai = q >> 2, m = q & 3; const size_t off = off0 + (size_t)(ai * HALF + m * 16) * 2048;
            const u32x4 r0 = pre[q & 1][0], r1 = pre[q & 1][1];
            if (q + 2 < 8) EPI4_LOAD(q + 2, q & 1)
            const f32x4 v00 = (f32x4){BFLO(r0[0]), BFHI(r0[0]), BFLO(r0[1]), BFHI(r0[1])} + acc[ai][0][m][0], v01 = (f32x4){BFLO(r0[2]), BFHI(r0[2]), BFLO(r0[3]), BFHI(r0[3])} + acc[ai][0][m][1];
            const f32x4 v10 = (f32x4){BFLO(r1[0]), BFHI(r1[0]), BFLO(r1[1]), BFHI(r1[1])} + acc[ai][1][m][0], v11 = (f32x4){BFLO(r1[2]), BFHI(r1[2]), BFLO(r1[3]), BFHI(r1[3])} + acc[ai][1][m][1];
            *(u32x4*)((bf16_t*)(ws + WS_X1BF) + off) = pack8(v00, v01); *(u32x4*)((bf16_t*)(ws + WS_X1BF) + off + HALF) = pack8(v10, v11);
            float ss = (sumsq4(v00) + sumsq4(v01)) + (sumsq4(v10) + sumsq4(v11));
            ss = quad_sum(ss); if (fq == 0) ((float*)(ws + WS_SSX1))[(size_t)(u.pm * BM + ai * HALF + wr * 64 + m * 16 + fr) * 32 + pn * 4 + wc] = ss; }
#undef BFLO
#undef BFHI
#undef EPI4_LOAD
    }
};
struct FEpi5 {
    static constexpr bool PERM = true, AFTER_DRAIN = false; unsigned char* ws;
    __device__ __forceinline__ void operator()(const f32x4 (&acc)[2][2][4][2], const Unit& u, int wr, int wc, int fr, int fq) const {
        const int pn = u.pn, cw = (pn & 7) * 256 + wc * 32 + 8 * fq; const int sel = pn >> 3;
        PG8_EPI_ROWS(
            const f32x4* sp = (const f32x4*)((const float*)(ws + WS_SSX1) + (size_t)row * 32 + 8 * fq); const f32x4 p0 = sp[0], p1 = sp[1];
            const float tot = quad_sum((p0[0] + p0[1]) + (p0[2] + p0[3]) + (p1[0] + p1[1]) + (p1[2] + p1[3]));
            const float rs = rsqrtf(tot * (1.0f / 2048.0f) + EPS);
            bf16_t* dst = (bf16_t*)(ws + (sel == 0 ? WS_Q2 : sel == 1 ? WS_K2 : sel == 2 ? WS_V2 : WS_SG2)) + (size_t)row * 2048 + cw;
            if (sel == 3) { _Pragma("unroll") for (int bj = 0; bj < 2; ++bj) *(u32x4*)(dst + bj * HALF) = pack8(silu4(acc[ai][bj][m][0] * rs), silu4(acc[ai][bj][m][1] * rs)); }
            else { const float sc = sel == 0 ? rs * D128_QSCALE : rs;
                _Pragma("unroll") for (int bj = 0; bj < 2; ++bj) *(u32x4*)(dst + bj * HALF) = pack8(acc[ai][bj][m][0] * sc, acc[ai][bj][m][1] * sc); }
        )
    }
};
struct FEpi7 {
    static constexpr bool PERM = true, AFTER_DRAIN = false; bf16_t* x2; const bf16_t* x1;
    __device__ __forceinline__ void operator()(const f32x4 (&acc)[2][2][4][2], const Unit& u, int wr, int wc, int fr, int fq) const {
        const int cw = u.pn * 256 + wc * 32 + 8 * fq;
        const size_t off0 = (size_t)(u.pm * BM + wr * 64 + fr) * 2048 + cw;
        u32x4 pre[2][2];
#define EPI7_LOAD(q, slot) { const bf16_t* p_ = x1 + off0 + (size_t)(((q) >> 2) * HALF + ((q) & 3) * 16) * 2048; pre[slot][0] = *(const u32x4*)p_; pre[slot][1] = *(const u32x4*)(p_ + HALF); }
        EPI7_LOAD(0, 0) EPI7_LOAD(1, 1)
#pragma unroll
        for (int q = 0; q < 8; ++q) { const int ai = q >> 2, m = q & 3; const size_t off = off0 + (size_t)(ai * HALF + m * 16) * 2048;
            const u32x4 r0 = pre[q & 1][0], r1 = pre[q & 1][1];
            if (q + 2 < 8) EPI7_LOAD(q + 2, q & 1)
#define BFLO(w) __uint_as_float((w) << 16)
#define BFHI(w) __uint_as_float((w) & 0xffff0000u)
            *(u32x4*)(x2 + off) = pack8((f32x4){BFLO(r0[0]), BFHI(r0[0]), BFLO(r0[1]), BFHI(r0[1])} + acc[ai][0][m][0], (f32x4){BFLO(r0[2]), BFHI(r0[2]), BFLO(r0[3]), BFHI(r0[3])} + acc[ai][0][m][1]);
            *(u32x4*)(x2 + off + HALF) = pack8((f32x4){BFLO(r1[0]), BFHI(r1[0]), BFLO(r1[1]), BFHI(r1[1])} + acc[ai][1][m][0], (f32x4){BFLO(r1[2]), BFHI(r1[2]), BFLO(r1[3]), BFHI(r1[3])} + acc[ai][1][m][1]); }
#undef BFLO
#undef BFHI
#undef EPI7_LOAD
    }
};
template <class Epi, class Sched, bool ALIGN_EPI = false, bool SP2 = false>
__device__ __forceinline__ void gemm_phase(PG8_LAS unsigned char* lds, const Gemm g, const Sched& S, const Epi& E, const int tid) {
    const int wid = __builtin_amdgcn_readfirstlane(tid >> 6), lane = tid & 63, wr = wid >> 2, wc = wid & 3, fr = lane & 15, fq = lane >> 4;
    const int K = g.K, nt = K / BK;
    unsigned voffA[2], voffB[2];
#pragma unroll
    for (int i = 0; i < 2; ++i) { int R, C; stage_rc(tid * 16 + i * 8192, R, C); const int Rb = Epi::PERM ? ((R & ~31) + perm32(R & 31)) : R;
        voffA[i] = (unsigned)(R * K + C) * 2u; voffB[i] = (unsigned)(Rb * K + C) * 2u; }
    const size_t kstep = (size_t)(BK * 2);
    const size_t hstep = (size_t)HALF * K * 2;
    const size_t tstep = 2 * hstep;
    const unsigned ldsw = (unsigned)wid * 1024u;
    const int aoff = lds_byte(wr * 64 + fr, fq * 8), boff = lds_byte(wc * 32 + fr, fq * 8);
#define PG8_SA(b, h) (((b) * 2 + (h)) * HTB)
#define PG8_SB(b, h) ((4 + (b) * 2 + (h)) * HTB)
#define PG8_STAGE(bufoff, gbase, voff) do { _Pragma("unroll") for (int _i = 0; _i < 2; ++_i) \
        __builtin_amdgcn_global_load_lds((const unsigned*)((const char*)(gbase) + (voff)[_i]), (PG8_LAS unsigned*)(lds + (bufoff) + ldsw + _i * 8192), 16, 0, 0); } while (0)
#define PG8_LDA(dst, b, h) do { _Pragma("unroll") for (int m = 0; m < 4; ++m) _Pragma("unroll") for (int k = 0; k < 2; ++k) dst[m][k] = *(const PG8_LAS bf16x8*)(lds + PG8_SA(b, h) + aoff + m * 2048 + k * 1024); } while (0)
#define PG8_LDB(dst, b, h) do { _Pragma("unroll") for (int n = 0; n < 2; ++n) _Pragma("unroll") for (int k = 0; k < 2; ++k) dst[n][k] = *(const PG8_LAS bf16x8*)(lds + PG8_SB(b, h) + boff + n * 2048 + k * 1024); } while (0)
#define PG8_MMA(ai, bj, At, Bt) do { __builtin_amdgcn_s_setprio(1); _Pragma("unroll") for (int m = 0; m < 4; ++m) _Pragma("unroll") for (int n = 0; n < 2; ++n) _Pragma("unroll") for (int k = 0; k < 2; ++k) \
        acc[ai][bj][m][n] = __builtin_amdgcn_mfma_f32_16x16x32_bf16(Bt[n][k], At[m][k], acc[ai][bj][m][n], 0, 0, 0); __builtin_amdgcn_s_setprio(0); } while (0)
#define PG8_WAIT_V(n) asm volatile("s_waitcnt vmcnt(" #n ")" ::: "memory")
#define PG8_WAIT_L(n) asm volatile("s_waitcnt lgkmcnt(" #n ")" ::: "memory")
#define PG8_BAR __builtin_amdgcn_s_barrier()
#define PG8_SCHED __builtin_amdgcn_sched_barrier(0)
    Unit cur, nxt; int ui = 0;
    if (!S.next(0, cur)) return;
    f32x4 acc[2][2][4][2];
#pragma unroll
    for (int a = 0; a < 2; ++a)
#pragma unroll
        for (int b = 0; b < 2; ++b)
#pragma unroll
            for (int m = 0; m < 4; ++m)
#pragma unroll
                for (int n = 0; n < 2; ++n) acc[a][b][m][n] = (f32x4){0.f, 0.f, 0.f, 0.f};
    bf16x8 At[4][2], B0[2][2], B1[2][2];
    const char* cA = (const char*)g.A + (size_t)cur.pm * tstep; const char* cB = (const char*)g.Bt + (size_t)cur.pn * tstep;
    S.a_ready(cur);
    if constexpr (SP2) {
        PG8_STAGE(PG8_SB(0, 0), cB, voffB); PG8_STAGE(PG8_SB(0, 1), cB + hstep, voffB); PG8_STAGE(PG8_SA(0, 0), cA, voffA); PG8_STAGE(PG8_SA(0, 1), cA + hstep, voffA);
        if (wr == 1) PG8_BAR;
        PG8_WAIT_V(2); PG8_BAR;
        PG8_STAGE(PG8_SB(1, 0), cB + kstep, voffB); PG8_STAGE(PG8_SA(1, 0), cA + kstep, voffA); PG8_STAGE(PG8_SB(1, 1), cB + hstep + kstep, voffB);
        PG8_WAIT_V(6); PG8_BAR;
    } else {
        PG8_STAGE(PG8_SB(0, 0), cB, voffB); PG8_STAGE(PG8_SA(0, 0), cA, voffA); PG8_STAGE(PG8_SB(0, 1), cB + hstep, voffB); PG8_STAGE(PG8_SA(0, 1), cA + hstep, voffA);
        if (wr == 1) PG8_BAR;
        PG8_WAIT_V(4); PG8_BAR;
        PG8_STAGE(PG8_SB(1, 0), cB + kstep, voffB); PG8_STAGE(PG8_SA(1, 0), cA + kstep, voffA); PG8_STAGE(PG8_SB(1, 1), cB + hstep + kstep, voffB);
        PG8_WAIT_V(6); PG8_BAR;
    }
    for (;;) {
        const bool has_next = S.next(ui + 1, nxt);
        const char* nA = has_next ? (const char*)g.A + (size_t)nxt.pm * tstep : cA; const char* nB = has_next ? (const char*)g.Bt + (size_t)nxt.pn * tstep : cB;
        for (int t = 0; t < nt; t += 2) {
            const bool last = (t == nt - 2);
            const char* a1 = cA + (size_t)(t + 1) * kstep;
            const char* a2 = last ? nA : cA + (size_t)(t + 2) * kstep; const char* b2 = last ? nB : cB + (size_t)(t + 2) * kstep;
            const char* a3 = a2 + kstep; const char* b3 = b2 + kstep;
            if (last && has_next) S.a_ready(nxt);
            if constexpr (SP2) {
            PG8_LDB(B0, 0, 0); PG8_LDB(B1, 0, 1); PG8_SCHED; PG8_LDA(At, 0, 0); PG8_STAGE(PG8_SA(1, 1), a1 + hstep, voffA);
            PG8_WAIT_V(8); PG8_WAIT_L(0); PG8_BAR; PG8_MMA(0, 0, At, B0); PG8_MMA(0, 1, At, B1); PG8_BAR; PG8_SCHED;
            PG8_LDA(At, 0, 1); PG8_STAGE(PG8_SB(0, 0), b2, voffB); PG8_STAGE(PG8_SB(0, 1), b2 + hstep, voffB); PG8_STAGE(PG8_SA(0, 0), a2, voffA);
            PG8_WAIT_V(8); PG8_WAIT_L(0); PG8_BAR; PG8_MMA(1, 0, At, B0); PG8_MMA(1, 1, At, B1); PG8_BAR; PG8_SCHED;
            PG8_LDB(B0, 1, 0); PG8_LDB(B1, 1, 1); PG8_SCHED; PG8_LDA(At, 1, 0); PG8_STAGE(PG8_SA(0, 1), a2 + hstep, voffA);
            PG8_WAIT_V(8); PG8_WAIT_L(0); PG8_BAR; PG8_MMA(0, 0, At, B0); PG8_MMA(0, 1, At, B1); PG8_BAR; PG8_SCHED;
            PG8_LDA(At, 1, 1); PG8_STAGE(PG8_SB(1, 0), b3, voffB); PG8_STAGE(PG8_SB(1, 1), b3 + hstep, voffB); PG8_STAGE(PG8_SA(1, 0), a3, voffA);
            PG8_WAIT_V(8); PG8_WAIT_L(0); PG8_BAR; PG8_MMA(1, 0, At, B0); PG8_MMA(1, 1, At, B1); PG8_BAR; PG8_SCHED;
            } else {
            PG8_LDB(B0, 0, 0); PG8_SCHED; PG8_LDA(At, 0, 0); PG8_STAGE(PG8_SA(1, 1), a1 + hstep, voffA);
            PG8_WAIT_L(8); PG8_BAR; PG8_WAIT_L(0); PG8_MMA(0, 0, At, B0); PG8_BAR; PG8_SCHED;
            PG8_LDB(B1, 0, 1); PG8_STAGE(PG8_SB(0, 0), b2, voffB);
            PG8_BAR; PG8_WAIT_L(0); PG8_MMA(0, 1, At, B1); PG8_BAR;
            PG8_LDA(At, 0, 1); PG8_STAGE(PG8_SA(0, 0), a2, voffA);
            PG8_BAR; PG8_WAIT_L(0); PG8_MMA(1, 0, At, B0); PG8_BAR; PG8_SCHED;
            PG8_STAGE(PG8_SB(0, 1), b2 + hstep, voffB);
            PG8_WAIT_V(6); PG8_BAR; PG8_MMA(1, 1, At, B1); PG8_BAR;
            PG8_LDB(B0, 1, 0); PG8_SCHED; PG8_LDA(At, 1, 0); PG8_STAGE(PG8_SA(0, 1), a2 + hstep, voffA);
            PG8_WAIT_L(8); PG8_BAR; PG8_WAIT_L(0); PG8_MMA(0, 0, At, B0); PG8_BAR; PG8_SCHED;
            PG8_LDB(B1, 1, 1); PG8_STAGE(PG8_SB(1, 0), b3, voffB);
            PG8_BAR; PG8_WAIT_L(0); PG8_MMA(0, 1, At, B1); PG8_BAR;
            PG8_LDA(At, 1, 1); PG8_STAGE(PG8_SA(1, 0), a3, voffA);
            PG8_BAR; PG8_WAIT_L(0); PG8_MMA(1, 0, At, B0); PG8_BAR; PG8_SCHED;
            PG8_STAGE(PG8_SB(1, 1), b3 + hstep, voffB);
            PG8_WAIT_V(6); PG8_BAR; PG8_MMA(1, 1, At, B1); PG8_BAR;
            }
        }
        if constexpr (ALIGN_EPI) { if (wr == 0) PG8_BAR; }
        if constexpr (!Epi::AFTER_DRAIN) { E(acc, cur, wr, wc, fr, fq); S.done(cur); }
        if (!has_next) break;
#pragma unroll
        for (int a = 0; a < 2; ++a)
#pragma unroll
            for (int b = 0; b < 2; ++b)
#pragma unroll
                for (int m = 0; m < 4; ++m)
#pragma unroll
                    for (int n = 0; n < 2; ++n) acc[a][b][m][n] = (f32x4){0.f, 0.f, 0.f, 0.f};
        cur = nxt; cA = nA; cB = nB; ++ui;
        if constexpr (ALIGN_EPI) { if (wr == 1) PG8_BAR; }
    }
    PG8_WAIT_V(0);
    if constexpr (!ALIGN_EPI) { if (wr == 0) PG8_BAR; }
    PG8_BAR;
    if constexpr (Epi::AFTER_DRAIN) { E.fused(acc, cur, wr, wc, fr, fq, lds, wid, lane); S.done(cur); }
#undef PG8_SA
#undef PG8_SB
#undef PG8_STAGE
#undef PG8_LDA
#undef PG8_LDB
#undef PG8_MMA
#undef PG8_WAIT_V
#undef PG8_WAIT_L
#undef PG8_BAR
#undef PG8_SCHED
}
}

#define LAS __attribute__((address_space(3)))
template <class Epi> __global__ void __launch_bounds__(512, 2) k_gemm_fast(pg8::Gemm g, Epi E) {
    extern __shared__ __attribute__((aligned(16))) unsigned char lds[];
    pg8::StaticOrder S; S.init(g.M, g.N, (int)gridDim.x, (int)blockIdx.x);
    pg8::gemm_phase<Epi, pg8::StaticOrder, true, true>((LAS unsigned char*)lds, g, S, E, (int)threadIdx.x);
}

template <class Epi>
__global__ void __launch_bounds__(256) k_gemm_naive(const bf16_t* A, const bf16_t* Bt, int N, int K, Epi epi) {
    __shared__ float As[64][33], Bs[64][33];
    const int tid = threadIdx.x, tx = tid & 15, ty = tid >> 4;
    const int nbn = N / 64; const int bm = blockIdx.x / nbn, bn = blockIdx.x % nbn;
    float acc[4][4] = {};
    const int lr = tid >> 2, lc = (tid & 3) * 8;
    for (int k0 = 0; k0 < K; k0 += 32) {
        const u32x4 av = *(const u32x4*)(A + (size_t)(bm * 64 + lr) * K + k0 + lc);
        const u32x4 bv = *(const u32x4*)(Bt + (size_t)(bn * 64 + lr) * K + k0 + lc);
        __syncthreads();
#pragma unroll
        for (int j = 0; j < 4; ++j) { As[lr][lc + 2 * j] = __uint_as_float(av[j] << 16); As[lr][lc + 2 * j + 1] = __uint_as_float(av[j] & 0xffff0000u);
                                      Bs[lr][lc + 2 * j] = __uint_as_float(bv[j] << 16); Bs[lr][lc + 2 * j + 1] = __uint_as_float(bv[j] & 0xffff0000u); }
        __syncthreads();
#pragma unroll 8
        for (int kk = 0; kk < 32; ++kk) { float a[4], b[4];
#pragma unroll
            for (int i = 0; i < 4; ++i) { a[i] = As[ty * 4 + i][kk]; b[i] = Bs[tx * 4 + i][kk]; }
#pragma unroll
            for (int i = 0; i < 4; ++i)
#pragma unroll
                for (int j = 0; j < 4; ++j) acc[i][j] += a[i] * b[j]; }
    }
#pragma unroll
    for (int i = 0; i < 4; ++i)
#pragma unroll
        for (int j = 0; j < 4; ++j) epi(bm * 64 + ty * 4 + i, bn * 64 + tx * 4 + j, acc[i][j]);
}

template <bool F32>
__global__ void __launch_bounds__(256) k_rowss(const void* src, int ld, int ncols, float* dst, int dst_ld, int nslots) {
    const int lane = threadIdx.x & 63, row = blockIdx.x * 4 + (threadIdx.x >> 6);
    float s = 0.f;
    for (int c = lane; c < ncols; c += 64) { const float v = F32 ? ((const float*)src)[(size_t)row * ld + c] : bf2f(((const bf16_t*)src)[(size_t)row * ld + c]); s += v * v; }
    s = wave_sum(s);
    if (lane < nslots) dst[(size_t)row * dst_ld + lane] = lane == 0 ? s : 0.f;
}

__global__ void __launch_bounds__(256) k_rope(bf16_t* buf, int nh, const float* rc, const float* rs) {
    const int idx = blockIdx.x * 256 + threadIdx.x; const int per_row = nh * 32; if (idx >= M * per_row) return;
    const int row = idx / per_row, t = idx % per_row, h = t >> 5, i = t & 31, pos = row % SEQ;
    bf16_t* p = buf + (size_t)row * nh * 64 + h * 64; const float x1 = bf2f(p[i]), x2 = bf2f(p[32 + i]); const float cs = rc[pos * 32 + i], sn = rs[pos * 32 + i];
    p[i] = f2bf(x1 * cs - x2 * sn); p[32 + i] = f2bf(x1 * sn + x2 * cs);
}

template <int D> DI float dot_row(const float* q, const bf16_t* k) {
    float s = 0.f;
#pragma unroll
    for (int d = 0; d < D; d += 8) { const u32x4 v = *(const u32x4*)(k + d);
#pragma unroll
        for (int j = 0; j < 4; ++j) { s += q[d + 2 * j] * __uint_as_float(v[j] << 16); s += q[d + 2 * j + 1] * __uint_as_float(v[j] & 0xffff0000u); } }
    return s;
}

__global__ void __launch_bounds__(256) k_mla_naive(Ctx c) {
    __shared__ float qs[4][192];
    const int lane = threadIdx.x & 63, w = threadIdx.x >> 6; const int gq = blockIdx.x * 4 + w;
    const int t = gq % SEQ, bh = gq / SEQ, h = bh % 8, b = bh / 8; const size_t row = (size_t)b * SEQ + t;
    unsigned char* ws = c.ws;
    const bf16_t *QN = (const bf16_t*)(ws + WS_QN), *QR = (const bf16_t*)(ws + WS_QR), *KN = (const bf16_t*)(ws + WS_KN), *KR = (const bf16_t*)(ws + WS_KR), *VA = (const bf16_t*)(ws + WS_VA), *SG = (const bf16_t*)(ws + WS_SG);
    for (int d = lane; d < 192; d += 64) qs[w][d] = d < 128 ? bf2f(QN[row * 1024 + h * 128 + d]) : bf2f(QR[row * 512 + h * 64 + d - 128]);
    __syncthreads();
    float m = -INFINITY, l = 0.f, o0 = 0.f, o1 = 0.f;
    for (int j0 = 0; j0 <= t; j0 += 64) {
        const int j = j0 + lane; const bool valid = j <= t; const size_t krow = (size_t)b * SEQ + (valid ? j : t);
        float s = dot_row<128>(qs[w], KN + krow * 1024 + h * 128) + dot_row<64>(qs[w] + 128, KR + krow * 64);
        if (!valid) s = -INFINITY;
        const float mn = fmaxf(m, wave_max(s)); const float alpha = exp2f(m - mn); const float p = valid ? exp2f(s - mn) : 0.f;
        l = l * alpha + wave_sum(p); o0 *= alpha; o1 *= alpha; m = mn;
        const int nj = min(64, t - j0 + 1);
        for (int jj = 0; jj < nj; ++jj) { const float pj = __shfl(p, jj); const bf16_t* vr = VA + ((size_t)b * SEQ + j0 + jj) * 1024 + h * 128; o0 += pj * bf2f(vr[lane]); o1 += pj * bf2f(vr[lane + 64]); }
    }
    bf16_t* MIX = (bf16_t*)(ws + WS_MIX); const float il = 1.0f / l;
    MIX[row * 2048 + h * 128 + lane] = f2bf(o0 * il * bf2f(SG[row * 2048 + h * 128 + lane]));
    MIX[row * 2048 + h * 128 + lane + 64] = f2bf(o1 * il * bf2f(SG[row * 2048 + h * 128 + lane + 64]));
}

__global__ void __launch_bounds__(256) k_dil_naive(Ctx c) {
    __shared__ float qs[4][128];
    const int lane = threadIdx.x & 63, w = threadIdx.x >> 6; const int gq = blockIdx.x * 4 + w;
    const int t = gq % SEQ, bh = gq / SEQ, h = bh % 8, b = bh / 8; const size_t row = (size_t)b * SEQ + t;
    unsigned char* ws = c.ws;
    const bf16_t *QB = (const bf16_t*)(ws + WS_QB), *KB = (const bf16_t*)(ws + WS_KB), *VB = (const bf16_t*)(ws + WS_VB);
    const float* bn = (const float*)(ws + WS_BIASN);
    for (int d = lane; d < 128; d += 64) qs[w][d] = bf2f(QB[row * 1024 + h * 128 + d]);
    __syncthreads();
    for (int p = 0; p < 3; ++p) { const int dil = p == 0 ? 1 : p == 1 ? 4 : 16;
        float m = -INFINITY, l = 0.f, o0 = 0.f, o1 = 0.f;
        for (int r0 = 0; r0 < 192; r0 += 64) {
            const int rel = r0 + lane; const int j = t - rel * dil; const bool valid = rel <= 128 && j >= 0; const size_t krow = (size_t)b * SEQ + (valid ? j : t);
            float s = dot_row<128>(qs[w], KB + krow * 1024 + h * 128) + bn[(p * 8 + h) * 132 + (valid ? rel : 0)];
            if (!valid) s = -INFINITY;
            const float mn = fmaxf(m, wave_max(s));
            const float alpha = exp2f(m - mn); const float pp = valid ? exp2f(s - mn) : 0.f;
            l = l * alpha + wave_sum(pp); o0 *= alpha; o1 *= alpha; m = mn;
            for (int jj = 0; jj < 64; ++jj) { const float pj = __shfl(pp, jj); if (pj != 0.f) { const int jr = t - (r0 + jj) * dil; const bf16_t* vr = VB + ((size_t)b * SEQ + jr) * 1024 + h * 128; o0 += pj * bf2f(vr[lane]); o1 += pj * bf2f(vr[lane + 64]); } }
        }
        bf16_t* OP = (bf16_t*)(ws + (p == 0 ? WS_OP0 : p == 1 ? WS_OP1 : WS_OP2)); const float il = 1.0f / l;
        OP[row * 1024 + h * 128 + lane] = f2bf(o0 * il); OP[row * 1024 + h * 128 + lane + 64] = f2bf(o1 * il);
        if (lane == 0) ((float*)(ws + WS_LSE))[((size_t)p * M + row) * 8 + h] = m + log2f(l);
    }
}

DI void dil_merge_item(unsigned char* ws, int row, int col) {
    const int h = col >> 7; const float* lse = (const float*)(ws + WS_LSE);
    const float l0 = lse[((size_t)0 * M + row) * 8 + h], l1 = lse[((size_t)1 * M + row) * 8 + h], l2 = lse[((size_t)2 * M + row) * 8 + h];
    const float mx = fmaxf(l0, fmaxf(l1, l2)); float w0 = exp2f(l0 - mx), w1 = exp2f(l1 - mx), w2 = exp2f(l2 - mx); const float inv = 1.0f / (w0 + w1 + w2); w0 *= inv; w1 *= inv; w2 *= inv;
    const u32x4 a0 = *(const u32x4*)((const bf16_t*)(ws + WS_OP0) + (size_t)row * 1024 + col), a1 = *(const u32x4*)((const bf16_t*)(ws + WS_OP1) + (size_t)row * 1024 + col),
                a2 = *(const u32x4*)((const bf16_t*)(ws + WS_OP2) + (size_t)row * 1024 + col), sg = *(const u32x4*)((const bf16_t*)(ws + WS_SG) + (size_t)row * 2048 + 1024 + col);
    u32x4 o;
#pragma unroll
    for (int j = 0; j < 4; ++j) {
        const float lo = (w0 * __uint_as_float(a0[j] << 16) + w1 * __uint_as_float(a1[j] << 16) + w2 * __uint_as_float(a2[j] << 16)) * __uint_as_float(sg[j] << 16);
        const float hi = (w0 * __uint_as_float(a0[j] & 0xffff0000u) + w1 * __uint_as_float(a1[j] & 0xffff0000u) + w2 * __uint_as_float(a2[j] & 0xffff0000u)) * __uint_as_float(sg[j] & 0xffff0000u);
        o[j] = (unsigned)f2bf(lo) | ((unsigned)f2bf(hi) << 16); }
    *(u32x4*)((bf16_t*)(ws + WS_MIX) + (size_t)row * 2048 + 1024 + col) = o;
}
__global__ void __launch_bounds__(128) k_dil_merge(Ctx c) { dil_merge_item(c.ws, blockIdx.x, threadIdx.x * 8); }

__global__ void __launch_bounds__(256) k_sb_naive(Ctx c) {
    __shared__ float qs[4][128];
    const int lane = threadIdx.x & 63, w = threadIdx.x >> 6; const int gq = blockIdx.x * 4 + w;
    const int t = gq % SEQ, bh = gq / SEQ, h = bh % 16, b = bh / 16; const size_t row = (size_t)b * SEQ + t;
    unsigned char* ws = c.ws;
    const bf16_t *Q2 = (const bf16_t*)(ws + WS_Q2), *K2 = (const bf16_t*)(ws + WS_K2), *V2 = (const bf16_t*)(ws + WS_V2), *SG2 = (const bf16_t*)(ws + WS_SG2);
    for (int d = lane; d < 128; d += 64) qs[w][d] = bf2f(Q2[row * 2048 + h * 128 + d]);
    __syncthreads();
    float carry = 0.f, o0 = 0.f, o1 = 0.f;
    for (int c0 = 0; c0 < t; c0 += 64) {
        const int j = t - 1 - c0 - lane; const bool valid = j >= 0; const size_t krow = (size_t)b * SEQ + (valid ? j : 0);
        const float z = dot_row<128>(qs[w], K2 + krow * 2048 + h * 128);
        const float sp = fmaxf(z, 0.f) + log2f(1.0f + exp2f(-fabsf(z)));
        const float L = valid ? -sp : 0.f;
        float incl = L;
#pragma unroll
        for (int o = 1; o < 64; o <<= 1) { const float v = __shfl_up(incl, o); if (lane >= o) incl += v; }
        const float between = carry + (incl - L);
        const float a = valid ? exp2f(z - sp + between) : 0.f;
        carry += __shfl(incl, 63);
        const int nj = min(64, t - c0);
        for (int jj = 0; jj < nj; ++jj) { const float aj = __shfl(a, jj); const bf16_t* vr = V2 + ((size_t)b * SEQ + t - 1 - c0 - jj) * 2048 + h * 128; o0 += aj * bf2f(vr[lane]); o1 += aj * bf2f(vr[lane + 64]); }
    }
    bf16_t* MIX2 = (bf16_t*)(ws + WS_MIX2);
    MIX2[row * 2048 + h * 128 + lane] = f2bf(o0 * bf2f(SG2[row * 2048 + h * 128 + lane]));
    MIX2[row * 2048 + h * 128 + lane + 64] = f2bf(o1 * bf2f(SG2[row * 2048 + h * 128 + lane + 64]));
}

#ifndef MLA_PIPE
#define MLA_PIPE 1
#endif
namespace att {
typedef short bf16x8 __attribute__((ext_vector_type(8)));
typedef short s16x4 __attribute__((ext_vector_type(4)));
typedef short v4i16_t __attribute__((ext_vector_type(4)));
typedef float f32x16 __attribute__((ext_vector_type(16)));
typedef _Float16 f16x8 __attribute__((ext_vector_type(8)));
typedef _Float16 f16x2 __attribute__((ext_vector_type(2)));
typedef float f32x2_t __attribute__((ext_vector_type(2))); typedef __bf16 bf16x2_t __attribute__((ext_vector_type(2)));
typedef LAS const unsigned char* lcp;
#define MFMA_BF16(a, b, c) __builtin_amdgcn_mfma_f32_32x32x16_bf16((a), (b), (c), 0, 0, 0)
#define MFMA_F16(a, b, c) __builtin_amdgcn_mfma_f32_32x32x16_f16((a), (b), (c), 0, 0, 0)
#define SBAR() __builtin_amdgcn_sched_barrier(0)
DI int crow(int g, int h) { return (g & 3) + 8 * (g >> 2) + 4 * h; }
DI unsigned off_b(unsigned row, unsigned ch) { return 256u * row + 16u * (ch ^ (((row & 3) << 2) | ((row >> 2) & 3))); }
DI unsigned cvtpk(float lo, float hi) { f32x2_t v = {lo, hi}; bf16x2_t b = __builtin_convertvector(v, bf16x2_t); return __builtin_bit_cast(unsigned, b); }
DI unsigned cvtpk_h(float lo, float hi) { f32x2_t v = {lo, hi}; f16x2 b = __builtin_convertvector(v, f16x2); return __builtin_bit_cast(unsigned, b); }
DI bf16x8 pack_bf(const f32x16& x, int s) { u32x4 p; p.x = cvtpk(x[8 * s], x[8 * s + 1]); p.y = cvtpk(x[8 * s + 2], x[8 * s + 3]); p.z = cvtpk(x[8 * s + 4], x[8 * s + 5]); p.w = cvtpk(x[8 * s + 6], x[8 * s + 7]); return __builtin_bit_cast(bf16x8, p); }
DI f16x8 pack_h(const f32x16& x, int s) { u32x4 p; p.x = cvtpk_h(x[8 * s], x[8 * s + 1]); p.y = cvtpk_h(x[8 * s + 2], x[8 * s + 3]); p.z = cvtpk_h(x[8 * s + 4], x[8 * s + 5]); p.w = cvtpk_h(x[8 * s + 6], x[8 * s + 7]); return __builtin_bit_cast(f16x8, p); }
#pragma clang diagnostic push
#pragma clang diagnostic ignored "-Winline-asm"
DI void lds_dma16(const void* g, LAS unsigned char* l) {
    const unsigned la = (unsigned)__builtin_amdgcn_readfirstlane((int)(unsigned)(size_t)l);
    asm volatile("s_mov_b32 m0, %0\n\ts_nop 0\n\tglobal_load_lds_dwordx4 %1, off" :: "s"(la), "v"(g) : "memory", "m0");
}
#pragma clang diagnostic pop
#define DMA_WAIT_ALL() asm volatile("s_waitcnt vmcnt(0)" ::: "memory")
DI s16x4 vtr(lcp p) { return __builtin_bit_cast(s16x4, __builtin_amdgcn_ds_read_tr16_b64_v4i16((LAS v4i16_t*)p)); }
DI float swap_max(float m) { auto rr = __builtin_amdgcn_permlane32_swap(__float_as_uint(m), __float_as_uint(m), false, false); return fmaxf(__uint_as_float(rr[0]), __uint_as_float(rr[1])); }
DI float swap_sum(float m) { auto rr = __builtin_amdgcn_permlane32_swap(__float_as_uint(m), __float_as_uint(m), false, false); return __uint_as_float(rr[0]) + __uint_as_float(rr[1]); }
DI float bcast_lo(float m) { auto rr = __builtin_amdgcn_permlane32_swap(__float_as_uint(m), __float_as_uint(m), false, false); return __uint_as_float(rr[0]); }
DI void o_pair8(const f32x16& o, int p, float (&e)[8]) {
#pragma unroll
    for (int i = 0; i < 4; ++i) { auto rr = __builtin_amdgcn_permlane32_swap(__float_as_uint(o[8 * p + i]), __float_as_uint(o[8 * p + 4 + i]), false, false); e[i] = __uint_as_float(rr[0]); e[4 + i] = __uint_as_float(rr[1]); }
}
DI __amdgpu_buffer_rsrc_t mk_rsrc(const void* p, unsigned bytes) { return __builtin_amdgcn_make_buffer_rsrc((void*)p, 0, bytes, 0x00020000); }
DI u32x4 bload(__amdgpu_buffer_rsrc_t rs, unsigned voff, unsigned soff) { return __builtin_amdgcn_raw_buffer_load_b128(rs, voff, soff, 0); }
struct VAddr { unsigned a[2][4]; };
DI VAddr make_vaddr(int lane) { VAddr v; const unsigned hh = lane >> 5, blk = (lane >> 4) & 1, qq = (lane & 15) >> 2, p = lane & 3;
#pragma unroll
    for (int t = 0; t < 2; ++t)
#pragma unroll
        for (int d0 = 0; d0 < 4; ++d0) v.a[t][d0] = off_b(8 * t + 4 * hh + qq, 4 * d0 + 2 * blk + (p >> 1)) + 8 * (p & 1);
    return v; }
DI bf16x8 vfrag(lcp img, int s, int d0, const VAddr& va) {
    const s16x4 lo = vtr(img + 4096 * s + va.a[0][d0]);
    const s16x4 hi = vtr(img + 4096 * s + va.a[1][d0]);
    return (bf16x8){lo[0], lo[1], lo[2], lo[3], hi[0], hi[1], hi[2], hi[3]};
}
DI void softmax_tile(f32x16& s0, f32x16& s1, f32x16 (&o)[4], float& mrun, float& lrun) {
    float mt = fmaxf(s0[0], s1[0]);
#pragma unroll
    for (int g = 1; g < 16; ++g) mt = fmaxf(mt, fmaxf(s0[g], s1[g]));
    mt = swap_max(mt);
    const float mn = fmaxf(mrun, mt), alpha = __builtin_amdgcn_exp2f(mrun - mn); mrun = mn;
    float ps = 0.f;
#pragma unroll
    for (int g = 0; g < 16; ++g) { s0[g] = __builtin_amdgcn_exp2f(s0[g] - mn); s1[g] = __builtin_amdgcn_exp2f(s1[g] - mn); ps += s0[g] + s1[g]; }
    lrun = lrun * alpha + ps;
#pragma unroll
    for (int d0 = 0; d0 < 4; ++d0)
#pragma unroll
        for (int g = 0; g < 16; ++g) o[d0][g] *= alpha;
}

constexpr int MLA_KSTR = 400, MLA_KBUF = 64 * MLA_KSTR, VBUF = 16384, MLA_LDS_V = 2 * MLA_KBUF, MLA_LDS_BYTES = 2 * MLA_KBUF + 2 * VBUF;
template <bool MASKED>
DI void mla_tile(lcp kb, lcp vb, const bf16x8 (&qf)[12], f32x16 (&o)[4], float& mrun, float& lrun, const VAddr& va, int qrel, int hh) {
    f32x16 s0, s1;
#pragma unroll
    for (int g = 0; g < 16; ++g) { s0[g] = 0.f; s1[g] = 0.f; }
    bf16x8 f0a = *(LAS const bf16x8*)kb, f0b = *(LAS const bf16x8*)(kb + 32 * MLA_KSTR), f1a = *(LAS const bf16x8*)(kb + 32), f1b = *(LAS const bf16x8*)(kb + 32 * MLA_KSTR + 32), f2a, f2b;
#pragma unroll
    for (int d0 = 0; d0 < 12; ++d0) {
        if (d0 + 2 < 12) { const bf16x8 n0 = *(LAS const bf16x8*)(kb + (d0 + 2) * 32), n1 = *(LAS const bf16x8*)(kb + 32 * MLA_KSTR + (d0 + 2) * 32);
            if ((d0 + 2) % 3 == 0) { f0a = n0; f0b = n1; } else if ((d0 + 2) % 3 == 1) { f1a = n0; f1b = n1; } else { f2a = n0; f2b = n1; } }
        SBAR();
        s0 = MFMA_BF16(d0 % 3 == 0 ? f0a : d0 % 3 == 1 ? f1a : f2a, qf[d0], s0); s1 = MFMA_BF16(d0 % 3 == 0 ? f0b : d0 % 3 == 1 ? f1b : f2b, qf[d0], s1);
        SBAR();
    }
    if (MASKED) {
#pragma unroll
        for (int g = 0; g < 16; ++g) { const int kv = crow(g, 0); if (kv > qrel - 4 * hh) s0[g] = -INFINITY; if (kv + 32 > qrel - 4 * hh) s1[g] = -INFINITY; } }
    float mt = fmaxf(s0[0], s1[0]);
#pragma unroll
    for (int g = 1; g < 16; ++g) mt = fmaxf(mt, fmaxf(s0[g], s1[g]));
    mt = swap_max(mt);
    if (__builtin_amdgcn_ballot_w64(mt > mrun) != 0ull) {
        const float mn = fmaxf(mrun, mt), alpha = __builtin_amdgcn_exp2f(mrun - mn); mrun = mn; lrun *= alpha;
#pragma unroll
        for (int d0 = 0; d0 < 4; ++d0)
#pragma unroll
            for (int g = 0; g < 16; ++g) o[d0][g] *= alpha;
    }
    float ps = 0.f;
#pragma unroll
    for (int g = 0; g < 16; ++g) { s0[g] = __builtin_amdgcn_exp2f(s0[g] - mrun); s1[g] = __builtin_amdgcn_exp2f(s1[g] - mrun); ps += s0[g] + s1[g]; }
    lrun += ps;
    bf16x8 pf[4]; pf[0] = pack_bf(s0, 0); pf[1] = pack_bf(s0, 1); pf[2] = pack_bf(s1, 0); pf[3] = pack_bf(s1, 1);
    bf16x8 v0 = vfrag(vb, 0, 0, va), v1 = vfrag(vb, 0, 1, va), v2;
#pragma unroll
    for (int j = 0; j < 16; ++j) {
        if (j + 2 < 16) { const int ks = (j + 2) >> 2, d0 = (j + 2) & 3; const bf16x8 nx = vfrag(vb + (ks >> 1) * 8192, ks & 1, d0, va);
            if ((j + 2) % 3 == 0) v0 = nx; else if ((j + 2) % 3 == 1) v1 = nx; else v2 = nx; }
        SBAR();
        o[j & 3] = MFMA_BF16(j % 3 == 0 ? v0 : j % 3 == 1 ? v1 : v2, pf[j >> 2], o[j & 3]);
        SBAR();
    }
}
DI void mla_unit(LAS unsigned char* lds, unsigned char* ws, int b, int h, int qb, const int tid_in) {
    int tid = tid_in; asm volatile("" : "+v"(tid));
    const int lane = tid & 63, wid = __builtin_amdgcn_readfirstlane(tid >> 6), r = lane & 31, hh = lane >> 5;
    const bf16_t *QN = (const bf16_t*)(ws + WS_QN), *QR = (const bf16_t*)(ws + WS_QR), *KN = (const bf16_t*)(ws + WS_KN), *KR = (const bf16_t*)(ws + WS_KR), *VA = (const bf16_t*)(ws + WS_VA), *SG = (const bf16_t*)(ws + WS_SG);
    bf16_t* MIX = (bf16_t*)(ws + WS_MIX);
    const int q0 = qb * 256, NT = 4 * (qb + 1), tmax = (q0 + 32 * wid) >> 6; const size_t rowbase = (size_t)b * SEQ;
    bf16x8 qf[12];
    { const size_t qrow = rowbase + q0 + 32 * wid + r;
#pragma unroll
      for (int d0 = 0; d0 < 8; ++d0) qf[d0] = *(const bf16x8*)(QN + qrow * 1024 + h * 128 + d0 * 16 + hh * 8);
#pragma unroll
      for (int d0 = 0; d0 < 4; ++d0) qf[8 + d0] = *(const bf16x8*)(QR + qrow * 512 + h * 64 + d0 * 16 + hh * 8); }
    f32x16 o[4];
#pragma unroll
    for (int d0 = 0; d0 < 4; ++d0)
#pragma unroll
        for (int g = 0; g < 16; ++g) o[d0][g] = 0.f;
    float mrun = -INFINITY, lrun = 0.f;
    u32x4 kreg[3], vreg[2];
    const VAddr va = make_vaddr(lane);
    const __amdgpu_buffer_rsrc_t rKN = mk_rsrc(KN, M * 1024 * 2), rKR = mk_rsrc(KR, M * 64 * 2), rVA = mk_rsrc(VA, M * 1024 * 2);
    const unsigned vo0 = (tid >> 4) * 2048 + (tid & 15) * 16, vo1 = vo0 + 32 * 2048, vor = (tid >> 3) * 128 + (tid & 7) * 16;
    const unsigned so_n = ((unsigned)rowbase * 1024 + h * 128) * 2, so_r = (unsigned)rowbase * 64 * 2;
    const unsigned lk0 = (tid >> 4) * MLA_KSTR + (tid & 15) * 16, lk1 = lk0 + 32 * MLA_KSTR, lkr = (tid >> 3) * MLA_KSTR + 256 + (tid & 7) * 16;
    const unsigned lv0 = off_b((tid >> 4) & 31, tid & 15), lv1 = lv0 + 8192;
    const unsigned kfo = r * MLA_KSTR + hh * 16;
#define MLA_LOAD(t) do { const unsigned tn = so_n + (unsigned)(t) * (64 * 2048), tr_ = so_r + (unsigned)(t) * (64 * 128); \
        kreg[0] = bload(rKN, vo0, tn); kreg[1] = bload(rKN, vo1, tn); kreg[2] = bload(rKR, vor, tr_); vreg[0] = bload(rVA, vo0, tn); vreg[1] = bload(rVA, vo1, tn); } while (0)
#define MLA_STORE(buf) do { LAS unsigned char* kd = lds + (buf) * MLA_KBUF; LAS unsigned char* vd = lds + MLA_LDS_V + (buf) * VBUF; \
        *(LAS u32x4*)(kd + lk0) = kreg[0]; *(LAS u32x4*)(kd + lk1) = kreg[1]; *(LAS u32x4*)(kd + lkr) = kreg[2]; *(LAS u32x4*)(vd + lv0) = vreg[0]; *(LAS u32x4*)(vd + lv1) = vreg[1]; } while (0)
    MLA_LOAD(0); MLA_STORE(0); __builtin_amdgcn_s_waitcnt(0x0F70);   __syncthreads();
#define MLA_INTERVAL(MODE) { const int buf = t & 1; \
        if (t + 1 < NT) MLA_LOAD(t + 1); \
        if (MODE == 0) mla_tile<false>(lds + buf * MLA_KBUF + kfo, lds + MLA_LDS_V + buf * VBUF, qf, o, mrun, lrun, va, 0, hh); \
        if (MODE == 1) mla_tile<true>(lds + buf * MLA_KBUF + kfo, lds + MLA_LDS_V + buf * VBUF, qf, o, mrun, lrun, va, q0 + 32 * wid + r - 64 * t, hh); \
        if (t + 1 < NT) MLA_STORE(buf ^ 1); \
        __syncthreads(); }
    int t = 0;
    for (; t < tmax; ++t) MLA_INTERVAL(0)
    MLA_INTERVAL(1)
    for (++t; t < NT; ++t) MLA_INTERVAL(2)
#undef MLA_INTERVAL
#undef MLA_LOAD
#undef MLA_STORE
    const float inv = 1.0f / swap_sum(lrun);
    int t4 = tid; asm volatile("" : "+v"(t4)); const size_t qrow = rowbase + q0 + 32 * wid + (t4 & 31); const int hh2 = (t4 >> 5) & 1;
#pragma unroll
    for (int d0 = 0; d0 < 4; ++d0)
#pragma unroll
        for (int gg = 0; gg < 4; ++gg) { const size_t off = qrow * 2048 + h * 128 + 32 * d0 + 8 * gg + 4 * hh2;
            const unsigned long long sg = *(const unsigned long long*)(SG + off);
            const float g0 = __uint_as_float((unsigned)(sg << 16)), g1 = __uint_as_float((unsigned)sg & 0xffff0000u), g2 = __uint_as_float((unsigned)(sg >> 32) << 16), g3 = __uint_as_float((unsigned)(sg >> 32) & 0xffff0000u);
            const unsigned lo = cvtpk(o[d0][4 * gg] * inv * g0, o[d0][4 * gg + 1] * inv * g1), hi = cvtpk(o[d0][4 * gg + 2] * inv * g2, o[d0][4 * gg + 3] * inv * g3);
            *(unsigned long long*)(MIX + off) = (unsigned long long)lo | ((unsigned long long)hi << 32); }
}
DI float vmax3_s(float a, float b, float c) { float r; asm("v_max3_f32 %0, %1, %2, %3" : "=v"(r) : "v"(a), "v"(b), "v"(c)); return r; }
constexpr int M2_KBUF = 64 * 384, M2_LDS_V = 3 * M2_KBUF, M2_LDS_BYTES = M2_LDS_V + 3 * VBUF;
struct M2State { f32x16 o[4]; f32x16 negv; float mrun, lrun, nref; };
template <int KIMM, int VIMM>
DI void mla2_iter(f32x16& zin, float& rin, f32x16& zout, float& rout, M2State& st, const u32x4& pi0, const u32x4& pi1, u32x4& po0, u32x4& po1, const bf16x8 (&qf)[12], const unsigned (&koff)[4], const unsigned (&voff)[2][4],
                  const bool masked, const int qrh) {
#define M2_KF(d0) (*(LAS const bf16x8*)(koff[(d0) & 3] + (unsigned)(KIMM + 128 * ((d0) >> 2))))
#define M2_VF(t, j) vtr((lcp)(voff[t][(j) & 3] + (unsigned)(VIMM + 4096 * ((j) >> 2))))
    if (masked) {
        asm volatile("" ::: "memory");
#pragma unroll
        for (int g = 0; g < 16; ++g) if (crow(g, 0) > qrh) zin[g] = -INFINITY;
    }
    bf16x8 kfA = M2_KF(0), kfB; s16x4 la, ha, lb, hb;
    float mt = 0.f, mnew = 0.f, alpha = 1.f, ps = 0.f; bool grow = false; float pe[16];
    SBAR();
#pragma unroll
    for (int i = 0; i < 20; ++i) {
        const int c5 = i % 5, blk5 = i / 5; const bool isP = (c5 == 2 || c5 == 4);
        const int qi = blk5 * 3 + (c5 < 2 ? c5 : 2), pj = blk5 * 2 + (c5 == 2 ? 0 : 1);
        if (isP) { const s16x4 lo = (pj & 1) ? lb : la, hi = (pj & 1) ? hb : ha; const bf16x8 vf = (bf16x8){lo[0], lo[1], lo[2], lo[3], hi[0], hi[1], hi[2], hi[3]};
            st.o[pj & 3] = MFMA_BF16(vf, __builtin_bit_cast(bf16x8, (pj >> 2) ? pi1 : pi0), st.o[pj & 3]); }
        else if (i == 0) { f32x16 zero_;
#pragma unroll
            for (int g = 0; g < 16; ++g) zero_[g] = 0.f;
            (void)zero_; zout = MFMA_BF16(kfA, qf[0], st.negv); rout = st.nref; }
        else zout = MFMA_BF16((qi & 1) ? kfB : kfA, qf[qi], zout);
        if (!isP && qi + 1 < 12) { const bf16x8 nx = M2_KF(qi + 1); if ((qi + 1) & 1) kfB = nx; else kfA = nx; }
        if (isP && pj + 1 < 8) { const s16x4 l_ = M2_VF(0, pj + 1), h_ = M2_VF(1, pj + 1); if ((pj + 1) & 1) { lb = l_; hb = h_; } else { la = l_; ha = h_; } }
        if (i == 0) { la = M2_VF(0, 0); ha = M2_VF(1, 0); }
        SBAR();
        if (i < 4) { float a = vmax3_s(zin[4 * i], zin[4 * i + 1], zin[4 * i + 2]); mt = i == 0 ? vmax3_s(a, zin[3], zin[3]) : vmax3_s(mt, a, zin[4 * i + 3]); asm volatile("" : "+v"(mt)); }
        if (i == 4) { mt = swap_max(mt) + rin;
            grow = __builtin_amdgcn_ballot_w64((mt > st.mrun) || (rin != st.mrun)) != 0ull;
            if (grow) {
                mnew = fmaxf(st.mrun, mt); alpha = __builtin_amdgcn_exp2f(st.mrun - mnew); const float dl = mnew - rin;
#pragma unroll
                for (int g = 0; g < 16; ++g) zin[g] -= dl;
                st.mrun = mnew; st.lrun *= alpha; } }
        if (i >= 5 && i < 13) { const int g = 2 * (i - 5); float e0 = __builtin_amdgcn_exp2f(zin[g]), e1 = __builtin_amdgcn_exp2f(zin[g + 1]); ps += e0 + e1;
            asm volatile("" : "+v"(ps)); pe[g] = e0; pe[g + 1] = e1; }
        if (i >= 13 && i < 17) { const int w_ = i - 13; unsigned w0 = cvtpk(pe[4 * w_], pe[4 * w_ + 1]), w1 = cvtpk(pe[4 * w_ + 2], pe[4 * w_ + 3]); asm volatile("" : "+v"(w0), "+v"(w1));
            if (w_ < 2) { po0[2 * w_] = w0; po0[2 * w_ + 1] = w1; } else { po1[2 * (w_ - 2)] = w0; po1[2 * (w_ - 2) + 1] = w1; } }
        SBAR();
    }
    st.lrun += ps;
    if (grow) {
#pragma unroll
        for (int d0 = 0; d0 < 4; ++d0)
#pragma unroll
            for (int g = 0; g < 16; ++g) st.o[d0][g] *= alpha;
        st.nref = st.mrun;
#pragma unroll
        for (int g = 0; g < 16; ++g) st.negv[g] = -st.mrun;
    }
#undef M2_KF
#undef M2_VF
}
DI void mla2_unit(LAS unsigned char* lds, unsigned char* ws, int b, int h, int qb, const int tid_in) {
    int tid = tid_in; asm volatile("" : "+v"(tid));
    const int lane = tid & 63, wid = __builtin_amdgcn_readfirstlane(tid >> 6), r = lane & 31, hh = lane >> 5;
    const bf16_t *QN = (const bf16_t*)(ws + WS_QN), *QR = (const bf16_t*)(ws + WS_QR), *KN = (const bf16_t*)(ws + WS_KN), *KR = (const bf16_t*)(ws + WS_KR), *VA = (const bf16_t*)(ws + WS_VA), *SG = (const bf16_t*)(ws + WS_SG);
    bf16_t* MIX = (bf16_t*)(ws + WS_MIX);
    const int q0 = qb * 256, NT = 4 * (qb + 1), tmax = (q0 + 32 * wid) >> 6; const size_t rowbase = (size_t)b * SEQ;
    bf16x8 qf[12];
    { const size_t qrow = rowbase + q0 + 32 * wid + r;
#pragma unroll
      for (int d0 = 0; d0 < 8; ++d0) qf[d0] = *(const bf16x8*)(QN + qrow * 1024 + h * 128 + d0 * 16 + hh * 8);
#pragma unroll
      for (int d0 = 0; d0 < 4; ++d0) qf[8 + d0] = *(const bf16x8*)(QR + qrow * 512 + h * 64 + d0 * 16 + hh * 8); }
    M2State st;
#pragma unroll
    for (int d0 = 0; d0 < 4; ++d0)
#pragma unroll
        for (int g = 0; g < 16; ++g) st.o[d0][g] = 0.f;
    st.mrun = -INFINITY; st.lrun = 0.f; st.nref = 0.f;
#pragma unroll
    for (int g = 0; g < 16; ++g) st.negv[g] = 0.f;
    float ra = 0.f, rb = 0.f;
    unsigned koff[4], voff[2][4];
    { const unsigned blk = (lane >> 4) & 1, qq = (lane & 15) >> 2, p = lane & 3, f = (r >> 1) & 7;
      const unsigned kb_ = (unsigned)(size_t)lds + r * 384;
#pragma unroll
      for (int j = 0; j < 4; ++j) koff[j] = kb_ + 16 * ((2 * j + hh) ^ f);
      const unsigned vb0 = 256 * (4 * hh + qq) + 8 * (p & 1) + 16 * ((2 * blk + (p >> 1)) ^ hh), v0_ = (unsigned)(size_t)lds + M2_LDS_V + vb0, v1_ = (unsigned)(size_t)lds + M2_LDS_V + 2048 + (vb0 ^ 32);
#pragma unroll
      for (int d0 = 0; d0 < 4; ++d0) { voff[0][d0] = v0_ + ((64u * d0) ^ (64u * qq)); voff[1][d0] = v1_ + ((64u * d0) ^ (64u * qq)); } }
    const bf16_t* knb = KN + rowbase * 1024 + h * 128; const bf16_t* krb = KR + rowbase * 64; const bf16_t* vab = VA + rowbase * 1024 + h * 128;
    unsigned ksrc[3];
#pragma unroll
    for (int i_ = 0; i_ < 3; ++i_) { const int c_ = (3 * wid + i_) * 64 + lane, row_ = c_ / 24, ch_ = (c_ % 24) ^ ((row_ >> 1) & 7);
        ksrc[i_] = ch_ < 16 ? (unsigned)(row_ * 1024 + ch_ * 8) : (0x80000000u | (unsigned)(row_ * 64 + (ch_ - 16) * 8)); }
#define M2_DMAK(t, slot) do { _Pragma("unroll") for (int i_ = 0; i_ < 3; ++i_) { const unsigned o_ = ksrc[i_] & 0x7fffffffu; \
            const bf16_t* src_ = (ksrc[i_] >> 31) ? krb + (size_t)(t) * (64 * 64) + o_ : knb + (size_t)(t) * (64 * 1024) + o_; \
            lds_dma16(src_, lds + (slot) * M2_KBUF + (3 * wid + i_) * 1024); } } while (0)
#define M2_DMAV(t, slot) do { int t2_ = tid; asm volatile("" : "+v"(t2_)); const int ln_ = t2_ & 63, drow_ = 8 * wid + (ln_ >> 4), c15_ = ln_ & 15; \
        const unsigned s0_ = (unsigned)drow_ * 1024 + ((c15_ ^ (((drow_ & 3) << 2) | ((drow_ >> 2) & 3))) * 8), s1_ = (unsigned)(drow_ + 4) * 1024 + ((c15_ ^ ((((drow_ + 4) & 3) << 2) | (((drow_ + 4) >> 2) & 3))) * 8); \
        const bf16_t* vt = vab + (size_t)(t) * (64 * 1024); LAS unsigned char* vd = lds + M2_LDS_V + (slot) * VBUF + wid * 2048; \
        lds_dma16(vt + s0_, vd); lds_dma16(vt + s1_, vd + 1024); } while (0)
    M2_DMAK(0, 0); M2_DMAV(0, 0); M2_DMAV(0, 2);
    if (NT > 1) M2_DMAK(1, 1);
    __builtin_amdgcn_s_waitcnt(0x0F70);
    __syncthreads();
    f32x16 za, zb;
#pragma unroll
    for (int g = 0; g < 16; ++g) { za[g] = 0.f; zb[g] = 0.f; }
#pragma unroll
    for (int d0 = 0; d0 < 12; ++d0) za = MFMA_BF16(*(LAS const bf16x8*)(koff[d0 & 3] + (unsigned)(128 * (d0 >> 2))), qf[d0], za);
    u32x4 pa[2], pb[2]; pa[0] = (u32x4){0u, 0u, 0u, 0u}; pa[1] = pa[0]; pb[0] = pa[0]; pb[1] = pa[0];
#define M2_INTERVAL(P) { if (t + 2 < NT) M2_DMAK(t + 2, ((P) + 2) % 3); if (t + 1 < NT) M2_DMAV(t + 1, ((P) + 1) % 3); \
        if (t <= tmax) {           \
            int qrh; { int t3 = tid; asm volatile("" : "+v"(t3)); qrh = q0 + 32 * wid + (t3 & 31) - 4 * ((t3 >> 5) & 1) - 64 * t; } const bool msk = t == tmax; \
            mla2_iter<(P) * M2_KBUF + 32 * 384, (((P) + 2) % 3) * VBUF + 8192>(za, ra, zb, rb, st, pa[0], pa[1], pb[0], pb[1], qf, koff, voff, msk, qrh); \
            mla2_iter<(((P) + 1) % 3) * M2_KBUF, (P) * VBUF>(zb, rb, za, ra, st, pb[0], pb[1], pa[0], pa[1], qf, koff, voff, msk, qrh - 32); \
            if (msk) {            \
                lcp vb_ = lds + M2_LDS_V + (P) * VBUF + 8192; const VAddr va_ = make_vaddr(tid & 63); \
                _Pragma("unroll") for (int j = 0; j < 8; ++j) st.o[j & 3] = MFMA_BF16(vfrag(vb_, j >> 2, j & 3, va_), __builtin_bit_cast(bf16x8, (j >> 2) ? pa[1] : pa[0]), st.o[j & 3]); } } \
        ++t; DMA_WAIT_ALL(); __syncthreads(); }
    int t = 0;
    for (;;) { M2_INTERVAL(0) if (t >= NT) break; M2_INTERVAL(1) if (t >= NT) break; M2_INTERVAL(2) if (t >= NT) break; }
#undef M2_INTERVAL
#undef M2_DMAK
#undef M2_DMAV
    const float inv = 1.0f / swap_sum(st.lrun);
    int t4 = tid; asm volatile("" : "+v"(t4)); const size_t qrow = rowbase + q0 + 32 * wid + (t4 & 31); const int hh2 = (t4 >> 5) & 1;
#pragma unroll
    for (int d0 = 0; d0 < 4; ++d0)
#pragma unroll
        for (int p = 0; p < 2; ++p) { const size_t off = qrow * 2048 + h * 128 + 32 * d0 + 16 * p + 8 * hh2; float e[8]; o_pair8(st.o[d0], p, e);
            const u32x4 sg = *(const u32x4*)(SG + off); u32x4 w;
#pragma unroll
            for (int j = 0; j < 4; ++j) w[j] = cvtpk(e[2 * j] * inv * __uint_as_float(sg[j] << 16), e[2 * j + 1] * inv * __uint_as_float(sg[j] & 0xffff0000u));
            *(u32x4*)(MIX + off) = w; }
}
DI void mla_phase(LAS unsigned char* lds, unsigned char* ws, const int tid) {
    const int G = gridDim.x, bx = blockIdx.x; const int vcu = (G % 8 == 0) ? (bx % 8) * (G / 8) + bx / 8 : bx;
    for (int p = vcu; p < 256; p += G) { const int bh = p >> 3, pr = p & 7;
#if MLA_PIPE
        mla2_unit(lds, ws, bh >> 3, bh & 7, 15 - pr, tid); mla2_unit(lds, ws, bh >> 3, bh & 7, pr, tid);
#else
        mla_unit(lds, ws, bh >> 3, bh & 7, 15 - pr, tid); mla_unit(lds, ws, bh >> 3, bh & 7, pr, tid);
#endif
 }
}

constexpr int SB_KBUF = 16384, SB_LDS_V = 3 * SB_KBUF, SB_LDS_UM = SB_LDS_V + 3 * VBUF, SB_LDS_BYTES = SB_LDS_UM + 2048 + 64;
DI float vmin_s(float a, float b) { float r; asm("v_min_f32 %0, %1, %2" : "=v"(r) : "v"(a), "v"(b)); return r; }
struct SbAddr { unsigned kx, vb0, vq; };
template <bool MASKED, int VAR>
DI void sb_iter(f32x16& zin, f32x16& zout, f32x16 (&o)[4], const u32x4& pi0, const u32x4& pi1, u32x4& po0, u32x4& po1, float& carry, const bf16x8 (&qf)[8], lcp ump, lcp knext, lcp vprev, const SbAddr& ad, int qrh) {
    u32x4 lw0, lw1; const float z0 = zin[0];
    unsigned kx = ad.kx, vq = ad.vq; asm volatile("" : "+v"(kx), "+v"(vq));
    bf16x8 kfa = *(LAS const bf16x8*)(knext + kx), kfb;
#pragma unroll
    for (int k = 0; k < 8; ++k) {
        if (k == 0) {
#pragma unroll
            for (int g = 0; g < 16; ++g) zout[g] = 0.f;
        }
        if (VAR == 2 || VAR == 4 || VAR == 11 || VAR == 13) { asm volatile("" :: "v"((k & 1) ? kfb : kfa)); } else zout = MFMA_BF16((k & 1) ? kfb : kfa, qf[k], zout);
        if (VAR == 12) { zout = MFMA_BF16((k & 1) ? kfb : kfa, qf[k], zout); zout = MFMA_BF16((k & 1) ? kfb : kfa, qf[k], zout); }
        if (k + 1 < 8) { bf16x8 nx; if (VAR == 3 || VAR == 4 || VAR == 9 || VAR == 11 || VAR == 12 || VAR == 13) nx = qf[k]; else nx = *(LAS const bf16x8*)(knext + ((32u * (k + 1)) ^ kx)); if (k & 1) kfa = nx; else kfb = nx; }
        SBAR();
        float lv[2];
#pragma unroll
        for (int i = 0; i < 2; ++i) { const int g = 2 * k + i;
            float sp; if (VAR == 8 || VAR == 9 || VAR == 12) sp = zin[g]; else if (VAR == 13) { sp = __builtin_amdgcn_logf(1.0f + __builtin_amdgcn_exp2f(vmin_s(zin[g], 64.0f))); sp = __builtin_amdgcn_logf(1.0f + __builtin_amdgcn_exp2f(vmin_s(sp, 64.0f))); sp = __builtin_amdgcn_logf(1.0f + __builtin_amdgcn_exp2f(vmin_s(sp, 64.0f))); } else if (VAR == 1 || VAR == 4) sp = vmin_s(zin[g], 64.0f) * 0.5f; else sp = __builtin_amdgcn_logf(1.0f + __builtin_amdgcn_exp2f(vmin_s(zin[g], 64.0f)));
            if (MASKED) lv[i] = (crow(g, 0) < qrh) ? sp : 0.f; else lv[i] = sp; }
        unsigned w = cvtpk_h(lv[0], lv[1]);
        asm volatile("" : "+v"(w));
        if (k < 4) lw0[k & 3] = w; else lw1[k & 3] = w;
        SBAR();
    }
    const f16x8 um0 = *(LAS const f16x8*)ump, um1 = *(LAS const f16x8*)(ump + 16);
    zin = MFMA_F16(um0, __builtin_bit_cast(f16x8, lw0), zin); zin = MFMA_F16(um1, __builtin_bit_cast(f16x8, lw1), zin);
    SBAR();
    s16x4 la, ha, lb, hb;
    const unsigned vb0 = ad.vb0, vb1 = 2048 + (vb0 ^ 32);
    { const unsigned dq = vq; la = vtr(vprev + vb0 + dq); ha = vtr(vprev + vb1 + dq); }
#pragma unroll
    for (int j = 0; j < 8; ++j) {
        { const s16x4 lo = (j & 1) ? lb : la, hi = (j & 1) ? hb : ha;
          const bf16x8 vf = (bf16x8){lo[0], lo[1], lo[2], lo[3], hi[0], hi[1], hi[2], hi[3]};
          if (VAR == 2 || VAR == 4 || VAR == 11 || VAR == 13) { asm volatile("" :: "v"(vf)); } else o[j & 3] = MFMA_BF16(vf, __builtin_bit_cast(bf16x8, (j >> 2) ? pi1 : pi0), o[j & 3]);
          if (VAR == 12) { o[(j + 1) & 3] = MFMA_BF16(vf, __builtin_bit_cast(bf16x8, (j >> 2) ? pi1 : pi0), o[(j + 1) & 3]); o[(j + 2) & 3] = MFMA_BF16(vf, __builtin_bit_cast(bf16x8, (j >> 2) ? pi1 : pi0), o[(j + 2) & 3]); } }
        if (j + 1 < 8) { const unsigned dq = (64u * ((j + 1) & 3)) ^ vq; s16x4 l_, h_; if (VAR == 3 || VAR == 4 || VAR == 9 || VAR == 11 || VAR == 12 || VAR == 13) { l_ = (s16x4){(short)pi0[0], (short)pi0[1], (short)pi0[2], (short)pi0[3]}; h_ = l_; } else { l_ = vtr(vprev + 4096 * ((j + 1) >> 2) + vb0 + dq); h_ = vtr(vprev + 4096 * ((j + 1) >> 2) + vb1 + dq); }
            if (j & 1) { la = l_; ha = h_; } else { lb = l_; hb = h_; } }
        SBAR();
        float av[2];
#pragma unroll
        for (int i = 0; i < 2; ++i) { const int g = 2 * j + i; float a; if (VAR == 8 || VAR == 9 || VAR == 12) a = zin[g]; else if (VAR == 13) { a = __builtin_amdgcn_exp2f(zin[g] + carry); a = __builtin_amdgcn_exp2f(a + carry); a = __builtin_amdgcn_exp2f(a + carry); } else if (VAR == 1 || VAR == 4) a = zin[g] + carry; else a = __builtin_amdgcn_exp2f(zin[g] + carry); if (MASKED) av[i] = (crow(g, 0) < qrh) ? a : 0.f; else av[i] = a; }
        unsigned w = cvtpk(av[0], av[1]);
        asm volatile("" : "+v"(w));
        if (j < 4) po0[j & 3] = w; else po1[j & 3] = w;
        SBAR();
    }
    carry += bcast_lo(zin[0] - z0);
}
template <int KIMM, int VIMM>
DI void sb_iter_s(f32x16& zin, f32x16& zout, f32x16 (&o)[4], const u32x4& pi0, const u32x4& pi1, u32x4& po0, u32x4& po1, float& carry, const bf16x8 (&qf)[8], lcp ump,
                  const unsigned (&koff)[8], const unsigned (&voff)[2][4]) {
    u32x4 lw0, lw1; const float z0 = zin[0];
#define SB_KF(k) (*(LAS const bf16x8*)(koff[k] + (unsigned)KIMM))
#define SB_VF(t, j) vtr((lcp)(voff[t][(j) & 3] + (unsigned)(VIMM + 4096 * ((j) >> 2))))
    bf16x8 kfa = SB_KF(0), kfb;
    const f16x8 um0 = *(LAS const f16x8*)ump, um1 = *(LAS const f16x8*)(ump + 16);
    SBAR();
#pragma unroll
    for (int k = 0; k < 8; ++k) {
        if (k == 0) {
#pragma unroll
            for (int g = 0; g < 16; ++g) zout[g] = 0.f;
        }
        zout = MFMA_BF16((k & 1) ? kfb : kfa, qf[k], zout);
        if (k + 1 < 8) { const bf16x8 nx = SB_KF(k + 1); if (k & 1) kfa = nx; else kfb = nx; }
        SBAR();
        float lv[2];
#pragma unroll
        for (int i = 0; i < 2; ++i) lv[i] = __builtin_amdgcn_logf(1.0f + __builtin_amdgcn_exp2f(vmin_s(zin[2 * k + i], 64.0f)));
        unsigned w = cvtpk_h(lv[0], lv[1]);
        asm volatile("" : "+v"(w));
        if (k < 4) lw0[k & 3] = w; else lw1[k & 3] = w;
        SBAR();
    }
    s16x4 la = SB_VF(0, 0), ha = SB_VF(1, 0), lb, hb;
    SBAR();
    zin = MFMA_F16(um0, __builtin_bit_cast(f16x8, lw0), zin); zin = MFMA_F16(um1, __builtin_bit_cast(f16x8, lw1), zin);
    SBAR();
#pragma unroll
    for (int j = 0; j < 8; ++j) {
        { const s16x4 lo = (j & 1) ? lb : la, hi = (j & 1) ? hb : ha;
          const bf16x8 vf = (bf16x8){lo[0], lo[1], lo[2], lo[3], hi[0], hi[1], hi[2], hi[3]};
          o[j & 3] = MFMA_BF16(vf, __builtin_bit_cast(bf16x8, (j >> 2) ? pi1 : pi0), o[j & 3]); }
        if (j + 1 < 8) { const s16x4 l_ = SB_VF(0, j + 1), h_ = SB_VF(1, j + 1); if (j & 1) { la = l_; ha = h_; } else { lb = l_; hb = h_; } }
        SBAR();
        float av[2];
#pragma unroll
        for (int i = 0; i < 2; ++i) av[i] = __builtin_amdgcn_exp2f(zin[2 * j + i] + carry);
        unsigned w = cvtpk(av[0], av[1]);
        asm volatile("" : "+v"(w));
        if (j < 4) po0[j & 3] = w; else po1[j & 3] = w;
        SBAR();
    }
#undef SB_KF
#undef SB_VF
    carry += bcast_lo(zin[0] - z0);
}
template <int P>
DI void sb_tile_s(f32x16& za, f32x16& zb, f32x16 (&o)[4], u32x4 (&pa)[2], u32x4 (&pb)[2], float& carry, const bf16x8 (&qf)[8], lcp ump, const unsigned (&koff)[8], const unsigned (&voff)[2][4]) {
    constexpr int KS = P, KSN = (P + 1) % 3, VS = P, VSP = (P + 2) % 3;
    sb_iter_s<KS * SB_KBUF, VSP * VBUF>(za, zb, o, pa[0], pa[1], pb[0], pb[1], carry, qf, ump, koff, voff);
    sb_iter_s<KSN * SB_KBUF + 8192, VS * VBUF + 8192>(zb, za, o, pb[0], pb[1], pa[0], pa[1], carry, qf, ump, koff, voff);
}
template <bool MASKED, int VAR>
DI void sb_tile(LAS unsigned char* lds, f32x16& za, f32x16& zb, f32x16 (&o)[4], u32x4 (&pa)[2], u32x4 (&pb)[2], float& carry, const bf16x8 (&qf)[8], lcp ump, const SbAddr& ad,
                unsigned krow_off, int ks, int ksn, int vs, int vsp, int qrh0) {
    sb_iter<MASKED, VAR>(za, zb, o, pa[0], pa[1], pb[0], pb[1], carry, qf, ump, lds + ks * SB_KBUF + krow_off, lds + SB_LDS_V + vsp * VBUF, ad, qrh0 - 32);
    sb_iter<MASKED, VAR>(zb, za, o, pb[0], pb[1], pa[0], pa[1], carry, qf, ump, lds + ksn * SB_KBUF + 8192 + krow_off, lds + SB_LDS_V + vs * VBUF + 8192, ad, qrh0);
}
template <int VAR> DI void sb_unit(LAS unsigned char* lds, unsigned char* ws, int b, int h, int qb, const int tid_in) {
    int tid = tid_in; asm volatile("" : "+v"(tid));
    const int lane = tid & 63, wid = __builtin_amdgcn_readfirstlane(tid >> 6), r = lane & 31, hh = lane >> 5;
    const bf16_t *Q2 = (const bf16_t*)(ws + WS_Q2), *K2 = (const bf16_t*)(ws + WS_K2), *V2 = (const bf16_t*)(ws + WS_V2), *SG2 = (const bf16_t*)(ws + WS_SG2);
    bf16_t* MIX2 = (bf16_t*)(ws + (VAR ? WS_A : WS_MIX2));
    const int q0 = qb * 256, NT = 4 * (qb + 1), tmax = (q0 + 32 * wid) >> 6; const size_t rowbase = (size_t)b * SEQ;
    bf16x8 qf[8];
    { const size_t qrow = rowbase + q0 + 32 * wid + r;
#pragma unroll
      for (int d0 = 0; d0 < 8; ++d0) qf[d0] = *(const bf16x8*)(Q2 + qrow * 2048 + h * 128 + d0 * 16 + hh * 8); }
    { f16x8 um[2];
#pragma unroll
      for (int s = 0; s < 2; ++s)
#pragma unroll
          for (int j = 0; j < 8; ++j) um[s][j] = (16 * s + 8 * (j >> 2) + 4 * hh + (j & 3)) >= r ? (_Float16)-1.0f : (_Float16)0.0f;
      *(LAS f16x8*)(lds + SB_LDS_UM + lane * 32) = um[0]; *(LAS f16x8*)(lds + SB_LDS_UM + lane * 32 + 16) = um[1]; }
    lcp ump = lds + SB_LDS_UM + lane * 32;
    f32x16 o[4];
#pragma unroll
    for (int d0 = 0; d0 < 4; ++d0)
#pragma unroll
        for (int g = 0; g < 16; ++g) o[d0][g] = 0.f;
    float carry = 0.f;
    SbAddr ad;
    { const unsigned blk = (lane >> 4) & 1, qq = (lane & 15) >> 2, p = lane & 3;
      ad.kx = ((r & 15) >> 1) << 5;
      ad.vb0 = 256 * (4 * hh + qq) + 8 * (p & 1) + 16 * ((2 * blk + (p >> 1)) ^ hh); ad.vq = 64 * qq; }
    const unsigned krow_off = r * 256 + ((hh ^ (r & 1)) << 4);
    const bf16_t* kbase = K2 + rowbase * 2048 + h * 128; const bf16_t* vbase = V2 + rowbase * 2048 + h * 128;
#define SB_DMA_SRC() int t2_ = tid; asm volatile("" : "+v"(t2_)); const int ln_ = t2_ & 63, drow_ = 8 * wid + (ln_ >> 4), c15_ = ln_ & 15;
#define SB_DMAK(tau, slot) do { SB_DMA_SRC(); const unsigned s0_ = (unsigned)drow_ * 2048 + ((c15_ ^ (drow_ & 15)) * 8), s1_ = (unsigned)(drow_ + 4) * 2048 + ((c15_ ^ ((drow_ + 4) & 15)) * 8); \
        const bf16_t* kt = kbase + (size_t)(NT - 1 - (tau)) * (64 * 2048); LAS unsigned char* kd = lds + (slot) * SB_KBUF + wid * 2048; \
        lds_dma16(kt + s0_, kd); lds_dma16(kt + s1_, kd + 1024); } while (0)
#define SB_DMAV(tau, slot) do { SB_DMA_SRC(); const unsigned s0_ = (unsigned)drow_ * 2048 + ((c15_ ^ (((drow_ & 3) << 2) | ((drow_ >> 2) & 3))) * 8), s1_ = (unsigned)(drow_ + 4) * 2048 + ((c15_ ^ ((((drow_ + 4) & 3) << 2) | (((drow_ + 4) >> 2) & 3))) * 8); \
        const bf16_t* vt = vbase + (size_t)(NT - 1 - (tau)) * (64 * 2048); LAS unsigned char* vd = lds + SB_LDS_V + (slot) * VBUF + wid * 2048; \
        lds_dma16(vt + s0_, vd); lds_dma16(vt + s1_, vd + 1024); } while (0)
    SB_DMAK(0, 0); SB_DMAV(0, 0);
    if (NT > 1) SB_DMAK(1, 1);
    __builtin_amdgcn_s_waitcnt(0x0F70);
    __syncthreads();
    f32x16 za, zb;
#pragma unroll
    for (int g = 0; g < 16; ++g) { za[g] = 0.f; zb[g] = 0.f; }
    u32x4 pa[2], pb[2]; pa[0] = (u32x4){0u, 0u, 0u, 0u}; pa[1] = pa[0]; pb[0] = pa[0]; pb[1] = pa[0];
    int ks = 0, ks1 = 1, vs = 0, vsp = 0;
    const int nmask = NT - tmax;
    constexpr float SB_STOP = -140.0f;
    LAS unsigned* flg = (LAS unsigned*)(lds + SB_LDS_UM + 2048);
    bool wdone = false, alldone = false; int par = 0, lim = NT;
#define SB_CLOSE() { wdone = wdone | (__builtin_amdgcn_ballot_w64(carry > SB_STOP) == 0ull); lim = wdone ? (lim < tau + 1 ? lim : tau + 1) : lim;        \
        { int t5 = tid; asm volatile("" : "+v"(t5)); if ((t5 & 63) == 0) flg[par * 8 + wid] = wdone ? 1u : 0u; } \
        DMA_WAIT_ALL(); __syncthreads();            \
        { const u32x4 f0 = *(LAS const u32x4*)(flg + par * 8), f1 = *(LAS const u32x4*)(flg + par * 8 + 4); \
          alldone = __builtin_amdgcn_readfirstlane((int)(f0[0] & f0[1] & f0[2] & f0[3] & f1[0] & f1[1] & f1[2] & f1[3])) != 0; } par ^= 1; }
#define SB_INTERVAL(MASKED) { const int t = NT - 1 - tau; const int ks2 = (ks1 == 2) ? 0 : ks1 + 1, vs1 = (vs == 2) ? 0 : vs + 1; \
        if (tau + 2 < NT) SB_DMAK(tau + 2, ks2); \
        if (tau + 1 < NT) SB_DMAV(tau + 1, vs1); \
        int qrh0; { int t3 = tid; asm volatile("" : "+v"(t3)); qrh0 = q0 + 32 * wid + (t3 & 31) - 4 * ((t3 >> 5) & 1) - 64 * t; }        \
        sb_tile<MASKED, VAR>(lds, za, zb, o, pa, pb, carry, qf, ump, ad, krow_off, ks, (tau + 1 < NT ? ks1 : ks), vs, vsp, qrh0); \
        SB_CLOSE() \
        ks = ks1; ks1 = ks2; vsp = vs; vs = vs1; }
    int tau = 0;
    for (; tau < nmask - 1 && !alldone; ++tau) { const int ks2 = (ks1 == 2) ? 0 : ks1 + 1, vs1 = (vs == 2) ? 0 : vs + 1;
        if (tau + 2 < NT) SB_DMAK(tau + 2, ks2);
        if (tau + 1 < NT) SB_DMAV(tau + 1, vs1);
        SB_CLOSE()
        ks = ks1; ks1 = ks2; vsp = vs; vs = vs1; }
    { lcp kp = lds + ks * SB_KBUF + 8192 + krow_off;
#pragma unroll
      for (int k = 0; k < 8; ++k) za = MFMA_BF16(*(LAS const bf16x8*)(kp + ((32u * k) ^ ad.kx)), qf[k], za); }
    for (; tau < nmask && tau < lim; ++tau) SB_INTERVAL(true)
    for (; tau < lim; ++tau) SB_INTERVAL(false)
#undef SB_INTERVAL
    { lcp vp = lds + SB_LDS_V + vsp * VBUF;
#pragma unroll
      for (int j = 0; j < 8; ++j) { const unsigned dq = (64u * (j & 3)) ^ ad.vq;
          const s16x4 lo = vtr(vp + 4096 * (j >> 2) + ad.vb0 + dq), hi = vtr(vp + 4096 * (j >> 2) + 2048 + (ad.vb0 ^ 32) + dq);
          o[j & 3] = MFMA_BF16(((bf16x8){lo[0], lo[1], lo[2], lo[3], hi[0], hi[1], hi[2], hi[3]}), __builtin_bit_cast(bf16x8, (j >> 2) ? pa[1] : pa[0]), o[j & 3]); } }
    for (; tau < NT && !alldone; ++tau) { const int ks2 = (ks1 == 2) ? 0 : ks1 + 1, vs1 = (vs == 2) ? 0 : vs + 1;
        if (tau + 2 < NT) SB_DMAK(tau + 2, ks2);
        if (tau + 1 < NT) SB_DMAV(tau + 1, vs1);
        SB_CLOSE()
        ks = ks1; ks1 = ks2; vsp = vs; vs = vs1; }
#undef SB_CLOSE
    DMA_WAIT_ALL(); __syncthreads();
#undef SB_DMAK
#undef SB_DMAV
#undef SB_DMA_SRC
    int t4 = tid; asm volatile("" : "+v"(t4)); const size_t qrow = rowbase + q0 + 32 * wid + (t4 & 31); const int hh2 = (t4 >> 5) & 1;
#pragma unroll
    for (int d0 = 0; d0 < 4; ++d0)
#pragma unroll
        for (int p = 0; p < 2; ++p) { const size_t off = qrow * 2048 + h * 128 + 32 * d0 + 16 * p + 8 * hh2; float e[8]; o_pair8(o[d0], p, e);
            const u32x4 sg = *(const u32x4*)(SG2 + off); u32x4 w;
#pragma unroll
            for (int j = 0; j < 4; ++j) w[j] = cvtpk(e[2 * j] * __uint_as_float(sg[j] << 16), e[2 * j + 1] * __uint_as_float(sg[j] & 0xffff0000u));
            *(u32x4*)(MIX2 + off) = w; }
}
template <int VAR> DI void sb_phase(LAS unsigned char* lds, unsigned char* ws, const int tid) {
    const int G = gridDim.x, bx = blockIdx.x; const int vcu = (G % 8 == 0) ? (bx % 8) * (G / 8) + bx / 8 : bx;
    for (int p = vcu; p < 512; p += G) { const int bh = p >> 3, pr = p & 7; sb_unit<VAR>(lds, ws, bh >> 4, bh & 15, 15 - pr, tid); sb_unit<VAR>(lds, ws, bh >> 4, bh & 15, pr, tid); }
}

constexpr int DIL_KSTR = 272, DIL_WAVE_BYTES = 32 * DIL_KSTR + 8192, DIL_LDS_BYTES = 8 * DIL_WAVE_BYTES;
DI void softmax_blk(f32x16& s0, f32x16 (&o)[4], float& mrun, float& lrun) {
    float mt = s0[0];
#pragma unroll
    for (int g = 1; g < 16; ++g) mt = fmaxf(mt, s0[g]);
    mt = swap_max(mt);
    if (__builtin_amdgcn_ballot_w64(mt > mrun) != 0ull) {
        const float mn = fmaxf(mrun, mt), alpha = __builtin_amdgcn_exp2f(mrun - mn); mrun = mn; lrun *= alpha;
#pragma unroll
        for (int d0 = 0; d0 < 4; ++d0)
#pragma unroll
            for (int g = 0; g < 16; ++g) o[d0][g] *= alpha;
    }
    float ps = 0.f;
#pragma unroll
    for (int g = 0; g < 16; ++g) { s0[g] = __builtin_amdgcn_exp2f(s0[g] - mrun); ps += s0[g]; }
    lrun += ps;
}
DI void dil_wave_unit(LAS unsigned char* wl, unsigned char* ws, int p, int b, int h, int res, int m0w, const int tid_in) {
    int tid = tid_in; asm volatile("" : "+v"(tid));
    const int lane = tid & 63, r = lane & 31, hh = lane >> 5; const int dil = p == 0 ? 1 : p == 1 ? 4 : 16;
    const bf16_t *QB = (const bf16_t*)(ws + WS_QB), *KB = (const bf16_t*)(ws + WS_KB), *VB = (const bf16_t*)(ws + WS_VB);
    const size_t rowbase = (size_t)b * SEQ; const size_t qrow = rowbase + (size_t)(m0w + r) * dil + res;
    const __amdgpu_buffer_rsrc_t rK = mk_rsrc(KB, M * 1024 * 2), rV = mk_rsrc(VB, M * 1024 * 2);
    const unsigned vo = (unsigned)(lane >> 4) * dil * 2048 + (lane & 15) * 16;
    const unsigned so0 = (unsigned)((rowbase + res) * 1024 + h * 128) * 2;
    const float* biasc = (const float*)(ws + WS_BIASC) + (size_t)(p * 8 + h) * 5 * 1024 + lane * 16;
    u32x4 kr[8], vr[8]; f32x4 br[4];
    const int kb0 = m0w >> 5;
#define DIL_LOAD(di) do { const unsigned sb_ = so0 + (unsigned)(32 * (kb0 - (di))) * dil * 2048; \
        _Pragma("unroll") for (int i = 0; i < 8; ++i) { kr[i] = bload(rK, vo + (unsigned)(4 * i) * dil * 2048, sb_); vr[i] = bload(rV, vo + (unsigned)(4 * i) * dil * 2048, sb_); } \
        _Pragma("unroll") for (int j = 0; j < 4; ++j) br[j] = ((const f32x4*)(biasc + (di) * 1024))[j]; } while (0)
    DIL_LOAD(0);
    bf16x8 qf[8];
#pragma unroll
    for (int d0 = 0; d0 < 8; ++d0) qf[d0] = *(const bf16x8*)(QB + qrow * 1024 + h * 128 + d0 * 16 + hh * 8);
    f32x16 o[4];
#pragma unroll
    for (int d0 = 0; d0 < 4; ++d0)
#pragma unroll
        for (int g = 0; g < 16; ++g) o[d0][g] = 0.f;
    float mrun = -INFINITY, lrun = 0.f;
    const VAddr va = make_vaddr(lane);
    const unsigned lk = (lane >> 4) * DIL_KSTR + (lane & 15) * 16;
    for (int di = 0; di < 5; ++di) {
        if (kb0 - di < 0) break;
        asm volatile("s_waitcnt lgkmcnt(0)" ::: "memory");
#pragma unroll
        for (int i = 0; i < 8; ++i) { *(LAS u32x4*)(wl + lk + 4 * i * DIL_KSTR) = kr[i]; *(LAS u32x4*)(wl + 32 * DIL_KSTR + off_b((lane >> 4) + 4 * i, lane & 15)) = vr[i]; }
        f32x16 s0;
#pragma unroll
        for (int j = 0; j < 4; ++j) { s0[4 * j] = br[j][0]; s0[4 * j + 1] = br[j][1]; s0[4 * j + 2] = br[j][2]; s0[4 * j + 3] = br[j][3]; }
        if (di + 1 < 5 && kb0 - (di + 1) >= 0) DIL_LOAD(di + 1);
        asm volatile("s_waitcnt lgkmcnt(0)" ::: "memory");
        lcp kp = wl + r * DIL_KSTR + hh * 16;
#pragma unroll
        for (int d0 = 0; d0 < 8; ++d0) s0 = MFMA_BF16(*(LAS const bf16x8*)(kp + d0 * 32), qf[d0], s0);
        softmax_blk(s0, o, mrun, lrun);
        lcp vb = wl + 32 * DIL_KSTR;
#pragma unroll
        for (int s = 0; s < 2; ++s) { const bf16x8 pf = pack_bf(s0, s);
#pragma unroll
            for (int d0 = 0; d0 < 4; ++d0) o[d0] = MFMA_BF16(vfrag(vb, s, d0, va), pf, o[d0]); }
    }
#undef DIL_LOAD
    const float lt = swap_sum(lrun), inv = 1.0f / lt;
    bf16_t* OP = (bf16_t*)(ws + (p == 0 ? WS_OP0 : p == 1 ? WS_OP1 : WS_OP2));
#pragma unroll
    for (int d0 = 0; d0 < 4; ++d0)
#pragma unroll
        for (int gg = 0; gg < 4; ++gg) { const size_t off = qrow * 1024 + h * 128 + 32 * d0 + 8 * gg + 4 * hh;
            const unsigned lo = cvtpk(o[d0][4 * gg] * inv, o[d0][4 * gg + 1] * inv), hi = cvtpk(o[d0][4 * gg + 2] * inv, o[d0][4 * gg + 3] * inv);
            *(unsigned long long*)(OP + off) = (unsigned long long)lo | ((unsigned long long)hi << 32); }
    if (hh == 0) ((float*)(ws + WS_LSE))[((size_t)p * M + qrow) * 8 + h] = mrun + __builtin_amdgcn_logf(lt);
}
constexpr int DILW_LDS_BYTES = 12 * 8192;
DI void dil_wg_unit(LAS unsigned char* lds, unsigned char* ws, int p, int b, int h, int res, int m0, const int tid_in) {
    int tid = tid_in; asm volatile("" : "+v"(tid));
    const int lane = tid & 63, wid = __builtin_amdgcn_readfirstlane(tid >> 6), r = lane & 31, hh = lane >> 5; const int dil = p == 0 ? 1 : p == 1 ? 4 : 16;
    const bf16_t *QB = (const bf16_t*)(ws + WS_QB), *KB = (const bf16_t*)(ws + WS_KB), *VB = (const bf16_t*)(ws + WS_VB);
    const size_t rowbase = (size_t)b * SEQ; const size_t qrow = rowbase + (size_t)(m0 + 32 * wid + r) * dil + res;
    const int kbw = (m0 >> 5) - 4;
    const int prow = 4 * wid + (lane >> 4);
    const unsigned ksw = ((lane & 15) ^ (prow & 15)) * 8, vsw = ((lane & 15) ^ (((prow & 3) << 2) | ((prow >> 2) & 3))) * 8;
    const bf16_t* kg = KB + (rowbase + res) * 1024 + h * 128; const bf16_t* vg = VB + (rowbase + res) * 1024 + h * 128;
#pragma unroll
    for (int i = 0; i < 12; ++i) { const int kb = kbw + i; if (kb >= 0)
        __builtin_amdgcn_global_load_lds((const unsigned*)(kg + (size_t)(32 * kb + prow) * dil * 1024 + ksw), (LAS unsigned*)(lds + i * 8192 + wid * 1024), 16, 0, 0); }
    bf16x8 qf[8];
#pragma unroll
    for (int d0 = 0; d0 < 8; ++d0) qf[d0] = *(const bf16x8*)(QB + qrow * 1024 + h * 128 + d0 * 16 + hh * 8);
    const float* biasc = (const float*)(ws + WS_BIASC) + (size_t)(p * 8 + h) * 5 * 1024 + lane * 16;
    f32x16 sc[5];
#pragma unroll
    for (int di = 0; di < 5; ++di) { const f32x4* bp = (const f32x4*)(biasc + di * 1024);
#pragma unroll
        for (int j = 0; j < 4; ++j) { const f32x4 v = bp[j]; sc[di][4 * j] = v[0]; sc[di][4 * j + 1] = v[1]; sc[di][4 * j + 2] = v[2]; sc[di][4 * j + 3] = v[3]; } }
    __builtin_amdgcn_s_waitcnt(0x0F70);
    __syncthreads();
    const unsigned kx = ((r & 15) >> 1) << 5, krow_off = r * 256 + ((hh ^ (r & 1)) << 4);
#pragma unroll
    for (int di = 0; di < 5; ++di) { const int jj = wid + 4 - di;
        if (kbw + jj >= 0) { lcp kp = lds + jj * 8192 + krow_off;
#pragma unroll
            for (int k = 0; k < 8; ++k) sc[di] = MFMA_BF16(*(LAS const bf16x8*)(kp + ((32u * k) ^ kx)), qf[k], sc[di]); }
        else {
#pragma unroll
            for (int g = 0; g < 16; ++g) sc[di][g] = -INFINITY; } }
    float mx = sc[0][0];
#pragma unroll
    for (int di = 0; di < 5; ++di)
#pragma unroll
        for (int g = 0; g < 16; ++g) mx = fmaxf(mx, sc[di][g]);
    mx = swap_max(mx);
    float ps = 0.f; u32x4 pw[5][2];
#pragma unroll
    for (int di = 0; di < 5; ++di) {
#pragma unroll
        for (int g = 0; g < 16; ++g) { sc[di][g] = __builtin_amdgcn_exp2f(sc[di][g] - mx); ps += sc[di][g]; }
        pw[di][0] = __builtin_bit_cast(u32x4, pack_bf(sc[di], 0)); pw[di][1] = __builtin_bit_cast(u32x4, pack_bf(sc[di], 1)); }
    __syncthreads();
#pragma unroll
    for (int i = 0; i < 12; ++i) { const int kb = kbw + i; if (kb >= 0)
        __builtin_amdgcn_global_load_lds((const unsigned*)(vg + (size_t)(32 * kb + prow) * dil * 1024 + vsw), (LAS unsigned*)(lds + i * 8192 + wid * 1024), 16, 0, 0); }
    f32x16 o[4];
#pragma unroll
    for (int d0 = 0; d0 < 4; ++d0)
#pragma unroll
        for (int g = 0; g < 16; ++g) o[d0][g] = 0.f;
    const VAddr va = make_vaddr(lane);
    __builtin_amdgcn_s_waitcnt(0x0F70);
    __syncthreads();
#pragma unroll
    for (int di = 0; di < 5; ++di) { const int jj = wid + 4 - di;
        if (kbw + jj >= 0) { lcp vb = lds + jj * 8192;
#pragma unroll
            for (int s = 0; s < 2; ++s)
#pragma unroll
                for (int d0 = 0; d0 < 4; ++d0) o[d0] = MFMA_BF16(vfrag(vb, s, d0, va), __builtin_bit_cast(bf16x8, pw[di][s]), o[d0]); } }
    const float lt = swap_sum(ps), inv = 1.0f / lt;
    bf16_t* OP = (bf16_t*)(ws + (p == 0 ? WS_OP0 : p == 1 ? WS_OP1 : WS_OP2));
    { LAS unsigned char* stg = lds + DILW_LDS_BYTES + wid * 4608; const int rl = lane >> 3, ch = lane & 7;
#pragma unroll
      for (int half = 0; half < 2; ++half) {
#pragma unroll
        for (int dd = 0; dd < 2; ++dd)
#pragma unroll
            for (int gg = 0; gg < 4; ++gg) { const int d0 = 2 * half + dd;
                const unsigned lo = cvtpk(o[d0][4 * gg] * inv, o[d0][4 * gg + 1] * inv), hi = cvtpk(o[d0][4 * gg + 2] * inv, o[d0][4 * gg + 3] * inv);
                *(LAS unsigned long long*)(stg + r * 144 + (32 * dd + 8 * gg + 4 * hh) * 2) = (unsigned long long)lo | ((unsigned long long)hi << 32); }
#pragma unroll
        for (int j = 0; j < 4; ++j) { const u32x4 w = *(LAS const u32x4*)(stg + (8 * j + rl) * 144 + ch * 16);
            const size_t grow = rowbase + (size_t)(m0 + 32 * wid + 8 * j + rl) * dil + res;
            *(u32x4*)(OP + grow * 1024 + h * 128 + half * 64 + ch * 8) = w; } } }
    if (hh == 0) ((float*)(ws + WS_LSE))[((size_t)p * M + qrow) * 8 + h] = mx + __builtin_amdgcn_logf(lt);
    __syncthreads();
}
DI void dil_phase(LAS unsigned char* lds, unsigned char* ws, const int tid) {
    for (int u = blockIdx.x; u < 1536; u += gridDim.x) {
        const int cidx = u & 15, h = (u >> 4) & 7, b = (u >> 7) & 3, p = u >> 9;
        const int res = p == 0 ? 0 : p == 1 ? (cidx & 3) : cidx, m0 = p == 0 ? 256 * cidx : p == 1 ? 256 * (cidx >> 2) : 0;
        dil_wg_unit(lds, ws, p, b, h, res, m0, tid);
    }
}
}

__global__ void __launch_bounds__(512, 2) k_mla_fast(Ctx c) { extern __shared__ __attribute__((aligned(16))) unsigned char lds[]; att::mla_phase((LAS unsigned char*)lds, c.ws, (int)threadIdx.x); }
__global__ void __launch_bounds__(512, 2) k_sb_fast(Ctx c) { extern __shared__ __attribute__((aligned(16))) unsigned char lds[]; att::sb_phase<0>((LAS unsigned char*)lds, c.ws, (int)threadIdx.x); }
__global__ void __launch_bounds__(512, 2) k_dil_fast(Ctx c) { extern __shared__ __attribute__((aligned(16))) unsigned char lds[]; att::dil_phase((LAS unsigned char*)lds, c.ws, (int)threadIdx.x); }

template <bool FROMBF>
DI void final_norm_row(float* out, const bf16_t* xb, const float* gain, int row, int lane) {
    f32x4* xr = (f32x4*)(out + (size_t)row * D_MODEL) + lane; const f32x4* g = (const f32x4*)gain + lane;
    f32x4 v[8]; float s = 0.f;
    if (FROMBF) { const u32x4* br = (const u32x4*)(xb + (size_t)row * D_MODEL) + lane;
#pragma unroll
        for (int j = 0; j < 4; ++j) { const u32x4 w = br[64 * j];
            v[2 * j] = (f32x4){__uint_as_float(w[0] << 16), __uint_as_float(w[0] & 0xffff0000u), __uint_as_float(w[1] << 16), __uint_as_float(w[1] & 0xffff0000u)};
            v[2 * j + 1] = (f32x4){__uint_as_float(w[2] << 16), __uint_as_float(w[2] & 0xffff0000u), __uint_as_float(w[3] << 16), __uint_as_float(w[3] & 0xffff0000u)}; }
#pragma unroll
        for (int j = 0; j < 8; ++j) s += v[j].x * v[j].x + v[j].y * v[j].y + v[j].z * v[j].z + v[j].w * v[j].w;
        const float r = rsqrtf(wave_sum(s) * (1.0f / D_MODEL) + EPS);
        f32x4* o4 = (f32x4*)(out + (size_t)row * D_MODEL); const f32x4* g4 = (const f32x4*)gain;
#pragma unroll
        for (int j = 0; j < 4; ++j) { const int i0 = 128 * j + 2 * lane; o4[i0] = v[2 * j] * r * g4[i0]; o4[i0 + 1] = v[2 * j + 1] * r * g4[i0 + 1]; }
    } else {
#pragma unroll
        for (int j = 0; j < 8; ++j) { v[j] = xr[64 * j]; s += v[j].x * v[j].x + v[j].y * v[j].y + v[j].z * v[j].z + v[j].w * v[j].w; }
        const float r = rsqrtf(wave_sum(s) * (1.0f / D_MODEL) + EPS);
#pragma unroll
        for (int j = 0; j < 8; ++j) xr[64 * j] = v[j] * r * g[64 * j];
    }
}
__global__ void __launch_bounds__(256) k_final_norm(float* out, const float* gain) { final_norm_row<false>(out, nullptr, gain, blockIdx.x * 4 + (threadIdx.x >> 6), threadIdx.x & 63); }
__global__ void __launch_bounds__(256) k_final_norm_bf(float* out, const bf16_t* xb, const float* gain) { final_norm_row<true>(out, xb, gain, blockIdx.x * 4 + (threadIdx.x >> 6), threadIdx.x & 63); }

#define XB_TMO      128
#define XB_XCNT(j)  (256  + 64 * (j))
#define XB_XSUB(j)  (1280 + 64 * (j))
#define XB_XGEN(j)  (2304 + 64 * (j))
#define XB_TOP      3328
#define XB_TOPGEN   3392
#define XCD_BAR_WORDS 3456
#define XB_SPIN_CAP (1u << 22)
DI unsigned xb_ld(unsigned* p)              { return __hip_atomic_load(p, __ATOMIC_RELAXED, __HIP_MEMORY_SCOPE_AGENT); }
DI unsigned xb_add(unsigned* p, unsigned v) { return __hip_atomic_fetch_add(p, v, __ATOMIC_RELAXED, __HIP_MEMORY_SCOPE_AGENT); }
DI unsigned xb_xcc_id() { return (unsigned)__builtin_amdgcn_s_getreg((3 << 11) | 20) & 0xFu; }
#define XB_SPIN(cond, bar) do { unsigned _sp = 0; while (cond) { __builtin_amdgcn_s_sleep(1); \
    if ((++_sp & 255u) == 0u) { if (xb_ld(&(bar)[XB_TMO])) break; if (_sp > XB_SPIN_CAP) { atomicAdd(&(bar)[XB_TMO], 1u); break; } } } } while (0)
struct XcdBarrier { unsigned* bar; unsigned x; volatile LAS unsigned* st; };
DI XcdBarrier xcd_barrier_post(unsigned* bar, volatile LAS unsigned* st, int tid) {
    XcdBarrier b; b.bar = bar; b.x = xb_xcc_id(); b.st = st;
    if (tid == 0) (void)xb_add(&bar[XB_XCNT(b.x)], 1u);
    return b;
}
DI void xcd_barrier_complete(unsigned* bar, unsigned x, unsigned& nloc, unsigned& nx) {
    const unsigned G = gridDim.x * gridDim.y * gridDim.z;
    unsigned sum, cnt, mine, sp = 0u;
    for (;;) {
        sum = 0u; cnt = 0u; mine = 0u;
#pragma unroll
        for (unsigned j = 0; j < 16; ++j) { const unsigned c = xb_ld(&bar[XB_XCNT(j)]); sum += c; cnt += (c > 0u) ? 1u : 0u; mine = (j == x) ? c : mine; }
        if (sum == G) break;
        __builtin_amdgcn_s_sleep(1);
        if ((++sp & 255u) == 0u) { if (xb_ld(&bar[XB_TMO])) break; if (sp > XB_SPIN_CAP) { atomicAdd(&bar[XB_TMO], 1u); break; } }
    }
    nloc = mine > 0u ? mine : 1u; nx = cnt > 0u ? cnt : 1u;
}
DI void xcd_barrier(const XcdBarrier& b, int tid) {
    asm volatile("s_waitcnt vmcnt(0)" ::: "memory");
    __syncthreads();
    if (tid == 0) {
        unsigned* bar = b.bar;
        __builtin_amdgcn_s_waitcnt(0);
        unsigned nloc = b.st[0], nx = b.st[1];
        if (nloc == 0u) { xcd_barrier_complete(bar, b.x, nloc, nx); b.st[0] = nloc; b.st[1] = nx; }
        const unsigned old = xb_add(&bar[XB_XSUB(b.x)], 1u);
        const unsigned gen = old / nloc;
        if (old + 1u == (gen + 1u) * nloc) {
            __builtin_amdgcn_fence(__ATOMIC_RELEASE, "agent");
            asm volatile("s_waitcnt vmcnt(0)" ::: "memory");
            const unsigned og = xb_add(&bar[XB_TOP], 1u);
            const unsigned tg = og / nx;
            if (og + 1u == (tg + 1u) * nx) xb_add(&bar[XB_TOPGEN], 1u);
            else XB_SPIN(xb_ld(&bar[XB_TOPGEN]) == tg, bar);
            __builtin_amdgcn_fence(__ATOMIC_ACQUIRE, "agent");
            xb_add(&bar[XB_XGEN(b.x)], 1u);
            asm volatile("s_waitcnt vmcnt(0)" ::: "memory");
        } else {
            XB_SPIN(xb_ld(&bar[XB_XGEN(b.x)]) == gen, bar);
            __builtin_amdgcn_fence(__ATOMIC_ACQUIRE, "agent");
            asm volatile("s_waitcnt vmcnt(0)" ::: "memory");
        }
    }
    __syncthreads();
}

constexpr int MEGA_LDS_PHASE = 135168, MEGA_LDS = MEGA_LDS_PHASE + 64;
#ifndef P4_REP
#define P4_REP 1
#endif
#ifndef SYNC_PROBE
#define SYNC_PROBE 0
#endif
#ifndef SB_PROBE_VAR
#define SB_PROBE_VAR 0
#endif
#ifndef PROBE_MASK
#define PROBE_MASK 0
#endif
#define PREP(k) for (int rep_ = 0; rep_ < 1 + ((PROBE_MASK >> (k)) & 1); ++rep_)
__global__ void __launch_bounds__(512, 2) k_mega(Ctx c) {
    extern __shared__ __attribute__((aligned(16))) unsigned char lds_raw[];
    LAS unsigned char* lds = (LAS unsigned char*)lds_raw;
    unsigned char* ws = c.ws; const int G = gridDim.x, bx = blockIdx.x;
    const int wave_s = __builtin_amdgcn_readfirstlane((int)threadIdx.x >> 6);
    volatile LAS unsigned* bst = (volatile LAS unsigned*)(lds + MEGA_LDS_PHASE);
    if (threadIdx.x < 16) bst[threadIdx.x] = 0u;
    __syncthreads();
    const XcdBarrier xbar = xcd_barrier_post((unsigned*)(ws + WS_CTL), bst, (int)threadIdx.x);
#define GRID_BAR() xcd_barrier(xbar, phase_tid(wave_s))
    PREP(0) { prep_phase<8, 0>(c, (float*)lds_raw, phase_tid(wave_s)); __syncthreads(); }
    GRID_BAR();
    PREP(1) { pg8::Gemm g{(const bf16_t*)c.out, (const bf16_t*)(ws + WS_WT_IN_E), M, IN_EVEN_PAD, 2048}; pg8::StaticOrder S; S.init(g.M, g.N, G, bx);
      pg8::gemm_phase<pg8::FEpi1, pg8::StaticOrder, true, true>(lds, g, S, pg8::FEpi1{ws}, phase_tid(wave_s)); }
    { const int nlast = (M / 256) * (IN_EVEN_PAD / 256) % G; const int nfree = nlast ? G - nlast : G, me = nlast ? bx - nlast : bx;
      if (me >= 0) { const int tid = phase_tid(wave_s); prep_weights<1>(c, (float*)lds_raw + (tid >> 6) * 64 * 36, tid & 63, me * 8 + (tid >> 6), nfree * 8); } }
    GRID_BAR();
    PREP(2) { att::dil_phase(lds, ws, phase_tid(wave_s));
    __syncthreads(); }
    PREP(7) { pg8::Gemm g{(const bf16_t*)(ws + WS_CQ), (const bf16_t*)(ws + WS_WT_UQ), M, 1536, 512}; pg8::StaticOrder S; S.init(g.M, g.N, G, bx);
      pg8::gemm_phase<pg8::FEpi2a, pg8::StaticOrder, true, true>(lds, g, S, pg8::FEpi2a{ws}, phase_tid(wave_s)); }
    PREP(7) { pg8::Gemm g{(const bf16_t*)(ws + WS_CKV), (const bf16_t*)(ws + WS_WT_UKV), M, 2048, 512}; pg8::StaticOrder S; S.init(g.M, g.N, G, bx);
      pg8::gemm_phase<pg8::FEpi2b, pg8::StaticOrder, true, true>(lds, g, S, pg8::FEpi2b{ws}, phase_tid(wave_s)); }
    GRID_BAR();
    PREP(3) att::mla_phase(lds, ws, phase_tid(wave_s));
    PREP(8) { const int tid = phase_tid(wave_s); for (int it = bx * 512 + tid; it < M * 128; it += G * 512) dil_merge_item(ws, it >> 7, (it & 127) * 8); }
    GRID_BAR();
    PREP(4) { pg8::Gemm g{(const bf16_t*)(ws + WS_MIX), (const bf16_t*)(ws + WS_WT_OUT_E), M, 2048, 2048}; pg8::StaticOrder S; S.init(g.M, g.N, G, bx); S.rep = P4_REP;
      pg8::gemm_phase<pg8::FEpi4, pg8::StaticOrder, false, true>(lds, g, S, pg8::FEpi4{ws, (const bf16_t*)c.out}, phase_tid(wave_s)); }
    GRID_BAR();
    PREP(5) { pg8::Gemm g{(const bf16_t*)(ws + WS_X1BF), (const bf16_t*)(ws + WS_WT_IN_O), M, IN_ODD, 2048}; pg8::StaticOrder S; S.init(g.M, g.N, G, bx);
      pg8::gemm_phase<pg8::FEpi5, pg8::StaticOrder, true, true>(lds, g, S, pg8::FEpi5{ws}, phase_tid(wave_s)); }
    GRID_BAR();
    PREP(6) att::sb_phase<0>(lds, ws, phase_tid(wave_s));
#if SB_PROBE_VAR
    att::sb_phase<SB_PROBE_VAR>(lds, ws, phase_tid(wave_s));
#endif
    GRID_BAR();
    { pg8::Gemm g{(const bf16_t*)(ws + WS_MIX2), (const bf16_t*)(ws + WS_WT_OUT_O), M, 2048, 2048}; pg8::StaticOrder S; S.init(g.M, g.N, G, bx);
      pg8::gemm_phase<pg8::FEpi7, pg8::StaticOrder, false, true>(lds, g, S, pg8::FEpi7{(bf16_t*)(ws + WS_X2BF), (const bf16_t*)(ws + WS_X1BF)}, phase_tid(wave_s)); }
    GRID_BAR();
#if SYNC_PROBE
    for (int i_ = 0; i_ < 8; ++i_) GRID_BAR();
#endif
    { const int tid = phase_tid(wave_s); for (int row = bx * 8 + (tid >> 6); row < M; row += G * 8) final_norm_row<true>(c.out, (const bf16_t*)(ws + WS_X2BF), c.final_gain, row, tid & 63); }
}

#ifndef MK_ONE_LAUNCH
#define MK_ONE_LAUNCH 1
#endif
#ifndef FAST_G1
#define FAST_G1 1
#endif
#ifndef FAST_G2
#define FAST_G2 1
#endif
#ifndef FAST_G4
#define FAST_G4 1
#endif
#ifndef FAST_G5
#define FAST_G5 1
#endif
#ifndef FAST_G7
#define FAST_G7 1
#endif
#ifndef FAST_MLA
#define FAST_MLA 1
#endif
#ifndef FAST_SB
#define FAST_SB 1
#endif
#ifndef FAST_DIL
#define FAST_DIL 1
#endif
static void launch_att(void (*k)(Ctx), int lds_bytes, const Ctx& c, hipStream_t s) {
    (void)hipFuncSetAttribute((const void*)k, hipFuncAttributeMaxDynamicSharedMemorySize, lds_bytes);
    hipLaunchKernelGGL(k, dim3(256), dim3(512), lds_bytes, s, c);
}
template <class Epi> static void launch_gemm_fast(const bf16_t* A, const bf16_t* Bt, int N, int K, Epi E, hipStream_t s) {
    static bool attr = false; if (!attr) { (void)hipFuncSetAttribute((const void*)k_gemm_fast<Epi>, hipFuncAttributeMaxDynamicSharedMemorySize, 131072); attr = true; }
    pg8::Gemm g{A, Bt, M, N, K};
    k_gemm_fast<Epi><<<256, 512, 131072, s>>>(g, E);
}

extern "C" void kernel_launch(void* const* d_in, const int* in_sizes, int n_in, void* d_out, int out_size, void* d_ws, size_t ws_size, hipStream_t stream) {
    if (n_in != 12 || out_size != M * D_MODEL || ws_size < WS_END) { fprintf(stderr, "kernel_launch: unexpected shapes (n_in %d out %d ws %zu)\n", n_in, out_size, ws_size); return; }
    Ctx c{};
    c.x = (const float*)d_in[0]; c.norm_gain = (const float*)d_in[1]; c.w_in_even = (const float*)d_in[2]; c.q_norm_gain = (const float*)d_in[3]; c.kv_norm_gain = (const float*)d_in[4];
    c.w_uq = (const float*)d_in[5]; c.w_ukv = (const float*)d_in[6]; c.w_out_even = (const float*)d_in[7]; c.rel_bias = (const float*)d_in[8]; c.w_in_odd = (const float*)d_in[9];
    c.w_out_odd = (const float*)d_in[10]; c.final_gain = (const float*)d_in[11]; c.out = (float*)d_out; c.ws = (unsigned char*)d_ws;
#if MK_ONE_LAUNCH
    static int grid_blocks = 0;
    if (!grid_blocks) {
        int dev = 0, cus = 0, per_cu = 0;
        (void)hipGetDevice(&dev); (void)hipDeviceGetAttribute(&cus, hipDeviceAttributeMultiprocessorCount, dev);
        (void)hipFuncSetAttribute((const void*)k_mega, hipFuncAttributeMaxDynamicSharedMemorySize, MEGA_LDS);
        (void)hipOccupancyMaxActiveBlocksPerMultiprocessor(&per_cu, (const void*)k_mega, 512, MEGA_LDS);
        if (per_cu < 1) { fprintf(stderr, "kernel_launch: occupancy query says %d blocks/CU\n", per_cu); per_cu = 1; }
        grid_blocks = cus;
    }
    (void)hipMemsetAsync((char*)d_ws + WS_CTL, 0, 65536, stream);
    { void* args[] = {&c};
      hipError_t e = hipLaunchCooperativeKernel((void*)k_mega, dim3(grid_blocks), dim3(512), args, MEGA_LDS, stream);
      if (e != hipSuccess) fprintf(stderr, "cooperative launch failed: %s (grid %d)\n", hipGetErrorString(e), grid_blocks); }
    return;
#endif
    unsigned char* ws = c.ws;
    const float* rc = (const float*)(ws + WS_ROPE); const float* rs = rc + 4096 * 32;
    k_prep<<<2048, 256, 0, stream>>>(c);
#if FAST_G1
    launch_gemm_fast((const bf16_t*)c.out, (const bf16_t*)(ws + WS_WT_IN_E), IN_EVEN_PAD, 2048, pg8::FEpi1{ws}, stream);
#else
    k_gemm_naive<Epi1><<<(M / 64) * (IN_EVEN_PAD / 64), 256, 0, stream>>>((const bf16_t*)c.out, (const bf16_t*)(ws + WS_WT_IN_E), IN_EVEN_PAD, 2048, Epi1{ws});
    k_rowss<false><<<M / 4, 256, 0, stream>>>(ws + WS_CQ, 512, 512, (float*)(ws + WS_SSC), 16, 8);
    k_rowss<false><<<M / 4, 256, 0, stream>>>(ws + WS_CKV, 512, 512, (float*)(ws + WS_SSC) + 8, 16, 8);
    k_rope<<<(M * 32 + 255) / 256, 256, 0, stream>>>((bf16_t*)(ws + WS_KR), 1, rc, rs);
#endif
#if FAST_DIL
    launch_att(k_dil_fast, att::DIL_LDS_BYTES, c, stream);
#else
    k_dil_naive<<<BATCH * 8 * SEQ / 4, 256, 0, stream>>>(c);
#endif
#if FAST_G2
    launch_gemm_fast((const bf16_t*)(ws + WS_CQ), (const bf16_t*)(ws + WS_WT_UQ), 1536, 512, pg8::FEpi2a{ws}, stream);
    launch_gemm_fast((const bf16_t*)(ws + WS_CKV), (const bf16_t*)(ws + WS_WT_UKV), 2048, 512, pg8::FEpi2b{ws}, stream);
#else
    k_gemm_naive<Epi2a><<<(M / 64) * (1536 / 64), 256, 0, stream>>>((const bf16_t*)(ws + WS_CQ), (const bf16_t*)(ws + WS_WT_UQ), 1536, 512, Epi2a{ws});
    k_rope<<<(M * 256 + 255) / 256, 256, 0, stream>>>((bf16_t*)(ws + WS_QR), 8, rc, rs);
    k_gemm_naive<Epi2b><<<(M / 64) * (2048 / 64), 256, 0, stream>>>((const bf16_t*)(ws + WS_CKV), (const bf16_t*)(ws + WS_WT_UKV), 2048, 512, Epi2b{ws});
#endif
#if FAST_MLA
    launch_att(k_mla_fast, att::M2_LDS_BYTES > att::MLA_LDS_BYTES ? att::M2_LDS_BYTES : att::MLA_LDS_BYTES, c, stream);
#else
    k_mla_naive<<<BATCH * 8 * SEQ / 4, 256, 0, stream>>>(c);
#endif
    k_dil_merge<<<M, 128, 0, stream>>>(c);
#if FAST_G4
    launch_gemm_fast((const bf16_t*)(ws + WS_MIX), (const bf16_t*)(ws + WS_WT_OUT_E), 2048, 2048, pg8::FEpi4{ws, (const bf16_t*)c.out}, stream);
#else
    k_gemm_naive<Epi4><<<(M / 64) * (2048 / 64), 256, 0, stream>>>((const bf16_t*)(ws + WS_MIX), (const bf16_t*)(ws + WS_WT_OUT_E), 2048, 2048, Epi4{ws, c.x, c.out});
    k_rowss<true><<<M / 4, 256, 0, stream>>>(c.out, 2048, 2048, (float*)(ws + WS_SSX1), 32, 32);
#endif
#if FAST_G5
    launch_gemm_fast((const bf16_t*)(ws + WS_X1BF), (const bf16_t*)(ws + WS_WT_IN_O), IN_ODD, 2048, pg8::FEpi5{ws}, stream);
#else
    k_gemm_naive<Epi5><<<(M / 64) * (IN_ODD / 64), 256, 0, stream>>>((const bf16_t*)(ws + WS_X1BF), (const bf16_t*)(ws + WS_WT_IN_O), IN_ODD, 2048, Epi5{ws});
#endif
#if FAST_SB
    launch_att(k_sb_fast, att::SB_LDS_BYTES, c, stream);
#else
    k_sb_naive<<<BATCH * 16 * SEQ / 4, 256, 0, stream>>>(c);
#endif
#if FAST_G7
    launch_gemm_fast((const bf16_t*)(ws + WS_MIX2), (const bf16_t*)(ws + WS_WT_OUT_O), 2048, 2048, pg8::FEpi7{(bf16_t*)(ws + WS_X2BF), (const bf16_t*)(ws + WS_X1BF)}, stream);
#else
    k_gemm_naive<Epi7><<<(M / 64) * (2048 / 64), 256, 0, stream>>>((const bf16_t*)(ws + WS_MIX2), (const bf16_t*)(ws + WS_WT_OUT_O), 2048, 2048, Epi7{c.out});
#endif
#if FAST_G7
    k_final_norm_bf<<<M / 4, 256, 0, stream>>>(c.out, (const bf16_t*)(ws + WS_X2BF), c.final_gain);
#else
    k_final_norm<<<M / 4, 256, 0, stream>>>(c.out, c.final_gain);
#endif
}
```
